# Optimizing an MI355X kernel written in HIP

```python
import math
import jax
import jax.numpy as jnp
from jax import lax
import numpy as np

D_MODEL = 2048
BATCH = 8
SEQ = 2048
DEPTH = 2

GRID_W = 64
CTX_LEN = 256
HEAD_DIM = 128
ROPE_THETA = 10000.0
NORM_EPS = 1e-6
Q_BLOCK = 128

A_HEADS = 8
A_KV_HEADS = 2
B_HEADS = 8
B_Q_LORA = 512
B_KV_LORA = 512
B_NOPE = 128
B_ROPE = 64
B_V = 128
C_HEADS = 8
C_HD = 64
C_V = 2 * C_HD
D_HEADS = 8
D_KV_HEADS = 2
WINDOW = 128

EVEN_SIZES = [A_HEADS * HEAD_DIM, A_KV_HEADS * HEAD_DIM, A_KV_HEADS * HEAD_DIM, B_Q_LORA, B_KV_LORA, B_ROPE]
EVEN_IN = sum(EVEN_SIZES)
EVEN_MIX = A_HEADS * HEAD_DIM + B_HEADS * B_V
ODD_SIZES = [C_HEADS * 2 * C_HD, C_HEADS * 2 * C_HD, C_HEADS * C_V, D_HEADS * HEAD_DIM, D_KV_HEADS * HEAD_DIM, D_KV_HEADS * HEAD_DIM]
ODD_IN = sum(ODD_SIZES)
ODD_MIX = C_HEADS * C_V + D_HEADS * HEAD_DIM

N_GROUPS = 4
EXPERTS_PER_GROUP = 8
N_EXPERTS = N_GROUPS * EXPERTS_PER_GROUP
TOP_K_IN_GROUP = 2
D_EXPERT = 1024
MOE_BLOCK = 128

N_EVEN = (DEPTH + 1) // 2
N_ODD = DEPTH // 2

kernel_name = 'hybrid_diffusion_trunk'


def rms_norm(x, gain=None):
    xf = x.astype(jnp.float32)
    y = xf * lax.rsqrt(jnp.mean(xf * xf, axis=-1, keepdims=True) + NORM_EPS)
    if gain is not None:
        y = y * gain.astype(jnp.float32)
    return y.astype(x.dtype)


def modulate(x, shift, scale):
    return rms_norm(x) * (1 + scale) + shift


def split_cols(p, sizes):
    return jnp.split(p, np.cumsum(sizes)[:-1].tolist(), axis=-1)


def axial_rope_tables(row, col, dim):
    n_freq = dim // 4
    inv = 1.0 / (ROPE_THETA ** (jnp.arange(n_freq, dtype=jnp.float32) / n_freq))
    ang_r = row.astype(jnp.float32)[:, None] * inv
    ang_c = col.astype(jnp.float32)[:, None] * inv
    ang = jnp.concatenate([ang_r, ang_r, ang_c, ang_c], axis=-1)
    return jnp.cos(ang), jnp.sin(ang)


def rotate_half(u):
    u1, u2 = jnp.split(u, 2, axis=-1)
    return jnp.concatenate([-u2, u1], axis=-1)


def apply_axial_rope(x, cos, sin):
    xr, xc = jnp.split(x, 2, axis=-1)
    rot = jnp.concatenate([rotate_half(xr), rotate_half(xc)], axis=-1)
    y = x.astype(jnp.float32) * cos[:, None, :] + rot.astype(jnp.float32) * sin[:, None, :]
    return y.astype(x.dtype)


def sweep_query_blocks(fn, *qs):
    bsz, seq = qs[0].shape[:2]
    nb = seq // Q_BLOCK
    blocks = tuple(jnp.moveaxis(q.reshape((bsz, nb, Q_BLOCK) + q.shape[2:]), 1, 0) for q in qs)
    out = lax.map(lambda args: fn(*args), blocks)
    out = jnp.moveaxis(out, 0, 1)
    return out.reshape((bsz, seq) + out.shape[3:])


def gqa_attend(q, k, v, scale):
    bsz, nq, nh, d = q.shape
    kvh = k.shape[2]
    qg = q.reshape(bsz, nq, kvh, nh // kvh, d)
    s = jnp.einsum('bqkgd,btkd->bkgqt', qg, k).astype(jnp.float32) * scale
    p = jax.nn.softmax(s, axis=-1).astype(v.dtype)
    o = jnp.einsum('bkgqt,btkd->bqkgd', p, v)
    return o.reshape(bsz, nq, nh, v.shape[-1])


def diff_attend(q, k, v, lam, scale):
    s = jnp.einsum('bqhcd,bthcd->bhcqt', q, k).astype(jnp.float32) * scale
    p = jax.nn.softmax(s, axis=-1)
    pd = (p[:, :, 0] - lam * p[:, :, 1]).astype(v.dtype)
    return jnp.einsum('bhqt,bthd->bqhd', pd, v)


def window_sink_attend(q, k, v, kc, vc, sink, scale):
    bsz, seq, nh, d = q.shape
    kvh = k.shape[2]
    g = nh // kvh
    nb = seq // Q_BLOCK
    n_ctx = kc.shape[1]
    qb = q.reshape(bsz, nb, Q_BLOCK, kvh, g, d)

    def band(u):
        ub = u.reshape(bsz, nb, Q_BLOCK, kvh, u.shape[-1])
        up = jnp.pad(ub, ((0, 0), (1, 1), (0, 0), (0, 0), (0, 0)))
        return jnp.concatenate([up[:, :-2], up[:, 1:-1], up[:, 2:]], axis=2)

    kband, vband = band(k), band(v)
    qi = jnp.arange(Q_BLOCK)
    kj = jnp.arange(3 * Q_BLOCK) - Q_BLOCK
    near = jnp.abs(kj[None, :] - qi[:, None]) <= WINDOW
    absj = jnp.arange(nb)[:, None] * Q_BLOCK + kj[None, :]
    inside = (absj >= 0) & (absj < seq)
    mask = near[None, :, :] & inside[:, None, :]
    s_loc = jnp.einsum('bnqkgd,bntkd->bnkgqt', qb, kband).astype(jnp.float32) * scale
    s_loc = jnp.where(mask[None, :, None, None], s_loc, -jnp.inf)
    s_ctx = jnp.einsum('bnqkgd,btkd->bnkgqt', qb, kc).astype(jnp.float32) * scale
    s_sink = jnp.broadcast_to(sink.astype(jnp.float32).reshape(1, 1, kvh, g, 1, 1), s_ctx.shape[:-1] + (1,))
    p = jax.nn.softmax(jnp.concatenate([s_ctx, s_loc, s_sink], axis=-1), axis=-1).astype(v.dtype)
    o = (jnp.einsum('bnkgqt,btkd->bnqkgd', p[..., :n_ctx], vc)
         + jnp.einsum('bnkgqt,bntkd->bnqkgd', p[..., n_ctx:n_ctx + 3 * Q_BLOCK], vband))
    return o.reshape(bsz, seq, nh, v.shape[-1])


def ctx_sink_attend(q, kc, vc, sink, scale):
    bsz, n_ctx, nh, d = q.shape
    kvh = kc.shape[2]
    g = nh // kvh
    qg = q.reshape(bsz, n_ctx, kvh, g, d)
    s = jnp.einsum('bqkgd,btkd->bkgqt', qg, kc).astype(jnp.float32) * scale
    s_sink = jnp.broadcast_to(sink.astype(jnp.float32).reshape(1, kvh, g, 1, 1), s.shape[:-1] + (1,))
    p = jax.nn.softmax(jnp.concatenate([s, s_sink], axis=-1), axis=-1)[..., :-1].astype(vc.dtype)
    o = jnp.einsum('bkgqt,btkd->bqkgd', p, vc)
    return o.reshape(bsz, n_ctx, nh, vc.shape[-1])


def even_mixer(ax, ac, w_in, w_out, a_qn, a_kn, b_cqn, b_wuq, b_ckvn, b_wukv, b_qn, b_kn, rope_128, rope_64, with_ctx):
    scale_a = HEAD_DIM ** -0.5
    scale_b = (B_NOPE + B_ROPE) ** -0.5

    def project(h, use_rope):
        bsz, t, _ = h.shape
        qa, ka, va, cq, ckv, kr = split_cols(h @ w_in, EVEN_SIZES)
        qa = rms_norm(qa.reshape(bsz, t, A_HEADS, HEAD_DIM), a_qn)
        ka = rms_norm(ka.reshape(bsz, t, A_KV_HEADS, HEAD_DIM), a_kn)
        va = va.reshape(bsz, t, A_KV_HEADS, HEAD_DIM)
        qb = (rms_norm(cq, b_cqn) @ b_wuq).reshape(bsz, t, B_HEADS, B_NOPE + B_ROPE)
        kv = (rms_norm(ckv, b_ckvn) @ b_wukv).reshape(bsz, t, B_HEADS, B_NOPE + B_V)
        kn, vb = jnp.split(kv, [B_NOPE], axis=-1)
        kb = jnp.concatenate([kn, jnp.broadcast_to(kr[:, :, None, :], (bsz, t, B_HEADS, B_ROPE))], axis=-1)
        qb = rms_norm(qb, b_qn)
        kb = rms_norm(kb, b_kn)
        if use_rope:
            qa = apply_axial_rope(qa, *rope_128)
            ka = apply_axial_rope(ka, *rope_128)
            qb = jnp.concatenate([qb[..., :B_NOPE], apply_axial_rope(qb[..., B_NOPE:], *rope_64)], axis=-1)
            kb = jnp.concatenate([kb[..., :B_NOPE], apply_axial_rope(kb[..., B_NOPE:], *rope_64)], axis=-1)
        return qa, ka, va, qb, kb, vb

    qax, kax, vax, qbx, kbx, vbx = project(ax, True)
    qac, kac, vac, qbc, kbc, vbc = project(ac, False)
    ka_all = jnp.concatenate([kac, kax], axis=1)
    va_all = jnp.concatenate([vac, vax], axis=1)
    kb_all = jnp.concatenate([kbc, kbx], axis=1)
    vb_all = jnp.concatenate([vbc, vbx], axis=1)

    def block(qa_blk, qb_blk):
        oa = gqa_attend(qa_blk, ka_all, va_all, scale_a)
        ob = gqa_attend(qb_blk, kb_all, vb_all, scale_b)
        return jnp.concatenate([oa.reshape(oa.shape[:2] + (-1,)), ob.reshape(ob.shape[:2] + (-1,))], axis=-1)

    ox = sweep_query_blocks(block, qax, qbx) @ w_out
    oc = None
    if with_ctx:
        oa = gqa_attend(qac, kac, vac, scale_a)
        ob = gqa_attend(qbc, kbc, vbc, scale_b)
        oc = jnp.concatenate([oa.reshape(oa.shape[:2] + (-1,)), ob.reshape(ob.shape[:2] + (-1,))], axis=-1) @ w_out
    return ox, oc


def odd_mixer(ax, ac, w_in, w_out, c_qn, c_kn, lq1, lk1, lq2, lk2, c_subln, d_qn, d_kn, d_sink,
              lambda_init, rope_64, rope_128, with_ctx):
    scale_c = C_HD ** -0.5
    scale_d = HEAD_DIM ** -0.5

    def project(h, use_rope):
        bsz, t, _ = h.shape
        qc, kc, vc, qd, kd, vd = split_cols(h @ w_in, ODD_SIZES)
        qc = rms_norm(qc.reshape(bsz, t, 2 * C_HEADS, C_HD), c_qn)
        kc = rms_norm(kc.reshape(bsz, t, 2 * C_HEADS, C_HD), c_kn)
        qd = rms_norm(qd.reshape(bsz, t, D_HEADS, HEAD_DIM), d_qn)
        kd = rms_norm(kd.reshape(bsz, t, D_KV_HEADS, HEAD_DIM), d_kn)
        if use_rope:
            qc = apply_axial_rope(qc, *rope_64)
            kc = apply_axial_rope(kc, *rope_64)
            qd = apply_axial_rope(qd, *rope_128)
            kd = apply_axial_rope(kd, *rope_128)
        return (qc.reshape(bsz, t, C_HEADS, 2, C_HD), kc.reshape(bsz, t, C_HEADS, 2, C_HD),
                vc.reshape(bsz, t, C_HEADS, C_V), qd, kd, vd.reshape(bsz, t, D_KV_HEADS, HEAD_DIM))

    lam = (jnp.exp(jnp.sum(lq1.astype(jnp.float32) * lk1.astype(jnp.float32)))
           - jnp.exp(jnp.sum(lq2.astype(jnp.float32) * lk2.astype(jnp.float32))) + lambda_init)
    qcx, kcx, vcx, qdx, kdx, vdx = project(ax, True)
    qcc, kcc, vcc, qdc, kdc, vdc = project(ac, False)
    kc_all = jnp.concatenate([kcc, kcx], axis=1)
    vc_all = jnp.concatenate([vcc, vcx], axis=1)

    def diff_head_out(o):
        o = rms_norm(o, c_subln) * (1 - lambda_init)
        return o.reshape(o.shape[:2] + (-1,))

    def diff_block(q_blk):
        return diff_head_out(diff_attend(q_blk, kc_all, vc_all, lam, scale_c))

    oc_x = sweep_query_blocks(diff_block, qcx)
    od_x = window_sink_attend(qdx, kdx, vdx, kdc, vdc, d_sink, scale_d)
    ox = jnp.concatenate([oc_x, od_x.reshape(od_x.shape[:2] + (-1,))], axis=-1) @ w_out
    oc = None
    if with_ctx:
        oc_c = diff_head_out(diff_attend(qcc, kcc, vcc, lam, scale_c))
        od_c = ctx_sink_attend(qdc, kdc, vdc, d_sink, scale_d)
        oc = jnp.concatenate([oc_c, od_c.reshape(od_c.shape[:2] + (-1,))], axis=-1) @ w_out
    return ox, oc


def routed_experts(h, expert_idx, gates, w_gate, w_up, w_down):
    n_tok, d = h.shape
    k = expert_idx.shape[1]
    n_assign = n_tok * k
    flat_e = expert_idx.reshape(-1)
    order = jnp.argsort(flat_e)
    sorted_e = flat_e[order]
    tok = order // k
    counts = jnp.bincount(flat_e, length=N_EXPERTS)
    padded = (counts + MOE_BLOCK - 1) // MOE_BLOCK * MOE_BLOCK
    start = jnp.cumsum(counts) - counts
    pad_end = jnp.cumsum(padded)
    pad_start = pad_end - padded
    dest = pad_start[sorted_e] + jnp.arange(n_assign) - start[sorted_e]
    n_blocks = -(-n_assign // MOE_BLOCK) + N_EXPERTS
    slot_tok = jnp.full((n_blocks * MOE_BLOCK,), n_tok, jnp.int32).at[dest].set(tok.astype(jnp.int32))
    block_expert = jnp.minimum(jnp.searchsorted(pad_end, jnp.arange(n_blocks) * MOE_BLOCK, side='right'), N_EXPERTS - 1)
    h_pad = jnp.concatenate([h, jnp.zeros((1, d), h.dtype)], axis=0)

    def expert_block(args):
        toks, e = args
        xb = h_pad[toks]
        u = jax.nn.silu(xb @ w_gate[e]) * (xb @ w_up[e])
        return u @ w_down[e]

    y_slots = lax.map(expert_block, (slot_tok.reshape(n_blocks, MOE_BLOCK), block_expert)).reshape(-1, d)
    w_sorted = gates.reshape(-1)[order].astype(h.dtype)
    return jnp.zeros_like(h).at[tok].add(y_slots[dest] * w_sorted[:, None])


def hier_moe(h, wr_g, br_g, wr_e, br_e, w_gate, w_up, w_down):
    n_tok = h.shape[0]
    p_group = jax.nn.softmax((h @ wr_g).astype(jnp.float32) + br_g.astype(jnp.float32), axis=-1)
    p_top, g_idx = lax.top_k(p_group, 1)
    e_logits = ((h @ wr_e).astype(jnp.float32) + br_e.astype(jnp.float32)).reshape(n_tok, N_GROUPS, EXPERTS_PER_GROUP)
    e_in = e_logits[jnp.arange(n_tok), g_idx[:, 0]]
    l_top, e_loc = lax.top_k(e_in, TOP_K_IN_GROUP)
    gates = p_top * jax.nn.softmax(l_top, axis=-1)
    expert_idx = g_idx * EXPERTS_PER_GROUP + e_loc
    return routed_experts(h, expert_idx, gates, w_gate, w_up, w_down)


def setup_inputs(seed: int = 0) -> dict:
    key = jax.random.key(seed)
    keys = jax.random.split(key, 64)
    counter = [0]

    def normal(shape, scale):
        counter[0] += 1
        return jax.random.normal(keys[counter[0] - 1], shape, dtype=jnp.float32) * scale

    def gain(shape):
        return 1.0 + normal(shape, 0.05)

    d = D_MODEL
    return {
        'x': normal((BATCH, SEQ, d), 1.0),
        'c': normal((BATCH, d), 1.0),
        'ctx': normal((BATCH, CTX_LEN, d), 1.0),
        'c_ctx': normal((d,), 1.0),
        'mod_w': normal((DEPTH, d, 6 * d), 0.5 * d ** -0.5),
        'mod_b': normal((DEPTH, 6 * d), 0.01),
        'even_w_in': normal((N_EVEN, d, EVEN_IN), d ** -0.5),
        'even_w_out': normal((N_EVEN, EVEN_MIX, d), EVEN_MIX ** -0.5),
        'a_q_norm': gain((N_EVEN, HEAD_DIM)),
        'a_k_norm': gain((N_EVEN, HEAD_DIM)),
        'b_cq_norm': gain((N_EVEN, B_Q_LORA)),
        'b_w_uq': normal((N_EVEN, B_Q_LORA, B_HEADS * (B_NOPE + B_ROPE)), B_Q_LORA ** -0.5),
        'b_ckv_norm': gain((N_EVEN, B_KV_LORA)),
        'b_w_ukv': normal((N_EVEN, B_KV_LORA, B_HEADS * (B_NOPE + B_V)), B_KV_LORA ** -0.5),
        'b_q_norm': gain((N_EVEN, B_NOPE + B_ROPE)),
        'b_k_norm': gain((N_EVEN, B_NOPE + B_ROPE)),
        'odd_w_in': normal((N_ODD, d, ODD_IN), d ** -0.5),
        'odd_w_out': normal((N_ODD, ODD_MIX, d), ODD_MIX ** -0.5),
        'c_q_norm': gain((N_ODD, C_HD)),
        'c_k_norm': gain((N_ODD, C_HD)),
        'c_lambda_q1': normal((N_ODD, C_HD), 0.1),
        'c_lambda_k1': normal((N_ODD, C_HD), 0.1),
        'c_lambda_q2': normal((N_ODD, C_HD), 0.1),
        'c_lambda_k2': normal((N_ODD, C_HD), 0.1),
        'c_subln': gain((N_ODD, C_V)),
        'd_q_norm': gain((N_ODD, HEAD_DIM)),
        'd_k_norm': gain((N_ODD, HEAD_DIM)),
        'd_sink': normal((N_ODD, D_HEADS), 0.5),
        'moe_wr_group': normal((DEPTH, d, N_GROUPS), d ** -0.5),
        'moe_br_group': normal((DEPTH, N_GROUPS), 0.01),
        'moe_wr_expert': normal((DEPTH, d, N_EXPERTS), d ** -0.5),
        'moe_br_expert': normal((DEPTH, N_EXPERTS), 0.01),
        'moe_w_gate': normal((DEPTH, N_EXPERTS, d, D_EXPERT), d ** -0.5),
        'moe_w_up': normal((DEPTH, N_EXPERTS, d, D_EXPERT), d ** -0.5),
        'moe_w_down': normal((DEPTH, N_EXPERTS, D_EXPERT, d), D_EXPERT ** -0.5),
    }


def reference(x, c, ctx, c_ctx, mod_w, mod_b, even_w_in, even_w_out, a_q_norm, a_k_norm, b_cq_norm, b_w_uq,
              b_ckv_norm, b_w_ukv, b_q_norm, b_k_norm, odd_w_in, odd_w_out, c_q_norm, c_k_norm, c_lambda_q1,
              c_lambda_k1, c_lambda_q2, c_lambda_k2, c_subln, d_q_norm, d_k_norm, d_sink, moe_wr_group,
              moe_br_group, moe_wr_expert, moe_br_expert, moe_w_gate, moe_w_up, moe_w_down):
    bsz, seq, d = x.shape
    rows = seq // GRID_W
    row = jnp.repeat(jnp.arange(rows), GRID_W)
    col = jnp.tile(jnp.arange(GRID_W), rows)
    rope_128 = axial_rope_tables(row, col, HEAD_DIM)
    rope_64 = axial_rope_tables(row, col, B_ROPE)

    h_x, h_c = x, ctx
    for layer in range(DEPTH):
        last = layer == DEPTH - 1
        i = layer // 2
        mod_x = jax.nn.silu(c) @ mod_w[layer] + mod_b[layer]
        mod_c = jax.nn.silu(c_ctx) @ mod_w[layer] + mod_b[layer]
        sh1, sc1, g1, sh2, sc2, g2 = jnp.split(mod_x[:, None, :], 6, axis=-1)
        csh1, csc1, cg1, csh2, csc2, cg2 = jnp.split(mod_c, 6, axis=-1)

        ax = modulate(h_x, sh1, sc1)
        ac = modulate(h_c, csh1, csc1)
        if layer % 2 == 0:
            ox, oc = even_mixer(ax, ac, even_w_in[i], even_w_out[i], a_q_norm[i], a_k_norm[i], b_cq_norm[i],
                                b_w_uq[i], b_ckv_norm[i], b_w_ukv[i], b_q_norm[i], b_k_norm[i],
                                rope_128, rope_64, not last)
        else:
            lambda_init = 0.8 - 0.6 * math.exp(-0.3 * layer)
            ox, oc = odd_mixer(ax, ac, odd_w_in[i], odd_w_out[i], c_q_norm[i], c_k_norm[i], c_lambda_q1[i],
                               c_lambda_k1[i], c_lambda_q2[i], c_lambda_k2[i], c_subln[i], d_q_norm[i],
                               d_k_norm[i], d_sink[i], lambda_init, rope_64, rope_128, not last)
        h_x = h_x + g1 * ox
        fx = modulate(h_x, sh2, sc2)
        moe_args = (moe_wr_group[layer], moe_br_group[layer], moe_wr_expert[layer], moe_br_expert[layer],
                    moe_w_gate[layer], moe_w_up[layer], moe_w_down[layer])
        if last:
            yx = hier_moe(fx.reshape(-1, d), *moe_args)
            h_x = h_x + g2 * yx.reshape(bsz, seq, d)
        else:
            h_c = h_c + cg1 * oc
            fc = modulate(h_c, csh2, csc2)
            y = hier_moe(jnp.concatenate([fx.reshape(-1, d), fc.reshape(-1, d)], axis=0), *moe_args)
            h_x = h_x + g2 * y[:bsz * seq].reshape(bsz, seq, d)
            h_c = h_c + cg2 * y[bsz * seq:].reshape(h_c.shape)
    return h_x
```

```cpp
#include <hip/hip_runtime.h>
#include <cstdio>
#include <cstdint>
#define MK_PER_PHASE 0
namespace pg8 {
#define PG8_LAS __attribute__((address_space(3)))
typedef unsigned short bf16_t;
typedef short bf16x8 __attribute__((ext_vector_type(8)));
typedef float f32x4 __attribute__((ext_vector_type(4)));
typedef unsigned u32x4 __attribute__((ext_vector_type(4)));
constexpr int BM = 256, BK = 64, HALF = 128, HTB = HALF * BK * 2  , STAGE_BYTES = 8 * HTB, NXCD = 8, WGM = 8;

__host__ __device__ __forceinline__ int lds_byte(int r, int c) { const int st = (r >> 4) * 2 + (c >> 5), rr = r & 15, cc = c & 31, ob = rr * 64 + cc * 2; return st * 1024 + (ob ^ (((ob >> 9) & 1) << 5)); }
__host__ __device__ __forceinline__ void stage_rc(int b, int& R, int& C) { const int st = b / 1024, sb = b % 1024, swz = sb ^ (((sb >> 9) & 1) << 5); R = (st >> 1) * 16 + swz / 64; C = (st & 1) * 32 + (swz % 64) / 2; }
__host__ __device__ __forceinline__ int perm32(int rho) { const int n = rho >> 4, i = rho & 15; return 8 * (i >> 2) + 4 * n + (i & 3); }

struct Unit { int pm, pn, ko, kt, gb; };
struct Gemm { const bf16_t* A; const bf16_t* Bt; int lda, ldb, K; const int* rowidx; };

struct StaticOrder {
    int nM, nN, nwg, G, c;
    __host__ __device__ void init(int M, int N, int G_, int c_) { nM = M / BM; nN = N / BM; nwg = nM * nN; G = G_; c = c_; }
    __host__ __device__ bool next(int i, Unit& u) const {
        const long L = (long)i * G + c; if (L >= nwg) return false;
        int wgid = (int)L; { const int q = nwg / NXCD, r = nwg % NXCD, xcd = wgid % NXCD, off = wgid / NXCD; wgid = (xcd < r ? xcd * (q + 1) : r * (q + 1) + (xcd - r) * q) + off; }
        const int nig = WGM * nN, gid = wgid / nig, fm = gid * WGM, gsz = (nM - fm) < WGM ? (nM - fm) : WGM;
        u.pm = fm + ((wgid % nig) % gsz); u.pn = (wgid % nig) / gsz; u.ko = 0; u.kt = 0; u.gb = u.pm * BM; return true;
    }
    __device__ __forceinline__ void a_ready(const Unit&) const {}
    __device__ __forceinline__ void done(const Unit&) const {}
};


__device__ __forceinline__ unsigned cvt_pk_bf16(float lo, float hi) { unsigned r; asm volatile("v_cvt_pk_bf16_f32 %0, %1, %2" : "=v"(r) : "v"(lo), "v"(hi)); return r; }

struct EpiStoreBf16 {
    static constexpr bool PERM = true, AFTER_DRAIN = false;
    bf16_t* O; int ldc; int pn_mask;
    __device__ __forceinline__ void operator()(const f32x4 (&acc)[2][2][4][2], const Unit& u, int wr, int wc, int fr, int fq) const {
        const int row0 = u.pm * BM + wr * 64 + fr, col0 = (u.pn & pn_mask) * BM + wc * 32 + 8 * fq;
#pragma unroll
        for (int ai = 0; ai < 2; ++ai)
#pragma unroll
            for (int m = 0; m < 4; ++m) { bf16_t* rowp = O + (size_t)(row0 + ai * HALF + m * 16) * ldc + col0;
#pragma unroll
                for (int bj = 0; bj < 2; ++bj) { const f32x4 v0 = acc[ai][bj][m][0], v1 = acc[ai][bj][m][1];
                    u32x4 w; w.x = cvt_pk_bf16(v0[0], v0[1]); w.y = cvt_pk_bf16(v0[2], v0[3]); w.z = cvt_pk_bf16(v1[0], v1[1]); w.w = cvt_pk_bf16(v1[2], v1[3]);
                    *(u32x4*)(rowp + bj * HALF) = w; } }
    }
};
__device__ __forceinline__ float silu_f(float x) { return x * __builtin_amdgcn_rcpf(1.0f + __builtin_amdgcn_exp2f(-1.4426950408889634f * x)); }
struct EpiSwiGLU {
    static constexpr bool PERM = true, AFTER_DRAIN = false;
    bf16_t* O; int ldc;
    __device__ __forceinline__ void operator()(const f32x4 (&acc)[2][2][4][2], const Unit& u, int wr, int wc, int fr, int fq) const {
        const int row0 = u.pm * BM + wr * 64 + fr, col0 = (u.pn & 7) * HALF + wc * 32 + 8 * fq;
#pragma unroll
        for (int ai = 0; ai < 2; ++ai)
#pragma unroll
            for (int m = 0; m < 4; ++m) { bf16_t* rowp = O + (size_t)(row0 + ai * HALF + m * 16) * ldc + col0;
                const f32x4 g0 = acc[ai][0][m][0], g1 = acc[ai][0][m][1], u0 = acc[ai][1][m][0], u1 = acc[ai][1][m][1];
                u32x4 w; w.x = cvt_pk_bf16(silu_f(g0[0]) * u0[0], silu_f(g0[1]) * u0[1]); w.y = cvt_pk_bf16(silu_f(g0[2]) * u0[2], silu_f(g0[3]) * u0[3]);
                w.z = cvt_pk_bf16(silu_f(g1[0]) * u1[0], silu_f(g1[1]) * u1[1]); w.w = cvt_pk_bf16(silu_f(g1[2]) * u1[2], silu_f(g1[3]) * u1[3]);
                *(u32x4*)rowp = w; }
    }
};
__device__ __forceinline__ float bf_lo(unsigned w) { return __builtin_bit_cast(float, w << 16); }
__device__ __forceinline__ float bf_hi(unsigned w) { return __builtin_bit_cast(float, w & 0xffff0000u); }
struct EpiResid {
    static constexpr bool PERM = true, AFTER_DRAIN = false;
    bf16_t* H; const float* modg;
    __device__ __forceinline__ void operator()(const f32x4 (&acc)[2][2][4][2], const Unit& u, int wr, int wc, int fr, int fq) const {
        const int row0 = u.pm * BM + wr * 64 + fr, col0 = u.pn * BM + wc * 32 + 8 * fq;
        const int j = (u.pm % 9 == 0) ? 8 : (u.pm / 9);
        const float* g = modg + (size_t)j * 12288 + col0;
        f32x4 gv[2][2];
#pragma unroll
        for (int bj = 0; bj < 2; ++bj)
#pragma unroll
            for (int n = 0; n < 2; ++n) gv[bj][n] = *(const f32x4*)(g + bj * HALF + 4 * n);
#pragma unroll
        for (int ai = 0; ai < 2; ++ai)
#pragma unroll
            for (int m = 0; m < 4; ++m) { bf16_t* rowp = H + (size_t)(row0 + ai * HALF + m * 16) * 2048 + col0;
#pragma unroll
                for (int bj = 0; bj < 2; ++bj) { u32x4* p = (u32x4*)(rowp + bj * HALF); const u32x4 h = *p;
                    const f32x4 a0 = gv[bj][0] * acc[ai][bj][m][0], a1 = gv[bj][1] * acc[ai][bj][m][1];
                    u32x4 w; w.x = cvt_pk_bf16(bf_lo(h.x) + a0[0], bf_hi(h.x) + a0[1]); w.y = cvt_pk_bf16(bf_lo(h.y) + a0[2], bf_hi(h.y) + a0[3]);
                    w.z = cvt_pk_bf16(bf_lo(h.z) + a1[0], bf_hi(h.z) + a1[1]); w.w = cvt_pk_bf16(bf_lo(h.w) + a1[2], bf_hi(h.w) + a1[3]);
                    *p = w; } }
    }
};
struct EpiResidInit {
    static constexpr bool PERM = true, AFTER_DRAIN = false;
    bf16_t* H; const float* modg; const float* xin; const float* ctxin;
    __device__ __forceinline__ void operator()(const f32x4 (&acc)[2][2][4][2], const Unit& u, int wr, int wc, int fr, int fq) const {
        const int rl0 = wr * 64 + fr, col0 = u.pn * BM + wc * 32 + 8 * fq;
        const int b = u.pm / 9, t = u.pm - 9 * b, j = (t == 0) ? 8 : b;
        const float* src = (t == 0) ? ctxin + (size_t)(b * 256) * 2048 : xin + (size_t)(b * 2048 + (t - 1) * 256) * 2048;
        const float* g = modg + (size_t)j * 12288 + col0;
        f32x4 gv[2][2];
#pragma unroll
        for (int bj = 0; bj < 2; ++bj)
#pragma unroll
            for (int n = 0; n < 2; ++n) gv[bj][n] = *(const f32x4*)(g + bj * HALF + 4 * n);
#pragma unroll
        for (int ai = 0; ai < 2; ++ai)
#pragma unroll
            for (int m = 0; m < 4; ++m) { const int rl = rl0 + ai * HALF + m * 16; bf16_t* rowp = H + (size_t)(u.pm * BM + rl) * 2048 + col0; const float* srow = src + (size_t)rl * 2048 + col0;
#pragma unroll
                for (int bj = 0; bj < 2; ++bj) { const f32x4 h0 = *(const f32x4*)(srow + bj * HALF), h1 = *(const f32x4*)(srow + bj * HALF + 4);
                    const f32x4 v0 = h0 + gv[bj][0] * acc[ai][bj][m][0], v1 = h1 + gv[bj][1] * acc[ai][bj][m][1];
                    u32x4 w; w.x = cvt_pk_bf16(v0[0], v0[1]); w.y = cvt_pk_bf16(v0[2], v0[3]); w.z = cvt_pk_bf16(v1[0], v1[1]); w.w = cvt_pk_bf16(v1[2], v1[3]);
                    *(u32x4*)(rowp + bj * HALF) = w; } }
    }
};
struct EpiLogits {
    static constexpr bool PERM = false, AFTER_DRAIN = false;
    float* LG; int kslice; size_t slice_stride;
    __device__ __forceinline__ void operator()(const f32x4 (&acc)[2][2][4][2], const Unit& u, int wr, int wc, int fr, int fq) const {
        if (wc >= 2) return;
        const int row0 = u.pm * BM + wr * 64 + fr, col0 = wc * 32 + 4 * fq;
        float* base = LG + (size_t)(u.ko / kslice) * slice_stride;
#pragma unroll
        for (int ai = 0; ai < 2; ++ai)
#pragma unroll
            for (int m = 0; m < 4; ++m) { float* rowp = base + (size_t)(row0 + ai * HALF + m * 16) * 64 + col0;
#pragma unroll
                for (int n = 0; n < 2; ++n) *(f32x4*)(rowp + n * 16) = acc[ai][0][m][n]; }
    }
};
struct SplitKOrder {
    int nM, KS, kslice, G, c;
    __device__ void init(int nM_, int KS_, int kslice_, int G_, int c_) { nM = nM_; KS = KS_; kslice = kslice_; G = G_; c = c_; }
    __device__ bool next(int i, Unit& u) const { const long L = (long)i * G + c; if (L >= (long)nM * KS) return false; const int ks = (int)L / nM; u.pm = (int)L - ks * nM; u.pn = 0; u.ko = ks * kslice; u.kt = 0; u.gb = 0; return true; }
    __device__ __forceinline__ void a_ready(const Unit&) const {}
    __device__ __forceinline__ void done(const Unit&) const {}
};
struct EvenInOrder {
    StaticOrder so; int G, c;
    __device__ void init(int M, int G_, int c_) { so.init(M, 2560, G_, c_); G = G_; c = c_; }
    __device__ bool next(int i, Unit& u) const {
        if (so.next(i, u)) return true;
        const long L = (long)i * G + c - so.nwg; if (L < 0 || L >= 72 * 4) return false;
        const int ks = (int)L / 72; u.pm = (int)L - ks * 72; u.pn = 10; u.ko = ks * 512; u.kt = 8; u.gb = 0; return true;
    }
    __device__ __forceinline__ void a_ready(const Unit&) const {}
    __device__ __forceinline__ void done(const Unit&) const {}
};
struct EpiEvenIn {
    static constexpr bool PERM = true, AFTER_DRAIN = false;
    bf16_t* Y; float* KRP;
    __device__ __forceinline__ void operator()(const f32x4 (&acc)[2][2][4][2], const Unit& u, int wr, int wc, int fr, int fq) const {
        if (u.pn < 10) { const EpiStoreBf16 e{Y, 2816, 0x7fffffff}; e(acc, u, wr, wc, fr, fq); return; }
        if (wc >= 2) return;
        const int row0 = u.pm * BM + wr * 64 + fr, col0 = wc * 32 + 8 * fq;
        float* base = KRP + (size_t)(u.ko >> 9) * ((size_t)18432 * 64);
#pragma unroll
        for (int ai = 0; ai < 2; ++ai)
#pragma unroll
            for (int m = 0; m < 4; ++m) { float* rowp = base + (size_t)(row0 + ai * HALF + m * 16) * 64 + col0;
#pragma unroll
                for (int n = 0; n < 2; ++n) *(f32x4*)(rowp + 4 * n) = acc[ai][0][m][n]; }
    }
};
struct Proj2Order {
    StaticOrder s1, s2; int G, c;
    __device__ void init(int M, int G_, int c_) { s1.init(M, 1536, G_, c_); s2.init(M, 2048, G_, c_); G = G_; c = c_; }
    __device__ bool next(int i, Unit& u) const {
        if (s1.next(i, u)) return true;
        StaticOrder t = s2; const long L = (long)i * G + c - s1.nwg; if (L < 0 || L >= s2.nwg) return false;
        t.G = 1; t.c = (int)L; if (!t.next(0, u)) return false;
        u.pm += 72; u.pn += 8; return true;
    }
    __device__ __forceinline__ void a_ready(const Unit&) const {}
    __device__ __forceinline__ void done(const Unit&) const {}
};
struct EpiProj2 {
    static constexpr bool PERM = true, AFTER_DRAIN = false;
    bf16_t* QB; bf16_t* KV;
    __device__ __forceinline__ void operator()(const f32x4 (&acc)[2][2][4][2], const Unit& u, int wr, int wc, int fr, int fq) const {
        if (u.pm < 72) { const EpiStoreBf16 e{QB, 1536, 0x7fffffff}; e(acc, u, wr, wc, fr, fq); }
        else { Unit v = u; v.pm -= 72; v.pn -= 8; const EpiStoreBf16 e{KV, 2048, 0x7fffffff}; e(acc, v, wr, wc, fr, fq); }
    }
};
struct XOnlyOrder {
    StaticOrder so;
    __device__ void init(int N, int G_, int c_) { so.init(64 * BM, N, G_, c_); }
    __device__ bool next(int i, Unit& u) const { if (!so.next(i, u)) return false; u.pm = 9 * (u.pm >> 3) + 1 + (u.pm & 7); return true; }
    __device__ __forceinline__ void a_ready(const Unit&) const {}
    __device__ __forceinline__ void done(const Unit&) const {}
};
struct OddInOrder {
    StaticOrder so; int G, c;
    __device__ void init(int G_, int c_) { so.init(64 * BM, 18 * BM, G_, c_); G = G_; c = c_; }
    __device__ bool next(int i, Unit& u) const {
        if (so.next(i, u)) { u.pm = 9 * (u.pm >> 3) + 1 + (u.pm & 7); return true; }
        const long L = (long)i * G + c - 64 * 18; if (L >= 80) return false;
        const int b = (int)L / 10, j = (int)L - b * 10; u.pm = 9 * b; u.pn = j < 8 ? 4 + j : 8 + j; u.ko = 0; u.kt = 0; u.gb = 0; return true;
    }
    __device__ __forceinline__ void a_ready(const Unit&) const {}
    __device__ __forceinline__ void done(const Unit&) const {}
};
struct SplitKXOrder {
    int KS, kslice, G, c;
    __device__ void init(int KS_, int kslice_, int G_, int c_) { KS = KS_; kslice = kslice_; G = G_; c = c_; }
    __device__ bool next(int i, Unit& u) const { const long L = (long)i * G + c; if (L >= 64L * KS) return false; const int ks = (int)L / 64, x = (int)L - ks * 64; u.pm = 9 * (x >> 3) + 1 + (x & 7); u.pn = 0; u.ko = ks * kslice; u.kt = 0; u.gb = 0; return true; }
    __device__ __forceinline__ void a_ready(const Unit&) const {}
    __device__ __forceinline__ void done(const Unit&) const {}
};
struct MoeOrder {
    const PG8_LAS int* texp; const PG8_LAS int* frt; int nunits, G, c, cap;
    __device__ void init(const PG8_LAS int* texp_, const PG8_LAS int* frt_, int n_row_tiles, int cap_, int G_, int c_) { texp = texp_; frt = frt_; nunits = n_row_tiles * 8; cap = cap_; G = G_; c = c_; }
    __device__ bool next(int i, Unit& u) const {
        const long L = (long)i * G + c; if (L >= nunits) return false;
        int wgid = (int)L; { const int q = nunits / NXCD, r = nunits % NXCD, xcd = wgid % NXCD, off = wgid / NXCD; wgid = (xcd < r ? xcd * (q + 1) : r * (q + 1) + (xcd - r) * q) + off; }
        const int rt = wgid >> 3, pn = wgid & 7, e = __builtin_amdgcn_readfirstlane(texp[rt]);
        u.pm = rt; u.pn = e * 8 + pn; u.ko = 0; u.kt = 0; u.gb = e * cap + (rt - __builtin_amdgcn_readfirstlane(frt[e])) * BM; return true;
    }
    __device__ __forceinline__ void a_ready(const Unit&) const {}
    __device__ __forceinline__ void done(const Unit&) const {}
};
template <class Epi, class Sched, bool GATHER = false>
__device__ __forceinline__ void gemm_phase(PG8_LAS unsigned char* lds, const Gemm g, const Sched& S, const Epi& E) {
    int tid = threadIdx.x; asm volatile("" : "+v"(tid));
    const int wid = __builtin_amdgcn_readfirstlane(tid >> 6), lane = tid & 63, wr = wid >> 2, wc = wid & 3, fr = lane & 15, fq = lane >> 4;
    const int K = g.K, lda = g.lda, ldb = g.ldb;
    unsigned va[2][2], vn[2][2], voffB[2]; int sR[2], sC[2];
#pragma unroll
    for (int i = 0; i < 2; ++i) { int R, C; stage_rc(tid * 16 + i * 8192, R, C); const int Rb = Epi::PERM ? ((R & ~31) + perm32(R & 31)) : R; sR[i] = R; sC[i] = C;
        voffB[i] = (unsigned)(Rb * ldb + C) * 2u;
        va[0][i] = (unsigned)(R * lda + C) * 2u; va[1][i] = (unsigned)((R + HALF) * lda + C) * 2u; vn[0][i] = va[0][i]; vn[1][i] = va[1][i]; }
    const size_t kstep = (size_t)(BK * 2);
    const size_t hstepB = (size_t)HALF * ldb * 2;
    const size_t tstepA = (size_t)BM * lda * 2, tstepB = (size_t)BM * ldb * 2;
    const unsigned ldsw = (unsigned)wid * 1024u;
    const int aoff = lds_byte(wr * 64 + fr, fq * 8), boff = lds_byte(wc * 32 + fr, fq * 8);
#define PG8_SA(b, h) (((b) * 2 + (h)) * HTB)
#define PG8_SB(b, h) ((4 + (b) * 2 + (h)) * HTB)
#define PG8_STAGE(bufoff, gbase, voff) do { _Pragma("unroll") for (int _i = 0; _i < 2; ++_i) \
        __builtin_amdgcn_global_load_lds((const unsigned*)((const char*)(gbase) + (voff)[_i]), (PG8_LAS unsigned*)(lds + (bufoff) + ldsw + _i * 8192), 16, 0, 0); } while (0)
#define PG8_LDA(dst, b, h) do { _Pragma("unroll") for (int m = 0; m < 4; ++m) _Pragma("unroll") for (int k = 0; k < 2; ++k) dst[m][k] = *(const PG8_LAS bf16x8*)(lds + PG8_SA(b, h) + aoff + m * 2048 + k * 1024); } while (0)
#define PG8_LDB(dst, b, h) do { _Pragma("unroll") for (int n = 0; n < 2; ++n) _Pragma("unroll") for (int k = 0; k < 2; ++k) dst[n][k] = *(const PG8_LAS bf16x8*)(lds + PG8_SB(b, h) + boff + n * 2048 + k * 1024); } while (0)
#define PG8_MMA(ai, bj, At, Bt) do { __builtin_amdgcn_s_setprio(1); _Pragma("unroll") for (int m = 0; m < 4; ++m) _Pragma("unroll") for (int n = 0; n < 2; ++n) _Pragma("unroll") for (int k = 0; k < 2; ++k) \
        acc[ai][bj][m][n] = __builtin_amdgcn_mfma_f32_16x16x32_bf16(Bt[n][k], At[m][k], acc[ai][bj][m][n], 0, 0, 0); __builtin_amdgcn_s_setprio(0); } while (0)
#define PG8_WAIT_V(n) asm volatile("s_waitcnt vmcnt(" #n ")" ::: "memory")
#define PG8_WAIT_L(n) asm volatile("s_waitcnt lgkmcnt(" #n ")" ::: "memory")
#define PG8_BAR __builtin_amdgcn_s_barrier()
#define PG8_SCHED __builtin_amdgcn_sched_barrier(0)
#define PG8_GATHER_OFFS(dst, u) do { if constexpr (GATHER) { _Pragma("unroll") for (int _h = 0; _h < 2; ++_h) _Pragma("unroll") for (int _i = 0; _i < 2; ++_i) \
        dst[_h][_i] = (unsigned)(g.rowidx[(u).gb + _h * HALF + sR[_i]] * lda + sC[_i]) * 2u; } } while (0)
    Unit cur, nxt; int ui = 0;
    if (!S.next(0, cur)) return;
    f32x4 acc[2][2][4][2];
#pragma unroll
    for (int a = 0; a < 2; ++a)
#pragma unroll
        for (int b = 0; b < 2; ++b)
#pragma unroll
            for (int m = 0; m < 4; ++m)
#pragma unroll
                for (int n = 0; n < 2; ++n) acc[a][b][m][n] = (f32x4){0.f, 0.f, 0.f, 0.f};
    bf16x8 At[4][2], B0[2][2], B1[2][2];
    const char* cA = (const char*)g.A + (GATHER ? (size_t)0 : (size_t)cur.pm * tstepA) + (size_t)cur.ko * 2; const char* cB = (const char*)g.Bt + (size_t)cur.pn * tstepB + (size_t)cur.ko * 2;
    PG8_GATHER_OFFS(va, cur);
    S.a_ready(cur);
    PG8_STAGE(PG8_SB(0, 0), cB, voffB); PG8_STAGE(PG8_SB(0, 1), cB + hstepB, voffB); PG8_STAGE(PG8_SA(0, 0), cA, va[0]); PG8_STAGE(PG8_SA(0, 1), cA, va[1]);
    if (wr == 1) PG8_BAR;
    PG8_WAIT_V(2); PG8_BAR;
    PG8_STAGE(PG8_SB(1, 0), cB + kstep, voffB); PG8_STAGE(PG8_SA(1, 0), cA + kstep, va[0]); PG8_STAGE(PG8_SB(1, 1), cB + hstepB + kstep, voffB);
    PG8_WAIT_V(6); PG8_BAR;
    for (;;) {
        const bool has_next = S.next(ui + 1, nxt);
        const char* nA = has_next ? (const char*)g.A + (GATHER ? (size_t)0 : (size_t)nxt.pm * tstepA) + (size_t)nxt.ko * 2 : cA; const char* nB = has_next ? (const char*)g.Bt + (size_t)nxt.pn * tstepB + (size_t)nxt.ko * 2 : cB;
        if constexpr (GATHER) { if (has_next) PG8_GATHER_OFFS(vn, nxt); else { _Pragma("unroll") for (int _h = 0; _h < 2; ++_h) _Pragma("unroll") for (int _i = 0; _i < 2; ++_i) vn[_h][_i] = va[_h][_i]; } }
        const int nt = K / BK;
        for (int t = 0; t < nt; t += 2) {
            const bool last = (t == nt - 2);
            const char* a1 = cA + (size_t)(t + 1) * kstep;
            const char* a2 = last ? nA : cA + (size_t)(t + 2) * kstep; const char* b2 = last ? nB : cB + (size_t)(t + 2) * kstep;
            const char* a3 = a2 + kstep; const char* b3 = b2 + kstep;
            unsigned v2[2][2];
#pragma unroll
            for (int _h = 0; _h < 2; ++_h)
#pragma unroll
                for (int _i = 0; _i < 2; ++_i) v2[_h][_i] = (GATHER && last) ? vn[_h][_i] : va[_h][_i];
            if (last && has_next) S.a_ready(nxt);
            PG8_LDB(B0, 0, 0); PG8_LDB(B1, 0, 1); PG8_SCHED; PG8_LDA(At, 0, 0); PG8_STAGE(PG8_SA(1, 1), a1, va[1]);
            PG8_WAIT_V(8); PG8_WAIT_L(0); PG8_BAR; PG8_MMA(0, 0, At, B0); PG8_MMA(0, 1, At, B1); PG8_BAR; PG8_SCHED;
            PG8_LDA(At, 0, 1); PG8_STAGE(PG8_SB(0, 0), b2, voffB); PG8_STAGE(PG8_SB(0, 1), b2 + hstepB, voffB); PG8_STAGE(PG8_SA(0, 0), a2, v2[0]);
            PG8_WAIT_V(8); PG8_WAIT_L(0); PG8_BAR; PG8_MMA(1, 0, At, B0); PG8_MMA(1, 1, At, B1); PG8_BAR; PG8_SCHED;
            PG8_LDB(B0, 1, 0); PG8_LDB(B1, 1, 1); PG8_SCHED; PG8_LDA(At, 1, 0); PG8_STAGE(PG8_SA(0, 1), a2, v2[1]);
            PG8_WAIT_V(8); PG8_WAIT_L(0); PG8_BAR; PG8_MMA(0, 0, At, B0); PG8_MMA(0, 1, At, B1); PG8_BAR; PG8_SCHED;
            PG8_LDA(At, 1, 1); PG8_STAGE(PG8_SB(1, 0), b3, voffB); PG8_STAGE(PG8_SB(1, 1), b3 + hstepB, voffB); PG8_STAGE(PG8_SA(1, 0), a3, v2[0]);
            PG8_WAIT_V(8); PG8_WAIT_L(0); PG8_BAR; PG8_MMA(1, 0, At, B0); PG8_MMA(1, 1, At, B1); PG8_BAR; PG8_SCHED;
        }
        if (wr == 0) PG8_BAR;
        E(acc, cur, wr, wc, fr, fq); S.done(cur);
        if (!has_next) break;
#pragma unroll
        for (int a = 0; a < 2; ++a)
#pragma unroll
            for (int b = 0; b < 2; ++b)
#pragma unroll
                for (int m = 0; m < 4; ++m)
#pragma unroll
                    for (int n = 0; n < 2; ++n) acc[a][b][m][n] = (f32x4){0.f, 0.f, 0.f, 0.f};
        cur = nxt; cA = nA; cB = nB; ++ui;
        if constexpr (GATHER) { _Pragma("unroll") for (int _h = 0; _h < 2; ++_h) _Pragma("unroll") for (int _i = 0; _i < 2; ++_i) va[_h][_i] = vn[_h][_i]; }
        if (wr == 1) PG8_BAR;
    }
    PG8_WAIT_V(0);
    PG8_BAR;
#undef PG8_SA
#undef PG8_SB
#undef PG8_STAGE
#undef PG8_LDA
#undef PG8_LDB
#undef PG8_MMA
#undef PG8_WAIT_V
#undef PG8_WAIT_L
#undef PG8_BAR
#undef PG8_SCHED
#undef PG8_GATHER_OFFS
}
typedef unsigned u32x2 __attribute__((ext_vector_type(2)));
struct BSrc { const float* m0; const float* m1; size_t estride; int ldn, colmul, hoff; };
template <class Epi, class Sched, bool GATHER = false>
__device__ __forceinline__ void gemm_phase_f32b(PG8_LAS unsigned char* lds, const Gemm g, const BSrc bs, const Sched& S, const Epi& E) {
    int tid = threadIdx.x; asm volatile("" : "+v"(tid));
    const int wid = __builtin_amdgcn_readfirstlane(tid >> 6), lane = tid & 63, wr = wid >> 2, wc = wid & 3, fr = lane & 15, fq = lane >> 4;
    const int K = g.K, lda = g.lda;
    unsigned va00, va01, va10, va11, vn00, vn01, vn10, vn11;
#pragma unroll
    for (int i = 0; i < 2; ++i) { int R, C; stage_rc(tid * 16 + i * 8192, R, C);
        const unsigned o0_ = (unsigned)(R * lda + C) * 2u, o1_ = (unsigned)((R + HALF) * lda + C) * 2u; if (i == 0) { va00 = o0_; va10 = o1_; } else { va01 = o0_; va11 = o1_; } }
    vn00 = va00; vn01 = va01; vn10 = va10; vn11 = va11;
    const size_t kstep = (size_t)(BK * 2);
    const size_t tstepA = (size_t)BM * lda * 2;
    const int kq = lane & 15, nq = (lane >> 4) + 4 * wid;
    const int brow = (nq >> 3) * 32 + (Epi::PERM ? (16 * (nq & 1) + 4 * ((nq & 7) >> 1)) : (4 * (nq & 7)));
    const int bwr = lds_byte(brow, 4 * kq);
    const unsigned bvo = (unsigned)((4 * kq) * bs.ldn + 4 * nq) * 4u;
    const size_t bkstep = (size_t)BK * bs.ldn * 4, brstep = (size_t)bs.ldn * 4;
    f32x4 w0, w1, w2, w3;
    const unsigned ldsw = (unsigned)wid * 1024u;
    const int aoff = lds_byte(wr * 64 + fr, fq * 8), boff = lds_byte(wc * 32 + fr, fq * 8);
#define PG8_SA(b, h) (((b) * 2 + (h)) * HTB)
#define PG8_SB(b, h) ((4 + (b) * 2 + (h)) * HTB)
#define PG8_BLOAD(src) do { const char* p0_ = (const char*)(src); const char* p1_ = p0_ + brstep; const char* p2_ = p1_ + brstep; const char* p3_ = p2_ + brstep; \
        asm volatile("s_nop 4\n\tglobal_load_dwordx4 %0, %4, %5\n\tglobal_load_dwordx4 %1, %4, %6\n\tglobal_load_dwordx4 %2, %4, %7\n\tglobal_load_dwordx4 %3, %4, %8" \
                     : "=&v"(w0), "=&v"(w1), "=&v"(w2), "=&v"(w3) : "v"(bvo), "s"(p0_), "s"(p1_), "s"(p2_), "s"(p3_)); } while (0)
#define PG8_BWAIT(n) asm volatile("s_waitcnt vmcnt(" #n ")" : "+v"(w0), "+v"(w1), "+v"(w2), "+v"(w3))
#define PG8_BWRITE(bufoff) do { PG8_LAS unsigned char* d_ = lds + (bufoff) + bwr; \
        { u32x2 c_; c_.x = cvt_pk_bf16(w0[0], w1[0]); c_.y = cvt_pk_bf16(w2[0], w3[0]); *(PG8_LAS u32x2*)(d_) = c_; } \
        { u32x2 c_; c_.x = cvt_pk_bf16(w0[1], w1[1]); c_.y = cvt_pk_bf16(w2[1], w3[1]); *(PG8_LAS u32x2*)(d_ + 64) = c_; } \
        { u32x2 c_; c_.x = cvt_pk_bf16(w0[2], w1[2]); c_.y = cvt_pk_bf16(w2[2], w3[2]); *(PG8_LAS u32x2*)(d_ + 128) = c_; } \
        { u32x2 c_; c_.x = cvt_pk_bf16(w0[3], w1[3]); c_.y = cvt_pk_bf16(w2[3], w3[3]); *(PG8_LAS u32x2*)(d_ + 192) = c_; } } while (0)
#define PG8_BSRC(u, h) ((const char*)(((h) ? bs.m1 : bs.m0) + (size_t)((u).pn >> 3) * bs.estride + (size_t)((u).pn & 7) * bs.colmul + (h) * bs.hoff) + (size_t)(u).ko * brstep)
#define PG8_STAGE(bufoff, gbase, o0, o1) do { \
        __builtin_amdgcn_global_load_lds((const unsigned*)((const char*)(gbase) + (o0)), (PG8_LAS unsigned*)(lds + (bufoff) + ldsw), 16, 0, 0); \
        __builtin_amdgcn_global_load_lds((const unsigned*)((const char*)(gbase) + (o1)), (PG8_LAS unsigned*)(lds + (bufoff) + ldsw + 8192), 16, 0, 0); } while (0)
#define PG8_LDA(dst, b, h) do { _Pragma("unroll") for (int m = 0; m < 4; ++m) _Pragma("unroll") for (int k = 0; k < 2; ++k) dst[m][k] = *(const PG8_LAS bf16x8*)(lds + PG8_SA(b, h) + aoff + m * 2048 + k * 1024); } while (0)
#define PG8_LDB(dst, b, h) do { _Pragma("unroll") for (int n = 0; n < 2; ++n) _Pragma("unroll") for (int k = 0; k < 2; ++k) dst[n][k] = *(const PG8_LAS bf16x8*)(lds + PG8_SB(b, h) + boff + n * 2048 + k * 1024); } while (0)
#define PG8_MMA(ai, bj, At, Bt) do { __builtin_amdgcn_s_setprio(1); _Pragma("unroll") for (int m = 0; m < 4; ++m) _Pragma("unroll") for (int n = 0; n < 2; ++n) _Pragma("unroll") for (int k = 0; k < 2; ++k) \
        acc[ai][bj][m][n] = __builtin_amdgcn_mfma_f32_16x16x32_bf16(Bt[n][k], At[m][k], acc[ai][bj][m][n], 0, 0, 0); __builtin_amdgcn_s_setprio(0); } while (0)
#define PG8_WAIT_V(n) asm volatile("s_waitcnt vmcnt(" #n ")" ::: "memory")
#define PG8_WAIT_L(n) asm volatile("s_waitcnt lgkmcnt(" #n ")" ::: "memory")
#define PG8_BAR __builtin_amdgcn_s_barrier()
#define PG8_SCHED __builtin_amdgcn_sched_barrier(0)
#define PG8_GATHER_OFFS(d00, d01, d10, d11, u) do { if constexpr (GATHER) { const int* ri_ = g.rowidx + (u).gb; int t_ = threadIdx.x; asm volatile("" : "+v"(t_)); \
        int R0_, C0_, R1_, C1_; stage_rc(t_ * 16, R0_, C0_); stage_rc(t_ * 16 + 8192, R1_, C1_);     \
        d00 = (unsigned)(ri_[R0_] * lda + C0_) * 2u; d01 = (unsigned)(ri_[R1_] * lda + C1_) * 2u; \
        d10 = (unsigned)(ri_[HALF + R0_] * lda + C0_) * 2u; d11 = (unsigned)(ri_[HALF + R1_] * lda + C1_) * 2u; } } while (0)
    Unit cur, nxt; int ui = 0;
    if (!S.next(0, cur)) return;
    f32x4 acc[2][2][4][2];
#pragma unroll
    for (int a = 0; a < 2; ++a)
#pragma unroll
        for (int b = 0; b < 2; ++b)
#pragma unroll
            for (int m = 0; m < 4; ++m)
#pragma unroll
                for (int n = 0; n < 2; ++n) acc[a][b][m][n] = (f32x4){0.f, 0.f, 0.f, 0.f};
    bf16x8 At[4][2], B0[2][2], B1[2][2];
    const char* cA = (const char*)g.A + (GATHER ? (size_t)0 : (size_t)cur.pm * tstepA) + (size_t)cur.ko * 2; const char* cB0 = PG8_BSRC(cur, 0); const char* cB1 = PG8_BSRC(cur, 1);
    PG8_GATHER_OFFS(va00, va01, va10, va11, cur);
    S.a_ready(cur);
    PG8_STAGE(PG8_SA(0, 0), cA, va00, va01); PG8_STAGE(PG8_SA(0, 1), cA, va10, va11);
    PG8_BLOAD(cB0); PG8_BWAIT(0); PG8_BWRITE(PG8_SB(0, 0));
    PG8_BLOAD(cB1); PG8_BWAIT(0); PG8_BWRITE(PG8_SB(0, 1));
    PG8_BLOAD(cB0 + bkstep); PG8_BWAIT(0); PG8_BWRITE(PG8_SB(1, 0));
    PG8_BLOAD(cB1 + bkstep); PG8_STAGE(PG8_SA(1, 0), cA + kstep, va00, va01);
    PG8_WAIT_L(0);
    if (wr == 1) PG8_BAR;
    PG8_BAR;
    PG8_BAR;
    for (;;) {
        const bool has_next = S.next(ui + 1, nxt);
        const char* nA = has_next ? (const char*)g.A + (GATHER ? (size_t)0 : (size_t)nxt.pm * tstepA) + (size_t)nxt.ko * 2 : cA; const char* nB0 = has_next ? PG8_BSRC(nxt, 0) : cB0; const char* nB1 = has_next ? PG8_BSRC(nxt, 1) : cB1;
        const int nt = K / BK;
        for (int t = 0; t < nt; t += 2) {
            const bool last = (t == nt - 2);
            const char* a1 = cA + (size_t)(t + 1) * kstep;
            const char* a2 = last ? nA : cA + (size_t)(t + 2) * kstep;
            const char* b20 = last ? nB0 : cB0 + (size_t)(t + 2) * bkstep; const char* b21 = last ? nB1 : cB1 + (size_t)(t + 2) * bkstep;
            const char* a3 = a2 + kstep; const char* b30 = b20 + bkstep; const char* b31 = b21 + bkstep;
            if constexpr (GATHER) { if (last) { if (has_next) PG8_GATHER_OFFS(vn00, vn01, vn10, vn11, nxt); else { vn00 = va00; vn01 = va01; vn10 = va10; vn11 = va11; } } }
            const bool usen_ = GATHER && last;
            const unsigned v200 = usen_ ? vn00 : va00, v201 = usen_ ? vn01 : va01, v210 = usen_ ? vn10 : va10, v211 = usen_ ? vn11 : va11;
            if (last && has_next) S.a_ready(nxt);
            PG8_LDB(B0, 0, 0); PG8_LDB(B1, 0, 1); PG8_SCHED; PG8_LDA(At, 0, 0);
            PG8_BWAIT(2); PG8_BWRITE(PG8_SB(1, 1)); PG8_BLOAD(b20); PG8_STAGE(PG8_SA(1, 1), a1, va10, va11);
            PG8_WAIT_L(0); PG8_BAR; PG8_MMA(0, 0, At, B0); PG8_MMA(0, 1, At, B1); PG8_BAR; PG8_SCHED;
            PG8_LDA(At, 0, 1);
            PG8_BWAIT(2); PG8_BWRITE(PG8_SB(0, 0)); PG8_BLOAD(b21); PG8_STAGE(PG8_SA(0, 0), a2, v200, v201);
            PG8_WAIT_L(0); PG8_BAR; PG8_MMA(1, 0, At, B0); PG8_MMA(1, 1, At, B1); PG8_BAR; PG8_SCHED;
            PG8_LDB(B0, 1, 0); PG8_LDB(B1, 1, 1); PG8_SCHED; PG8_LDA(At, 1, 0);
            PG8_BWAIT(2); PG8_BWRITE(PG8_SB(0, 1)); PG8_BLOAD(b30); PG8_STAGE(PG8_SA(0, 1), a2, v210, v211);
            PG8_WAIT_L(0); PG8_BAR; PG8_MMA(0, 0, At, B0); PG8_MMA(0, 1, At, B1); PG8_BAR; PG8_SCHED;
            PG8_LDA(At, 1, 1);
            PG8_BWAIT(2); PG8_BWRITE(PG8_SB(1, 0)); PG8_BLOAD(b31); PG8_STAGE(PG8_SA(1, 0), a3, v200, v201);
            PG8_WAIT_L(0); PG8_BAR; PG8_MMA(1, 0, At, B0); PG8_MMA(1, 1, At, B1); PG8_BAR; PG8_SCHED;
        }
        if (wr == 0) PG8_BAR;
        E(acc, cur, wr, wc, fr, fq); S.done(cur);
        if (!has_next) break;
#pragma unroll
        for (int a = 0; a < 2; ++a)
#pragma unroll
            for (int b = 0; b < 2; ++b)
#pragma unroll
                for (int m = 0; m < 4; ++m)
#pragma unroll
                    for (int n = 0; n < 2; ++n) acc[a][b][m][n] = (f32x4){0.f, 0.f, 0.f, 0.f};
        cur = nxt; cA = nA; cB0 = nB0; cB1 = nB1; ++ui;
        if constexpr (GATHER) { va00 = vn00; va01 = vn01; va10 = vn10; va11 = vn11; }
        if (wr == 1) PG8_BAR;
    }
    PG8_WAIT_V(0);
    PG8_BAR;
#undef PG8_SA
#undef PG8_SB
#undef PG8_STAGE
#undef PG8_BLOAD
#undef PG8_BWAIT
#undef PG8_BWRITE
#undef PG8_BSRC
#undef PG8_LDA
#undef PG8_LDB
#undef PG8_MMA
#undef PG8_WAIT_V
#undef PG8_WAIT_L
#undef PG8_BAR
#undef PG8_SCHED
#undef PG8_GATHER_OFFS
}
}

#ifndef PG8_SP2
#define PG8_SP2 true
#endif
#ifndef PG8_ALIGN
#define PG8_ALIGN true
#endif
#ifndef MK_PER_PHASE
#define MK_PER_PHASE 0
#endif

constexpr int NWAVES = 8;
constexpr int DM = 2048, NB = 8, SEQ = 2048, CTX = 256, TPB = CTX + SEQ, T = NB * TPB;
constexpr int EVEN_IN_P = 2816, ODD_IN = 4608;
constexpr int NE = 32, DE = 1024, MAXSLOT = 45056;
constexpr float NORM_EPS = 1e-6f;
constexpr float LAMBDA_INIT = 0.35550906759f;
constexpr int NPHASE = 27;
#ifndef MOE_F32B
#define MOE_F32B 0
#endif
#ifndef FUSED_ROUTE
#define FUSED_ROUTE 1
#endif
#ifndef ATT_DIFF_FUSED
#define ATT_DIFF_FUSED 1
#endif
#ifndef USE_NAIVE_ATTN
#define USE_NAIVE_ATTN 0
#endif

constexpr size_t MiB = 1u << 20;
constexpr size_t WS_CTL = 0, CTL_ZERO_BYTES = 1 * MiB;
constexpr size_t WS_MOD = 1 * MiB;
constexpr size_t WS_ROPE = 2 * MiB;
constexpr size_t WS_ROUTE = 3 * MiB;
constexpr size_t WS_WE_IN = 4 * MiB;
constexpr size_t WS_WE_UQ = 15 * MiB;
constexpr size_t WS_WE_UKV = 17 * MiB;
constexpr size_t WS_WE_OUT = 19 * MiB;
constexpr size_t WS_WO_IN = 27 * MiB;
constexpr size_t WS_WO_OUT = 45 * MiB;
constexpr size_t WS_WR = 53 * MiB;
constexpr size_t WS_WGU = 60 * MiB;
constexpr size_t WS_WDN = 572 * MiB;
constexpr size_t WS_H = 828 * MiB;
constexpr size_t WS_A1 = 972 * MiB;
constexpr size_t WS_MIX = 1044 * MiB;
constexpr size_t WS_R = 1116 * MiB;
constexpr size_t WS_Y1 = WS_R;
constexpr size_t WS_CQN = WS_R + 162 * MiB;
constexpr size_t WS_CKVN = WS_R + 180 * MiB;
constexpr size_t WS_QB = WS_R + 198 * MiB;
constexpr size_t WS_KV = WS_R + 252 * MiB;
constexpr size_t WS_KB = WS_R + 324 * MiB;
constexpr size_t WS_XS = WS_R;
constexpr size_t WS_U = WS_R + 176 * MiB;
constexpr size_t WS_YS = WS_R + 264 * MiB;
constexpr size_t WS_LG = WS_R + 440 * MiB;
constexpr size_t WS_POS = WS_R + 460 * MiB;
constexpr int POSCAP = 18432;
constexpr size_t WS_END = WS_R + 466 * MiB;
constexpr int RKS = 4;
constexpr int CW_CNT = 64;
constexpr int CW_NRT = 256;
constexpr int CW_TEXP = 512;
constexpr int CW_BAR = 4096;
constexpr int CW_SLOT = 16384;

constexpr int RING_OFF = 0, RING_BYTES = 131072;
constexpr int LDSCTL_OFF = RING_BYTES, MISC_OFF = LDSCTL_OFF + 320;
constexpr int LDS_BYTES = 147456;
constexpr int LDS_TAB = 135168;

#define GAS __attribute__((address_space(1)))
#define LAS __attribute__((address_space(3)))
typedef unsigned short bf16;
typedef unsigned v4u __attribute__((ext_vector_type(4)));
typedef unsigned v2u __attribute__((ext_vector_type(2)));
typedef float f32x4 __attribute__((ext_vector_type(4)));
typedef GAS unsigned gu32;
#define RLX_AGENT __ATOMIC_RELAXED, __HIP_MEMORY_SCOPE_AGENT
#define LDS_WAIT() asm volatile("s_waitcnt lgkmcnt(0)" ::: "memory")
#define VM_WAIT() asm volatile("s_waitcnt vmcnt(0)" ::: "memory")
__device__ __forceinline__ unsigned f2bf(float f) { unsigned u = __builtin_bit_cast(unsigned, f); return (u + 0x7fffu + ((u >> 16) & 1u)) >> 16; }
__device__ __forceinline__ unsigned pk2(float lo, float hi) { return f2bf(lo) | (f2bf(hi) << 16); }
__device__ __forceinline__ float bf2f(unsigned short h) { return __builtin_bit_cast(float, (unsigned)h << 16); }
__device__ __forceinline__ float bflo(unsigned w) { return __builtin_bit_cast(float, w << 16); }
__device__ __forceinline__ float bfhi(unsigned w) { return __builtin_bit_cast(float, w & 0xffff0000u); }
__device__ __forceinline__ float wave_sum(float v) {
#pragma unroll
    for (int o = 1; o < 64; o <<= 1) v += __shfl_xor(v, o);
    return v;
}
__device__ __forceinline__ float wave_max(float v) {
#pragma unroll
    for (int o = 1; o < 64; o <<= 1) v = fmaxf(v, __shfl_xor(v, o));
    return v;
}
#define XB_TMO      128
#define XB_XCNT(j)  (256  + 64 * (j))
#define XB_XSUB(j)  (1280 + 64 * (j))
#define XB_XGEN(j)  (2304 + 64 * (j))
#define XB_TOP      3328
#define XB_TOPGEN   3392
#define XCD_BAR_WORDS 3456
#define XB_SPIN_CAP (1u << 18)

__device__ __forceinline__ unsigned xb_ld(unsigned* p)              { return __hip_atomic_load(p, __ATOMIC_RELAXED, __HIP_MEMORY_SCOPE_AGENT); }
__device__ __forceinline__ unsigned xb_add(unsigned* p, unsigned v) { return __hip_atomic_fetch_add(p, v, __ATOMIC_RELAXED, __HIP_MEMORY_SCOPE_AGENT); }
__device__ __forceinline__ unsigned xb_xcc_id() { return (unsigned)__builtin_amdgcn_s_getreg((3 << 11) | 20) & 0xFu; }
#define XB_SPIN(cond, bar) do { unsigned _sp = 0; while (cond) { __builtin_amdgcn_s_sleep(1); \
    if ((++_sp & 255u) == 0u) { if (xb_ld(&(bar)[XB_TMO])) break; if (_sp > XB_SPIN_CAP) { atomicAdd(&(bar)[XB_TMO], 1u); break; } } } } while (0)

struct XcdBarrier {
    unsigned* bar; unsigned x;
    volatile LAS unsigned* st;
};

__device__ __forceinline__ XcdBarrier xcd_barrier_post(unsigned* bar, volatile LAS unsigned* st) {
    XcdBarrier b; b.bar = bar; b.x = xb_xcc_id(); b.st = st;
    if (threadIdx.x == 0) (void)xb_add(&bar[XB_XCNT(b.x)], 1u);
    return b;
}
__device__ __forceinline__ void xcd_barrier_complete(unsigned* bar, unsigned x, unsigned& nloc, unsigned& nx) {
    const unsigned G = gridDim.x * gridDim.y * gridDim.z;
    unsigned sum, cnt, mine, sp = 0u;
    for (;;) {
        sum = 0u; cnt = 0u; mine = 0u;
#pragma unroll
        for (unsigned j = 0; j < 16; ++j) { const unsigned c = xb_ld(&bar[XB_XCNT(j)]); sum += c; cnt += (c > 0u) ? 1u : 0u; mine = (j == x) ? c : mine; }
        if (sum == G) break;
        __builtin_amdgcn_s_sleep(1);
        if ((++sp & 255u) == 0u) { if (xb_ld(&bar[XB_TMO])) break; if (sp > XB_SPIN_CAP) { atomicAdd(&bar[XB_TMO], 1u); break; } }
    }
    nloc = mine > 0u ? mine : 1u; nx = cnt > 0u ? cnt : 1u;
}

__device__ __forceinline__ void xcd_barrier(const XcdBarrier& b) {
    asm volatile("s_waitcnt vmcnt(0)" ::: "memory");
    __syncthreads();
    if (threadIdx.x == 0) {
        unsigned* bar = b.bar;
        __builtin_amdgcn_s_waitcnt(0);
        unsigned nloc = b.st[0], nx = b.st[1];
        if (nloc == 0u) { xcd_barrier_complete(bar, b.x, nloc, nx); b.st[0] = nloc; b.st[1] = nx; }
        const unsigned old = xb_add(&bar[XB_XSUB(b.x)], 1u);
        const unsigned gen = old / nloc;
        if (old + 1u == (gen + 1u) * nloc) {
            __builtin_amdgcn_fence(__ATOMIC_RELEASE, "agent");
            asm volatile("s_waitcnt vmcnt(0)" ::: "memory");
            const unsigned og = xb_add(&bar[XB_TOP], 1u);
            const unsigned tg = og / nx;
            if (og + 1u == (tg + 1u) * nx) xb_add(&bar[XB_TOPGEN], 1u);
            else XB_SPIN(xb_ld(&bar[XB_TOPGEN]) == tg, bar);
            __builtin_amdgcn_fence(__ATOMIC_ACQUIRE, "agent");
            xb_add(&bar[XB_XGEN(b.x)], 1u);
            asm volatile("s_waitcnt vmcnt(0)" ::: "memory");
        } else {
            XB_SPIN(xb_ld(&bar[XB_XGEN(b.x)]) == gen, bar);
            __builtin_amdgcn_fence(__ATOMIC_ACQUIRE, "agent");
            asm volatile("s_waitcnt vmcnt(0)" ::: "memory");
        }
    }
    __syncthreads();
}

struct Frame {
    LAS unsigned char* lds;
    volatile LAS unsigned* MISC;
    gu32* ctl;
    unsigned char* ws;
    int tid, lane, wave, vcu, G;
};
struct LocalId { int tid, lane, wave; };
__device__ __forceinline__ LocalId local_id() { int t = threadIdx.x; asm volatile("" : "+v"(t)); LocalId l; l.tid = t; l.lane = t & 63; l.wave = __builtin_amdgcn_readfirstlane(t >> 6); return l; }
struct Args { const float* in[35]; float* out; unsigned char* ws; int ph_lo, ph_hi; };
enum { I_X = 0, I_C, I_CTX, I_CCTX, I_MODW, I_MODB, I_EWIN, I_EWOUT, I_AQN, I_AKN, I_BCQN, I_BWUQ, I_BCKVN, I_BWUKV, I_BQN, I_BKN, I_OWIN, I_OWOUT,
       I_CQN, I_CKN, I_LQ1, I_LK1, I_LQ2, I_LK2, I_SUBLN, I_DQN, I_DKN, I_SINK, I_WRG, I_BRG, I_WRE, I_BRE, I_WG, I_WU, I_WD };

__device__ __forceinline__ int mod_index(int row) { const int b = row / TPB; return (row - b * TPB) < CTX ? 8 : b; }

__device__ __forceinline__ void transpose_item(const float* W, int N, int k0, int n0, bf16* dst, int Kd, LAS float* scr, int lane) {
    f32x4 v[8];
    const int kr = lane >> 3, cq = lane & 7;
#pragma unroll
    for (int i = 0; i < 8; ++i) v[i] = *(const f32x4*)(W + (size_t)(k0 + kr + 8 * i) * N + n0 + 4 * cq);
#pragma unroll
    for (int i = 0; i < 8; ++i) { LAS float* d = scr + (kr + 8 * i) * 33 + 4 * cq; d[0] = v[i].x; d[1] = v[i].y; d[2] = v[i].z; d[3] = v[i].w; }
    LDS_WAIT(); asm volatile("" ::: "memory");
    const int c = lane & 7;
#pragma unroll
    for (int j = 0; j < 4; ++j) { const int n = (lane >> 3) + 8 * j; const LAS float* s = scr + (8 * c) * 33 + n;
        v4u o; o.x = pk2(s[0 * 33], s[1 * 33]); o.y = pk2(s[2 * 33], s[3 * 33]); o.z = pk2(s[4 * 33], s[5 * 33]); o.w = pk2(s[6 * 33], s[7 * 33]);
        *(GAS v4u*)(dst + (size_t)n * Kd + k0 + 8 * c) = o; }
    LDS_WAIT(); asm volatile("" ::: "memory");
}
__device__ __forceinline__ void small_transpose(const float* W, int K, int N, bf16* WT, int item, LAS float* scr, int lane) {
    const int nblk = N / 32, kb = item / nblk, nb = item - kb * nblk;
    transpose_item(W, N, kb * 64, nb * 32, WT + (size_t)(nb * 32) * K, K, scr, lane);
}
__device__ __forceinline__ void p0_prologue(const Frame& F, const Args& a) {
    const LocalId L_ = local_id(); (void)L_;
    const int gt = F.vcu * 512 + L_.tid, NT = F.G * 512;
    {
        float2* t128 = (float2*)(F.ws + WS_ROPE); float2* t64 = (float2*)(F.ws + WS_ROPE + 16384);
        for (int i = gt; i < 3072; i += NT) {
            if (i < 2048) { const int pos = i >> 5, f = i & 31; const float inv = 1.0f / powf(10000.0f, (float)f / 32.0f); const float ang = (float)pos * inv; t128[i] = make_float2(cosf(ang), sinf(ang)); }
            else { const int k = i - 2048, pos = k >> 4, f = k & 15; const float inv = 1.0f / powf(10000.0f, (float)f / 16.0f); const float ang = (float)pos * inv; t64[k] = make_float2(cosf(ang), sinf(ang)); }
        }
    }
    { float* gsub = (float*)(F.ws + WS_ROPE + 32768); for (int i = gt; i < 128; i += NT) gsub[i] = a.in[I_SUBLN][i] * (1.0f - LAMBDA_INIT); }
    {
        bf16* WR = (bf16*)(F.ws + WS_WR);
        for (int i = gt; i < 2 * 256 * 2048; i += NT) { const int l = i >> 19, r = (i >> 11) & 255, k = i & 2047;
            float v = 0.f; if (r < 4) v = a.in[I_WRG][((size_t)l * 2048 + k) * 4 + r]; else if (r < 36) v = a.in[I_WRE][((size_t)l * 2048 + k) * 32 + (r - 4)];
            WR[i] = (bf16)f2bf(v); }
        v4u* z = (v4u*)((bf16*)(F.ws + WS_WE_IN) + (size_t)2624 * 2048);
        for (int i = gt; i < 192 * 2048 / 8; i += NT) z[i] = (v4u){0u, 0u, 0u, 0u};
    }
    {
        LAS float* sl = (LAS float*)(F.lds + RING_OFF);
        LAS float* red = (LAS float*)(F.lds + RING_OFF + 73728);
        for (int i = L_.tid; i < 9 * 2048; i += 512) { const int j = i >> 11, k = i & 2047; const float v = j < 8 ? a.in[I_C][j * 2048 + k] : a.in[I_CCTX][k]; sl[i] = v / (1.0f + expf(-v)); }
        __syncthreads();
        float* MOD = (float*)(F.ws + WS_MOD);
        const int cg = L_.lane & 7, ks = L_.lane >> 3;
        for (int item = blockIdx.x; item < 768; item += F.G) {
            const int layer = item / 384, chunk = item - layer * 384, col0 = chunk * 32;
            const float* W = a.in[I_MODW] + (size_t)layer * 2048 * 12288 + col0 + cg * 4;
            f32x4 acc[9];
#pragma unroll
            for (int j = 0; j < 9; ++j) acc[j] = (f32x4){0.f, 0.f, 0.f, 0.f};
#pragma unroll 8
            for (int it = 0; it < 32; ++it) { const int k = L_.wave * 256 + it * 8 + ks; const f32x4 w = *(const f32x4*)(W + (size_t)k * 12288);
#pragma unroll
                for (int j = 0; j < 9; ++j) { const float s = sl[j * 2048 + k]; acc[j] = acc[j] + w * s; } }
#pragma unroll
            for (int j = 0; j < 9; ++j)
#pragma unroll
                for (int e = 0; e < 4; ++e) { float v = acc[j][e]; v += __shfl_xor(v, 8); v += __shfl_xor(v, 16); v += __shfl_xor(v, 32); acc[j][e] = v; }
            if (L_.lane < 8) {
#pragma unroll
                for (int j = 0; j < 9; ++j)
#pragma unroll
                    for (int e = 0; e < 4; ++e) red[(L_.wave * 9 + j) * 32 + cg * 4 + e] = acc[j][e]; }
            __syncthreads();
            if (L_.tid < 288) { const int j = L_.tid >> 5, cc = L_.tid & 31; float s = a.in[I_MODB][layer * 12288 + col0 + cc];
#pragma unroll
                for (int w = 0; w < 8; ++w) s += red[(w * 9 + j) * 32 + cc];
                MOD[((size_t)layer * 9 + j) * 12288 + col0 + cc] = s; }
            __syncthreads();
        }
    }
    {
        LAS float* scr = (LAS float*)(F.lds + RING_OFF + L_.wave * 16384);
        const int gw = F.vcu * NWAVES + L_.wave, NGW = F.G * NWAVES;
        constexpr int I0 = 32 * 82, I1 = 8 * 48, I2 = 8 * 64, I3 = 32 * 64, I4 = 32 * 144, I5 = 32 * 64, NSMALL = I0 + I1 + I2 + I3 + I4 + I5;
#if MOE_F32B
        constexpr int NMOE = 0;
#else
        constexpr int NMOE = 64 * 3072;
#endif
        for (int it = gw; it < NSMALL + NMOE; it += NGW) {
            int r = it;
            if (r < NSMALL) {
                if (r < I0) { small_transpose(a.in[I_EWIN], 2048, 2624, (bf16*)(F.ws + WS_WE_IN), r, scr, L_.lane); continue; } r -= I0;
                if (r < I1) { small_transpose(a.in[I_BWUQ], 512, 1536, (bf16*)(F.ws + WS_WE_UQ), r, scr, L_.lane); continue; } r -= I1;
                if (r < I2) { small_transpose(a.in[I_BWUKV], 512, 2048, (bf16*)(F.ws + WS_WE_UKV), r, scr, L_.lane); continue; } r -= I2;
                if (r < I3) { small_transpose(a.in[I_EWOUT], 2048, 2048, (bf16*)(F.ws + WS_WE_OUT), r, scr, L_.lane); continue; } r -= I3;
                if (r < I4) { small_transpose(a.in[I_OWIN], 2048, 4608, (bf16*)(F.ws + WS_WO_IN), r, scr, L_.lane); continue; } r -= I4;
                small_transpose(a.in[I_OWOUT], 2048, 2048, (bf16*)(F.ws + WS_WO_OUT), r, scr, L_.lane); continue;
            }
            r -= NSMALL;
            const int le = r / 3072, q = r - le * 3072, which = q >> 10, ri = q & 1023;
            if (which < 2) {
                const int kb = ri >> 5, nb = ri & 31, n0 = nb * 32;
                const float* W = a.in[which == 0 ? I_WG : I_WU] + (size_t)le * 2048 * 1024;
                bf16* dst = (bf16*)(F.ws + WS_WGU) + (size_t)le * 2048 * 2048 + (size_t)((n0 >> 7) * 256 + which * 128 + (n0 & 127)) * 2048;
                transpose_item(W, 1024, kb * 64, n0, dst, 2048, scr, L_.lane);
            } else {
                const int kb = ri >> 6, nb = ri & 63, n0 = nb * 32;
                const float* W = a.in[I_WD] + (size_t)le * 1024 * 2048;
                bf16* dst = (bf16*)(F.ws + WS_WDN) + (size_t)le * 2048 * 1024 + (size_t)n0 * 1024;
                transpose_item(W, 2048, kb * 64, n0, dst, 1024, scr, L_.lane);
            }
        }
    }
}

__device__ __forceinline__ void modulate_store(const f32x4 (&v)[8], const float* shift, const float* scale, bf16* orow, int lane) {
    float ss = 0.f;
#pragma unroll
    for (int j = 0; j < 8; ++j) ss += (v[j].x * v[j].x + v[j].y * v[j].y) + (v[j].z * v[j].z + v[j].w * v[j].w);
    ss = wave_sum(ss);
    const float r = 1.0f / sqrtf(ss * (1.0f / 2048.0f) + NORM_EPS);
#pragma unroll
    for (int j = 0; j < 8; ++j) { const f32x4 sh = ((const f32x4*)shift)[lane + 64 * j], sc = ((const f32x4*)scale)[lane + 64 * j];
        const f32x4 y = v[j] * r * (sc + 1.0f) + sh; v2u o; o.x = pk2(y.x, y.y); o.y = pk2(y.z, y.w); ((v2u*)orow)[lane + 64 * j] = o; }
}
__device__ __forceinline__ void moe_combine_load(const bf16* YS, const int* rec, const LAS int* offs, int lane, f32x4 (&y)[8]) {
    const int s0 = offs[rec[0]] + rec[2], s1 = offs[rec[1]] + rec[3]; const float w0 = __builtin_bit_cast(float, rec[4]), w1 = __builtin_bit_cast(float, rec[5]);
    const v2u* p0 = (const v2u*)(YS + (size_t)s0 * 2048); const v2u* p1 = (const v2u*)(YS + (size_t)s1 * 2048);
#pragma unroll
    for (int j = 0; j < 8; ++j) { const v2u a = p0[lane + 64 * j], b = p1[lane + 64 * j];
        y[j].x = w0 * bflo(a.x) + w1 * bflo(b.x); y[j].y = w0 * bfhi(a.x) + w1 * bfhi(b.x); y[j].z = w0 * bflo(a.y) + w1 * bflo(b.y); y[j].w = w0 * bfhi(a.y) + w1 * bfhi(b.y); }
}

__device__ __forceinline__ int moe_tables(const Frame& F, int layer, int tid) {
    LAS int* texp = (LAS int*)(F.lds + LDS_TAB); LAS int* frt = texp + 256; LAS int* offs = frt + 40;
    if (tid < 64) {
        const int e = tid & 31;
        const unsigned c = __hip_atomic_load((unsigned*)(F.ctl + CW_CNT + layer * 64 + e), RLX_AGENT);
        const int pad = (int)((c + 255u) & ~255u);
        int incl = pad;
#pragma unroll
        for (int d = 1; d < 32; d <<= 1) { const int v = __shfl_up(incl, d); if ((tid & 31) >= d) incl += v; }
        const int excl = incl - pad;
        if (tid < 32) { offs[e] = excl; frt[e] = excl >> 8; for (int r = excl >> 8; r < (incl >> 8); ++r) texp[r] = e; if (e == 31) { offs[NE] = incl; frt[NE] = incl >> 8; } }
    }
    __syncthreads();
    return frt[NE];
}
__device__ __forceinline__ void hrow_load(const bf16* hrow, int lane, f32x4 (&v)[8]) {
#pragma unroll
    for (int q = 0; q < 8; ++q) { const v2u w = ((const v2u*)hrow)[lane + 64 * q]; v[q].x = bflo(w.x); v[q].y = bfhi(w.x); v[q].z = bflo(w.y); v[q].w = bfhi(w.y); }
}
__device__ __forceinline__ void hrow_store(bf16* hrow, int lane, const f32x4 (&v)[8]) {
#pragma unroll
    for (int q = 0; q < 8; ++q) { v2u o; o.x = pk2(v[q].x, v[q].y); o.y = pk2(v[q].z, v[q].w); ((v2u*)hrow)[lane + 64 * q] = o; }
}
__device__ __forceinline__ const float* l0_src_row(const Args& a, int row, int& j) {
    const int b = row / TPB, r = row - b * TPB; j = r < CTX ? 8 : b;
    return r < CTX ? a.in[I_CTX] + (size_t)(b * CTX + r) * DM : a.in[I_X] + (size_t)(b * SEQ + (r - CTX)) * DM;
}
__device__ __forceinline__ void p_l0_mod1(const Frame& F, const Args& a) {
    const LocalId L_ = local_id(); (void)L_;
    const int gw = F.vcu * NWAVES + L_.wave, NGW = F.G * NWAVES;
    const float* MOD = (const float*)(F.ws + WS_MOD); bf16* A1 = (bf16*)(F.ws + WS_A1);
    for (int r0 = gw; r0 < T; r0 += 2 * NGW) {
        const int r1 = r0 + NGW; const bool ok1 = r1 < T;
        int j0, j1 = 0; const float* s0 = l0_src_row(a, r0, j0); const float* s1 = ok1 ? l0_src_row(a, r1, j1) : s0;
        f32x4 v0[8], v1[8];
#pragma unroll
        for (int q = 0; q < 8; ++q) v0[q] = ((const f32x4*)s0)[L_.lane + 64 * q];
#pragma unroll
        for (int q = 0; q < 8; ++q) v1[q] = ((const f32x4*)s1)[L_.lane + 64 * q];
        const float* m0 = MOD + (size_t)(0 * 9 + j0) * 12288;
        modulate_store(v0, m0 + 0 * 2048, m0 + 1 * 2048, A1 + (size_t)r0 * DM, L_.lane);
        if (ok1) {
            const float* m1 = MOD + (size_t)(0 * 9 + j1) * 12288;
            modulate_store(v1, m1 + 0 * 2048, m1 + 1 * 2048, A1 + (size_t)r1 * DM, L_.lane);
        }
    }
}
__device__ __forceinline__ void p_mod2(const Frame& F, int layer) {
    const LocalId L_ = local_id(); (void)L_;
    const int gw = F.vcu * NWAVES + L_.wave, NGW = F.G * NWAVES;
    const float* MOD = (const float*)(F.ws + WS_MOD); const bf16* H = (const bf16*)(F.ws + WS_H); bf16* A1 = (bf16*)(F.ws + WS_A1);
    for (int r0 = gw; r0 < T; r0 += 2 * NGW) {
        const int r1 = r0 + NGW; const int j0 = mod_index(r0), j1 = r1 < T ? mod_index(r1) : 8;
        const bool ok0 = !(layer == 1 && j0 == 8), ok1 = r1 < T && !(layer == 1 && j1 == 8);
        f32x4 v0[8], v1[8];
        if (ok0) hrow_load(H + (size_t)r0 * DM, L_.lane, v0);
        if (ok1) hrow_load(H + (size_t)r1 * DM, L_.lane, v1);
        if (ok0) { const float* m = MOD + (size_t)(layer * 9 + j0) * 12288; modulate_store(v0, m + 3 * 2048, m + 4 * 2048, A1 + (size_t)r0 * DM, L_.lane); }
        if (ok1) { const float* m = MOD + (size_t)(layer * 9 + j1) * 12288; modulate_store(v1, m + 3 * 2048, m + 4 * 2048, A1 + (size_t)r1 * DM, L_.lane); }
    }
}
__device__ __forceinline__ void p_l1_mod1(const Frame& F, size_t hdst_off = WS_H, size_t adst_off = WS_A1) {
    const LocalId L_ = local_id(); (void)L_;
    const int gw = F.vcu * NWAVES + L_.wave, NGW = F.G * NWAVES;
    const float* MOD = (const float*)(F.ws + WS_MOD); const bf16* H = (const bf16*)(F.ws + WS_H); bf16* Hd = (bf16*)(F.ws + hdst_off); bf16* A1 = (bf16*)(F.ws + adst_off);
    const bf16* YS = (const bf16*)(F.ws + WS_YS); const int* ROUTE = (const int*)(F.ws + WS_ROUTE);
    (void)moe_tables(F, 0, L_.tid); const LAS int* offs = (const LAS int*)(F.lds + LDS_TAB) + 296;
    for (int r0 = gw; r0 < T; r0 += 2 * NGW) {
        const int r1 = r0 + NGW; const bool ok1 = r1 < T; const int rr1 = ok1 ? r1 : r0;
        const int j0 = mod_index(r0), j1 = mod_index(rr1);
        f32x4 v0[8], v1[8], y0[8], y1[8];
        moe_combine_load(YS, ROUTE + (size_t)r0 * 8, offs, L_.lane, y0);
        moe_combine_load(YS, ROUTE + (size_t)rr1 * 8, offs, L_.lane, y1);
        hrow_load(H + (size_t)r0 * DM, L_.lane, v0);
        hrow_load(H + (size_t)rr1 * DM, L_.lane, v1);
        const float* g0 = MOD + (size_t)(0 * 9 + j0) * 12288 + 5 * 2048; const float* g1 = MOD + (size_t)(0 * 9 + j1) * 12288 + 5 * 2048;
#pragma unroll
        for (int q = 0; q < 8; ++q) { v0[q] = v0[q] + ((const f32x4*)g0)[L_.lane + 64 * q] * y0[q]; v1[q] = v1[q] + ((const f32x4*)g1)[L_.lane + 64 * q] * y1[q]; }
        if (j0 != 8) hrow_store(Hd + (size_t)r0 * DM, L_.lane, v0);
        const float* m0 = MOD + (size_t)(1 * 9 + j0) * 12288;
        modulate_store(v0, m0 + 0 * 2048, m0 + 1 * 2048, A1 + (size_t)r0 * DM, L_.lane);
        if (ok1) {
            if (j1 != 8) hrow_store(Hd + (size_t)r1 * DM, L_.lane, v1);
            const float* m1 = MOD + (size_t)(1 * 9 + j1) * 12288;
            modulate_store(v1, m1 + 0 * 2048, m1 + 1 * 2048, A1 + (size_t)r1 * DM, L_.lane);
        }
    }
}
__device__ __forceinline__ void p_final(const Frame& F, float* out) {
    const LocalId L_ = local_id(); (void)L_;
    const int gw = F.vcu * NWAVES + L_.wave, NGW = F.G * NWAVES;
    const float* MOD = (const float*)(F.ws + WS_MOD); const bf16* H = (const bf16*)(F.ws + WS_H);
    const bf16* YS = (const bf16*)(F.ws + WS_YS); const int* ROUTE = (const int*)(F.ws + WS_ROUTE);
    (void)moe_tables(F, 1, L_.tid); const LAS int* offs = (const LAS int*)(F.lds + LDS_TAB) + 296;
    for (int i0 = gw; i0 < NB * SEQ; i0 += 2 * NGW) {
        const int i1 = i0 + NGW; const bool ok1 = i1 < NB * SEQ; const int ii1 = ok1 ? i1 : i0;
        const int b0 = i0 / SEQ, row0 = b0 * TPB + CTX + (i0 - b0 * SEQ), b1 = ii1 / SEQ, row1 = b1 * TPB + CTX + (ii1 - b1 * SEQ);
        f32x4 y0[8], y1[8], h0[8], h1[8];
        moe_combine_load(YS, ROUTE + (size_t)row0 * 8, offs, L_.lane, y0);
        moe_combine_load(YS, ROUTE + (size_t)row1 * 8, offs, L_.lane, y1);
        hrow_load(H + (size_t)row0 * DM, L_.lane, h0);
        hrow_load(H + (size_t)row1 * DM, L_.lane, h1);
        const float* g0 = MOD + (size_t)(1 * 9 + b0) * 12288 + 5 * 2048; const float* g1 = MOD + (size_t)(1 * 9 + b1) * 12288 + 5 * 2048;
#pragma unroll
        for (int q = 0; q < 8; ++q) ((f32x4*)(out + (size_t)i0 * DM))[L_.lane + 64 * q] = h0[q] + ((const f32x4*)g0)[L_.lane + 64 * q] * y0[q];
        if (ok1) {
#pragma unroll
            for (int q = 0; q < 8; ++q) ((f32x4*)(out + (size_t)i1 * DM))[L_.lane + 64 * q] = h1[q] + ((const f32x4*)g1)[L_.lane + 64 * q] * y1[q]; }
    }
}

__device__ __forceinline__ void head128_norm_rope(const bf16* p, bf16* pd, const float* gain, bool rope, int prow, int pcol, const float2* t128, int lane) {
    const float x0 = bf2f(p[lane]), x1 = bf2f(p[lane + 64]);
    const float ss = wave_sum(x0 * x0 + x1 * x1);
    const float r = 1.0f / sqrtf(ss * (1.0f / 128.0f) + NORM_EPS);
    float y0 = x0 * r * gain[lane], y1 = x1 * r * gain[lane + 64];
    if (rope) {
        const int f = lane & 31; const float2 cr = t128[prow * 32 + f], cc = t128[pcol * 32 + f];
        const float p0 = __shfl_xor(y0, 32), p1 = __shfl_xor(y1, 32); const float sg = (lane & 32) ? 1.0f : -1.0f;
        y0 = y0 * cr.x + sg * p0 * cr.y; y1 = y1 * cc.x + sg * p1 * cc.y;
    }
    pd[lane] = (bf16)f2bf(y0); pd[lane + 64] = (bf16)f2bf(y1);
}
__device__ __forceinline__ float rope64_apply(float y, int prow, int pcol, const float2* t64, int lane) {
    const int f = lane & 15, pos = (lane & 32) ? pcol : prow; const float2 cs = t64[pos * 16 + f];
    const float pr = __shfl_xor(y, 16); const float sg = (lane & 16) ? 1.0f : -1.0f;
    return y * cs.x + sg * pr * cs.y;
}
__device__ __forceinline__ void head64_norm_rope(const bf16* p, bf16* pd, const float* gain, bool rope, int prow, int pcol, const float2* t64, int lane) {
    const float x = bf2f(p[lane]);
    const float ss = wave_sum(x * x);
    const float r = 1.0f / sqrtf(ss * (1.0f / 64.0f) + NORM_EPS);
    float y = x * r * gain[lane];
    if (rope) y = rope64_apply(y, prow, pcol, t64, lane);
    pd[lane] = (bf16)f2bf(y);
}
__device__ __forceinline__ void norm512(const bf16* src, const float* gain, bf16* dst, int lane) {
    const v4u w = ((const v4u*)src)[lane];
    float x[8] = {bflo(w.x), bfhi(w.x), bflo(w.y), bfhi(w.y), bflo(w.z), bfhi(w.z), bflo(w.w), bfhi(w.w)};
    float ss = 0.f;
#pragma unroll
    for (int i = 0; i < 8; ++i) ss += x[i] * x[i];
    ss = wave_sum(ss);
    const float r = 1.0f / sqrtf(ss * (1.0f / 512.0f) + NORM_EPS);
    const f32x4 g0 = ((const f32x4*)gain)[2 * lane], g1 = ((const f32x4*)gain)[2 * lane + 1];
    v4u o; o.x = pk2(x[0] * r * g0.x, x[1] * r * g0.y); o.y = pk2(x[2] * r * g0.z, x[3] * r * g0.w); o.z = pk2(x[4] * r * g1.x, x[5] * r * g1.y); o.w = pk2(x[6] * r * g1.z, x[7] * r * g1.w);
    ((v4u*)dst)[lane] = o;
}

__device__ __forceinline__ void unpack8(const v4u w, float (&x)[8]) { x[0] = bflo(w.x); x[1] = bfhi(w.x); x[2] = bflo(w.y); x[3] = bfhi(w.y); x[4] = bflo(w.z); x[5] = bfhi(w.z); x[6] = bflo(w.w); x[7] = bfhi(w.w); }
__device__ __forceinline__ v4u pack8(const float (&y)[8]) { v4u o; o.x = pk2(y[0], y[1]); o.y = pk2(y[2], y[3]); o.z = pk2(y[4], y[5]); o.w = pk2(y[6], y[7]); return o; }
__device__ __forceinline__ float sumsq8(const float (&x)[8]) { return ((x[0] * x[0] + x[1] * x[1]) + (x[2] * x[2] + x[3] * x[3])) + ((x[4] * x[4] + x[5] * x[5]) + (x[6] * x[6] + x[7] * x[7])); }
template <int GS> __device__ __forceinline__ float group_sum(float v) {
    v += __shfl_xor(v, 1); v += __shfl_xor(v, 2); v += __shfl_xor(v, 4); if (GS == 16) v += __shfl_xor(v, 8); return v;
}
template <int RD> __device__ __forceinline__ void rope8(float (&y)[8], int l, int prow, int pcol, const float2* tab) {
    constexpr int NF = RD / 4, LQ = NF / 8;
    const int quarter = l / LQ, f0 = (l % LQ) * 8, pos = (quarter >= 2) ? pcol : prow;
    const float sg = (quarter & 1) ? 1.0f : -1.0f;
    const f32x4* t = (const f32x4*)(tab + pos * NF + f0);
    const f32x4 c0 = t[0], c1 = t[1], c2 = t[2], c3 = t[3];
    float p[8];
#pragma unroll
    for (int j = 0; j < 8; ++j) p[j] = __shfl_xor(y[j], LQ);
    y[0] = y[0] * c0.x + sg * p[0] * c0.y; y[1] = y[1] * c0.z + sg * p[1] * c0.w; y[2] = y[2] * c1.x + sg * p[2] * c1.y; y[3] = y[3] * c1.z + sg * p[3] * c1.w;
    y[4] = y[4] * c2.x + sg * p[4] * c2.y; y[5] = y[5] * c2.z + sg * p[5] * c2.w; y[6] = y[6] * c3.x + sg * p[6] * c3.y; y[7] = y[7] * c3.z + sg * p[7] * c3.w;
}
template <int DIM> __device__ __forceinline__ v4u head_chunk(const v4u w, const float* gain, bool rope, int prow, int pcol, const float2* tab, int lane) {
    constexpr int GS = DIM / 8; const int l = lane & (GS - 1);
    float x[8]; unpack8(w, x);
    const float ss = group_sum<GS>(sumsq8(x));
    const float r = 1.0f / sqrtf(ss * (1.0f / DIM) + NORM_EPS);
    const f32x4 g0 = ((const f32x4*)gain)[2 * l], g1 = ((const f32x4*)gain)[2 * l + 1];
    x[0] *= r * g0.x; x[1] *= r * g0.y; x[2] *= r * g0.z; x[3] *= r * g0.w; x[4] *= r * g1.x; x[5] *= r * g1.y; x[6] *= r * g1.z; x[7] *= r * g1.w;
    if (rope) rope8<DIM>(x, l, prow, pcol, tab);
    return pack8(x);
}
__device__ __forceinline__ v4u norm512_chunk(const v4u w, const float* gain, int lane) {
    float x[8]; unpack8(w, x);
    const float ss = wave_sum(sumsq8(x));
    const float r = 1.0f / sqrtf(ss * (1.0f / 512.0f) + NORM_EPS);
    const f32x4 g0 = ((const f32x4*)gain)[2 * lane], g1 = ((const f32x4*)gain)[2 * lane + 1];
    x[0] *= r * g0.x; x[1] *= r * g0.y; x[2] *= r * g0.z; x[3] *= r * g0.w; x[4] *= r * g1.x; x[5] *= r * g1.y; x[6] *= r * g1.z; x[7] *= r * g1.w;
    return pack8(x);
}

__device__ __forceinline__ void p_even_post1(const Frame& F, const Args& a, size_t ydst_off = WS_Y1) {
    const LocalId L_ = local_id(); (void)L_;
    const int gw = F.vcu * NWAVES + L_.wave, NGW = F.G * NWAVES, lane = L_.lane;
    const bf16* Y1 = (const bf16*)(F.ws + WS_Y1); bf16* CQN = (bf16*)(F.ws + WS_CQN); bf16* CKVN = (bf16*)(F.ws + WS_CKVN);
    const float2* t128 = (const float2*)(F.ws + WS_ROPE);
    for (int row = gw; row < T; row += NGW) {
        const int b = row / TPB, r = row - b * TPB; const bool xr = r >= CTX; const int s = r - CTX, prow = xr ? (s >> 6) : 0, pcol = xr ? (s & 63) : 0;
        const v4u* y = (const v4u*)(Y1 + (size_t)row * EVEN_IN_P); v4u* yd = (v4u*)((bf16*)(F.ws + ydst_off) + (size_t)row * EVEN_IN_P);
        const v4u q0 = y[lane], q1 = y[64 + lane], k0 = y[128 + (lane & 31)], cq = y[192 + lane], ckv = y[256 + lane];
        const v4u oq0 = head_chunk<128>(q0, a.in[I_AQN], xr, prow, pcol, t128, lane), oq1 = head_chunk<128>(q1, a.in[I_AQN], xr, prow, pcol, t128, lane);
        const v4u ok0 = head_chunk<128>(k0, a.in[I_AKN], xr, prow, pcol, t128, lane);
        const v4u ocq = norm512_chunk(cq, a.in[I_BCQN], lane), ockv = norm512_chunk(ckv, a.in[I_BCKVN], lane);
        yd[lane] = oq0; yd[64 + lane] = oq1; if (lane < 32) yd[128 + lane] = ok0;
        ((v4u*)(CQN + (size_t)row * 512))[lane] = ocq; ((v4u*)(CKVN + (size_t)row * 512))[lane] = ockv;
    }
}
__device__ __forceinline__ void p_even_post2(const Frame& F, const Args& a, size_t qdst_off = WS_QB, size_t kdst_off = WS_KB) {
    const LocalId L_ = local_id(); (void)L_;
    const int gw = F.vcu * NWAVES + L_.wave, NGW = F.G * NWAVES, lane = L_.lane;
    const bf16* Y1 = (const bf16*)(F.ws + WS_Y1); const bf16* QB = (const bf16*)(F.ws + WS_QB); const bf16* KV = (const bf16*)(F.ws + WS_KV);
    bf16* KB = (bf16*)(F.ws + kdst_off); bf16* QBd = (bf16*)(F.ws + qdst_off);
    const float2* t64 = (const float2*)(F.ws + WS_ROPE + 16384);
    const float* gq = a.in[I_BQN]; const float* gk = a.in[I_BKN]; const float* KRP = (const float*)(F.ws + WS_LG);
    const int l16 = lane & 15, l8 = lane & 7, hn = lane >> 4, hr = lane >> 3;
    const f32x4 gqn0 = ((const f32x4*)gq)[2 * l16], gqn1 = ((const f32x4*)gq)[2 * l16 + 1], gqr0 = ((const f32x4*)(gq + 128))[2 * l8], gqr1 = ((const f32x4*)(gq + 128))[2 * l8 + 1];
    const f32x4 gkn0 = ((const f32x4*)gk)[2 * l16], gkn1 = ((const f32x4*)gk)[2 * l16 + 1], gkr0 = ((const f32x4*)(gk + 128))[2 * l8], gkr1 = ((const f32x4*)(gk + 128))[2 * l8 + 1];
    for (int row = gw; row < T; row += NGW) {
        const int b = row / TPB, r = row - b * TPB; const bool xr = r >= CTX; const int s = r - CTX, prow = xr ? (s >> 6) : 0, pcol = xr ? (s & 63) : 0;
        const bf16* q = QB + (size_t)row * 1536; const bf16* kv = KV + (size_t)row * 2048;
        const v4u wq0 = *(const v4u*)(q + hn * 192 + l16 * 8), wq1 = *(const v4u*)(q + (hn + 4) * 192 + l16 * 8), wqr = *(const v4u*)(q + hr * 192 + 128 + l8 * 8);
        const v4u wk0 = *(const v4u*)(kv + hn * 256 + l16 * 8), wk1 = *(const v4u*)(kv + (hn + 4) * 256 + l16 * 8);
        const v4u wkr = *(const v4u*)(Y1 + (size_t)row * EVEN_IN_P + 2560 + l8 * 8);
#define POST2_ONE(W0, W1, WR, GN0, GN1, GR0, GR1, DST) do { \
        float x0[8], x1[8], xr_[8]; unpack8(W0, x0); unpack8(W1, x1); unpack8(WR, xr_); \
        const float n0 = group_sum<16>(sumsq8(x0)), n1 = group_sum<16>(sumsq8(x1)), rs = group_sum<8>(sumsq8(xr_));     \
        const float rs0 = __shfl(rs, 8 * hn), rs1 = __shfl(rs, 8 * (hn + 4));                                         \
        const float t0 = __shfl(n0, 16 * (hr & 3)), t1 = __shfl(n1, 16 * (hr & 3)); const float nr = (hr >> 2) ? t1 : t0;    \
        const float r0 = 1.0f / sqrtf((n0 + rs0) * (1.0f / 192.0f) + NORM_EPS), r1 = 1.0f / sqrtf((n1 + rs1) * (1.0f / 192.0f) + NORM_EPS), rr = 1.0f / sqrtf((nr + rs) * (1.0f / 192.0f) + NORM_EPS); \
        x0[0] *= r0 * GN0.x; x0[1] *= r0 * GN0.y; x0[2] *= r0 * GN0.z; x0[3] *= r0 * GN0.w; x0[4] *= r0 * GN1.x; x0[5] *= r0 * GN1.y; x0[6] *= r0 * GN1.z; x0[7] *= r0 * GN1.w; \
        x1[0] *= r1 * GN0.x; x1[1] *= r1 * GN0.y; x1[2] *= r1 * GN0.z; x1[3] *= r1 * GN0.w; x1[4] *= r1 * GN1.x; x1[5] *= r1 * GN1.y; x1[6] *= r1 * GN1.z; x1[7] *= r1 * GN1.w; \
        xr_[0] *= rr * GR0.x; xr_[1] *= rr * GR0.y; xr_[2] *= rr * GR0.z; xr_[3] *= rr * GR0.w; xr_[4] *= rr * GR1.x; xr_[5] *= rr * GR1.y; xr_[6] *= rr * GR1.z; xr_[7] *= rr * GR1.w; \
        if (xr) rope8<64>(xr_, l8, prow, pcol, t64); \
        *(v4u*)((DST) + hn * 192 + l16 * 8) = pack8(x0); *(v4u*)((DST) + (hn + 4) * 192 + l16 * 8) = pack8(x1); *(v4u*)((DST) + hr * 192 + 128 + l8 * 8) = pack8(xr_); } while (0)
        POST2_ONE(wq0, wq1, wqr, gqn0, gqn1, gqr0, gqr1, QBd + (size_t)row * 1536);
        POST2_ONE(wk0, wk1, wkr, gkn0, gkn1, gkr0, gkr1, KB + (size_t)row * 1536);
#undef POST2_ONE
    }
}
__device__ __forceinline__ void p_odd_post1(const Frame& F, const Args& a, size_t ydst_off = WS_Y1) {
    const LocalId L_ = local_id(); (void)L_;
    const int gw = F.vcu * NWAVES + L_.wave, NGW = F.G * NWAVES, lane = L_.lane;
    const bf16* Y1 = (const bf16*)(F.ws + WS_Y1);
    const float2* t128 = (const float2*)(F.ws + WS_ROPE); const float2* t64 = (const float2*)(F.ws + WS_ROPE + 16384);
    for (int row = gw; row < T; row += NGW) {
        const int b = row / TPB, r = row - b * TPB; const bool xr = r >= CTX; const int s = r - CTX, prow = xr ? (s >> 6) : 0, pcol = xr ? (s & 63) : 0;
        const v4u* y = (const v4u*)(Y1 + (size_t)row * ODD_IN); v4u* yd = (v4u*)((bf16*)(F.ws + ydst_off) + (size_t)row * ODD_IN);
        const v4u kc0 = y[128 + lane], kc1 = y[192 + lane], kd0 = y[512 + (lane & 31)];
        if (xr) {
            const v4u qc0 = y[lane], qc1 = y[64 + lane], qd0 = y[384 + lane], qd1 = y[448 + lane];
            const v4u o0 = head_chunk<64>(qc0, a.in[I_CQN], true, prow, pcol, t64, lane), o1 = head_chunk<64>(qc1, a.in[I_CQN], true, prow, pcol, t64, lane);
            const v4u o2 = head_chunk<128>(qd0, a.in[I_DQN], true, prow, pcol, t128, lane), o3 = head_chunk<128>(qd1, a.in[I_DQN], true, prow, pcol, t128, lane);
            yd[lane] = o0; yd[64 + lane] = o1; yd[384 + lane] = o2; yd[448 + lane] = o3;
        }
        const v4u p0 = head_chunk<64>(kc0, a.in[I_CKN], xr, prow, pcol, t64, lane), p1 = head_chunk<64>(kc1, a.in[I_CKN], xr, prow, pcol, t64, lane);
        const v4u p2 = head_chunk<128>(kd0, a.in[I_DKN], xr, prow, pcol, t128, lane);
        yd[128 + lane] = p0; yd[192 + lane] = p1; if (lane < 32) yd[512 + lane] = p2;
    }
}

__device__ __forceinline__ void p_route(const Frame& F, const Args& a, int layer) {
    const LocalId L_ = local_id(); (void)L_;
    const float* LG = (const float*)(F.ws + WS_LG); int* ROUTE = (int*)(F.ws + WS_ROUTE);
    unsigned* cnt = (unsigned*)(F.ctl + CW_CNT + layer * 64);
    const float* brg = a.in[I_BRG] + layer * 4; const float* bre = a.in[I_BRE] + layer * 32;
    const int NT = F.G * 512;
    for (int base = F.vcu * 512 + L_.wave * 64; base < T; base += NT) {
        const int t = base + L_.lane;
        bool valid = t < T; if (valid && layer == 1) valid = (t % TPB) >= CTX;
        int e0 = -1, e1 = -1; float w0 = 0.f, w1 = 0.f;
        if (valid) {
            const float* lg = LG + (size_t)t * 64;
            float g[4]; for (int i = 0; i < 4; ++i) { float v = brg[i]; for (int ks = 0; ks < RKS; ++ks) v += lg[(size_t)ks * T * 64 + i]; g[i] = v; }
            int gi = 0; float gm = g[0]; for (int i = 1; i < 4; ++i) if (g[i] > gm) { gm = g[i]; gi = i; }
            float den = 0.f; for (int i = 0; i < 4; ++i) den += expf(g[i] - gm);
            const float ptop = 1.0f / den;
            float el[8]; for (int i = 0; i < 8; ++i) { float v = bre[gi * 8 + i]; for (int ks = 0; ks < RKS; ++ks) v += lg[(size_t)ks * T * 64 + 4 + gi * 8 + i]; el[i] = v; }
            int i1 = 0; float l1 = el[0]; for (int i = 1; i < 8; ++i) if (el[i] > l1) { l1 = el[i]; i1 = i; }
            int i2 = -1; float l2 = -3.0e38f; for (int i = 0; i < 8; ++i) if (i != i1 && el[i] > l2) { l2 = el[i]; i2 = i; }
            const float ex = expf(l2 - l1), inv = 1.0f / (1.0f + ex);
            w0 = ptop * inv; w1 = ptop * ex * inv; e0 = gi * 8 + i1; e1 = gi * 8 + i2;
        }
        int pos0 = 0, pos1 = 0;
        const unsigned long long lt = (1ull << L_.lane) - 1ull;
        for (int e = 0; e < NE; ++e) {
            const unsigned long long m0 = __ballot(e0 == e), m1 = __ballot(e1 == e);
            const int n0 = __popcll(m0), n1 = __popcll(m1);
            if (n0 + n1 == 0) continue;
            unsigned basev = 0;
            if (L_.lane == 0) basev = __hip_atomic_fetch_add(cnt + e, (unsigned)(n0 + n1), RLX_AGENT);
            basev = (unsigned)__builtin_amdgcn_readfirstlane((int)basev);
            if (e0 == e) pos0 = (int)basev + __popcll(m0 & lt);
            if (e1 == e) pos1 = (int)basev + n0 + __popcll(m1 & lt);
        }
        if (valid) { int* rec = ROUTE + (size_t)t * 8; rec[0] = e0; rec[1] = e1; rec[2] = pos0; rec[3] = pos1; rec[4] = __builtin_bit_cast(int, w0); rec[5] = __builtin_bit_cast(int, w1); }
    }
}
typedef short bf16x8_t __attribute__((ext_vector_type(8)));
__device__ __forceinline__ void p_mod2_route(const Frame& F, const Args& a, int layer) {
    const LocalId L_ = local_id(); (void)L_;
    const int lane = L_.lane, wave = L_.wave;
    constexpr int FPITCH = 4112;
    LAS unsigned char* Fs = F.lds + RING_OFF; LAS float* P = (LAS float*)(F.lds + RING_OFF + 16 * FPITCH + 256);
    const float* MOD = (const float*)(F.ws + WS_MOD); const bf16* H = (const bf16*)(F.ws + WS_H); bf16* A1 = (bf16*)(F.ws + WS_A1);
    const bf16* WR = (const bf16*)(F.ws + WS_WR) + (size_t)layer * 256 * 2048;
    int* ROUTE = (int*)(F.ws + WS_ROUTE); unsigned* cnt = (unsigned*)(F.ctl + CW_CNT + layer * 64); int* postok = (int*)(F.ws + WS_POS) + (size_t)layer * NE * POSCAP;
    const float* brg = a.in[I_BRG] + layer * 4; const float* bre = a.in[I_BRE] + layer * 32;
    bf16x8_t bfr[3][8];
#pragma unroll
    for (int nb = 0; nb < 3; ++nb)
#pragma unroll
        for (int ks = 0; ks < 8; ++ks) bfr[nb][ks] = *(const bf16x8_t*)(WR + (size_t)(nb * 16 + (lane & 15)) * 2048 + wave * 256 + ks * 32 + (lane >> 4) * 8);
    const int NG = layer == 1 ? NB * SEQ / 16 : T / 16;
    int it = 0;
    for (int g = F.vcu; g < NG; g += F.G, ++it) {
        int row0; if (layer == 1) { const int b = g >> 7; row0 = b * TPB + CTX + (g & 127) * 16; } else row0 = g * 16;
        const int j = mod_index(row0);
        const float* m = MOD + (size_t)(layer * 9 + j) * 12288;
        f32x4 v0[8], v1[8];
        const int r0 = 2 * wave, r1 = r0 + 1;
        hrow_load(H + (size_t)(row0 + r0) * DM, lane, v0);
        hrow_load(H + (size_t)(row0 + r1) * DM, lane, v1);
#define M2R_ROW(V, R) do { float ss = 0.f; \
        _Pragma("unroll") for (int q = 0; q < 8; ++q) ss += (V[q].x * V[q].x + V[q].y * V[q].y) + (V[q].z * V[q].z + V[q].w * V[q].w); \
        ss = wave_sum(ss); const float rn = 1.0f / sqrtf(ss * (1.0f / 2048.0f) + NORM_EPS); \
        _Pragma("unroll") for (int q = 0; q < 8; ++q) { const f32x4 sh = ((const f32x4*)(m + 3 * 2048))[lane + 64 * q], sc = ((const f32x4*)(m + 4 * 2048))[lane + 64 * q]; \
            const f32x4 y = V[q] * rn * (sc + 1.0f) + sh; v2u o; o.x = pk2(y.x, y.y); o.y = pk2(y.z, y.w); \
            ((v2u*)(A1 + (size_t)(row0 + (R)) * DM))[lane + 64 * q] = o; *(LAS v2u*)(Fs + (R) * FPITCH + (lane + 64 * q) * 8) = o; } } while (0)
        M2R_ROW(v0, r0); M2R_ROW(v1, r1);
#undef M2R_ROW
        __syncthreads();
        f32x4 acc[3];
#pragma unroll
        for (int nb = 0; nb < 3; ++nb) acc[nb] = (f32x4){0.f, 0.f, 0.f, 0.f};
#pragma unroll
        for (int ks = 0; ks < 8; ++ks) { const bf16x8_t af = *(const LAS bf16x8_t*)(Fs + (lane & 15) * FPITCH + (wave * 256 + ks * 32 + (lane >> 4) * 8) * 2);
#pragma unroll
            for (int nb = 0; nb < 3; ++nb) acc[nb] = __builtin_amdgcn_mfma_f32_16x16x32_bf16(af, bfr[nb][ks], acc[nb], 0, 0, 0); }
        LAS float* Pb = P + (it & 1) * (8 * 16 * 48);
#pragma unroll
        for (int nb = 0; nb < 3; ++nb)
#pragma unroll
            for (int rg = 0; rg < 4; ++rg) Pb[(wave * 16 + 4 * (lane >> 4) + rg) * 48 + nb * 16 + (lane & 15)] = acc[nb][rg];
        __syncthreads();
        if (wave == 0) {
            const bool valid = lane < 16; const int t = row0 + (lane & 15);
            int e0 = -1, e1 = -1; float w0 = 0.f, w1 = 0.f;
            if (valid) {
                const LAS float* pr = Pb + lane * 48;
                float gg[4];
#pragma unroll
                for (int i = 0; i < 4; ++i) { float sacc = brg[i];
#pragma unroll
                    for (int w = 0; w < 8; ++w) sacc += pr[w * 768 + i];
                    gg[i] = sacc; }
                int gi = 0; float gm = gg[0];
#pragma unroll
                for (int i = 1; i < 4; ++i) if (gg[i] > gm) { gm = gg[i]; gi = i; }
                float den = 0.f;
#pragma unroll
                for (int i = 0; i < 4; ++i) den += expf(gg[i] - gm);
                const float ptop = 1.0f / den;
                float el[8];
#pragma unroll
                for (int i = 0; i < 8; ++i) { float sacc = bre[gi * 8 + i];
#pragma unroll
                    for (int w = 0; w < 8; ++w) sacc += pr[w * 768 + 4 + gi * 8 + i];
                    el[i] = sacc; }
                int i1 = 0; float l1 = el[0];
#pragma unroll
                for (int i = 1; i < 8; ++i) if (el[i] > l1) { l1 = el[i]; i1 = i; }
                int i2 = -1; float l2 = -3.0e38f;
#pragma unroll
                for (int i = 0; i < 8; ++i) if (i != i1 && el[i] > l2) { l2 = el[i]; i2 = i; }
                const float ex = expf(l2 - l1), inv = 1.0f / (1.0f + ex);
                w0 = ptop * inv; w1 = ptop * ex * inv; e0 = gi * 8 + i1; e1 = gi * 8 + i2;
            }
            int rank0 = 0, rank1 = 0, mycnt = 0;
            const unsigned long long lt = (1ull << lane) - 1ull;
            for (int e = 0; e < NE; ++e) {
                const unsigned long long m0 = __ballot(e0 == e), m1 = __ballot(e1 == e);
                const int n0 = __popcll(m0), n1 = __popcll(m1);
                if (lane == e) mycnt = n0 + n1;
                if (e0 == e) rank0 = __popcll(m0 & lt);
                if (e1 == e) rank1 = n0 + __popcll(m1 & lt);
            }
            int basev = 0;
            if (lane < NE && mycnt > 0) basev = (int)__hip_atomic_fetch_add(cnt + lane, (unsigned)mycnt, RLX_AGENT);
            const int pos0 = __shfl(basev, e0 & 31) + rank0, pos1 = __shfl(basev, e1 & 31) + rank1;
            if (valid) { int* rec = ROUTE + (size_t)t * 8; rec[0] = e0; rec[1] = e1; rec[2] = pos0; rec[3] = pos1; rec[4] = __builtin_bit_cast(int, w0); rec[5] = __builtin_bit_cast(int, w1);
                         postok[(size_t)e0 * POSCAP + pos0] = t; postok[(size_t)e1 * POSCAP + pos1] = t; }
        }
    }
    __syncthreads();
}
__device__ __forceinline__ void p_gather(const Frame& F, int layer) {
    const LocalId L_ = local_id(); (void)L_;
    LAS int* offs = (LAS int*)(F.lds + RING_OFF);
    if (L_.tid == 0) { int o = 0; for (int e = 0; e < NE; ++e) { offs[e] = o; const unsigned c = __hip_atomic_load((unsigned*)(F.ctl + CW_CNT + layer * 64 + e), RLX_AGENT); o += (int)((c + 255u) & ~255u); } offs[NE] = o; }
    __syncthreads();
    if (blockIdx.x == 0 && L_.tid < NE) { const int e = L_.tid; int* texp = (int*)(F.ctl + CW_TEXP + layer * 256);
        for (int r = offs[e] >> 8; r < (offs[e + 1] >> 8); ++r) texp[r] = e;
        if (e == 0) *(int*)(F.ctl + CW_NRT + layer * 64) = offs[NE] >> 8; }
    int* ROUTE = (int*)(F.ws + WS_ROUTE); int* slot_tok = (int*)(F.ctl + CW_SLOT + layer * MAXSLOT);
    for (int t = F.vcu * 512 + L_.tid; t < T; t += F.G * 512) {
        if (layer == 1 && (t % TPB) < CTX) continue;
        int* rec = ROUTE + (size_t)t * 8;
        const int s0 = offs[rec[0]] + rec[2], s1 = offs[rec[1]] + rec[3];
        slot_tok[s0] = t; slot_tok[s1] = t; rec[6] = s0; rec[7] = s1;
    }
    __syncthreads();
}

constexpr int SLD = 2304;
template <int DQ, int QR>
__device__ __forceinline__ void naive_scores_softmax(LAS float* S, LAS float* qf, const bf16* Q, int ldq, const bf16* K, int ldk, int lo, int nk, float scale,
                                                     bool window, int qpos0, bool has_sink, float sink, int tid, int lane, int wave) {
    for (int i = tid; i < QR * DQ; i += 512) { const int r = i / DQ, d = i - r * DQ; qf[i] = bf2f(Q[(size_t)r * ldq + d]); }
    __syncthreads();
    for (int t = tid; t < nk; t += 512) {
        const int kr = t < CTX ? t : CTX + lo + (t - CTX);
        const bf16* kp = K + (size_t)kr * ldk;
        float acc[QR];
#pragma unroll
        for (int r = 0; r < QR; ++r) acc[r] = 0.f;
        for (int d = 0; d < DQ; d += 8) {
            const v4u kv = *(const v4u*)(kp + d);
            const float k0 = bflo(kv.x), k1 = bfhi(kv.x), k2 = bflo(kv.y), k3 = bfhi(kv.y), k4 = bflo(kv.z), k5 = bfhi(kv.z), k6 = bflo(kv.w), k7 = bfhi(kv.w);
#pragma unroll
            for (int r = 0; r < QR; ++r) { const LAS float* qp = qf + r * DQ + d;
                acc[r] += (k0 * qp[0] + k1 * qp[1]) + (k2 * qp[2] + k3 * qp[3]) + (k4 * qp[4] + k5 * qp[5]) + (k6 * qp[6] + k7 * qp[7]); }
        }
#pragma unroll
        for (int r = 0; r < QR; ++r) { float s = acc[r] * scale;
            if (window && t >= CTX) { const int dd = (qpos0 + r) - (lo + t - CTX); if (dd > 128 || dd < -128) s = -1e30f; }
            S[r * SLD + t] = s; }
    }
    __syncthreads();
    if (wave < QR) {
        LAS float* row = S + wave * SLD;
        float m = -1e30f; for (int t = lane; t < nk; t += 64) m = fmaxf(m, row[t]);
        m = wave_max(m); if (has_sink) m = fmaxf(m, sink);
        float sum = 0.f; for (int t = lane; t < nk; t += 64) { const float e = expf(row[t] - m); row[t] = e; sum += e; }
        sum = wave_sum(sum); if (has_sink) sum += expf(sink - m);
        const float inv = 1.0f / sum;
        for (int t = lane; t < nk; t += 64) row[t] *= inv;
    }
    __syncthreads();
}
template <int QR>
__device__ __forceinline__ void naive_pv(const LAS float* S, const bf16* V, int ldv, int lo, int nk, int tid, float (&o)[QR / 4]) {
    const int c = tid & 127, rg = tid >> 7; constexpr int RPT = QR / 4;
#pragma unroll
    for (int i = 0; i < RPT; ++i) o[i] = 0.f;
#pragma unroll 4
    for (int t = 0; t < nk; ++t) { const int kr = t < CTX ? t : CTX + lo + (t - CTX); const float v = bf2f(V[(size_t)kr * ldv + c]);
#pragma unroll
        for (int i = 0; i < RPT; ++i) o[i] += S[(rg * RPT + i) * SLD + t] * v; }
}
__device__ __forceinline__ void p_even_attn_naive(const Frame& F) {
    const LocalId L_ = local_id(); (void)L_;
    LAS float* S = (LAS float*)(F.lds + RING_OFF); LAS float* qf = (LAS float*)(F.lds + RING_OFF + 8 * SLD * 4);
    const bf16* Y1 = (const bf16*)(F.ws + WS_Y1); const bf16* QB = (const bf16*)(F.ws + WS_QB); const bf16* KV = (const bf16*)(F.ws + WS_KV); const bf16* KB = (const bf16*)(F.ws + WS_KB);
    bf16* MIX = (bf16*)(F.ws + WS_MIX);
    constexpr int UPV = NB * 8 * 288;
    for (int u = blockIdx.x; u < 2 * UPV; u += F.G) {
        const int var = u / UPV, rem = u - var * UPV, b = rem / 2304, rem2 = rem - b * 2304, h = rem2 / 288, ch = rem2 - h * 288;
        const int r0 = ch * 8, row0 = b * TPB + r0; const int nk = r0 < CTX ? CTX : TPB;
        float o[2];
        if (var == 0) {
            naive_scores_softmax<128, 8>(S, qf, Y1 + (size_t)row0 * EVEN_IN_P + h * 128, EVEN_IN_P, Y1 + (size_t)(b * TPB) * EVEN_IN_P + 1024 + (h >> 2) * 128, EVEN_IN_P, 0, nk,
                                         0.08838834764831845f, false, 0, false, 0.f, L_.tid, L_.lane, L_.wave);
            naive_pv<8>(S, Y1 + (size_t)(b * TPB) * EVEN_IN_P + 1280 + (h >> 2) * 128, EVEN_IN_P, 0, nk, L_.tid, o);
        } else {
            naive_scores_softmax<192, 8>(S, qf, QB + (size_t)row0 * 1536 + h * 192, 1536, KB + (size_t)(b * TPB) * 1536 + h * 192, 1536, 0, nk,
                                         0.07216878364870322f, false, 0, false, 0.f, L_.tid, L_.lane, L_.wave);
            naive_pv<8>(S, KV + (size_t)(b * TPB) * 2048 + h * 256 + 128, 2048, 0, nk, L_.tid, o);
        }
        const int c = L_.tid & 127, rg = L_.tid >> 7;
#pragma unroll
        for (int i = 0; i < 2; ++i) MIX[(size_t)(row0 + rg * 2 + i) * DM + var * 1024 + h * 128 + c] = (bf16)f2bf(o[i]);
        __syncthreads();
    }
}
__device__ __forceinline__ void p_odd_attn_naive(const Frame& F, const Args& a) {
    const LocalId L_ = local_id(); (void)L_;
    LAS float* S = (LAS float*)(F.lds + RING_OFF); LAS float* qf = (LAS float*)(F.lds + RING_OFF + 8 * SLD * 4); LAS float* ob = qf + 8 * 192;
    const bf16* Y1 = (const bf16*)(F.ws + WS_Y1); bf16* MIX = (bf16*)(F.ws + WS_MIX);
    float d1 = 0.f, d2 = 0.f;
    for (int i = 0; i < 64; ++i) { d1 += a.in[I_LQ1][i] * a.in[I_LK1][i]; d2 += a.in[I_LQ2][i] * a.in[I_LK2][i]; }
    const float lam = expf(d1) - expf(d2) + LAMBDA_INIT;
    constexpr int UC = NB * 8 * 512, UD = NB * 8 * 256;
    for (int u = blockIdx.x; u < UC + UD; u += F.G) {
        const int c = L_.tid & 127, rg = L_.tid >> 7;
        if (u < UC) {
            const int b = u / 4096, rem = u - b * 4096, h = rem / 512, ch = rem - h * 512;
            const int r0 = CTX + ch * 4, row0 = b * TPB + r0; const int nk = TPB;
            const bf16* kb = Y1 + (size_t)(b * TPB) * ODD_IN;
            naive_scores_softmax<64, 4>(S, qf, Y1 + (size_t)row0 * ODD_IN + (2 * h) * 64, ODD_IN, kb + 1024 + (2 * h) * 64, ODD_IN, 0, nk, 0.125f, false, 0, false, 0.f, L_.tid, L_.lane, L_.wave);
            naive_scores_softmax<64, 4>(S + 4 * SLD, qf, Y1 + (size_t)row0 * ODD_IN + (2 * h + 1) * 64, ODD_IN, kb + 1024 + (2 * h + 1) * 64, ODD_IN, 0, nk, 0.125f, false, 0, false, 0.f, L_.tid, L_.lane, L_.wave);
            for (int i = L_.tid; i < 4 * SLD; i += 512) S[i] = S[i] - lam * S[4 * SLD + i];
            __syncthreads();
            float o[1];
            naive_pv<4>(S, kb + 2048 + h * 128, ODD_IN, 0, nk, L_.tid, o);
            ob[rg * 128 + c] = o[0];
            __syncthreads();
            float ss = 0.f; for (int i = 0; i < 128; ++i) { const float v = ob[rg * 128 + i]; ss += v * v; }
            const float r = 1.0f / sqrtf(ss * (1.0f / 128.0f) + NORM_EPS);
            MIX[(size_t)(row0 + rg) * DM + h * 128 + c] = (bf16)f2bf(o[0] * r * a.in[I_SUBLN][c] * (1.0f - LAMBDA_INIT));
        } else {
            const int v = u - UC, b = v / 2048, rem = v - b * 2048, h = rem / 256, ch = rem - h * 256;
            const int s0 = ch * 8, row0 = b * TPB + CTX + s0;
            const int lo = s0 - 128 < 0 ? 0 : s0 - 128, hi = s0 + 7 + 128 > SEQ - 1 ? SEQ - 1 : s0 + 7 + 128; const int nk = CTX + (hi - lo + 1);
            const bf16* kb = Y1 + (size_t)(b * TPB) * ODD_IN;
            naive_scores_softmax<128, 8>(S, qf, Y1 + (size_t)row0 * ODD_IN + 3072 + h * 128, ODD_IN, kb + 4096 + (h >> 2) * 128, ODD_IN, lo, nk, 0.08838834764831845f, true, s0, true, a.in[I_SINK][h], L_.tid, L_.lane, L_.wave);
            float o[2];
            naive_pv<8>(S, kb + 4352 + (h >> 2) * 128, ODD_IN, lo, nk, L_.tid, o);
#pragma unroll
            for (int i = 0; i < 2; ++i) MIX[(size_t)(row0 + rg * 2 + i) * DM + 1024 + h * 128 + c] = (bf16)f2bf(o[i]);
        }
        __syncthreads();
    }
}

namespace att {
using bf16x8 = __attribute__((ext_vector_type(8))) short;
using s16x4  = __attribute__((ext_vector_type(4))) short;
using f32x16 = __attribute__((ext_vector_type(16))) float;
using u32x4  = __attribute__((ext_vector_type(4))) unsigned;
constexpr int KVBLK = 64, QBLK = 32;
constexpr int SHM_V = KVBLK * 128 * 2;
constexpr int K_OFF = 2 * SHM_V, K_MAX = KVBLK * 192 * 2, QL_OFF = K_OFF + 2 * K_MAX, WS_OFF = 131072 + 2048;
constexpr float THR = 8.f;
#define ATT_KSWZ(row, colB, RB) ((row) * (RB) + ((colB) ^ (((row) & 7) << 4)))
#define ATT_SBAR() __builtin_amdgcn_sched_barrier(0)
__device__ __forceinline__ int crow(int r, int hi) { return (r & 3) + 8 * (r >> 2) + 4 * hi; }
__device__ __forceinline__ unsigned cvtpk(float lo, float hi) { unsigned r; asm volatile("v_cvt_pk_bf16_f32 %0, %1, %2" : "=v"(r) : "v"(lo), "v"(hi)); return r; }

__device__ __forceinline__ void partialSM(f32x16& p0, f32x16& p1, float& m_reg, float& mn, float& alpha, float C, float thr_raw) {
  float pmax = p0[0];
#pragma unroll
  for (int r = 1; r < 16; ++r) pmax = fmaxf(pmax, p0[r]);
#pragma unroll
  for (int r = 0; r < 16; ++r) pmax = fmaxf(pmax, p1[r]);
  { auto rr = __builtin_amdgcn_permlane32_swap(__float_as_uint(pmax), __float_as_uint(pmax), false, false);
    pmax = fmaxf(__uint_as_float(rr[0]), __uint_as_float(rr[1])); }
  if (__builtin_expect(__all(pmax - m_reg <= thr_raw), 1)) { mn = m_reg; alpha = 1.f; }
  else { mn = fmaxf(m_reg, pmax); alpha = __builtin_amdgcn_exp2f((m_reg - mn) * C); m_reg = mn; }
  const float mnC = -mn * C;
#pragma unroll
  for (int r = 0; r < 16; ++r) p0[r] = fmaf(p0[r], C, mnC);
#pragma unroll
  for (int r = 0; r < 16; ++r) p1[r] = fmaf(p1[r], C, mnC);
#pragma unroll
  for (int r = 0; r < 16; ++r) p0[r] = __builtin_amdgcn_exp2f(p0[r]);
}
__device__ __forceinline__ void finishSM(f32x16& p0, f32x16& p1, float alpha, float& l_reg, bf16x8& pa0, bf16x8& pa1, bf16x8& pa2, bf16x8& pa3) {
#pragma unroll
  for (int r = 0; r < 16; ++r) p1[r] = __builtin_amdgcn_exp2f(p1[r]);
  float ps = 0;
#pragma unroll
  for (int r = 0; r < 16; ++r) ps += p0[r];
#pragma unroll
  for (int r = 0; r < 16; ++r) ps += p1[r];
  { auto rr = __builtin_amdgcn_permlane32_swap(__float_as_uint(ps), __float_as_uint(ps), false, false);
    ps = __uint_as_float(rr[0]) + __uint_as_float(rr[1]); }
  l_reg = l_reg * alpha + ps;
#define ATT_PK4(P, BASE, OUT) do { unsigned a0 = cvtpk(P[BASE + 0], P[BASE + 1]), a1 = cvtpk(P[BASE + 2], P[BASE + 3]);   \
    unsigned b0 = cvtpk(P[BASE + 4], P[BASE + 5]), b1 = cvtpk(P[BASE + 6], P[BASE + 7]);                              \
    auto r0 = __builtin_amdgcn_permlane32_swap(a0, b0, false, false); auto r1 = __builtin_amdgcn_permlane32_swap(a1, b1, false, false); \
    u32x4 w = {r0[0], r1[0], r0[1], r1[1]}; OUT = *reinterpret_cast<bf16x8*>(&w); } while (0)
  ATT_PK4(p0, 0, pa0); ATT_PK4(p0, 8, pa1); ATT_PK4(p1, 0, pa2); ATT_PK4(p1, 8, pa3);
#undef ATT_PK4
}
template <int DQ, int NQT, int NQR, int QSB>
__device__ __forceinline__ void qkt(f32x16& p0, f32x16& p1, const char* Ks, const bf16x8 (&qr)[NQR], const char* qlds, const int (&kb)[4]) {
  p0 = f32x16{}; p1 = f32x16{};
#pragma unroll
  for (int d0 = 0; d0 < NQT; ++d0) {
    const bf16x8 b0 = *reinterpret_cast<const bf16x8*>(Ks + kb[d0 & 3] + (d0 >> 2) * 128);
    const bf16x8 b1 = *reinterpret_cast<const bf16x8*>(Ks + kb[d0 & 3] + (d0 >> 2) * 128 + 32 * DQ * 2);
    bf16x8 q; if (d0 < NQR) q = qr[d0 < NQR ? d0 : 0]; else q = *reinterpret_cast<const bf16x8*>(qlds + (d0 - NQR) * 1024);
    p0 = __builtin_amdgcn_mfma_f32_32x32x16_bf16(b0, q, p0, 0, 0, 0);
    p1 = __builtin_amdgcn_mfma_f32_32x32x16_bf16(b1, q, p1, 0, 0, 0);
    if (QSB > 0 && (d0 % (QSB > 0 ? QSB : 1)) == (QSB - 1) && d0 + 1 < NQT) ATT_SBAR(); }
}
__device__ __forceinline__ void mask_tile(f32x16& p0, f32x16& p1, int kp0, int qpos, int hi) {
#pragma unroll
  for (int r = 0; r < 16; ++r) { const int d = qpos - (kp0 + crow(r, hi));
    if (d > 128 || d < -128) p0[r] = -1e30f;
    if (d - 32 > 128 || d - 32 < -128) p1[r] = -1e30f; }
}
__device__ __forceinline__ int v_st(int k, int c) { const int kk = (k & ~0xC) | ((k & 4) << 1) | ((k & 8) >> 1); return ((kk >> 3) * 4 + (c >> 5)) * 512 + ((kk & 7) * 32 + (c & 31)) * 2; }
__device__ __forceinline__ int v_rd_base(int lane) { return ((lane & 3) << 3) | (((lane >> 2) & 3) << 6) | (((lane >> 4) & 1) << 5) | (((lane >> 5) & 1) << 8); }
constexpr int v_rd_off(int d0, int ks, int half) { return d0 * 512 + ks * 4096 + half * 2048; }
template <int OFF> __device__ __forceinline__ s16x4 tr_read(int vb) {
  s16x4 r; asm volatile("ds_read_b64_tr_b16 %0, %1 offset:%2" : "=&v"(r) : "v"(vb), "i"(OFF) : "memory"); return r;
}
template <int D0> __device__ __forceinline__ void pv_one(f32x16& od, int vb, bf16x8 pa0, bf16x8 pa1, bf16x8 pa2, bf16x8 pa3) {
  const s16x4 l0 = tr_read<v_rd_off(D0, 0, 0)>(vb), h0 = tr_read<v_rd_off(D0, 0, 1)>(vb), l1 = tr_read<v_rd_off(D0, 1, 0)>(vb), h1 = tr_read<v_rd_off(D0, 1, 1)>(vb);
  const s16x4 l2 = tr_read<v_rd_off(D0, 2, 0)>(vb), h2 = tr_read<v_rd_off(D0, 2, 1)>(vb), l3 = tr_read<v_rd_off(D0, 3, 0)>(vb), h3 = tr_read<v_rd_off(D0, 3, 1)>(vb);
  asm volatile("s_waitcnt lgkmcnt(0)" ::: "memory"); ATT_SBAR();
#define ATT_PK(L, H) (bf16x8){L[0], L[1], L[2], L[3], H[0], H[1], H[2], H[3]}
  od = __builtin_amdgcn_mfma_f32_32x32x16_bf16(pa0, ATT_PK(l0, h0), od, 0, 0, 0);
  od = __builtin_amdgcn_mfma_f32_32x32x16_bf16(pa1, ATT_PK(l1, h1), od, 0, 0, 0);
  od = __builtin_amdgcn_mfma_f32_32x32x16_bf16(pa2, ATT_PK(l2, h2), od, 0, 0, 0);
  od = __builtin_amdgcn_mfma_f32_32x32x16_bf16(pa3, ATT_PK(l3, h3), od, 0, 0, 0);
#undef ATT_PK
}
__device__ __forceinline__ void pv_d0(f32x16* o, int vb, bf16x8 pa0, bf16x8 pa1, bf16x8 pa2, bf16x8 pa3) {
  pv_one<0>(o[0], vb, pa0, pa1, pa2, pa3); pv_one<1>(o[1], vb, pa0, pa1, pa2, pa3); pv_one<2>(o[2], vb, pa0, pa1, pa2, pa3); pv_one<3>(o[3], vb, pa0, pa1, pa2, pa3);
}

template <int DQ, bool WINDOW, bool SINK, int LDQ, int LDK, int LDV, int SD, int QSB, int NQRMAX, bool DIFF = false>
__device__ __forceinline__ void attn_unit(const bf16* __restrict__ Qb, const bf16* __restrict__ Kb, const bf16* __restrict__ Vb,
                                          bf16* __restrict__ Ob, int ntiles, int band_lo, int qpos0, float scale, float sink, char* lds, const float* gainp = nullptr) {
  constexpr int NQ = (DIFF ? DQ / 2 : DQ) / 16, NQR = NQ > NQRMAX ? NQRMAX : NQ, NCH = DQ / 64, RB = DQ * 2, SHM_K = KVBLK * DQ * 2, LDO = 2048;
  int tid = threadIdx.x; asm volatile("" : "+v"(tid));
  const int wid = tid >> 6, lane = tid & 63, r32 = lane & 31, hi = lane >> 5;
  const int comp = DIFF ? (wid >> 2) : 0, wrow = DIFF ? (wid & 3) : wid, kcomp = comp * 128;
  char* V_lds = lds; char* K_lds = lds + K_OFF;
  float* ws = (float*)(lds + WS_OFF) + wid * 64; float* li_l = ws; float* al_l = ws + 32;
  const float C = scale * 1.4426950408889634f, thr_raw = THR / scale;
  float m_reg = -1e30f, l_reg = 0; f32x16 o[4] = {}; bf16x8 qr[NQR];
  const unsigned qoff = (unsigned)((wrow * QBLK + r32) * LDQ + hi * 8 + comp * 64) * 2u;
#pragma unroll
  for (int d0 = 0; d0 < NQR; ++d0) qr[d0] = *reinterpret_cast<const bf16x8*>((const char*)Qb + qoff + d0 * 32);
  char* qlds = lds + QL_OFF + wid * ((NQ - NQR) * 1024) + lane * 16;
  __syncthreads();
  if constexpr (NQ > NQR) {
#pragma unroll
    for (int d0 = NQR; d0 < NQ; ++d0) *reinterpret_cast<bf16x8*>(qlds + (d0 - NQR) * 1024) = *reinterpret_cast<const bf16x8*>((const char*)Qb + qoff + d0 * 32);
  }
  const int sr = tid >> 4, sc = (tid & 15) * 8, vst0 = v_st(sr, sc);
  const unsigned voV = (unsigned)(sr * LDV + sc) * 2u;
  const int kr_ = tid >> 3, kc_ = (tid & 7) * 8;
  const unsigned voK = (unsigned)(kr_ * LDK + kc_) * 2u; const int kwr = ATT_KSWZ(kr_, kc_ * 2, RB);
  const int vb0 = (int)(uintptr_t)V_lds + v_rd_base(lane);
  int kb[4];
#pragma unroll
  for (int k = 0; k < 4; ++k) kb[k] = r32 * RB + ((k ^ ((r32 & 7) >> 1)) * 32) + ((hi ^ (r32 & 1)) * 16);
  const int qpos = qpos0 + wrow * QBLK + r32;
  struct { bf16x8 vs0, vs1, ks[NCH]; } sr_[SD];
#define ATT_KROW(j) (WINDOW ? ((j) < 4 ? (j) * KVBLK : 256 + band_lo + ((j) - 4) * KVBLK) : (j) * KVBLK)
#define ATT_SLOAD(i, j) do { const int k0_ = ATT_KROW(j); const char* vt_ = (const char*)Vb + (size_t)k0_ * (LDV * 2); const char* kt_ = (const char*)Kb + (size_t)k0_ * (LDK * 2); \
    sr_[i].vs0 = *reinterpret_cast<const bf16x8*>(vt_ + voV); sr_[i].vs1 = *reinterpret_cast<const bf16x8*>(vt_ + voV + 32 * LDV * 2); \
    _Pragma("unroll") for (int c_ = 0; c_ < NCH; ++c_) sr_[i].ks[c_] = *reinterpret_cast<const bf16x8*>(kt_ + voK + c_ * 128); } while (0)
#define ATT_SWRITE(b, i) do { *(bf16x8*)(V_lds + (b) * SHM_V + vst0) = sr_[i].vs0; *(bf16x8*)(V_lds + (b) * SHM_V + vst0 + 8192) = sr_[i].vs1; \
    _Pragma("unroll") for (int c_ = 0; c_ < NCH; ++c_) *(bf16x8*)(K_lds + (b) * SHM_K + kwr + c_ * 128) = sr_[i].ks[c_]; } while (0)
#define ATT_SWAIT() do { if constexpr (SD == 1) asm volatile("s_waitcnt vmcnt(0)" ::: "memory"); else if constexpr (NCH == 1) asm volatile("s_waitcnt vmcnt(3)" ::: "memory"); else if constexpr (NCH == 2) asm volatile("s_waitcnt vmcnt(4)" ::: "memory"); else asm volatile("s_waitcnt vmcnt(5)" ::: "memory"); } while (0)
#define ATT_RESC(a) do { if (__any((a) < 1.f)) { if (hi == 0) al_l[r32] = (a); asm volatile("s_waitcnt lgkmcnt(0)" ::: "memory"); \
    _Pragma("unroll") for (int d = 0; d < 4; ++d) _Pragma("unroll") for (int r = 0; r < 16; ++r) o[d][r] *= al_l[crow(r, hi)]; } } while (0)
#define ATT_MASK(P0, P1, j) do { if constexpr (WINDOW) { if ((j) >= 4) mask_tile(P0, P1, band_lo + ((j) - 4) * KVBLK, qpos, hi); } } while (0)
  f32x16 pA0, pA1, pB0, pB1; float mnA, mnB, alA, alB; bf16x8 pa0, pa1, pa2, pa3; const int NT = ntiles;
  constexpr int SE = 0, SO = SD - 1;
  ATT_SLOAD(SE, 0); asm volatile("s_waitcnt vmcnt(0)" ::: "memory"); ATT_SWRITE(0, SE); __syncthreads();
  qkt<DQ, NQ, NQR, QSB>(pA0, pA1, K_lds + kcomp, qr, qlds, kb); ATT_MASK(pA0, pA1, 0); partialSM(pA0, pA1, m_reg, mnA, alA, C, thr_raw);
  ATT_SLOAD(SO, 1); if constexpr (SD == 2) { if (2 < NT) ATT_SLOAD(SE, 2); }
  ATT_SWAIT(); ATT_SWRITE(1, SO); __syncthreads();
  for (int j = 1; j + 1 < NT; j += 2) {
    ATT_SBAR(); qkt<DQ, NQ, NQR, QSB>(pB0, pB1, K_lds + SHM_K + kcomp, qr, qlds, kb);
    finishSM(pA0, pA1, alA, l_reg, pa0, pa1, pa2, pa3); ATT_SBAR();
    ATT_SLOAD(SO, j + SD); ATT_SBAR();
    pv_d0(o, vb0, pa0, pa1, pa2, pa3); ATT_MASK(pB0, pB1, j); partialSM(pB0, pB1, m_reg, mnB, alB, C, thr_raw);
    __syncthreads(); ATT_SWAIT(); ATT_SWRITE(0, SE);
    ATT_RESC(alB); __syncthreads();
    ATT_SBAR(); qkt<DQ, NQ, NQR, QSB>(pA0, pA1, K_lds + kcomp, qr, qlds, kb);
    finishSM(pB0, pB1, alB, l_reg, pa0, pa1, pa2, pa3); ATT_SBAR();
    if (SD == 1 || j + 3 < NT) ATT_SLOAD(SE, j + 1 + SD); ATT_SBAR();
    pv_d0(o, vb0 + SHM_V, pa0, pa1, pa2, pa3); ATT_MASK(pA0, pA1, j + 1); partialSM(pA0, pA1, m_reg, mnA, alA, C, thr_raw);
    __syncthreads(); ATT_SWAIT(); ATT_SWRITE(1, SO);
    ATT_RESC(alA); __syncthreads();
  }
  ATT_SBAR(); qkt<DQ, NQ, NQR, QSB>(pB0, pB1, K_lds + SHM_K + kcomp, qr, qlds, kb);
  finishSM(pA0, pA1, alA, l_reg, pa0, pa1, pa2, pa3); ATT_SBAR();
  pv_d0(o, vb0, pa0, pa1, pa2, pa3); ATT_MASK(pB0, pB1, NT - 1); partialSM(pB0, pB1, m_reg, mnB, alB, C, thr_raw);
  __syncthreads(); ATT_RESC(alB);
  finishSM(pB0, pB1, alB, l_reg, pa0, pa1, pa2, pa3); ATT_SBAR();
  pv_d0(o, vb0 + SHM_V, pa0, pa1, pa2, pa3);
  if constexpr (SINK) l_reg += __builtin_amdgcn_exp2f(sink * 1.4426950408889634f - m_reg * C);
  if (hi == 0) li_l[r32] = l_reg; asm volatile("s_waitcnt lgkmcnt(0)" ::: "memory");
  float rli[16];
#pragma unroll
  for (int r = 0; r < 16; ++r) rli[r] = __builtin_amdgcn_rcpf(li_l[crow(r, hi)]);
  int tid2 = threadIdx.x; asm volatile("" : "+v"(tid2));
  if constexpr (!DIFF) {
    const unsigned ooff = (unsigned)(((tid2 >> 6) * QBLK + 4 * ((tid2 >> 5) & 1)) * LDO + (tid2 & 31)) * 2u;
#pragma unroll
    for (int r = 0; r < 16; ++r) { const int orow = (r & 3) + 8 * (r >> 2);
#pragma unroll
      for (int d0 = 0; d0 < 4; ++d0) *reinterpret_cast<bf16*>((char*)Ob + ooff + (orow * LDO + d0 * 32) * 2) = (bf16)f2bf(o[d0][r] * rli[r]); }
  } else {
    float* X = (float*)lds + ((tid2 >> 6) & 3) * 4096 + (tid2 & 63);
    __syncthreads();
    if (tid2 >= 256) {
#pragma unroll
      for (int d0 = 0; d0 < 4; ++d0)
#pragma unroll
        for (int r = 0; r < 16; ++r) X[(d0 * 16 + r) * 64] = sink * (o[d0][r] * rli[r]);
    }
    __syncthreads();
    if (tid2 < 256) {
      float g[4];
#pragma unroll
      for (int d0 = 0; d0 < 4; ++d0) g[d0] = gainp[d0 * 32 + (tid2 & 31)];
      const unsigned ooff = (unsigned)(((tid2 >> 6) * QBLK + 4 * ((tid2 >> 5) & 1)) * LDO + (tid2 & 31)) * 2u;
#pragma unroll
      for (int r = 0; r < 16; ++r) { const int orow = (r & 3) + 8 * (r >> 2);
        float d[4], ss = 0.f;
#pragma unroll
        for (int d0 = 0; d0 < 4; ++d0) { d[d0] = o[d0][r] * rli[r] - X[(d0 * 16 + r) * 64]; ss += d[d0] * d[d0]; }
        ss += __shfl_xor(ss, 1); ss += __shfl_xor(ss, 2); ss += __shfl_xor(ss, 4); ss += __shfl_xor(ss, 8); ss += __shfl_xor(ss, 16);
        const float rs = __builtin_amdgcn_rsqf(ss * (1.0f / 128.0f) + 1e-6f);
#pragma unroll
        for (int d0 = 0; d0 < 4; ++d0) *reinterpret_cast<bf16*>((char*)Ob + ooff + (orow * LDO + d0 * 32) * 2) = (bf16)f2bf(d[d0] * rs * g[d0]); }
    }
  }
#undef ATT_KROW
#undef ATT_SLOAD
#undef ATT_SWRITE
#undef ATT_SWAIT
#undef ATT_RESC
#undef ATT_MASK
}
}

__device__ __forceinline__ void p_even_attn(const Frame& F, char* lds) {
    const LocalId L_ = local_id(); (void)L_;
    const bf16* Y1 = (const bf16*)(F.ws + WS_Y1); const bf16* QB = (const bf16*)(F.ws + WS_QB); const bf16* KV = (const bf16*)(F.ws + WS_KV); const bf16* KB = (const bf16*)(F.ws + WS_KB);
    bf16* MIX = (bf16*)(F.ws + WS_MIX);
    for (int n = blockIdx.x; n < 512 + 64; n += F.G) {
        int b, h, row0, nt;
        if (n < 512) { const int i = n >> 8, c = n & 255, x = c & 7, lc = c >> 3, gi = i * 8 + x; b = gi >> 1; h = (gi & 1) * 4 + (lc >> 3); row0 = b * TPB + CTX + (lc & 7) * 256; nt = 36; }
        else { const int m = n - 512; b = m >> 3; h = m & 7; row0 = b * TPB; nt = 4; }
        const size_t kb = (size_t)b * TPB;
        att::attn_unit<128, false, false, EVEN_IN_P, EVEN_IN_P, EVEN_IN_P, 2, 4, 8>(Y1 + (size_t)row0 * EVEN_IN_P + h * 128, Y1 + kb * EVEN_IN_P + 1024 + (h >> 2) * 128, Y1 + kb * EVEN_IN_P + 1280 + (h >> 2) * 128,
                                                                                 MIX + (size_t)row0 * DM + h * 128, nt, 0, 0, 0.08838834764831845f, 0.f, lds);
    }
    for (int n = blockIdx.x; n < 512 + 64; n += F.G) {
        int b, h, row0, nt;
        if (n < 512) { const int i = n >> 8, c = n & 255, x = c & 7, lc = c >> 3, gi = i * 8 + x; b = gi >> 1; h = (gi & 1) * 4 + (lc >> 3); row0 = b * TPB + CTX + (lc & 7) * 256; nt = 36; }
        else { const int m = n - 512; b = m >> 3; h = m & 7; row0 = b * TPB; nt = 4; }
        const size_t kb = (size_t)b * TPB;
        att::attn_unit<192, false, false, 1536, 1536, 2048, 1, 4, 8>(QB + (size_t)row0 * 1536 + h * 192, KB + kb * 1536 + h * 192, KV + kb * 2048 + h * 256 + 128,
                                                                  MIX + (size_t)row0 * DM + 1024 + h * 128, nt, 0, 0, 0.07216878364870322f, 0.f, lds);
    }
    __syncthreads();
}
__device__ __forceinline__ void p_odd_attn(const Frame& F, const Args& a, char* lds) {
    const LocalId L_ = local_id(); (void)L_;
    const bf16* Y1 = (const bf16*)(F.ws + WS_Y1); bf16* O12 = (bf16*)(F.ws + WS_A1); bf16* MIX = (bf16*)(F.ws + WS_MIX);
#if ATT_DIFF_FUSED
    float d1 = 0.f, d2 = 0.f;
    for (int i = 0; i < 64; ++i) { d1 += a.in[I_LQ1][i] * a.in[I_LK1][i]; d2 += a.in[I_LQ2][i] * a.in[I_LK2][i]; }
    const float lam = expf(d1) - expf(d2) + LAMBDA_INIT;
    const float* gsub = (const float*)(F.ws + WS_ROPE + 32768);
    for (int n = blockIdx.x; n < 1024; n += F.G) {
        const int i = n >> 8, c = n & 255, x = c & 7, lc = c >> 3, gi = i * 8 + x, b = gi >> 2, h = (gi & 3) * 2 + (lc >> 4), row0 = b * TPB + CTX + (lc & 15) * 128;
        const size_t kb = (size_t)b * TPB * ODD_IN;
        att::attn_unit<128, false, false, ODD_IN, ODD_IN, ODD_IN, 2, 0, 8, true>(Y1 + (size_t)row0 * ODD_IN + h * 128, Y1 + kb + 1024 + h * 128, Y1 + kb + 2048 + h * 128,
                                                                             MIX + (size_t)row0 * DM + h * 128, 36, 0, 0, 0.125f, lam, lds, gsub);
    }
#else
    for (int n = blockIdx.x; n < 1024; n += F.G) {
        const int i = n >> 8, c = n & 255, x = c & 7, lc = c >> 3, gi = i * 8 + x, b = gi >> 2, ch = (gi & 3) * 4 + (lc >> 3), row0 = b * TPB + CTX + (lc & 7) * 256;
        const size_t kb = (size_t)b * TPB * ODD_IN;
        att::attn_unit<64, false, false, ODD_IN, ODD_IN, ODD_IN, 2, 0, 8>(Y1 + (size_t)row0 * ODD_IN + ch * 64, Y1 + kb + 1024 + ch * 64, Y1 + kb + 2048 + (ch >> 1) * 128,
                                                                       O12 + (size_t)row0 * DM + ch * 128, 36, 0, 0, 0.125f, 0.f, lds);
    }
#endif
    for (int m = blockIdx.x; m < 512; m += F.G) {
        const int i = m >> 8, c = m & 255, x = c & 7, lc = c >> 3, gi = i * 8 + x, b = gi >> 1, kvh = gi & 1, h = kvh * 4 + (lc >> 3), s0 = (lc & 7) * 256, row0 = b * TPB + CTX + s0;
        const int lo = s0 - 128 < 0 ? 0 : s0 - 128, hie = s0 + 384 > SEQ ? SEQ : s0 + 384;
        const size_t kb = (size_t)b * TPB * ODD_IN;
        att::attn_unit<128, true, true, ODD_IN, ODD_IN, ODD_IN, 1, 4, 8>(Y1 + (size_t)row0 * ODD_IN + 3072 + h * 128, Y1 + kb + 4096 + kvh * 128, Y1 + kb + 4352 + kvh * 128,
                                                                      MIX + (size_t)row0 * DM + 1024 + h * 128, 4 + (hie - lo) / 64, lo, s0, 0.08838834764831845f, a.in[I_SINK][h], lds);
    }
    __syncthreads();
}
__device__ __forceinline__ void p_odd_combine(const Frame& F, const Args& a) {
    const LocalId L_ = local_id(); (void)L_;
    const int gw = F.vcu * NWAVES + L_.wave, NGW = F.G * NWAVES;
    const bf16* O12 = (const bf16*)(F.ws + WS_A1); bf16* MIX = (bf16*)(F.ws + WS_MIX);
    float d1 = 0.f, d2 = 0.f;
    for (int i = 0; i < 64; ++i) { d1 += a.in[I_LQ1][i] * a.in[I_LK1][i]; d2 += a.in[I_LQ2][i] * a.in[I_LK2][i]; }
    const float lam = expf(d1) - expf(d2) + LAMBDA_INIT;
    const float g0 = a.in[I_SUBLN][L_.lane] * (1.0f - LAMBDA_INIT), g1 = a.in[I_SUBLN][L_.lane + 64] * (1.0f - LAMBDA_INIT);
    for (int i = gw; i < NB * SEQ; i += NGW) {
        const int b = i / SEQ, row = b * TPB + CTX + (i - b * SEQ);
        const bf16* src = O12 + (size_t)row * DM; bf16* dst = MIX + (size_t)row * DM;
        for (int h = 0; h < 8; ++h) {
            const float x0 = bf2f(src[2 * h * 128 + L_.lane]) - lam * bf2f(src[(2 * h + 1) * 128 + L_.lane]);
            const float x1 = bf2f(src[2 * h * 128 + 64 + L_.lane]) - lam * bf2f(src[(2 * h + 1) * 128 + 64 + L_.lane]);
            const float ss = wave_sum(x0 * x0 + x1 * x1);
            const float r = 1.0f / sqrtf(ss * (1.0f / 128.0f) + NORM_EPS);
            dst[h * 128 + L_.lane] = (bf16)f2bf(x0 * r * g0); dst[h * 128 + 64 + L_.lane] = (bf16)f2bf(x1 * r * g1);
        }
    }
}

__global__ void __launch_bounds__(NWAVES * 64, 2) trunk_fwd(Args args) {
    extern __shared__ __attribute__((aligned(16))) unsigned char lds[];
    Frame F;
    F.lds = (LAS unsigned char*)lds;
    F.MISC = (volatile LAS unsigned*)(F.lds + MISC_OFF);
    F.tid = threadIdx.x; F.lane = F.tid & 63; F.wave = __builtin_amdgcn_readfirstlane(F.tid >> 6);
    F.G = gridDim.x; { const int bx = blockIdx.x; F.vcu = (F.G % 8 == 0) ? (bx % 8) * (F.G / 8) + bx / 8 : bx; }
    F.ws = args.ws; F.ctl = (gu32*)(args.ws + WS_CTL);
    for (int u = F.tid; u < (LDS_BYTES - LDSCTL_OFF) / 4; u += NWAVES * 64) ((LAS unsigned*)(F.lds + LDSCTL_OFF))[u] = 0u;
    __syncthreads();
    XcdBarrier bar; bar.bar = (unsigned*)(F.ctl + CW_BAR); bar.x = 0; bar.st = nullptr;
#if !MK_PER_PHASE
    bar = xcd_barrier_post((unsigned*)(F.ctl + CW_BAR), F.MISC + 8);
#endif
    const int lo = args.ph_lo, hi = args.ph_hi;
#define IN(k) (lo <= (k) && (k) < hi)
#if MK_PER_PHASE
#define SEAM(k) do { } while (0)
#else
#define SEAM(k) do { if (IN(k) && IN((k) + 1)) xcd_barrier(bar); } while (0)
#endif
    bf16* const A1 = (bf16*)(F.ws + WS_A1); bf16* const MIX = (bf16*)(F.ws + WS_MIX); bf16* const H = (bf16*)(F.ws + WS_H); const float* const MOD = (const float*)(F.ws + WS_MOD);
    PG8_LAS unsigned char* const ring = (PG8_LAS unsigned char*)(F.lds + RING_OFF);

#ifndef DUP_PHASE
#define DUP_PHASE (-1)
#endif
#ifndef PROBE_PHASE
#define PROBE_PHASE (-1)
#endif
constexpr size_t WS_DUMMY = 1600 * MiB;
#define PROBE(k, ...) do { if (PROBE_PHASE == (k) && IN(k)) { for (int r_ = 0; r_ < 3; ++r_) { __VA_ARGS__ xcd_barrier(bar); } } } while (0)
#define PH(k, ...) do { if (IN(k)) { __VA_ARGS__ if (DUP_PHASE == (k)) { for (int r_ = 0; r_ < 3; ++r_) { xcd_barrier(bar); __VA_ARGS__ } } } SEAM(k); } while (0)
#define GEMM_STATIC(EPI, Aptr, Bptr, N_, K_, ...) do { pg8::Gemm g{(const bf16*)(Aptr), (const bf16*)(Bptr), (K_), (K_), (K_), nullptr}; pg8::StaticOrder S; S.init(T, (N_), F.G, (int)blockIdx.x); \
        pg8::EPI E{__VA_ARGS__}; pg8::gemm_phase<pg8::EPI, pg8::StaticOrder, false>(ring, g, S, E); } while (0)
#ifndef MOE_F32B
#define MOE_F32B 0
#endif
#define GEMM_MOE_F(EPI, GATH, Aptr, M0, M1, ESTR, LDN, COLMUL, HOFF, K_, layer, ...) do { const int nrt = __builtin_amdgcn_readfirstlane(*(const int*)(F.ctl + CW_NRT + (layer) * 64)); \
        pg8::Gemm g{(const bf16*)(Aptr), nullptr, (K_), 0, (K_), (const int*)(F.ctl + CW_SLOT + (layer) * MAXSLOT)}; pg8::BSrc bs{(M0), (M1), (size_t)(ESTR), (LDN), (COLMUL), (HOFF)}; \
        pg8::MoeOrder S; S.init((const int*)(F.ctl + CW_TEXP + (layer) * 256), nrt, F.G, (int)blockIdx.x); \
        pg8::EPI E{__VA_ARGS__}; pg8::gemm_phase_f32b<pg8::EPI, pg8::MoeOrder, GATH>(ring, g, bs, S, E); } while (0)
#define GEMM_ORDER(EPI, ORDER, INIT, Aptr, Bptr, K_, ...) do { pg8::Gemm g{(const bf16*)(Aptr), (const bf16*)(Bptr), (K_), (K_), (K_), nullptr}; pg8::ORDER S; S.init INIT; \
        pg8::EPI E{__VA_ARGS__}; pg8::gemm_phase<pg8::EPI, pg8::ORDER, false>(ring, g, S, E); } while (0)
#define GEMM_ROUTER_X(Bptr) do { pg8::Gemm g{(const bf16*)A1, (const bf16*)(Bptr), DM, DM, DM / RKS, nullptr}; pg8::SplitKXOrder S; S.init(RKS, DM / RKS, F.G, (int)blockIdx.x); \
        pg8::EpiLogits E{(float*)(ws + WS_LG), DM / RKS, (size_t)T * 64}; pg8::gemm_phase<pg8::EpiLogits, pg8::SplitKXOrder, false>(ring, g, S, E); } while (0)
#define GEMM_ROUTER(Bptr) do { pg8::Gemm g{(const bf16*)A1, (const bf16*)(Bptr), DM, DM, DM / RKS, nullptr}; pg8::SplitKOrder S; S.init(T / 256, RKS, DM / RKS, F.G, (int)blockIdx.x); \
        pg8::EpiLogits E{(float*)(ws + WS_LG), DM / RKS, (size_t)T * 64}; pg8::gemm_phase<pg8::EpiLogits, pg8::SplitKOrder, false>(ring, g, S, E); } while (0)
#define GEMM_MOE(EPI, GATH, Aptr, Bptr, K_, layer, ...) do { const int nrt = __builtin_amdgcn_readfirstlane(moe_tables(F, (layer), (int)threadIdx.x)); \
        pg8::Gemm g{(const bf16*)(Aptr), (const bf16*)(Bptr), (K_), (K_), (K_), (const int*)(ws + WS_POS) + (size_t)(layer) * NE * POSCAP}; pg8::MoeOrder S; \
        S.init((const PG8_LAS int*)(F.lds + LDS_TAB), (const PG8_LAS int*)(F.lds + LDS_TAB) + 256, nrt, POSCAP, F.G, (int)blockIdx.x); \
        pg8::EPI E{__VA_ARGS__}; pg8::gemm_phase<pg8::EPI, pg8::MoeOrder, GATH>(ring, g, S, E); } while (0)
    unsigned char* const ws = F.ws;
    PH(0, p0_prologue(F, args););
    PH(1, p_l0_mod1(F, args););
#ifdef NEXTRA_BAR
    for (int i_ = 0; i_ < NEXTRA_BAR; ++i_) xcd_barrier(bar);
#endif
    PH(2, GEMM_STATIC(EpiStoreBf16, A1, ws + WS_WE_IN, EVEN_IN_P, DM, (bf16*)(ws + WS_Y1), EVEN_IN_P, 0x7fffffff););
    PROBE(3, p_even_post1(F, args, WS_DUMMY););
    PH(3, p_even_post1(F, args););
    PH(4, GEMM_STATIC(EpiStoreBf16, ws + WS_CQN, ws + WS_WE_UQ, 1536, 512, (bf16*)(ws + WS_QB), 1536, 0x7fffffff);
          GEMM_STATIC(EpiStoreBf16, ws + WS_CKVN, ws + WS_WE_UKV, 2048, 512, (bf16*)(ws + WS_KV), 2048, 0x7fffffff););
    PH(5, p_even_post2(F, args););
#if USE_NAIVE_ATTN
    PH(6, p_even_attn_naive(F););
#else
    PH(6, p_even_attn(F, (char*)lds););
#endif
    PH(7, GEMM_STATIC(EpiResidInit, MIX, ws + WS_WE_OUT, DM, DM, H, MOD + (size_t)0 * 9 * 12288 + 2 * 2048, args.in[I_X], args.in[I_CTX]););
#if FUSED_ROUTE
    PH(8, p_mod2_route(F, args, 0););
#else
    PH(8, p_mod2(F, 0););
    PH(9, GEMM_ROUTER(ws + WS_WR););
    PH(10, p_route(F, args, 0););
#endif
#if MOE_F32B
    PH(12, GEMM_MOE_F(EpiSwiGLU, true, A1, args.in[I_WG], args.in[I_WU], 2048 * 1024, 1024, 128, 0, DM, 0, (bf16*)(ws + WS_U), DE););
    PH(13, GEMM_MOE_F(EpiStoreBf16, false, ws + WS_U, args.in[I_WD], args.in[I_WD], 1024 * 2048, 2048, 256, 128, DE, 0, (bf16*)(ws + WS_YS), DM, 7););
#else
    PH(12, GEMM_MOE(EpiSwiGLU, true, A1, ws + WS_WGU, DM, 0, (bf16*)(ws + WS_U), DE););
    PH(13, GEMM_MOE(EpiStoreBf16, false, ws + WS_U, ws + WS_WDN, DE, 0, (bf16*)(ws + WS_YS), DM, 7););
#endif
    PROBE(14, p_l1_mod1(F, WS_DUMMY, WS_DUMMY + 160 * MiB););
    PH(14, p_l1_mod1(F););
    PH(15, GEMM_ORDER(EpiStoreBf16, OddInOrder, (F.G, (int)blockIdx.x), A1, ws + WS_WO_IN, DM, (bf16*)(ws + WS_Y1), ODD_IN, 0x7fffffff););
    PROBE(16, p_odd_post1(F, args, WS_DUMMY););
    PH(16, p_odd_post1(F, args););
#if USE_NAIVE_ATTN
    PH(17, p_odd_attn_naive(F, args););
    PH(18, ;);
#else
    PH(17, p_odd_attn(F, args, (char*)lds););
#if !ATT_DIFF_FUSED
    PH(18, p_odd_combine(F, args););
#endif
#endif
    PH(19, GEMM_ORDER(EpiResid, XOnlyOrder, (DM, F.G, (int)blockIdx.x), MIX, ws + WS_WO_OUT, DM, H, MOD + (size_t)1 * 9 * 12288 + 2 * 2048););
#if FUSED_ROUTE
    PH(20, p_mod2_route(F, args, 1););
#else
    PH(20, p_mod2(F, 1););
    PH(21, GEMM_ROUTER_X((const bf16*)(ws + WS_WR) + (size_t)256 * 2048););
    PH(22, p_route(F, args, 1););
#endif
#if MOE_F32B
    PH(24, GEMM_MOE_F(EpiSwiGLU, true, A1, args.in[I_WG] + (size_t)32 * 2048 * 1024, args.in[I_WU] + (size_t)32 * 2048 * 1024, 2048 * 1024, 1024, 128, 0, DM, 1, (bf16*)(ws + WS_U), DE););
    PH(25, GEMM_MOE_F(EpiStoreBf16, false, ws + WS_U, args.in[I_WD] + (size_t)32 * 1024 * 2048, args.in[I_WD] + (size_t)32 * 1024 * 2048, 1024 * 2048, 2048, 256, 128, DE, 1, (bf16*)(ws + WS_YS), DM, 7););
#else
    PH(24, GEMM_MOE(EpiSwiGLU, true, A1, (const bf16*)(ws + WS_WGU) + (size_t)32 * 2048 * 2048, DM, 1, (bf16*)(ws + WS_U), DE););
    PH(25, GEMM_MOE(EpiStoreBf16, false, ws + WS_U, (const bf16*)(ws + WS_WDN) + (size_t)32 * 2048 * 1024, DE, 1, (bf16*)(ws + WS_YS), DM, 7););
#endif
    PH(26, p_final(F, args.out););
#undef IN
#undef SEAM
}

extern "C" void kernel_launch(void* const* d_in, const int* in_sizes, int n_in, void* d_out, int out_size, void* d_ws, size_t ws_size, hipStream_t stream) {
    static int grid = 0;
    if (grid == 0) {
        if (n_in != 35 || out_size != NB * SEQ * DM || ws_size < WS_END) { fprintf(stderr, "kernel_launch: unexpected shapes: n_in %d out %d ws %zu (need %zu)\n", n_in, out_size, ws_size, (size_t)WS_END); grid = -1; return; }
        int dev = 0, cus = 0, per_cu = 0;
        if (hipGetDevice(&dev) != hipSuccess || hipDeviceGetAttribute(&cus, hipDeviceAttributeMultiprocessorCount, dev) != hipSuccess) { grid = -1; return; }
        if (hipFuncSetAttribute((const void*)trunk_fwd, hipFuncAttributeMaxDynamicSharedMemorySize, LDS_BYTES) != hipSuccess) { fprintf(stderr, "kernel_launch: hipFuncSetAttribute failed\n"); grid = -1; return; }
        if (hipOccupancyMaxActiveBlocksPerMultiprocessor(&per_cu, (const void*)trunk_fwd, NWAVES * 64, LDS_BYTES) != hipSuccess || per_cu < 1)
            fprintf(stderr, "kernel_launch: occupancy query reports %d workgroups per CU\n", per_cu);
        (void)hipGetLastError();
        grid = cus;
    }
    if (grid < 0) return;
    if (hipMemsetAsync((char*)d_ws + WS_CTL, 0, CTL_ZERO_BYTES, stream) != hipSuccess) { fprintf(stderr, "kernel_launch: memset failed\n"); return; }
    if (hipMemsetAsync((char*)d_ws + WS_POS, 0, (size_t)2 * NE * POSCAP * 4, stream) != hipSuccess) { fprintf(stderr, "kernel_launch: memset failed\n"); return; }
    Args a{};
    for (int i = 0; i < 35; ++i) a.in[i] = (const float*)d_in[i];
    a.out = (float*)d_out; a.ws = (unsigned char*)d_ws;
#if MK_PER_PHASE
    for (int p = 0; p < NPHASE; ++p) { a.ph_lo = p; a.ph_hi = p + 1; hipLaunchKernelGGL(trunk_fwd, dim3(grid), dim3(NWAVES * 64), LDS_BYTES, stream, a); }
#else
    a.ph_lo = 0; a.ph_hi = NPHASE; hipLaunchKernelGGL(trunk_fwd, dim3(grid), dim3(NWAVES * 64), LDS_BYTES, stream, a);
#endif
    const hipError_t le = hipPeekAtLastError();
    if (le != hipSuccess) fprintf(stderr, "kernel_launch: launch failed: %s\n", hipGetErrorName(le));
}
```

```cpp
#include <hip/hip_runtime.h>
#include <cstdio>
#include <cstdint>
__device__ __forceinline__ int lane_id_() { return (int)__builtin_amdgcn_mbcnt_hi(~0u, __builtin_amdgcn_mbcnt_lo(~0u, 0u)); }
#define MK_PER_PHASE 0
namespace pg8 {
#define PG8_LAS __attribute__((address_space(3)))
typedef unsigned short bf16_t;
typedef short bf16x8 __attribute__((ext_vector_type(8)));
typedef float f32x4 __attribute__((ext_vector_type(4)));
typedef unsigned u32x4 __attribute__((ext_vector_type(4)));
constexpr int BM = 256, BK = 64, HALF = 128, HTB = HALF * BK * 2  , STAGE_BYTES = 8 * HTB, NXCD = 8, WGM = 8;

__host__ __device__ __forceinline__ int lds_byte(int r, int c) { const int st = (r >> 4) * 2 + (c >> 5), rr = r & 15, cc = c & 31, ob = rr * 64 + cc * 2; return st * 1024 + (ob ^ (((ob >> 9) & 1) << 5)); }
__host__ __device__ __forceinline__ void stage_rc(int b, int& R, int& C) { const int st = b / 1024, sb = b % 1024, swz = sb ^ (((sb >> 9) & 1) << 5); R = (st >> 1) * 16 + swz / 64; C = (st & 1) * 32 + (swz % 64) / 2; }
__host__ __device__ __forceinline__ int perm32(int rho) { const int n = rho >> 4, i = rho & 15; return 8 * (i >> 2) + 4 * n + (i & 3); }

struct Unit { int pm, pn, ko, kt, gb; };
struct Gemm { const bf16_t* A; const bf16_t* Bt; int lda, ldb, K; const int* rowidx; };

struct StaticOrder {
    int nM, nN, nwg, G, c;
    __host__ __device__ void init(int M, int N, int G_, int c_) { nM = M / BM; nN = N / BM; nwg = nM * nN; G = G_; c = c_; }
    __host__ __device__ bool next(int i, Unit& u) const {
        const long L = (long)i * G + c; if (L >= nwg) return false;
        int wgid = (int)L; { const int q = nwg / NXCD, r = nwg % NXCD, xcd = wgid % NXCD, off = wgid / NXCD; wgid = (xcd < r ? xcd * (q + 1) : r * (q + 1) + (xcd - r) * q) + off; }
        const int nig = WGM * nN, gid = wgid / nig, fm = gid * WGM, gsz = (nM - fm) < WGM ? (nM - fm) : WGM;
        u.pm = fm + ((wgid % nig) % gsz); u.pn = (wgid % nig) / gsz; u.ko = 0; u.kt = 0; u.gb = u.pm * BM; return true;
    }
    __device__ __forceinline__ void a_ready(const Unit&) const {}
    __device__ __forceinline__ void done(const Unit&) const {}
};


__device__ __forceinline__ unsigned cvt_pk_bf16(float lo, float hi) { unsigned r; asm volatile("v_cvt_pk_bf16_f32 %0, %1, %2" : "=v"(r) : "v"(lo), "v"(hi)); return r; }

struct EpiStoreBf16 {
    static constexpr bool PERM = true, AFTER_DRAIN = false;
    bf16_t* O; int ldc; int pn_mask;
    __device__ __forceinline__ void operator()(const f32x4 (&acc)[2][2][4][2], const Unit& u, int wr, int wc, int fr, int fq) const {
        const int row0 = u.pm * BM + wr * 64 + fr, col0 = (u.pn & pn_mask) * BM + wc * 32 + 8 * fq;
#pragma unroll
        for (int ai = 0; ai < 2; ++ai)
#pragma unroll
            for (int m = 0; m < 4; ++m) { bf16_t* rowp = O + (size_t)(row0 + ai * HALF + m * 16) * ldc + col0;
#pragma unroll
                for (int bj = 0; bj < 2; ++bj) { const f32x4 v0 = acc[ai][bj][m][0], v1 = acc[ai][bj][m][1];
                    u32x4 w; w.x = cvt_pk_bf16(v0[0], v0[1]); w.y = cvt_pk_bf16(v0[2], v0[3]); w.z = cvt_pk_bf16(v1[0], v1[1]); w.w = cvt_pk_bf16(v1[2], v1[3]);
                    *(u32x4*)(rowp + bj * HALF) = w; } }
    }
};
__device__ __forceinline__ float silu_f(float x) { return x * __builtin_amdgcn_rcpf(1.0f + __builtin_amdgcn_exp2f(-1.4426950408889634f * x)); }
struct EpiSwiGLU {
    static constexpr bool PERM = true, AFTER_DRAIN = false;
    bf16_t* O; int ldc;
    __device__ __forceinline__ void operator()(const f32x4 (&acc)[2][2][4][2], const Unit& u, int wr, int wc, int fr, int fq) const {
        const int row0 = u.pm * BM + wr * 64 + fr, col0 = (u.pn & 7) * HALF + wc * 32 + 8 * fq;
#pragma unroll
        for (int ai = 0; ai < 2; ++ai)
#pragma unroll
            for (int m = 0; m < 4; ++m) { bf16_t* rowp = O + (size_t)(row0 + ai * HALF + m * 16) * ldc + col0;
                const f32x4 g0 = acc[ai][0][m][0], g1 = acc[ai][0][m][1], u0 = acc[ai][1][m][0], u1 = acc[ai][1][m][1];
                u32x4 w; w.x = cvt_pk_bf16(silu_f(g0[0]) * u0[0], silu_f(g0[1]) * u0[1]); w.y = cvt_pk_bf16(silu_f(g0[2]) * u0[2], silu_f(g0[3]) * u0[3]);
                w.z = cvt_pk_bf16(silu_f(g1[0]) * u1[0], silu_f(g1[1]) * u1[1]); w.w = cvt_pk_bf16(silu_f(g1[2]) * u1[2], silu_f(g1[3]) * u1[3]);
                *(u32x4*)rowp = w; }
    }
};
__device__ __forceinline__ float bf_lo(unsigned w) { return __builtin_bit_cast(float, w << 16); }
__device__ __forceinline__ float bf_hi(unsigned w) { return __builtin_bit_cast(float, w & 0xffff0000u); }
struct EpiResid {
    static constexpr bool PERM = true, AFTER_DRAIN = false;
    bf16_t* H; const float* modg;
    __device__ __forceinline__ void operator()(const f32x4 (&acc)[2][2][4][2], const Unit& u, int wr, int wc, int fr, int fq) const {
        const int row0 = u.pm * BM + wr * 64 + fr, col0 = u.pn * BM + wc * 32 + 8 * fq;
        const int j = (u.pm % 9 == 0) ? 8 : (u.pm / 9);
        const float* g = modg + (size_t)j * 12288 + col0;
        f32x4 gv[2][2];
#pragma unroll
        for (int bj = 0; bj < 2; ++bj)
#pragma unroll
            for (int n = 0; n < 2; ++n) gv[bj][n] = *(const f32x4*)(g + bj * HALF + 4 * n);
#pragma unroll
        for (int ai = 0; ai < 2; ++ai)
#pragma unroll
            for (int m = 0; m < 4; ++m) { bf16_t* rowp = H + (size_t)(row0 + ai * HALF + m * 16) * 2048 + col0;
#pragma unroll
                for (int bj = 0; bj < 2; ++bj) { u32x4* p = (u32x4*)(rowp + bj * HALF); const u32x4 h = *p;
                    const f32x4 a0 = gv[bj][0] * acc[ai][bj][m][0], a1 = gv[bj][1] * acc[ai][bj][m][1];
                    u32x4 w; w.x = cvt_pk_bf16(bf_lo(h.x) + a0[0], bf_hi(h.x) + a0[1]); w.y = cvt_pk_bf16(bf_lo(h.y) + a0[2], bf_hi(h.y) + a0[3]);
                    w.z = cvt_pk_bf16(bf_lo(h.z) + a1[0], bf_hi(h.z) + a1[1]); w.w = cvt_pk_bf16(bf_lo(h.w) + a1[2], bf_hi(h.w) + a1[3]);
                    *p = w; } }
    }
};
struct EpiResidInit {
    static constexpr bool PERM = true, AFTER_DRAIN = false;
    bf16_t* H; const float* modg; const float* xin; const float* ctxin;
    __device__ __forceinline__ void operator()(const f32x4 (&acc)[2][2][4][2], const Unit& u, int wr, int wc, int fr, int fq) const {
        const int rl0 = wr * 64 + fr, col0 = u.pn * BM + wc * 32 + 8 * fq;
        const int b = u.pm / 9, t = u.pm - 9 * b, j = (t == 0) ? 8 : b;
        const float* src = (t == 0) ? ctxin + (size_t)(b * 256) * 2048 : xin + (size_t)(b * 2048 + (t - 1) * 256) * 2048;
        const float* g = modg + (size_t)j * 12288 + col0;
        f32x4 gv[2][2];
#pragma unroll
        for (int bj = 0; bj < 2; ++bj)
#pragma unroll
            for (int n = 0; n < 2; ++n) gv[bj][n] = *(const f32x4*)(g + bj * HALF + 4 * n);
#pragma unroll
        for (int ai = 0; ai < 2; ++ai)
#pragma unroll
            for (int m = 0; m < 4; ++m) { const int rl = rl0 + ai * HALF + m * 16; bf16_t* rowp = H + (size_t)(u.pm * BM + rl) * 2048 + col0; const float* srow = src + (size_t)rl * 2048 + col0;
#pragma unroll
                for (int bj = 0; bj < 2; ++bj) { const f32x4 h0 = *(const f32x4*)(srow + bj * HALF), h1 = *(const f32x4*)(srow + bj * HALF + 4);
                    const f32x4 v0 = h0 + gv[bj][0] * acc[ai][bj][m][0], v1 = h1 + gv[bj][1] * acc[ai][bj][m][1];
                    u32x4 w; w.x = cvt_pk_bf16(v0[0], v0[1]); w.y = cvt_pk_bf16(v0[2], v0[3]); w.z = cvt_pk_bf16(v1[0], v1[1]); w.w = cvt_pk_bf16(v1[2], v1[3]);
                    *(u32x4*)(rowp + bj * HALF) = w; } }
    }
};
struct EpiLogits {
    static constexpr bool PERM = false, AFTER_DRAIN = false;
    float* LG; int kslice; size_t slice_stride;
    __device__ __forceinline__ void operator()(const f32x4 (&acc)[2][2][4][2], const Unit& u, int wr, int wc, int fr, int fq) const {
        if (wc >= 2) return;
        const int row0 = u.pm * BM + wr * 64 + fr, col0 = wc * 32 + 4 * fq;
        float* base = LG + (size_t)(u.ko / kslice) * slice_stride;
#pragma unroll
        for (int ai = 0; ai < 2; ++ai)
#pragma unroll
            for (int m = 0; m < 4; ++m) { float* rowp = base + (size_t)(row0 + ai * HALF + m * 16) * 64 + col0;
#pragma unroll
                for (int n = 0; n < 2; ++n) *(f32x4*)(rowp + n * 16) = acc[ai][0][m][n]; }
    }
};
struct SplitKOrder {
    int nM, KS, kslice, G, c;
    __device__ void init(int nM_, int KS_, int kslice_, int G_, int c_) { nM = nM_; KS = KS_; kslice = kslice_; G = G_; c = c_; }
    __device__ bool next(int i, Unit& u) const { const long L = (long)i * G + c; if (L >= (long)nM * KS) return false; const int ks = (int)L / nM; u.pm = (int)L - ks * nM; u.pn = 0; u.ko = ks * kslice; u.kt = 0; u.gb = 0; return true; }
    __device__ __forceinline__ void a_ready(const Unit&) const {}
    __device__ __forceinline__ void done(const Unit&) const {}
};
struct EvenInOrder {
    StaticOrder so; int G, c;
    __device__ void init(int M, int G_, int c_) { so.init(M, 2560, G_, c_); G = G_; c = c_; }
    __device__ bool next(int i, Unit& u) const {
        if (so.next(i, u)) return true;
        const long L = (long)i * G + c - so.nwg; if (L < 0 || L >= 72 * 4) return false;
        const int ks = (int)L / 72; u.pm = (int)L - ks * 72; u.pn = 10; u.ko = ks * 512; u.kt = 8; u.gb = 0; return true;
    }
    __device__ __forceinline__ void a_ready(const Unit&) const {}
    __device__ __forceinline__ void done(const Unit&) const {}
};
struct EpiEvenIn {
    static constexpr bool PERM = true, AFTER_DRAIN = false;
    bf16_t* Y; float* KRP;
    __device__ __forceinline__ void operator()(const f32x4 (&acc)[2][2][4][2], const Unit& u, int wr, int wc, int fr, int fq) const {
        if (u.pn < 10) { const EpiStoreBf16 e{Y, 2816, 0x7fffffff}; e(acc, u, wr, wc, fr, fq); return; }
        if (wc >= 2) return;
        const int row0 = u.pm * BM + wr * 64 + fr, col0 = wc * 32 + 8 * fq;
        float* base = KRP + (size_t)(u.ko >> 9) * ((size_t)18432 * 64);
#pragma unroll
        for (int ai = 0; ai < 2; ++ai)
#pragma unroll
            for (int m = 0; m < 4; ++m) { float* rowp = base + (size_t)(row0 + ai * HALF + m * 16) * 64 + col0;
#pragma unroll
                for (int n = 0; n < 2; ++n) *(f32x4*)(rowp + 4 * n) = acc[ai][0][m][n]; }
    }
};
struct Proj2Order {
    StaticOrder s1, s2; int G, c;
    __device__ void init(int M, int G_, int c_) { s1.init(M, 1536, G_, c_); s2.init(M, 2048, G_, c_); G = G_; c = c_; }
    __device__ bool next(int i, Unit& u) const {
        if (s1.next(i, u)) return true;
        StaticOrder t = s2; const long L = (long)i * G + c - s1.nwg; if (L < 0 || L >= s2.nwg) return false;
        t.G = 1; t.c = (int)L; if (!t.next(0, u)) return false;
        u.pm += 72; u.pn += 8; return true;
    }
    __device__ __forceinline__ void a_ready(const Unit&) const {}
    __device__ __forceinline__ void done(const Unit&) const {}
};
struct EpiProj2 {
    static constexpr bool PERM = true, AFTER_DRAIN = false;
    bf16_t* QB; bf16_t* KV;
    __device__ __forceinline__ void operator()(const f32x4 (&acc)[2][2][4][2], const Unit& u, int wr, int wc, int fr, int fq) const {
        if (u.pm < 72) { const EpiStoreBf16 e{QB, 1536, 0x7fffffff}; e(acc, u, wr, wc, fr, fq); }
        else { Unit v = u; v.pm -= 72; v.pn -= 8; const EpiStoreBf16 e{KV, 2048, 0x7fffffff}; e(acc, v, wr, wc, fr, fq); }
    }
};
struct XOnlyOrder {
    StaticOrder so;
    __device__ void init(int N, int G_, int c_) { so.init(64 * BM, N, G_, c_); }
    __device__ bool next(int i, Unit& u) const { if (!so.next(i, u)) return false; u.pm = 9 * (u.pm >> 3) + 1 + (u.pm & 7); return true; }
    __device__ __forceinline__ void a_ready(const Unit&) const {}
    __device__ __forceinline__ void done(const Unit&) const {}
};
struct OddInOrder {
    StaticOrder so; int G, c;
    __device__ void init(int G_, int c_) { so.init(64 * BM, 18 * BM, G_, c_); G = G_; c = c_; }
    __device__ bool next(int i, Unit& u) const {
        if (so.next(i, u)) { u.pm = 9 * (u.pm >> 3) + 1 + (u.pm & 7); return true; }
        const long L = (long)i * G + c - 64 * 18; if (L >= 80) return false;
        const int b = (int)L / 10, j = (int)L - b * 10; u.pm = 9 * b; u.pn = j < 8 ? 4 + j : 8 + j; u.ko = 0; u.kt = 0; u.gb = 0; return true;
    }
    __device__ __forceinline__ void a_ready(const Unit&) const {}
    __device__ __forceinline__ void done(const Unit&) const {}
};
struct SplitKXOrder {
    int KS, kslice, G, c;
    __device__ void init(int KS_, int kslice_, int G_, int c_) { KS = KS_; kslice = kslice_; G = G_; c = c_; }
    __device__ bool next(int i, Unit& u) const { const long L = (long)i * G + c; if (L >= 64L * KS) return false; const int ks = (int)L / 64, x = (int)L - ks * 64; u.pm = 9 * (x >> 3) + 1 + (x & 7); u.pn = 0; u.ko = ks * kslice; u.kt = 0; u.gb = 0; return true; }
    __device__ __forceinline__ void a_ready(const Unit&) const {}
    __device__ __forceinline__ void done(const Unit&) const {}
};
struct MoeOrder {
    const PG8_LAS int* texp; const PG8_LAS int* frt; int nunits, G, c, cap;
    __device__ void init(const PG8_LAS int* texp_, const PG8_LAS int* frt_, int n_row_tiles, int cap_, int G_, int c_) { texp = texp_; frt = frt_; nunits = n_row_tiles * 8; cap = cap_; G = G_; c = c_; }
    __device__ bool next(int i, Unit& u) const {
        const long L = (long)i * G + c; if (L >= nunits) return false;
        int wgid = (int)L; { const int q = nunits / NXCD, r = nunits % NXCD, xcd = wgid % NXCD, off = wgid / NXCD; wgid = (xcd < r ? xcd * (q + 1) : r * (q + 1) + (xcd - r) * q) + off; }
        const int rt = wgid >> 3, pn = wgid & 7, e = __builtin_amdgcn_readfirstlane(texp[rt]);
        u.pm = rt; u.pn = e * 8 + pn; u.ko = 0; u.kt = 0; u.gb = e * cap + (rt - __builtin_amdgcn_readfirstlane(frt[e])) * BM; return true;
    }
    __device__ __forceinline__ void a_ready(const Unit&) const {}
    __device__ __forceinline__ void done(const Unit&) const {}
};
template <class Epi, class Sched, bool GATHER = false>
__device__ __forceinline__ void gemm_phase(PG8_LAS unsigned char* lds, const Gemm g, const Sched& S, const Epi& E, int wv) {
    int tid = wv * 64 + lane_id_(); asm volatile("" : "+v"(tid));
    const int wid = __builtin_amdgcn_readfirstlane(tid >> 6), lane = tid & 63, wr = wid >> 2, wc = wid & 3, fr = lane & 15, fq = lane >> 4;
    const int K = g.K, lda = g.lda, ldb = g.ldb;
    unsigned va[2][2], vn[2][2], voffB[2]; int sR[2], sC[2];
#pragma unroll
    for (int i = 0; i < 2; ++i) { int R, C; stage_rc(tid * 16 + i * 8192, R, C); const int Rb = Epi::PERM ? ((R & ~31) + perm32(R & 31)) : R; sR[i] = R; sC[i] = C;
        voffB[i] = (unsigned)(Rb * ldb + C) * 2u;
        va[0][i] = (unsigned)(R * lda + C) * 2u; va[1][i] = (unsigned)((R + HALF) * lda + C) * 2u; vn[0][i] = va[0][i]; vn[1][i] = va[1][i]; }
    const size_t kstep = (size_t)(BK * 2);
    const size_t hstepB = (size_t)HALF * ldb * 2;
    const size_t tstepA = (size_t)BM * lda * 2, tstepB = (size_t)BM * ldb * 2;
    const unsigned ldsw = (unsigned)wid * 1024u;
    const int aoff = lds_byte(wr * 64 + fr, fq * 8), boff = lds_byte(wc * 32 + fr, fq * 8);
#define PG8_SA(b, h) (((b) * 2 + (h)) * HTB)
#define PG8_SB(b, h) ((4 + (b) * 2 + (h)) * HTB)
#define PG8_STAGE(bufoff, gbase, voff) do { _Pragma("unroll") for (int _i = 0; _i < 2; ++_i) \
        __builtin_amdgcn_global_load_lds((const unsigned*)((const char*)(gbase) + (voff)[_i]), (PG8_LAS unsigned*)(lds + (bufoff) + ldsw + _i * 8192), 16, 0, 0); } while (0)
#define PG8_LDA(dst, b, h) do { _Pragma("unroll") for (int m = 0; m < 4; ++m) _Pragma("unroll") for (int k = 0; k < 2; ++k) dst[m][k] = *(const PG8_LAS bf16x8*)(lds + PG8_SA(b, h) + aoff + m * 2048 + k * 1024); } while (0)
#define PG8_LDB(dst, b, h) do { _Pragma("unroll") for (int n = 0; n < 2; ++n) _Pragma("unroll") for (int k = 0; k < 2; ++k) dst[n][k] = *(const PG8_LAS bf16x8*)(lds + PG8_SB(b, h) + boff + n * 2048 + k * 1024); } while (0)
#define PG8_MMA(ai, bj, At, Bt) do { __builtin_amdgcn_s_setprio(1); _Pragma("unroll") for (int m = 0; m < 4; ++m) _Pragma("unroll") for (int n = 0; n < 2; ++n) _Pragma("unroll") for (int k = 0; k < 2; ++k) \
        acc[ai][bj][m][n] = __builtin_amdgcn_mfma_f32_16x16x32_bf16(Bt[n][k], At[m][k], acc[ai][bj][m][n], 0, 0, 0); __builtin_amdgcn_s_setprio(0); } while (0)
#define PG8_WAIT_V(n) asm volatile("s_waitcnt vmcnt(" #n ")" ::: "memory")
#define PG8_WAIT_L(n) asm volatile("s_waitcnt lgkmcnt(" #n ")" ::: "memory")
#define PG8_BAR __builtin_amdgcn_s_barrier()
#define PG8_SCHED __builtin_amdgcn_sched_barrier(0)
#define PG8_GATHER_OFFS(dst, u) do { if constexpr (GATHER) { _Pragma("unroll") for (int _h = 0; _h < 2; ++_h) _Pragma("unroll") for (int _i = 0; _i < 2; ++_i) \
        dst[_h][_i] = (unsigned)(g.rowidx[(u).gb + _h * HALF + sR[_i]] * lda + sC[_i]) * 2u; } } while (0)
    Unit cur, nxt; int ui = 0;
    if (!S.next(0, cur)) return;
    f32x4 acc[2][2][4][2];
#pragma unroll
    for (int a = 0; a < 2; ++a)
#pragma unroll
        for (int b = 0; b < 2; ++b)
#pragma unroll
            for (int m = 0; m < 4; ++m)
#pragma unroll
                for (int n = 0; n < 2; ++n) acc[a][b][m][n] = (f32x4){0.f, 0.f, 0.f, 0.f};
    bf16x8 At[4][2], B0[2][2], B1[2][2];
    const char* cA = (const char*)g.A + (GATHER ? (size_t)0 : (size_t)cur.pm * tstepA) + (size_t)cur.ko * 2; const char* cB = (const char*)g.Bt + (size_t)cur.pn * tstepB + (size_t)cur.ko * 2;
    PG8_GATHER_OFFS(va, cur);
    S.a_ready(cur);
    PG8_STAGE(PG8_SB(0, 0), cB, voffB); PG8_STAGE(PG8_SB(0, 1), cB + hstepB, voffB); PG8_STAGE(PG8_SA(0, 0), cA, va[0]); PG8_STAGE(PG8_SA(0, 1), cA, va[1]);
    if (wr == 1) PG8_BAR;
    PG8_WAIT_V(2); PG8_BAR;
    PG8_STAGE(PG8_SB(1, 0), cB + kstep, voffB); PG8_STAGE(PG8_SA(1, 0), cA + kstep, va[0]); PG8_STAGE(PG8_SB(1, 1), cB + hstepB + kstep, voffB);
    PG8_WAIT_V(6); PG8_BAR;
    for (;;) {
        const bool has_next = S.next(ui + 1, nxt);
        const char* nA = has_next ? (const char*)g.A + (GATHER ? (size_t)0 : (size_t)nxt.pm * tstepA) + (size_t)nxt.ko * 2 : cA; const char* nB = has_next ? (const char*)g.Bt + (size_t)nxt.pn * tstepB + (size_t)nxt.ko * 2 : cB;
        if constexpr (GATHER) { if (has_next) PG8_GATHER_OFFS(vn, nxt); else { _Pragma("unroll") for (int _h = 0; _h < 2; ++_h) _Pragma("unroll") for (int _i = 0; _i < 2; ++_i) vn[_h][_i] = va[_h][_i]; } }
        const int nt = K / BK;
        for (int t = 0; t < nt; t += 2) {
            const bool last = (t == nt - 2);
            const char* a1 = cA + (size_t)(t + 1) * kstep;
            const char* a2 = last ? nA : cA + (size_t)(t + 2) * kstep; const char* b2 = last ? nB : cB + (size_t)(t + 2) * kstep;
            const char* a3 = a2 + kstep; const char* b3 = b2 + kstep;
            unsigned v2[2][2];
#pragma unroll
            for (int _h = 0; _h < 2; ++_h)
#pragma unroll
                for (int _i = 0; _i < 2; ++_i) v2[_h][_i] = (GATHER && last) ? vn[_h][_i] : va[_h][_i];
            if (last && has_next) S.a_ready(nxt);
            PG8_LDB(B0, 0, 0); PG8_LDB(B1, 0, 1); PG8_SCHED; PG8_LDA(At, 0, 0); PG8_STAGE(PG8_SA(1, 1), a1, va[1]);
            PG8_WAIT_V(8); PG8_WAIT_L(0); PG8_BAR; PG8_MMA(0, 0, At, B0); PG8_MMA(0, 1, At, B1); PG8_BAR; PG8_SCHED;
            PG8_LDA(At, 0, 1); PG8_STAGE(PG8_SB(0, 0), b2, voffB); PG8_STAGE(PG8_SB(0, 1), b2 + hstepB, voffB); PG8_STAGE(PG8_SA(0, 0), a2, v2[0]);
            PG8_WAIT_V(8); PG8_WAIT_L(0); PG8_BAR; PG8_MMA(1, 0, At, B0); PG8_MMA(1, 1, At, B1); PG8_BAR; PG8_SCHED;
            PG8_LDB(B0, 1, 0); PG8_LDB(B1, 1, 1); PG8_SCHED; PG8_LDA(At, 1, 0); PG8_STAGE(PG8_SA(0, 1), a2, v2[1]);
            PG8_WAIT_V(8); PG8_WAIT_L(0); PG8_BAR; PG8_MMA(0, 0, At, B0); PG8_MMA(0, 1, At, B1); PG8_BAR; PG8_SCHED;
            PG8_LDA(At, 1, 1); PG8_STAGE(PG8_SB(1, 0), b3, voffB); PG8_STAGE(PG8_SB(1, 1), b3 + hstepB, voffB); PG8_STAGE(PG8_SA(1, 0), a3, v2[0]);
            PG8_WAIT_V(8); PG8_WAIT_L(0); PG8_BAR; PG8_MMA(1, 0, At, B0); PG8_MMA(1, 1, At, B1); PG8_BAR; PG8_SCHED;
        }
        if (wr == 0) PG8_BAR;
        E(acc, cur, wr, wc, fr, fq); S.done(cur);
        if (!has_next) break;
#pragma unroll
        for (int a = 0; a < 2; ++a)
#pragma unroll
            for (int b = 0; b < 2; ++b)
#pragma unroll
                for (int m = 0; m < 4; ++m)
#pragma unroll
                    for (int n = 0; n < 2; ++n) acc[a][b][m][n] = (f32x4){0.f, 0.f, 0.f, 0.f};
        cur = nxt; cA = nA; cB = nB; ++ui;
        if constexpr (GATHER) { _Pragma("unroll") for (int _h = 0; _h < 2; ++_h) _Pragma("unroll") for (int _i = 0; _i < 2; ++_i) va[_h][_i] = vn[_h][_i]; }
        if (wr == 1) PG8_BAR;
    }
    PG8_WAIT_V(0);
    PG8_BAR;
#undef PG8_SA
#undef PG8_SB
#undef PG8_STAGE
#undef PG8_LDA
#undef PG8_LDB
#undef PG8_MMA
#undef PG8_WAIT_V
#undef PG8_WAIT_L
#undef PG8_BAR
#undef PG8_SCHED
#undef PG8_GATHER_OFFS
}
typedef unsigned u32x2 __attribute__((ext_vector_type(2)));
struct BSrc { const float* m0; const float* m1; size_t estride; int ldn, colmul, hoff; };
template <class Epi, class Sched, bool GATHER = false>
__device__ __forceinline__ void gemm_phase_f32b(PG8_LAS unsigned char* lds, const Gemm g, const BSrc bs, const Sched& S, const Epi& E, int wv) {
    int tid = wv * 64 + lane_id_(); asm volatile("" : "+v"(tid));
    const int wid = __builtin_amdgcn_readfirstlane(tid >> 6), lane = tid & 63, wr = wid >> 2, wc = wid & 3, fr = lane & 15, fq = lane >> 4;
    const int K = g.K, lda = g.lda;
    unsigned va00, va01, va10, va11, vn00, vn01, vn10, vn11;
#pragma unroll
    for (int i = 0; i < 2; ++i) { int R, C; stage_rc(tid * 16 + i * 8192, R, C);
        const unsigned o0_ = (unsigned)(R * lda + C) * 2u, o1_ = (unsigned)((R + HALF) * lda + C) * 2u; if (i == 0) { va00 = o0_; va10 = o1_; } else { va01 = o0_; va11 = o1_; } }
    vn00 = va00; vn01 = va01; vn10 = va10; vn11 = va11;
    const size_t kstep = (size_t)(BK * 2);
    const size_t tstepA = (size_t)BM * lda * 2;
    const int kq = lane & 15, nq = (lane >> 4) + 4 * wid;
    const int brow = (nq >> 3) * 32 + (Epi::PERM ? (16 * (nq & 1) + 4 * ((nq & 7) >> 1)) : (4 * (nq & 7)));
    const int bwr = lds_byte(brow, 4 * kq);
    const unsigned bvo = (unsigned)((4 * kq) * bs.ldn + 4 * nq) * 4u;
    const size_t bkstep = (size_t)BK * bs.ldn * 4, brstep = (size_t)bs.ldn * 4;
    f32x4 w0, w1, w2, w3;
    const unsigned ldsw = (unsigned)wid * 1024u;
    const int aoff = lds_byte(wr * 64 + fr, fq * 8), boff = lds_byte(wc * 32 + fr, fq * 8);
#define PG8_SA(b, h) (((b) * 2 + (h)) * HTB)
#define PG8_SB(b, h) ((4 + (b) * 2 + (h)) * HTB)
#define PG8_BLOAD(src) do { const char* p0_ = (const char*)(src); const char* p1_ = p0_ + brstep; const char* p2_ = p1_ + brstep; const char* p3_ = p2_ + brstep; \
        asm volatile("s_nop 4\n\tglobal_load_dwordx4 %0, %4, %5\n\tglobal_load_dwordx4 %1, %4, %6\n\tglobal_load_dwordx4 %2, %4, %7\n\tglobal_load_dwordx4 %3, %4, %8" \
                     : "=&v"(w0), "=&v"(w1), "=&v"(w2), "=&v"(w3) : "v"(bvo), "s"(p0_), "s"(p1_), "s"(p2_), "s"(p3_)); } while (0)
#define PG8_BWAIT(n) asm volatile("s_waitcnt vmcnt(" #n ")" : "+v"(w0), "+v"(w1), "+v"(w2), "+v"(w3))
#define PG8_BWRITE(bufoff) do { PG8_LAS unsigned char* d_ = lds + (bufoff) + bwr; \
        { u32x2 c_; c_.x = cvt_pk_bf16(w0[0], w1[0]); c_.y = cvt_pk_bf16(w2[0], w3[0]); *(PG8_LAS u32x2*)(d_) = c_; } \
        { u32x2 c_; c_.x = cvt_pk_bf16(w0[1], w1[1]); c_.y = cvt_pk_bf16(w2[1], w3[1]); *(PG8_LAS u32x2*)(d_ + 64) = c_; } \
        { u32x2 c_; c_.x = cvt_pk_bf16(w0[2], w1[2]); c_.y = cvt_pk_bf16(w2[2], w3[2]); *(PG8_LAS u32x2*)(d_ + 128) = c_; } \
        { u32x2 c_; c_.x = cvt_pk_bf16(w0[3], w1[3]); c_.y = cvt_pk_bf16(w2[3], w3[3]); *(PG8_LAS u32x2*)(d_ + 192) = c_; } } while (0)
#define PG8_BSRC(u, h) ((const char*)(((h) ? bs.m1 : bs.m0) + (size_t)((u).pn >> 3) * bs.estride + (size_t)((u).pn & 7) * bs.colmul + (h) * bs.hoff) + (size_t)(u).ko * brstep)
#define PG8_STAGE(bufoff, gbase, o0, o1) do { \
        __builtin_amdgcn_global_load_lds((const unsigned*)((const char*)(gbase) + (o0)), (PG8_LAS unsigned*)(lds + (bufoff) + ldsw), 16, 0, 0); \
        __builtin_amdgcn_global_load_lds((const unsigned*)((const char*)(gbase) + (o1)), (PG8_LAS unsigned*)(lds + (bufoff) + ldsw + 8192), 16, 0, 0); } while (0)
#define PG8_LDA(dst, b, h) do { _Pragma("unroll") for (int m = 0; m < 4; ++m) _Pragma("unroll") for (int k = 0; k < 2; ++k) dst[m][k] = *(const PG8_LAS bf16x8*)(lds + PG8_SA(b, h) + aoff + m * 2048 + k * 1024); } while (0)
#define PG8_LDB(dst, b, h) do { _Pragma("unroll") for (int n = 0; n < 2; ++n) _Pragma("unroll") for (int k = 0; k < 2; ++k) dst[n][k] = *(const PG8_LAS bf16x8*)(lds + PG8_SB(b, h) + boff + n * 2048 + k * 1024); } while (0)
#define PG8_MMA(ai, bj, At, Bt) do { __builtin_amdgcn_s_setprio(1); _Pragma("unroll") for (int m = 0; m < 4; ++m) _Pragma("unroll") for (int n = 0; n < 2; ++n) _Pragma("unroll") for (int k = 0; k < 2; ++k) \
        acc[ai][bj][m][n] = __builtin_amdgcn_mfma_f32_16x16x32_bf16(Bt[n][k], At[m][k], acc[ai][bj][m][n], 0, 0, 0); __builtin_amdgcn_s_setprio(0); } while (0)
#define PG8_WAIT_V(n) asm volatile("s_waitcnt vmcnt(" #n ")" ::: "memory")
#define PG8_WAIT_L(n) asm volatile("s_waitcnt lgkmcnt(" #n ")" ::: "memory")
#define PG8_BAR __builtin_amdgcn_s_barrier()
#define PG8_SCHED __builtin_amdgcn_sched_barrier(0)
#define PG8_GATHER_OFFS(d00, d01, d10, d11, u) do { if constexpr (GATHER) { const int* ri_ = g.rowidx + (u).gb; int t_ = wv * 64 + lane_id_(); asm volatile("" : "+v"(t_)); \
        int R0_, C0_, R1_, C1_; stage_rc(t_ * 16, R0_, C0_); stage_rc(t_ * 16 + 8192, R1_, C1_);     \
        d00 = (unsigned)(ri_[R0_] * lda + C0_) * 2u; d01 = (unsigned)(ri_[R1_] * lda + C1_) * 2u; \
        d10 = (unsigned)(ri_[HALF + R0_] * lda + C0_) * 2u; d11 = (unsigned)(ri_[HALF + R1_] * lda + C1_) * 2u; } } while (0)
    Unit cur, nxt; int ui = 0;
    if (!S.next(0, cur)) return;
    f32x4 acc[2][2][4][2];
#pragma unroll
    for (int a = 0; a < 2; ++a)
#pragma unroll
        for (int b = 0; b < 2; ++b)
#pragma unroll
            for (int m = 0; m < 4; ++m)
#pragma unroll
                for (int n = 0; n < 2; ++n) acc[a][b][m][n] = (f32x4){0.f, 0.f, 0.f, 0.f};
    bf16x8 At[4][2], B0[2][2], B1[2][2];
    const char* cA = (const char*)g.A + (GATHER ? (size_t)0 : (size_t)cur.pm * tstepA) + (size_t)cur.ko * 2; const char* cB0 = PG8_BSRC(cur, 0); const char* cB1 = PG8_BSRC(cur, 1);
    PG8_GATHER_OFFS(va00, va01, va10, va11, cur);
    S.a_ready(cur);
    PG8_STAGE(PG8_SA(0, 0), cA, va00, va01); PG8_STAGE(PG8_SA(0, 1), cA, va10, va11);
    PG8_BLOAD(cB0); PG8_BWAIT(0); PG8_BWRITE(PG8_SB(0, 0));
    PG8_BLOAD(cB1); PG8_BWAIT(0); PG8_BWRITE(PG8_SB(0, 1));
    PG8_BLOAD(cB0 + bkstep); PG8_BWAIT(0); PG8_BWRITE(PG8_SB(1, 0));
    PG8_BLOAD(cB1 + bkstep); PG8_STAGE(PG8_SA(1, 0), cA + kstep, va00, va01);
    PG8_WAIT_L(0);
    if (wr == 1) PG8_BAR;
    PG8_BAR;
    PG8_BAR;
    for (;;) {
        const bool has_next = S.next(ui + 1, nxt);
        const char* nA = has_next ? (const char*)g.A + (GATHER ? (size_t)0 : (size_t)nxt.pm * tstepA) + (size_t)nxt.ko * 2 : cA; const char* nB0 = has_next ? PG8_BSRC(nxt, 0) : cB0; const char* nB1 = has_next ? PG8_BSRC(nxt, 1) : cB1;
        const int nt = K / BK;
        for (int t = 0; t < nt; t += 2) {
            const bool last = (t == nt - 2);
            const char* a1 = cA + (size_t)(t + 1) * kstep;
            const char* a2 = last ? nA : cA + (size_t)(t + 2) * kstep;
            const char* b20 = last ? nB0 : cB0 + (size_t)(t + 2) * bkstep; const char* b21 = last ? nB1 : cB1 + (size_t)(t + 2) * bkstep;
            const char* a3 = a2 + kstep; const char* b30 = b20 + bkstep; const char* b31 = b21 + bkstep;
            if constexpr (GATHER) { if (last) { if (has_next) PG8_GATHER_OFFS(vn00, vn01, vn10, vn11, nxt); else { vn00 = va00; vn01 = va01; vn10 = va10; vn11 = va11; } } }
            const bool usen_ = GATHER && last;
            const unsigned v200 = usen_ ? vn00 : va00, v201 = usen_ ? vn01 : va01, v210 = usen_ ? vn10 : va10, v211 = usen_ ? vn11 : va11;
            if (last && has_next) S.a_ready(nxt);
            PG8_LDB(B0, 0, 0); PG8_LDB(B1, 0, 1); PG8_SCHED; PG8_LDA(At, 0, 0);
            PG8_BWAIT(2); PG8_BWRITE(PG8_SB(1, 1)); PG8_BLOAD(b20); PG8_STAGE(PG8_SA(1, 1), a1, va10, va11);
            PG8_WAIT_L(0); PG8_BAR; PG8_MMA(0, 0, At, B0); PG8_MMA(0, 1, At, B1); PG8_BAR; PG8_SCHED;
            PG8_LDA(At, 0, 1);
            PG8_BWAIT(2); PG8_BWRITE(PG8_SB(0, 0)); PG8_BLOAD(b21); PG8_STAGE(PG8_SA(0, 0), a2, v200, v201);
            PG8_WAIT_L(0); PG8_BAR; PG8_MMA(1, 0, At, B0); PG8_MMA(1, 1, At, B1); PG8_BAR; PG8_SCHED;
            PG8_LDB(B0, 1, 0); PG8_LDB(B1, 1, 1); PG8_SCHED; PG8_LDA(At, 1, 0);
            PG8_BWAIT(2); PG8_BWRITE(PG8_SB(0, 1)); PG8_BLOAD(b30); PG8_STAGE(PG8_SA(0, 1), a2, v210, v211);
            PG8_WAIT_L(0); PG8_BAR; PG8_MMA(0, 0, At, B0); PG8_MMA(0, 1, At, B1); PG8_BAR; PG8_SCHED;
            PG8_LDA(At, 1, 1);
            PG8_BWAIT(2); PG8_BWRITE(PG8_SB(1, 0)); PG8_BLOAD(b31); PG8_STAGE(PG8_SA(1, 0), a3, v200, v201);
            PG8_WAIT_L(0); PG8_BAR; PG8_MMA(1, 0, At, B0); PG8_MMA(1, 1, At, B1); PG8_BAR; PG8_SCHED;
        }
        if (wr == 0) PG8_BAR;
        E(acc, cur, wr, wc, fr, fq); S.done(cur);
        if (!has_next) break;
#pragma unroll
        for (int a = 0; a < 2; ++a)
#pragma unroll
            for (int b = 0; b < 2; ++b)
#pragma unroll
                for (int m = 0; m < 4; ++m)
#pragma unroll
                    for (int n = 0; n < 2; ++n) acc[a][b][m][n] = (f32x4){0.f, 0.f, 0.f, 0.f};
        cur = nxt; cA = nA; cB0 = nB0; cB1 = nB1; ++ui;
        if constexpr (GATHER) { va00 = vn00; va01 = vn01; va10 = vn10; va11 = vn11; }
        if (wr == 1) PG8_BAR;
    }
    PG8_WAIT_V(0);
    PG8_BAR;
#undef PG8_SA
#undef PG8_SB
#undef PG8_STAGE
#undef PG8_BLOAD
#undef PG8_BWAIT
#undef PG8_BWRITE
#undef PG8_BSRC
#undef PG8_LDA
#undef PG8_LDB
#undef PG8_MMA
#undef PG8_WAIT_V
#undef PG8_WAIT_L
#undef PG8_BAR
#undef PG8_SCHED
#undef PG8_GATHER_OFFS
}
}

#ifndef PG8_SP2
#define PG8_SP2 true
#endif
#ifndef PG8_ALIGN
#define PG8_ALIGN true
#endif
#ifndef MK_PER_PHASE
#define MK_PER_PHASE 0
#endif

constexpr int NWAVES = 8;
constexpr int DM = 2048, NB = 8, SEQ = 2048, CTX = 256, TPB = CTX + SEQ, T = NB * TPB;
constexpr int EVEN_IN_P = 2816, ODD_IN = 4608;
constexpr int NE = 32, DE = 1024, MAXSLOT = 45056;
constexpr float NORM_EPS = 1e-6f;
constexpr float LAMBDA_INIT = 0.35550906759f;
constexpr int NPHASE = 27;
#ifndef MOE_F32B
#define MOE_F32B 0
#endif
#ifndef FUSED_ROUTE
#define FUSED_ROUTE 1
#endif
#ifndef ATT_DIFF_FUSED
#define ATT_DIFF_FUSED 1
#endif
#ifndef USE_NAIVE_ATTN
#define USE_NAIVE_ATTN 0
#endif

constexpr size_t MiB = 1u << 20;
constexpr size_t WS_CTL = 0, CTL_ZERO_BYTES = 1 * MiB;
constexpr size_t WS_MOD = 1 * MiB;
constexpr size_t WS_ROPE = 2 * MiB;
constexpr size_t WS_ROUTE = 3 * MiB;
constexpr size_t WS_WE_IN = 4 * MiB;
constexpr size_t WS_WE_UQ = 15 * MiB;
constexpr size_t WS_WE_UKV = 17 * MiB;
constexpr size_t WS_WE_OUT = 19 * MiB;
constexpr size_t WS_WO_IN = 27 * MiB;
constexpr size_t WS_WO_OUT = 45 * MiB;
constexpr size_t WS_WR = 53 * MiB;
constexpr size_t WS_WGU = 60 * MiB;
constexpr size_t WS_WDN = 572 * MiB;
constexpr size_t WS_H = 828 * MiB;
constexpr size_t WS_A1 = 972 * MiB;
constexpr size_t WS_MIX = 1044 * MiB;
constexpr size_t WS_R = 1116 * MiB;
constexpr size_t WS_Y1 = WS_R;
constexpr size_t WS_CQN = WS_R + 162 * MiB;
constexpr size_t WS_CKVN = WS_R + 180 * MiB;
constexpr size_t WS_QB = WS_R + 198 * MiB;
constexpr size_t WS_KV = WS_R + 252 * MiB;
constexpr size_t WS_KB = WS_R + 324 * MiB;
constexpr size_t WS_XS = WS_R;
constexpr size_t WS_U = WS_R + 176 * MiB;
constexpr size_t WS_YS = WS_R + 264 * MiB;
constexpr size_t WS_LG = WS_R + 440 * MiB;
constexpr size_t WS_POS = WS_R + 460 * MiB;
constexpr int POSCAP = 18432;
constexpr size_t WS_END = WS_R + 466 * MiB;
constexpr int RKS = 4;
constexpr int CW_CNT = 64;
constexpr int CW_NRT = 256;
constexpr int CW_TEXP = 512;
constexpr int CW_BAR = 4096;
constexpr int CW_SLOT = 16384;

constexpr int RING_OFF = 0, RING_BYTES = 131072;
constexpr int LDSCTL_OFF = RING_BYTES, MISC_OFF = LDSCTL_OFF + 320;
constexpr int LDS_BYTES = 147456;
constexpr int LDS_TAB = 135168;

#define GAS __attribute__((address_space(1)))
#define LAS __attribute__((address_space(3)))
typedef unsigned short bf16;
typedef unsigned v4u __attribute__((ext_vector_type(4)));
typedef unsigned v2u __attribute__((ext_vector_type(2)));
typedef float f32x4 __attribute__((ext_vector_type(4)));
typedef GAS unsigned gu32;
#define RLX_AGENT __ATOMIC_RELAXED, __HIP_MEMORY_SCOPE_AGENT
#define LDS_WAIT() asm volatile("s_waitcnt lgkmcnt(0)" ::: "memory")
#define VM_WAIT() asm volatile("s_waitcnt vmcnt(0)" ::: "memory")
__device__ __forceinline__ unsigned f2bf(float f) { unsigned u = __builtin_bit_cast(unsigned, f); return (u + 0x7fffu + ((u >> 16) & 1u)) >> 16; }
__device__ __forceinline__ unsigned pk2(float lo, float hi) { return f2bf(lo) | (f2bf(hi) << 16); }
__device__ __forceinline__ float bf2f(unsigned short h) { return __builtin_bit_cast(float, (unsigned)h << 16); }
__device__ __forceinline__ float bflo(unsigned w) { return __builtin_bit_cast(float, w << 16); }
__device__ __forceinline__ float bfhi(unsigned w) { return __builtin_bit_cast(float, w & 0xffff0000u); }
__device__ __forceinline__ float wave_sum(float v) {
#pragma unroll
    for (int o = 1; o < 64; o <<= 1) v += __shfl_xor(v, o);
    return v;
}
__device__ __forceinline__ float wave_max(float v) {
#pragma unroll
    for (int o = 1; o < 64; o <<= 1) v = fmaxf(v, __shfl_xor(v, o));
    return v;
}
#define XB_TMO      128
#define XB_XCNT(j)  (256  + 64 * (j))
#define XB_XSUB(j)  (1280 + 64 * (j))
#define XB_XGEN(j)  (2304 + 64 * (j))
#define XB_TOP      3328
#define XB_TOPGEN   3392
#define XCD_BAR_WORDS 3456
#define XB_SPIN_CAP (1u << 18)

__device__ __forceinline__ unsigned xb_ld(unsigned* p)              { return __hip_atomic_load(p, __ATOMIC_RELAXED, __HIP_MEMORY_SCOPE_AGENT); }
__device__ __forceinline__ unsigned xb_add(unsigned* p, unsigned v) { return __hip_atomic_fetch_add(p, v, __ATOMIC_RELAXED, __HIP_MEMORY_SCOPE_AGENT); }
__device__ __forceinline__ unsigned xb_xcc_id() { return (unsigned)__builtin_amdgcn_s_getreg((3 << 11) | 20) & 0xFu; }
#define XB_SPIN(cond, bar) do { unsigned _sp = 0; while (cond) { __builtin_amdgcn_s_sleep(1); \
    if ((++_sp & 255u) == 0u) { if (xb_ld(&(bar)[XB_TMO])) break; if (_sp > XB_SPIN_CAP) { atomicAdd(&(bar)[XB_TMO], 1u); break; } } } } while (0)

struct XcdBarrier {
    unsigned* bar; unsigned x;
    volatile LAS unsigned* st;
};

__device__ __forceinline__ XcdBarrier xcd_barrier_post(unsigned* bar, volatile LAS unsigned* st) {
    XcdBarrier b; b.bar = bar; b.x = xb_xcc_id(); b.st = st;
    if (threadIdx.x == 0) (void)xb_add(&bar[XB_XCNT(b.x)], 1u);
    return b;
}
__device__ __forceinline__ void xcd_barrier_complete(unsigned* bar, unsigned x, unsigned& nloc, unsigned& nx) {
    const unsigned G = gridDim.x * gridDim.y * gridDim.z;
    unsigned sum, cnt, mine, sp = 0u;
    for (;;) {
        sum = 0u; cnt = 0u; mine = 0u;
#pragma unroll
        for (unsigned j = 0; j < 16; ++j) { const unsigned c = xb_ld(&bar[XB_XCNT(j)]); sum += c; cnt += (c > 0u) ? 1u : 0u; mine = (j == x) ? c : mine; }
        if (sum == G) break;
        __builtin_amdgcn_s_sleep(1);
        if ((++sp & 255u) == 0u) { if (xb_ld(&bar[XB_TMO])) break; if (sp > XB_SPIN_CAP) { atomicAdd(&bar[XB_TMO], 1u); break; } }
    }
    nloc = mine > 0u ? mine : 1u; nx = cnt > 0u ? cnt : 1u;
}

__device__ __forceinline__ void xcd_barrier(const XcdBarrier& b) {
    asm volatile("s_waitcnt vmcnt(0)" ::: "memory");
    __syncthreads();
    if (threadIdx.x == 0) {
        unsigned* bar = b.bar;
        __builtin_amdgcn_s_waitcnt(0);
        unsigned nloc = b.st[0], nx = b.st[1];
        if (nloc == 0u) { xcd_barrier_complete(bar, b.x, nloc, nx); b.st[0] = nloc; b.st[1] = nx; }
        const unsigned old = xb_add(&bar[XB_XSUB(b.x)], 1u);
        const unsigned gen = old / nloc;
        if (old + 1u == (gen + 1u) * nloc) {
            __builtin_amdgcn_fence(__ATOMIC_RELEASE, "agent");
            asm volatile("s_waitcnt vmcnt(0)" ::: "memory");
            const unsigned og = xb_add(&bar[XB_TOP], 1u);
            const unsigned tg = og / nx;
            if (og + 1u == (tg + 1u) * nx) xb_add(&bar[XB_TOPGEN], 1u);
            else XB_SPIN(xb_ld(&bar[XB_TOPGEN]) == tg, bar);
            __builtin_amdgcn_fence(__ATOMIC_ACQUIRE, "agent");
            xb_add(&bar[XB_XGEN(b.x)], 1u);
            asm volatile("s_waitcnt vmcnt(0)" ::: "memory");
        } else {
            XB_SPIN(xb_ld(&bar[XB_XGEN(b.x)]) == gen, bar);
            __builtin_amdgcn_fence(__ATOMIC_ACQUIRE, "agent");
            asm volatile("s_waitcnt vmcnt(0)" ::: "memory");
        }
    }
    __syncthreads();
}

struct Frame {
    LAS unsigned char* lds;
    volatile LAS unsigned* MISC;
    gu32* ctl;
    unsigned char* ws;
    int tid, lane, wave, vcu, G;
};
struct LocalId { int tid, lane, wave; };
__device__ __forceinline__ LocalId local_id_w(int wave) { int t = wave * 64 + lane_id_(); asm volatile("" : "+v"(t)); LocalId l; l.tid = t; l.lane = t & 63; l.wave = wave; return l; }
#define local_id() local_id_w(F.wave)
struct Args { const float* in[35]; float* out; unsigned char* ws; int ph_lo, ph_hi; };
enum { I_X = 0, I_C, I_CTX, I_CCTX, I_MODW, I_MODB, I_EWIN, I_EWOUT, I_AQN, I_AKN, I_BCQN, I_BWUQ, I_BCKVN, I_BWUKV, I_BQN, I_BKN, I_OWIN, I_OWOUT,
       I_CQN, I_CKN, I_LQ1, I_LK1, I_LQ2, I_LK2, I_SUBLN, I_DQN, I_DKN, I_SINK, I_WRG, I_BRG, I_WRE, I_BRE, I_WG, I_WU, I_WD };

__device__ __forceinline__ int mod_index(int row) { const int b = row / TPB; return (row - b * TPB) < CTX ? 8 : b; }

__device__ __forceinline__ void transpose_item(const float* W, int N, int k0, int n0, bf16* dst, int Kd, LAS float* scr, int lane) {
    f32x4 v[8];
    const int kr = lane >> 3, cq = lane & 7;
#pragma unroll
    for (int i = 0; i < 8; ++i) v[i] = *(const f32x4*)(W + (size_t)(k0 + kr + 8 * i) * N + n0 + 4 * cq);
#pragma unroll
    for (int i = 0; i < 8; ++i) { LAS float* d = scr + (kr + 8 * i) * 33 + 4 * cq; d[0] = v[i].x; d[1] = v[i].y; d[2] = v[i].z; d[3] = v[i].w; }
    LDS_WAIT(); asm volatile("" ::: "memory");
    const int c = lane & 7;
#pragma unroll
    for (int j = 0; j < 4; ++j) { const int n = (lane >> 3) + 8 * j; const LAS float* s = scr + (8 * c) * 33 + n;
        v4u o; o.x = pk2(s[0 * 33], s[1 * 33]); o.y = pk2(s[2 * 33], s[3 * 33]); o.z = pk2(s[4 * 33], s[5 * 33]); o.w = pk2(s[6 * 33], s[7 * 33]);
        *(GAS v4u*)(dst + (size_t)n * Kd + k0 + 8 * c) = o; }
    LDS_WAIT(); asm volatile("" ::: "memory");
}
__device__ __forceinline__ void small_transpose(const float* W, int K, int N, bf16* WT, int item, LAS float* scr, int lane) {
    const int nblk = N / 32, kb = item / nblk, nb = item - kb * nblk;
    transpose_item(W, N, kb * 64, nb * 32, WT + (size_t)(nb * 32) * K, K, scr, lane);
}
__device__ __forceinline__ void p0_prologue(const Frame& F, const Args& a) {
    const LocalId L_ = local_id(); (void)L_;
    const int gt = F.vcu * 512 + L_.tid, NT = F.G * 512;
    {
        float2* t128 = (float2*)(F.ws + WS_ROPE); float2* t64 = (float2*)(F.ws + WS_ROPE + 16384);
        for (int i = gt; i < 3072; i += NT) {
            if (i < 2048) { const int pos = i >> 5, f = i & 31; const float inv = 1.0f / powf(10000.0f, (float)f / 32.0f); const float ang = (float)pos * inv; t128[i] = make_float2(cosf(ang), sinf(ang)); }
            else { const int k = i - 2048, pos = k >> 4, f = k & 15; const float inv = 1.0f / powf(10000.0f, (float)f / 16.0f); const float ang = (float)pos * inv; t64[k] = make_float2(cosf(ang), sinf(ang)); }
        }
    }
    { float* gsub = (float*)(F.ws + WS_ROPE + 32768); for (int i = gt; i < 128; i += NT) gsub[i] = a.in[I_SUBLN][i] * (1.0f - LAMBDA_INIT); }
    {
        bf16* WR = (bf16*)(F.ws + WS_WR);
        for (int i = gt; i < 2 * 256 * 2048; i += NT) { const int l = i >> 19, r = (i >> 11) & 255, k = i & 2047;
            float v = 0.f; if (r < 4) v = a.in[I_WRG][((size_t)l * 2048 + k) * 4 + r]; else if (r < 36) v = a.in[I_WRE][((size_t)l * 2048 + k) * 32 + (r - 4)];
            WR[i] = (bf16)f2bf(v); }
        v4u* z = (v4u*)((bf16*)(F.ws + WS_WE_IN) + (size_t)2624 * 2048);
        for (int i = gt; i < 192 * 2048 / 8; i += NT) z[i] = (v4u){0u, 0u, 0u, 0u};
    }
    {
        LAS float* sl = (LAS float*)(F.lds + RING_OFF);
        LAS float* red = (LAS float*)(F.lds + RING_OFF + 73728);
        for (int i = L_.tid; i < 9 * 2048; i += 512) { const int j = i >> 11, k = i & 2047; const float v = j < 8 ? a.in[I_C][j * 2048 + k] : a.in[I_CCTX][k]; sl[i] = v / (1.0f + expf(-v)); }
        __syncthreads();
        float* MOD = (float*)(F.ws + WS_MOD);
        const int cg = L_.lane & 7, ks = L_.lane >> 3;
        for (int item = blockIdx.x; item < 768; item += F.G) {
            const int layer = item / 384, chunk = item - layer * 384, col0 = chunk * 32;
            const float* W = a.in[I_MODW] + (size_t)layer * 2048 * 12288 + col0 + cg * 4;
            f32x4 acc[9];
#pragma unroll
            for (int j = 0; j < 9; ++j) acc[j] = (f32x4){0.f, 0.f, 0.f, 0.f};
#pragma unroll 8
            for (int it = 0; it < 32; ++it) { const int k = L_.wave * 256 + it * 8 + ks; const f32x4 w = *(const f32x4*)(W + (size_t)k * 12288);
#pragma unroll
                for (int j = 0; j < 9; ++j) { const float s = sl[j * 2048 + k]; acc[j] = acc[j] + w * s; } }
#pragma unroll
            for (int j = 0; j < 9; ++j)
#pragma unroll
                for (int e = 0; e < 4; ++e) { float v = acc[j][e]; v += __shfl_xor(v, 8); v += __shfl_xor(v, 16); v += __shfl_xor(v, 32); acc[j][e] = v; }
            if (L_.lane < 8) {
#pragma unroll
                for (int j = 0; j < 9; ++j)
#pragma unroll
                    for (int e = 0; e < 4; ++e) red[(L_.wave * 9 + j) * 32 + cg * 4 + e] = acc[j][e]; }
            __syncthreads();
            if (L_.tid < 288) { const int j = L_.tid >> 5, cc = L_.tid & 31; float s = a.in[I_MODB][layer * 12288 + col0 + cc];
#pragma unroll
                for (int w = 0; w < 8; ++w) s += red[(w * 9 + j) * 32 + cc];
                MOD[((size_t)layer * 9 + j) * 12288 + col0 + cc] = s; }
            __syncthreads();
        }
    }
    {
        LAS float* scr = (LAS float*)(F.lds + RING_OFF + L_.wave * 16384);
        const int gw = F.vcu * NWAVES + L_.wave, NGW = F.G * NWAVES;
        constexpr int I0 = 32 * 82, I1 = 8 * 48, I2 = 8 * 64, I3 = 32 * 64, I4 = 32 * 144, I5 = 32 * 64, NSMALL = I0 + I1 + I2 + I3 + I4 + I5;
#if MOE_F32B
        constexpr int NMOE = 0;
#else
        constexpr int NMOE = 64 * 3072;
#endif
        for (int it = gw; it < NSMALL + NMOE; it += NGW) {
            int r = it;
            if (r < NSMALL) {
                if (r < I0) { small_transpose(a.in[I_EWIN], 2048, 2624, (bf16*)(F.ws + WS_WE_IN), r, scr, L_.lane); continue; } r -= I0;
                if (r < I1) { small_transpose(a.in[I_BWUQ], 512, 1536, (bf16*)(F.ws + WS_WE_UQ), r, scr, L_.lane); continue; } r -= I1;
                if (r < I2) { small_transpose(a.in[I_BWUKV], 512, 2048, (bf16*)(F.ws + WS_WE_UKV), r, scr, L_.lane); continue; } r -= I2;
                if (r < I3) { small_transpose(a.in[I_EWOUT], 2048, 2048, (bf16*)(F.ws + WS_WE_OUT), r, scr, L_.lane); continue; } r -= I3;
                if (r < I4) { small_transpose(a.in[I_OWIN], 2048, 4608, (bf16*)(F.ws + WS_WO_IN), r, scr, L_.lane); continue; } r -= I4;
                small_transpose(a.in[I_OWOUT], 2048, 2048, (bf16*)(F.ws + WS_WO_OUT), r, scr, L_.lane); continue;
            }
            r -= NSMALL;
            const int le = r / 3072, q = r - le * 3072, which = q >> 10, ri = q & 1023;
            if (which < 2) {
                const int kb = ri >> 5, nb = ri & 31, n0 = nb * 32;
                const float* W = a.in[which == 0 ? I_WG : I_WU] + (size_t)le * 2048 * 1024;
                bf16* dst = (bf16*)(F.ws + WS_WGU) + (size_t)le * 2048 * 2048 + (size_t)((n0 >> 7) * 256 + which * 128 + (n0 & 127)) * 2048;
                transpose_item(W, 1024, kb * 64, n0, dst, 2048, scr, L_.lane);
            } else {
                const int kb = ri >> 6, nb = ri & 63, n0 = nb * 32;
                const float* W = a.in[I_WD] + (size_t)le * 1024 * 2048;
                bf16* dst = (bf16*)(F.ws + WS_WDN) + (size_t)le * 2048 * 1024 + (size_t)n0 * 1024;
                transpose_item(W, 2048, kb * 64, n0, dst, 1024, scr, L_.lane);
            }
        }
    }
}

__device__ __forceinline__ void modulate_store(const f32x4 (&v)[8], const float* shift, const float* scale, bf16* orow, int lane) {
    float ss = 0.f;
#pragma unroll
    for (int j = 0; j < 8; ++j) ss += (v[j].x * v[j].x + v[j].y * v[j].y) + (v[j].z * v[j].z + v[j].w * v[j].w);
    ss = wave_sum(ss);
    const float r = 1.0f / sqrtf(ss * (1.0f / 2048.0f) + NORM_EPS);
#pragma unroll
    for (int j = 0; j < 8; ++j) { const f32x4 sh = ((const f32x4*)shift)[lane + 64 * j], sc = ((const f32x4*)scale)[lane + 64 * j];
        const f32x4 y = v[j] * r * (sc + 1.0f) + sh; v2u o; o.x = pk2(y.x, y.y); o.y = pk2(y.z, y.w); ((v2u*)orow)[lane + 64 * j] = o; }
}
__device__ __forceinline__ void moe_combine_load(const bf16* YS, const int* rec, const LAS int* offs, int lane, f32x4 (&y)[8]) {
    const int s0 = offs[rec[0]] + rec[2], s1 = offs[rec[1]] + rec[3]; const float w0 = __builtin_bit_cast(float, rec[4]), w1 = __builtin_bit_cast(float, rec[5]);
    const v2u* p0 = (const v2u*)(YS + (size_t)s0 * 2048); const v2u* p1 = (const v2u*)(YS + (size_t)s1 * 2048);
#pragma unroll
    for (int j = 0; j < 8; ++j) { const v2u a = p0[lane + 64 * j], b = p1[lane + 64 * j];
        y[j].x = w0 * bflo(a.x) + w1 * bflo(b.x); y[j].y = w0 * bfhi(a.x) + w1 * bfhi(b.x); y[j].z = w0 * bflo(a.y) + w1 * bflo(b.y); y[j].w = w0 * bfhi(a.y) + w1 * bfhi(b.y); }
}

__device__ __forceinline__ int moe_tables(const Frame& F, int layer, int tid) {
    LAS int* texp = (LAS int*)(F.lds + LDS_TAB); LAS int* frt = texp + 256; LAS int* offs = frt + 40;
    if (tid < 64) {
        const int e = tid & 31;
        const unsigned c = __hip_atomic_load((unsigned*)(F.ctl + CW_CNT + layer * 64 + e), RLX_AGENT);
        const int pad = (int)((c + 255u) & ~255u);
        int incl = pad;
#pragma unroll
        for (int d = 1; d < 32; d <<= 1) { const int v = __shfl_up(incl, d); if ((tid & 31) >= d) incl += v; }
        const int excl = incl - pad;
        if (tid < 32) { offs[e] = excl; frt[e] = excl >> 8; for (int r = excl >> 8; r < (incl >> 8); ++r) texp[r] = e; if (e == 31) { offs[NE] = incl; frt[NE] = incl >> 8; } }
    }
    __syncthreads();
    return frt[NE];
}
__device__ __forceinline__ void hrow_load(const bf16* hrow, int lane, f32x4 (&v)[8]) {
#pragma unroll
    for (int q = 0; q < 8; ++q) { const v2u w = ((const v2u*)hrow)[lane + 64 * q]; v[q].x = bflo(w.x); v[q].y = bfhi(w.x); v[q].z = bflo(w.y); v[q].w = bfhi(w.y); }
}
__device__ __forceinline__ void hrow_store(bf16* hrow, int lane, const f32x4 (&v)[8]) {
#pragma unroll
    for (int q = 0; q < 8; ++q) { v2u o; o.x = pk2(v[q].x, v[q].y); o.y = pk2(v[q].z, v[q].w); ((v2u*)hrow)[lane + 64 * q] = o; }
}
__device__ __forceinline__ const float* l0_src_row(const Args& a, int row, int& j) {
    const int b = row / TPB, r = row - b * TPB; j = r < CTX ? 8 : b;
    return r < CTX ? a.in[I_CTX] + (size_t)(b * CTX + r) * DM : a.in[I_X] + (size_t)(b * SEQ + (r - CTX)) * DM;
}
__device__ __forceinline__ void p_l0_mod1(const Frame& F, const Args& a) {
    const LocalId L_ = local_id(); (void)L_;
    const int gw = F.vcu * NWAVES + L_.wave, NGW = F.G * NWAVES;
    const float* MOD = (const float*)(F.ws + WS_MOD); bf16* A1 = (bf16*)(F.ws + WS_A1);
    for (int r0 = gw; r0 < T; r0 += 2 * NGW) {
        const int r1 = r0 + NGW; const bool ok1 = r1 < T;
        int j0, j1 = 0; const float* s0 = l0_src_row(a, r0, j0); const float* s1 = ok1 ? l0_src_row(a, r1, j1) : s0;
        f32x4 v0[8], v1[8];
#pragma unroll
        for (int q = 0; q < 8; ++q) v0[q] = ((const f32x4*)s0)[L_.lane + 64 * q];
#pragma unroll
        for (int q = 0; q < 8; ++q) v1[q] = ((const f32x4*)s1)[L_.lane + 64 * q];
        const float* m0 = MOD + (size_t)(0 * 9 + j0) * 12288;
        modulate_store(v0, m0 + 0 * 2048, m0 + 1 * 2048, A1 + (size_t)r0 * DM, L_.lane);
        if (ok1) {
            const float* m1 = MOD + (size_t)(0 * 9 + j1) * 12288;
            modulate_store(v1, m1 + 0 * 2048, m1 + 1 * 2048, A1 + (size_t)r1 * DM, L_.lane);
        }
    }
}
__device__ __forceinline__ void p_mod2(const Frame& F, int layer) {
    const LocalId L_ = local_id(); (void)L_;
    const int gw = F.vcu * NWAVES + L_.wave, NGW = F.G * NWAVES;
    const float* MOD = (const float*)(F.ws + WS_MOD); const bf16* H = (const bf16*)(F.ws + WS_H); bf16* A1 = (bf16*)(F.ws + WS_A1);
    for (int r0 = gw; r0 < T; r0 += 2 * NGW) {
        const int r1 = r0 + NGW; const int j0 = mod_index(r0), j1 = r1 < T ? mod_index(r1) : 8;
        const bool ok0 = !(layer == 1 && j0 == 8), ok1 = r1 < T && !(layer == 1 && j1 == 8);
        f32x4 v0[8], v1[8];
        if (ok0) hrow_load(H + (size_t)r0 * DM, L_.lane, v0);
        if (ok1) hrow_load(H + (size_t)r1 * DM, L_.lane, v1);
        if (ok0) { const float* m = MOD + (size_t)(layer * 9 + j0) * 12288; modulate_store(v0, m + 3 * 2048, m + 4 * 2048, A1 + (size_t)r0 * DM, L_.lane); }
        if (ok1) { const float* m = MOD + (size_t)(layer * 9 + j1) * 12288; modulate_store(v1, m + 3 * 2048, m + 4 * 2048, A1 + (size_t)r1 * DM, L_.lane); }
    }
}
__device__ __forceinline__ void p_l1_mod1(const Frame& F, size_t hdst_off = WS_H, size_t adst_off = WS_A1) {
    const LocalId L_ = local_id(); (void)L_;
    const int gw = F.vcu * NWAVES + L_.wave, NGW = F.G * NWAVES;
    const float* MOD = (const float*)(F.ws + WS_MOD); const bf16* H = (const bf16*)(F.ws + WS_H); bf16* Hd = (bf16*)(F.ws + hdst_off); bf16* A1 = (bf16*)(F.ws + adst_off);
    const bf16* YS = (const bf16*)(F.ws + WS_YS); const int* ROUTE = (const int*)(F.ws + WS_ROUTE);
    (void)moe_tables(F, 0, L_.tid); const LAS int* offs = (const LAS int*)(F.lds + LDS_TAB) + 296;
    for (int r0 = gw; r0 < T; r0 += 2 * NGW) {
        const int r1 = r0 + NGW; const bool ok1 = r1 < T; const int rr1 = ok1 ? r1 : r0;
        const int j0 = mod_index(r0), j1 = mod_index(rr1);
        f32x4 v0[8], v1[8], y0[8], y1[8];
        moe_combine_load(YS, ROUTE + (size_t)r0 * 8, offs, L_.lane, y0);
        moe_combine_load(YS, ROUTE + (size_t)rr1 * 8, offs, L_.lane, y1);
        hrow_load(H + (size_t)r0 * DM, L_.lane, v0);
        hrow_load(H + (size_t)rr1 * DM, L_.lane, v1);
        const float* g0 = MOD + (size_t)(0 * 9 + j0) * 12288 + 5 * 2048; const float* g1 = MOD + (size_t)(0 * 9 + j1) * 12288 + 5 * 2048;
#pragma unroll
        for (int q = 0; q < 8; ++q) { v0[q] = v0[q] + ((const f32x4*)g0)[L_.lane + 64 * q] * y0[q]; v1[q] = v1[q] + ((const f32x4*)g1)[L_.lane + 64 * q] * y1[q]; }
        if (j0 != 8) hrow_store(Hd + (size_t)r0 * DM, L_.lane, v0);
        const float* m0 = MOD + (size_t)(1 * 9 + j0) * 12288;
        modulate_store(v0, m0 + 0 * 2048, m0 + 1 * 2048, A1 + (size_t)r0 * DM, L_.lane);
        if (ok1) {
            if (j1 != 8) hrow_store(Hd + (size_t)r1 * DM, L_.lane, v1);
            const float* m1 = MOD + (size_t)(1 * 9 + j1) * 12288;
            modulate_store(v1, m1 + 0 * 2048, m1 + 1 * 2048, A1 + (size_t)r1 * DM, L_.lane);
        }
    }
}
__device__ __forceinline__ void p_final(const Frame& F, float* out) {
    const LocalId L_ = local_id(); (void)L_;
    const int gw = F.vcu * NWAVES + L_.wave, NGW = F.G * NWAVES;
    const float* MOD = (const float*)(F.ws + WS_MOD); const bf16* H = (const bf16*)(F.ws + WS_H);
    const bf16* YS = (const bf16*)(F.ws + WS_YS); const int* ROUTE = (const int*)(F.ws + WS_ROUTE);
    (void)moe_tables(F, 1, L_.tid); const LAS int* offs = (const LAS int*)(F.lds + LDS_TAB) + 296;
    for (int i0 = gw; i0 < NB * SEQ; i0 += 2 * NGW) {
        const int i1 = i0 + NGW; const bool ok1 = i1 < NB * SEQ; const int ii1 = ok1 ? i1 : i0;
        const int b0 = i0 / SEQ, row0 = b0 * TPB + CTX + (i0 - b0 * SEQ), b1 = ii1 / SEQ, row1 = b1 * TPB + CTX + (ii1 - b1 * SEQ);
        f32x4 y0[8], y1[8], h0[8], h1[8];
        moe_combine_load(YS, ROUTE + (size_t)row0 * 8, offs, L_.lane, y0);
        moe_combine_load(YS, ROUTE + (size_t)row1 * 8, offs, L_.lane, y1);
        hrow_load(H + (size_t)row0 * DM, L_.lane, h0);
        hrow_load(H + (size_t)row1 * DM, L_.lane, h1);
        const float* g0 = MOD + (size_t)(1 * 9 + b0) * 12288 + 5 * 2048; const float* g1 = MOD + (size_t)(1 * 9 + b1) * 12288 + 5 * 2048;
#pragma unroll
        for (int q = 0; q < 8; ++q) ((f32x4*)(out + (size_t)i0 * DM))[L_.lane + 64 * q] = h0[q] + ((const f32x4*)g0)[L_.lane + 64 * q] * y0[q];
        if (ok1) {
#pragma unroll
            for (int q = 0; q < 8; ++q) ((f32x4*)(out + (size_t)i1 * DM))[L_.lane + 64 * q] = h1[q] + ((const f32x4*)g1)[L_.lane + 64 * q] * y1[q]; }
    }
}

__device__ __forceinline__ void head128_norm_rope(const bf16* p, bf16* pd, const float* gain, bool rope, int prow, int pcol, const float2* t128, int lane) {
    const float x0 = bf2f(p[lane]), x1 = bf2f(p[lane + 64]);
    const float ss = wave_sum(x0 * x0 + x1 * x1);
    const float r = 1.0f / sqrtf(ss * (1.0f / 128.0f) + NORM_EPS);
    float y0 = x0 * r * gain[lane], y1 = x1 * r * gain[lane + 64];
    if (rope) {
        const int f = lane & 31; const float2 cr = t128[prow * 32 + f], cc = t128[pcol * 32 + f];
        const float p0 = __shfl_xor(y0, 32), p1 = __shfl_xor(y1, 32); const float sg = (lane & 32) ? 1.0f : -1.0f;
        y0 = y0 * cr.x + sg * p0 * cr.y; y1 = y1 * cc.x + sg * p1 * cc.y;
    }
    pd[lane] = (bf16)f2bf(y0); pd[lane + 64] = (bf16)f2bf(y1);
}
__device__ __forceinline__ float rope64_apply(float y, int prow, int pcol, const float2* t64, int lane) {
    const int f = lane & 15, pos = (lane & 32) ? pcol : prow; const float2 cs = t64[pos * 16 + f];
    const float pr = __shfl_xor(y, 16); const float sg = (lane & 16) ? 1.0f : -1.0f;
    return y * cs.x + sg * pr * cs.y;
}
__device__ __forceinline__ void head64_norm_rope(const bf16* p, bf16* pd, const float* gain, bool rope, int prow, int pcol, const float2* t64, int lane) {
    const float x = bf2f(p[lane]);
    const float ss = wave_sum(x * x);
    const float r = 1.0f / sqrtf(ss * (1.0f / 64.0f) + NORM_EPS);
    float y = x * r * gain[lane];
    if (rope) y = rope64_apply(y, prow, pcol, t64, lane);
    pd[lane] = (bf16)f2bf(y);
}
__device__ __forceinline__ void norm512(const bf16* src, const float* gain, bf16* dst, int lane) {
    const v4u w = ((const v4u*)src)[lane];
    float x[8] = {bflo(w.x), bfhi(w.x), bflo(w.y), bfhi(w.y), bflo(w.z), bfhi(w.z), bflo(w.w), bfhi(w.w)};
    float ss = 0.f;
#pragma unroll
    for (int i = 0; i < 8; ++i) ss += x[i] * x[i];
    ss = wave_sum(ss);
    const float r = 1.0f / sqrtf(ss * (1.0f / 512.0f) + NORM_EPS);
    const f32x4 g0 = ((const f32x4*)gain)[2 * lane], g1 = ((const f32x4*)gain)[2 * lane + 1];
    v4u o; o.x = pk2(x[0] * r * g0.x, x[1] * r * g0.y); o.y = pk2(x[2] * r * g0.z, x[3] * r * g0.w); o.z = pk2(x[4] * r * g1.x, x[5] * r * g1.y); o.w = pk2(x[6] * r * g1.z, x[7] * r * g1.w);
    ((v4u*)dst)[lane] = o;
}

__device__ __forceinline__ void unpack8(const v4u w, float (&x)[8]) { x[0] = bflo(w.x); x[1] = bfhi(w.x); x[2] = bflo(w.y); x[3] = bfhi(w.y); x[4] = bflo(w.z); x[5] = bfhi(w.z); x[6] = bflo(w.w); x[7] = bfhi(w.w); }
__device__ __forceinline__ v4u pack8(const float (&y)[8]) { v4u o; o.x = pk2(y[0], y[1]); o.y = pk2(y[2], y[3]); o.z = pk2(y[4], y[5]); o.w = pk2(y[6], y[7]); return o; }
__device__ __forceinline__ float sumsq8(const float (&x)[8]) { return ((x[0] * x[0] + x[1] * x[1]) + (x[2] * x[2] + x[3] * x[3])) + ((x[4] * x[4] + x[5] * x[5]) + (x[6] * x[6] + x[7] * x[7])); }
template <int GS> __device__ __forceinline__ float group_sum(float v) {
    v += __shfl_xor(v, 1); v += __shfl_xor(v, 2); v += __shfl_xor(v, 4); if (GS == 16) v += __shfl_xor(v, 8); return v;
}
template <int RD> __device__ __forceinline__ void rope8(float (&y)[8], int l, int prow, int pcol, const float2* tab) {
    constexpr int NF = RD / 4, LQ = NF / 8;
    const int quarter = l / LQ, f0 = (l % LQ) * 8, pos = (quarter >= 2) ? pcol : prow;
    const float sg = (quarter & 1) ? 1.0f : -1.0f;
    const f32x4* t = (const f32x4*)(tab + pos * NF + f0);
    const f32x4 c0 = t[0], c1 = t[1], c2 = t[2], c3 = t[3];
    float p[8];
#pragma unroll
    for (int j = 0; j < 8; ++j) p[j] = __shfl_xor(y[j], LQ);
    y[0] = y[0] * c0.x + sg * p[0] * c0.y; y[1] = y[1] * c0.z + sg * p[1] * c0.w; y[2] = y[2] * c1.x + sg * p[2] * c1.y; y[3] = y[3] * c1.z + sg * p[3] * c1.w;
    y[4] = y[4] * c2.x + sg * p[4] * c2.y; y[5] = y[5] * c2.z + sg * p[5] * c2.w; y[6] = y[6] * c3.x + sg * p[6] * c3.y; y[7] = y[7] * c3.z + sg * p[7] * c3.w;
}
template <int DIM> __device__ __forceinline__ v4u head_chunk(const v4u w, const float* gain, bool rope, int prow, int pcol, const float2* tab, int lane) {
    constexpr int GS = DIM / 8; const int l = lane & (GS - 1);
    float x[8]; unpack8(w, x);
    const float ss = group_sum<GS>(sumsq8(x));
    const float r = 1.0f / sqrtf(ss * (1.0f / DIM) + NORM_EPS);
    const f32x4 g0 = ((const f32x4*)gain)[2 * l], g1 = ((const f32x4*)gain)[2 * l + 1];
    x[0] *= r * g0.x; x[1] *= r * g0.y; x[2] *= r * g0.z; x[3] *= r * g0.w; x[4] *= r * g1.x; x[5] *= r * g1.y; x[6] *= r * g1.z; x[7] *= r * g1.w;
    if (rope) rope8<DIM>(x, l, prow, pcol, tab);
    return pack8(x);
}
__device__ __forceinline__ v4u norm512_chunk(const v4u w, const float* gain, int lane) {
    float x[8]; unpack8(w, x);
    const float ss = wave_sum(sumsq8(x));
    const float r = 1.0f / sqrtf(ss * (1.0f / 512.0f) + NORM_EPS);
    const f32x4 g0 = ((const f32x4*)gain)[2 * lane], g1 = ((const f32x4*)gain)[2 * lane + 1];
    x[0] *= r * g0.x; x[1] *= r * g0.y; x[2] *= r * g0.z; x[3] *= r * g0.w; x[4] *= r * g1.x; x[5] *= r * g1.y; x[6] *= r * g1.z; x[7] *= r * g1.w;
    return pack8(x);
}

__device__ __forceinline__ void p_even_post1(const Frame& F, const Args& a, size_t ydst_off = WS_Y1) {
    const LocalId L_ = local_id(); (void)L_;
    const int gw = F.vcu * NWAVES + L_.wave, NGW = F.G * NWAVES, lane = L_.lane;
    const bf16* Y1 = (const bf16*)(F.ws + WS_Y1); bf16* CQN = (bf16*)(F.ws + WS_CQN); bf16* CKVN = (bf16*)(F.ws + WS_CKVN);
    const float2* t128 = (const float2*)(F.ws + WS_ROPE);
    for (int row = gw; row < T; row += NGW) {
        const int b = row / TPB, r = row - b * TPB; const bool xr = r >= CTX; const int s = r - CTX, prow = xr ? (s >> 6) : 0, pcol = xr ? (s & 63) : 0;
        const v4u* y = (const v4u*)(Y1 + (size_t)row * EVEN_IN_P); v4u* yd = (v4u*)((bf16*)(F.ws + ydst_off) + (size_t)row * EVEN_IN_P);
        const v4u k0 = y[128 + (lane & 31)], cq = y[192 + lane], ckv = y[256 + lane];
        const v4u ok0 = head_chunk<128>(k0, a.in[I_AKN], xr, prow, pcol, t128, lane);
        const v4u ocq = norm512_chunk(cq, a.in[I_BCQN], lane), ockv = norm512_chunk(ckv, a.in[I_BCKVN], lane);
        if (lane < 32) yd[128 + lane] = ok0;
        ((v4u*)(CQN + (size_t)row * 512))[lane] = ocq; ((v4u*)(CKVN + (size_t)row * 512))[lane] = ockv;
    }
}
__device__ __forceinline__ void p_even_post2(const Frame& F, const Args& a, size_t qdst_off = WS_QB, size_t kdst_off = WS_KB) {
    const LocalId L_ = local_id(); (void)L_;
    const int gw = F.vcu * NWAVES + L_.wave, NGW = F.G * NWAVES, lane = L_.lane;
    const bf16* Y1 = (const bf16*)(F.ws + WS_Y1); const bf16* QB = (const bf16*)(F.ws + WS_QB); const bf16* KV = (const bf16*)(F.ws + WS_KV);
    bf16* KB = (bf16*)(F.ws + kdst_off); bf16* QBd = (bf16*)(F.ws + qdst_off);
    const float2* t64 = (const float2*)(F.ws + WS_ROPE + 16384);
    const float* gq = a.in[I_BQN]; const float* gk = a.in[I_BKN]; const float* KRP = (const float*)(F.ws + WS_LG);
    const int l16 = lane & 15, l8 = lane & 7, hn = lane >> 4, hr = lane >> 3;
    const f32x4 gqn0 = ((const f32x4*)gq)[2 * l16], gqn1 = ((const f32x4*)gq)[2 * l16 + 1], gqr0 = ((const f32x4*)(gq + 128))[2 * l8], gqr1 = ((const f32x4*)(gq + 128))[2 * l8 + 1];
    const f32x4 gkn0 = ((const f32x4*)gk)[2 * l16], gkn1 = ((const f32x4*)gk)[2 * l16 + 1], gkr0 = ((const f32x4*)(gk + 128))[2 * l8], gkr1 = ((const f32x4*)(gk + 128))[2 * l8 + 1];
    for (int row = gw; row < T; row += NGW) {
        const int b = row / TPB, r = row - b * TPB; const bool xr = r >= CTX; const int s = r - CTX, prow = xr ? (s >> 6) : 0, pcol = xr ? (s & 63) : 0;
        const bf16* q = QB + (size_t)row * 1536; const bf16* kv = KV + (size_t)row * 2048;
        const v4u wk0 = *(const v4u*)(kv + hn * 256 + l16 * 8), wk1 = *(const v4u*)(kv + (hn + 4) * 256 + l16 * 8);
        const v4u wkr = *(const v4u*)(Y1 + (size_t)row * EVEN_IN_P + 2560 + l8 * 8);
#define POST2_ONE(W0, W1, WR, GN0, GN1, GR0, GR1, DST) do { \
        float x0[8], x1[8], xr_[8]; unpack8(W0, x0); unpack8(W1, x1); unpack8(WR, xr_); \
        const float n0 = group_sum<16>(sumsq8(x0)), n1 = group_sum<16>(sumsq8(x1)), rs = group_sum<8>(sumsq8(xr_));     \
        const float rs0 = __shfl(rs, 8 * hn), rs1 = __shfl(rs, 8 * (hn + 4));                                         \
        const float t0 = __shfl(n0, 16 * (hr & 3)), t1 = __shfl(n1, 16 * (hr & 3)); const float nr = (hr >> 2) ? t1 : t0;    \
        const float r0 = 1.0f / sqrtf((n0 + rs0) * (1.0f / 192.0f) + NORM_EPS), r1 = 1.0f / sqrtf((n1 + rs1) * (1.0f / 192.0f) + NORM_EPS), rr = 1.0f / sqrtf((nr + rs) * (1.0f / 192.0f) + NORM_EPS); \
        x0[0] *= r0 * GN0.x; x0[1] *= r0 * GN0.y; x0[2] *= r0 * GN0.z; x0[3] *= r0 * GN0.w; x0[4] *= r0 * GN1.x; x0[5] *= r0 * GN1.y; x0[6] *= r0 * GN1.z; x0[7] *= r0 * GN1.w; \
        x1[0] *= r1 * GN0.x; x1[1] *= r1 * GN0.y; x1[2] *= r1 * GN0.z; x1[3] *= r1 * GN0.w; x1[4] *= r1 * GN1.x; x1[5] *= r1 * GN1.y; x1[6] *= r1 * GN1.z; x1[7] *= r1 * GN1.w; \
        xr_[0] *= rr * GR0.x; xr_[1] *= rr * GR0.y; xr_[2] *= rr * GR0.z; xr_[3] *= rr * GR0.w; xr_[4] *= rr * GR1.x; xr_[5] *= rr * GR1.y; xr_[6] *= rr * GR1.z; xr_[7] *= rr * GR1.w; \
        if (xr) rope8<64>(xr_, l8, prow, pcol, t64); \
        *(v4u*)((DST) + hn * 192 + l16 * 8) = pack8(x0); *(v4u*)((DST) + (hn + 4) * 192 + l16 * 8) = pack8(x1); *(v4u*)((DST) + hr * 192 + 128 + l8 * 8) = pack8(xr_); } while (0)
        POST2_ONE(wk0, wk1, wkr, gkn0, gkn1, gkr0, gkr1, KB + (size_t)row * 1536);
#undef POST2_ONE
    }
}
__device__ __forceinline__ void p_odd_post1(const Frame& F, const Args& a, size_t ydst_off = WS_Y1) {
    const LocalId L_ = local_id(); (void)L_;
    const int gw = F.vcu * NWAVES + L_.wave, NGW = F.G * NWAVES, lane = L_.lane;
    const bf16* Y1 = (const bf16*)(F.ws + WS_Y1);
    const float2* t128 = (const float2*)(F.ws + WS_ROPE); const float2* t64 = (const float2*)(F.ws + WS_ROPE + 16384);
    for (int row = gw; row < T; row += NGW) {
        const int b = row / TPB, r = row - b * TPB; const bool xr = r >= CTX; const int s = r - CTX, prow = xr ? (s >> 6) : 0, pcol = xr ? (s & 63) : 0;
        const v4u* y = (const v4u*)(Y1 + (size_t)row * ODD_IN); v4u* yd = (v4u*)((bf16*)(F.ws + ydst_off) + (size_t)row * ODD_IN);
        const v4u kc0 = y[128 + lane], kc1 = y[192 + lane], kd0 = y[512 + (lane & 31)];
        const v4u p0 = head_chunk<64>(kc0, a.in[I_CKN], xr, prow, pcol, t64, lane), p1 = head_chunk<64>(kc1, a.in[I_CKN], xr, prow, pcol, t64, lane);
        const v4u p2 = head_chunk<128>(kd0, a.in[I_DKN], xr, prow, pcol, t128, lane);
        yd[128 + lane] = p0; yd[192 + lane] = p1; if (lane < 32) yd[512 + lane] = p2;
    }
}

__device__ __forceinline__ void p_route(const Frame& F, const Args& a, int layer) {
    const LocalId L_ = local_id(); (void)L_;
    const float* LG = (const float*)(F.ws + WS_LG); int* ROUTE = (int*)(F.ws + WS_ROUTE);
    unsigned* cnt = (unsigned*)(F.ctl + CW_CNT + layer * 64);
    const float* brg = a.in[I_BRG] + layer * 4; const float* bre = a.in[I_BRE] + layer * 32;
    const int NT = F.G * 512;
    for (int base = F.vcu * 512 + L_.wave * 64; base < T; base += NT) {
        const int t = base + L_.lane;
        bool valid = t < T; if (valid && layer == 1) valid = (t % TPB) >= CTX;
        int e0 = -1, e1 = -1; float w0 = 0.f, w1 = 0.f;
        if (valid) {
            const float* lg = LG + (size_t)t * 64;
            float g[4]; for (int i = 0; i < 4; ++i) { float v = brg[i]; for (int ks = 0; ks < RKS; ++ks) v += lg[(size_t)ks * T * 64 + i]; g[i] = v; }
            int gi = 0; float gm = g[0]; for (int i = 1; i < 4; ++i) if (g[i] > gm) { gm = g[i]; gi = i; }
            float den = 0.f; for (int i = 0; i < 4; ++i) den += expf(g[i] - gm);
            const float ptop = 1.0f / den;
            float el[8]; for (int i = 0; i < 8; ++i) { float v = bre[gi * 8 + i]; for (int ks = 0; ks < RKS; ++ks) v += lg[(size_t)ks * T * 64 + 4 + gi * 8 + i]; el[i] = v; }
            int i1 = 0; float l1 = el[0]; for (int i = 1; i < 8; ++i) if (el[i] > l1) { l1 = el[i]; i1 = i; }
            int i2 = -1; float l2 = -3.0e38f; for (int i = 0; i < 8; ++i) if (i != i1 && el[i] > l2) { l2 = el[i]; i2 = i; }
            const float ex = expf(l2 - l1), inv = 1.0f / (1.0f + ex);
            w0 = ptop * inv; w1 = ptop * ex * inv; e0 = gi * 8 + i1; e1 = gi * 8 + i2;
        }
        int pos0 = 0, pos1 = 0;
        const unsigned long long lt = (1ull << L_.lane) - 1ull;
        for (int e = 0; e < NE; ++e) {
            const unsigned long long m0 = __ballot(e0 == e), m1 = __ballot(e1 == e);
            const int n0 = __popcll(m0), n1 = __popcll(m1);
            if (n0 + n1 == 0) continue;
            unsigned basev = 0;
            if (L_.lane == 0) basev = __hip_atomic_fetch_add(cnt + e, (unsigned)(n0 + n1), RLX_AGENT);
            basev = (unsigned)__builtin_amdgcn_readfirstlane((int)basev);
            if (e0 == e) pos0 = (int)basev + __popcll(m0 & lt);
            if (e1 == e) pos1 = (int)basev + n0 + __popcll(m1 & lt);
        }
        if (valid) { int* rec = ROUTE + (size_t)t * 8; rec[0] = e0; rec[1] = e1; rec[2] = pos0; rec[3] = pos1; rec[4] = __builtin_bit_cast(int, w0); rec[5] = __builtin_bit_cast(int, w1); }
    }
}
typedef short bf16x8_t __attribute__((ext_vector_type(8)));
__device__ __forceinline__ void p_mod2_route(const Frame& F, const Args& a, int layer) {
    const LocalId L_ = local_id(); (void)L_;
    const int lane = L_.lane, wave = L_.wave;
    constexpr int FPITCH = 4112;
    LAS unsigned char* Fs = F.lds + RING_OFF; LAS float* P = (LAS float*)(F.lds + RING_OFF + 16 * FPITCH + 256);
    const float* MOD = (const float*)(F.ws + WS_MOD); const bf16* H = (const bf16*)(F.ws + WS_H); bf16* A1 = (bf16*)(F.ws + WS_A1);
    const bf16* WR = (const bf16*)(F.ws + WS_WR) + (size_t)layer * 256 * 2048;
    int* ROUTE = (int*)(F.ws + WS_ROUTE); unsigned* cnt = (unsigned*)(F.ctl + CW_CNT + layer * 64); int* postok = (int*)(F.ws + WS_POS) + (size_t)layer * NE * POSCAP;
    const float* brg = a.in[I_BRG] + layer * 4; const float* bre = a.in[I_BRE] + layer * 32;
    bf16x8_t bfr[3][8];
#pragma unroll
    for (int nb = 0; nb < 3; ++nb)
#pragma unroll
        for (int ks = 0; ks < 8; ++ks) bfr[nb][ks] = *(const bf16x8_t*)(WR + (size_t)(nb * 16 + (lane & 15)) * 2048 + wave * 256 + ks * 32 + (lane >> 4) * 8);
    const int NG = layer == 1 ? NB * SEQ / 16 : T / 16;
    int it = 0;
    for (int g = F.vcu; g < NG; g += F.G, ++it) {
        int row0; if (layer == 1) { const int b = g >> 7; row0 = b * TPB + CTX + (g & 127) * 16; } else row0 = g * 16;
        const int j = mod_index(row0);
        const float* m = MOD + (size_t)(layer * 9 + j) * 12288;
        f32x4 v0[8], v1[8];
        const int r0 = 2 * wave, r1 = r0 + 1;
        hrow_load(H + (size_t)(row0 + r0) * DM, lane, v0);
        hrow_load(H + (size_t)(row0 + r1) * DM, lane, v1);
#define M2R_ROW(V, R) do { float ss = 0.f; \
        _Pragma("unroll") for (int q = 0; q < 8; ++q) ss += (V[q].x * V[q].x + V[q].y * V[q].y) + (V[q].z * V[q].z + V[q].w * V[q].w); \
        ss = wave_sum(ss); const float rn = 1.0f / sqrtf(ss * (1.0f / 2048.0f) + NORM_EPS); \
        _Pragma("unroll") for (int q = 0; q < 8; ++q) { const f32x4 sh = ((const f32x4*)(m + 3 * 2048))[lane + 64 * q], sc = ((const f32x4*)(m + 4 * 2048))[lane + 64 * q]; \
            const f32x4 y = V[q] * rn * (sc + 1.0f) + sh; v2u o; o.x = pk2(y.x, y.y); o.y = pk2(y.z, y.w); \
            ((v2u*)(A1 + (size_t)(row0 + (R)) * DM))[lane + 64 * q] = o; *(LAS v2u*)(Fs + (R) * FPITCH + (lane + 64 * q) * 8) = o; } } while (0)
        M2R_ROW(v0, r0); M2R_ROW(v1, r1);
#undef M2R_ROW
        __syncthreads();
        f32x4 acc[3];
#pragma unroll
        for (int nb = 0; nb < 3; ++nb) acc[nb] = (f32x4){0.f, 0.f, 0.f, 0.f};
#pragma unroll
        for (int ks = 0; ks < 8; ++ks) { const bf16x8_t af = *(const LAS bf16x8_t*)(Fs + (lane & 15) * FPITCH + (wave * 256 + ks * 32 + (lane >> 4) * 8) * 2);
#pragma unroll
            for (int nb = 0; nb < 3; ++nb) acc[nb] = __builtin_amdgcn_mfma_f32_16x16x32_bf16(af, bfr[nb][ks], acc[nb], 0, 0, 0); }
        LAS float* Pb = P + (it & 1) * (8 * 16 * 48);
#pragma unroll
        for (int nb = 0; nb < 3; ++nb)
#pragma unroll
            for (int rg = 0; rg < 4; ++rg) Pb[(wave * 16 + 4 * (lane >> 4) + rg) * 48 + nb * 16 + (lane & 15)] = acc[nb][rg];
        __syncthreads();
        if (wave == 0) {
            const bool valid = lane < 16; const int t = row0 + (lane & 15);
            int e0 = -1, e1 = -1; float w0 = 0.f, w1 = 0.f;
            if (valid) {
                const LAS float* pr = Pb + lane * 48;
                float gg[4];
#pragma unroll
                for (int i = 0; i < 4; ++i) { float sacc = brg[i];
#pragma unroll
                    for (int w = 0; w < 8; ++w) sacc += pr[w * 768 + i];
                    gg[i] = sacc; }
                int gi = 0; float gm = gg[0];
#pragma unroll
                for (int i = 1; i < 4; ++i) if (gg[i] > gm) { gm = gg[i]; gi = i; }
                float den = 0.f;
#pragma unroll
                for (int i = 0; i < 4; ++i) den += expf(gg[i] - gm);
                const float ptop = 1.0f / den;
                float el[8];
#pragma unroll
                for (int i = 0; i < 8; ++i) { float sacc = bre[gi * 8 + i];
#pragma unroll
                    for (int w = 0; w < 8; ++w) sacc += pr[w * 768 + 4 + gi * 8 + i];
                    el[i] = sacc; }
                int i1 = 0; float l1 = el[0];
#pragma unroll
                for (int i = 1; i < 8; ++i) if (el[i] > l1) { l1 = el[i]; i1 = i; }
                int i2 = -1; float l2 = -3.0e38f;
#pragma unroll
                for (int i = 0; i < 8; ++i) if (i != i1 && el[i] > l2) { l2 = el[i]; i2 = i; }
                const float ex = expf(l2 - l1), inv = 1.0f / (1.0f + ex);
                w0 = ptop * inv; w1 = ptop * ex * inv; e0 = gi * 8 + i1; e1 = gi * 8 + i2;
            }
            int rank0 = 0, rank1 = 0, mycnt = 0;
            const unsigned long long lt = (1ull << lane) - 1ull;
            for (int e = 0; e < NE; ++e) {
                const unsigned long long m0 = __ballot(e0 == e), m1 = __ballot(e1 == e);
                const int n0 = __popcll(m0), n1 = __popcll(m1);
                if (lane == e) mycnt = n0 + n1;
                if (e0 == e) rank0 = __popcll(m0 & lt);
                if (e1 == e) rank1 = n0 + __popcll(m1 & lt);
            }
            int basev = 0;
            if (lane < NE && mycnt > 0) basev = (int)__hip_atomic_fetch_add(cnt + lane, (unsigned)mycnt, RLX_AGENT);
            const int pos0 = __shfl(basev, e0 & 31) + rank0, pos1 = __shfl(basev, e1 & 31) + rank1;
            if (valid) { int* rec = ROUTE + (size_t)t * 8; rec[0] = e0; rec[1] = e1; rec[2] = pos0; rec[3] = pos1; rec[4] = __builtin_bit_cast(int, w0); rec[5] = __builtin_bit_cast(int, w1);
                         postok[(size_t)e0 * POSCAP + pos0] = t; postok[(size_t)e1 * POSCAP + pos1] = t; }
        }
    }
    __syncthreads();
}
__device__ __forceinline__ void p_gather(const Frame& F, int layer) {
    const LocalId L_ = local_id(); (void)L_;
    LAS int* offs = (LAS int*)(F.lds + RING_OFF);
    if (L_.tid == 0) { int o = 0; for (int e = 0; e < NE; ++e) { offs[e] = o; const unsigned c = __hip_atomic_load((unsigned*)(F.ctl + CW_CNT + layer * 64 + e), RLX_AGENT); o += (int)((c + 255u) & ~255u); } offs[NE] = o; }
    __syncthreads();
    if (blockIdx.x == 0 && L_.tid < NE) { const int e = L_.tid; int* texp = (int*)(F.ctl + CW_TEXP + layer * 256);
        for (int r = offs[e] >> 8; r < (offs[e + 1] >> 8); ++r) texp[r] = e;
        if (e == 0) *(int*)(F.ctl + CW_NRT + layer * 64) = offs[NE] >> 8; }
    int* ROUTE = (int*)(F.ws + WS_ROUTE); int* slot_tok = (int*)(F.ctl + CW_SLOT + layer * MAXSLOT);
    for (int t = F.vcu * 512 + L_.tid; t < T; t += F.G * 512) {
        if (layer == 1 && (t % TPB) < CTX) continue;
        int* rec = ROUTE + (size_t)t * 8;
        const int s0 = offs[rec[0]] + rec[2], s1 = offs[rec[1]] + rec[3];
        slot_tok[s0] = t; slot_tok[s1] = t; rec[6] = s0; rec[7] = s1;
    }
    __syncthreads();
}

constexpr int SLD = 2304;
template <int DQ, int QR>
__device__ __forceinline__ void naive_scores_softmax(LAS float* S, LAS float* qf, const bf16* Q, int ldq, const bf16* K, int ldk, int lo, int nk, float scale,
                                                     bool window, int qpos0, bool has_sink, float sink, int tid, int lane, int wave) {
    for (int i = tid; i < QR * DQ; i += 512) { const int r = i / DQ, d = i - r * DQ; qf[i] = bf2f(Q[(size_t)r * ldq + d]); }
    __syncthreads();
    for (int t = tid; t < nk; t += 512) {
        const int kr = t < CTX ? t : CTX + lo + (t - CTX);
        const bf16* kp = K + (size_t)kr * ldk;
        float acc[QR];
#pragma unroll
        for (int r = 0; r < QR; ++r) acc[r] = 0.f;
        for (int d = 0; d < DQ; d += 8) {
            const v4u kv = *(const v4u*)(kp + d);
            const float k0 = bflo(kv.x), k1 = bfhi(kv.x), k2 = bflo(kv.y), k3 = bfhi(kv.y), k4 = bflo(kv.z), k5 = bfhi(kv.z), k6 = bflo(kv.w), k7 = bfhi(kv.w);
#pragma unroll
            for (int r = 0; r < QR; ++r) { const LAS float* qp = qf + r * DQ + d;
                acc[r] += (k0 * qp[0] + k1 * qp[1]) + (k2 * qp[2] + k3 * qp[3]) + (k4 * qp[4] + k5 * qp[5]) + (k6 * qp[6] + k7 * qp[7]); }
        }
#pragma unroll
        for (int r = 0; r < QR; ++r) { float s = acc[r] * scale;
            if (window && t >= CTX) { const int dd = (qpos0 + r) - (lo + t - CTX); if (dd > 128 || dd < -128) s = -1e30f; }
            S[r * SLD + t] = s; }
    }
    __syncthreads();
    if (wave < QR) {
        LAS float* row = S + wave * SLD;
        float m = -1e30f; for (int t = lane; t < nk; t += 64) m = fmaxf(m, row[t]);
        m = wave_max(m); if (has_sink) m = fmaxf(m, sink);
        float sum = 0.f; for (int t = lane; t < nk; t += 64) { const float e = expf(row[t] - m); row[t] = e; sum += e; }
        sum = wave_sum(sum); if (has_sink) sum += expf(sink - m);
        const float inv = 1.0f / sum;
        for (int t = lane; t < nk; t += 64) row[t] *= inv;
    }
    __syncthreads();
}
template <int QR>
__device__ __forceinline__ void naive_pv(const LAS float* S, const bf16* V, int ldv, int lo, int nk, int tid, float (&o)[QR / 4]) {
    const int c = tid & 127, rg = tid >> 7; constexpr int RPT = QR / 4;
#pragma unroll
    for (int i = 0; i < RPT; ++i) o[i] = 0.f;
#pragma unroll 4
    for (int t = 0; t < nk; ++t) { const int kr = t < CTX ? t : CTX + lo + (t - CTX); const float v = bf2f(V[(size_t)kr * ldv + c]);
#pragma unroll
        for (int i = 0; i < RPT; ++i) o[i] += S[(rg * RPT + i) * SLD + t] * v; }
}
__device__ __forceinline__ void p_even_attn_naive(const Frame& F) {
    const LocalId L_ = local_id(); (void)L_;
    LAS float* S = (LAS float*)(F.lds + RING_OFF); LAS float* qf = (LAS float*)(F.lds + RING_OFF + 8 * SLD * 4);
    const bf16* Y1 = (const bf16*)(F.ws + WS_Y1); const bf16* QB = (const bf16*)(F.ws + WS_QB); const bf16* KV = (const bf16*)(F.ws + WS_KV); const bf16* KB = (const bf16*)(F.ws + WS_KB);
    bf16* MIX = (bf16*)(F.ws + WS_MIX);
    constexpr int UPV = NB * 8 * 288;
    for (int u = blockIdx.x; u < 2 * UPV; u += F.G) {
        const int var = u / UPV, rem = u - var * UPV, b = rem / 2304, rem2 = rem - b * 2304, h = rem2 / 288, ch = rem2 - h * 288;
        const int r0 = ch * 8, row0 = b * TPB + r0; const int nk = r0 < CTX ? CTX : TPB;
        float o[2];
        if (var == 0) {
            naive_scores_softmax<128, 8>(S, qf, Y1 + (size_t)row0 * EVEN_IN_P + h * 128, EVEN_IN_P, Y1 + (size_t)(b * TPB) * EVEN_IN_P + 1024 + (h >> 2) * 128, EVEN_IN_P, 0, nk,
                                         0.08838834764831845f, false, 0, false, 0.f, L_.tid, L_.lane, L_.wave);
            naive_pv<8>(S, Y1 + (size_t)(b * TPB) * EVEN_IN_P + 1280 + (h >> 2) * 128, EVEN_IN_P, 0, nk, L_.tid, o);
        } else {
            naive_scores_softmax<192, 8>(S, qf, QB + (size_t)row0 * 1536 + h * 192, 1536, KB + (size_t)(b * TPB) * 1536 + h * 192, 1536, 0, nk,
                                         0.07216878364870322f, false, 0, false, 0.f, L_.tid, L_.lane, L_.wave);
            naive_pv<8>(S, KV + (size_t)(b * TPB) * 2048 + h * 256 + 128, 2048, 0, nk, L_.tid, o);
        }
        const int c = L_.tid & 127, rg = L_.tid >> 7;
#pragma unroll
        for (int i = 0; i < 2; ++i) MIX[(size_t)(row0 + rg * 2 + i) * DM + var * 1024 + h * 128 + c] = (bf16)f2bf(o[i]);
        __syncthreads();
    }
}
__device__ __forceinline__ void p_odd_attn_naive(const Frame& F, const Args& a) {
    const LocalId L_ = local_id(); (void)L_;
    LAS float* S = (LAS float*)(F.lds + RING_OFF); LAS float* qf = (LAS float*)(F.lds + RING_OFF + 8 * SLD * 4); LAS float* ob = qf + 8 * 192;
    const bf16* Y1 = (const bf16*)(F.ws + WS_Y1); bf16* MIX = (bf16*)(F.ws + WS_MIX);
    float d1 = 0.f, d2 = 0.f;
    for (int i = 0; i < 64; ++i) { d1 += a.in[I_LQ1][i] * a.in[I_LK1][i]; d2 += a.in[I_LQ2][i] * a.in[I_LK2][i]; }
    const float lam = expf(d1) - expf(d2) + LAMBDA_INIT;
    constexpr int UC = NB * 8 * 512, UD = NB * 8 * 256;
    for (int u = blockIdx.x; u < UC + UD; u += F.G) {
        const int c = L_.tid & 127, rg = L_.tid >> 7;
        if (u < UC) {
            const int b = u / 4096, rem = u - b * 4096, h = rem / 512, ch = rem - h * 512;
            const int r0 = CTX + ch * 4, row0 = b * TPB + r0; const int nk = TPB;
            const bf16* kb = Y1 + (size_t)(b * TPB) * ODD_IN;
            naive_scores_softmax<64, 4>(S, qf, Y1 + (size_t)row0 * ODD_IN + (2 * h) * 64, ODD_IN, kb + 1024 + (2 * h) * 64, ODD_IN, 0, nk, 0.125f, false, 0, false, 0.f, L_.tid, L_.lane, L_.wave);
            naive_scores_softmax<64, 4>(S + 4 * SLD, qf, Y1 + (size_t)row0 * ODD_IN + (2 * h + 1) * 64, ODD_IN, kb + 1024 + (2 * h + 1) * 64, ODD_IN, 0, nk, 0.125f, false, 0, false, 0.f, L_.tid, L_.lane, L_.wave);
            for (int i = L_.tid; i < 4 * SLD; i += 512) S[i] = S[i] - lam * S[4 * SLD + i];
            __syncthreads();
            float o[1];
            naive_pv<4>(S, kb + 2048 + h * 128, ODD_IN, 0, nk, L_.tid, o);
            ob[rg * 128 + c] = o[0];
            __syncthreads();
            float ss = 0.f; for (int i = 0; i < 128; ++i) { const float v = ob[rg * 128 + i]; ss += v * v; }
            const float r = 1.0f / sqrtf(ss * (1.0f / 128.0f) + NORM_EPS);
            MIX[(size_t)(row0 + rg) * DM + h * 128 + c] = (bf16)f2bf(o[0] * r * a.in[I_SUBLN][c] * (1.0f - LAMBDA_INIT));
        } else {
            const int v = u - UC, b = v / 2048, rem = v - b * 2048, h = rem / 256, ch = rem - h * 256;
            const int s0 = ch * 8, row0 = b * TPB + CTX + s0;
            const int lo = s0 - 128 < 0 ? 0 : s0 - 128, hi = s0 + 7 + 128 > SEQ - 1 ? SEQ - 1 : s0 + 7 + 128; const int nk = CTX + (hi - lo + 1);
            const bf16* kb = Y1 + (size_t)(b * TPB) * ODD_IN;
            naive_scores_softmax<128, 8>(S, qf, Y1 + (size_t)row0 * ODD_IN + 3072 + h * 128, ODD_IN, kb + 4096 + (h >> 2) * 128, ODD_IN, lo, nk, 0.08838834764831845f, true, s0, true, a.in[I_SINK][h], L_.tid, L_.lane, L_.wave);
            float o[2];
            naive_pv<8>(S, kb + 4352 + (h >> 2) * 128, ODD_IN, lo, nk, L_.tid, o);
#pragma unroll
            for (int i = 0; i < 2; ++i) MIX[(size_t)(row0 + rg * 2 + i) * DM + 1024 + h * 128 + c] = (bf16)f2bf(o[i]);
        }
        __syncthreads();
    }
}

namespace att {
using bf16x8 = __attribute__((ext_vector_type(8))) short;
using s16x4  = __attribute__((ext_vector_type(4))) short;
using f32x16 = __attribute__((ext_vector_type(16))) float;
using u32x4  = __attribute__((ext_vector_type(4))) unsigned;
constexpr int KVBLK = 64, QBLK = 32;
constexpr int SHM_V = KVBLK * 128 * 2;
constexpr int K_OFF = 2 * SHM_V, K_MAX = KVBLK * 192 * 2, QL_OFF = K_OFF + 2 * K_MAX, WS_OFF = 131072 + 2048;
constexpr float THR = 8.f;
#define ATT_KSWZ(row, colB, RB) ((row) * (RB) + ((colB) ^ (((row) & 7) << 4)))
#define ATT_SBAR() __builtin_amdgcn_sched_barrier(0)
__device__ __forceinline__ int crow(int r, int hi) { return (r & 3) + 8 * (r >> 2) + 4 * hi; }
__device__ __forceinline__ unsigned cvtpk(float lo, float hi) { unsigned r; asm volatile("v_cvt_pk_bf16_f32 %0, %1, %2" : "=v"(r) : "v"(lo), "v"(hi)); return r; }

__device__ __forceinline__ void partialSM(f32x16& p0, f32x16& p1, float& m_reg, float& mn, float& alpha, float C, float thr_raw) {
  float pmax = p0[0];
#pragma unroll
  for (int r = 1; r < 16; ++r) pmax = fmaxf(pmax, p0[r]);
#pragma unroll
  for (int r = 0; r < 16; ++r) pmax = fmaxf(pmax, p1[r]);
  { auto rr = __builtin_amdgcn_permlane32_swap(__float_as_uint(pmax), __float_as_uint(pmax), false, false);
    pmax = fmaxf(__uint_as_float(rr[0]), __uint_as_float(rr[1])); }
  if (__builtin_expect(__all(pmax - m_reg <= thr_raw), 1)) { mn = m_reg; alpha = 1.f; }
  else { mn = fmaxf(m_reg, pmax); alpha = __builtin_amdgcn_exp2f((m_reg - mn) * C); m_reg = mn; }
  const float mnC = -mn * C;
#pragma unroll
  for (int r = 0; r < 16; ++r) p0[r] = fmaf(p0[r], C, mnC);
#pragma unroll
  for (int r = 0; r < 16; ++r) p1[r] = fmaf(p1[r], C, mnC);
#pragma unroll
  for (int r = 0; r < 16; ++r) p0[r] = __builtin_amdgcn_exp2f(p0[r]);
}
__device__ __forceinline__ void finishSM(f32x16& p0, f32x16& p1, float alpha, float& l_reg, bf16x8& pa0, bf16x8& pa1, bf16x8& pa2, bf16x8& pa3) {
#pragma unroll
  for (int r = 0; r < 16; ++r) p1[r] = __builtin_amdgcn_exp2f(p1[r]);
  float ps = 0;
#pragma unroll
  for (int r = 0; r < 16; ++r) ps += p0[r];
#pragma unroll
  for (int r = 0; r < 16; ++r) ps += p1[r];
  { auto rr = __builtin_amdgcn_permlane32_swap(__float_as_uint(ps), __float_as_uint(ps), false, false);
    ps = __uint_as_float(rr[0]) + __uint_as_float(rr[1]); }
  l_reg = l_reg * alpha + ps;
#define ATT_PK4(P, BASE, OUT) do { unsigned a0 = cvtpk(P[BASE + 0], P[BASE + 1]), a1 = cvtpk(P[BASE + 2], P[BASE + 3]);   \
    unsigned b0 = cvtpk(P[BASE + 4], P[BASE + 5]), b1 = cvtpk(P[BASE + 6], P[BASE + 7]);                              \
    auto r0 = __builtin_amdgcn_permlane32_swap(a0, b0, false, false); auto r1 = __builtin_amdgcn_permlane32_swap(a1, b1, false, false); \
    u32x4 w = {r0[0], r1[0], r0[1], r1[1]}; OUT = *reinterpret_cast<bf16x8*>(&w); } while (0)
  ATT_PK4(p0, 0, pa0); ATT_PK4(p0, 8, pa1); ATT_PK4(p1, 0, pa2); ATT_PK4(p1, 8, pa3);
#undef ATT_PK4
}
template <int DQ, int NQT, int NQR, int QSB>
__device__ __forceinline__ void qkt(f32x16& p0, f32x16& p1, const char* Ks, const bf16x8 (&qr)[NQR], const char* qlds, const int (&kb)[4]) {
  p0 = f32x16{}; p1 = f32x16{};
#pragma unroll
  for (int d0 = 0; d0 < NQT; ++d0) {
    const bf16x8 b0 = *reinterpret_cast<const bf16x8*>(Ks + kb[d0 & 3] + (d0 >> 2) * 128);
    const bf16x8 b1 = *reinterpret_cast<const bf16x8*>(Ks + kb[d0 & 3] + (d0 >> 2) * 128 + 32 * DQ * 2);
    bf16x8 q; if (d0 < NQR) q = qr[d0 < NQR ? d0 : 0]; else q = *reinterpret_cast<const bf16x8*>(qlds + (d0 - NQR) * 1024);
    p0 = __builtin_amdgcn_mfma_f32_32x32x16_bf16(b0, q, p0, 0, 0, 0);
    p1 = __builtin_amdgcn_mfma_f32_32x32x16_bf16(b1, q, p1, 0, 0, 0);
    if (QSB > 0 && (d0 % (QSB > 0 ? QSB : 1)) == (QSB - 1) && d0 + 1 < NQT) ATT_SBAR(); }
}
__device__ __forceinline__ void mask_tile(f32x16& p0, f32x16& p1, int kp0, int qpos, int hi) {
#pragma unroll
  for (int r = 0; r < 16; ++r) { const int d = qpos - (kp0 + crow(r, hi));
    if (d > 128 || d < -128) p0[r] = -1e30f;
    if (d - 32 > 128 || d - 32 < -128) p1[r] = -1e30f; }
}
__device__ __forceinline__ int v_st(int k, int c) { const int kk = (k & ~0xC) | ((k & 4) << 1) | ((k & 8) >> 1); return ((kk >> 3) * 4 + (c >> 5)) * 512 + ((kk & 7) * 32 + (c & 31)) * 2; }
__device__ __forceinline__ int v_rd_base(int lane) { return ((lane & 3) << 3) | (((lane >> 2) & 3) << 6) | (((lane >> 4) & 1) << 5) | (((lane >> 5) & 1) << 8); }
constexpr int v_rd_off(int d0, int ks, int half) { return d0 * 512 + ks * 4096 + half * 2048; }
template <int OFF> __device__ __forceinline__ s16x4 tr_read(int vb) {
  s16x4 r; asm volatile("ds_read_b64_tr_b16 %0, %1 offset:%2" : "=&v"(r) : "v"(vb), "i"(OFF) : "memory"); return r;
}
template <int D0> __device__ __forceinline__ void pv_one(f32x16& od, int vb, bf16x8 pa0, bf16x8 pa1, bf16x8 pa2, bf16x8 pa3) {
  const s16x4 l0 = tr_read<v_rd_off(D0, 0, 0)>(vb), h0 = tr_read<v_rd_off(D0, 0, 1)>(vb), l1 = tr_read<v_rd_off(D0, 1, 0)>(vb), h1 = tr_read<v_rd_off(D0, 1, 1)>(vb);
  const s16x4 l2 = tr_read<v_rd_off(D0, 2, 0)>(vb), h2 = tr_read<v_rd_off(D0, 2, 1)>(vb), l3 = tr_read<v_rd_off(D0, 3, 0)>(vb), h3 = tr_read<v_rd_off(D0, 3, 1)>(vb);
  asm volatile("s_waitcnt lgkmcnt(0)" ::: "memory"); ATT_SBAR();
#define ATT_PK(L, H) (bf16x8){L[0], L[1], L[2], L[3], H[0], H[1], H[2], H[3]}
  od = __builtin_amdgcn_mfma_f32_32x32x16_bf16(pa0, ATT_PK(l0, h0), od, 0, 0, 0);
  od = __builtin_amdgcn_mfma_f32_32x32x16_bf16(pa1, ATT_PK(l1, h1), od, 0, 0, 0);
  od = __builtin_amdgcn_mfma_f32_32x32x16_bf16(pa2, ATT_PK(l2, h2), od, 0, 0, 0);
  od = __builtin_amdgcn_mfma_f32_32x32x16_bf16(pa3, ATT_PK(l3, h3), od, 0, 0, 0);
#undef ATT_PK
}
__device__ __forceinline__ void pv_d0(f32x16* o, int vb, bf16x8 pa0, bf16x8 pa1, bf16x8 pa2, bf16x8 pa3) {
  pv_one<0>(o[0], vb, pa0, pa1, pa2, pa3); pv_one<1>(o[1], vb, pa0, pa1, pa2, pa3); pv_one<2>(o[2], vb, pa0, pa1, pa2, pa3); pv_one<3>(o[3], vb, pa0, pa1, pa2, pa3);
}

__device__ __forceinline__ float bfx(short v) { return __builtin_bit_cast(float, ((unsigned)(unsigned short)v) << 16); }
template <int MODE, int NQ>
__device__ __forceinline__ void q_fix(bf16x8 (&q)[NQ], const float* gain, const float* tab  , int pos, int hi) {
  constexpr int DIM = NQ * 16;
  float x[NQ][8]; float ss = 0.f;
#pragma unroll
  for (int d0 = 0; d0 < NQ; ++d0)
#pragma unroll
    for (int j = 0; j < 8; ++j) { x[d0][j] = bfx(q[d0][j]); ss += x[d0][j] * x[d0][j]; }
  ss += __shfl_xor(ss, 32);
  const float r = 1.0f / sqrtf(ss * (1.0f / DIM) + 1e-6f);
#pragma unroll
  for (int d0 = 0; d0 < NQ; ++d0) { const float* g = gain + d0 * 16 + hi * 8;
#pragma unroll
    for (int j = 0; j < 8; ++j) x[d0][j] *= r * g[j]; }
  if (pos >= 0) {
    const int prow = pos >> 6, pcol = pos & 63;
    constexpr int RB0 = (MODE == 2) ? 8 : 0, NRB = (MODE == 1) ? 8 : 4, NF = (MODE == 1) ? 32 : 16, PX = (MODE == 1) ? 2 : 1;
    float y[NRB][8];
#pragma unroll
    for (int b = 0; b < NRB; ++b) { const int p = (b < NRB / 2) ? prow : pcol; const int f0 = (MODE == 1 ? (b & 1) * 16 : 0) + hi * 8; const float sg = (b & PX) ? 1.0f : -1.0f;
      const float* t = tab + (size_t)(p * NF + f0) * 2;
#pragma unroll
      for (int j = 0; j < 8; ++j) y[b][j] = x[RB0 + b][j] * t[2 * j] + sg * x[RB0 + (b ^ PX)][j] * t[2 * j + 1]; }
#pragma unroll
    for (int b = 0; b < NRB; ++b)
#pragma unroll
      for (int j = 0; j < 8; ++j) x[RB0 + b][j] = y[b][j];
  }
#pragma unroll
  for (int d0 = 0; d0 < NQ; ++d0) { u32x4 w; w.x = cvtpk(x[d0][0], x[d0][1]); w.y = cvtpk(x[d0][2], x[d0][3]); w.z = cvtpk(x[d0][4], x[d0][5]); w.w = cvtpk(x[d0][6], x[d0][7]); q[d0] = *reinterpret_cast<bf16x8*>(&w); }
}

template <int DQ, bool WINDOW, bool SINK, int LDQ, int LDK, int LDV, int SD, int QSB, int NQRMAX, bool DIFF = false, int QMODE = 0>
__device__ __forceinline__ void attn_unit(const bf16* __restrict__ Qb, const bf16* __restrict__ Kb, const bf16* __restrict__ Vb,
                                          bf16* __restrict__ Ob, int ntiles, int band_lo, int qpos0, float scale, float sink, char* lds, const float* gainp = nullptr,
                                          const float* qgain = nullptr, const float* qtab = nullptr, int qs0 = -1, int wv = 0) {
  constexpr int NQ = (DIFF ? DQ / 2 : DQ) / 16, NQR = NQ > NQRMAX ? NQRMAX : NQ, NCH = DQ / 64, RB = DQ * 2, SHM_K = KVBLK * DQ * 2, LDO = 2048;
  int tid = wv * 64 + lane_id_(); asm volatile("" : "+v"(tid));
  const int wid = tid >> 6, lane = tid & 63, r32 = lane & 31, hi = lane >> 5;
  const int comp = DIFF ? (wid >> 2) : 0, wrow = DIFF ? (wid & 3) : wid, kcomp = comp * 128;
  char* V_lds = lds; char* K_lds = lds + K_OFF;
  float* ws = (float*)(lds + WS_OFF) + wid * 64; float* li_l = ws; float* al_l = ws + 32;
  const float C = scale * 1.4426950408889634f, thr_raw = THR / scale;
  float m_reg = -1e30f, l_reg = 0; f32x16 o[4] = {}; bf16x8 qr[NQR];
  const unsigned qoff = (unsigned)((wrow * QBLK + r32) * LDQ + hi * 8 + comp * 64) * 2u;
  char* qlds = lds + QL_OFF + wid * ((NQ - NQR) * 1024) + lane * 16;
  if constexpr (QMODE == 0) {
#pragma unroll
    for (int d0 = 0; d0 < NQR; ++d0) qr[d0] = *reinterpret_cast<const bf16x8*>((const char*)Qb + qoff + d0 * 32);
    __syncthreads();
    if constexpr (NQ > NQR) {
#pragma unroll
      for (int d0 = NQR; d0 < NQ; ++d0) *reinterpret_cast<bf16x8*>(qlds + (d0 - NQR) * 1024) = *reinterpret_cast<const bf16x8*>((const char*)Qb + qoff + d0 * 32);
    }
  } else {
    bf16x8 qall[NQ];
#pragma unroll
    for (int d0 = 0; d0 < NQ; ++d0) qall[d0] = *reinterpret_cast<const bf16x8*>((const char*)Qb + qoff + d0 * 32);
    q_fix<QMODE, NQ>(qall, qgain, qtab, qs0 < 0 ? -1 : qs0 + wrow * QBLK + r32, hi);
#pragma unroll
    for (int d0 = 0; d0 < NQR; ++d0) qr[d0] = qall[d0];
    __syncthreads();
    if constexpr (NQ > NQR) {
#pragma unroll
      for (int d0 = NQR; d0 < NQ; ++d0) *reinterpret_cast<bf16x8*>(qlds + (d0 - NQR) * 1024) = qall[d0];
    }
  }
  const int sr = tid >> 4, sc = (tid & 15) * 8, vst0 = v_st(sr, sc);
  const unsigned voV = (unsigned)(sr * LDV + sc) * 2u;
  const int kr_ = tid >> 3, kc_ = (tid & 7) * 8;
  const unsigned voK = (unsigned)(kr_ * LDK + kc_) * 2u; const int kwr = ATT_KSWZ(kr_, kc_ * 2, RB);
  const int vb0 = (int)(uintptr_t)V_lds + v_rd_base(lane);
  int kb[4];
#pragma unroll
  for (int k = 0; k < 4; ++k) kb[k] = r32 * RB + ((k ^ ((r32 & 7) >> 1)) * 32) + ((hi ^ (r32 & 1)) * 16);
  const int qpos = qpos0 + wrow * QBLK + r32;
  struct { bf16x8 vs0, vs1, ks[NCH]; } sr_[SD];
#define ATT_KROW(j) (WINDOW ? ((j) < 4 ? (j) * KVBLK : 256 + band_lo + ((j) - 4) * KVBLK) : (j) * KVBLK)
#define ATT_SLOAD(i, j) do { const int k0_ = ATT_KROW(j); const char* vt_ = (const char*)Vb + (size_t)k0_ * (LDV * 2); const char* kt_ = (const char*)Kb + (size_t)k0_ * (LDK * 2); \
    sr_[i].vs0 = *reinterpret_cast<const bf16x8*>(vt_ + voV); sr_[i].vs1 = *reinterpret_cast<const bf16x8*>(vt_ + voV + 32 * LDV * 2); \
    _Pragma("unroll") for (int c_ = 0; c_ < NCH; ++c_) sr_[i].ks[c_] = *reinterpret_cast<const bf16x8*>(kt_ + voK + c_ * 128); } while (0)
#define ATT_SWRITE(b, i) do { *(bf16x8*)(V_lds + (b) * SHM_V + vst0) = sr_[i].vs0; *(bf16x8*)(V_lds + (b) * SHM_V + vst0 + 8192) = sr_[i].vs1; \
    _Pragma("unroll") for (int c_ = 0; c_ < NCH; ++c_) *(bf16x8*)(K_lds + (b) * SHM_K + kwr + c_ * 128) = sr_[i].ks[c_]; } while (0)
#define ATT_SWAIT() do { if constexpr (SD == 1) asm volatile("s_waitcnt vmcnt(0)" ::: "memory"); else if constexpr (NCH == 1) asm volatile("s_waitcnt vmcnt(3)" ::: "memory"); else if constexpr (NCH == 2) asm volatile("s_waitcnt vmcnt(4)" ::: "memory"); else asm volatile("s_waitcnt vmcnt(5)" ::: "memory"); } while (0)
#define ATT_RESC(a) do { if (__any((a) < 1.f)) { if (hi == 0) al_l[r32] = (a); asm volatile("s_waitcnt lgkmcnt(0)" ::: "memory"); \
    _Pragma("unroll") for (int d = 0; d < 4; ++d) _Pragma("unroll") for (int r = 0; r < 16; ++r) o[d][r] *= al_l[crow(r, hi)]; } } while (0)
#define ATT_MASK(P0, P1, j) do { if constexpr (WINDOW) { if ((j) >= 4) mask_tile(P0, P1, band_lo + ((j) - 4) * KVBLK, qpos, hi); } } while (0)
  f32x16 pA0, pA1, pB0, pB1; float mnA, mnB, alA, alB; bf16x8 pa0, pa1, pa2, pa3; const int NT = ntiles;
  constexpr int SE = 0, SO = SD - 1;
  ATT_SLOAD(SE, 0); asm volatile("s_waitcnt vmcnt(0)" ::: "memory"); ATT_SWRITE(0, SE); __syncthreads();
  qkt<DQ, NQ, NQR, QSB>(pA0, pA1, K_lds + kcomp, qr, qlds, kb); ATT_MASK(pA0, pA1, 0); partialSM(pA0, pA1, m_reg, mnA, alA, C, thr_raw);
  ATT_SLOAD(SO, 1); if constexpr (SD == 2) { if (2 < NT) ATT_SLOAD(SE, 2); }
  ATT_SWAIT(); ATT_SWRITE(1, SO); __syncthreads();
  for (int j = 1; j + 1 < NT; j += 2) {
    ATT_SBAR(); qkt<DQ, NQ, NQR, QSB>(pB0, pB1, K_lds + SHM_K + kcomp, qr, qlds, kb);
    finishSM(pA0, pA1, alA, l_reg, pa0, pa1, pa2, pa3); ATT_SBAR();
    ATT_SLOAD(SO, j + SD); ATT_SBAR();
    pv_d0(o, vb0, pa0, pa1, pa2, pa3); ATT_MASK(pB0, pB1, j); partialSM(pB0, pB1, m_reg, mnB, alB, C, thr_raw);
    __syncthreads(); ATT_SWAIT(); ATT_SWRITE(0, SE);
    ATT_RESC(alB); __syncthreads();
    ATT_SBAR(); qkt<DQ, NQ, NQR, QSB>(pA0, pA1, K_lds + kcomp, qr, qlds, kb);
    finishSM(pB0, pB1, alB, l_reg, pa0, pa1, pa2, pa3); ATT_SBAR();
    if (SD == 1 || j + 3 < NT) ATT_SLOAD(SE, j + 1 + SD); ATT_SBAR();
    pv_d0(o, vb0 + SHM_V, pa0, pa1, pa2, pa3); ATT_MASK(pA0, pA1, j + 1); partialSM(pA0, pA1, m_reg, mnA, alA, C, thr_raw);
    __syncthreads(); ATT_SWAIT(); ATT_SWRITE(1, SO);
    ATT_RESC(alA); __syncthreads();
  }
  ATT_SBAR(); qkt<DQ, NQ, NQR, QSB>(pB0, pB1, K_lds + SHM_K + kcomp, qr, qlds, kb);
  finishSM(pA0, pA1, alA, l_reg, pa0, pa1, pa2, pa3); ATT_SBAR();
  pv_d0(o, vb0, pa0, pa1, pa2, pa3); ATT_MASK(pB0, pB1, NT - 1); partialSM(pB0, pB1, m_reg, mnB, alB, C, thr_raw);
  __syncthreads(); ATT_RESC(alB);
  finishSM(pB0, pB1, alB, l_reg, pa0, pa1, pa2, pa3); ATT_SBAR();
  pv_d0(o, vb0 + SHM_V, pa0, pa1, pa2, pa3);
  if constexpr (SINK) l_reg += __builtin_amdgcn_exp2f(sink * 1.4426950408889634f - m_reg * C);
  if (hi == 0) li_l[r32] = l_reg; asm volatile("s_waitcnt lgkmcnt(0)" ::: "memory");
  float rli[16];
#pragma unroll
  for (int r = 0; r < 16; ++r) rli[r] = __builtin_amdgcn_rcpf(li_l[crow(r, hi)]);
  int tid2 = wv * 64 + lane_id_(); asm volatile("" : "+v"(tid2));
  if constexpr (!DIFF) {
    const unsigned ooff = (unsigned)(((tid2 >> 6) * QBLK + 4 * ((tid2 >> 5) & 1)) * LDO + (tid2 & 31)) * 2u;
#pragma unroll
    for (int r = 0; r < 16; ++r) { const int orow = (r & 3) + 8 * (r >> 2);
#pragma unroll
      for (int d0 = 0; d0 < 4; ++d0) *reinterpret_cast<bf16*>((char*)Ob + ooff + (orow * LDO + d0 * 32) * 2) = (bf16)f2bf(o[d0][r] * rli[r]); }
  } else {
    float* X = (float*)lds + ((tid2 >> 6) & 3) * 4096 + (tid2 & 63);
    __syncthreads();
    if (tid2 >= 256) {
#pragma unroll
      for (int d0 = 0; d0 < 4; ++d0)
#pragma unroll
        for (int r = 0; r < 16; ++r) X[(d0 * 16 + r) * 64] = sink * (o[d0][r] * rli[r]);
    }
    __syncthreads();
    if (tid2 < 256) {
      float g[4];
#pragma unroll
      for (int d0 = 0; d0 < 4; ++d0) g[d0] = gainp[d0 * 32 + (tid2 & 31)];
      const unsigned ooff = (unsigned)(((tid2 >> 6) * QBLK + 4 * ((tid2 >> 5) & 1)) * LDO + (tid2 & 31)) * 2u;
#pragma unroll
      for (int r = 0; r < 16; ++r) { const int orow = (r & 3) + 8 * (r >> 2);
        float d[4], ss = 0.f;
#pragma unroll
        for (int d0 = 0; d0 < 4; ++d0) { d[d0] = o[d0][r] * rli[r] - X[(d0 * 16 + r) * 64]; ss += d[d0] * d[d0]; }
        ss += __shfl_xor(ss, 1); ss += __shfl_xor(ss, 2); ss += __shfl_xor(ss, 4); ss += __shfl_xor(ss, 8); ss += __shfl_xor(ss, 16);
        const float rs = __builtin_amdgcn_rsqf(ss * (1.0f / 128.0f) + 1e-6f);
#pragma unroll
        for (int d0 = 0; d0 < 4; ++d0) *reinterpret_cast<bf16*>((char*)Ob + ooff + (orow * LDO + d0 * 32) * 2) = (bf16)f2bf(d[d0] * rs * g[d0]); }
    }
  }
#undef ATT_KROW
#undef ATT_SLOAD
#undef ATT_SWRITE
#undef ATT_SWAIT
#undef ATT_RESC
#undef ATT_MASK
}
}

__device__ __forceinline__ void p_even_attn(const Frame& F, const Args& a, char* lds) {
    const LocalId L_ = local_id(); (void)L_;
    const bf16* Y1 = (const bf16*)(F.ws + WS_Y1); const bf16* QB = (const bf16*)(F.ws + WS_QB); const bf16* KV = (const bf16*)(F.ws + WS_KV); const bf16* KB = (const bf16*)(F.ws + WS_KB);
    bf16* MIX = (bf16*)(F.ws + WS_MIX);
    const float* t128 = (const float*)(F.ws + WS_ROPE); const float* t64 = (const float*)(F.ws + WS_ROPE + 16384);
    for (int n = blockIdx.x; n < 512 + 64; n += F.G) {
        int b, h, row0, nt, qs0;
        if (n < 512) { const int i = n >> 8, c = n & 255, x = c & 7, lc = c >> 3, gi = i * 8 + x; b = gi >> 1; h = (gi & 1) * 4 + (lc >> 3); qs0 = (lc & 7) * 256; row0 = b * TPB + CTX + qs0; nt = 36; }
        else { const int m = n - 512; b = m >> 3; h = m & 7; row0 = b * TPB; nt = 4; qs0 = -1; }
        const size_t kb = (size_t)b * TPB;
        att::attn_unit<128, false, false, EVEN_IN_P, EVEN_IN_P, EVEN_IN_P, 2, 0, 8, false, 1>(Y1 + (size_t)row0 * EVEN_IN_P + h * 128, Y1 + kb * EVEN_IN_P + 1024 + (h >> 2) * 128, Y1 + kb * EVEN_IN_P + 1280 + (h >> 2) * 128,
                                                                                 MIX + (size_t)row0 * DM + h * 128, nt, 0, 0, 0.08838834764831845f, 0.f, lds, nullptr, a.in[I_AQN], t128, qs0, L_.wave);
    }
    for (int n = blockIdx.x; n < 512 + 64; n += F.G) {
        int b, h, row0, nt, qs0;
        if (n < 512) { const int i = n >> 8, c = n & 255, x = c & 7, lc = c >> 3, gi = i * 8 + x; b = gi >> 1; h = (gi & 1) * 4 + (lc >> 3); qs0 = (lc & 7) * 256; row0 = b * TPB + CTX + qs0; nt = 36; }
        else { const int m = n - 512; b = m >> 3; h = m & 7; row0 = b * TPB; nt = 4; qs0 = -1; }
        const size_t kb = (size_t)b * TPB;
        att::attn_unit<192, false, false, 1536, 1536, 2048, 1, 0, 8, false, 2>(QB + (size_t)row0 * 1536 + h * 192, KB + kb * 1536 + h * 192, KV + kb * 2048 + h * 256 + 128,
                                                                  MIX + (size_t)row0 * DM + 1024 + h * 128, nt, 0, 0, 0.07216878364870322f, 0.f, lds, nullptr, a.in[I_BQN], t64, qs0, L_.wave);
    }
    __syncthreads();
}
__device__ __forceinline__ void p_odd_attn(const Frame& F, const Args& a, char* lds) {
    const LocalId L_ = local_id(); (void)L_;
    const bf16* Y1 = (const bf16*)(F.ws + WS_Y1); bf16* O12 = (bf16*)(F.ws + WS_A1); bf16* MIX = (bf16*)(F.ws + WS_MIX);
#if ATT_DIFF_FUSED
    float d1 = 0.f, d2 = 0.f;
    for (int i = 0; i < 64; ++i) { d1 += a.in[I_LQ1][i] * a.in[I_LK1][i]; d2 += a.in[I_LQ2][i] * a.in[I_LK2][i]; }
    const float lam = expf(d1) - expf(d2) + LAMBDA_INIT;
    const float* gsub = (const float*)(F.ws + WS_ROPE + 32768);
    for (int n = blockIdx.x; n < 1024; n += F.G) {
        const int i = n >> 8, c = n & 255, x = c & 7, lc = c >> 3, gi = i * 8 + x, b = gi >> 2, h = (gi & 3) * 2 + (lc >> 4), row0 = b * TPB + CTX + (lc & 15) * 128;
        const size_t kb = (size_t)b * TPB * ODD_IN;
        att::attn_unit<128, false, false, ODD_IN, ODD_IN, ODD_IN, 2, 0, 8, true, 3>(Y1 + (size_t)row0 * ODD_IN + h * 128, Y1 + kb + 1024 + h * 128, Y1 + kb + 2048 + h * 128,
                                                                             MIX + (size_t)row0 * DM + h * 128, 36, 0, 0, 0.125f, lam, lds, gsub, a.in[I_CQN], (const float*)(F.ws + WS_ROPE + 16384), (lc & 15) * 128, L_.wave);
    }
#else
    for (int n = blockIdx.x; n < 1024; n += F.G) {
        const int i = n >> 8, c = n & 255, x = c & 7, lc = c >> 3, gi = i * 8 + x, b = gi >> 2, ch = (gi & 3) * 4 + (lc >> 3), row0 = b * TPB + CTX + (lc & 7) * 256;
        const size_t kb = (size_t)b * TPB * ODD_IN;
        att::attn_unit<64, false, false, ODD_IN, ODD_IN, ODD_IN, 2, 0, 8>(Y1 + (size_t)row0 * ODD_IN + ch * 64, Y1 + kb + 1024 + ch * 64, Y1 + kb + 2048 + (ch >> 1) * 128,
                                                                       O12 + (size_t)row0 * DM + ch * 128, 36, 0, 0, 0.125f, 0.f, lds, nullptr, nullptr, nullptr, -1, L_.wave);
    }
#endif
    for (int m = blockIdx.x; m < 512; m += F.G) {
        const int i = m >> 8, c = m & 255, x = c & 7, lc = c >> 3, gi = i * 8 + x, b = gi >> 1, kvh = gi & 1, h = kvh * 4 + (lc >> 3), s0 = (lc & 7) * 256, row0 = b * TPB + CTX + s0;
        const int lo = s0 - 128 < 0 ? 0 : s0 - 128, hie = s0 + 384 > SEQ ? SEQ : s0 + 384;
        const size_t kb = (size_t)b * TPB * ODD_IN;
        att::attn_unit<128, true, true, ODD_IN, ODD_IN, ODD_IN, 1, 0, 8, false, 1>(Y1 + (size_t)row0 * ODD_IN + 3072 + h * 128, Y1 + kb + 4096 + kvh * 128, Y1 + kb + 4352 + kvh * 128,
                                                                      MIX + (size_t)row0 * DM + 1024 + h * 128, 4 + (hie - lo) / 64, lo, s0, 0.08838834764831845f, a.in[I_SINK][h], lds, nullptr, a.in[I_DQN], (const float*)(F.ws + WS_ROPE), s0, L_.wave);
    }
    __syncthreads();
}
__device__ __forceinline__ void p_odd_combine(const Frame& F, const Args& a) {
    const LocalId L_ = local_id(); (void)L_;
    const int gw = F.vcu * NWAVES + L_.wave, NGW = F.G * NWAVES;
    const bf16* O12 = (const bf16*)(F.ws + WS_A1); bf16* MIX = (bf16*)(F.ws + WS_MIX);
    float d1 = 0.f, d2 = 0.f;
    for (int i = 0; i < 64; ++i) { d1 += a.in[I_LQ1][i] * a.in[I_LK1][i]; d2 += a.in[I_LQ2][i] * a.in[I_LK2][i]; }
    const float lam = expf(d1) - expf(d2) + LAMBDA_INIT;
    const float g0 = a.in[I_SUBLN][L_.lane] * (1.0f - LAMBDA_INIT), g1 = a.in[I_SUBLN][L_.lane + 64] * (1.0f - LAMBDA_INIT);
    for (int i = gw; i < NB * SEQ; i += NGW) {
        const int b = i / SEQ, row = b * TPB + CTX + (i - b * SEQ);
        const bf16* src = O12 + (size_t)row * DM; bf16* dst = MIX + (size_t)row * DM;
        for (int h = 0; h < 8; ++h) {
            const float x0 = bf2f(src[2 * h * 128 + L_.lane]) - lam * bf2f(src[(2 * h + 1) * 128 + L_.lane]);
            const float x1 = bf2f(src[2 * h * 128 + 64 + L_.lane]) - lam * bf2f(src[(2 * h + 1) * 128 + 64 + L_.lane]);
            const float ss = wave_sum(x0 * x0 + x1 * x1);
            const float r = 1.0f / sqrtf(ss * (1.0f / 128.0f) + NORM_EPS);
            dst[h * 128 + L_.lane] = (bf16)f2bf(x0 * r * g0); dst[h * 128 + 64 + L_.lane] = (bf16)f2bf(x1 * r * g1);
        }
    }
}

__global__ void __launch_bounds__(NWAVES * 64, 2) trunk_fwd(Args args) {
    extern __shared__ __attribute__((aligned(16))) unsigned char lds[];
    Frame F;
    F.lds = (LAS unsigned char*)lds;
    F.MISC = (volatile LAS unsigned*)(F.lds + MISC_OFF);
    F.tid = threadIdx.x; F.lane = F.tid & 63; F.wave = __builtin_amdgcn_readfirstlane(F.tid >> 6);
    F.G = gridDim.x; { const int bx = blockIdx.x; F.vcu = (F.G % 8 == 0) ? (bx % 8) * (F.G / 8) + bx / 8 : bx; }
    F.ws = args.ws; F.ctl = (gu32*)(args.ws + WS_CTL);
    for (int u = F.tid; u < (LDS_BYTES - LDSCTL_OFF) / 4; u += NWAVES * 64) ((LAS unsigned*)(F.lds + LDSCTL_OFF))[u] = 0u;
    __syncthreads();
    XcdBarrier bar; bar.bar = (unsigned*)(F.ctl + CW_BAR); bar.x = 0; bar.st = nullptr;
#if !MK_PER_PHASE
    bar = xcd_barrier_post((unsigned*)(F.ctl + CW_BAR), F.MISC + 8);
#endif
    const int lo = args.ph_lo, hi = args.ph_hi;
#define IN(k) (lo <= (k) && (k) < hi)
#if MK_PER_PHASE
#define SEAM(k) do { } while (0)
#else
#define SEAM(k) do { if (IN(k) && IN((k) + 1)) xcd_barrier(bar); } while (0)
#endif
    bf16* const A1 = (bf16*)(F.ws + WS_A1); bf16* const MIX = (bf16*)(F.ws + WS_MIX); bf16* const H = (bf16*)(F.ws + WS_H); const float* const MOD = (const float*)(F.ws + WS_MOD);
    PG8_LAS unsigned char* const ring = (PG8_LAS unsigned char*)(F.lds + RING_OFF);

#ifndef DUP_PHASE
#define DUP_PHASE (-1)
#endif
#ifndef PROBE_PHASE
#define PROBE_PHASE (-1)
#endif
constexpr size_t WS_DUMMY = 1600 * MiB;
#define PROBE(k, ...) do { if (PROBE_PHASE == (k) && IN(k)) { for (int r_ = 0; r_ < 3; ++r_) { __VA_ARGS__ xcd_barrier(bar); } } } while (0)
#define PH(k, ...) do { if (IN(k)) { __VA_ARGS__ if (DUP_PHASE == (k)) { for (int r_ = 0; r_ < 3; ++r_) { xcd_barrier(bar); __VA_ARGS__ } } } SEAM(k); } while (0)
#define GEMM_STATIC(EPI, Aptr, Bptr, N_, K_, ...) do { pg8::Gemm g{(const bf16*)(Aptr), (const bf16*)(Bptr), (K_), (K_), (K_), nullptr}; pg8::StaticOrder S; S.init(T, (N_), F.G, (int)blockIdx.x); \
        pg8::EPI E{__VA_ARGS__}; pg8::gemm_phase<pg8::EPI, pg8::StaticOrder, false>(ring, g, S, E, F.wave); } while (0)
#ifndef MOE_F32B
#define MOE_F32B 0
#endif
#define GEMM_MOE_F(EPI, GATH, Aptr, M0, M1, ESTR, LDN, COLMUL, HOFF, K_, layer, ...) do { const int nrt = __builtin_amdgcn_readfirstlane(*(const int*)(F.ctl + CW_NRT + (layer) * 64)); \
        pg8::Gemm g{(const bf16*)(Aptr), nullptr, (K_), 0, (K_), (const int*)(F.ctl + CW_SLOT + (layer) * MAXSLOT)}; pg8::BSrc bs{(M0), (M1), (size_t)(ESTR), (LDN), (COLMUL), (HOFF)}; \
        pg8::MoeOrder S; S.init((const int*)(F.ctl + CW_TEXP + (layer) * 256), nrt, F.G, (int)blockIdx.x); \
        pg8::EPI E{__VA_ARGS__}; pg8::gemm_phase_f32b<pg8::EPI, pg8::MoeOrder, GATH>(ring, g, bs, S, E, F.wave); } while (0)
#define GEMM_ORDER(EPI, ORDER, INIT, Aptr, Bptr, K_, ...) do { pg8::Gemm g{(const bf16*)(Aptr), (const bf16*)(Bptr), (K_), (K_), (K_), nullptr}; pg8::ORDER S; S.init INIT; \
        pg8::EPI E{__VA_ARGS__}; pg8::gemm_phase<pg8::EPI, pg8::ORDER, false>(ring, g, S, E, F.wave); } while (0)
#define GEMM_ROUTER_X(Bptr) do { pg8::Gemm g{(const bf16*)A1, (const bf16*)(Bptr), DM, DM, DM / RKS, nullptr}; pg8::SplitKXOrder S; S.init(RKS, DM / RKS, F.G, (int)blockIdx.x); \
        pg8::EpiLogits E{(float*)(ws + WS_LG), DM / RKS, (size_t)T * 64}; pg8::gemm_phase<pg8::EpiLogits, pg8::SplitKXOrder, false>(ring, g, S, E, F.wave); } while (0)
#define GEMM_ROUTER(Bptr) do { pg8::Gemm g{(const bf16*)A1, (const bf16*)(Bptr), DM, DM, DM / RKS, nullptr}; pg8::SplitKOrder S; S.init(T / 256, RKS, DM / RKS, F.G, (int)blockIdx.x); \
        pg8::EpiLogits E{(float*)(ws + WS_LG), DM / RKS, (size_t)T * 64}; pg8::gemm_phase<pg8::EpiLogits, pg8::SplitKOrder, false>(ring, g, S, E, F.wave); } while (0)
#define GEMM_MOE(EPI, GATH, Aptr, Bptr, K_, layer, ...) do { const int nrt = __builtin_amdgcn_readfirstlane(moe_tables(F, (layer), F.wave * 64 + lane_id_())); \
        pg8::Gemm g{(const bf16*)(Aptr), (const bf16*)(Bptr), (K_), (K_), (K_), (const int*)(ws + WS_POS) + (size_t)(layer) * NE * POSCAP}; pg8::MoeOrder S; \
        S.init((const PG8_LAS int*)(F.lds + LDS_TAB), (const PG8_LAS int*)(F.lds + LDS_TAB) + 256, nrt, POSCAP, F.G, (int)blockIdx.x); \
        pg8::EPI E{__VA_ARGS__}; pg8::gemm_phase<pg8::EPI, pg8::MoeOrder, GATH>(ring, g, S, E, F.wave); } while (0)
    unsigned char* const ws = F.ws;
    PH(0, p0_prologue(F, args););
    PH(1, p_l0_mod1(F, args););
#ifdef NEXTRA_BAR
    for (int i_ = 0; i_ < NEXTRA_BAR; ++i_) xcd_barrier(bar);
#endif
    PH(2, GEMM_STATIC(EpiStoreBf16, A1, ws + WS_WE_IN, EVEN_IN_P, DM, (bf16*)(ws + WS_Y1), EVEN_IN_P, 0x7fffffff););
    PROBE(3, p_even_post1(F, args, WS_DUMMY););
    PH(3, p_even_post1(F, args););
    PH(4, GEMM_STATIC(EpiStoreBf16, ws + WS_CQN, ws + WS_WE_UQ, 1536, 512, (bf16*)(ws + WS_QB), 1536, 0x7fffffff);
          GEMM_STATIC(EpiStoreBf16, ws + WS_CKVN, ws + WS_WE_UKV, 2048, 512, (bf16*)(ws + WS_KV), 2048, 0x7fffffff););
    PH(5, p_even_post2(F, args););
#if USE_NAIVE_ATTN
    PH(6, p_even_attn_naive(F););
#else
    PH(6, p_even_attn(F, args, (char*)lds););
#endif
    PH(7, GEMM_STATIC(EpiResidInit, MIX, ws + WS_WE_OUT, DM, DM, H, MOD + (size_t)0 * 9 * 12288 + 2 * 2048, args.in[I_X], args.in[I_CTX]););
#if FUSED_ROUTE
    PH(8, p_mod2_route(F, args, 0););
#else
    PH(8, p_mod2(F, 0););
    PH(9, GEMM_ROUTER(ws + WS_WR););
    PH(10, p_route(F, args, 0););
#endif
#if MOE_F32B
    PH(12, GEMM_MOE_F(EpiSwiGLU, true, A1, args.in[I_WG], args.in[I_WU], 2048 * 1024, 1024, 128, 0, DM, 0, (bf16*)(ws + WS_U), DE););
    PH(13, GEMM_MOE_F(EpiStoreBf16, false, ws + WS_U, args.in[I_WD], args.in[I_WD], 1024 * 2048, 2048, 256, 128, DE, 0, (bf16*)(ws + WS_YS), DM, 7););
#else
    PH(12, GEMM_MOE(EpiSwiGLU, true, A1, ws + WS_WGU, DM, 0, (bf16*)(ws + WS_U), DE););
    PH(13, GEMM_MOE(EpiStoreBf16, false, ws + WS_U, ws + WS_WDN, DE, 0, (bf16*)(ws + WS_YS), DM, 7););
#endif
    PROBE(14, p_l1_mod1(F, WS_DUMMY, WS_DUMMY + 160 * MiB););
    PH(14, p_l1_mod1(F););
    PH(15, GEMM_ORDER(EpiStoreBf16, OddInOrder, (F.G, (int)blockIdx.x), A1, ws + WS_WO_IN, DM, (bf16*)(ws + WS_Y1), ODD_IN, 0x7fffffff););
    PROBE(16, p_odd_post1(F, args, WS_DUMMY););
    PH(16, p_odd_post1(F, args););
#if USE_NAIVE_ATTN
    PH(17, p_odd_attn_naive(F, args););
    PH(18, ;);
#else
    PH(17, p_odd_attn(F, args, (char*)lds););
#if !ATT_DIFF_FUSED
    PH(18, p_odd_combine(F, args););
#endif
#endif
    PH(19, GEMM_ORDER(EpiResid, XOnlyOrder, (DM, F.G, (int)blockIdx.x), MIX, ws + WS_WO_OUT, DM, H, MOD + (size_t)1 * 9 * 12288 + 2 * 2048););
#if FUSED_ROUTE
    PH(20, p_mod2_route(F, args, 1););
#else
    PH(20, p_mod2(F, 1););
    PH(21, GEMM_ROUTER_X((const bf16*)(ws + WS_WR) + (size_t)256 * 2048););
    PH(22, p_route(F, args, 1););
#endif
#if MOE_F32B
    PH(24, GEMM_MOE_F(EpiSwiGLU, true, A1, args.in[I_WG] + (size_t)32 * 2048 * 1024, args.in[I_WU] + (size_t)32 * 2048 * 1024, 2048 * 1024, 1024, 128, 0, DM, 1, (bf16*)(ws + WS_U), DE););
    PH(25, GEMM_MOE_F(EpiStoreBf16, false, ws + WS_U, args.in[I_WD] + (size_t)32 * 1024 * 2048, args.in[I_WD] + (size_t)32 * 1024 * 2048, 1024 * 2048, 2048, 256, 128, DE, 1, (bf16*)(ws + WS_YS), DM, 7););
#else
    PH(24, GEMM_MOE(EpiSwiGLU, true, A1, (const bf16*)(ws + WS_WGU) + (size_t)32 * 2048 * 2048, DM, 1, (bf16*)(ws + WS_U), DE););
    PH(25, GEMM_MOE(EpiStoreBf16, false, ws + WS_U, (const bf16*)(ws + WS_WDN) + (size_t)32 * 2048 * 1024, DE, 1, (bf16*)(ws + WS_YS), DM, 7););
#endif
    PH(26, p_final(F, args.out););
#undef IN
#undef SEAM
}

extern "C" void kernel_launch(void* const* d_in, const int* in_sizes, int n_in, void* d_out, int out_size, void* d_ws, size_t ws_size, hipStream_t stream) {
    static int grid = 0;
    if (grid == 0) {
        if (n_in != 35 || out_size != NB * SEQ * DM || ws_size < WS_END) { fprintf(stderr, "kernel_launch: unexpected shapes: n_in %d out %d ws %zu (need %zu)\n", n_in, out_size, ws_size, (size_t)WS_END); grid = -1; return; }
        int dev = 0, cus = 0, per_cu = 0;
        if (hipGetDevice(&dev) != hipSuccess || hipDeviceGetAttribute(&cus, hipDeviceAttributeMultiprocessorCount, dev) != hipSuccess) { grid = -1; return; }
        if (hipFuncSetAttribute((const void*)trunk_fwd, hipFuncAttributeMaxDynamicSharedMemorySize, LDS_BYTES) != hipSuccess) { fprintf(stderr, "kernel_launch: hipFuncSetAttribute failed\n"); grid = -1; return; }
        if (hipOccupancyMaxActiveBlocksPerMultiprocessor(&per_cu, (const void*)trunk_fwd, NWAVES * 64, LDS_BYTES) != hipSuccess || per_cu < 1)
            fprintf(stderr, "kernel_launch: occupancy query reports %d workgroups per CU\n", per_cu);
        (void)hipGetLastError();
        grid = cus;
    }
    if (grid < 0) return;
    if (hipMemsetAsync((char*)d_ws + WS_CTL, 0, CTL_ZERO_BYTES, stream) != hipSuccess) { fprintf(stderr, "kernel_launch: memset failed\n"); return; }
    if (hipMemsetAsync((char*)d_ws + WS_POS, 0, (size_t)2 * NE * POSCAP * 4, stream) != hipSuccess) { fprintf(stderr, "kernel_launch: memset failed\n"); return; }
    Args a{};
    for (int i = 0; i < 35; ++i) a.in[i] = (const float*)d_in[i];
    a.out = (float*)d_out; a.ws = (unsigned char*)d_ws;
#if MK_PER_PHASE
    for (int p = 0; p < NPHASE; ++p) { a.ph_lo = p; a.ph_hi = p + 1; hipLaunchKernelGGL(trunk_fwd, dim3(grid), dim3(NWAVES * 64), LDS_BYTES, stream, a); }
#else
    a.ph_lo = 0; a.ph_hi = NPHASE; hipLaunchKernelGGL(trunk_fwd, dim3(grid), dim3(NWAVES * 64), LDS_BYTES, stream, a);
#endif
    const hipError_t le = hipPeekAtLastError();
    if (le != hipSuccess) fprintf(stderr, "kernel_launch: launch failed: %s\n", hipGetErrorName(le));
}
```

```cpp
#include <hip/hip_runtime.h>
#include <cstdio>
#include <cstdint>
__device__ __forceinline__ int lane_id_() { return (int)__builtin_amdgcn_mbcnt_hi(~0u, __builtin_amdgcn_mbcnt_lo(~0u, 0u)); }
#define MK_PER_PHASE 0
namespace pg8 {
#define PG8_LAS __attribute__((address_space(3)))
typedef unsigned short bf16_t;
typedef short bf16x8 __attribute__((ext_vector_type(8)));
typedef float f32x4 __attribute__((ext_vector_type(4)));
typedef unsigned u32x4 __attribute__((ext_vector_type(4)));
constexpr int BM = 256, BK = 64, HALF = 128, HTB = HALF * BK * 2  , STAGE_BYTES = 8 * HTB, NXCD = 8, WGM = 8;

__host__ __device__ __forceinline__ int lds_byte(int r, int c) { const int st = (r >> 4) * 2 + (c >> 5), rr = r & 15, cc = c & 31, ob = rr * 64 + cc * 2; return st * 1024 + (ob ^ (((ob >> 9) & 1) << 5)); }
__host__ __device__ __forceinline__ void stage_rc(int b, int& R, int& C) { const int st = b / 1024, sb = b % 1024, swz = sb ^ (((sb >> 9) & 1) << 5); R = (st >> 1) * 16 + swz / 64; C = (st & 1) * 32 + (swz % 64) / 2; }
__host__ __device__ __forceinline__ int perm32(int rho) { const int n = rho >> 4, i = rho & 15; return 8 * (i >> 2) + 4 * n + (i & 3); }

struct Unit { int pm, pn, ko, kt, gb; };
struct Gemm { const bf16_t* A; const bf16_t* Bt; int lda, ldb, K; const int* rowidx; };

struct StaticOrder {
    int nM, nN, nwg, G, c;
    __host__ __device__ void init(int M, int N, int G_, int c_) { nM = M / BM; nN = N / BM; nwg = nM * nN; G = G_; c = c_; }
    __host__ __device__ bool next(int i, Unit& u) const {
        const long L = (long)i * G + c; if (L >= nwg) return false;
        int wgid = (int)L; { const int q = nwg / NXCD, r = nwg % NXCD, xcd = wgid % NXCD, off = wgid / NXCD; wgid = (xcd < r ? xcd * (q + 1) : r * (q + 1) + (xcd - r) * q) + off; }
        const int nig = WGM * nN, gid = wgid / nig, fm = gid * WGM, gsz = (nM - fm) < WGM ? (nM - fm) : WGM;
        u.pm = fm + ((wgid % nig) % gsz); u.pn = (wgid % nig) / gsz; u.ko = 0; u.kt = 0; u.gb = u.pm * BM; return true;
    }
    __device__ __forceinline__ void a_ready(const Unit&) const {}
    __device__ __forceinline__ void done(const Unit&) const {}
};


__device__ __forceinline__ unsigned cvt_pk_bf16(float lo, float hi) { unsigned r; asm volatile("v_cvt_pk_bf16_f32 %0, %1, %2" : "=v"(r) : "v"(lo), "v"(hi)); return r; }

struct EpiStoreBf16 {
    static constexpr bool PERM = true, AFTER_DRAIN = false;
    bf16_t* O; int ldc; int pn_mask;
    __device__ __forceinline__ void operator()(const f32x4 (&acc)[2][2][4][2], const Unit& u, int wr, int wc, int fr, int fq) const {
        const int row0 = u.pm * BM + wr * 64 + fr, col0 = (u.pn & pn_mask) * BM + wc * 32 + 8 * fq;
#pragma unroll
        for (int ai = 0; ai < 2; ++ai)
#pragma unroll
            for (int m = 0; m < 4; ++m) { bf16_t* rowp = O + (size_t)(row0 + ai * HALF + m * 16) * ldc + col0;
#pragma unroll
                for (int bj = 0; bj < 2; ++bj) { const f32x4 v0 = acc[ai][bj][m][0], v1 = acc[ai][bj][m][1];
                    u32x4 w; w.x = cvt_pk_bf16(v0[0], v0[1]); w.y = cvt_pk_bf16(v0[2], v0[3]); w.z = cvt_pk_bf16(v1[0], v1[1]); w.w = cvt_pk_bf16(v1[2], v1[3]);
                    *(u32x4*)(rowp + bj * HALF) = w; } }
    }
};
__device__ __forceinline__ float silu_f(float x) { return x * __builtin_amdgcn_rcpf(1.0f + __builtin_amdgcn_exp2f(-1.4426950408889634f * x)); }
struct EpiSwiGLU {
    static constexpr bool PERM = true, AFTER_DRAIN = false;
    bf16_t* O; int ldc;
    __device__ __forceinline__ void operator()(const f32x4 (&acc)[2][2][4][2], const Unit& u, int wr, int wc, int fr, int fq) const {
        const int row0 = u.pm * BM + wr * 64 + fr, col0 = (u.pn & 7) * HALF + wc * 32 + 8 * fq;
#pragma unroll
        for (int ai = 0; ai < 2; ++ai)
#pragma unroll
            for (int m = 0; m < 4; ++m) { bf16_t* rowp = O + (size_t)(row0 + ai * HALF + m * 16) * ldc + col0;
                const f32x4 g0 = acc[ai][0][m][0], g1 = acc[ai][0][m][1], u0 = acc[ai][1][m][0], u1 = acc[ai][1][m][1];
                u32x4 w; w.x = cvt_pk_bf16(silu_f(g0[0]) * u0[0], silu_f(g0[1]) * u0[1]); w.y = cvt_pk_bf16(silu_f(g0[2]) * u0[2], silu_f(g0[3]) * u0[3]);
                w.z = cvt_pk_bf16(silu_f(g1[0]) * u1[0], silu_f(g1[1]) * u1[1]); w.w = cvt_pk_bf16(silu_f(g1[2]) * u1[2], silu_f(g1[3]) * u1[3]);
                *(u32x4*)rowp = w; }
    }
};
__device__ __forceinline__ float bf_lo(unsigned w) { return __builtin_bit_cast(float, w << 16); }
__device__ __forceinline__ float bf_hi(unsigned w) { return __builtin_bit_cast(float, w & 0xffff0000u); }
struct EpiResid {
    static constexpr bool PERM = true, AFTER_DRAIN = false;
    bf16_t* H; const float* modg;
    __device__ __forceinline__ void operator()(const f32x4 (&acc)[2][2][4][2], const Unit& u, int wr, int wc, int fr, int fq) const {
        const int row0 = u.pm * BM + wr * 64 + fr, col0 = u.pn * BM + wc * 32 + 8 * fq;
        const int j = (u.pm % 9 == 0) ? 8 : (u.pm / 9);
        const float* g = modg + (size_t)j * 12288 + col0;
        f32x4 gv[2][2];
#pragma unroll
        for (int bj = 0; bj < 2; ++bj)
#pragma unroll
            for (int n = 0; n < 2; ++n) gv[bj][n] = *(const f32x4*)(g + bj * HALF + 4 * n);
#pragma unroll
        for (int ai = 0; ai < 2; ++ai)
#pragma unroll
            for (int m = 0; m < 4; ++m) { bf16_t* rowp = H + (size_t)(row0 + ai * HALF + m * 16) * 2048 + col0;
#pragma unroll
                for (int bj = 0; bj < 2; ++bj) { u32x4* p = (u32x4*)(rowp + bj * HALF); const u32x4 h = *p;
                    const f32x4 a0 = gv[bj][0] * acc[ai][bj][m][0], a1 = gv[bj][1] * acc[ai][bj][m][1];
                    u32x4 w; w.x = cvt_pk_bf16(bf_lo(h.x) + a0[0], bf_hi(h.x) + a0[1]); w.y = cvt_pk_bf16(bf_lo(h.y) + a0[2], bf_hi(h.y) + a0[3]);
                    w.z = cvt_pk_bf16(bf_lo(h.z) + a1[0], bf_hi(h.z) + a1[1]); w.w = cvt_pk_bf16(bf_lo(h.w) + a1[2], bf_hi(h.w) + a1[3]);
                    *p = w; } }
    }
};
struct EpiResidInit {
    static constexpr bool PERM = true, AFTER_DRAIN = false;
    bf16_t* H; const float* modg; const float* xin; const float* ctxin;
    __device__ __forceinline__ void operator()(const f32x4 (&acc)[2][2][4][2], const Unit& u, int wr, int wc, int fr, int fq) const {
        const int rl0 = wr * 64 + fr, col0 = u.pn * BM + wc * 32 + 8 * fq;
        const int b = u.pm / 9, t = u.pm - 9 * b, j = (t == 0) ? 8 : b;
        const float* src = (t == 0) ? ctxin + (size_t)(b * 256) * 2048 : xin + (size_t)(b * 2048 + (t - 1) * 256) * 2048;
        const float* g = modg + (size_t)j * 12288 + col0;
        f32x4 gv[2][2];
#pragma unroll
        for (int bj = 0; bj < 2; ++bj)
#pragma unroll
            for (int n = 0; n < 2; ++n) gv[bj][n] = *(const f32x4*)(g + bj * HALF + 4 * n);
#pragma unroll
        for (int ai = 0; ai < 2; ++ai)
#pragma unroll
            for (int m = 0; m < 4; ++m) { const int rl = rl0 + ai * HALF + m * 16; bf16_t* rowp = H + (size_t)(u.pm * BM + rl) * 2048 + col0; const float* srow = src + (size_t)rl * 2048 + col0;
#pragma unroll
                for (int bj = 0; bj < 2; ++bj) { const f32x4 h0 = *(const f32x4*)(srow + bj * HALF), h1 = *(const f32x4*)(srow + bj * HALF + 4);
                    const f32x4 v0 = h0 + gv[bj][0] * acc[ai][bj][m][0], v1 = h1 + gv[bj][1] * acc[ai][bj][m][1];
                    u32x4 w; w.x = cvt_pk_bf16(v0[0], v0[1]); w.y = cvt_pk_bf16(v0[2], v0[3]); w.z = cvt_pk_bf16(v1[0], v1[1]); w.w = cvt_pk_bf16(v1[2], v1[3]);
                    *(u32x4*)(rowp + bj * HALF) = w; } }
    }
};
struct EpiLogits {
    static constexpr bool PERM = false, AFTER_DRAIN = false;
    float* LG; int kslice; size_t slice_stride;
    __device__ __forceinline__ void operator()(const f32x4 (&acc)[2][2][4][2], const Unit& u, int wr, int wc, int fr, int fq) const {
        if (wc >= 2) return;
        const int row0 = u.pm * BM + wr * 64 + fr, col0 = wc * 32 + 4 * fq;
        float* base = LG + (size_t)(u.ko / kslice) * slice_stride;
#pragma unroll
        for (int ai = 0; ai < 2; ++ai)
#pragma unroll
            for (int m = 0; m < 4; ++m) { float* rowp = base + (size_t)(row0 + ai * HALF + m * 16) * 64 + col0;
#pragma unroll
                for (int n = 0; n < 2; ++n) *(f32x4*)(rowp + n * 16) = acc[ai][0][m][n]; }
    }
};
struct SplitKOrder {
    int nM, KS, kslice, G, c;
    __device__ void init(int nM_, int KS_, int kslice_, int G_, int c_) { nM = nM_; KS = KS_; kslice = kslice_; G = G_; c = c_; }
    __device__ bool next(int i, Unit& u) const { const long L = (long)i * G + c; if (L >= (long)nM * KS) return false; const int ks = (int)L / nM; u.pm = (int)L - ks * nM; u.pn = 0; u.ko = ks * kslice; u.kt = 0; u.gb = 0; return true; }
    __device__ __forceinline__ void a_ready(const Unit&) const {}
    __device__ __forceinline__ void done(const Unit&) const {}
};
struct EvenInOrder {
    StaticOrder so; int G, c;
    __device__ void init(int M, int G_, int c_) { so.init(M, 2560, G_, c_); G = G_; c = c_; }
    __device__ bool next(int i, Unit& u) const {
        if (so.next(i, u)) return true;
        const long L = (long)i * G + c - so.nwg; if (L < 0 || L >= 72 * 4) return false;
        const int ks = (int)L / 72; u.pm = (int)L - ks * 72; u.pn = 10; u.ko = ks * 512; u.kt = 8; u.gb = 0; return true;
    }
    __device__ __forceinline__ void a_ready(const Unit&) const {}
    __device__ __forceinline__ void done(const Unit&) const {}
};
struct EpiEvenIn {
    static constexpr bool PERM = true, AFTER_DRAIN = false;
    bf16_t* Y; float* KRP;
    __device__ __forceinline__ void operator()(const f32x4 (&acc)[2][2][4][2], const Unit& u, int wr, int wc, int fr, int fq) const {
        if (u.pn < 10) { const EpiStoreBf16 e{Y, 2816, 0x7fffffff}; e(acc, u, wr, wc, fr, fq); return; }
        if (wc >= 2) return;
        const int row0 = u.pm * BM + wr * 64 + fr, col0 = wc * 32 + 8 * fq;
        float* base = KRP + (size_t)(u.ko >> 9) * ((size_t)18432 * 64);
#pragma unroll
        for (int ai = 0; ai < 2; ++ai)
#pragma unroll
            for (int m = 0; m < 4; ++m) { float* rowp = base + (size_t)(row0 + ai * HALF + m * 16) * 64 + col0;
#pragma unroll
                for (int n = 0; n < 2; ++n) *(f32x4*)(rowp + 4 * n) = acc[ai][0][m][n]; }
    }
};
struct Proj2Order {
    StaticOrder s1, s2; int G, c;
    __device__ void init(int M, int G_, int c_) { s1.init(M, 1536, G_, c_); s2.init(M, 2048, G_, c_); G = G_; c = c_; }
    __device__ bool next(int i, Unit& u) const {
        if (s1.next(i, u)) return true;
        StaticOrder t = s2; const long L = (long)i * G + c - s1.nwg; if (L < 0 || L >= s2.nwg) return false;
        t.G = 1; t.c = (int)L; if (!t.next(0, u)) return false;
        u.pm += 72; u.pn += 8; return true;
    }
    __device__ __forceinline__ void a_ready(const Unit&) const {}
    __device__ __forceinline__ void done(const Unit&) const {}
};
struct EpiProj2 {
    static constexpr bool PERM = true, AFTER_DRAIN = false;
    bf16_t* QB; bf16_t* KV;
    __device__ __forceinline__ void operator()(const f32x4 (&acc)[2][2][4][2], const Unit& u, int wr, int wc, int fr, int fq) const {
        if (u.pm < 72) { const EpiStoreBf16 e{QB, 1536, 0x7fffffff}; e(acc, u, wr, wc, fr, fq); }
        else { Unit v = u; v.pm -= 72; v.pn -= 8; const EpiStoreBf16 e{KV, 2048, 0x7fffffff}; e(acc, v, wr, wc, fr, fq); }
    }
};
struct XOnlyOrder {
    StaticOrder so;
    __device__ void init(int N, int G_, int c_) { so.init(64 * BM, N, G_, c_); }
    __device__ bool next(int i, Unit& u) const { if (!so.next(i, u)) return false; u.pm = 9 * (u.pm >> 3) + 1 + (u.pm & 7); return true; }
    __device__ __forceinline__ void a_ready(const Unit&) const {}
    __device__ __forceinline__ void done(const Unit&) const {}
};
struct OddInOrder {
    StaticOrder so; int G, c;
    __device__ void init(int G_, int c_) { so.init(64 * BM, 18 * BM, G_, c_); G = G_; c = c_; }
    __device__ bool next(int i, Unit& u) const {
        if (so.next(i, u)) { u.pm = 9 * (u.pm >> 3) + 1 + (u.pm & 7); return true; }
        const long L = (long)i * G + c - 64 * 18; if (L >= 80) return false;
        const int b = (int)L / 10, j = (int)L - b * 10; u.pm = 9 * b; u.pn = j < 8 ? 4 + j : 8 + j; u.ko = 0; u.kt = 0; u.gb = 0; return true;
    }
    __device__ __forceinline__ void a_ready(const Unit&) const {}
    __device__ __forceinline__ void done(const Unit&) const {}
};
struct SplitKXOrder {
    int KS, kslice, G, c;
    __device__ void init(int KS_, int kslice_, int G_, int c_) { KS = KS_; kslice = kslice_; G = G_; c = c_; }
    __device__ bool next(int i, Unit& u) const { const long L = (long)i * G + c; if (L >= 64L * KS) return false; const int ks = (int)L / 64, x = (int)L - ks * 64; u.pm = 9 * (x >> 3) + 1 + (x & 7); u.pn = 0; u.ko = ks * kslice; u.kt = 0; u.gb = 0; return true; }
    __device__ __forceinline__ void a_ready(const Unit&) const {}
    __device__ __forceinline__ void done(const Unit&) const {}
};
struct MoeOrder {
    const PG8_LAS int* texp; const PG8_LAS int* frt; int nunits, G, c, cap;
    __device__ void init(const PG8_LAS int* texp_, const PG8_LAS int* frt_, int n_row_tiles, int cap_, int G_, int c_) { texp = texp_; frt = frt_; nunits = n_row_tiles * 8; cap = cap_; G = G_; c = c_; }
    __device__ bool next(int i, Unit& u) const {
        const long L = (long)i * G + c; if (L >= nunits) return false;
        int wgid = (int)L; { const int q = nunits / NXCD, r = nunits % NXCD, xcd = wgid % NXCD, off = wgid / NXCD; wgid = (xcd < r ? xcd * (q + 1) : r * (q + 1) + (xcd - r) * q) + off; }
        const int rt = wgid >> 3, pn = wgid & 7, e = __builtin_amdgcn_readfirstlane(texp[rt]);
        u.pm = rt; u.pn = e * 8 + pn; u.ko = 0; u.kt = 0; u.gb = e * cap + (rt - __builtin_amdgcn_readfirstlane(frt[e])) * BM; return true;
    }
    __device__ __forceinline__ void a_ready(const Unit&) const {}
    __device__ __forceinline__ void done(const Unit&) const {}
};
template <class Epi, class Sched, bool GATHER = false>
__device__ __forceinline__ void gemm_phase(PG8_LAS unsigned char* lds, const Gemm g, const Sched& S, const Epi& E, int wv) {
    int tid = wv * 64 + lane_id_(); asm volatile("" : "+v"(tid));
    const int wid = __builtin_amdgcn_readfirstlane(tid >> 6), lane = tid & 63, wr = wid >> 2, wc = wid & 3, fr = lane & 15, fq = lane >> 4;
    const int K = g.K, lda = g.lda, ldb = g.ldb;
    unsigned va[2][2], vn[2][2], voffB[2]; int sR[2], sC[2];
#pragma unroll
    for (int i = 0; i < 2; ++i) { int R, C; stage_rc(tid * 16 + i * 8192, R, C); const int Rb = Epi::PERM ? ((R & ~31) + perm32(R & 31)) : R; sR[i] = R; sC[i] = C;
        voffB[i] = (unsigned)(Rb * ldb + C) * 2u;
        va[0][i] = (unsigned)(R * lda + C) * 2u; va[1][i] = (unsigned)((R + HALF) * lda + C) * 2u; vn[0][i] = va[0][i]; vn[1][i] = va[1][i]; }
    const size_t kstep = (size_t)(BK * 2);
    const size_t hstepB = (size_t)HALF * ldb * 2;
    const size_t tstepA = (size_t)BM * lda * 2, tstepB = (size_t)BM * ldb * 2;
    const unsigned ldsw = (unsigned)wid * 1024u;
    const int aoff = lds_byte(wr * 64 + fr, fq * 8), boff = lds_byte(wc * 32 + fr, fq * 8);
#define PG8_SA(b, h) (((b) * 2 + (h)) * HTB)
#define PG8_SB(b, h) ((4 + (b) * 2 + (h)) * HTB)
#define PG8_STAGE(bufoff, gbase, voff) do { _Pragma("unroll") for (int _i = 0; _i < 2; ++_i) \
        __builtin_amdgcn_global_load_lds((const unsigned*)((const char*)(gbase) + (voff)[_i]), (PG8_LAS unsigned*)(lds + (bufoff) + ldsw + _i * 8192), 16, 0, 0); } while (0)
#define PG8_LDA(dst, b, h) do { _Pragma("unroll") for (int m = 0; m < 4; ++m) _Pragma("unroll") for (int k = 0; k < 2; ++k) dst[m][k] = *(const PG8_LAS bf16x8*)(lds + PG8_SA(b, h) + aoff + m * 2048 + k * 1024); } while (0)
#define PG8_LDB(dst, b, h) do { _Pragma("unroll") for (int n = 0; n < 2; ++n) _Pragma("unroll") for (int k = 0; k < 2; ++k) dst[n][k] = *(const PG8_LAS bf16x8*)(lds + PG8_SB(b, h) + boff + n * 2048 + k * 1024); } while (0)
#define PG8_MMA(ai, bj, At, Bt) do { __builtin_amdgcn_s_setprio(1); _Pragma("unroll") for (int m = 0; m < 4; ++m) _Pragma("unroll") for (int n = 0; n < 2; ++n) _Pragma("unroll") for (int k = 0; k < 2; ++k) \
        acc[ai][bj][m][n] = __builtin_amdgcn_mfma_f32_16x16x32_bf16(Bt[n][k], At[m][k], acc[ai][bj][m][n], 0, 0, 0); __builtin_amdgcn_s_setprio(0); } while (0)
#define PG8_WAIT_V(n) asm volatile("s_waitcnt vmcnt(" #n ")" ::: "memory")
#define PG8_WAIT_L(n) asm volatile("s_waitcnt lgkmcnt(" #n ")" ::: "memory")
#define PG8_BAR __builtin_amdgcn_s_barrier()
#define PG8_SCHED __builtin_amdgcn_sched_barrier(0)
#define PG8_GATHER_OFFS(dst, u) do { if constexpr (GATHER) { _Pragma("unroll") for (int _h = 0; _h < 2; ++_h) _Pragma("unroll") for (int _i = 0; _i < 2; ++_i) \
        dst[_h][_i] = (unsigned)(g.rowidx[(u).gb + _h * HALF + sR[_i]] * lda + sC[_i]) * 2u; } } while (0)
    Unit cur, nxt; int ui = 0;
    if (!S.next(0, cur)) return;
    f32x4 acc[2][2][4][2];
#pragma unroll
    for (int a = 0; a < 2; ++a)
#pragma unroll
        for (int b = 0; b < 2; ++b)
#pragma unroll
            for (int m = 0; m < 4; ++m)
#pragma unroll
                for (int n = 0; n < 2; ++n) acc[a][b][m][n] = (f32x4){0.f, 0.f, 0.f, 0.f};
    bf16x8 At[4][2], B0[2][2], B1[2][2];
    const char* cA = (const char*)g.A + (GATHER ? (size_t)0 : (size_t)cur.pm * tstepA) + (size_t)cur.ko * 2; const char* cB = (const char*)g.Bt + (size_t)cur.pn * tstepB + (size_t)cur.ko * 2;
    PG8_GATHER_OFFS(va, cur);
    S.a_ready(cur);
    PG8_STAGE(PG8_SB(0, 0), cB, voffB); PG8_STAGE(PG8_SB(0, 1), cB + hstepB, voffB); PG8_STAGE(PG8_SA(0, 0), cA, va[0]); PG8_STAGE(PG8_SA(0, 1), cA, va[1]);
    if (wr == 1) PG8_BAR;
    PG8_WAIT_V(2); PG8_BAR;
    PG8_STAGE(PG8_SB(1, 0), cB + kstep, voffB); PG8_STAGE(PG8_SA(1, 0), cA + kstep, va[0]); PG8_STAGE(PG8_SB(1, 1), cB + hstepB + kstep, voffB);
    PG8_WAIT_V(6); PG8_BAR;
    for (;;) {
        const bool has_next = S.next(ui + 1, nxt);
        const char* nA = has_next ? (const char*)g.A + (GATHER ? (size_t)0 : (size_t)nxt.pm * tstepA) + (size_t)nxt.ko * 2 : cA; const char* nB = has_next ? (const char*)g.Bt + (size_t)nxt.pn * tstepB + (size_t)nxt.ko * 2 : cB;
        if constexpr (GATHER) { if (has_next) PG8_GATHER_OFFS(vn, nxt); else { _Pragma("unroll") for (int _h = 0; _h < 2; ++_h) _Pragma("unroll") for (int _i = 0; _i < 2; ++_i) vn[_h][_i] = va[_h][_i]; } }
        const int nt = K / BK;
        for (int t = 0; t < nt; t += 2) {
            const bool last = (t == nt - 2);
            const char* a1 = cA + (size_t)(t + 1) * kstep;
            const char* a2 = last ? nA : cA + (size_t)(t + 2) * kstep; const char* b2 = last ? nB : cB + (size_t)(t + 2) * kstep;
            const char* a3 = a2 + kstep; const char* b3 = b2 + kstep;
            unsigned v2[2][2];
#pragma unroll
            for (int _h = 0; _h < 2; ++_h)
#pragma unroll
                for (int _i = 0; _i < 2; ++_i) v2[_h][_i] = (GATHER && last) ? vn[_h][_i] : va[_h][_i];
            if (last && has_next) S.a_ready(nxt);
            PG8_LDB(B0, 0, 0); PG8_LDB(B1, 0, 1); PG8_SCHED; PG8_LDA(At, 0, 0); PG8_STAGE(PG8_SA(1, 1), a1, va[1]);
            PG8_WAIT_V(8); PG8_WAIT_L(0); PG8_BAR; PG8_MMA(0, 0, At, B0); PG8_MMA(0, 1, At, B1); PG8_BAR; PG8_SCHED;
            PG8_LDA(At, 0, 1); PG8_STAGE(PG8_SB(0, 0), b2, voffB); PG8_STAGE(PG8_SB(0, 1), b2 + hstepB, voffB); PG8_STAGE(PG8_SA(0, 0), a2, v2[0]);
            PG8_WAIT_V(8); PG8_WAIT_L(0); PG8_BAR; PG8_MMA(1, 0, At, B0); PG8_MMA(1, 1, At, B1); PG8_BAR; PG8_SCHED;
            PG8_LDB(B0, 1, 0); PG8_LDB(B1, 1, 1); PG8_SCHED; PG8_LDA(At, 1, 0); PG8_STAGE(PG8_SA(0, 1), a2, v2[1]);
            PG8_WAIT_V(8); PG8_WAIT_L(0); PG8_BAR; PG8_MMA(0, 0, At, B0); PG8_MMA(0, 1, At, B1); PG8_BAR; PG8_SCHED;
            PG8_LDA(At, 1, 1); PG8_STAGE(PG8_SB(1, 0), b3, voffB); PG8_STAGE(PG8_SB(1, 1), b3 + hstepB, voffB); PG8_STAGE(PG8_SA(1, 0), a3, v2[0]);
            PG8_WAIT_V(8); PG8_WAIT_L(0); PG8_BAR; PG8_MMA(1, 0, At, B0); PG8_MMA(1, 1, At, B1); PG8_BAR; PG8_SCHED;
        }
        if (wr == 0) PG8_BAR;
        E(acc, cur, wr, wc, fr, fq); S.done(cur);
        if (!has_next) break;
#pragma unroll
        for (int a = 0; a < 2; ++a)
#pragma unroll
            for (int b = 0; b < 2; ++b)
#pragma unroll
                for (int m = 0; m < 4; ++m)
#pragma unroll
                    for (int n = 0; n < 2; ++n) acc[a][b][m][n] = (f32x4){0.f, 0.f, 0.f, 0.f};
        cur = nxt; cA = nA; cB = nB; ++ui;
        if constexpr (GATHER) { _Pragma("unroll") for (int _h = 0; _h < 2; ++_h) _Pragma("unroll") for (int _i = 0; _i < 2; ++_i) va[_h][_i] = vn[_h][_i]; }
        if (wr == 1) PG8_BAR;
    }
    PG8_WAIT_V(0);
    PG8_BAR;
#undef PG8_SA
#undef PG8_SB
#undef PG8_STAGE
#undef PG8_LDA
#undef PG8_LDB
#undef PG8_MMA
#undef PG8_WAIT_V
#undef PG8_WAIT_L
#undef PG8_BAR
#undef PG8_SCHED
#undef PG8_GATHER_OFFS
}
typedef unsigned u32x2 __attribute__((ext_vector_type(2)));
struct BSrc { const float* m0; const float* m1; size_t estride; int ldn, colmul, hoff; };
template <class Epi, class Sched, bool GATHER = false>
__device__ __forceinline__ void gemm_phase_f32b(PG8_LAS unsigned char* lds, const Gemm g, const BSrc bs, const Sched& S, const Epi& E, int wv) {
    int tid = wv * 64 + lane_id_(); asm volatile("" : "+v"(tid));
    const int wid = __builtin_amdgcn_readfirstlane(tid >> 6), lane = tid & 63, wr = wid >> 2, wc = wid & 3, fr = lane & 15, fq = lane >> 4;
    const int K = g.K, lda = g.lda;
    unsigned va00, va01, va10, va11, vn00, vn01, vn10, vn11;
#pragma unroll
    for (int i = 0; i < 2; ++i) { int R, C; stage_rc(tid * 16 + i * 8192, R, C);
        const unsigned o0_ = (unsigned)(R * lda + C) * 2u, o1_ = (unsigned)((R + HALF) * lda + C) * 2u; if (i == 0) { va00 = o0_; va10 = o1_; } else { va01 = o0_; va11 = o1_; } }
    vn00 = va00; vn01 = va01; vn10 = va10; vn11 = va11;
    const size_t kstep = (size_t)(BK * 2);
    const size_t tstepA = (size_t)BM * lda * 2;
    const int kq = lane & 15, nq = (lane >> 4) + 4 * wid;
    const int brow = (nq >> 3) * 32 + (Epi::PERM ? (16 * (nq & 1) + 4 * ((nq & 7) >> 1)) : (4 * (nq & 7)));
    const int bwr = lds_byte(brow, 4 * kq);
    const unsigned bvo = (unsigned)((4 * kq) * bs.ldn + 4 * nq) * 4u;
    const size_t bkstep = (size_t)BK * bs.ldn * 4, brstep = (size_t)bs.ldn * 4;
    f32x4 w0, w1, w2, w3;
    const unsigned ldsw = (unsigned)wid * 1024u;
    const int aoff = lds_byte(wr * 64 + fr, fq * 8), boff = lds_byte(wc * 32 + fr, fq * 8);
#define PG8_SA(b, h) (((b) * 2 + (h)) * HTB)
#define PG8_SB(b, h) ((4 + (b) * 2 + (h)) * HTB)
#define PG8_BLOAD(src) do { const char* p0_ = (const char*)(src); const char* p1_ = p0_ + brstep; const char* p2_ = p1_ + brstep; const char* p3_ = p2_ + brstep; \
        asm volatile("s_nop 4\n\tglobal_load_dwordx4 %0, %4, %5\n\tglobal_load_dwordx4 %1, %4, %6\n\tglobal_load_dwordx4 %2, %4, %7\n\tglobal_load_dwordx4 %3, %4, %8" \
                     : "=&v"(w0), "=&v"(w1), "=&v"(w2), "=&v"(w3) : "v"(bvo), "s"(p0_), "s"(p1_), "s"(p2_), "s"(p3_)); } while (0)
#define PG8_BWAIT(n) asm volatile("s_waitcnt vmcnt(" #n ")" : "+v"(w0), "+v"(w1), "+v"(w2), "+v"(w3))
#define PG8_BWRITE(bufoff) do { PG8_LAS unsigned char* d_ = lds + (bufoff) + bwr; \
        { u32x2 c_; c_.x = cvt_pk_bf16(w0[0], w1[0]); c_.y = cvt_pk_bf16(w2[0], w3[0]); *(PG8_LAS u32x2*)(d_) = c_; } \
        { u32x2 c_; c_.x = cvt_pk_bf16(w0[1], w1[1]); c_.y = cvt_pk_bf16(w2[1], w3[1]); *(PG8_LAS u32x2*)(d_ + 64) = c_; } \
        { u32x2 c_; c_.x = cvt_pk_bf16(w0[2], w1[2]); c_.y = cvt_pk_bf16(w2[2], w3[2]); *(PG8_LAS u32x2*)(d_ + 128) = c_; } \
        { u32x2 c_; c_.x = cvt_pk_bf16(w0[3], w1[3]); c_.y = cvt_pk_bf16(w2[3], w3[3]); *(PG8_LAS u32x2*)(d_ + 192) = c_; } } while (0)
#define PG8_BSRC(u, h) ((const char*)(((h) ? bs.m1 : bs.m0) + (size_t)((u).pn >> 3) * bs.estride + (size_t)((u).pn & 7) * bs.colmul + (h) * bs.hoff) + (size_t)(u).ko * brstep)
#define PG8_STAGE(bufoff, gbase, o0, o1) do { \
        __builtin_amdgcn_global_load_lds((const unsigned*)((const char*)(gbase) + (o0)), (PG8_LAS unsigned*)(lds + (bufoff) + ldsw), 16, 0, 0); \
        __builtin_amdgcn_global_load_lds((const unsigned*)((const char*)(gbase) + (o1)), (PG8_LAS unsigned*)(lds + (bufoff) + ldsw + 8192), 16, 0, 0); } while (0)
#define PG8_LDA(dst, b, h) do { _Pragma("unroll") for (int m = 0; m < 4; ++m) _Pragma("unroll") for (int k = 0; k < 2; ++k) dst[m][k] = *(const PG8_LAS bf16x8*)(lds + PG8_SA(b, h) + aoff + m * 2048 + k * 1024); } while (0)
#define PG8_LDB(dst, b, h) do { _Pragma("unroll") for (int n = 0; n < 2; ++n) _Pragma("unroll") for (int k = 0; k < 2; ++k) dst[n][k] = *(const PG8_LAS bf16x8*)(lds + PG8_SB(b, h) + boff + n * 2048 + k * 1024); } while (0)
#define PG8_MMA(ai, bj, At, Bt) do { __builtin_amdgcn_s_setprio(1); _Pragma("unroll") for (int m = 0; m < 4; ++m) _Pragma("unroll") for (int n = 0; n < 2; ++n) _Pragma("unroll") for (int k = 0; k < 2; ++k) \
        acc[ai][bj][m][n] = __builtin_amdgcn_mfma_f32_16x16x32_bf16(Bt[n][k], At[m][k], acc[ai][bj][m][n], 0, 0, 0); __builtin_amdgcn_s_setprio(0); } while (0)
#define PG8_WAIT_V(n) asm volatile("s_waitcnt vmcnt(" #n ")" ::: "memory")
#define PG8_WAIT_L(n) asm volatile("s_waitcnt lgkmcnt(" #n ")" ::: "memory")
#define PG8_BAR __builtin_amdgcn_s_barrier()
#define PG8_SCHED __builtin_amdgcn_sched_barrier(0)
#define PG8_GATHER_OFFS(d00, d01, d10, d11, u) do { if constexpr (GATHER) { const int* ri_ = g.rowidx + (u).gb; int t_ = wv * 64 + lane_id_(); asm volatile("" : "+v"(t_)); \
        int R0_, C0_, R1_, C1_; stage_rc(t_ * 16, R0_, C0_); stage_rc(t_ * 16 + 8192, R1_, C1_);     \
        d00 = (unsigned)(ri_[R0_] * lda + C0_) * 2u; d01 = (unsigned)(ri_[R1_] * lda + C1_) * 2u; \
        d10 = (unsigned)(ri_[HALF + R0_] * lda + C0_) * 2u; d11 = (unsigned)(ri_[HALF + R1_] * lda + C1_) * 2u; } } while (0)
    Unit cur, nxt; int ui = 0;
    if (!S.next(0, cur)) return;
    f32x4 acc[2][2][4][2];
#pragma unroll
    for (int a = 0; a < 2; ++a)
#pragma unroll
        for (int b = 0; b < 2; ++b)
#pragma unroll
            for (int m = 0; m < 4; ++m)
#pragma unroll
                for (int n = 0; n < 2; ++n) acc[a][b][m][n] = (f32x4){0.f, 0.f, 0.f, 0.f};
    bf16x8 At[4][2], B0[2][2], B1[2][2];
    const char* cA = (const char*)g.A + (GATHER ? (size_t)0 : (size_t)cur.pm * tstepA) + (size_t)cur.ko * 2; const char* cB0 = PG8_BSRC(cur, 0); const char* cB1 = PG8_BSRC(cur, 1);
    PG8_GATHER_OFFS(va00, va01, va10, va11, cur);
    S.a_ready(cur);
    PG8_STAGE(PG8_SA(0, 0), cA, va00, va01); PG8_STAGE(PG8_SA(0, 1), cA, va10, va11);
    PG8_BLOAD(cB0); PG8_BWAIT(0); PG8_BWRITE(PG8_SB(0, 0));
    PG8_BLOAD(cB1); PG8_BWAIT(0); PG8_BWRITE(PG8_SB(0, 1));
    PG8_BLOAD(cB0 + bkstep); PG8_BWAIT(0); PG8_BWRITE(PG8_SB(1, 0));
    PG8_BLOAD(cB1 + bkstep); PG8_STAGE(PG8_SA(1, 0), cA + kstep, va00, va01);
    PG8_WAIT_L(0);
    if (wr == 1) PG8_BAR;
    PG8_BAR;
    PG8_BAR;
    for (;;) {
        const bool has_next = S.next(ui + 1, nxt);
        const char* nA = has_next ? (const char*)g.A + (GATHER ? (size_t)0 : (size_t)nxt.pm * tstepA) + (size_t)nxt.ko * 2 : cA; const char* nB0 = has_next ? PG8_BSRC(nxt, 0) : cB0; const char* nB1 = has_next ? PG8_BSRC(nxt, 1) : cB1;
        const int nt = K / BK;
        for (int t = 0; t < nt; t += 2) {
            const bool last = (t == nt - 2);
            const char* a1 = cA + (size_t)(t + 1) * kstep;
            const char* a2 = last ? nA : cA + (size_t)(t + 2) * kstep;
            const char* b20 = last ? nB0 : cB0 + (size_t)(t + 2) * bkstep; const char* b21 = last ? nB1 : cB1 + (size_t)(t + 2) * bkstep;
            const char* a3 = a2 + kstep; const char* b30 = b20 + bkstep; const char* b31 = b21 + bkstep;
            if constexpr (GATHER) { if (last) { if (has_next) PG8_GATHER_OFFS(vn00, vn01, vn10, vn11, nxt); else { vn00 = va00; vn01 = va01; vn10 = va10; vn11 = va11; } } }
            const bool usen_ = GATHER && last;
            const unsigned v200 = usen_ ? vn00 : va00, v201 = usen_ ? vn01 : va01, v210 = usen_ ? vn10 : va10, v211 = usen_ ? vn11 : va11;
            if (last && has_next) S.a_ready(nxt);
            PG8_LDB(B0, 0, 0); PG8_LDB(B1, 0, 1); PG8_SCHED; PG8_LDA(At, 0, 0);
            PG8_BWAIT(2); PG8_BWRITE(PG8_SB(1, 1)); PG8_BLOAD(b20); PG8_STAGE(PG8_SA(1, 1), a1, va10, va11);
            PG8_WAIT_L(0); PG8_BAR; PG8_MMA(0, 0, At, B0); PG8_MMA(0, 1, At, B1); PG8_BAR; PG8_SCHED;
            PG8_LDA(At, 0, 1);
            PG8_BWAIT(2); PG8_BWRITE(PG8_SB(0, 0)); PG8_BLOAD(b21); PG8_STAGE(PG8_SA(0, 0), a2, v200, v201);
            PG8_WAIT_L(0); PG8_BAR; PG8_MMA(1, 0, At, B0); PG8_MMA(1, 1, At, B1); PG8_BAR; PG8_SCHED;
            PG8_LDB(B0, 1, 0); PG8_LDB(B1, 1, 1); PG8_SCHED; PG8_LDA(At, 1, 0);
            PG8_BWAIT(2); PG8_BWRITE(PG8_SB(0, 1)); PG8_BLOAD(b30); PG8_STAGE(PG8_SA(0, 1), a2, v210, v211);
            PG8_WAIT_L(0); PG8_BAR; PG8_MMA(0, 0, At, B0); PG8_MMA(0, 1, At, B1); PG8_BAR; PG8_SCHED;
            PG8_LDA(At, 1, 1);
            PG8_BWAIT(2); PG8_BWRITE(PG8_SB(1, 0)); PG8_BLOAD(b31); PG8_STAGE(PG8_SA(1, 0), a3, v200, v201);
            PG8_WAIT_L(0); PG8_BAR; PG8_MMA(1, 0, At, B0); PG8_MMA(1, 1, At, B1); PG8_BAR; PG8_SCHED;
        }
        if (wr == 0) PG8_BAR;
        E(acc, cur, wr, wc, fr, fq); S.done(cur);
        if (!has_next) break;
#pragma unroll
        for (int a = 0; a < 2; ++a)
#pragma unroll
            for (int b = 0; b < 2; ++b)
#pragma unroll
                for (int m = 0; m < 4; ++m)
#pragma unroll
                    for (int n = 0; n < 2; ++n) acc[a][b][m][n] = (f32x4){0.f, 0.f, 0.f, 0.f};
        cur = nxt; cA = nA; cB0 = nB0; cB1 = nB1; ++ui;
        if constexpr (GATHER) { va00 = vn00; va01 = vn01; va10 = vn10; va11 = vn11; }
        if (wr == 1) PG8_BAR;
    }
    PG8_WAIT_V(0);
    PG8_BAR;
#undef PG8_SA
#undef PG8_SB
#undef PG8_STAGE
#undef PG8_BLOAD
#undef PG8_BWAIT
#undef PG8_BWRITE
#undef PG8_BSRC
#undef PG8_LDA
#undef PG8_LDB
#undef PG8_MMA
#undef PG8_WAIT_V
#undef PG8_WAIT_L
#undef PG8_BAR
#undef PG8_SCHED
#undef PG8_GATHER_OFFS
}
}

#ifndef PG8_SP2
#define PG8_SP2 true
#endif
#ifndef PG8_ALIGN
#define PG8_ALIGN true
#endif
#ifndef MK_PER_PHASE
#define MK_PER_PHASE 0
#endif

constexpr int NWAVES = 8;
constexpr int DM = 2048, NB = 8, SEQ = 2048, CTX = 256, TPB = CTX + SEQ, T = NB * TPB;
constexpr int EVEN_IN_P = 2816, ODD_IN = 4608;
constexpr int NE = 32, DE = 1024, MAXSLOT = 45056;
constexpr float NORM_EPS = 1e-6f;
constexpr float LAMBDA_INIT = 0.35550906759f;
constexpr int NPHASE = 27;
#ifndef MOE_F32B
#define MOE_F32B 0
#endif
#ifndef FUSED_ROUTE
#define FUSED_ROUTE 1
#endif
#ifndef ATT_DIFF_FUSED
#define ATT_DIFF_FUSED 1
#endif
#ifndef USE_NAIVE_ATTN
#define USE_NAIVE_ATTN 0
#endif

constexpr size_t MiB = 1u << 20;
constexpr size_t WS_CTL = 0, CTL_ZERO_BYTES = 1 * MiB;
constexpr size_t WS_MOD = 1 * MiB;
constexpr size_t WS_ROPE = 2 * MiB;
constexpr size_t WS_ROUTE = 3 * MiB;
constexpr size_t WS_WE_IN = 4 * MiB;
constexpr size_t WS_WE_UQ = 15 * MiB;
constexpr size_t WS_WE_UKV = 17 * MiB;
constexpr size_t WS_WE_OUT = 19 * MiB;
constexpr size_t WS_WO_IN = 27 * MiB;
constexpr size_t WS_WO_OUT = 45 * MiB;
constexpr size_t WS_WR = 53 * MiB;
constexpr size_t WS_WGU = 60 * MiB;
constexpr size_t WS_WDN = 572 * MiB;
constexpr size_t WS_H = 828 * MiB;
constexpr size_t WS_A1 = 972 * MiB;
constexpr size_t WS_MIX = 1044 * MiB;
constexpr size_t WS_R = 1116 * MiB;
constexpr size_t WS_Y1 = WS_R;
constexpr size_t WS_CQN = WS_R + 162 * MiB;
constexpr size_t WS_CKVN = WS_R + 180 * MiB;
constexpr size_t WS_QB = WS_R + 198 * MiB;
constexpr size_t WS_KV = WS_R + 252 * MiB;
constexpr size_t WS_KB = WS_R + 324 * MiB;
constexpr size_t WS_XS = WS_R;
constexpr size_t WS_U = WS_R + 176 * MiB;
constexpr size_t WS_YS = WS_R + 264 * MiB;
constexpr size_t WS_LG = WS_R + 440 * MiB;
constexpr size_t WS_POS = WS_R + 460 * MiB;
constexpr int POSCAP = 18432;
constexpr size_t WS_END = WS_R + 466 * MiB;
constexpr int RKS = 4;
constexpr int CW_CNT = 64;
constexpr int CW_NRT = 256;
constexpr int CW_TEXP = 512;
constexpr int CW_BAR = 4096;
constexpr int CW_SLOT = 16384;

constexpr int RING_OFF = 0, RING_BYTES = 131072;
constexpr int LDSCTL_OFF = RING_BYTES, MISC_OFF = LDSCTL_OFF + 320;
constexpr int LDS_BYTES = 147456;
constexpr int LDS_TAB = 135168;

#define GAS __attribute__((address_space(1)))
#define LAS __attribute__((address_space(3)))
typedef unsigned short bf16;
typedef unsigned v4u __attribute__((ext_vector_type(4)));
typedef unsigned v2u __attribute__((ext_vector_type(2)));
typedef float f32x4 __attribute__((ext_vector_type(4)));
typedef GAS unsigned gu32;
#define RLX_AGENT __ATOMIC_RELAXED, __HIP_MEMORY_SCOPE_AGENT
#define LDS_WAIT() asm volatile("s_waitcnt lgkmcnt(0)" ::: "memory")
#define VM_WAIT() asm volatile("s_waitcnt vmcnt(0)" ::: "memory")
__device__ __forceinline__ unsigned f2bf(float f) { unsigned u = __builtin_bit_cast(unsigned, f); return (u + 0x7fffu + ((u >> 16) & 1u)) >> 16; }
__device__ __forceinline__ unsigned pk2(float lo, float hi) { return f2bf(lo) | (f2bf(hi) << 16); }
__device__ __forceinline__ float bf2f(unsigned short h) { return __builtin_bit_cast(float, (unsigned)h << 16); }
__device__ __forceinline__ float bflo(unsigned w) { return __builtin_bit_cast(float, w << 16); }
__device__ __forceinline__ float bfhi(unsigned w) { return __builtin_bit_cast(float, w & 0xffff0000u); }
__device__ __forceinline__ float wave_sum(float v) {
#pragma unroll
    for (int o = 1; o < 64; o <<= 1) v += __shfl_xor(v, o);
    return v;
}
__device__ __forceinline__ float wave_max(float v) {
#pragma unroll
    for (int o = 1; o < 64; o <<= 1) v = fmaxf(v, __shfl_xor(v, o));
    return v;
}
#define XB_TMO      128
#define XB_XCNT(j)  (256  + 64 * (j))
#define XB_XSUB(j)  (1280 + 64 * (j))
#define XB_XGEN(j)  (2304 + 64 * (j))
#define XB_TOP      3328
#define XB_TOPGEN   3392
#define XCD_BAR_WORDS 3456
#define XB_SPIN_CAP (1u << 18)

__device__ __forceinline__ unsigned xb_ld(unsigned* p)              { return __hip_atomic_load(p, __ATOMIC_RELAXED, __HIP_MEMORY_SCOPE_AGENT); }
__device__ __forceinline__ unsigned xb_add(unsigned* p, unsigned v) { return __hip_atomic_fetch_add(p, v, __ATOMIC_RELAXED, __HIP_MEMORY_SCOPE_AGENT); }
__device__ __forceinline__ unsigned xb_xcc_id() { return (unsigned)__builtin_amdgcn_s_getreg((3 << 11) | 20) & 0xFu; }
#define XB_SPIN(cond, bar) do { unsigned _sp = 0; while (cond) { __builtin_amdgcn_s_sleep(1); \
    if ((++_sp & 255u) == 0u) { if (xb_ld(&(bar)[XB_TMO])) break; if (_sp > XB_SPIN_CAP) { atomicAdd(&(bar)[XB_TMO], 1u); break; } } } } while (0)

struct XcdBarrier {
    unsigned* bar; unsigned x;
    volatile LAS unsigned* st;
};

__device__ __forceinline__ XcdBarrier xcd_barrier_post(unsigned* bar, volatile LAS unsigned* st) {
    XcdBarrier b; b.bar = bar; b.x = xb_xcc_id(); b.st = st;
    if (threadIdx.x == 0) (void)xb_add(&bar[XB_XCNT(b.x)], 1u);
    return b;
}
__device__ __forceinline__ void xcd_barrier_complete(unsigned* bar, unsigned x, unsigned& nloc, unsigned& nx) {
    const unsigned G = gridDim.x * gridDim.y * gridDim.z;
    unsigned sum, cnt, mine, sp = 0u;
    for (;;) {
        sum = 0u; cnt = 0u; mine = 0u;
#pragma unroll
        for (unsigned j = 0; j < 16; ++j) { const unsigned c = xb_ld(&bar[XB_XCNT(j)]); sum += c; cnt += (c > 0u) ? 1u : 0u; mine = (j == x) ? c : mine; }
        if (sum == G) break;
        __builtin_amdgcn_s_sleep(1);
        if ((++sp & 255u) == 0u) { if (xb_ld(&bar[XB_TMO])) break; if (sp > XB_SPIN_CAP) { atomicAdd(&bar[XB_TMO], 1u); break; } }
    }
    nloc = mine > 0u ? mine : 1u; nx = cnt > 0u ? cnt : 1u;
}

__device__ __forceinline__ void xcd_barrier(const XcdBarrier& b) {
    asm volatile("s_waitcnt vmcnt(0)" ::: "memory");
    __syncthreads();
    if (threadIdx.x == 0) {
        unsigned* bar = b.bar;
        __builtin_amdgcn_s_waitcnt(0);
        unsigned nloc = b.st[0], nx = b.st[1];
        if (nloc == 0u) { xcd_barrier_complete(bar, b.x, nloc, nx); b.st[0] = nloc; b.st[1] = nx; }
        const unsigned old = xb_add(&bar[XB_XSUB(b.x)], 1u);
        const unsigned gen = old / nloc;
        if (old + 1u == (gen + 1u) * nloc) {
            __builtin_amdgcn_fence(__ATOMIC_RELEASE, "agent");
            asm volatile("s_waitcnt vmcnt(0)" ::: "memory");
            const unsigned og = xb_add(&bar[XB_TOP], 1u);
            const unsigned tg = og / nx;
            if (og + 1u == (tg + 1u) * nx) xb_add(&bar[XB_TOPGEN], 1u);
            else XB_SPIN(xb_ld(&bar[XB_TOPGEN]) == tg, bar);
            __builtin_amdgcn_fence(__ATOMIC_ACQUIRE, "agent");
            xb_add(&bar[XB_XGEN(b.x)], 1u);
            asm volatile("s_waitcnt vmcnt(0)" ::: "memory");
        } else {
            XB_SPIN(xb_ld(&bar[XB_XGEN(b.x)]) == gen, bar);
            __builtin_amdgcn_fence(__ATOMIC_ACQUIRE, "agent");
            asm volatile("s_waitcnt vmcnt(0)" ::: "memory");
        }
    }
    __syncthreads();
}

struct Frame {
    LAS unsigned char* lds;
    volatile LAS unsigned* MISC;
    gu32* ctl;
    unsigned char* ws;
    int tid, lane, wave, vcu, G;
};
struct LocalId { int tid, lane, wave; };
__device__ __forceinline__ LocalId local_id_w(int wave) { int t = wave * 64 + lane_id_(); asm volatile("" : "+v"(t)); LocalId l; l.tid = t; l.lane = t & 63; l.wave = wave; return l; }
#define local_id() local_id_w(F.wave)
struct Args { const float* in[35]; float* out; unsigned char* ws; int ph_lo, ph_hi; };
enum { I_X = 0, I_C, I_CTX, I_CCTX, I_MODW, I_MODB, I_EWIN, I_EWOUT, I_AQN, I_AKN, I_BCQN, I_BWUQ, I_BCKVN, I_BWUKV, I_BQN, I_BKN, I_OWIN, I_OWOUT,
       I_CQN, I_CKN, I_LQ1, I_LK1, I_LQ2, I_LK2, I_SUBLN, I_DQN, I_DKN, I_SINK, I_WRG, I_BRG, I_WRE, I_BRE, I_WG, I_WU, I_WD };

__device__ __forceinline__ int mod_index(int row) { const int b = row / TPB; return (row - b * TPB) < CTX ? 8 : b; }

__device__ __forceinline__ void transpose_item(const float* W, int N, int k0, int n0, bf16* dst, int Kd, LAS float* scr, int lane) {
    f32x4 v[8];
    const int kr = lane >> 3, cq = lane & 7;
#pragma unroll
    for (int i = 0; i < 8; ++i) v[i] = *(const f32x4*)(W + (size_t)(k0 + kr + 8 * i) * N + n0 + 4 * cq);
#pragma unroll
    for (int i = 0; i < 8; ++i) { LAS float* d = scr + (kr + 8 * i) * 33 + 4 * cq; d[0] = v[i].x; d[1] = v[i].y; d[2] = v[i].z; d[3] = v[i].w; }
    LDS_WAIT(); asm volatile("" ::: "memory");
    const int c = lane & 7;
#pragma unroll
    for (int j = 0; j < 4; ++j) { const int n = (lane >> 3) + 8 * j; const LAS float* s = scr + (8 * c) * 33 + n;
        v4u o; o.x = pk2(s[0 * 33], s[1 * 33]); o.y = pk2(s[2 * 33], s[3 * 33]); o.z = pk2(s[4 * 33], s[5 * 33]); o.w = pk2(s[6 * 33], s[7 * 33]);
        *(GAS v4u*)(dst + (size_t)n * Kd + k0 + 8 * c) = o; }
    LDS_WAIT(); asm volatile("" ::: "memory");
}
__device__ __forceinline__ void small_transpose(const float* W, int K, int N, bf16* WT, int item, LAS float* scr, int lane) {
    const int nblk = N / 32, kb = item / nblk, nb = item - kb * nblk;
    transpose_item(W, N, kb * 64, nb * 32, WT + (size_t)(nb * 32) * K, K, scr, lane);
}
__device__ __forceinline__ void p0_prologue(const Frame& F, const Args& a) {
    const LocalId L_ = local_id(); (void)L_;
    const int gt = F.vcu * 512 + L_.tid, NT = F.G * 512;
    {
        float2* t128 = (float2*)(F.ws + WS_ROPE); float2* t64 = (float2*)(F.ws + WS_ROPE + 16384);
        for (int i = gt; i < 3072; i += NT) {
            if (i < 2048) { const int pos = i >> 5, f = i & 31; const float inv = 1.0f / powf(10000.0f, (float)f / 32.0f); const float ang = (float)pos * inv; t128[i] = make_float2(cosf(ang), sinf(ang)); }
            else { const int k = i - 2048, pos = k >> 4, f = k & 15; const float inv = 1.0f / powf(10000.0f, (float)f / 16.0f); const float ang = (float)pos * inv; t64[k] = make_float2(cosf(ang), sinf(ang)); }
        }
    }
    { float* gsub = (float*)(F.ws + WS_ROPE + 32768); for (int i = gt; i < 128; i += NT) gsub[i] = a.in[I_SUBLN][i] * (1.0f - LAMBDA_INIT); }
    {
        bf16* WR = (bf16*)(F.ws + WS_WR);
        for (int i = gt; i < 2 * 256 * 2048; i += NT) { const int l = i >> 19, r = (i >> 11) & 255, k = i & 2047;
            float v = 0.f; if (r < 4) v = a.in[I_WRG][((size_t)l * 2048 + k) * 4 + r]; else if (r < 36) v = a.in[I_WRE][((size_t)l * 2048 + k) * 32 + (r - 4)];
            WR[i] = (bf16)f2bf(v); }
        v4u* z = (v4u*)((bf16*)(F.ws + WS_WE_IN) + (size_t)2624 * 2048);
        for (int i = gt; i < 192 * 2048 / 8; i += NT) z[i] = (v4u){0u, 0u, 0u, 0u};
    }
    {
        LAS float* sl = (LAS float*)(F.lds + RING_OFF);
        LAS float* red = (LAS float*)(F.lds + RING_OFF + 73728);
        for (int i = L_.tid; i < 9 * 2048; i += 512) { const int j = i >> 11, k = i & 2047; const float v = j < 8 ? a.in[I_C][j * 2048 + k] : a.in[I_CCTX][k]; sl[i] = v / (1.0f + expf(-v)); }
        __syncthreads();
        float* MOD = (float*)(F.ws + WS_MOD);
        const int cg = L_.lane & 7, ks = L_.lane >> 3;
        for (int item = blockIdx.x; item < 768; item += F.G) {
            const int layer = item / 384, chunk = item - layer * 384, col0 = chunk * 32;
            const float* W = a.in[I_MODW] + (size_t)layer * 2048 * 12288 + col0 + cg * 4;
            f32x4 acc[9];
#pragma unroll
            for (int j = 0; j < 9; ++j) acc[j] = (f32x4){0.f, 0.f, 0.f, 0.f};
#pragma unroll 8
            for (int it = 0; it < 32; ++it) { const int k = L_.wave * 256 + it * 8 + ks; const f32x4 w = *(const f32x4*)(W + (size_t)k * 12288);
#pragma unroll
                for (int j = 0; j < 9; ++j) { const float s = sl[j * 2048 + k]; acc[j] = acc[j] + w * s; } }
#pragma unroll
            for (int j = 0; j < 9; ++j)
#pragma unroll
                for (int e = 0; e < 4; ++e) { float v = acc[j][e]; v += __shfl_xor(v, 8); v += __shfl_xor(v, 16); v += __shfl_xor(v, 32); acc[j][e] = v; }
            if (L_.lane < 8) {
#pragma unroll
                for (int j = 0; j < 9; ++j)
#pragma unroll
                    for (int e = 0; e < 4; ++e) red[(L_.wave * 9 + j) * 32 + cg * 4 + e] = acc[j][e]; }
            __syncthreads();
            if (L_.tid < 288) { const int j = L_.tid >> 5, cc = L_.tid & 31; float s = a.in[I_MODB][layer * 12288 + col0 + cc];
#pragma unroll
                for (int w = 0; w < 8; ++w) s += red[(w * 9 + j) * 32 + cc];
                MOD[((size_t)layer * 9 + j) * 12288 + col0 + cc] = s; }
            __syncthreads();
        }
    }
    {
        LAS float* scr = (LAS float*)(F.lds + RING_OFF + L_.wave * 16384);
        const int gw = F.vcu * NWAVES + L_.wave, NGW = F.G * NWAVES;
        constexpr int I0 = 32 * 82, I1 = 8 * 48, I2 = 8 * 64, I3 = 32 * 64, I4 = 32 * 144, I5 = 32 * 64, NSMALL = I0 + I1 + I2 + I3 + I4 + I5;
#if MOE_F32B
        constexpr int NMOE = 0;
#else
        constexpr int NMOE = 64 * 3072;
#endif
        for (int it = gw; it < NSMALL + NMOE; it += NGW) {
            int r = it;
            if (r < NSMALL) {
                if (r < I0) { small_transpose(a.in[I_EWIN], 2048, 2624, (bf16*)(F.ws + WS_WE_IN), r, scr, L_.lane); continue; } r -= I0;
                if (r < I1) { small_transpose(a.in[I_BWUQ], 512, 1536, (bf16*)(F.ws + WS_WE_UQ), r, scr, L_.lane); continue; } r -= I1;
                if (r < I2) { small_transpose(a.in[I_BWUKV], 512, 2048, (bf16*)(F.ws + WS_WE_UKV), r, scr, L_.lane); continue; } r -= I2;
                if (r < I3) { small_transpose(a.in[I_EWOUT], 2048, 2048, (bf16*)(F.ws + WS_WE_OUT), r, scr, L_.lane); continue; } r -= I3;
                if (r < I4) { small_transpose(a.in[I_OWIN], 2048, 4608, (bf16*)(F.ws + WS_WO_IN), r, scr, L_.lane); continue; } r -= I4;
                small_transpose(a.in[I_OWOUT], 2048, 2048, (bf16*)(F.ws + WS_WO_OUT), r, scr, L_.lane); continue;
            }
            r -= NSMALL;
            const int le = r / 3072, q = r - le * 3072, which = q >> 10, ri = q & 1023;
            if (which < 2) {
                const int kb = ri >> 5, nb = ri & 31, n0 = nb * 32;
                const float* W = a.in[which == 0 ? I_WG : I_WU] + (size_t)le * 2048 * 1024;
                bf16* dst = (bf16*)(F.ws + WS_WGU) + (size_t)le * 2048 * 2048 + (size_t)((n0 >> 7) * 256 + which * 128 + (n0 & 127)) * 2048;
                transpose_item(W, 1024, kb * 64, n0, dst, 2048, scr, L_.lane);
            } else {
                const int kb = ri >> 6, nb = ri & 63, n0 = nb * 32;
                const float* W = a.in[I_WD] + (size_t)le * 1024 * 2048;
                bf16* dst = (bf16*)(F.ws + WS_WDN) + (size_t)le * 2048 * 1024 + (size_t)n0 * 1024;
                transpose_item(W, 2048, kb * 64, n0, dst, 1024, scr, L_.lane);
            }
        }
    }
}

__device__ __forceinline__ void modulate_store(const f32x4 (&v)[8], const float* shift, const float* scale, bf16* orow, int lane) {
    float ss = 0.f;
#pragma unroll
    for (int j = 0; j < 8; ++j) ss += (v[j].x * v[j].x + v[j].y * v[j].y) + (v[j].z * v[j].z + v[j].w * v[j].w);
    ss = wave_sum(ss);
    const float r = 1.0f / sqrtf(ss * (1.0f / 2048.0f) + NORM_EPS);
#pragma unroll
    for (int j = 0; j < 8; ++j) { const f32x4 sh = ((const f32x4*)shift)[lane + 64 * j], sc = ((const f32x4*)scale)[lane + 64 * j];
        const f32x4 y = v[j] * r * (sc + 1.0f) + sh; v2u o; o.x = pk2(y.x, y.y); o.y = pk2(y.z, y.w); ((v2u*)orow)[lane + 64 * j] = o; }
}
__device__ __forceinline__ void moe_combine_load(const bf16* YS, const int* rec, const LAS int* offs, int lane, f32x4 (&y)[8]) {
    const int s0 = offs[rec[0]] + rec[2], s1 = offs[rec[1]] + rec[3]; const float w0 = __builtin_bit_cast(float, rec[4]), w1 = __builtin_bit_cast(float, rec[5]);
    const v2u* p0 = (const v2u*)(YS + (size_t)s0 * 2048); const v2u* p1 = (const v2u*)(YS + (size_t)s1 * 2048);
#pragma unroll
    for (int j = 0; j < 8; ++j) { const v2u a = p0[lane + 64 * j], b = p1[lane + 64 * j];
        y[j].x = w0 * bflo(a.x) + w1 * bflo(b.x); y[j].y = w0 * bfhi(a.x) + w1 * bfhi(b.x); y[j].z = w0 * bflo(a.y) + w1 * bflo(b.y); y[j].w = w0 * bfhi(a.y) + w1 * bfhi(b.y); }
}

__device__ __forceinline__ int moe_tables(const Frame& F, int layer, int tid) {
    LAS int* texp = (LAS int*)(F.lds + LDS_TAB); LAS int* frt = texp + 256; LAS int* offs = frt + 40;
    if (tid < 64) {
        const int e = tid & 31;
        const unsigned c = __hip_atomic_load((unsigned*)(F.ctl + CW_CNT + layer * 64 + e), RLX_AGENT);
        const int pad = (int)((c + 255u) & ~255u);
        int incl = pad;
#pragma unroll
        for (int d = 1; d < 32; d <<= 1) { const int v = __shfl_up(incl, d); if ((tid & 31) >= d) incl += v; }
        const int excl = incl - pad;
        if (tid < 32) { offs[e] = excl; frt[e] = excl >> 8; for (int r = excl >> 8; r < (incl >> 8); ++r) texp[r] = e; if (e == 31) { offs[NE] = incl; frt[NE] = incl >> 8; } }
    }
    __syncthreads();
    return frt[NE];
}
__device__ __forceinline__ void hrow_load(const bf16* hrow, int lane, f32x4 (&v)[8]) {
#pragma unroll
    for (int q = 0; q < 8; ++q) { const v2u w = ((const v2u*)hrow)[lane + 64 * q]; v[q].x = bflo(w.x); v[q].y = bfhi(w.x); v[q].z = bflo(w.y); v[q].w = bfhi(w.y); }
}
__device__ __forceinline__ void hrow_store(bf16* hrow, int lane, const f32x4 (&v)[8]) {
#pragma unroll
    for (int q = 0; q < 8; ++q) { v2u o; o.x = pk2(v[q].x, v[q].y); o.y = pk2(v[q].z, v[q].w); ((v2u*)hrow)[lane + 64 * q] = o; }
}
__device__ __forceinline__ const float* l0_src_row(const Args& a, int row, int& j) {
    const int b = row / TPB, r = row - b * TPB; j = r < CTX ? 8 : b;
    return r < CTX ? a.in[I_CTX] + (size_t)(b * CTX + r) * DM : a.in[I_X] + (size_t)(b * SEQ + (r - CTX)) * DM;
}
__device__ __forceinline__ void p_l0_mod1(const Frame& F, const Args& a) {
    const LocalId L_ = local_id(); (void)L_;
    const int gw = F.vcu * NWAVES + L_.wave, NGW = F.G * NWAVES;
    const float* MOD = (const float*)(F.ws + WS_MOD); bf16* A1 = (bf16*)(F.ws + WS_A1);
    for (int r0 = gw; r0 < T; r0 += 2 * NGW) {
        const int r1 = r0 + NGW; const bool ok1 = r1 < T;
        int j0, j1 = 0; const float* s0 = l0_src_row(a, r0, j0); const float* s1 = ok1 ? l0_src_row(a, r1, j1) : s0;
        f32x4 v0[8], v1[8];
#pragma unroll
        for (int q = 0; q < 8; ++q) v0[q] = ((const f32x4*)s0)[L_.lane + 64 * q];
#pragma unroll
        for (int q = 0; q < 8; ++q) v1[q] = ((const f32x4*)s1)[L_.lane + 64 * q];
        const float* m0 = MOD + (size_t)(0 * 9 + j0) * 12288;
        modulate_store(v0, m0 + 0 * 2048, m0 + 1 * 2048, A1 + (size_t)r0 * DM, L_.lane);
        if (ok1) {
            const float* m1 = MOD + (size_t)(0 * 9 + j1) * 12288;
            modulate_store(v1, m1 + 0 * 2048, m1 + 1 * 2048, A1 + (size_t)r1 * DM, L_.lane);
        }
    }
}
__device__ __forceinline__ void p_mod2(const Frame& F, int layer) {
    const LocalId L_ = local_id(); (void)L_;
    const int gw = F.vcu * NWAVES + L_.wave, NGW = F.G * NWAVES;
    const float* MOD = (const float*)(F.ws + WS_MOD); const bf16* H = (const bf16*)(F.ws + WS_H); bf16* A1 = (bf16*)(F.ws + WS_A1);
    for (int r0 = gw; r0 < T; r0 += 2 * NGW) {
        const int r1 = r0 + NGW; const int j0 = mod_index(r0), j1 = r1 < T ? mod_index(r1) : 8;
        const bool ok0 = !(layer == 1 && j0 == 8), ok1 = r1 < T && !(layer == 1 && j1 == 8);
        f32x4 v0[8], v1[8];
        if (ok0) hrow_load(H + (size_t)r0 * DM, L_.lane, v0);
        if (ok1) hrow_load(H + (size_t)r1 * DM, L_.lane, v1);
        if (ok0) { const float* m = MOD + (size_t)(layer * 9 + j0) * 12288; modulate_store(v0, m + 3 * 2048, m + 4 * 2048, A1 + (size_t)r0 * DM, L_.lane); }
        if (ok1) { const float* m = MOD + (size_t)(layer * 9 + j1) * 12288; modulate_store(v1, m + 3 * 2048, m + 4 * 2048, A1 + (size_t)r1 * DM, L_.lane); }
    }
}
__device__ __forceinline__ void p_l1_mod1(const Frame& F, size_t hdst_off = WS_H, size_t adst_off = WS_A1) {
    const LocalId L_ = local_id(); (void)L_;
    const int gw = F.vcu * NWAVES + L_.wave, NGW = F.G * NWAVES;
    const float* MOD = (const float*)(F.ws + WS_MOD); const bf16* H = (const bf16*)(F.ws + WS_H); bf16* Hd = (bf16*)(F.ws + hdst_off); bf16* A1 = (bf16*)(F.ws + adst_off);
    const bf16* YS = (const bf16*)(F.ws + WS_YS); const int* ROUTE = (const int*)(F.ws + WS_ROUTE);
    (void)moe_tables(F, 0, L_.tid); const LAS int* offs = (const LAS int*)(F.lds + LDS_TAB) + 296;
    for (int r0 = gw; r0 < T; r0 += 2 * NGW) {
        const int r1 = r0 + NGW; const bool ok1 = r1 < T; const int rr1 = ok1 ? r1 : r0;
        const int j0 = mod_index(r0), j1 = mod_index(rr1);
        f32x4 v0[8], v1[8], y0[8], y1[8];
        moe_combine_load(YS, ROUTE + (size_t)r0 * 8, offs, L_.lane, y0);
        moe_combine_load(YS, ROUTE + (size_t)rr1 * 8, offs, L_.lane, y1);
        hrow_load(H + (size_t)r0 * DM, L_.lane, v0);
        hrow_load(H + (size_t)rr1 * DM, L_.lane, v1);
        const float* g0 = MOD + (size_t)(0 * 9 + j0) * 12288 + 5 * 2048; const float* g1 = MOD + (size_t)(0 * 9 + j1) * 12288 + 5 * 2048;
#pragma unroll
        for (int q = 0; q < 8; ++q) { v0[q] = v0[q] + ((const f32x4*)g0)[L_.lane + 64 * q] * y0[q]; v1[q] = v1[q] + ((const f32x4*)g1)[L_.lane + 64 * q] * y1[q]; }
        if (j0 != 8) hrow_store(Hd + (size_t)r0 * DM, L_.lane, v0);
        const float* m0 = MOD + (size_t)(1 * 9 + j0) * 12288;
        modulate_store(v0, m0 + 0 * 2048, m0 + 1 * 2048, A1 + (size_t)r0 * DM, L_.lane);
        if (ok1) {
            if (j1 != 8) hrow_store(Hd + (size_t)r1 * DM, L_.lane, v1);
            const float* m1 = MOD + (size_t)(1 * 9 + j1) * 12288;
            modulate_store(v1, m1 + 0 * 2048, m1 + 1 * 2048, A1 + (size_t)r1 * DM, L_.lane);
        }
    }
}
__device__ __forceinline__ void p_final(const Frame& F, float* out) {
    const LocalId L_ = local_id(); (void)L_;
    const int gw = F.vcu * NWAVES + L_.wave, NGW = F.G * NWAVES;
    const float* MOD = (const float*)(F.ws + WS_MOD); const bf16* H = (const bf16*)(F.ws + WS_H);
    const bf16* YS = (const bf16*)(F.ws + WS_YS); const int* ROUTE = (const int*)(F.ws + WS_ROUTE);
    (void)moe_tables(F, 1, L_.tid); const LAS int* offs = (const LAS int*)(F.lds + LDS_TAB) + 296;
    for (int i0 = gw; i0 < NB * SEQ; i0 += 2 * NGW) {
        const int i1 = i0 + NGW; const bool ok1 = i1 < NB * SEQ; const int ii1 = ok1 ? i1 : i0;
        const int b0 = i0 / SEQ, row0 = b0 * TPB + CTX + (i0 - b0 * SEQ), b1 = ii1 / SEQ, row1 = b1 * TPB + CTX + (ii1 - b1 * SEQ);
        f32x4 y0[8], y1[8], h0[8], h1[8];
        moe_combine_load(YS, ROUTE + (size_t)row0 * 8, offs, L_.lane, y0);
        moe_combine_load(YS, ROUTE + (size_t)row1 * 8, offs, L_.lane, y1);
        hrow_load(H + (size_t)row0 * DM, L_.lane, h0);
        hrow_load(H + (size_t)row1 * DM, L_.lane, h1);
        const float* g0 = MOD + (size_t)(1 * 9 + b0) * 12288 + 5 * 2048; const float* g1 = MOD + (size_t)(1 * 9 + b1) * 12288 + 5 * 2048;
#pragma unroll
        for (int q = 0; q < 8; ++q) ((f32x4*)(out + (size_t)i0 * DM))[L_.lane + 64 * q] = h0[q] + ((const f32x4*)g0)[L_.lane + 64 * q] * y0[q];
        if (ok1) {
#pragma unroll
            for (int q = 0; q < 8; ++q) ((f32x4*)(out + (size_t)i1 * DM))[L_.lane + 64 * q] = h1[q] + ((const f32x4*)g1)[L_.lane + 64 * q] * y1[q]; }
    }
}

__device__ __forceinline__ void head128_norm_rope(const bf16* p, bf16* pd, const float* gain, bool rope, int prow, int pcol, const float2* t128, int lane) {
    const float x0 = bf2f(p[lane]), x1 = bf2f(p[lane + 64]);
    const float ss = wave_sum(x0 * x0 + x1 * x1);
    const float r = 1.0f / sqrtf(ss * (1.0f / 128.0f) + NORM_EPS);
    float y0 = x0 * r * gain[lane], y1 = x1 * r * gain[lane + 64];
    if (rope) {
        const int f = lane & 31; const float2 cr = t128[prow * 32 + f], cc = t128[pcol * 32 + f];
        const float p0 = __shfl_xor(y0, 32), p1 = __shfl_xor(y1, 32); const float sg = (lane & 32) ? 1.0f : -1.0f;
        y0 = y0 * cr.x + sg * p0 * cr.y; y1 = y1 * cc.x + sg * p1 * cc.y;
    }
    pd[lane] = (bf16)f2bf(y0); pd[lane + 64] = (bf16)f2bf(y1);
}
__device__ __forceinline__ float rope64_apply(float y, int prow, int pcol, const float2* t64, int lane) {
    const int f = lane & 15, pos = (lane & 32) ? pcol : prow; const float2 cs = t64[pos * 16 + f];
    const float pr = __shfl_xor(y, 16); const float sg = (lane & 16) ? 1.0f : -1.0f;
    return y * cs.x + sg * pr * cs.y;
}
__device__ __forceinline__ void head64_norm_rope(const bf16* p, bf16* pd, const float* gain, bool rope, int prow, int pcol, const float2* t64, int lane) {
    const float x = bf2f(p[lane]);
    const float ss = wave_sum(x * x);
    const float r = 1.0f / sqrtf(ss * (1.0f / 64.0f) + NORM_EPS);
    float y = x * r * gain[lane];
    if (rope) y = rope64_apply(y, prow, pcol, t64, lane);
    pd[lane] = (bf16)f2bf(y);
}
__device__ __forceinline__ void norm512(const bf16* src, const float* gain, bf16* dst, int lane) {
    const v4u w = ((const v4u*)src)[lane];
    float x[8] = {bflo(w.x), bfhi(w.x), bflo(w.y), bfhi(w.y), bflo(w.z), bfhi(w.z), bflo(w.w), bfhi(w.w)};
    float ss = 0.f;
#pragma unroll
    for (int i = 0; i < 8; ++i) ss += x[i] * x[i];
    ss = wave_sum(ss);
    const float r = 1.0f / sqrtf(ss * (1.0f / 512.0f) + NORM_EPS);
    const f32x4 g0 = ((const f32x4*)gain)[2 * lane], g1 = ((const f32x4*)gain)[2 * lane + 1];
    v4u o; o.x = pk2(x[0] * r * g0.x, x[1] * r * g0.y); o.y = pk2(x[2] * r * g0.z, x[3] * r * g0.w); o.z = pk2(x[4] * r * g1.x, x[5] * r * g1.y); o.w = pk2(x[6] * r * g1.z, x[7] * r * g1.w);
    ((v4u*)dst)[lane] = o;
}

__device__ __forceinline__ void unpack8(const v4u w, float (&x)[8]) { x[0] = bflo(w.x); x[1] = bfhi(w.x); x[2] = bflo(w.y); x[3] = bfhi(w.y); x[4] = bflo(w.z); x[5] = bfhi(w.z); x[6] = bflo(w.w); x[7] = bfhi(w.w); }
__device__ __forceinline__ v4u pack8(const float (&y)[8]) { v4u o; o.x = pk2(y[0], y[1]); o.y = pk2(y[2], y[3]); o.z = pk2(y[4], y[5]); o.w = pk2(y[6], y[7]); return o; }
__device__ __forceinline__ float sumsq8(const float (&x)[8]) { return ((x[0] * x[0] + x[1] * x[1]) + (x[2] * x[2] + x[3] * x[3])) + ((x[4] * x[4] + x[5] * x[5]) + (x[6] * x[6] + x[7] * x[7])); }
template <int GS> __device__ __forceinline__ float group_sum(float v) {
    v += __shfl_xor(v, 1); v += __shfl_xor(v, 2); v += __shfl_xor(v, 4); if (GS == 16) v += __shfl_xor(v, 8); return v;
}
template <int RD> __device__ __forceinline__ void rope8(float (&y)[8], int l, int prow, int pcol, const float2* tab) {
    constexpr int NF = RD / 4, LQ = NF / 8;
    const int quarter = l / LQ, f0 = (l % LQ) * 8, pos = (quarter >= 2) ? pcol : prow;
    const float sg = (quarter & 1) ? 1.0f : -1.0f;
    const f32x4* t = (const f32x4*)(tab + pos * NF + f0);
    const f32x4 c0 = t[0], c1 = t[1], c2 = t[2], c3 = t[3];
    float p[8];
#pragma unroll
    for (int j = 0; j < 8; ++j) p[j] = __shfl_xor(y[j], LQ);
    y[0] = y[0] * c0.x + sg * p[0] * c0.y; y[1] = y[1] * c0.z + sg * p[1] * c0.w; y[2] = y[2] * c1.x + sg * p[2] * c1.y; y[3] = y[3] * c1.z + sg * p[3] * c1.w;
    y[4] = y[4] * c2.x + sg * p[4] * c2.y; y[5] = y[5] * c2.z + sg * p[5] * c2.w; y[6] = y[6] * c3.x + sg * p[6] * c3.y; y[7] = y[7] * c3.z + sg * p[7] * c3.w;
}
template <int DIM> __device__ __forceinline__ v4u head_chunk(const v4u w, const float* gain, bool rope, int prow, int pcol, const float2* tab, int lane) {
    constexpr int GS = DIM / 8; const int l = lane & (GS - 1);
    float x[8]; unpack8(w, x);
    const float ss = group_sum<GS>(sumsq8(x));
    const float r = 1.0f / sqrtf(ss * (1.0f / DIM) + NORM_EPS);
    const f32x4 g0 = ((const f32x4*)gain)[2 * l], g1 = ((const f32x4*)gain)[2 * l + 1];
    x[0] *= r * g0.x; x[1] *= r * g0.y; x[2] *= r * g0.z; x[3] *= r * g0.w; x[4] *= r * g1.x; x[5] *= r * g1.y; x[6] *= r * g1.z; x[7] *= r * g1.w;
    if (rope) rope8<DIM>(x, l, prow, pcol, tab);
    return pack8(x);
}
__device__ __forceinline__ v4u norm512_chunk(const v4u w, const float* gain, int lane) {
    float x[8]; unpack8(w, x);
    const float ss = wave_sum(sumsq8(x));
    const float r = 1.0f / sqrtf(ss * (1.0f / 512.0f) + NORM_EPS);
    const f32x4 g0 = ((const f32x4*)gain)[2 * lane], g1 = ((const f32x4*)gain)[2 * lane + 1];
    x[0] *= r * g0.x; x[1] *= r * g0.y; x[2] *= r * g0.z; x[3] *= r * g0.w; x[4] *= r * g1.x; x[5] *= r * g1.y; x[6] *= r * g1.z; x[7] *= r * g1.w;
    return pack8(x);
}

__device__ __forceinline__ void p_even_post1(const Frame& F, const Args& a, size_t ydst_off = WS_Y1) {
    const LocalId L_ = local_id(); (void)L_;
    const int gw = F.vcu * NWAVES + L_.wave, NGW = F.G * NWAVES, lane = L_.lane;
    const bf16* Y1 = (const bf16*)(F.ws + WS_Y1); bf16* CQN = (bf16*)(F.ws + WS_CQN); bf16* CKVN = (bf16*)(F.ws + WS_CKVN);
    const float2* t128 = (const float2*)(F.ws + WS_ROPE);
    for (int row = gw; row < T; row += NGW) {
        const int b = row / TPB, r = row - b * TPB; const bool xr = r >= CTX; const int s = r - CTX, prow = xr ? (s >> 6) : 0, pcol = xr ? (s & 63) : 0;
        const v4u* y = (const v4u*)(Y1 + (size_t)row * EVEN_IN_P); v4u* yd = (v4u*)((bf16*)(F.ws + ydst_off) + (size_t)row * EVEN_IN_P);
        const v4u k0 = y[128 + (lane & 31)], cq = y[192 + lane], ckv = y[256 + lane];
        const v4u ok0 = head_chunk<128>(k0, a.in[I_AKN], xr, prow, pcol, t128, lane);
        const v4u ocq = norm512_chunk(cq, a.in[I_BCQN], lane), ockv = norm512_chunk(ckv, a.in[I_BCKVN], lane);
        if (lane < 32) yd[128 + lane] = ok0;
        ((v4u*)(CQN + (size_t)row * 512))[lane] = ocq; ((v4u*)(CKVN + (size_t)row * 512))[lane] = ockv;
    }
}
__device__ __forceinline__ void p_even_post2(const Frame& F, const Args& a, size_t qdst_off = WS_QB, size_t kdst_off = WS_KB) {
    const LocalId L_ = local_id(); (void)L_;
    const int gw = F.vcu * NWAVES + L_.wave, NGW = F.G * NWAVES, lane = L_.lane;
    const bf16* Y1 = (const bf16*)(F.ws + WS_Y1); const bf16* QB = (const bf16*)(F.ws + WS_QB); const bf16* KV = (const bf16*)(F.ws + WS_KV);
    bf16* KB = (bf16*)(F.ws + kdst_off); bf16* QBd = (bf16*)(F.ws + qdst_off);
    const float2* t64 = (const float2*)(F.ws + WS_ROPE + 16384);
    const float* gq = a.in[I_BQN]; const float* gk = a.in[I_BKN]; const float* KRP = (const float*)(F.ws + WS_LG);
    const int l16 = lane & 15, l8 = lane & 7, hn = lane >> 4, hr = lane >> 3;
    const f32x4 gqn0 = ((const f32x4*)gq)[2 * l16], gqn1 = ((const f32x4*)gq)[2 * l16 + 1], gqr0 = ((const f32x4*)(gq + 128))[2 * l8], gqr1 = ((const f32x4*)(gq + 128))[2 * l8 + 1];
    const f32x4 gkn0 = ((const f32x4*)gk)[2 * l16], gkn1 = ((const f32x4*)gk)[2 * l16 + 1], gkr0 = ((const f32x4*)(gk + 128))[2 * l8], gkr1 = ((const f32x4*)(gk + 128))[2 * l8 + 1];
    for (int row = gw; row < T; row += NGW) {
        const int b = row / TPB, r = row - b * TPB; const bool xr = r >= CTX; const int s = r - CTX, prow = xr ? (s >> 6) : 0, pcol = xr ? (s & 63) : 0;
        const bf16* q = QB + (size_t)row * 1536; const bf16* kv = KV + (size_t)row * 2048;
        const v4u wk0 = *(const v4u*)(kv + hn * 256 + l16 * 8), wk1 = *(const v4u*)(kv + (hn + 4) * 256 + l16 * 8);
        const v4u wkr = *(const v4u*)(Y1 + (size_t)row * EVEN_IN_P + 2560 + l8 * 8);
#define POST2_ONE(W0, W1, WR, GN0, GN1, GR0, GR1, DST) do { \
        float x0[8], x1[8], xr_[8]; unpack8(W0, x0); unpack8(W1, x1); unpack8(WR, xr_); \
        const float n0 = group_sum<16>(sumsq8(x0)), n1 = group_sum<16>(sumsq8(x1)), rs = group_sum<8>(sumsq8(xr_));     \
        const float rs0 = __shfl(rs, 8 * hn), rs1 = __shfl(rs, 8 * (hn + 4));                                         \
        const float t0 = __shfl(n0, 16 * (hr & 3)), t1 = __shfl(n1, 16 * (hr & 3)); const float nr = (hr >> 2) ? t1 : t0;    \
        const float r0 = 1.0f / sqrtf((n0 + rs0) * (1.0f / 192.0f) + NORM_EPS), r1 = 1.0f / sqrtf((n1 + rs1) * (1.0f / 192.0f) + NORM_EPS), rr = 1.0f / sqrtf((nr + rs) * (1.0f / 192.0f) + NORM_EPS); \
        x0[0] *= r0 * GN0.x; x0[1] *= r0 * GN0.y; x0[2] *= r0 * GN0.z; x0[3] *= r0 * GN0.w; x0[4] *= r0 * GN1.x; x0[5] *= r0 * GN1.y; x0[6] *= r0 * GN1.z; x0[7] *= r0 * GN1.w; \
        x1[0] *= r1 * GN0.x; x1[1] *= r1 * GN0.y; x1[2] *= r1 * GN0.z; x1[3] *= r1 * GN0.w; x1[4] *= r1 * GN1.x; x1[5] *= r1 * GN1.y; x1[6] *= r1 * GN1.z; x1[7] *= r1 * GN1.w; \
        xr_[0] *= rr * GR0.x; xr_[1] *= rr * GR0.y; xr_[2] *= rr * GR0.z; xr_[3] *= rr * GR0.w; xr_[4] *= rr * GR1.x; xr_[5] *= rr * GR1.y; xr_[6] *= rr * GR1.z; xr_[7] *= rr * GR1.w; \
        if (xr) rope8<64>(xr_, l8, prow, pcol, t64); \
        *(v4u*)((DST) + hn * 192 + l16 * 8) = pack8(x0); *(v4u*)((DST) + (hn + 4) * 192 + l16 * 8) = pack8(x1); *(v4u*)((DST) + hr * 192 + 128 + l8 * 8) = pack8(xr_); } while (0)
        POST2_ONE(wk0, wk1, wkr, gkn0, gkn1, gkr0, gkr1, KB + (size_t)row * 1536);
#undef POST2_ONE
    }
}
__device__ __forceinline__ void p_odd_post1(const Frame& F, const Args& a, size_t ydst_off = WS_Y1) {
    const LocalId L_ = local_id(); (void)L_;
    const int gw = F.vcu * NWAVES + L_.wave, NGW = F.G * NWAVES, lane = L_.lane;
    const bf16* Y1 = (const bf16*)(F.ws + WS_Y1);
    const float2* t128 = (const float2*)(F.ws + WS_ROPE); const float2* t64 = (const float2*)(F.ws + WS_ROPE + 16384);
    for (int row = gw; row < T; row += NGW) {
        const int b = row / TPB, r = row - b * TPB; const bool xr = r >= CTX; const int s = r - CTX, prow = xr ? (s >> 6) : 0, pcol = xr ? (s & 63) : 0;
        const v4u* y = (const v4u*)(Y1 + (size_t)row * ODD_IN); v4u* yd = (v4u*)((bf16*)(F.ws + ydst_off) + (size_t)row * ODD_IN);
        const v4u kc0 = y[128 + lane], kc1 = y[192 + lane], kd0 = y[512 + (lane & 31)];
        const v4u p0 = head_chunk<64>(kc0, a.in[I_CKN], xr, prow, pcol, t64, lane), p1 = head_chunk<64>(kc1, a.in[I_CKN], xr, prow, pcol, t64, lane);
        const v4u p2 = head_chunk<128>(kd0, a.in[I_DKN], xr, prow, pcol, t128, lane);
        yd[128 + lane] = p0; yd[192 + lane] = p1; if (lane < 32) yd[512 + lane] = p2;
    }
}

__device__ __forceinline__ void p_route(const Frame& F, const Args& a, int layer) {
    const LocalId L_ = local_id(); (void)L_;
    const float* LG = (const float*)(F.ws + WS_LG); int* ROUTE = (int*)(F.ws + WS_ROUTE);
    unsigned* cnt = (unsigned*)(F.ctl + CW_CNT + layer * 64);
    const float* brg = a.in[I_BRG] + layer * 4; const float* bre = a.in[I_BRE] + layer * 32;
    const int NT = F.G * 512;
    for (int base = F.vcu * 512 + L_.wave * 64; base < T; base += NT) {
        const int t = base + L_.lane;
        bool valid = t < T; if (valid && layer == 1) valid = (t % TPB) >= CTX;
        int e0 = -1, e1 = -1; float w0 = 0.f, w1 = 0.f;
        if (valid) {
            const float* lg = LG + (size_t)t * 64;
            float g[4]; for (int i = 0; i < 4; ++i) { float v = brg[i]; for (int ks = 0; ks < RKS; ++ks) v += lg[(size_t)ks * T * 64 + i]; g[i] = v; }
            int gi = 0; float gm = g[0]; for (int i = 1; i < 4; ++i) if (g[i] > gm) { gm = g[i]; gi = i; }
            float den = 0.f; for (int i = 0; i < 4; ++i) den += expf(g[i] - gm);
            const float ptop = 1.0f / den;
            float el[8]; for (int i = 0; i < 8; ++i) { float v = bre[gi * 8 + i]; for (int ks = 0; ks < RKS; ++ks) v += lg[(size_t)ks * T * 64 + 4 + gi * 8 + i]; el[i] = v; }
            int i1 = 0; float l1 = el[0]; for (int i = 1; i < 8; ++i) if (el[i] > l1) { l1 = el[i]; i1 = i; }
            int i2 = -1; float l2 = -3.0e38f; for (int i = 0; i < 8; ++i) if (i != i1 && el[i] > l2) { l2 = el[i]; i2 = i; }
            const float ex = expf(l2 - l1), inv = 1.0f / (1.0f + ex);
            w0 = ptop * inv; w1 = ptop * ex * inv; e0 = gi * 8 + i1; e1 = gi * 8 + i2;
        }
        int pos0 = 0, pos1 = 0;
        const unsigned long long lt = (1ull << L_.lane) - 1ull;
        for (int e = 0; e < NE; ++e) {
            const unsigned long long m0 = __ballot(e0 == e), m1 = __ballot(e1 == e);
            const int n0 = __popcll(m0), n1 = __popcll(m1);
            if (n0 + n1 == 0) continue;
            unsigned basev = 0;
            if (L_.lane == 0) basev = __hip_atomic_fetch_add(cnt + e, (unsigned)(n0 + n1), RLX_AGENT);
            basev = (unsigned)__builtin_amdgcn_readfirstlane((int)basev);
            if (e0 == e) pos0 = (int)basev + __popcll(m0 & lt);
            if (e1 == e) pos1 = (int)basev + n0 + __popcll(m1 & lt);
        }
        if (valid) { int* rec = ROUTE + (size_t)t * 8; rec[0] = e0; rec[1] = e1; rec[2] = pos0; rec[3] = pos1; rec[4] = __builtin_bit_cast(int, w0); rec[5] = __builtin_bit_cast(int, w1); }
    }
}
typedef short bf16x8_t __attribute__((ext_vector_type(8)));
__device__ __forceinline__ void p_mod2_route(const Frame& F, const Args& a, int layer) {
    const LocalId L_ = local_id(); (void)L_;
    const int lane = L_.lane, wave = L_.wave;
    constexpr int FPITCH = 4112;
    LAS unsigned char* Fs = F.lds + RING_OFF; LAS float* P = (LAS float*)(F.lds + RING_OFF + 16 * FPITCH + 256);
    const float* MOD = (const float*)(F.ws + WS_MOD); const bf16* H = (const bf16*)(F.ws + WS_H); bf16* A1 = (bf16*)(F.ws + WS_A1);
    const bf16* WR = (const bf16*)(F.ws + WS_WR) + (size_t)layer * 256 * 2048;
    int* ROUTE = (int*)(F.ws + WS_ROUTE); unsigned* cnt = (unsigned*)(F.ctl + CW_CNT + layer * 64); int* postok = (int*)(F.ws + WS_POS) + (size_t)layer * NE * POSCAP;
    const float* brg = a.in[I_BRG] + layer * 4; const float* bre = a.in[I_BRE] + layer * 32;
    bf16x8_t bfr[3][8];
#pragma unroll
    for (int nb = 0; nb < 3; ++nb)
#pragma unroll
        for (int ks = 0; ks < 8; ++ks) bfr[nb][ks] = *(const bf16x8_t*)(WR + (size_t)(nb * 16 + (lane & 15)) * 2048 + wave * 256 + ks * 32 + (lane >> 4) * 8);
    const int NG = layer == 1 ? NB * SEQ / 16 : T / 16;
    int it = 0;
    for (int g = F.vcu; g < NG; g += F.G, ++it) {
        int row0; if (layer == 1) { const int b = g >> 7; row0 = b * TPB + CTX + (g & 127) * 16; } else row0 = g * 16;
        const int j = mod_index(row0);
        const float* m = MOD + (size_t)(layer * 9 + j) * 12288;
        f32x4 v0[8], v1[8];
        const int r0 = 2 * wave, r1 = r0 + 1;
        hrow_load(H + (size_t)(row0 + r0) * DM, lane, v0);
        hrow_load(H + (size_t)(row0 + r1) * DM, lane, v1);
#define M2R_ROW(V, R) do { float ss = 0.f; \
        _Pragma("unroll") for (int q = 0; q < 8; ++q) ss += (V[q].x * V[q].x + V[q].y * V[q].y) + (V[q].z * V[q].z + V[q].w * V[q].w); \
        ss = wave_sum(ss); const float rn = 1.0f / sqrtf(ss * (1.0f / 2048.0f) + NORM_EPS); \
        _Pragma("unroll") for (int q = 0; q < 8; ++q) { const f32x4 sh = ((const f32x4*)(m + 3 * 2048))[lane + 64 * q], sc = ((const f32x4*)(m + 4 * 2048))[lane + 64 * q]; \
            const f32x4 y = V[q] * rn * (sc + 1.0f) + sh; v2u o; o.x = pk2(y.x, y.y); o.y = pk2(y.z, y.w); \
            ((v2u*)(A1 + (size_t)(row0 + (R)) * DM))[lane + 64 * q] = o; *(LAS v2u*)(Fs + (R) * FPITCH + (lane + 64 * q) * 8) = o; } } while (0)
        M2R_ROW(v0, r0); M2R_ROW(v1, r1);
#undef M2R_ROW
        __syncthreads();
        f32x4 acc[3];
#pragma unroll
        for (int nb = 0; nb < 3; ++nb) acc[nb] = (f32x4){0.f, 0.f, 0.f, 0.f};
#pragma unroll
        for (int ks = 0; ks < 8; ++ks) { const bf16x8_t af = *(const LAS bf16x8_t*)(Fs + (lane & 15) * FPITCH + (wave * 256 + ks * 32 + (lane >> 4) * 8) * 2);
#pragma unroll
            for (int nb = 0; nb < 3; ++nb) acc[nb] = __builtin_amdgcn_mfma_f32_16x16x32_bf16(af, bfr[nb][ks], acc[nb], 0, 0, 0); }
        LAS float* Pb = P + (it & 1) * (8 * 16 * 48);
#pragma unroll
        for (int nb = 0; nb < 3; ++nb)
#pragma unroll
            for (int rg = 0; rg < 4; ++rg) Pb[(wave * 16 + 4 * (lane >> 4) + rg) * 48 + nb * 16 + (lane & 15)] = acc[nb][rg];
        __syncthreads();
        if (wave == 0) {
            const bool valid = lane < 16; const int t = row0 + (lane & 15);
            int e0 = -1, e1 = -1; float w0 = 0.f, w1 = 0.f;
            if (valid) {
                const LAS float* pr = Pb + lane * 48;
                float gg[4];
#pragma unroll
                for (int i = 0; i < 4; ++i) { float sacc = brg[i];
#pragma unroll
                    for (int w = 0; w < 8; ++w) sacc += pr[w * 768 + i];
                    gg[i] = sacc; }
                int gi = 0; float gm = gg[0];
#pragma unroll
                for (int i = 1; i < 4; ++i) if (gg[i] > gm) { gm = gg[i]; gi = i; }
                float den = 0.f;
#pragma unroll
                for (int i = 0; i < 4; ++i) den += expf(gg[i] - gm);
                const float ptop = 1.0f / den;
                float el[8];
#pragma unroll
                for (int i = 0; i < 8; ++i) { float sacc = bre[gi * 8 + i];
#pragma unroll
                    for (int w = 0; w < 8; ++w) sacc += pr[w * 768 + 4 + gi * 8 + i];
                    el[i] = sacc; }
                int i1 = 0; float l1 = el[0];
#pragma unroll
                for (int i = 1; i < 8; ++i) if (el[i] > l1) { l1 = el[i]; i1 = i; }
                int i2 = -1; float l2 = -3.0e38f;
#pragma unroll
                for (int i = 0; i < 8; ++i) if (i != i1 && el[i] > l2) { l2 = el[i]; i2 = i; }
                const float ex = expf(l2 - l1), inv = 1.0f / (1.0f + ex);
                w0 = ptop * inv; w1 = ptop * ex * inv; e0 = gi * 8 + i1; e1 = gi * 8 + i2;
            }
            int rank0 = 0, rank1 = 0, mycnt = 0;
            const unsigned long long lt = (1ull << lane) - 1ull;
            for (int e = 0; e < NE; ++e) {
                const unsigned long long m0 = __ballot(e0 == e), m1 = __ballot(e1 == e);
                const int n0 = __popcll(m0), n1 = __popcll(m1);
                if (lane == e) mycnt = n0 + n1;
                if (e0 == e) rank0 = __popcll(m0 & lt);
                if (e1 == e) rank1 = n0 + __popcll(m1 & lt);
            }
            int basev = 0;
            if (lane < NE && mycnt > 0) basev = (int)__hip_atomic_fetch_add(cnt + lane, (unsigned)mycnt, RLX_AGENT);
            const int pos0 = __shfl(basev, e0 & 31) + rank0, pos1 = __shfl(basev, e1 & 31) + rank1;
            if (valid) { int* rec = ROUTE + (size_t)t * 8; rec[0] = e0; rec[1] = e1; rec[2] = pos0; rec[3] = pos1; rec[4] = __builtin_bit_cast(int, w0); rec[5] = __builtin_bit_cast(int, w1);
                         postok[(size_t)e0 * POSCAP + pos0] = t; postok[(size_t)e1 * POSCAP + pos1] = t; }
        }
    }
    __syncthreads();
}
__device__ __forceinline__ void p_gather(const Frame& F, int layer) {
    const LocalId L_ = local_id(); (void)L_;
    LAS int* offs = (LAS int*)(F.lds + RING_OFF);
    if (L_.tid == 0) { int o = 0; for (int e = 0; e < NE; ++e) { offs[e] = o; const unsigned c = __hip_atomic_load((unsigned*)(F.ctl + CW_CNT + layer * 64 + e), RLX_AGENT); o += (int)((c + 255u) & ~255u); } offs[NE] = o; }
    __syncthreads();
    if (blockIdx.x == 0 && L_.tid < NE) { const int e = L_.tid; int* texp = (int*)(F.ctl + CW_TEXP + layer * 256);
        for (int r = offs[e] >> 8; r < (offs[e + 1] >> 8); ++r) texp[r] = e;
        if (e == 0) *(int*)(F.ctl + CW_NRT + layer * 64) = offs[NE] >> 8; }
    int* ROUTE = (int*)(F.ws + WS_ROUTE); int* slot_tok = (int*)(F.ctl + CW_SLOT + layer * MAXSLOT);
    for (int t = F.vcu * 512 + L_.tid; t < T; t += F.G * 512) {
        if (layer == 1 && (t % TPB) < CTX) continue;
        int* rec = ROUTE + (size_t)t * 8;
        const int s0 = offs[rec[0]] + rec[2], s1 = offs[rec[1]] + rec[3];
        slot_tok[s0] = t; slot_tok[s1] = t; rec[6] = s0; rec[7] = s1;
    }
    __syncthreads();
}

constexpr int SLD = 2304;
template <int DQ, int QR>
__device__ __forceinline__ void naive_scores_softmax(LAS float* S, LAS float* qf, const bf16* Q, int ldq, const bf16* K, int ldk, int lo, int nk, float scale,
                                                     bool window, int qpos0, bool has_sink, float sink, int tid, int lane, int wave) {
    for (int i = tid; i < QR * DQ; i += 512) { const int r = i / DQ, d = i - r * DQ; qf[i] = bf2f(Q[(size_t)r * ldq + d]); }
    __syncthreads();
    for (int t = tid; t < nk; t += 512) {
        const int kr = t < CTX ? t : CTX + lo + (t - CTX);
        const bf16* kp = K + (size_t)kr * ldk;
        float acc[QR];
#pragma unroll
        for (int r = 0; r < QR; ++r) acc[r] = 0.f;
        for (int d = 0; d < DQ; d += 8) {
            const v4u kv = *(const v4u*)(kp + d);
            const float k0 = bflo(kv.x), k1 = bfhi(kv.x), k2 = bflo(kv.y), k3 = bfhi(kv.y), k4 = bflo(kv.z), k5 = bfhi(kv.z), k6 = bflo(kv.w), k7 = bfhi(kv.w);
#pragma unroll
            for (int r = 0; r < QR; ++r) { const LAS float* qp = qf + r * DQ + d;
                acc[r] += (k0 * qp[0] + k1 * qp[1]) + (k2 * qp[2] + k3 * qp[3]) + (k4 * qp[4] + k5 * qp[5]) + (k6 * qp[6] + k7 * qp[7]); }
        }
#pragma unroll
        for (int r = 0; r < QR; ++r) { float s = acc[r] * scale;
            if (window && t >= CTX) { const int dd = (qpos0 + r) - (lo + t - CTX); if (dd > 128 || dd < -128) s = -1e30f; }
            S[r * SLD + t] = s; }
    }
    __syncthreads();
    if (wave < QR) {
        LAS float* row = S + wave * SLD;
        float m = -1e30f; for (int t = lane; t < nk; t += 64) m = fmaxf(m, row[t]);
        m = wave_max(m); if (has_sink) m = fmaxf(m, sink);
        float sum = 0.f; for (int t = lane; t < nk; t += 64) { const float e = expf(row[t] - m); row[t] = e; sum += e; }
        sum = wave_sum(sum); if (has_sink) sum += expf(sink - m);
        const float inv = 1.0f / sum;
        for (int t = lane; t < nk; t += 64) row[t] *= inv;
    }
    __syncthreads();
}
template <int QR>
__device__ __forceinline__ void naive_pv(const LAS float* S, const bf16* V, int ldv, int lo, int nk, int tid, float (&o)[QR / 4]) {
    const int c = tid & 127, rg = tid >> 7; constexpr int RPT = QR / 4;
#pragma unroll
    for (int i = 0; i < RPT; ++i) o[i] = 0.f;
#pragma unroll 4
    for (int t = 0; t < nk; ++t) { const int kr = t < CTX ? t : CTX + lo + (t - CTX); const float v = bf2f(V[(size_t)kr * ldv + c]);
#pragma unroll
        for (int i = 0; i < RPT; ++i) o[i] += S[(rg * RPT + i) * SLD + t] * v; }
}
__device__ __forceinline__ void p_even_attn_naive(const Frame& F) {
    const LocalId L_ = local_id(); (void)L_;
    LAS float* S = (LAS float*)(F.lds + RING_OFF); LAS float* qf = (LAS float*)(F.lds + RING_OFF + 8 * SLD * 4);
    const bf16* Y1 = (const bf16*)(F.ws + WS_Y1); const bf16* QB = (const bf16*)(F.ws + WS_QB); const bf16* KV = (const bf16*)(F.ws + WS_KV); const bf16* KB = (const bf16*)(F.ws + WS_KB);
    bf16* MIX = (bf16*)(F.ws + WS_MIX);
    constexpr int UPV = NB * 8 * 288;
    for (int u = blockIdx.x; u < 2 * UPV; u += F.G) {
        const int var = u / UPV, rem = u - var * UPV, b = rem / 2304, rem2 = rem - b * 2304, h = rem2 / 288, ch = rem2 - h * 288;
        const int r0 = ch * 8, row0 = b * TPB + r0; const int nk = r0 < CTX ? CTX : TPB;
        float o[2];
        if (var == 0) {
            naive_scores_softmax<128, 8>(S, qf, Y1 + (size_t)row0 * EVEN_IN_P + h * 128, EVEN_IN_P, Y1 + (size_t)(b * TPB) * EVEN_IN_P + 1024 + (h >> 2) * 128, EVEN_IN_P, 0, nk,
                                         0.08838834764831845f, false, 0, false, 0.f, L_.tid, L_.lane, L_.wave);
            naive_pv<8>(S, Y1 + (size_t)(b * TPB) * EVEN_IN_P + 1280 + (h >> 2) * 128, EVEN_IN_P, 0, nk, L_.tid, o);
        } else {
            naive_scores_softmax<192, 8>(S, qf, QB + (size_t)row0 * 1536 + h * 192, 1536, KB + (size_t)(b * TPB) * 1536 + h * 192, 1536, 0, nk,
                                         0.07216878364870322f, false, 0, false, 0.f, L_.tid, L_.lane, L_.wave);
            naive_pv<8>(S, KV + (size_t)(b * TPB) * 2048 + h * 256 + 128, 2048, 0, nk, L_.tid, o);
        }
        const int c = L_.tid & 127, rg = L_.tid >> 7;
#pragma unroll
        for (int i = 0; i < 2; ++i) MIX[(size_t)(row0 + rg * 2 + i) * DM + var * 1024 + h * 128 + c] = (bf16)f2bf(o[i]);
        __syncthreads();
    }
}
__device__ __forceinline__ void p_odd_attn_naive(const Frame& F, const Args& a) {
    const LocalId L_ = local_id(); (void)L_;
    LAS float* S = (LAS float*)(F.lds + RING_OFF); LAS float* qf = (LAS float*)(F.lds + RING_OFF + 8 * SLD * 4); LAS float* ob = qf + 8 * 192;
    const bf16* Y1 = (const bf16*)(F.ws + WS_Y1); bf16* MIX = (bf16*)(F.ws + WS_MIX);
    float d1 = 0.f, d2 = 0.f;
    for (int i = 0; i < 64; ++i) { d1 += a.in[I_LQ1][i] * a.in[I_LK1][i]; d2 += a.in[I_LQ2][i] * a.in[I_LK2][i]; }
    const float lam = expf(d1) - expf(d2) + LAMBDA_INIT;
    constexpr int UC = NB * 8 * 512, UD = NB * 8 * 256;
    for (int u = blockIdx.x; u < UC + UD; u += F.G) {
        const int c = L_.tid & 127, rg = L_.tid >> 7;
        if (u < UC) {
            const int b = u / 4096, rem = u - b * 4096, h = rem / 512, ch = rem - h * 512;
            const int r0 = CTX + ch * 4, row0 = b * TPB + r0; const int nk = TPB;
            const bf16* kb = Y1 + (size_t)(b * TPB) * ODD_IN;
            naive_scores_softmax<64, 4>(S, qf, Y1 + (size_t)row0 * ODD_IN + (2 * h) * 64, ODD_IN, kb + 1024 + (2 * h) * 64, ODD_IN, 0, nk, 0.125f, false, 0, false, 0.f, L_.tid, L_.lane, L_.wave);
            naive_scores_softmax<64, 4>(S + 4 * SLD, qf, Y1 + (size_t)row0 * ODD_IN + (2 * h + 1) * 64, ODD_IN, kb + 1024 + (2 * h + 1) * 64, ODD_IN, 0, nk, 0.125f, false, 0, false, 0.f, L_.tid, L_.lane, L_.wave);
            for (int i = L_.tid; i < 4 * SLD; i += 512) S[i] = S[i] - lam * S[4 * SLD + i];
            __syncthreads();
            float o[1];
            naive_pv<4>(S, kb + 2048 + h * 128, ODD_IN, 0, nk, L_.tid, o);
            ob[rg * 128 + c] = o[0];
            __syncthreads();
            float ss = 0.f; for (int i = 0; i < 128; ++i) { const float v = ob[rg * 128 + i]; ss += v * v; }
            const float r = 1.0f / sqrtf(ss * (1.0f / 128.0f) + NORM_EPS);
            MIX[(size_t)(row0 + rg) * DM + h * 128 + c] = (bf16)f2bf(o[0] * r * a.in[I_SUBLN][c] * (1.0f - LAMBDA_INIT));
        } else {
            const int v = u - UC, b = v / 2048, rem = v - b * 2048, h = rem / 256, ch = rem - h * 256;
            const int s0 = ch * 8, row0 = b * TPB + CTX + s0;
            const int lo = s0 - 128 < 0 ? 0 : s0 - 128, hi = s0 + 7 + 128 > SEQ - 1 ? SEQ - 1 : s0 + 7 + 128; const int nk = CTX + (hi - lo + 1);
            const bf16* kb = Y1 + (size_t)(b * TPB) * ODD_IN;
            naive_scores_softmax<128, 8>(S, qf, Y1 + (size_t)row0 * ODD_IN + 3072 + h * 128, ODD_IN, kb + 4096 + (h >> 2) * 128, ODD_IN, lo, nk, 0.08838834764831845f, true, s0, true, a.in[I_SINK][h], L_.tid, L_.lane, L_.wave);
            float o[2];
            naive_pv<8>(S, kb + 4352 + (h >> 2) * 128, ODD_IN, lo, nk, L_.tid, o);
#pragma unroll
            for (int i = 0; i < 2; ++i) MIX[(size_t)(row0 + rg * 2 + i) * DM + 1024 + h * 128 + c] = (bf16)f2bf(o[i]);
        }
        __syncthreads();
    }
}

namespace att {
using bf16x8 = __attribute__((ext_vector_type(8))) short;
using s16x4  = __attribute__((ext_vector_type(4))) short;
using f32x16 = __attribute__((ext_vector_type(16))) float;
using u32x4  = __attribute__((ext_vector_type(4))) unsigned;
constexpr int KVBLK = 64, QBLK = 32;
constexpr int SHM_V = KVBLK * 128 * 2;
constexpr int K_OFF = 2 * SHM_V, K_MAX = KVBLK * 192 * 2, QL_OFF = K_OFF + 2 * K_MAX, WS_OFF = 131072 + 2048;
constexpr float THR = 8.f;
#define ATT_KSWZ(row, colB, RB) ((row) * (RB) + ((colB) ^ (((row) & 7) << 4)))
#define ATT_SBAR() __builtin_amdgcn_sched_barrier(0)
__device__ __forceinline__ int crow(int r, int hi) { return (r & 3) + 8 * (r >> 2) + 4 * hi; }
__device__ __forceinline__ unsigned cvtpk(float lo, float hi) { unsigned r; asm volatile("v_cvt_pk_bf16_f32 %0, %1, %2" : "=v"(r) : "v"(lo), "v"(hi)); return r; }

__device__ __forceinline__ void partialSM(f32x16& p0, f32x16& p1, float& m_reg, float& mn, float& alpha, float C, float thr_raw) {
  float pmax = p0[0];
#pragma unroll
  for (int r = 1; r < 16; ++r) pmax = fmaxf(pmax, p0[r]);
#pragma unroll
  for (int r = 0; r < 16; ++r) pmax = fmaxf(pmax, p1[r]);
  { auto rr = __builtin_amdgcn_permlane32_swap(__float_as_uint(pmax), __float_as_uint(pmax), false, false);
    pmax = fmaxf(__uint_as_float(rr[0]), __uint_as_float(rr[1])); }
  if (__builtin_expect(__all(pmax - m_reg <= thr_raw), 1)) { mn = m_reg; alpha = 1.f; }
  else { mn = fmaxf(m_reg, pmax); alpha = __builtin_amdgcn_exp2f((m_reg - mn) * C); m_reg = mn; }
  const float mnC = -mn * C;
#pragma unroll
  for (int r = 0; r < 16; ++r) p0[r] = fmaf(p0[r], C, mnC);
#pragma unroll
  for (int r = 0; r < 16; ++r) p1[r] = fmaf(p1[r], C, mnC);
#pragma unroll
  for (int r = 0; r < 16; ++r) p0[r] = __builtin_amdgcn_exp2f(p0[r]);
}
__device__ __forceinline__ void finishSM(f32x16& p0, f32x16& p1, float alpha, float& l_reg, bf16x8& pa0, bf16x8& pa1, bf16x8& pa2, bf16x8& pa3) {
#pragma unroll
  for (int r = 0; r < 16; ++r) p1[r] = __builtin_amdgcn_exp2f(p1[r]);
  float ps = 0;
#pragma unroll
  for (int r = 0; r < 16; ++r) ps += p0[r];
#pragma unroll
  for (int r = 0; r < 16; ++r) ps += p1[r];
  { auto rr = __builtin_amdgcn_permlane32_swap(__float_as_uint(ps), __float_as_uint(ps), false, false);
    ps = __uint_as_float(rr[0]) + __uint_as_float(rr[1]); }
  l_reg = l_reg * alpha + ps;
#define ATT_PK4(P, BASE, OUT) do { unsigned a0 = cvtpk(P[BASE + 0], P[BASE + 1]), a1 = cvtpk(P[BASE + 2], P[BASE + 3]);   \
    unsigned b0 = cvtpk(P[BASE + 4], P[BASE + 5]), b1 = cvtpk(P[BASE + 6], P[BASE + 7]);                              \
    auto r0 = __builtin_amdgcn_permlane32_swap(a0, b0, false, false); auto r1 = __builtin_amdgcn_permlane32_swap(a1, b1, false, false); \
    u32x4 w = {r0[0], r1[0], r0[1], r1[1]}; OUT = *reinterpret_cast<bf16x8*>(&w); } while (0)
  ATT_PK4(p0, 0, pa0); ATT_PK4(p0, 8, pa1); ATT_PK4(p1, 0, pa2); ATT_PK4(p1, 8, pa3);
#undef ATT_PK4
}
template <int DQ, int NQT, int NQR, int QSB>
__device__ __forceinline__ void qkt(f32x16& p0, f32x16& p1, const char* Ks, const bf16x8 (&qr)[NQR], const char* qlds, const int (&kb)[4]) {
  p0 = f32x16{}; p1 = f32x16{};
#pragma unroll
  for (int d0 = 0; d0 < NQT; ++d0) {
    const bf16x8 b0 = *reinterpret_cast<const bf16x8*>(Ks + kb[d0 & 3] + (d0 >> 2) * 128);
    const bf16x8 b1 = *reinterpret_cast<const bf16x8*>(Ks + kb[d0 & 3] + (d0 >> 2) * 128 + 32 * DQ * 2);
    bf16x8 q; if (d0 < NQR) q = qr[d0 < NQR ? d0 : 0]; else q = *reinterpret_cast<const bf16x8*>(qlds + (d0 - NQR) * 1024);
    p0 = __builtin_amdgcn_mfma_f32_32x32x16_bf16(b0, q, p0, 0, 0, 0);
    p1 = __builtin_amdgcn_mfma_f32_32x32x16_bf16(b1, q, p1, 0, 0, 0);
    if (QSB > 0 && (d0 % (QSB > 0 ? QSB : 1)) == (QSB - 1) && d0 + 1 < NQT) ATT_SBAR(); }
}
__device__ __forceinline__ void mask_tile(f32x16& p0, f32x16& p1, int kp0, int qpos, int hi) {
#pragma unroll
  for (int r = 0; r < 16; ++r) { const int d = qpos - (kp0 + crow(r, hi));
    if (d > 128 || d < -128) p0[r] = -1e30f;
    if (d - 32 > 128 || d - 32 < -128) p1[r] = -1e30f; }
}
__device__ __forceinline__ int v_st(int k, int c) { const int kk = (k & ~0xC) | ((k & 4) << 1) | ((k & 8) >> 1); return ((kk >> 3) * 4 + (c >> 5)) * 512 + ((kk & 7) * 32 + (c & 31)) * 2; }
__device__ __forceinline__ int v_rd_base(int lane) { return ((lane & 3) << 3) | (((lane >> 2) & 3) << 6) | (((lane >> 4) & 1) << 5) | (((lane >> 5) & 1) << 8); }
constexpr int v_rd_off(int d0, int ks, int half) { return d0 * 512 + ks * 4096 + half * 2048; }
template <int OFF> __device__ __forceinline__ s16x4 tr_read(int vb) {
  s16x4 r; asm volatile("ds_read_b64_tr_b16 %0, %1 offset:%2" : "=&v"(r) : "v"(vb), "i"(OFF) : "memory"); return r;
}
template <int D0> __device__ __forceinline__ void pv_one(f32x16& od, int vb, bf16x8 pa0, bf16x8 pa1, bf16x8 pa2, bf16x8 pa3) {
  const s16x4 l0 = tr_read<v_rd_off(D0, 0, 0)>(vb), h0 = tr_read<v_rd_off(D0, 0, 1)>(vb), l1 = tr_read<v_rd_off(D0, 1, 0)>(vb), h1 = tr_read<v_rd_off(D0, 1, 1)>(vb);
  const s16x4 l2 = tr_read<v_rd_off(D0, 2, 0)>(vb), h2 = tr_read<v_rd_off(D0, 2, 1)>(vb), l3 = tr_read<v_rd_off(D0, 3, 0)>(vb), h3 = tr_read<v_rd_off(D0, 3, 1)>(vb);
  asm volatile("s_waitcnt lgkmcnt(0)" ::: "memory"); ATT_SBAR();
#define ATT_PK(L, H) (bf16x8){L[0], L[1], L[2], L[3], H[0], H[1], H[2], H[3]}
  od = __builtin_amdgcn_mfma_f32_32x32x16_bf16(pa0, ATT_PK(l0, h0), od, 0, 0, 0);
  od = __builtin_amdgcn_mfma_f32_32x32x16_bf16(pa1, ATT_PK(l1, h1), od, 0, 0, 0);
  od = __builtin_amdgcn_mfma_f32_32x32x16_bf16(pa2, ATT_PK(l2, h2), od, 0, 0, 0);
  od = __builtin_amdgcn_mfma_f32_32x32x16_bf16(pa3, ATT_PK(l3, h3), od, 0, 0, 0);
#undef ATT_PK
}
__device__ __forceinline__ void pv_d0(f32x16* o, int vb, bf16x8 pa0, bf16x8 pa1, bf16x8 pa2, bf16x8 pa3) {
  pv_one<0>(o[0], vb, pa0, pa1, pa2, pa3); pv_one<1>(o[1], vb, pa0, pa1, pa2, pa3); pv_one<2>(o[2], vb, pa0, pa1, pa2, pa3); pv_one<3>(o[3], vb, pa0, pa1, pa2, pa3);
}

template <int M> __device__ __forceinline__ float swz_xor(float v) { return __builtin_bit_cast(float, __builtin_amdgcn_ds_swizzle(__builtin_bit_cast(int, v), (M << 10) | 0x1F)); }
__device__ __forceinline__ float sum_xor32(float v) { auto rr = __builtin_amdgcn_permlane32_swap(__float_as_uint(v), __float_as_uint(v), false, false); return __uint_as_float(rr[0]) + __uint_as_float(rr[1]); }
__device__ __forceinline__ float bfx(short v) { return __builtin_bit_cast(float, ((unsigned)(unsigned short)v) << 16); }
template <int MODE, int NQ>
__device__ __forceinline__ void q_fix(bf16x8 (&q)[NQ], const float* gain, const float* tab  , int pos, int hi) {
  constexpr int DIM = NQ * 16;
  float x[NQ][8]; float ss = 0.f;
#pragma unroll
  for (int d0 = 0; d0 < NQ; ++d0)
#pragma unroll
    for (int j = 0; j < 8; ++j) { x[d0][j] = bfx(q[d0][j]); ss += x[d0][j] * x[d0][j]; }
  ss = sum_xor32(ss);
  const float r = 1.0f / sqrtf(ss * (1.0f / DIM) + 1e-6f);
#pragma unroll
  for (int d0 = 0; d0 < NQ; ++d0) { const float* g = gain + d0 * 16 + hi * 8;
#pragma unroll
    for (int j = 0; j < 8; ++j) x[d0][j] *= r * g[j]; }
  if (pos >= 0) {
    const int prow = pos >> 6, pcol = pos & 63;
    constexpr int RB0 = (MODE == 2) ? 8 : 0, NRB = (MODE == 1) ? 8 : 4, NF = (MODE == 1) ? 32 : 16, PX = (MODE == 1) ? 2 : 1;
    float y[NRB][8];
#pragma unroll
    for (int b = 0; b < NRB; ++b) { const int p = (b < NRB / 2) ? prow : pcol; const int f0 = (MODE == 1 ? (b & 1) * 16 : 0) + hi * 8; const float sg = (b & PX) ? 1.0f : -1.0f;
      const float* t = tab + (size_t)(p * NF + f0) * 2;
#pragma unroll
      for (int j = 0; j < 8; ++j) y[b][j] = x[RB0 + b][j] * t[2 * j] + sg * x[RB0 + (b ^ PX)][j] * t[2 * j + 1]; }
#pragma unroll
    for (int b = 0; b < NRB; ++b)
#pragma unroll
      for (int j = 0; j < 8; ++j) x[RB0 + b][j] = y[b][j];
  }
#pragma unroll
  for (int d0 = 0; d0 < NQ; ++d0) { u32x4 w; w.x = cvtpk(x[d0][0], x[d0][1]); w.y = cvtpk(x[d0][2], x[d0][3]); w.z = cvtpk(x[d0][4], x[d0][5]); w.w = cvtpk(x[d0][6], x[d0][7]); q[d0] = *reinterpret_cast<bf16x8*>(&w); }
}

template <int DQ, bool WINDOW, bool SINK, int LDQ, int LDK, int LDV, int SD, int QSB, int NQRMAX, bool DIFF = false, int QMODE = 0>
__device__ __forceinline__ void attn_unit(const bf16* __restrict__ Qb, const bf16* __restrict__ Kb, const bf16* __restrict__ Vb,
                                          bf16* __restrict__ Ob, int ntiles, int band_lo, int qpos0, float scale, float sink, char* lds, const float* gainp = nullptr,
                                          const float* qgain = nullptr, const float* qtab = nullptr, int qs0 = -1, int wv = 0) {
  constexpr int NQ = (DIFF ? DQ / 2 : DQ) / 16, NQR = NQ > NQRMAX ? NQRMAX : NQ, NCH = DQ / 64, RB = DQ * 2, SHM_K = KVBLK * DQ * 2, LDO = 2048;
  int tid = wv * 64 + lane_id_(); asm volatile("" : "+v"(tid));
  const int wid = tid >> 6, lane = tid & 63, r32 = lane & 31, hi = lane >> 5;
  const int comp = DIFF ? (wid >> 2) : 0, wrow = DIFF ? (wid & 3) : wid, kcomp = comp * 128;
  char* V_lds = lds; char* K_lds = lds + K_OFF;
  float* ws = (float*)(lds + WS_OFF) + wid * 64; float* li_l = ws; float* al_l = ws + 32;
  const float C = scale * 1.4426950408889634f, thr_raw = THR / scale;
  float m_reg = -1e30f, l_reg = 0; f32x16 o[4] = {}; bf16x8 qr[NQR];
  const unsigned qoff = (unsigned)((wrow * QBLK + r32) * LDQ + hi * 8 + comp * 64) * 2u;
  char* qlds = lds + QL_OFF + wid * ((NQ - NQR) * 1024) + lane * 16;
  if constexpr (QMODE == 0) {
#pragma unroll
    for (int d0 = 0; d0 < NQR; ++d0) qr[d0] = *reinterpret_cast<const bf16x8*>((const char*)Qb + qoff + d0 * 32);
    __syncthreads();
    if constexpr (NQ > NQR) {
#pragma unroll
      for (int d0 = NQR; d0 < NQ; ++d0) *reinterpret_cast<bf16x8*>(qlds + (d0 - NQR) * 1024) = *reinterpret_cast<const bf16x8*>((const char*)Qb + qoff + d0 * 32);
    }
  } else {
    bf16x8 qall[NQ];
#pragma unroll
    for (int d0 = 0; d0 < NQ; ++d0) qall[d0] = *reinterpret_cast<const bf16x8*>((const char*)Qb + qoff + d0 * 32);
    q_fix<QMODE, NQ>(qall, qgain, qtab, qs0 < 0 ? -1 : qs0 + wrow * QBLK + r32, hi);
#pragma unroll
    for (int d0 = 0; d0 < NQR; ++d0) qr[d0] = qall[d0];
    __syncthreads();
    if constexpr (NQ > NQR) {
#pragma unroll
      for (int d0 = NQR; d0 < NQ; ++d0) *reinterpret_cast<bf16x8*>(qlds + (d0 - NQR) * 1024) = qall[d0];
    }
  }
  const int sr = tid >> 4, sc = (tid & 15) * 8, vst0 = v_st(sr, sc);
  const unsigned voV = (unsigned)(sr * LDV + sc) * 2u;
  const int kr_ = tid >> 3, kc_ = (tid & 7) * 8;
  const unsigned voK = (unsigned)(kr_ * LDK + kc_) * 2u; const int kwr = ATT_KSWZ(kr_, kc_ * 2, RB);
  const int vb0 = (int)(uintptr_t)V_lds + v_rd_base(lane);
  int kb[4];
#pragma unroll
  for (int k = 0; k < 4; ++k) kb[k] = r32 * RB + ((k ^ ((r32 & 7) >> 1)) * 32) + ((hi ^ (r32 & 1)) * 16);
  const int qpos = qpos0 + wrow * QBLK + r32;
  struct { bf16x8 vs0, vs1, ks[NCH]; } sr_[SD];
#define ATT_KROW(j) (WINDOW ? ((j) < 4 ? (j) * KVBLK : 256 + band_lo + ((j) - 4) * KVBLK) : (j) * KVBLK)
#define ATT_SLOAD(i, j) do { const int k0_ = ATT_KROW(j); const char* vt_ = (const char*)Vb + (size_t)k0_ * (LDV * 2); const char* kt_ = (const char*)Kb + (size_t)k0_ * (LDK * 2); \
    sr_[i].vs0 = *reinterpret_cast<const bf16x8*>(vt_ + voV); sr_[i].vs1 = *reinterpret_cast<const bf16x8*>(vt_ + voV + 32 * LDV * 2); \
    _Pragma("unroll") for (int c_ = 0; c_ < NCH; ++c_) sr_[i].ks[c_] = *reinterpret_cast<const bf16x8*>(kt_ + voK + c_ * 128); } while (0)
#define ATT_SWRITE(b, i) do { *(bf16x8*)(V_lds + (b) * SHM_V + vst0) = sr_[i].vs0; *(bf16x8*)(V_lds + (b) * SHM_V + vst0 + 8192) = sr_[i].vs1; \
    _Pragma("unroll") for (int c_ = 0; c_ < NCH; ++c_) *(bf16x8*)(K_lds + (b) * SHM_K + kwr + c_ * 128) = sr_[i].ks[c_]; } while (0)
#define ATT_SWAIT() do { if constexpr (SD == 1) asm volatile("s_waitcnt vmcnt(0)" ::: "memory"); else if constexpr (NCH == 1) asm volatile("s_waitcnt vmcnt(3)" ::: "memory"); else if constexpr (NCH == 2) asm volatile("s_waitcnt vmcnt(4)" ::: "memory"); else asm volatile("s_waitcnt vmcnt(5)" ::: "memory"); } while (0)
#define ATT_RESC(a) do { if (__any((a) < 1.f)) { if (hi == 0) al_l[r32] = (a); asm volatile("s_waitcnt lgkmcnt(0)" ::: "memory"); \
    _Pragma("unroll") for (int d = 0; d < 4; ++d) _Pragma("unroll") for (int r = 0; r < 16; ++r) o[d][r] *= al_l[crow(r, hi)]; } } while (0)
#define ATT_MASK(P0, P1, j) do { if constexpr (WINDOW) { if ((j) >= 4) mask_tile(P0, P1, band_lo + ((j) - 4) * KVBLK, qpos, hi); } } while (0)
  f32x16 pA0, pA1, pB0, pB1; float mnA, mnB, alA, alB; bf16x8 pa0, pa1, pa2, pa3; const int NT = ntiles;
  constexpr int SE = 0, SO = SD - 1;
  ATT_SLOAD(SE, 0); asm volatile("s_waitcnt vmcnt(0)" ::: "memory"); ATT_SWRITE(0, SE); __syncthreads();
  qkt<DQ, NQ, NQR, QSB>(pA0, pA1, K_lds + kcomp, qr, qlds, kb); ATT_MASK(pA0, pA1, 0); partialSM(pA0, pA1, m_reg, mnA, alA, C, thr_raw);
  ATT_SLOAD(SO, 1); if constexpr (SD == 2) { if (2 < NT) ATT_SLOAD(SE, 2); }
  ATT_SWAIT(); ATT_SWRITE(1, SO); __syncthreads();
  for (int j = 1; j + 1 < NT; j += 2) {
    ATT_SBAR(); qkt<DQ, NQ, NQR, QSB>(pB0, pB1, K_lds + SHM_K + kcomp, qr, qlds, kb);
    finishSM(pA0, pA1, alA, l_reg, pa0, pa1, pa2, pa3); ATT_SBAR();
    ATT_SLOAD(SO, j + SD); ATT_SBAR();
    pv_d0(o, vb0, pa0, pa1, pa2, pa3); ATT_MASK(pB0, pB1, j); partialSM(pB0, pB1, m_reg, mnB, alB, C, thr_raw);
    __syncthreads(); ATT_SWAIT(); ATT_SWRITE(0, SE);
    ATT_RESC(alB); __syncthreads();
    ATT_SBAR(); qkt<DQ, NQ, NQR, QSB>(pA0, pA1, K_lds + kcomp, qr, qlds, kb);
    finishSM(pB0, pB1, alB, l_reg, pa0, pa1, pa2, pa3); ATT_SBAR();
    if (SD == 1 || j + 3 < NT) ATT_SLOAD(SE, j + 1 + SD); ATT_SBAR();
    pv_d0(o, vb0 + SHM_V, pa0, pa1, pa2, pa3); ATT_MASK(pA0, pA1, j + 1); partialSM(pA0, pA1, m_reg, mnA, alA, C, thr_raw);
    __syncthreads(); ATT_SWAIT(); ATT_SWRITE(1, SO);
    ATT_RESC(alA); __syncthreads();
  }
  ATT_SBAR(); qkt<DQ, NQ, NQR, QSB>(pB0, pB1, K_lds + SHM_K + kcomp, qr, qlds, kb);
  finishSM(pA0, pA1, alA, l_reg, pa0, pa1, pa2, pa3); ATT_SBAR();
  pv_d0(o, vb0, pa0, pa1, pa2, pa3); ATT_MASK(pB0, pB1, NT - 1); partialSM(pB0, pB1, m_reg, mnB, alB, C, thr_raw);
  __syncthreads(); ATT_RESC(alB);
  finishSM(pB0, pB1, alB, l_reg, pa0, pa1, pa2, pa3); ATT_SBAR();
  pv_d0(o, vb0 + SHM_V, pa0, pa1, pa2, pa3);
  if constexpr (SINK) l_reg += __builtin_amdgcn_exp2f(sink * 1.4426950408889634f - m_reg * C);
  if (hi == 0) li_l[r32] = l_reg; asm volatile("s_waitcnt lgkmcnt(0)" ::: "memory");
  float rli[16];
#pragma unroll
  for (int r = 0; r < 16; ++r) rli[r] = __builtin_amdgcn_rcpf(li_l[crow(r, hi)]);
  int tid2 = wv * 64 + lane_id_(); asm volatile("" : "+v"(tid2));
  if constexpr (!DIFF) {
    const bool odd = tid2 & 1;
    const unsigned ooff = (unsigned)(((tid2 >> 6) * QBLK + 4 * ((tid2 >> 5) & 1) + (tid2 & 1)) * LDO + (tid2 & 30)) * 2u;
#pragma unroll
    for (int rp = 0; rp < 8; ++rp) { const int orow = ((2 * rp) & 3) + 8 * ((2 * rp) >> 2);
#pragma unroll
      for (int d0 = 0; d0 < 4; ++d0) { const float a_ = o[d0][2 * rp] * rli[2 * rp], b_ = o[d0][2 * rp + 1] * rli[2 * rp + 1];
        const float rc = swz_xor<1>(odd ? a_ : b_);
        *reinterpret_cast<unsigned*>((char*)Ob + ooff + (orow * LDO + d0 * 32) * 2) = odd ? cvtpk(rc, b_) : cvtpk(a_, rc); } }
  } else {
    float* X = (float*)lds + ((tid2 >> 6) & 3) * 4096 + (tid2 & 63);
    __syncthreads();
    if (tid2 >= 256) {
#pragma unroll
      for (int d0 = 0; d0 < 4; ++d0)
#pragma unroll
        for (int r = 0; r < 16; ++r) X[(d0 * 16 + r) * 64] = sink * (o[d0][r] * rli[r]);
    }
    __syncthreads();
    if (tid2 < 256) {
      float g[4];
#pragma unroll
      for (int d0 = 0; d0 < 4; ++d0) g[d0] = gainp[d0 * 32 + (tid2 & 31)];
      const bool odd = tid2 & 1;
      const unsigned ooff = (unsigned)(((tid2 >> 6) * QBLK + 4 * ((tid2 >> 5) & 1) + (tid2 & 1)) * LDO + (tid2 & 30)) * 2u;
#pragma unroll
      for (int rp = 0; rp < 8; ++rp) { const int orow = ((2 * rp) & 3) + 8 * ((2 * rp) >> 2);
        float da[4], db[4], sa = 0.f, sb = 0.f;
#pragma unroll
        for (int d0 = 0; d0 < 4; ++d0) { da[d0] = o[d0][2 * rp] * rli[2 * rp] - X[(d0 * 16 + 2 * rp) * 64]; db[d0] = o[d0][2 * rp + 1] * rli[2 * rp + 1] - X[(d0 * 16 + 2 * rp + 1) * 64]; sa += da[d0] * da[d0]; sb += db[d0] * db[d0]; }
        sa += swz_xor<1>(sa); sa += swz_xor<2>(sa); sa += swz_xor<4>(sa); sa += swz_xor<8>(sa); sa += swz_xor<16>(sa);
        sb += swz_xor<1>(sb); sb += swz_xor<2>(sb); sb += swz_xor<4>(sb); sb += swz_xor<8>(sb); sb += swz_xor<16>(sb);
        const float ra = __builtin_amdgcn_rsqf(sa * (1.0f / 128.0f) + 1e-6f), rb = __builtin_amdgcn_rsqf(sb * (1.0f / 128.0f) + 1e-6f);
#pragma unroll
        for (int d0 = 0; d0 < 4; ++d0) { const float a_ = da[d0] * ra * g[d0], b_ = db[d0] * rb * g[d0];
          const float rc = swz_xor<1>(odd ? a_ : b_);
          *reinterpret_cast<unsigned*>((char*)Ob + ooff + (orow * LDO + d0 * 32) * 2) = odd ? cvtpk(rc, b_) : cvtpk(a_, rc); } }
    }
  }
#undef ATT_KROW
#undef ATT_SLOAD
#undef ATT_SWRITE
#undef ATT_SWAIT
#undef ATT_RESC
#undef ATT_MASK
}
}

__device__ __forceinline__ void p_even_attn(const Frame& F, const Args& a, char* lds) {
    const LocalId L_ = local_id(); (void)L_;
    const bf16* Y1 = (const bf16*)(F.ws + WS_Y1); const bf16* QB = (const bf16*)(F.ws + WS_QB); const bf16* KV = (const bf16*)(F.ws + WS_KV); const bf16* KB = (const bf16*)(F.ws + WS_KB);
    bf16* MIX = (bf16*)(F.ws + WS_MIX);
    const float* t128 = (const float*)(F.ws + WS_ROPE); const float* t64 = (const float*)(F.ws + WS_ROPE + 16384);
    for (int n = blockIdx.x; n < 512 + 64; n += F.G) {
        int b, h, row0, nt, qs0;
        if (n < 512) { const int i = n >> 8, c = n & 255, x = c & 7, lc = c >> 3, gi = i * 8 + x; b = gi >> 1; h = (gi & 1) * 4 + (lc >> 3); qs0 = (lc & 7) * 256; row0 = b * TPB + CTX + qs0; nt = 36; }
        else { const int m = n - 512; b = m >> 3; h = m & 7; row0 = b * TPB; nt = 4; qs0 = -1; }
        const size_t kb = (size_t)b * TPB;
        att::attn_unit<128, false, false, EVEN_IN_P, EVEN_IN_P, EVEN_IN_P, 2, 0, 8, false, 1>(Y1 + (size_t)row0 * EVEN_IN_P + h * 128, Y1 + kb * EVEN_IN_P + 1024 + (h >> 2) * 128, Y1 + kb * EVEN_IN_P + 1280 + (h >> 2) * 128,
                                                                                 MIX + (size_t)row0 * DM + h * 128, nt, 0, 0, 0.08838834764831845f, 0.f, lds, nullptr, a.in[I_AQN], t128, qs0, L_.wave);
    }
    for (int n = blockIdx.x; n < 512 + 64; n += F.G) {
        int b, h, row0, nt, qs0;
        if (n < 512) { const int i = n >> 8, c = n & 255, x = c & 7, lc = c >> 3, gi = i * 8 + x; b = gi >> 1; h = (gi & 1) * 4 + (lc >> 3); qs0 = (lc & 7) * 256; row0 = b * TPB + CTX + qs0; nt = 36; }
        else { const int m = n - 512; b = m >> 3; h = m & 7; row0 = b * TPB; nt = 4; qs0 = -1; }
        const size_t kb = (size_t)b * TPB;
        att::attn_unit<192, false, false, 1536, 1536, 2048, 1, 0, 8, false, 2>(QB + (size_t)row0 * 1536 + h * 192, KB + kb * 1536 + h * 192, KV + kb * 2048 + h * 256 + 128,
                                                                  MIX + (size_t)row0 * DM + 1024 + h * 128, nt, 0, 0, 0.07216878364870322f, 0.f, lds, nullptr, a.in[I_BQN], t64, qs0, L_.wave);
    }
    __syncthreads();
}
__device__ __forceinline__ void p_odd_attn(const Frame& F, const Args& a, char* lds) {
    const LocalId L_ = local_id(); (void)L_;
    const bf16* Y1 = (const bf16*)(F.ws + WS_Y1); bf16* O12 = (bf16*)(F.ws + WS_A1); bf16* MIX = (bf16*)(F.ws + WS_MIX);
#if ATT_DIFF_FUSED
    float d1 = 0.f, d2 = 0.f;
    for (int i = 0; i < 64; ++i) { d1 += a.in[I_LQ1][i] * a.in[I_LK1][i]; d2 += a.in[I_LQ2][i] * a.in[I_LK2][i]; }
    const float lam = expf(d1) - expf(d2) + LAMBDA_INIT;
    const float* gsub = (const float*)(F.ws + WS_ROPE + 32768);
    for (int n = blockIdx.x; n < 1024; n += F.G) {
        const int i = n >> 8, c = n & 255, x = c & 7, lc = c >> 3, gi = i * 8 + x, b = gi >> 2, h = (gi & 3) * 2 + (lc >> 4), row0 = b * TPB + CTX + (lc & 15) * 128;
        const size_t kb = (size_t)b * TPB * ODD_IN;
        att::attn_unit<128, false, false, ODD_IN, ODD_IN, ODD_IN, 2, 0, 8, true, 3>(Y1 + (size_t)row0 * ODD_IN + h * 128, Y1 + kb + 1024 + h * 128, Y1 + kb + 2048 + h * 128,
                                                                             MIX + (size_t)row0 * DM + h * 128, 36, 0, 0, 0.125f, lam, lds, gsub, a.in[I_CQN], (const float*)(F.ws + WS_ROPE + 16384), (lc & 15) * 128, L_.wave);
    }
#else
    for (int n = blockIdx.x; n < 1024; n += F.G) {
        const int i = n >> 8, c = n & 255, x = c & 7, lc = c >> 3, gi = i * 8 + x, b = gi >> 2, ch = (gi & 3) * 4 + (lc >> 3), row0 = b * TPB + CTX + (lc & 7) * 256;
        const size_t kb = (size_t)b * TPB * ODD_IN;
        att::attn_unit<64, false, false, ODD_IN, ODD_IN, ODD_IN, 2, 0, 8>(Y1 + (size_t)row0 * ODD_IN + ch * 64, Y1 + kb + 1024 + ch * 64, Y1 + kb + 2048 + (ch >> 1) * 128,
                                                                       O12 + (size_t)row0 * DM + ch * 128, 36, 0, 0, 0.125f, 0.f, lds, nullptr, nullptr, nullptr, -1, L_.wave);
    }
#endif
    for (int m = blockIdx.x; m < 512; m += F.G) {
        const int i = m >> 8, c = m & 255, x = c & 7, lc = c >> 3, gi = i * 8 + x, b = gi >> 1, kvh = gi & 1, h = kvh * 4 + (lc >> 3), s0 = (lc & 7) * 256, row0 = b * TPB + CTX + s0;
        const int lo = s0 - 128 < 0 ? 0 : s0 - 128, hie = s0 + 384 > SEQ ? SEQ : s0 + 384;
        const size_t kb = (size_t)b * TPB * ODD_IN;
        att::attn_unit<128, true, true, ODD_IN, ODD_IN, ODD_IN, 1, 0, 8, false, 1>(Y1 + (size_t)row0 * ODD_IN + 3072 + h * 128, Y1 + kb + 4096 + kvh * 128, Y1 + kb + 4352 + kvh * 128,
                                                                      MIX + (size_t)row0 * DM + 1024 + h * 128, 4 + (hie - lo) / 64, lo, s0, 0.08838834764831845f, a.in[I_SINK][h], lds, nullptr, a.in[I_DQN], (const float*)(F.ws + WS_ROPE), s0, L_.wave);
    }
    __syncthreads();
}
__device__ __forceinline__ void p_odd_combine(const Frame& F, const Args& a) {
    const LocalId L_ = local_id(); (void)L_;
    const int gw = F.vcu * NWAVES + L_.wave, NGW = F.G * NWAVES;
    const bf16* O12 = (const bf16*)(F.ws + WS_A1); bf16* MIX = (bf16*)(F.ws + WS_MIX);
    float d1 = 0.f, d2 = 0.f;
    for (int i = 0; i < 64; ++i) { d1 += a.in[I_LQ1][i] * a.in[I_LK1][i]; d2 += a.in[I_LQ2][i] * a.in[I_LK2][i]; }
    const float lam = expf(d1) - expf(d2) + LAMBDA_INIT;
    const float g0 = a.in[I_SUBLN][L_.lane] * (1.0f - LAMBDA_INIT), g1 = a.in[I_SUBLN][L_.lane + 64] * (1.0f - LAMBDA_INIT);
    for (int i = gw; i < NB * SEQ; i += NGW) {
        const int b = i / SEQ, row = b * TPB + CTX + (i - b * SEQ);
        const bf16* src = O12 + (size_t)row * DM; bf16* dst = MIX + (size_t)row * DM;
        for (int h = 0; h < 8; ++h) {
            const float x0 = bf2f(src[2 * h * 128 + L_.lane]) - lam * bf2f(src[(2 * h + 1) * 128 + L_.lane]);
            const float x1 = bf2f(src[2 * h * 128 + 64 + L_.lane]) - lam * bf2f(src[(2 * h + 1) * 128 + 64 + L_.lane]);
            const float ss = wave_sum(x0 * x0 + x1 * x1);
            const float r = 1.0f / sqrtf(ss * (1.0f / 128.0f) + NORM_EPS);
            dst[h * 128 + L_.lane] = (bf16)f2bf(x0 * r * g0); dst[h * 128 + 64 + L_.lane] = (bf16)f2bf(x1 * r * g1);
        }
    }
}

__global__ void __launch_bounds__(NWAVES * 64, 2) trunk_fwd(Args args) {
    extern __shared__ __attribute__((aligned(16))) unsigned char lds[];
    Frame F;
    F.lds = (LAS unsigned char*)lds;
    F.MISC = (volatile LAS unsigned*)(F.lds + MISC_OFF);
    F.tid = threadIdx.x; F.lane = F.tid & 63; F.wave = __builtin_amdgcn_readfirstlane(F.tid >> 6);
    F.G = gridDim.x; { const int bx = blockIdx.x; F.vcu = (F.G % 8 == 0) ? (bx % 8) * (F.G / 8) + bx / 8 : bx; }
    F.ws = args.ws; F.ctl = (gu32*)(args.ws + WS_CTL);
    for (int u = F.tid; u < (LDS_BYTES - LDSCTL_OFF) / 4; u += NWAVES * 64) ((LAS unsigned*)(F.lds + LDSCTL_OFF))[u] = 0u;
    __syncthreads();
    XcdBarrier bar; bar.bar = (unsigned*)(F.ctl + CW_BAR); bar.x = 0; bar.st = nullptr;
#if !MK_PER_PHASE
    bar = xcd_barrier_post((unsigned*)(F.ctl + CW_BAR), F.MISC + 8);
#endif
    const int lo = args.ph_lo, hi = args.ph_hi;
#define IN(k) (lo <= (k) && (k) < hi)
#if MK_PER_PHASE
#define SEAM(k) do { } while (0)
#else
#define SEAM(k) do { if (IN(k) && IN((k) + 1)) xcd_barrier(bar); } while (0)
#endif
    bf16* const A1 = (bf16*)(F.ws + WS_A1); bf16* const MIX = (bf16*)(F.ws + WS_MIX); bf16* const H = (bf16*)(F.ws + WS_H); const float* const MOD = (const float*)(F.ws + WS_MOD);
    PG8_LAS unsigned char* const ring = (PG8_LAS unsigned char*)(F.lds + RING_OFF);

#ifndef DUP_PHASE
#define DUP_PHASE (-1)
#endif
#ifndef PROBE_PHASE
#define PROBE_PHASE (-1)
#endif
constexpr size_t WS_DUMMY = 1600 * MiB;
#define PROBE(k, ...) do { if (PROBE_PHASE == (k) && IN(k)) { for (int r_ = 0; r_ < 3; ++r_) { __VA_ARGS__ xcd_barrier(bar); } } } while (0)
#define PH(k, ...) do { if (IN(k)) { __VA_ARGS__ if (DUP_PHASE == (k)) { for (int r_ = 0; r_ < 3; ++r_) { xcd_barrier(bar); __VA_ARGS__ } } } SEAM(k); } while (0)
#define GEMM_STATIC(EPI, Aptr, Bptr, N_, K_, ...) do { pg8::Gemm g{(const bf16*)(Aptr), (const bf16*)(Bptr), (K_), (K_), (K_), nullptr}; pg8::StaticOrder S; S.init(T, (N_), F.G, (int)blockIdx.x); \
        pg8::EPI E{__VA_ARGS__}; pg8::gemm_phase<pg8::EPI, pg8::StaticOrder, false>(ring, g, S, E, F.wave); } while (0)
#ifndef MOE_F32B
#define MOE_F32B 0
#endif
#define GEMM_MOE_F(EPI, GATH, Aptr, M0, M1, ESTR, LDN, COLMUL, HOFF, K_, layer, ...) do { const int nrt = __builtin_amdgcn_readfirstlane(*(const int*)(F.ctl + CW_NRT + (layer) * 64)); \
        pg8::Gemm g{(const bf16*)(Aptr), nullptr, (K_), 0, (K_), (const int*)(F.ctl + CW_SLOT + (layer) * MAXSLOT)}; pg8::BSrc bs{(M0), (M1), (size_t)(ESTR), (LDN), (COLMUL), (HOFF)}; \
        pg8::MoeOrder S; S.init((const int*)(F.ctl + CW_TEXP + (layer) * 256), nrt, F.G, (int)blockIdx.x); \
        pg8::EPI E{__VA_ARGS__}; pg8::gemm_phase_f32b<pg8::EPI, pg8::MoeOrder, GATH>(ring, g, bs, S, E, F.wave); } while (0)
#define GEMM_ORDER(EPI, ORDER, INIT, Aptr, Bptr, K_, ...) do { pg8::Gemm g{(const bf16*)(Aptr), (const bf16*)(Bptr), (K_), (K_), (K_), nullptr}; pg8::ORDER S; S.init INIT; \
        pg8::EPI E{__VA_ARGS__}; pg8::gemm_phase<pg8::EPI, pg8::ORDER, false>(ring, g, S, E, F.wave); } while (0)
#define GEMM_ROUTER_X(Bptr) do { pg8::Gemm g{(const bf16*)A1, (const bf16*)(Bptr), DM, DM, DM / RKS, nullptr}; pg8::SplitKXOrder S; S.init(RKS, DM / RKS, F.G, (int)blockIdx.x); \
        pg8::EpiLogits E{(float*)(ws + WS_LG), DM / RKS, (size_t)T * 64}; pg8::gemm_phase<pg8::EpiLogits, pg8::SplitKXOrder, false>(ring, g, S, E, F.wave); } while (0)
#define GEMM_ROUTER(Bptr) do { pg8::Gemm g{(const bf16*)A1, (const bf16*)(Bptr), DM, DM, DM / RKS, nullptr}; pg8::SplitKOrder S; S.init(T / 256, RKS, DM / RKS, F.G, (int)blockIdx.x); \
        pg8::EpiLogits E{(float*)(ws + WS_LG), DM / RKS, (size_t)T * 64}; pg8::gemm_phase<pg8::EpiLogits, pg8::SplitKOrder, false>(ring, g, S, E, F.wave); } while (0)
#define GEMM_MOE(EPI, GATH, Aptr, Bptr, K_, layer, ...) do { const int nrt = __builtin_amdgcn_readfirstlane(moe_tables(F, (layer), F.wave * 64 + lane_id_())); \
        pg8::Gemm g{(const bf16*)(Aptr), (const bf16*)(Bptr), (K_), (K_), (K_), (const int*)(ws + WS_POS) + (size_t)(layer) * NE * POSCAP}; pg8::MoeOrder S; \
        S.init((const PG8_LAS int*)(F.lds + LDS_TAB), (const PG8_LAS int*)(F.lds + LDS_TAB) + 256, nrt, POSCAP, F.G, (int)blockIdx.x); \
        pg8::EPI E{__VA_ARGS__}; pg8::gemm_phase<pg8::EPI, pg8::MoeOrder, GATH>(ring, g, S, E, F.wave); } while (0)
    unsigned char* const ws = F.ws;
    PH(0, p0_prologue(F, args););
    PH(1, p_l0_mod1(F, args););
#ifdef NEXTRA_BAR
    for (int i_ = 0; i_ < NEXTRA_BAR; ++i_) xcd_barrier(bar);
#endif
    PH(2, GEMM_STATIC(EpiStoreBf16, A1, ws + WS_WE_IN, EVEN_IN_P, DM, (bf16*)(ws + WS_Y1), EVEN_IN_P, 0x7fffffff););
    PROBE(3, p_even_post1(F, args, WS_DUMMY););
    PH(3, p_even_post1(F, args););
    PH(4, GEMM_STATIC(EpiStoreBf16, ws + WS_CQN, ws + WS_WE_UQ, 1536, 512, (bf16*)(ws + WS_QB), 1536, 0x7fffffff);
          GEMM_STATIC(EpiStoreBf16, ws + WS_CKVN, ws + WS_WE_UKV, 2048, 512, (bf16*)(ws + WS_KV), 2048, 0x7fffffff););
    PH(5, p_even_post2(F, args););
#if USE_NAIVE_ATTN
    PH(6, p_even_attn_naive(F););
#else
    PH(6, p_even_attn(F, args, (char*)lds););
#endif
    PH(7, GEMM_STATIC(EpiResidInit, MIX, ws + WS_WE_OUT, DM, DM, H, MOD + (size_t)0 * 9 * 12288 + 2 * 2048, args.in[I_X], args.in[I_CTX]););
#if FUSED_ROUTE
    PH(8, p_mod2_route(F, args, 0););
#else
    PH(8, p_mod2(F, 0););
    PH(9, GEMM_ROUTER(ws + WS_WR););
    PH(10, p_route(F, args, 0););
#endif
#if MOE_F32B
    PH(12, GEMM_MOE_F(EpiSwiGLU, true, A1, args.in[I_WG], args.in[I_WU], 2048 * 1024, 1024, 128, 0, DM, 0, (bf16*)(ws + WS_U), DE););
    PH(13, GEMM_MOE_F(EpiStoreBf16, false, ws + WS_U, args.in[I_WD], args.in[I_WD], 1024 * 2048, 2048, 256, 128, DE, 0, (bf16*)(ws + WS_YS), DM, 7););
#else
    PH(12, GEMM_MOE(EpiSwiGLU, true, A1, ws + WS_WGU, DM, 0, (bf16*)(ws + WS_U), DE););
    PH(13, GEMM_MOE(EpiStoreBf16, false, ws + WS_U, ws + WS_WDN, DE, 0, (bf16*)(ws + WS_YS), DM, 7););
#endif
    PROBE(14, p_l1_mod1(F, WS_DUMMY, WS_DUMMY + 160 * MiB););
    PH(14, p_l1_mod1(F););
    PH(15, GEMM_ORDER(EpiStoreBf16, OddInOrder, (F.G, (int)blockIdx.x), A1, ws + WS_WO_IN, DM, (bf16*)(ws + WS_Y1), ODD_IN, 0x7fffffff););
    PROBE(16, p_odd_post1(F, args, WS_DUMMY););
    PH(16, p_odd_post1(F, args););
#if USE_NAIVE_ATTN
    PH(17, p_odd_attn_naive(F, args););
    PH(18, ;);
#else
    PH(17, p_odd_attn(F, args, (char*)lds););
#if !ATT_DIFF_FUSED
    PH(18, p_odd_combine(F, args););
#endif
#endif
    PH(19, GEMM_ORDER(EpiResid, XOnlyOrder, (DM, F.G, (int)blockIdx.x), MIX, ws + WS_WO_OUT, DM, H, MOD + (size_t)1 * 9 * 12288 + 2 * 2048););
#if FUSED_ROUTE
    PH(20, p_mod2_route(F, args, 1););
#else
    PH(20, p_mod2(F, 1););
    PH(21, GEMM_ROUTER_X((const bf16*)(ws + WS_WR) + (size_t)256 * 2048););
    PH(22, p_route(F, args, 1););
#endif
#if MOE_F32B
    PH(24, GEMM_MOE_F(EpiSwiGLU, true, A1, args.in[I_WG] + (size_t)32 * 2048 * 1024, args.in[I_WU] + (size_t)32 * 2048 * 1024, 2048 * 1024, 1024, 128, 0, DM, 1, (bf16*)(ws + WS_U), DE););
    PH(25, GEMM_MOE_F(EpiStoreBf16, false, ws + WS_U, args.in[I_WD] + (size_t)32 * 1024 * 2048, args.in[I_WD] + (size_t)32 * 1024 * 2048, 1024 * 2048, 2048, 256, 128, DE, 1, (bf16*)(ws + WS_YS), DM, 7););
#else
    PH(24, GEMM_MOE(EpiSwiGLU, true, A1, (const bf16*)(ws + WS_WGU) + (size_t)32 * 2048 * 2048, DM, 1, (bf16*)(ws + WS_U), DE););
    PH(25, GEMM_MOE(EpiStoreBf16, false, ws + WS_U, (const bf16*)(ws + WS_WDN) + (size_t)32 * 2048 * 1024, DE, 1, (bf16*)(ws + WS_YS), DM, 7););
#endif
    PH(26, p_final(F, args.out););
#undef IN
#undef SEAM
}

extern "C" void kernel_launch(void* const* d_in, const int* in_sizes, int n_in, void* d_out, int out_size, void* d_ws, size_t ws_size, hipStream_t stream) {
    static int grid = 0;
    if (grid == 0) {
        if (n_in != 35 || out_size != NB * SEQ * DM || ws_size < WS_END) { fprintf(stderr, "kernel_launch: unexpected shapes: n_in %d out %d ws %zu (need %zu)\n", n_in, out_size, ws_size, (size_t)WS_END); grid = -1; return; }
        int dev = 0, cus = 0, per_cu = 0;
        if (hipGetDevice(&dev) != hipSuccess || hipDeviceGetAttribute(&cus, hipDeviceAttributeMultiprocessorCount, dev) != hipSuccess) { grid = -1; return; }
        if (hipFuncSetAttribute((const void*)trunk_fwd, hipFuncAttributeMaxDynamicSharedMemorySize, LDS_BYTES) != hipSuccess) { fprintf(stderr, "kernel_launch: hipFuncSetAttribute failed\n"); grid = -1; return; }
        if (hipOccupancyMaxActiveBlocksPerMultiprocessor(&per_cu, (const void*)trunk_fwd, NWAVES * 64, LDS_BYTES) != hipSuccess || per_cu < 1)
            fprintf(stderr, "kernel_launch: occupancy query reports %d workgroups per CU\n", per_cu);
        (void)hipGetLastError();
        grid = cus;
    }
    if (grid < 0) return;
    if (hipMemsetAsync((char*)d_ws + WS_CTL, 0, CTL_ZERO_BYTES, stream) != hipSuccess) { fprintf(stderr, "kernel_launch: memset failed\n"); return; }
    if (hipMemsetAsync((char*)d_ws + WS_POS, 0, (size_t)2 * NE * POSCAP * 4, stream) != hipSuccess) { fprintf(stderr, "kernel_launch: memset failed\n"); return; }
    Args a{};
    for (int i = 0; i < 35; ++i) a.in[i] = (const float*)d_in[i];
    a.out = (float*)d_out; a.ws = (unsigned char*)d_ws;
#if MK_PER_PHASE
    for (int p = 0; p < NPHASE; ++p) { a.ph_lo = p; a.ph_hi = p + 1; hipLaunchKernelGGL(trunk_fwd, dim3(grid), dim3(NWAVES * 64), LDS_BYTES, stream, a); }
#else
    a.ph_lo = 0; a.ph_hi = NPHASE; hipLaunchKernelGGL(trunk_fwd, dim3(grid), dim3(NWAVES * 64), LDS_BYTES, stream, a);
#endif
    const hipError_t le = hipPeekAtLastError();
    if (le != hipSuccess) fprintf(stderr, "kernel_launch: launch failed: %s\n", hipGetErrorName(le));
}
```

```cpp
#include <hip/hip_runtime.h>
#include <cstdio>
#include <cstdint>
__device__ __forceinline__ int lane_id_() { return (int)__builtin_amdgcn_mbcnt_hi(~0u, __builtin_amdgcn_mbcnt_lo(~0u, 0u)); }
#define MK_PER_PHASE 0
namespace pg8 {
#define PG8_LAS __attribute__((address_space(3)))
typedef unsigned short bf16_t;
typedef short bf16x8 __attribute__((ext_vector_type(8)));
typedef float f32x4 __attribute__((ext_vector_type(4)));
typedef unsigned u32x4 __attribute__((ext_vector_type(4)));
constexpr int BM = 256, BK = 64, HALF = 128, HTB = HALF * BK * 2  , STAGE_BYTES = 8 * HTB, NXCD = 8, WGM = 8;

__host__ __device__ __forceinline__ int lds_byte(int r, int c) { const int st = (r >> 4) * 2 + (c >> 5), rr = r & 15, cc = c & 31, ob = rr * 64 + cc * 2; return st * 1024 + (ob ^ (((ob >> 9) & 1) << 5)); }
__host__ __device__ __forceinline__ void stage_rc(int b, int& R, int& C) { const int st = b / 1024, sb = b % 1024, swz = sb ^ (((sb >> 9) & 1) << 5); R = (st >> 1) * 16 + swz / 64; C = (st & 1) * 32 + (swz % 64) / 2; }
__host__ __device__ __forceinline__ int perm32(int rho) { const int n = rho >> 4, i = rho & 15; return 8 * (i >> 2) + 4 * n + (i & 3); }

struct Unit { int pm, pn, ko, kt, gb; };
struct Gemm { const bf16_t* A; const bf16_t* Bt; int lda, ldb, K; const int* rowidx; };

struct StaticOrder {
    int nM, nN, nwg, G, c;
    __host__ __device__ void init(int M, int N, int G_, int c_) { nM = M / BM; nN = N / BM; nwg = nM * nN; G = G_; c = c_; }
    __host__ __device__ bool next(int i, Unit& u) const {
        const long L = (long)i * G + c; if (L >= nwg) return false;
        int wgid = (int)L; { const int q = nwg / NXCD, r = nwg % NXCD, xcd = wgid % NXCD, off = wgid / NXCD; wgid = (xcd < r ? xcd * (q + 1) : r * (q + 1) + (xcd - r) * q) + off; }
        const int nig = WGM * nN, gid = wgid / nig, fm = gid * WGM, gsz = (nM - fm) < WGM ? (nM - fm) : WGM;
        u.pm = fm + ((wgid % nig) % gsz); u.pn = (wgid % nig) / gsz; u.ko = 0; u.kt = 0; u.gb = u.pm * BM; return true;
    }
    __device__ __forceinline__ void a_ready(const Unit&) const {}
    __device__ __forceinline__ void done(const Unit&) const {}
};


__device__ __forceinline__ unsigned cvt_pk_bf16(float lo, float hi) { unsigned r; asm volatile("v_cvt_pk_bf16_f32 %0, %1, %2" : "=v"(r) : "v"(lo), "v"(hi)); return r; }

struct EpiStoreBf16 {
    static constexpr bool PERM = true, AFTER_DRAIN = false;
    bf16_t* O; int ldc; int pn_mask;
    __device__ __forceinline__ void operator()(const f32x4 (&acc)[2][2][4][2], const Unit& u, int wr, int wc, int fr, int fq) const {
        const int row0 = u.pm * BM + wr * 64 + fr, col0 = (u.pn & pn_mask) * BM + wc * 32 + 8 * fq;
#pragma unroll
        for (int ai = 0; ai < 2; ++ai)
#pragma unroll
            for (int m = 0; m < 4; ++m) { bf16_t* rowp = O + (size_t)(row0 + ai * HALF + m * 16) * ldc + col0;
#pragma unroll
                for (int bj = 0; bj < 2; ++bj) { const f32x4 v0 = acc[ai][bj][m][0], v1 = acc[ai][bj][m][1];
                    u32x4 w; w.x = cvt_pk_bf16(v0[0], v0[1]); w.y = cvt_pk_bf16(v0[2], v0[3]); w.z = cvt_pk_bf16(v1[0], v1[1]); w.w = cvt_pk_bf16(v1[2], v1[3]);
                    *(u32x4*)(rowp + bj * HALF) = w; } }
    }
};
__device__ __forceinline__ float silu_f(float x) { return x * __builtin_amdgcn_rcpf(1.0f + __builtin_amdgcn_exp2f(-1.4426950408889634f * x)); }
struct EpiSwiGLU {
    static constexpr bool PERM = true, AFTER_DRAIN = false;
    bf16_t* O; int ldc;
    __device__ __forceinline__ void operator()(const f32x4 (&acc)[2][2][4][2], const Unit& u, int wr, int wc, int fr, int fq) const {
        const int row0 = u.pm * BM + wr * 64 + fr, col0 = (u.pn & 7) * HALF + wc * 32 + 8 * fq;
#pragma unroll
        for (int ai = 0; ai < 2; ++ai)
#pragma unroll
            for (int m = 0; m < 4; ++m) { bf16_t* rowp = O + (size_t)(row0 + ai * HALF + m * 16) * ldc + col0;
                const f32x4 g0 = acc[ai][0][m][0], g1 = acc[ai][0][m][1], u0 = acc[ai][1][m][0], u1 = acc[ai][1][m][1];
                u32x4 w; w.x = cvt_pk_bf16(silu_f(g0[0]) * u0[0], silu_f(g0[1]) * u0[1]); w.y = cvt_pk_bf16(silu_f(g0[2]) * u0[2], silu_f(g0[3]) * u0[3]);
                w.z = cvt_pk_bf16(silu_f(g1[0]) * u1[0], silu_f(g1[1]) * u1[1]); w.w = cvt_pk_bf16(silu_f(g1[2]) * u1[2], silu_f(g1[3]) * u1[3]);
                *(u32x4*)rowp = w; }
    }
};
__device__ __forceinline__ float bf_lo(unsigned w) { return __builtin_bit_cast(float, w << 16); }
__device__ __forceinline__ float bf_hi(unsigned w) { return __builtin_bit_cast(float, w & 0xffff0000u); }
struct EpiResid {
    static constexpr bool PERM = true, AFTER_DRAIN = false;
    bf16_t* H; const float* modg;
    __device__ __forceinline__ void operator()(const f32x4 (&acc)[2][2][4][2], const Unit& u, int wr, int wc, int fr, int fq) const {
        const int row0 = u.pm * BM + wr * 64 + fr, col0 = u.pn * BM + wc * 32 + 8 * fq;
        const int j = (u.pm % 9 == 0) ? 8 : (u.pm / 9);
        const float* g = modg + (size_t)j * 12288 + col0;
        f32x4 gv[2][2];
#pragma unroll
        for (int bj = 0; bj < 2; ++bj)
#pragma unroll
            for (int n = 0; n < 2; ++n) gv[bj][n] = *(const f32x4*)(g + bj * HALF + 4 * n);
#pragma unroll
        for (int ai = 0; ai < 2; ++ai)
#pragma unroll
            for (int m = 0; m < 4; ++m) { bf16_t* rowp = H + (size_t)(row0 + ai * HALF + m * 16) * 2048 + col0;
#pragma unroll
                for (int bj = 0; bj < 2; ++bj) { u32x4* p = (u32x4*)(rowp + bj * HALF); const u32x4 h = *p;
                    const f32x4 a0 = gv[bj][0] * acc[ai][bj][m][0], a1 = gv[bj][1] * acc[ai][bj][m][1];
                    u32x4 w; w.x = cvt_pk_bf16(bf_lo(h.x) + a0[0], bf_hi(h.x) + a0[1]); w.y = cvt_pk_bf16(bf_lo(h.y) + a0[2], bf_hi(h.y) + a0[3]);
                    w.z = cvt_pk_bf16(bf_lo(h.z) + a1[0], bf_hi(h.z) + a1[1]); w.w = cvt_pk_bf16(bf_lo(h.w) + a1[2], bf_hi(h.w) + a1[3]);
                    *p = w; } }
    }
};
struct EpiResidInit {
    static constexpr bool PERM = true, AFTER_DRAIN = false;
    bf16_t* H; const float* modg; const float* xin; const float* ctxin;
    __device__ __forceinline__ void operator()(const f32x4 (&acc)[2][2][4][2], const Unit& u, int wr, int wc, int fr, int fq) const {
        const int rl0 = wr * 64 + fr, col0 = u.pn * BM + wc * 32 + 8 * fq;
        const int b = u.pm / 9, t = u.pm - 9 * b, j = (t == 0) ? 8 : b;
        const float* src = (t == 0) ? ctxin + (size_t)(b * 256) * 2048 : xin + (size_t)(b * 2048 + (t - 1) * 256) * 2048;
        const float* g = modg + (size_t)j * 12288 + col0;
        f32x4 gv[2][2];
#pragma unroll
        for (int bj = 0; bj < 2; ++bj)
#pragma unroll
            for (int n = 0; n < 2; ++n) gv[bj][n] = *(const f32x4*)(g + bj * HALF + 4 * n);
#pragma unroll
        for (int ai = 0; ai < 2; ++ai)
#pragma unroll
            for (int m = 0; m < 4; ++m) { const int rl = rl0 + ai * HALF + m * 16; bf16_t* rowp = H + (size_t)(u.pm * BM + rl) * 2048 + col0; const float* srow = src + (size_t)rl * 2048 + col0;
#pragma unroll
                for (int bj = 0; bj < 2; ++bj) { const f32x4 h0 = *(const f32x4*)(srow + bj * HALF), h1 = *(const f32x4*)(srow + bj * HALF + 4);
                    const f32x4 v0 = h0 + gv[bj][0] * acc[ai][bj][m][0], v1 = h1 + gv[bj][1] * acc[ai][bj][m][1];
                    u32x4 w; w.x = cvt_pk_bf16(v0[0], v0[1]); w.y = cvt_pk_bf16(v0[2], v0[3]); w.z = cvt_pk_bf16(v1[0], v1[1]); w.w = cvt_pk_bf16(v1[2], v1[3]);
                    *(u32x4*)(rowp + bj * HALF) = w; } }
    }
};
struct EpiLogits {
    static constexpr bool PERM = false, AFTER_DRAIN = false;
    float* LG; int kslice; size_t slice_stride;
    __device__ __forceinline__ void operator()(const f32x4 (&acc)[2][2][4][2], const Unit& u, int wr, int wc, int fr, int fq) const {
        if (wc >= 2) return;
        const int row0 = u.pm * BM + wr * 64 + fr, col0 = wc * 32 + 4 * fq;
        float* base = LG + (size_t)(u.ko / kslice) * slice_stride;
#pragma unroll
        for (int ai = 0; ai < 2; ++ai)
#pragma unroll
            for (int m = 0; m < 4; ++m) { float* rowp = base + (size_t)(row0 + ai * HALF + m * 16) * 64 + col0;
#pragma unroll
                for (int n = 0; n < 2; ++n) *(f32x4*)(rowp + n * 16) = acc[ai][0][m][n]; }
    }
};
struct SplitKOrder {
    int nM, KS, kslice, G, c;
    __device__ void init(int nM_, int KS_, int kslice_, int G_, int c_) { nM = nM_; KS = KS_; kslice = kslice_; G = G_; c = c_; }
    __device__ bool next(int i, Unit& u) const { const long L = (long)i * G + c; if (L >= (long)nM * KS) return false; const int ks = (int)L / nM; u.pm = (int)L - ks * nM; u.pn = 0; u.ko = ks * kslice; u.kt = 0; u.gb = 0; return true; }
    __device__ __forceinline__ void a_ready(const Unit&) const {}
    __device__ __forceinline__ void done(const Unit&) const {}
};
struct EvenInOrder {
    StaticOrder so; int G, c;
    __device__ void init(int M, int G_, int c_) { so.init(M, 2560, G_, c_); G = G_; c = c_; }
    __device__ bool next(int i, Unit& u) const {
        if (so.next(i, u)) return true;
        const long L = (long)i * G + c - so.nwg; if (L < 0 || L >= 72 * 4) return false;
        const int ks = (int)L / 72; u.pm = (int)L - ks * 72; u.pn = 10; u.ko = ks * 512; u.kt = 8; u.gb = 0; return true;
    }
    __device__ __forceinline__ void a_ready(const Unit&) const {}
    __device__ __forceinline__ void done(const Unit&) const {}
};
struct EpiEvenIn {
    static constexpr bool PERM = true, AFTER_DRAIN = false;
    bf16_t* Y; float* KRP;
    __device__ __forceinline__ void operator()(const f32x4 (&acc)[2][2][4][2], const Unit& u, int wr, int wc, int fr, int fq) const {
        if (u.pn < 10) { const EpiStoreBf16 e{Y, 2816, 0x7fffffff}; e(acc, u, wr, wc, fr, fq); return; }
        if (wc >= 2) return;
        const int row0 = u.pm * BM + wr * 64 + fr, col0 = wc * 32 + 8 * fq;
        float* base = KRP + (size_t)(u.ko >> 9) * ((size_t)18432 * 64);
#pragma unroll
        for (int ai = 0; ai < 2; ++ai)
#pragma unroll
            for (int m = 0; m < 4; ++m) { float* rowp = base + (size_t)(row0 + ai * HALF + m * 16) * 64 + col0;
#pragma unroll
                for (int n = 0; n < 2; ++n) *(f32x4*)(rowp + 4 * n) = acc[ai][0][m][n]; }
    }
};
struct Proj2Order {
    StaticOrder s1, s2; int G, c;
    __device__ void init(int M, int G_, int c_) { s1.init(M, 1536, G_, c_); s2.init(M, 2048, G_, c_); G = G_; c = c_; }
    __device__ bool next(int i, Unit& u) const {
        if (s1.next(i, u)) return true;
        StaticOrder t = s2; const long L = (long)i * G + c - s1.nwg; if (L < 0 || L >= s2.nwg) return false;
        t.G = 1; t.c = (int)L; if (!t.next(0, u)) return false;
        u.pm += 72; u.pn += 8; return true;
    }
    __device__ __forceinline__ void a_ready(const Unit&) const {}
    __device__ __forceinline__ void done(const Unit&) const {}
};
struct EpiProj2 {
    static constexpr bool PERM = true, AFTER_DRAIN = false;
    bf16_t* QB; bf16_t* KV;
    __device__ __forceinline__ void operator()(const f32x4 (&acc)[2][2][4][2], const Unit& u, int wr, int wc, int fr, int fq) const {
        if (u.pm < 72) { const EpiStoreBf16 e{QB, 1536, 0x7fffffff}; e(acc, u, wr, wc, fr, fq); }
        else { Unit v = u; v.pm -= 72; v.pn -= 8; const EpiStoreBf16 e{KV, 2048, 0x7fffffff}; e(acc, v, wr, wc, fr, fq); }
    }
};
struct XOnlyOrder {
    StaticOrder so;
    __device__ void init(int N, int G_, int c_) { so.init(64 * BM, N, G_, c_); }
    __device__ bool next(int i, Unit& u) const { if (!so.next(i, u)) return false; u.pm = 9 * (u.pm >> 3) + 1 + (u.pm & 7); return true; }
    __device__ __forceinline__ void a_ready(const Unit&) const {}
    __device__ __forceinline__ void done(const Unit&) const {}
};
struct OddInOrder {
    StaticOrder so; int G, c;
    __device__ void init(int G_, int c_) { so.init(64 * BM, 18 * BM, G_, c_); G = G_; c = c_; }
    __device__ bool next(int i, Unit& u) const {
        if (so.next(i, u)) { u.pm = 9 * (u.pm >> 3) + 1 + (u.pm & 7); return true; }
        const long L = (long)i * G + c - 64 * 18; if (L >= 80) return false;
        const int b = (int)L / 10, j = (int)L - b * 10; u.pm = 9 * b; u.pn = j < 8 ? 4 + j : 8 + j; u.ko = 0; u.kt = 0; u.gb = 0; return true;
    }
    __device__ __forceinline__ void a_ready(const Unit&) const {}
    __device__ __forceinline__ void done(const Unit&) const {}
};
struct SplitKXOrder {
    int KS, kslice, G, c;
    __device__ void init(int KS_, int kslice_, int G_, int c_) { KS = KS_; kslice = kslice_; G = G_; c = c_; }
    __device__ bool next(int i, Unit& u) const { const long L = (long)i * G + c; if (L >= 64L * KS) return false; const int ks = (int)L / 64, x = (int)L - ks * 64; u.pm = 9 * (x >> 3) + 1 + (x & 7); u.pn = 0; u.ko = ks * kslice; u.kt = 0; u.gb = 0; return true; }
    __device__ __forceinline__ void a_ready(const Unit&) const {}
    __device__ __forceinline__ void done(const Unit&) const {}
};
struct MoeOrder {
    const PG8_LAS int* texp; const PG8_LAS int* frt; int nunits, G, c, cap;
    __device__ void init(const PG8_LAS int* texp_, const PG8_LAS int* frt_, int n_row_tiles, int cap_, int G_, int c_) { texp = texp_; frt = frt_; nunits = n_row_tiles * 8; cap = cap_; G = G_; c = c_; }
    __device__ bool next(int i, Unit& u) const {
        const long L = (long)i * G + c; if (L >= nunits) return false;
        int wgid = (int)L; { const int q = nunits / NXCD, r = nunits % NXCD, xcd = wgid % NXCD, off = wgid / NXCD; wgid = (xcd < r ? xcd * (q + 1) : r * (q + 1) + (xcd - r) * q) + off; }
        const int rt = wgid >> 3, pn = wgid & 7, e = __builtin_amdgcn_readfirstlane(texp[rt]);
        u.pm = rt; u.pn = e * 8 + pn; u.ko = 0; u.kt = 0; u.gb = e * cap + (rt - __builtin_amdgcn_readfirstlane(frt[e])) * BM; return true;
    }
    __device__ __forceinline__ void a_ready(const Unit&) const {}
    __device__ __forceinline__ void done(const Unit&) const {}
};
template <class Epi, class Sched, bool GATHER = false>
__device__ __forceinline__ void gemm_phase(PG8_LAS unsigned char* lds, const Gemm g, const Sched& S, const Epi& E, int wv) {
    int tid = wv * 64 + lane_id_(); asm volatile("" : "+v"(tid));
    const int wid = __builtin_amdgcn_readfirstlane(tid >> 6), lane = tid & 63, wr = wid >> 2, wc = wid & 3, fr = lane & 15, fq = lane >> 4;
    const int K = g.K, lda = g.lda, ldb = g.ldb;
    unsigned va[2][2], vn[2][2], voffB[2]; int sR[2], sC[2];
#pragma unroll
    for (int i = 0; i < 2; ++i) { int R, C; stage_rc(tid * 16 + i * 8192, R, C); const int Rb = Epi::PERM ? ((R & ~31) + perm32(R & 31)) : R; sR[i] = R; sC[i] = C;
        voffB[i] = (unsigned)(Rb * ldb + C) * 2u;
        va[0][i] = (unsigned)(R * lda + C) * 2u; va[1][i] = (unsigned)((R + HALF) * lda + C) * 2u; vn[0][i] = va[0][i]; vn[1][i] = va[1][i]; }
    const size_t kstep = (size_t)(BK * 2);
    const size_t hstepB = (size_t)HALF * ldb * 2;
    const size_t tstepA = (size_t)BM * lda * 2, tstepB = (size_t)BM * ldb * 2;
    const unsigned ldsw = (unsigned)wid * 1024u;
    const int aoff = lds_byte(wr * 64 + fr, fq * 8), boff = lds_byte(wc * 32 + fr, fq * 8);
#define PG8_SA(b, h) (((b) * 2 + (h)) * HTB)
#define PG8_SB(b, h) ((4 + (b) * 2 + (h)) * HTB)
#define PG8_STAGE(bufoff, gbase, voff) do { _Pragma("unroll") for (int _i = 0; _i < 2; ++_i) \
        __builtin_amdgcn_global_load_lds((const unsigned*)((const char*)(gbase) + (voff)[_i]), (PG8_LAS unsigned*)(lds + (bufoff) + ldsw + _i * 8192), 16, 0, 0); } while (0)
#define PG8_LDA(dst, b, h) do { _Pragma("unroll") for (int m = 0; m < 4; ++m) _Pragma("unroll") for (int k = 0; k < 2; ++k) dst[m][k] = *(const PG8_LAS bf16x8*)(lds + PG8_SA(b, h) + aoff + m * 2048 + k * 1024); } while (0)
#define PG8_LDB(dst, b, h) do { _Pragma("unroll") for (int n = 0; n < 2; ++n) _Pragma("unroll") for (int k = 0; k < 2; ++k) dst[n][k] = *(const PG8_LAS bf16x8*)(lds + PG8_SB(b, h) + boff + n * 2048 + k * 1024); } while (0)
#define PG8_MMA(ai, bj, At, Bt) do { __builtin_amdgcn_s_setprio(1); _Pragma("unroll") for (int m = 0; m < 4; ++m) _Pragma("unroll") for (int n = 0; n < 2; ++n) _Pragma("unroll") for (int k = 0; k < 2; ++k) \
        acc[ai][bj][m][n] = __builtin_amdgcn_mfma_f32_16x16x32_bf16(Bt[n][k], At[m][k], acc[ai][bj][m][n], 0, 0, 0); __builtin_amdgcn_s_setprio(0); } while (0)
#define PG8_WAIT_V(n) asm volatile("s_waitcnt vmcnt(" #n ")" ::: "memory")
#define PG8_WAIT_L(n) asm volatile("s_waitcnt lgkmcnt(" #n ")" ::: "memory")
#define PG8_BAR __builtin_amdgcn_s_barrier()
#define PG8_SCHED __builtin_amdgcn_sched_barrier(0)
#define PG8_GATHER_OFFS(dst, u) do { if constexpr (GATHER) { _Pragma("unroll") for (int _h = 0; _h < 2; ++_h) _Pragma("unroll") for (int _i = 0; _i < 2; ++_i) \
        dst[_h][_i] = (unsigned)(g.rowidx[(u).gb + _h * HALF + sR[_i]] * lda + sC[_i]) * 2u; } } while (0)
    Unit cur, nxt; int ui = 0;
    if (!S.next(0, cur)) return;
    f32x4 acc[2][2][4][2];
#pragma unroll
    for (int a = 0; a < 2; ++a)
#pragma unroll
        for (int b = 0; b < 2; ++b)
#pragma unroll
            for (int m = 0; m < 4; ++m)
#pragma unroll
                for (int n = 0; n < 2; ++n) acc[a][b][m][n] = (f32x4){0.f, 0.f, 0.f, 0.f};
    bf16x8 At[4][2], B0[2][2], B1[2][2];
    const char* cA = (const char*)g.A + (GATHER ? (size_t)0 : (size_t)cur.pm * tstepA) + (size_t)cur.ko * 2; const char* cB = (const char*)g.Bt + (size_t)cur.pn * tstepB + (size_t)cur.ko * 2;
    PG8_GATHER_OFFS(va, cur);
    S.a_ready(cur);
    PG8_STAGE(PG8_SB(0, 0), cB, voffB); PG8_STAGE(PG8_SB(0, 1), cB + hstepB, voffB); PG8_STAGE(PG8_SA(0, 0), cA, va[0]); PG8_STAGE(PG8_SA(0, 1), cA, va[1]);
    if (wr == 1) PG8_BAR;
    PG8_WAIT_V(2); PG8_BAR;
    PG8_STAGE(PG8_SB(1, 0), cB + kstep, voffB); PG8_STAGE(PG8_SA(1, 0), cA + kstep, va[0]); PG8_STAGE(PG8_SB(1, 1), cB + hstepB + kstep, voffB);
    PG8_WAIT_V(6); PG8_BAR;
    for (;;) {
        const bool has_next = S.next(ui + 1, nxt);
        const char* nA = has_next ? (const char*)g.A + (GATHER ? (size_t)0 : (size_t)nxt.pm * tstepA) + (size_t)nxt.ko * 2 : cA; const char* nB = has_next ? (const char*)g.Bt + (size_t)nxt.pn * tstepB + (size_t)nxt.ko * 2 : cB;
        if constexpr (GATHER) { if (has_next) PG8_GATHER_OFFS(vn, nxt); else { _Pragma("unroll") for (int _h = 0; _h < 2; ++_h) _Pragma("unroll") for (int _i = 0; _i < 2; ++_i) vn[_h][_i] = va[_h][_i]; } }
        const int nt = K / BK;
        for (int t = 0; t < nt; t += 2) {
            const bool last = (t == nt - 2);
            const char* a1 = cA + (size_t)(t + 1) * kstep;
            const char* a2 = last ? nA : cA + (size_t)(t + 2) * kstep; const char* b2 = last ? nB : cB + (size_t)(t + 2) * kstep;
            const char* a3 = a2 + kstep; const char* b3 = b2 + kstep;
            unsigned v2[2][2];
#pragma unroll
            for (int _h = 0; _h < 2; ++_h)
#pragma unroll
                for (int _i = 0; _i < 2; ++_i) v2[_h][_i] = (GATHER && last) ? vn[_h][_i] : va[_h][_i];
            if (last && has_next) S.a_ready(nxt);
            PG8_LDB(B0, 0, 0); PG8_LDB(B1, 0, 1); PG8_SCHED; PG8_LDA(At, 0, 0); PG8_STAGE(PG8_SA(1, 1), a1, va[1]);
            PG8_WAIT_V(8); PG8_WAIT_L(0); PG8_BAR; PG8_MMA(0, 0, At, B0); PG8_MMA(0, 1, At, B1); PG8_BAR; PG8_SCHED;
            PG8_LDA(At, 0, 1); PG8_STAGE(PG8_SB(0, 0), b2, voffB); PG8_STAGE(PG8_SB(0, 1), b2 + hstepB, voffB); PG8_STAGE(PG8_SA(0, 0), a2, v2[0]);
            PG8_WAIT_V(8); PG8_WAIT_L(0); PG8_BAR; PG8_MMA(1, 0, At, B0); PG8_MMA(1, 1, At, B1); PG8_BAR; PG8_SCHED;
            PG8_LDB(B0, 1, 0); PG8_LDB(B1, 1, 1); PG8_SCHED; PG8_LDA(At, 1, 0); PG8_STAGE(PG8_SA(0, 1), a2, v2[1]);
            PG8_WAIT_V(8); PG8_WAIT_L(0); PG8_BAR; PG8_MMA(0, 0, At, B0); PG8_MMA(0, 1, At, B1); PG8_BAR; PG8_SCHED;
            PG8_LDA(At, 1, 1); PG8_STAGE(PG8_SB(1, 0), b3, voffB); PG8_STAGE(PG8_SB(1, 1), b3 + hstepB, voffB); PG8_STAGE(PG8_SA(1, 0), a3, v2[0]);
            PG8_WAIT_V(8); PG8_WAIT_L(0); PG8_BAR; PG8_MMA(1, 0, At, B0); PG8_MMA(1, 1, At, B1); PG8_BAR; PG8_SCHED;
        }
        if (wr == 0) PG8_BAR;
        E(acc, cur, wr, wc, fr, fq); S.done(cur);
        if (!has_next) break;
#pragma unroll
        for (int a = 0; a < 2; ++a)
#pragma unroll
            for (int b = 0; b < 2; ++b)
#pragma unroll
                for (int m = 0; m < 4; ++m)
#pragma unroll
                    for (int n = 0; n < 2; ++n) acc[a][b][m][n] = (f32x4){0.f, 0.f, 0.f, 0.f};
        cur = nxt; cA = nA; cB = nB; ++ui;
        if constexpr (GATHER) { _Pragma("unroll") for (int _h = 0; _h < 2; ++_h) _Pragma("unroll") for (int _i = 0; _i < 2; ++_i) va[_h][_i] = vn[_h][_i]; }
        if (wr == 1) PG8_BAR;
    }
    PG8_WAIT_V(0);
    PG8_BAR;
#undef PG8_SA
#undef PG8_SB
#undef PG8_STAGE
#undef PG8_LDA
#undef PG8_LDB
#undef PG8_MMA
#undef PG8_WAIT_V
#undef PG8_WAIT_L
#undef PG8_BAR
#undef PG8_SCHED
#undef PG8_GATHER_OFFS
}
typedef unsigned u32x2 __attribute__((ext_vector_type(2)));
struct BSrc { const float* m0; const float* m1; size_t estride; int ldn, colmul, hoff; };
template <class Epi, class Sched, bool GATHER = false>
__device__ __forceinline__ void gemm_phase_f32b(PG8_LAS unsigned char* lds, const Gemm g, const BSrc bs, const Sched& S, const Epi& E, int wv) {
    int tid = wv * 64 + lane_id_(); asm volatile("" : "+v"(tid));
    const int wid = __builtin_amdgcn_readfirstlane(tid >> 6), lane = tid & 63, wr = wid >> 2, wc = wid & 3, fr = lane & 15, fq = lane >> 4;
    const int K = g.K, lda = g.lda;
    unsigned va00, va01, va10, va11, vn00, vn01, vn10, vn11;
#pragma unroll
    for (int i = 0; i < 2; ++i) { int R, C; stage_rc(tid * 16 + i * 8192, R, C);
        const unsigned o0_ = (unsigned)(R * lda + C) * 2u, o1_ = (unsigned)((R + HALF) * lda + C) * 2u; if (i == 0) { va00 = o0_; va10 = o1_; } else { va01 = o0_; va11 = o1_; } }
    vn00 = va00; vn01 = va01; vn10 = va10; vn11 = va11;
    const size_t kstep = (size_t)(BK * 2);
    const size_t tstepA = (size_t)BM * lda * 2;
    const int kq = lane & 15, nq = (lane >> 4) + 4 * wid;
    const int brow = (nq >> 3) * 32 + (Epi::PERM ? (16 * (nq & 1) + 4 * ((nq & 7) >> 1)) : (4 * (nq & 7)));
    const int bwr = lds_byte(brow, 4 * kq);
    const unsigned bvo = (unsigned)((4 * kq) * bs.ldn + 4 * nq) * 4u;
    const size_t bkstep = (size_t)BK * bs.ldn * 4, brstep = (size_t)bs.ldn * 4;
    f32x4 w0, w1, w2, w3;
    const unsigned ldsw = (unsigned)wid * 1024u;
    const int aoff = lds_byte(wr * 64 + fr, fq * 8), boff = lds_byte(wc * 32 + fr, fq * 8);
#define PG8_SA(b, h) (((b) * 2 + (h)) * HTB)
#define PG8_SB(b, h) ((4 + (b) * 2 + (h)) * HTB)
#define PG8_BLOAD(src) do { const char* p0_ = (const char*)(src); const char* p1_ = p0_ + brstep; const char* p2_ = p1_ + brstep; const char* p3_ = p2_ + brstep; \
        asm volatile("s_nop 4\n\tglobal_load_dwordx4 %0, %4, %5\n\tglobal_load_dwordx4 %1, %4, %6\n\tglobal_load_dwordx4 %2, %4, %7\n\tglobal_load_dwordx4 %3, %4, %8" \
                     : "=&v"(w0), "=&v"(w1), "=&v"(w2), "=&v"(w3) : "v"(bvo), "s"(p0_), "s"(p1_), "s"(p2_), "s"(p3_)); } while (0)
#define PG8_BWAIT(n) asm volatile("s_waitcnt vmcnt(" #n ")" : "+v"(w0), "+v"(w1), "+v"(w2), "+v"(w3))
#define PG8_BWRITE(bufoff) do { PG8_LAS unsigned char* d_ = lds + (bufoff) + bwr; \
        { u32x2 c_; c_.x = cvt_pk_bf16(w0[0], w1[0]); c_.y = cvt_pk_bf16(w2[0], w3[0]); *(PG8_LAS u32x2*)(d_) = c_; } \
        { u32x2 c_; c_.x = cvt_pk_bf16(w0[1], w1[1]); c_.y = cvt_pk_bf16(w2[1], w3[1]); *(PG8_LAS u32x2*)(d_ + 64) = c_; } \
        { u32x2 c_; c_.x = cvt_pk_bf16(w0[2], w1[2]); c_.y = cvt_pk_bf16(w2[2], w3[2]); *(PG8_LAS u32x2*)(d_ + 128) = c_; } \
        { u32x2 c_; c_.x = cvt_pk_bf16(w0[3], w1[3]); c_.y = cvt_pk_bf16(w2[3], w3[3]); *(PG8_LAS u32x2*)(d_ + 192) = c_; } } while (0)
#define PG8_BSRC(u, h) ((const char*)(((h) ? bs.m1 : bs.m0) + (size_t)((u).pn >> 3) * bs.estride + (size_t)((u).pn & 7) * bs.colmul + (h) * bs.hoff) + (size_t)(u).ko * brstep)
#define PG8_STAGE(bufoff, gbase, o0, o1) do { \
        __builtin_amdgcn_global_load_lds((const unsigned*)((const char*)(gbase) + (o0)), (PG8_LAS unsigned*)(lds + (bufoff) + ldsw), 16, 0, 0); \
        __builtin_amdgcn_global_load_lds((const unsigned*)((const char*)(gbase) + (o1)), (PG8_LAS unsigned*)(lds + (bufoff) + ldsw + 8192), 16, 0, 0); } while (0)
#define PG8_LDA(dst, b, h) do { _Pragma("unroll") for (int m = 0; m < 4; ++m) _Pragma("unroll") for (int k = 0; k < 2; ++k) dst[m][k] = *(const PG8_LAS bf16x8*)(lds + PG8_SA(b, h) + aoff + m * 2048 + k * 1024); } while (0)
#define PG8_LDB(dst, b, h) do { _Pragma("unroll") for (int n = 0; n < 2; ++n) _Pragma("unroll") for (int k = 0; k < 2; ++k) dst[n][k] = *(const PG8_LAS bf16x8*)(lds + PG8_SB(b, h) + boff + n * 2048 + k * 1024); } while (0)
#define PG8_MMA(ai, bj, At, Bt) do { __builtin_amdgcn_s_setprio(1); _Pragma("unroll") for (int m = 0; m < 4; ++m) _Pragma("unroll") for (int n = 0; n < 2; ++n) _Pragma("unroll") for (int k = 0; k < 2; ++k) \
        acc[ai][bj][m][n] = __builtin_amdgcn_mfma_f32_16x16x32_bf16(Bt[n][k], At[m][k], acc[ai][bj][m][n], 0, 0, 0); __builtin_amdgcn_s_setprio(0); } while (0)
#define PG8_WAIT_V(n) asm volatile("s_waitcnt vmcnt(" #n ")" ::: "memory")
#define PG8_WAIT_L(n) asm volatile("s_waitcnt lgkmcnt(" #n ")" ::: "memory")
#define PG8_BAR __builtin_amdgcn_s_barrier()
#define PG8_SCHED __builtin_amdgcn_sched_barrier(0)
#define PG8_GATHER_OFFS(d00, d01, d10, d11, u) do { if constexpr (GATHER) { const int* ri_ = g.rowidx + (u).gb; int t_ = wv * 64 + lane_id_(); asm volatile("" : "+v"(t_)); \
        int R0_, C0_, R1_, C1_; stage_rc(t_ * 16, R0_, C0_); stage_rc(t_ * 16 + 8192, R1_, C1_);     \
        d00 = (unsigned)(ri_[R0_] * lda + C0_) * 2u; d01 = (unsigned)(ri_[R1_] * lda + C1_) * 2u; \
        d10 = (unsigned)(ri_[HALF + R0_] * lda + C0_) * 2u; d11 = (unsigned)(ri_[HALF + R1_] * lda + C1_) * 2u; } } while (0)
    Unit cur, nxt; int ui = 0;
    if (!S.next(0, cur)) return;
    f32x4 acc[2][2][4][2];
#pragma unroll
    for (int a = 0; a < 2; ++a)
#pragma unroll
        for (int b = 0; b < 2; ++b)
#pragma unroll
            for (int m = 0; m < 4; ++m)
#pragma unroll
                for (int n = 0; n < 2; ++n) acc[a][b][m][n] = (f32x4){0.f, 0.f, 0.f, 0.f};
    bf16x8 At[4][2], B0[2][2], B1[2][2];
    const char* cA = (const char*)g.A + (GATHER ? (size_t)0 : (size_t)cur.pm * tstepA) + (size_t)cur.ko * 2; const char* cB0 = PG8_BSRC(cur, 0); const char* cB1 = PG8_BSRC(cur, 1);
    PG8_GATHER_OFFS(va00, va01, va10, va11, cur);
    S.a_ready(cur);
    PG8_STAGE(PG8_SA(0, 0), cA, va00, va01); PG8_STAGE(PG8_SA(0, 1), cA, va10, va11);
    PG8_BLOAD(cB0); PG8_BWAIT(0); PG8_BWRITE(PG8_SB(0, 0));
    PG8_BLOAD(cB1); PG8_BWAIT(0); PG8_BWRITE(PG8_SB(0, 1));
    PG8_BLOAD(cB0 + bkstep); PG8_BWAIT(0); PG8_BWRITE(PG8_SB(1, 0));
    PG8_BLOAD(cB1 + bkstep); PG8_STAGE(PG8_SA(1, 0), cA + kstep, va00, va01);
    PG8_WAIT_L(0);
    if (wr == 1) PG8_BAR;
    PG8_BAR;
    PG8_BAR;
    for (;;) {
        const bool has_next = S.next(ui + 1, nxt);
        const char* nA = has_next ? (const char*)g.A + (GATHER ? (size_t)0 : (size_t)nxt.pm * tstepA) + (size_t)nxt.ko * 2 : cA; const char* nB0 = has_next ? PG8_BSRC(nxt, 0) : cB0; const char* nB1 = has_next ? PG8_BSRC(nxt, 1) : cB1;
        const int nt = K / BK;
        for (int t = 0; t < nt; t += 2) {
            const bool last = (t == nt - 2);
            const char* a1 = cA + (size_t)(t + 1) * kstep;
            const char* a2 = last ? nA : cA + (size_t)(t + 2) * kstep;
            const char* b20 = last ? nB0 : cB0 + (size_t)(t + 2) * bkstep; const char* b21 = last ? nB1 : cB1 + (size_t)(t + 2) * bkstep;
            const char* a3 = a2 + kstep; const char* b30 = b20 + bkstep; const char* b31 = b21 + bkstep;
            if constexpr (GATHER) { if (last) { if (has_next) PG8_GATHER_OFFS(vn00, vn01, vn10, vn11, nxt); else { vn00 = va00; vn01 = va01; vn10 = va10; vn11 = va11; } } }
            const bool usen_ = GATHER && last;
            const unsigned v200 = usen_ ? vn00 : va00, v201 = usen_ ? vn01 : va01, v210 = usen_ ? vn10 : va10, v211 = usen_ ? vn11 : va11;
            if (last && has_next) S.a_ready(nxt);
            PG8_LDB(B0, 0, 0); PG8_LDB(B1, 0, 1); PG8_SCHED; PG8_LDA(At, 0, 0);
            PG8_BWAIT(2); PG8_BWRITE(PG8_SB(1, 1)); PG8_BLOAD(b20); PG8_STAGE(PG8_SA(1, 1), a1, va10, va11);
            PG8_WAIT_L(0); PG8_BAR; PG8_MMA(0, 0, At, B0); PG8_MMA(0, 1, At, B1); PG8_BAR; PG8_SCHED;
            PG8_LDA(At, 0, 1);
            PG8_BWAIT(2); PG8_BWRITE(PG8_SB(0, 0)); PG8_BLOAD(b21); PG8_STAGE(PG8_SA(0, 0), a2, v200, v201);
            PG8_WAIT_L(0); PG8_BAR; PG8_MMA(1, 0, At, B0); PG8_MMA(1, 1, At, B1); PG8_BAR; PG8_SCHED;
            PG8_LDB(B0, 1, 0); PG8_LDB(B1, 1, 1); PG8_SCHED; PG8_LDA(At, 1, 0);
            PG8_BWAIT(2); PG8_BWRITE(PG8_SB(0, 1)); PG8_BLOAD(b30); PG8_STAGE(PG8_SA(0, 1), a2, v210, v211);
            PG8_WAIT_L(0); PG8_BAR; PG8_MMA(0, 0, At, B0); PG8_MMA(0, 1, At, B1); PG8_BAR; PG8_SCHED;
            PG8_LDA(At, 1, 1);
            PG8_BWAIT(2); PG8_BWRITE(PG8_SB(1, 0)); PG8_BLOAD(b31); PG8_STAGE(PG8_SA(1, 0), a3, v200, v201);
            PG8_WAIT_L(0); PG8_BAR; PG8_MMA(1, 0, At, B0); PG8_MMA(1, 1, At, B1); PG8_BAR; PG8_SCHED;
        }
        if (wr == 0) PG8_BAR;
        E(acc, cur, wr, wc, fr, fq); S.done(cur);
        if (!has_next) break;
#pragma unroll
        for (int a = 0; a < 2; ++a)
#pragma unroll
            for (int b = 0; b < 2; ++b)
#pragma unroll
                for (int m = 0; m < 4; ++m)
#pragma unroll
                    for (int n = 0; n < 2; ++n) acc[a][b][m][n] = (f32x4){0.f, 0.f, 0.f, 0.f};
        cur = nxt; cA = nA; cB0 = nB0; cB1 = nB1; ++ui;
        if constexpr (GATHER) { va00 = vn00; va01 = vn01; va10 = vn10; va11 = vn11; }
        if (wr == 1) PG8_BAR;
    }
    PG8_WAIT_V(0);
    PG8_BAR;
#undef PG8_SA
#undef PG8_SB
#undef PG8_STAGE
#undef PG8_BLOAD
#undef PG8_BWAIT
#undef PG8_BWRITE
#undef PG8_BSRC
#undef PG8_LDA
#undef PG8_LDB
#undef PG8_MMA
#undef PG8_WAIT_V
#undef PG8_WAIT_L
#undef PG8_BAR
#undef PG8_SCHED
#undef PG8_GATHER_OFFS
}
}

#ifndef PG8_SP2
#define PG8_SP2 true
#endif
#ifndef PG8_ALIGN
#define PG8_ALIGN true
#endif
#ifndef MK_PER_PHASE
#define MK_PER_PHASE 0
#endif

constexpr int NWAVES = 8;
constexpr int DM = 2048, NB = 8, SEQ = 2048, CTX = 256, TPB = CTX + SEQ, T = NB * TPB;
constexpr int EVEN_IN_P = 2816, ODD_IN = 4608;
constexpr int NE = 32, DE = 1024, MAXSLOT = 45056;
constexpr float NORM_EPS = 1e-6f;
constexpr float LAMBDA_INIT = 0.35550906759f;
constexpr int NPHASE = 27;
#ifndef MOE_F32B
#define MOE_F32B 0
#endif
#ifndef FUSED_ROUTE
#define FUSED_ROUTE 1
#endif
#ifndef ATT_DIFF_FUSED
#define ATT_DIFF_FUSED 1
#endif
#ifndef USE_NAIVE_ATTN
#define USE_NAIVE_ATTN 0
#endif

constexpr size_t MiB = 1u << 20;
constexpr size_t WS_CTL = 0, CTL_ZERO_BYTES = 1 * MiB;
constexpr size_t WS_MOD = 1 * MiB;
constexpr size_t WS_ROPE = 2 * MiB;
constexpr size_t WS_ROUTE = 3 * MiB;
constexpr size_t WS_WE_IN = 4 * MiB;
constexpr size_t WS_WE_UQ = 15 * MiB;
constexpr size_t WS_WE_UKV = 17 * MiB;
constexpr size_t WS_WE_OUT = 19 * MiB;
constexpr size_t WS_WO_IN = 27 * MiB;
constexpr size_t WS_WO_OUT = 45 * MiB;
constexpr size_t WS_WR = 53 * MiB;
constexpr size_t WS_WGU = 60 * MiB;
constexpr size_t WS_WDN = 572 * MiB;
constexpr size_t WS_H = 828 * MiB;
constexpr size_t WS_A1 = 972 * MiB;
constexpr size_t WS_MIX = 1044 * MiB;
constexpr size_t WS_R = 1116 * MiB;
constexpr size_t WS_Y1 = WS_R;
constexpr size_t WS_CQN = WS_R + 162 * MiB;
constexpr size_t WS_CKVN = WS_R + 180 * MiB;
constexpr size_t WS_QB = WS_R + 198 * MiB;
constexpr size_t WS_KV = WS_R + 252 * MiB;
constexpr size_t WS_KB = WS_R + 324 * MiB;
constexpr size_t WS_XS = WS_R;
constexpr size_t WS_U = WS_R + 176 * MiB;
constexpr size_t WS_YS = WS_R + 264 * MiB;
constexpr size_t WS_LG = WS_R + 440 * MiB;
constexpr size_t WS_POS = WS_R + 460 * MiB;
constexpr int POSCAP = 18432;
constexpr size_t WS_END = WS_R + 466 * MiB;
constexpr int RKS = 4;
constexpr int CW_CNT = 64;
constexpr int CW_NRT = 256;
constexpr int CW_TEXP = 512;
constexpr int CW_BAR = 4096;
constexpr int CW_SLOT = 16384;

constexpr int RING_OFF = 0, RING_BYTES = 131072;
constexpr int LDSCTL_OFF = RING_BYTES, MISC_OFF = LDSCTL_OFF + 320;
constexpr int LDS_BYTES = 147456;
constexpr int LDS_TAB = 135168;

#define GAS __attribute__((address_space(1)))
#define LAS __attribute__((address_space(3)))
typedef unsigned short bf16;
typedef unsigned v4u __attribute__((ext_vector_type(4)));
typedef unsigned v2u __attribute__((ext_vector_type(2)));
typedef float f32x4 __attribute__((ext_vector_type(4)));
typedef GAS unsigned gu32;
#define RLX_AGENT __ATOMIC_RELAXED, __HIP_MEMORY_SCOPE_AGENT
#define LDS_WAIT() asm volatile("s_waitcnt lgkmcnt(0)" ::: "memory")
#define VM_WAIT() asm volatile("s_waitcnt vmcnt(0)" ::: "memory")
__device__ __forceinline__ unsigned f2bf(float f) { unsigned u = __builtin_bit_cast(unsigned, f); return (u + 0x7fffu + ((u >> 16) & 1u)) >> 16; }
__device__ __forceinline__ unsigned pk2(float lo, float hi) { return f2bf(lo) | (f2bf(hi) << 16); }
__device__ __forceinline__ float bf2f(unsigned short h) { return __builtin_bit_cast(float, (unsigned)h << 16); }
__device__ __forceinline__ float bflo(unsigned w) { return __builtin_bit_cast(float, w << 16); }
__device__ __forceinline__ float bfhi(unsigned w) { return __builtin_bit_cast(float, w & 0xffff0000u); }
__device__ __forceinline__ float wave_sum(float v) {
#pragma unroll
    for (int o = 1; o < 64; o <<= 1) v += __shfl_xor(v, o);
    return v;
}
__device__ __forceinline__ float wave_max(float v) {
#pragma unroll
    for (int o = 1; o < 64; o <<= 1) v = fmaxf(v, __shfl_xor(v, o));
    return v;
}
#define XB_TMO      128
#define XB_XCNT(j)  (256  + 64 * (j))
#define XB_XSUB(j)  (1280 + 64 * (j))
#define XB_XGEN(j)  (2304 + 64 * (j))
#define XB_TOP      3328
#define XB_TOPGEN   3392
#define XCD_BAR_WORDS 3456
#define XB_SPIN_CAP (1u << 18)

__device__ __forceinline__ unsigned xb_ld(unsigned* p)              { return __hip_atomic_load(p, __ATOMIC_RELAXED, __HIP_MEMORY_SCOPE_AGENT); }
__device__ __forceinline__ unsigned xb_add(unsigned* p, unsigned v) { return __hip_atomic_fetch_add(p, v, __ATOMIC_RELAXED, __HIP_MEMORY_SCOPE_AGENT); }
__device__ __forceinline__ unsigned xb_xcc_id() { return (unsigned)__builtin_amdgcn_s_getreg((3 << 11) | 20) & 0xFu; }
#define XB_SPIN(cond, bar) do { unsigned _sp = 0; while (cond) { __builtin_amdgcn_s_sleep(1); \
    if ((++_sp & 255u) == 0u) { if (xb_ld(&(bar)[XB_TMO])) break; if (_sp > XB_SPIN_CAP) { atomicAdd(&(bar)[XB_TMO], 1u); break; } } } } while (0)

struct XcdBarrier {
    unsigned* bar; unsigned x;
    volatile LAS unsigned* st;
};

__device__ __forceinline__ XcdBarrier xcd_barrier_post(unsigned* bar, volatile LAS unsigned* st) {
    XcdBarrier b; b.bar = bar; b.x = xb_xcc_id(); b.st = st;
    if (threadIdx.x == 0) (void)xb_add(&bar[XB_XCNT(b.x)], 1u);
    return b;
}
__device__ __forceinline__ void xcd_barrier_complete(unsigned* bar, unsigned x, unsigned& nloc, unsigned& nx) {
    const unsigned G = gridDim.x * gridDim.y * gridDim.z;
    unsigned sum, cnt, mine, sp = 0u;
    for (;;) {
        sum = 0u; cnt = 0u; mine = 0u;
#pragma unroll
        for (unsigned j = 0; j < 16; ++j) { const unsigned c = xb_ld(&bar[XB_XCNT(j)]); sum += c; cnt += (c > 0u) ? 1u : 0u; mine = (j == x) ? c : mine; }
        if (sum == G) break;
        __builtin_amdgcn_s_sleep(1);
        if ((++sp & 255u) == 0u) { if (xb_ld(&bar[XB_TMO])) break; if (sp > XB_SPIN_CAP) { atomicAdd(&bar[XB_TMO], 1u); break; } }
    }
    nloc = mine > 0u ? mine : 1u; nx = cnt > 0u ? cnt : 1u;
}

__device__ __forceinline__ void xcd_barrier(const XcdBarrier& b) {
    asm volatile("s_waitcnt vmcnt(0)" ::: "memory");
    __syncthreads();
    if (threadIdx.x == 0) {
        unsigned* bar = b.bar;
        __builtin_amdgcn_s_waitcnt(0);
        unsigned nloc = b.st[0], nx = b.st[1];
        if (nloc == 0u) { xcd_barrier_complete(bar, b.x, nloc, nx); b.st[0] = nloc; b.st[1] = nx; }
        const unsigned old = xb_add(&bar[XB_XSUB(b.x)], 1u);
        const unsigned gen = old / nloc;
        if (old + 1u == (gen + 1u) * nloc) {
            __builtin_amdgcn_fence(__ATOMIC_RELEASE, "agent");
            asm volatile("s_waitcnt vmcnt(0)" ::: "memory");
            const unsigned og = xb_add(&bar[XB_TOP], 1u);
            const unsigned tg = og / nx;
            if (og + 1u == (tg + 1u) * nx) xb_add(&bar[XB_TOPGEN], 1u);
            else XB_SPIN(xb_ld(&bar[XB_TOPGEN]) == tg, bar);
            __builtin_amdgcn_fence(__ATOMIC_ACQUIRE, "agent");
            xb_add(&bar[XB_XGEN(b.x)], 1u);
            asm volatile("s_waitcnt vmcnt(0)" ::: "memory");
        } else {
            XB_SPIN(xb_ld(&bar[XB_XGEN(b.x)]) == gen, bar);
            __builtin_amdgcn_fence(__ATOMIC_ACQUIRE, "agent");
            asm volatile("s_waitcnt vmcnt(0)" ::: "memory");
        }
    }
    __syncthreads();
}

struct Frame {
    LAS unsigned char* lds;
    volatile LAS unsigned* MISC;
    gu32* ctl;
    unsigned char* ws;
    int tid, lane, wave, vcu, G;
};
struct LocalId { int tid, lane, wave; };
__device__ __forceinline__ LocalId local_id_w(int wave) { int t = wave * 64 + lane_id_(); asm volatile("" : "+v"(t)); LocalId l; l.tid = t; l.lane = t & 63; l.wave = wave; return l; }
#define local_id() local_id_w(F.wave)
struct Args { const float* in[35]; float* out; unsigned char* ws; int ph_lo, ph_hi; };
enum { I_X = 0, I_C, I_CTX, I_CCTX, I_MODW, I_MODB, I_EWIN, I_EWOUT, I_AQN, I_AKN, I_BCQN, I_BWUQ, I_BCKVN, I_BWUKV, I_BQN, I_BKN, I_OWIN, I_OWOUT,
       I_CQN, I_CKN, I_LQ1, I_LK1, I_LQ2, I_LK2, I_SUBLN, I_DQN, I_DKN, I_SINK, I_WRG, I_BRG, I_WRE, I_BRE, I_WG, I_WU, I_WD };

__device__ __forceinline__ int mod_index(int row) { const int b = row / TPB; return (row - b * TPB) < CTX ? 8 : b; }

__device__ __forceinline__ void transpose_item(const float* W, int N, int k0, int n0, bf16* dst, int Kd, LAS float* scr, int lane) {
    f32x4 v[8];
    const int kr = lane >> 3, cq = lane & 7;
#pragma unroll
    for (int i = 0; i < 8; ++i) v[i] = *(const f32x4*)(W + (size_t)(k0 + kr + 8 * i) * N + n0 + 4 * cq);
#pragma unroll
    for (int i = 0; i < 8; ++i) { LAS float* d = scr + (kr + 8 * i) * 33 + 4 * cq; d[0] = v[i].x; d[1] = v[i].y; d[2] = v[i].z; d[3] = v[i].w; }
    LDS_WAIT(); asm volatile("" ::: "memory");
    const int c = lane & 7;
#pragma unroll
    for (int j = 0; j < 4; ++j) { const int n = (lane >> 3) + 8 * j; const LAS float* s = scr + (8 * c) * 33 + n;
        v4u o; o.x = pk2(s[0 * 33], s[1 * 33]); o.y = pk2(s[2 * 33], s[3 * 33]); o.z = pk2(s[4 * 33], s[5 * 33]); o.w = pk2(s[6 * 33], s[7 * 33]);
        *(GAS v4u*)(dst + (size_t)n * Kd + k0 + 8 * c) = o; }
    LDS_WAIT(); asm volatile("" ::: "memory");
}
__device__ __forceinline__ void small_transpose(const float* W, int K, int N, bf16* WT, int item, LAS float* scr, int lane) {
    const int nblk = N / 32, kb = item / nblk, nb = item - kb * nblk;
    transpose_item(W, N, kb * 64, nb * 32, WT + (size_t)(nb * 32) * K, K, scr, lane);
}
__device__ __forceinline__ void p0_prologue(const Frame& F, const Args& a) {
    const LocalId L_ = local_id(); (void)L_;
    const int gt = F.vcu * 512 + L_.tid, NT = F.G * 512;
    {
        float2* t128 = (float2*)(F.ws + WS_ROPE); float2* t64 = (float2*)(F.ws + WS_ROPE + 16384);
        for (int i = gt; i < 3072; i += NT) {
            if (i < 2048) { const int pos = i >> 5, f = i & 31; const float inv = 1.0f / powf(10000.0f, (float)f / 32.0f); const float ang = (float)pos * inv; t128[i] = make_float2(cosf(ang), sinf(ang)); }
            else { const int k = i - 2048, pos = k >> 4, f = k & 15; const float inv = 1.0f / powf(10000.0f, (float)f / 16.0f); const float ang = (float)pos * inv; t64[k] = make_float2(cosf(ang), sinf(ang)); }
        }
    }
    { float* gsub = (float*)(F.ws + WS_ROPE + 32768); for (int i = gt; i < 128; i += NT) gsub[i] = a.in[I_SUBLN][i] * (1.0f - LAMBDA_INIT); }
    {
        bf16* WR = (bf16*)(F.ws + WS_WR);
        for (int i = gt; i < 2 * 256 * 2048; i += NT) { const int l = i >> 19, r = (i >> 11) & 255, k = i & 2047;
            float v = 0.f; if (r < 4) v = a.in[I_WRG][((size_t)l * 2048 + k) * 4 + r]; else if (r < 36) v = a.in[I_WRE][((size_t)l * 2048 + k) * 32 + (r - 4)];
            WR[i] = (bf16)f2bf(v); }
        v4u* z = (v4u*)((bf16*)(F.ws + WS_WE_IN) + (size_t)2624 * 2048);
        for (int i = gt; i < 192 * 2048 / 8; i += NT) z[i] = (v4u){0u, 0u, 0u, 0u};
    }
    {
        LAS float* sl = (LAS float*)(F.lds + RING_OFF);
        LAS float* red = (LAS float*)(F.lds + RING_OFF + 73728);
        for (int i = L_.tid; i < 9 * 2048; i += 512) { const int j = i >> 11, k = i & 2047; const float v = j < 8 ? a.in[I_C][j * 2048 + k] : a.in[I_CCTX][k]; sl[i] = v / (1.0f + expf(-v)); }
        __syncthreads();
        float* MOD = (float*)(F.ws + WS_MOD);
        const int cg = L_.lane & 7, ks = L_.lane >> 3;
        for (int item = blockIdx.x; item < 768; item += F.G) {
            const int layer = item / 384, chunk = item - layer * 384, col0 = chunk * 32;
            const float* W = a.in[I_MODW] + (size_t)layer * 2048 * 12288 + col0 + cg * 4;
            f32x4 acc[9];
#pragma unroll
            for (int j = 0; j < 9; ++j) acc[j] = (f32x4){0.f, 0.f, 0.f, 0.f};
#pragma unroll 8
            for (int it = 0; it < 32; ++it) { const int k = L_.wave * 256 + it * 8 + ks; const f32x4 w = *(const f32x4*)(W + (size_t)k * 12288);
#pragma unroll
                for (int j = 0; j < 9; ++j) { const float s = sl[j * 2048 + k]; acc[j] = acc[j] + w * s; } }
#pragma unroll
            for (int j = 0; j < 9; ++j)
#pragma unroll
                for (int e = 0; e < 4; ++e) { float v = acc[j][e]; v += __shfl_xor(v, 8); v += __shfl_xor(v, 16); v += __shfl_xor(v, 32); acc[j][e] = v; }
            if (L_.lane < 8) {
#pragma unroll
                for (int j = 0; j < 9; ++j)
#pragma unroll
                    for (int e = 0; e < 4; ++e) red[(L_.wave * 9 + j) * 32 + cg * 4 + e] = acc[j][e]; }
            __syncthreads();
            if (L_.tid < 288) { const int j = L_.tid >> 5, cc = L_.tid & 31; float s = a.in[I_MODB][layer * 12288 + col0 + cc];
#pragma unroll
                for (int w = 0; w < 8; ++w) s += red[(w * 9 + j) * 32 + cc];
                MOD[((size_t)layer * 9 + j) * 12288 + col0 + cc] = s; }
            __syncthreads();
        }
    }
    {
        LAS float* scr = (LAS float*)(F.lds + RING_OFF + L_.wave * 16384);
        const int gw = F.vcu * NWAVES + L_.wave, NGW = F.G * NWAVES;
        constexpr int I0 = 32 * 82, I1 = 8 * 48, I2 = 8 * 64, I3 = 32 * 64, I4 = 32 * 144, I5 = 32 * 64, NSMALL = I0 + I1 + I2 + I3 + I4 + I5;
#if MOE_F32B
        constexpr int NMOE = 0;
#else
        constexpr int NMOE = 64 * 3072;
#endif
        for (int it = gw; it < NSMALL + NMOE; it += NGW) {
            int r = it;
            if (r < NSMALL) {
                if (r < I0) { small_transpose(a.in[I_EWIN], 2048, 2624, (bf16*)(F.ws + WS_WE_IN), r, scr, L_.lane); continue; } r -= I0;
                if (r < I1) { small_transpose(a.in[I_BWUQ], 512, 1536, (bf16*)(F.ws + WS_WE_UQ), r, scr, L_.lane); continue; } r -= I1;
                if (r < I2) { small_transpose(a.in[I_BWUKV], 512, 2048, (bf16*)(F.ws + WS_WE_UKV), r, scr, L_.lane); continue; } r -= I2;
                if (r < I3) { small_transpose(a.in[I_EWOUT], 2048, 2048, (bf16*)(F.ws + WS_WE_OUT), r, scr, L_.lane); continue; } r -= I3;
                if (r < I4) { small_transpose(a.in[I_OWIN], 2048, 4608, (bf16*)(F.ws + WS_WO_IN), r, scr, L_.lane); continue; } r -= I4;
                small_transpose(a.in[I_OWOUT], 2048, 2048, (bf16*)(F.ws + WS_WO_OUT), r, scr, L_.lane); continue;
            }
            r -= NSMALL;
            const int le = r / 3072, q = r - le * 3072, which = q >> 10, ri = q & 1023;
            if (which < 2) {
                const int kb = ri >> 5, nb = ri & 31, n0 = nb * 32;
                const float* W = a.in[which == 0 ? I_WG : I_WU] + (size_t)le * 2048 * 1024;
                bf16* dst = (bf16*)(F.ws + WS_WGU) + (size_t)le * 2048 * 2048 + (size_t)((n0 >> 7) * 256 + which * 128 + (n0 & 127)) * 2048;
                transpose_item(W, 1024, kb * 64, n0, dst, 2048, scr, L_.lane);
            } else {
                const int kb = ri >> 6, nb = ri & 63, n0 = nb * 32;
                const float* W = a.in[I_WD] + (size_t)le * 1024 * 2048;
                bf16* dst = (bf16*)(F.ws + WS_WDN) + (size_t)le * 2048 * 1024 + (size_t)n0 * 1024;
                transpose_item(W, 2048, kb * 64, n0, dst, 1024, scr, L_.lane);
            }
        }
    }
}

__device__ __forceinline__ void modulate_store(const f32x4 (&v)[8], const float* shift, const float* scale, bf16* orow, int lane) {
    float ss = 0.f;
#pragma unroll
    for (int j = 0; j < 8; ++j) ss += (v[j].x * v[j].x + v[j].y * v[j].y) + (v[j].z * v[j].z + v[j].w * v[j].w);
    ss = wave_sum(ss);
    const float r = 1.0f / sqrtf(ss * (1.0f / 2048.0f) + NORM_EPS);
#pragma unroll
    for (int j = 0; j < 8; ++j) { const f32x4 sh = ((const f32x4*)shift)[lane + 64 * j], sc = ((const f32x4*)scale)[lane + 64 * j];
        const f32x4 y = v[j] * r * (sc + 1.0f) + sh; v2u o; o.x = pk2(y.x, y.y); o.y = pk2(y.z, y.w); ((v2u*)orow)[lane + 64 * j] = o; }
}
__device__ __forceinline__ void moe_combine_load(const bf16* YS, const int* rec, const LAS int* offs, int lane, f32x4 (&y)[8]) {
    const int s0 = offs[rec[0]] + rec[2], s1 = offs[rec[1]] + rec[3]; const float w0 = __builtin_bit_cast(float, rec[4]), w1 = __builtin_bit_cast(float, rec[5]);
    const v2u* p0 = (const v2u*)(YS + (size_t)s0 * 2048); const v2u* p1 = (const v2u*)(YS + (size_t)s1 * 2048);
#pragma unroll
    for (int j = 0; j < 8; ++j) { const v2u a = p0[lane + 64 * j], b = p1[lane + 64 * j];
        y[j].x = w0 * bflo(a.x) + w1 * bflo(b.x); y[j].y = w0 * bfhi(a.x) + w1 * bfhi(b.x); y[j].z = w0 * bflo(a.y) + w1 * bflo(b.y); y[j].w = w0 * bfhi(a.y) + w1 * bfhi(b.y); }
}

__device__ __forceinline__ int moe_tables(const Frame& F, int layer, int tid) {
    LAS int* texp = (LAS int*)(F.lds + LDS_TAB); LAS int* frt = texp + 256; LAS int* offs = frt + 40;
    if (tid < 64) {
        const int e = tid & 31;
        const unsigned c = __hip_atomic_load((unsigned*)(F.ctl + CW_CNT + layer * 64 + e), RLX_AGENT);
        const int pad = (int)((c + 255u) & ~255u);
        int incl = pad;
#pragma unroll
        for (int d = 1; d < 32; d <<= 1) { const int v = __shfl_up(incl, d); if ((tid & 31) >= d) incl += v; }
        const int excl = incl - pad;
        if (tid < 32) { offs[e] = excl; frt[e] = excl >> 8; for (int r = excl >> 8; r < (incl >> 8); ++r) texp[r] = e; if (e == 31) { offs[NE] = incl; frt[NE] = incl >> 8; } }
    }
    __syncthreads();
    return frt[NE];
}
__device__ __forceinline__ void hrow_load(const bf16* hrow, int lane, f32x4 (&v)[8]) {
#pragma unroll
    for (int q = 0; q < 8; ++q) { const v2u w = ((const v2u*)hrow)[lane + 64 * q]; v[q].x = bflo(w.x); v[q].y = bfhi(w.x); v[q].z = bflo(w.y); v[q].w = bfhi(w.y); }
}
__device__ __forceinline__ void hrow_store(bf16* hrow, int lane, const f32x4 (&v)[8]) {
#pragma unroll
    for (int q = 0; q < 8; ++q) { v2u o; o.x = pk2(v[q].x, v[q].y); o.y = pk2(v[q].z, v[q].w); ((v2u*)hrow)[lane + 64 * q] = o; }
}
__device__ __forceinline__ const float* l0_src_row(const Args& a, int row, int& j) {
    const int b = row / TPB, r = row - b * TPB; j = r < CTX ? 8 : b;
    return r < CTX ? a.in[I_CTX] + (size_t)(b * CTX + r) * DM : a.in[I_X] + (size_t)(b * SEQ + (r - CTX)) * DM;
}
__device__ __forceinline__ void p_l0_mod1(const Frame& F, const Args& a) {
    const LocalId L_ = local_id(); (void)L_;
    const int gw = F.vcu * NWAVES + L_.wave, NGW = F.G * NWAVES;
    const float* MOD = (const float*)(F.ws + WS_MOD); bf16* A1 = (bf16*)(F.ws + WS_A1);
    for (int r0 = gw; r0 < T; r0 += 2 * NGW) {
        const int r1 = r0 + NGW; const bool ok1 = r1 < T;
        int j0, j1 = 0; const float* s0 = l0_src_row(a, r0, j0); const float* s1 = ok1 ? l0_src_row(a, r1, j1) : s0;
        f32x4 v0[8], v1[8];
#pragma unroll
        for (int q = 0; q < 8; ++q) v0[q] = ((const f32x4*)s0)[L_.lane + 64 * q];
#pragma unroll
        for (int q = 0; q < 8; ++q) v1[q] = ((const f32x4*)s1)[L_.lane + 64 * q];
        const float* m0 = MOD + (size_t)(0 * 9 + j0) * 12288;
        modulate_store(v0, m0 + 0 * 2048, m0 + 1 * 2048, A1 + (size_t)r0 * DM, L_.lane);
        if (ok1) {
            const float* m1 = MOD + (size_t)(0 * 9 + j1) * 12288;
            modulate_store(v1, m1 + 0 * 2048, m1 + 1 * 2048, A1 + (size_t)r1 * DM, L_.lane);
        }
    }
}
__device__ __forceinline__ void p_mod2(const Frame& F, int layer) {
    const LocalId L_ = local_id(); (void)L_;
    const int gw = F.vcu * NWAVES + L_.wave, NGW = F.G * NWAVES;
    const float* MOD = (const float*)(F.ws + WS_MOD); const bf16* H = (const bf16*)(F.ws + WS_H); bf16* A1 = (bf16*)(F.ws + WS_A1);
    for (int r0 = gw; r0 < T; r0 += 2 * NGW) {
        const int r1 = r0 + NGW; const int j0 = mod_index(r0), j1 = r1 < T ? mod_index(r1) : 8;
        const bool ok0 = !(layer == 1 && j0 == 8), ok1 = r1 < T && !(layer == 1 && j1 == 8);
        f32x4 v0[8], v1[8];
        if (ok0) hrow_load(H + (size_t)r0 * DM, L_.lane, v0);
        if (ok1) hrow_load(H + (size_t)r1 * DM, L_.lane, v1);
        if (ok0) { const float* m = MOD + (size_t)(layer * 9 + j0) * 12288; modulate_store(v0, m + 3 * 2048, m + 4 * 2048, A1 + (size_t)r0 * DM, L_.lane); }
        if (ok1) { const float* m = MOD + (size_t)(layer * 9 + j1) * 12288; modulate_store(v1, m + 3 * 2048, m + 4 * 2048, A1 + (size_t)r1 * DM, L_.lane); }
    }
}
__device__ __forceinline__ void p_l1_mod1(const Frame& F, size_t hdst_off = WS_H, size_t adst_off = WS_A1) {
    const LocalId L_ = local_id(); (void)L_;
    const int gw = F.vcu * NWAVES + L_.wave, NGW = F.G * NWAVES;
    const float* MOD = (const float*)(F.ws + WS_MOD); const bf16* H = (const bf16*)(F.ws + WS_H); bf16* Hd = (bf16*)(F.ws + hdst_off); bf16* A1 = (bf16*)(F.ws + adst_off);
    const bf16* YS = (const bf16*)(F.ws + WS_YS); const int* ROUTE = (const int*)(F.ws + WS_ROUTE);
    (void)moe_tables(F, 0, L_.tid); const LAS int* offs = (const LAS int*)(F.lds + LDS_TAB) + 296;
    for (int r0 = gw; r0 < T; r0 += 2 * NGW) {
        const int r1 = r0 + NGW; const bool ok1 = r1 < T; const int rr1 = ok1 ? r1 : r0;
        const int j0 = mod_index(r0), j1 = mod_index(rr1);
        f32x4 v0[8], v1[8], y0[8], y1[8];
        moe_combine_load(YS, ROUTE + (size_t)r0 * 8, offs, L_.lane, y0);
        moe_combine_load(YS, ROUTE + (size_t)rr1 * 8, offs, L_.lane, y1);
        hrow_load(H + (size_t)r0 * DM, L_.lane, v0);
        hrow_load(H + (size_t)rr1 * DM, L_.lane, v1);
        const float* g0 = MOD + (size_t)(0 * 9 + j0) * 12288 + 5 * 2048; const float* g1 = MOD + (size_t)(0 * 9 + j1) * 12288 + 5 * 2048;
#pragma unroll
        for (int q = 0; q < 8; ++q) { v0[q] = v0[q] + ((const f32x4*)g0)[L_.lane + 64 * q] * y0[q]; v1[q] = v1[q] + ((const f32x4*)g1)[L_.lane + 64 * q] * y1[q]; }
        if (j0 != 8) hrow_store(Hd + (size_t)r0 * DM, L_.lane, v0);
        const float* m0 = MOD + (size_t)(1 * 9 + j0) * 12288;
        modulate_store(v0, m0 + 0 * 2048, m0 + 1 * 2048, A1 + (size_t)r0 * DM, L_.lane);
        if (ok1) {
            if (j1 != 8) hrow_store(Hd + (size_t)r1 * DM, L_.lane, v1);
            const float* m1 = MOD + (size_t)(1 * 9 + j1) * 12288;
            modulate_store(v1, m1 + 0 * 2048, m1 + 1 * 2048, A1 + (size_t)r1 * DM, L_.lane);
        }
    }
}
__device__ __forceinline__ void p_final(const Frame& F, float* out) {
    const LocalId L_ = local_id(); (void)L_;
    const int gw = F.vcu * NWAVES + L_.wave, NGW = F.G * NWAVES;
    const float* MOD = (const float*)(F.ws + WS_MOD); const bf16* H = (const bf16*)(F.ws + WS_H);
    const bf16* YS = (const bf16*)(F.ws + WS_YS); const int* ROUTE = (const int*)(F.ws + WS_ROUTE);
    (void)moe_tables(F, 1, L_.tid); const LAS int* offs = (const LAS int*)(F.lds + LDS_TAB) + 296;
    for (int i0 = gw; i0 < NB * SEQ; i0 += 2 * NGW) {
        const int i1 = i0 + NGW; const bool ok1 = i1 < NB * SEQ; const int ii1 = ok1 ? i1 : i0;
        const int b0 = i0 / SEQ, row0 = b0 * TPB + CTX + (i0 - b0 * SEQ), b1 = ii1 / SEQ, row1 = b1 * TPB + CTX + (ii1 - b1 * SEQ);
        f32x4 y0[8], y1[8], h0[8], h1[8];
        moe_combine_load(YS, ROUTE + (size_t)row0 * 8, offs, L_.lane, y0);
        moe_combine_load(YS, ROUTE + (size_t)row1 * 8, offs, L_.lane, y1);
        hrow_load(H + (size_t)row0 * DM, L_.lane, h0);
        hrow_load(H + (size_t)row1 * DM, L_.lane, h1);
        const float* g0 = MOD + (size_t)(1 * 9 + b0) * 12288 + 5 * 2048; const float* g1 = MOD + (size_t)(1 * 9 + b1) * 12288 + 5 * 2048;
#pragma unroll
        for (int q = 0; q < 8; ++q) ((f32x4*)(out + (size_t)i0 * DM))[L_.lane + 64 * q] = h0[q] + ((const f32x4*)g0)[L_.lane + 64 * q] * y0[q];
        if (ok1) {
#pragma unroll
            for (int q = 0; q < 8; ++q) ((f32x4*)(out + (size_t)i1 * DM))[L_.lane + 64 * q] = h1[q] + ((const f32x4*)g1)[L_.lane + 64 * q] * y1[q]; }
    }
}

__device__ __forceinline__ void head128_norm_rope(const bf16* p, bf16* pd, const float* gain, bool rope, int prow, int pcol, const float2* t128, int lane) {
    const float x0 = bf2f(p[lane]), x1 = bf2f(p[lane + 64]);
    const float ss = wave_sum(x0 * x0 + x1 * x1);
    const float r = 1.0f / sqrtf(ss * (1.0f / 128.0f) + NORM_EPS);
    float y0 = x0 * r * gain[lane], y1 = x1 * r * gain[lane + 64];
    if (rope) {
        const int f = lane & 31; const float2 cr = t128[prow * 32 + f], cc = t128[pcol * 32 + f];
        const float p0 = __shfl_xor(y0, 32), p1 = __shfl_xor(y1, 32); const float sg = (lane & 32) ? 1.0f : -1.0f;
        y0 = y0 * cr.x + sg * p0 * cr.y; y1 = y1 * cc.x + sg * p1 * cc.y;
    }
    pd[lane] = (bf16)f2bf(y0); pd[lane + 64] = (bf16)f2bf(y1);
}
__device__ __forceinline__ float rope64_apply(float y, int prow, int pcol, const float2* t64, int lane) {
    const int f = lane & 15, pos = (lane & 32) ? pcol : prow; const float2 cs = t64[pos * 16 + f];
    const float pr = __shfl_xor(y, 16); const float sg = (lane & 16) ? 1.0f : -1.0f;
    return y * cs.x + sg * pr * cs.y;
}
__device__ __forceinline__ void head64_norm_rope(const bf16* p, bf16* pd, const float* gain, bool rope, int prow, int pcol, const float2* t64, int lane) {
    const float x = bf2f(p[lane]);
    const float ss = wave_sum(x * x);
    const float r = 1.0f / sqrtf(ss * (1.0f / 64.0f) + NORM_EPS);
    float y = x * r * gain[lane];
    if (rope) y = rope64_apply(y, prow, pcol, t64, lane);
    pd[lane] = (bf16)f2bf(y);
}
__device__ __forceinline__ void norm512(const bf16* src, const float* gain, bf16* dst, int lane) {
    const v4u w = ((const v4u*)src)[lane];
    float x[8] = {bflo(w.x), bfhi(w.x), bflo(w.y), bfhi(w.y), bflo(w.z), bfhi(w.z), bflo(w.w), bfhi(w.w)};
    float ss = 0.f;
#pragma unroll
    for (int i = 0; i < 8; ++i) ss += x[i] * x[i];
    ss = wave_sum(ss);
    const float r = 1.0f / sqrtf(ss * (1.0f / 512.0f) + NORM_EPS);
    const f32x4 g0 = ((const f32x4*)gain)[2 * lane], g1 = ((const f32x4*)gain)[2 * lane + 1];
    v4u o; o.x = pk2(x[0] * r * g0.x, x[1] * r * g0.y); o.y = pk2(x[2] * r * g0.z, x[3] * r * g0.w); o.z = pk2(x[4] * r * g1.x, x[5] * r * g1.y); o.w = pk2(x[6] * r * g1.z, x[7] * r * g1.w);
    ((v4u*)dst)[lane] = o;
}

__device__ __forceinline__ void unpack8(const v4u w, float (&x)[8]) { x[0] = bflo(w.x); x[1] = bfhi(w.x); x[2] = bflo(w.y); x[3] = bfhi(w.y); x[4] = bflo(w.z); x[5] = bfhi(w.z); x[6] = bflo(w.w); x[7] = bfhi(w.w); }
__device__ __forceinline__ v4u pack8(const float (&y)[8]) { v4u o; o.x = pk2(y[0], y[1]); o.y = pk2(y[2], y[3]); o.z = pk2(y[4], y[5]); o.w = pk2(y[6], y[7]); return o; }
__device__ __forceinline__ float sumsq8(const float (&x)[8]) { return ((x[0] * x[0] + x[1] * x[1]) + (x[2] * x[2] + x[3] * x[3])) + ((x[4] * x[4] + x[5] * x[5]) + (x[6] * x[6] + x[7] * x[7])); }
template <int GS> __device__ __forceinline__ float group_sum(float v) {
    v += __shfl_xor(v, 1); v += __shfl_xor(v, 2); v += __shfl_xor(v, 4); if (GS == 16) v += __shfl_xor(v, 8); return v;
}
template <int RD> __device__ __forceinline__ void rope8(float (&y)[8], int l, int prow, int pcol, const float2* tab) {
    constexpr int NF = RD / 4, LQ = NF / 8;
    const int quarter = l / LQ, f0 = (l % LQ) * 8, pos = (quarter >= 2) ? pcol : prow;
    const float sg = (quarter & 1) ? 1.0f : -1.0f;
    const f32x4* t = (const f32x4*)(tab + pos * NF + f0);
    const f32x4 c0 = t[0], c1 = t[1], c2 = t[2], c3 = t[3];
    float p[8];
#pragma unroll
    for (int j = 0; j < 8; ++j) p[j] = __shfl_xor(y[j], LQ);
    y[0] = y[0] * c0.x + sg * p[0] * c0.y; y[1] = y[1] * c0.z + sg * p[1] * c0.w; y[2] = y[2] * c1.x + sg * p[2] * c1.y; y[3] = y[3] * c1.z + sg * p[3] * c1.w;
    y[4] = y[4] * c2.x + sg * p[4] * c2.y; y[5] = y[5] * c2.z + sg * p[5] * c2.w; y[6] = y[6] * c3.x + sg * p[6] * c3.y; y[7] = y[7] * c3.z + sg * p[7] * c3.w;
}
template <int DIM> __device__ __forceinline__ v4u head_chunk(const v4u w, const float* gain, bool rope, int prow, int pcol, const float2* tab, int lane) {
    constexpr int GS = DIM / 8; const int l = lane & (GS - 1);
    float x[8]; unpack8(w, x);
    const float ss = group_sum<GS>(sumsq8(x));
    const float r = 1.0f / sqrtf(ss * (1.0f / DIM) + NORM_EPS);
    const f32x4 g0 = ((const f32x4*)gain)[2 * l], g1 = ((const f32x4*)gain)[2 * l + 1];
    x[0] *= r * g0.x; x[1] *= r * g0.y; x[2] *= r * g0.z; x[3] *= r * g0.w; x[4] *= r * g1.x; x[5] *= r * g1.y; x[6] *= r * g1.z; x[7] *= r * g1.w;
    if (rope) rope8<DIM>(x, l, prow, pcol, tab);
    return pack8(x);
}
__device__ __forceinline__ v4u norm512_chunk(const v4u w, const float* gain, int lane) {
    float x[8]; unpack8(w, x);
    const float ss = wave_sum(sumsq8(x));
    const float r = 1.0f / sqrtf(ss * (1.0f / 512.0f) + NORM_EPS);
    const f32x4 g0 = ((const f32x4*)gain)[2 * lane], g1 = ((const f32x4*)gain)[2 * lane + 1];
    x[0] *= r * g0.x; x[1] *= r * g0.y; x[2] *= r * g0.z; x[3] *= r * g0.w; x[4] *= r * g1.x; x[5] *= r * g1.y; x[6] *= r * g1.z; x[7] *= r * g1.w;
    return pack8(x);
}

__device__ __forceinline__ void p_even_post1(const Frame& F, const Args& a, size_t ydst_off = WS_Y1) {
    const LocalId L_ = local_id(); (void)L_;
    const int gw = F.vcu * NWAVES + L_.wave, NGW = F.G * NWAVES, lane = L_.lane;
    const bf16* Y1 = (const bf16*)(F.ws + WS_Y1); bf16* CQN = (bf16*)(F.ws + WS_CQN); bf16* CKVN = (bf16*)(F.ws + WS_CKVN);
    const float2* t128 = (const float2*)(F.ws + WS_ROPE);
    for (int row = gw; row < T; row += NGW) {
        const int b = row / TPB, r = row - b * TPB; const bool xr = r >= CTX; const int s = r - CTX, prow = xr ? (s >> 6) : 0, pcol = xr ? (s & 63) : 0;
        const v4u* y = (const v4u*)(Y1 + (size_t)row * EVEN_IN_P); v4u* yd = (v4u*)((bf16*)(F.ws + ydst_off) + (size_t)row * EVEN_IN_P);
        const v4u k0 = y[128 + (lane & 31)], cq = y[192 + lane], ckv = y[256 + lane];
        const v4u ok0 = head_chunk<128>(k0, a.in[I_AKN], xr, prow, pcol, t128, lane);
        const v4u ocq = norm512_chunk(cq, a.in[I_BCQN], lane), ockv = norm512_chunk(ckv, a.in[I_BCKVN], lane);
        if (lane < 32) yd[128 + lane] = ok0;
        ((v4u*)(CQN + (size_t)row * 512))[lane] = ocq; ((v4u*)(CKVN + (size_t)row * 512))[lane] = ockv;
    }
}
__device__ __forceinline__ void p_even_post2(const Frame& F, const Args& a, size_t qdst_off = WS_QB, size_t kdst_off = WS_KB) {
    const LocalId L_ = local_id(); (void)L_;
    const int gw = F.vcu * NWAVES + L_.wave, NGW = F.G * NWAVES, lane = L_.lane;
    const bf16* Y1 = (const bf16*)(F.ws + WS_Y1); const bf16* QB = (const bf16*)(F.ws + WS_QB); const bf16* KV = (const bf16*)(F.ws + WS_KV);
    bf16* KB = (bf16*)(F.ws + kdst_off); bf16* QBd = (bf16*)(F.ws + qdst_off);
    const float2* t64 = (const float2*)(F.ws + WS_ROPE + 16384);
    const float* gq = a.in[I_BQN]; const float* gk = a.in[I_BKN]; const float* KRP = (const float*)(F.ws + WS_LG);
    const int l16 = lane & 15, l8 = lane & 7, hn = lane >> 4, hr = lane >> 3;
    const f32x4 gqn0 = ((const f32x4*)gq)[2 * l16], gqn1 = ((const f32x4*)gq)[2 * l16 + 1], gqr0 = ((const f32x4*)(gq + 128))[2 * l8], gqr1 = ((const f32x4*)(gq + 128))[2 * l8 + 1];
    const f32x4 gkn0 = ((const f32x4*)gk)[2 * l16], gkn1 = ((const f32x4*)gk)[2 * l16 + 1], gkr0 = ((const f32x4*)(gk + 128))[2 * l8], gkr1 = ((const f32x4*)(gk + 128))[2 * l8 + 1];
    for (int row = gw; row < T; row += NGW) {
        const int b = row / TPB, r = row - b * TPB; const bool xr = r >= CTX; const int s = r - CTX, prow = xr ? (s >> 6) : 0, pcol = xr ? (s & 63) : 0;
        const bf16* q = QB + (size_t)row * 1536; const bf16* kv = KV + (size_t)row * 2048;
        const v4u wk0 = *(const v4u*)(kv + hn * 256 + l16 * 8), wk1 = *(const v4u*)(kv + (hn + 4) * 256 + l16 * 8);
        const v4u wkr = *(const v4u*)(Y1 + (size_t)row * EVEN_IN_P + 2560 + l8 * 8);
#define POST2_ONE(W0, W1, WR, GN0, GN1, GR0, GR1, DST) do { \
        float x0[8], x1[8], xr_[8]; unpack8(W0, x0); unpack8(W1, x1); unpack8(WR, xr_); \
        const float n0 = group_sum<16>(sumsq8(x0)), n1 = group_sum<16>(sumsq8(x1)), rs = group_sum<8>(sumsq8(xr_));     \
        const float rs0 = __shfl(rs, 8 * hn), rs1 = __shfl(rs, 8 * (hn + 4));                                         \
        const float t0 = __shfl(n0, 16 * (hr & 3)), t1 = __shfl(n1, 16 * (hr & 3)); const float nr = (hr >> 2) ? t1 : t0;    \
        const float r0 = 1.0f / sqrtf((n0 + rs0) * (1.0f / 192.0f) + NORM_EPS), r1 = 1.0f / sqrtf((n1 + rs1) * (1.0f / 192.0f) + NORM_EPS), rr = 1.0f / sqrtf((nr + rs) * (1.0f / 192.0f) + NORM_EPS); \
        x0[0] *= r0 * GN0.x; x0[1] *= r0 * GN0.y; x0[2] *= r0 * GN0.z; x0[3] *= r0 * GN0.w; x0[4] *= r0 * GN1.x; x0[5] *= r0 * GN1.y; x0[6] *= r0 * GN1.z; x0[7] *= r0 * GN1.w; \
        x1[0] *= r1 * GN0.x; x1[1] *= r1 * GN0.y; x1[2] *= r1 * GN0.z; x1[3] *= r1 * GN0.w; x1[4] *= r1 * GN1.x; x1[5] *= r1 * GN1.y; x1[6] *= r1 * GN1.z; x1[7] *= r1 * GN1.w; \
        xr_[0] *= rr * GR0.x; xr_[1] *= rr * GR0.y; xr_[2] *= rr * GR0.z; xr_[3] *= rr * GR0.w; xr_[4] *= rr * GR1.x; xr_[5] *= rr * GR1.y; xr_[6] *= rr * GR1.z; xr_[7] *= rr * GR1.w; \
        if (xr) rope8<64>(xr_, l8, prow, pcol, t64); \
        *(v4u*)((DST) + hn * 192 + l16 * 8) = pack8(x0); *(v4u*)((DST) + (hn + 4) * 192 + l16 * 8) = pack8(x1); *(v4u*)((DST) + hr * 192 + 128 + l8 * 8) = pack8(xr_); } while (0)
        POST2_ONE(wk0, wk1, wkr, gkn0, gkn1, gkr0, gkr1, KB + (size_t)row * 1536);
#undef POST2_ONE
    }
}
__device__ __forceinline__ void p_odd_post1(const Frame& F, const Args& a, size_t ydst_off = WS_Y1) {
    const LocalId L_ = local_id(); (void)L_;
    const int gw = F.vcu * NWAVES + L_.wave, NGW = F.G * NWAVES, lane = L_.lane;
    const bf16* Y1 = (const bf16*)(F.ws + WS_Y1);
    const float2* t128 = (const float2*)(F.ws + WS_ROPE); const float2* t64 = (const float2*)(F.ws + WS_ROPE + 16384);
    for (int row = gw; row < T; row += NGW) {
        const int b = row / TPB, r = row - b * TPB; const bool xr = r >= CTX; const int s = r - CTX, prow = xr ? (s >> 6) : 0, pcol = xr ? (s & 63) : 0;
        const v4u* y = (const v4u*)(Y1 + (size_t)row * ODD_IN); v4u* yd = (v4u*)((bf16*)(F.ws + ydst_off) + (size_t)row * ODD_IN);
        const v4u kc0 = y[128 + lane], kc1 = y[192 + lane], kd0 = y[512 + (lane & 31)];
        const v4u p0 = head_chunk<64>(kc0, a.in[I_CKN], xr, prow, pcol, t64, lane), p1 = head_chunk<64>(kc1, a.in[I_CKN], xr, prow, pcol, t64, lane);
        const v4u p2 = head_chunk<128>(kd0, a.in[I_DKN], xr, prow, pcol, t128, lane);
        yd[128 + lane] = p0; yd[192 + lane] = p1; if (lane < 32) yd[512 + lane] = p2;
    }
}

__device__ __forceinline__ void p_route(const Frame& F, const Args& a, int layer) {
    const LocalId L_ = local_id(); (void)L_;
    const float* LG = (const float*)(F.ws + WS_LG); int* ROUTE = (int*)(F.ws + WS_ROUTE);
    unsigned* cnt = (unsigned*)(F.ctl + CW_CNT + layer * 64);
    const float* brg = a.in[I_BRG] + layer * 4; const float* bre = a.in[I_BRE] + layer * 32;
    const int NT = F.G * 512;
    for (int base = F.vcu * 512 + L_.wave * 64; base < T; base += NT) {
        const int t = base + L_.lane;
        bool valid = t < T; if (valid && layer == 1) valid = (t % TPB) >= CTX;
        int e0 = -1, e1 = -1; float w0 = 0.f, w1 = 0.f;
        if (valid) {
            const float* lg = LG + (size_t)t * 64;
            float g[4]; for (int i = 0; i < 4; ++i) { float v = brg[i]; for (int ks = 0; ks < RKS; ++ks) v += lg[(size_t)ks * T * 64 + i]; g[i] = v; }
            int gi = 0; float gm = g[0]; for (int i = 1; i < 4; ++i) if (g[i] > gm) { gm = g[i]; gi = i; }
            float den = 0.f; for (int i = 0; i < 4; ++i) den += expf(g[i] - gm);
            const float ptop = 1.0f / den;
            float el[8]; for (int i = 0; i < 8; ++i) { float v = bre[gi * 8 + i]; for (int ks = 0; ks < RKS; ++ks) v += lg[(size_t)ks * T * 64 + 4 + gi * 8 + i]; el[i] = v; }
            int i1 = 0; float l1 = el[0]; for (int i = 1; i < 8; ++i) if (el[i] > l1) { l1 = el[i]; i1 = i; }
            int i2 = -1; float l2 = -3.0e38f; for (int i = 0; i < 8; ++i) if (i != i1 && el[i] > l2) { l2 = el[i]; i2 = i; }
            const float ex = expf(l2 - l1), inv = 1.0f / (1.0f + ex);
            w0 = ptop * inv; w1 = ptop * ex * inv; e0 = gi * 8 + i1; e1 = gi * 8 + i2;
        }
        int pos0 = 0, pos1 = 0;
        const unsigned long long lt = (1ull << L_.lane) - 1ull;
        for (int e = 0; e < NE; ++e) {
            const unsigned long long m0 = __ballot(e0 == e), m1 = __ballot(e1 == e);
            const int n0 = __popcll(m0), n1 = __popcll(m1);
            if (n0 + n1 == 0) continue;
            unsigned basev = 0;
            if (L_.lane == 0) basev = __hip_atomic_fetch_add(cnt + e, (unsigned)(n0 + n1), RLX_AGENT);
            basev = (unsigned)__builtin_amdgcn_readfirstlane((int)basev);
            if (e0 == e) pos0 = (int)basev + __popcll(m0 & lt);
            if (e1 == e) pos1 = (int)basev + n0 + __popcll(m1 & lt);
        }
        if (valid) { int* rec = ROUTE + (size_t)t * 8; rec[0] = e0; rec[1] = e1; rec[2] = pos0; rec[3] = pos1; rec[4] = __builtin_bit_cast(int, w0); rec[5] = __builtin_bit_cast(int, w1); }
    }
}
typedef short bf16x8_t __attribute__((ext_vector_type(8)));
__device__ __forceinline__ void p_mod2_route(const Frame& F, const Args& a, int layer) {
    const LocalId L_ = local_id(); (void)L_;
    const int lane = L_.lane, wave = L_.wave;
    constexpr int FPITCH = 4112;
    LAS unsigned char* Fs = F.lds + RING_OFF; LAS float* P = (LAS float*)(F.lds + RING_OFF + 16 * FPITCH + 256);
    const float* MOD = (const float*)(F.ws + WS_MOD); const bf16* H = (const bf16*)(F.ws + WS_H); bf16* A1 = (bf16*)(F.ws + WS_A1);
    const bf16* WR = (const bf16*)(F.ws + WS_WR) + (size_t)layer * 256 * 2048;
    int* ROUTE = (int*)(F.ws + WS_ROUTE); unsigned* cnt = (unsigned*)(F.ctl + CW_CNT + layer * 64); int* postok = (int*)(F.ws + WS_POS) + (size_t)layer * NE * POSCAP;
    const float* brg = a.in[I_BRG] + layer * 4; const float* bre = a.in[I_BRE] + layer * 32;
    bf16x8_t bfr[3][8];
#pragma unroll
    for (int nb = 0; nb < 3; ++nb)
#pragma unroll
        for (int ks = 0; ks < 8; ++ks) bfr[nb][ks] = *(const bf16x8_t*)(WR + (size_t)(nb * 16 + (lane & 15)) * 2048 + wave * 256 + ks * 32 + (lane >> 4) * 8);
    const int NG = layer == 1 ? NB * SEQ / 16 : T / 16;
    int it = 0;
    for (int g = F.vcu; g < NG; g += F.G, ++it) {
        int row0; if (layer == 1) { const int b = g >> 7; row0 = b * TPB + CTX + (g & 127) * 16; } else row0 = g * 16;
        const int j = mod_index(row0);
        const float* m = MOD + (size_t)(layer * 9 + j) * 12288;
        f32x4 v0[8], v1[8];
        const int r0 = 2 * wave, r1 = r0 + 1;
        hrow_load(H + (size_t)(row0 + r0) * DM, lane, v0);
        hrow_load(H + (size_t)(row0 + r1) * DM, lane, v1);
#define M2R_ROW(V, R) do { float ss = 0.f; \
        _Pragma("unroll") for (int q = 0; q < 8; ++q) ss += (V[q].x * V[q].x + V[q].y * V[q].y) + (V[q].z * V[q].z + V[q].w * V[q].w); \
        ss = wave_sum(ss); const float rn = 1.0f / sqrtf(ss * (1.0f / 2048.0f) + NORM_EPS); \
        _Pragma("unroll") for (int q = 0; q < 8; ++q) { const f32x4 sh = ((const f32x4*)(m + 3 * 2048))[lane + 64 * q], sc = ((const f32x4*)(m + 4 * 2048))[lane + 64 * q]; \
            const f32x4 y = V[q] * rn * (sc + 1.0f) + sh; v2u o; o.x = pk2(y.x, y.y); o.y = pk2(y.z, y.w); \
            ((v2u*)(A1 + (size_t)(row0 + (R)) * DM))[lane + 64 * q] = o; *(LAS v2u*)(Fs + (R) * FPITCH + (lane + 64 * q) * 8) = o; } } while (0)
        M2R_ROW(v0, r0); M2R_ROW(v1, r1);
#undef M2R_ROW
        __syncthreads();
        f32x4 acc[3];
#pragma unroll
        for (int nb = 0; nb < 3; ++nb) acc[nb] = (f32x4){0.f, 0.f, 0.f, 0.f};
#pragma unroll
        for (int ks = 0; ks < 8; ++ks) { const bf16x8_t af = *(const LAS bf16x8_t*)(Fs + (lane & 15) * FPITCH + (wave * 256 + ks * 32 + (lane >> 4) * 8) * 2);
#pragma unroll
            for (int nb = 0; nb < 3; ++nb) acc[nb] = __builtin_amdgcn_mfma_f32_16x16x32_bf16(af, bfr[nb][ks], acc[nb], 0, 0, 0); }
        LAS float* Pb = P + (it & 1) * (8 * 16 * 48);
#pragma unroll
        for (int nb = 0; nb < 3; ++nb)
#pragma unroll
            for (int rg = 0; rg < 4; ++rg) Pb[(wave * 16 + 4 * (lane >> 4) + rg) * 48 + nb * 16 + (lane & 15)] = acc[nb][rg];
        __syncthreads();
        if (wave == 0) {
            const bool valid = lane < 16; const int t = row0 + (lane & 15);
            int e0 = -1, e1 = -1; float w0 = 0.f, w1 = 0.f;
            if (valid) {
                const LAS float* pr = Pb + lane * 48;
                float gg[4];
#pragma unroll
                for (int i = 0; i < 4; ++i) { float sacc = brg[i];
#pragma unroll
                    for (int w = 0; w < 8; ++w) sacc += pr[w * 768 + i];
                    gg[i] = sacc; }
                int gi = 0; float gm = gg[0];
#pragma unroll
                for (int i = 1; i < 4; ++i) if (gg[i] > gm) { gm = gg[i]; gi = i; }
                float den = 0.f;
#pragma unroll
                for (int i = 0; i < 4; ++i) den += expf(gg[i] - gm);
                const float ptop = 1.0f / den;
                float el[8];
#pragma unroll
                for (int i = 0; i < 8; ++i) { float sacc = bre[gi * 8 + i];
#pragma unroll
                    for (int w = 0; w < 8; ++w) sacc += pr[w * 768 + 4 + gi * 8 + i];
                    el[i] = sacc; }
                int i1 = 0; float l1 = el[0];
#pragma unroll
                for (int i = 1; i < 8; ++i) if (el[i] > l1) { l1 = el[i]; i1 = i; }
                int i2 = -1; float l2 = -3.0e38f;
#pragma unroll
                for (int i = 0; i < 8; ++i) if (i != i1 && el[i] > l2) { l2 = el[i]; i2 = i; }
                const float ex = expf(l2 - l1), inv = 1.0f / (1.0f + ex);
                w0 = ptop * inv; w1 = ptop * ex * inv; e0 = gi * 8 + i1; e1 = gi * 8 + i2;
            }
            int rank0 = 0, rank1 = 0, mycnt = 0;
            const unsigned long long lt = (1ull << lane) - 1ull;
            for (int e = 0; e < NE; ++e) {
                const unsigned long long m0 = __ballot(e0 == e), m1 = __ballot(e1 == e);
                const int n0 = __popcll(m0), n1 = __popcll(m1);
                if (lane == e) mycnt = n0 + n1;
                if (e0 == e) rank0 = __popcll(m0 & lt);
                if (e1 == e) rank1 = n0 + __popcll(m1 & lt);
            }
            int basev = 0;
            if (lane < NE && mycnt > 0) basev = (int)__hip_atomic_fetch_add(cnt + lane, (unsigned)mycnt, RLX_AGENT);
            const int pos0 = __shfl(basev, e0 & 31) + rank0, pos1 = __shfl(basev, e1 & 31) + rank1;
            if (valid) { int* rec = ROUTE + (size_t)t * 8; rec[0] = e0; rec[1] = e1; rec[2] = pos0; rec[3] = pos1; rec[4] = __builtin_bit_cast(int, w0); rec[5] = __builtin_bit_cast(int, w1);
                         postok[(size_t)e0 * POSCAP + pos0] = t; postok[(size_t)e1 * POSCAP + pos1] = t; }
        }
    }
    __syncthreads();
}
__device__ __forceinline__ void p_gather(const Frame& F, int layer) {
    const LocalId L_ = local_id(); (void)L_;
    LAS int* offs = (LAS int*)(F.lds + RING_OFF);
    if (L_.tid == 0) { int o = 0; for (int e = 0; e < NE; ++e) { offs[e] = o; const unsigned c = __hip_atomic_load((unsigned*)(F.ctl + CW_CNT + layer * 64 + e), RLX_AGENT); o += (int)((c + 255u) & ~255u); } offs[NE] = o; }
    __syncthreads();
    if (blockIdx.x == 0 && L_.tid < NE) { const int e = L_.tid; int* texp = (int*)(F.ctl + CW_TEXP + layer * 256);
        for (int r = offs[e] >> 8; r < (offs[e + 1] >> 8); ++r) texp[r] = e;
        if (e == 0) *(int*)(F.ctl + CW_NRT + layer * 64) = offs[NE] >> 8; }
    int* ROUTE = (int*)(F.ws + WS_ROUTE); int* slot_tok = (int*)(F.ctl + CW_SLOT + layer * MAXSLOT);
    for (int t = F.vcu * 512 + L_.tid; t < T; t += F.G * 512) {
        if (layer == 1 && (t % TPB) < CTX) continue;
        int* rec = ROUTE + (size_t)t * 8;
        const int s0 = offs[rec[0]] + rec[2], s1 = offs[rec[1]] + rec[3];
        slot_tok[s0] = t; slot_tok[s1] = t; rec[6] = s0; rec[7] = s1;
    }
    __syncthreads();
}

constexpr int SLD = 2304;
template <int DQ, int QR>
__device__ __forceinline__ void naive_scores_softmax(LAS float* S, LAS float* qf, const bf16* Q, int ldq, const bf16* K, int ldk, int lo, int nk, float scale,
                                                     bool window, int qpos0, bool has_sink, float sink, int tid, int lane, int wave) {
    for (int i = tid; i < QR * DQ; i += 512) { const int r = i / DQ, d = i - r * DQ; qf[i] = bf2f(Q[(size_t)r * ldq + d]); }
    __syncthreads();
    for (int t = tid; t < nk; t += 512) {
        const int kr = t < CTX ? t : CTX + lo + (t - CTX);
        const bf16* kp = K + (size_t)kr * ldk;
        float acc[QR];
#pragma unroll
        for (int r = 0; r < QR; ++r) acc[r] = 0.f;
        for (int d = 0; d < DQ; d += 8) {
            const v4u kv = *(const v4u*)(kp + d);
            const float k0 = bflo(kv.x), k1 = bfhi(kv.x), k2 = bflo(kv.y), k3 = bfhi(kv.y), k4 = bflo(kv.z), k5 = bfhi(kv.z), k6 = bflo(kv.w), k7 = bfhi(kv.w);
#pragma unroll
            for (int r = 0; r < QR; ++r) { const LAS float* qp = qf + r * DQ + d;
                acc[r] += (k0 * qp[0] + k1 * qp[1]) + (k2 * qp[2] + k3 * qp[3]) + (k4 * qp[4] + k5 * qp[5]) + (k6 * qp[6] + k7 * qp[7]); }
        }
#pragma unroll
        for (int r = 0; r < QR; ++r) { float s = acc[r] * scale;
            if (window && t >= CTX) { const int dd = (qpos0 + r) - (lo + t - CTX); if (dd > 128 || dd < -128) s = -1e30f; }
            S[r * SLD + t] = s; }
    }
    __syncthreads();
    if (wave < QR) {
        LAS float* row = S + wave * SLD;
        float m = -1e30f; for (int t = lane; t < nk; t += 64) m = fmaxf(m, row[t]);
        m = wave_max(m); if (has_sink) m = fmaxf(m, sink);
        float sum = 0.f; for (int t = lane; t < nk; t += 64) { const float e = expf(row[t] - m); row[t] = e; sum += e; }
        sum = wave_sum(sum); if (has_sink) sum += expf(sink - m);
        const float inv = 1.0f / sum;
        for (int t = lane; t < nk; t += 64) row[t] *= inv;
    }
    __syncthreads();
}
template <int QR>
__device__ __forceinline__ void naive_pv(const LAS float* S, const bf16* V, int ldv, int lo, int nk, int tid, float (&o)[QR / 4]) {
    const int c = tid & 127, rg = tid >> 7; constexpr int RPT = QR / 4;
#pragma unroll
    for (int i = 0; i < RPT; ++i) o[i] = 0.f;
#pragma unroll 4
    for (int t = 0; t < nk; ++t) { const int kr = t < CTX ? t : CTX + lo + (t - CTX); const float v = bf2f(V[(size_t)kr * ldv + c]);
#pragma unroll
        for (int i = 0; i < RPT; ++i) o[i] += S[(rg * RPT + i) * SLD + t] * v; }
}
__device__ __forceinline__ void p_even_attn_naive(const Frame& F) {
    const LocalId L_ = local_id(); (void)L_;
    LAS float* S = (LAS float*)(F.lds + RING_OFF); LAS float* qf = (LAS float*)(F.lds + RING_OFF + 8 * SLD * 4);
    const bf16* Y1 = (const bf16*)(F.ws + WS_Y1); const bf16* QB = (const bf16*)(F.ws + WS_QB); const bf16* KV = (const bf16*)(F.ws + WS_KV); const bf16* KB = (const bf16*)(F.ws + WS_KB);
    bf16* MIX = (bf16*)(F.ws + WS_MIX);
    constexpr int UPV = NB * 8 * 288;
    for (int u = blockIdx.x; u < 2 * UPV; u += F.G) {
        const int var = u / UPV, rem = u - var * UPV, b = rem / 2304, rem2 = rem - b * 2304, h = rem2 / 288, ch = rem2 - h * 288;
        const int r0 = ch * 8, row0 = b * TPB + r0; const int nk = r0 < CTX ? CTX : TPB;
        float o[2];
        if (var == 0) {
            naive_scores_softmax<128, 8>(S, qf, Y1 + (size_t)row0 * EVEN_IN_P + h * 128, EVEN_IN_P, Y1 + (size_t)(b * TPB) * EVEN_IN_P + 1024 + (h >> 2) * 128, EVEN_IN_P, 0, nk,
                                         0.08838834764831845f, false, 0, false, 0.f, L_.tid, L_.lane, L_.wave);
            naive_pv<8>(S, Y1 + (size_t)(b * TPB) * EVEN_IN_P + 1280 + (h >> 2) * 128, EVEN_IN_P, 0, nk, L_.tid, o);
        } else {
            naive_scores_softmax<192, 8>(S, qf, QB + (size_t)row0 * 1536 + h * 192, 1536, KB + (size_t)(b * TPB) * 1536 + h * 192, 1536, 0, nk,
                                         0.07216878364870322f, false, 0, false, 0.f, L_.tid, L_.lane, L_.wave);
            naive_pv<8>(S, KV + (size_t)(b * TPB) * 2048 + h * 256 + 128, 2048, 0, nk, L_.tid, o);
        }
        const int c = L_.tid & 127, rg = L_.tid >> 7;
#pragma unroll
        for (int i = 0; i < 2; ++i) MIX[(size_t)(row0 + rg * 2 + i) * DM + var * 1024 + h * 128 + c] = (bf16)f2bf(o[i]);
        __syncthreads();
    }
}
__device__ __forceinline__ void p_odd_attn_naive(const Frame& F, const Args& a) {
    const LocalId L_ = local_id(); (void)L_;
    LAS float* S = (LAS float*)(F.lds + RING_OFF); LAS float* qf = (LAS float*)(F.lds + RING_OFF + 8 * SLD * 4); LAS float* ob = qf + 8 * 192;
    const bf16* Y1 = (const bf16*)(F.ws + WS_Y1); bf16* MIX = (bf16*)(F.ws + WS_MIX);
    float d1 = 0.f, d2 = 0.f;
    for (int i = 0; i < 64; ++i) { d1 += a.in[I_LQ1][i] * a.in[I_LK1][i]; d2 += a.in[I_LQ2][i] * a.in[I_LK2][i]; }
    const float lam = expf(d1) - expf(d2) + LAMBDA_INIT;
    constexpr int UC = NB * 8 * 512, UD = NB * 8 * 256;
    for (int u = blockIdx.x; u < UC + UD; u += F.G) {
        const int c = L_.tid & 127, rg = L_.tid >> 7;
        if (u < UC) {
            const int b = u / 4096, rem = u - b * 4096, h = rem / 512, ch = rem - h * 512;
            const int r0 = CTX + ch * 4, row0 = b * TPB + r0; const int nk = TPB;
            const bf16* kb = Y1 + (size_t)(b * TPB) * ODD_IN;
            naive_scores_softmax<64, 4>(S, qf, Y1 + (size_t)row0 * ODD_IN + (2 * h) * 64, ODD_IN, kb + 1024 + (2 * h) * 64, ODD_IN, 0, nk, 0.125f, false, 0, false, 0.f, L_.tid, L_.lane, L_.wave);
            naive_scores_softmax<64, 4>(S + 4 * SLD, qf, Y1 + (size_t)row0 * ODD_IN + (2 * h + 1) * 64, ODD_IN, kb + 1024 + (2 * h + 1) * 64, ODD_IN, 0, nk, 0.125f, false, 0, false, 0.f, L_.tid, L_.lane, L_.wave);
            for (int i = L_.tid; i < 4 * SLD; i += 512) S[i] = S[i] - lam * S[4 * SLD + i];
            __syncthreads();
            float o[1];
            naive_pv<4>(S, kb + 2048 + h * 128, ODD_IN, 0, nk, L_.tid, o);
            ob[rg * 128 + c] = o[0];
            __syncthreads();
            float ss = 0.f; for (int i = 0; i < 128; ++i) { const float v = ob[rg * 128 + i]; ss += v * v; }
            const float r = 1.0f / sqrtf(ss * (1.0f / 128.0f) + NORM_EPS);
            MIX[(size_t)(row0 + rg) * DM + h * 128 + c] = (bf16)f2bf(o[0] * r * a.in[I_SUBLN][c] * (1.0f - LAMBDA_INIT));
        } else {
            const int v = u - UC, b = v / 2048, rem = v - b * 2048, h = rem / 256, ch = rem - h * 256;
            const int s0 = ch * 8, row0 = b * TPB + CTX + s0;
            const int lo = s0 - 128 < 0 ? 0 : s0 - 128, hi = s0 + 7 + 128 > SEQ - 1 ? SEQ - 1 : s0 + 7 + 128; const int nk = CTX + (hi - lo + 1);
            const bf16* kb = Y1 + (size_t)(b * TPB) * ODD_IN;
            naive_scores_softmax<128, 8>(S, qf, Y1 + (size_t)row0 * ODD_IN + 3072 + h * 128, ODD_IN, kb + 4096 + (h >> 2) * 128, ODD_IN, lo, nk, 0.08838834764831845f, true, s0, true, a.in[I_SINK][h], L_.tid, L_.lane, L_.wave);
            float o[2];
            naive_pv<8>(S, kb + 4352 + (h >> 2) * 128, ODD_IN, lo, nk, L_.tid, o);
#pragma unroll
            for (int i = 0; i < 2; ++i) MIX[(size_t)(row0 + rg * 2 + i) * DM + 1024 + h * 128 + c] = (bf16)f2bf(o[i]);
        }
        __syncthreads();
    }
}

namespace att {
using bf16x8 = __attribute__((ext_vector_type(8))) short;
using s16x4  = __attribute__((ext_vector_type(4))) short;
using f32x16 = __attribute__((ext_vector_type(16))) float;
using u32x4  = __attribute__((ext_vector_type(4))) unsigned;
constexpr int KVBLK = 64, QBLK = 32;
constexpr int SHM_V = KVBLK * 128 * 2;
constexpr int K_OFF = 2 * SHM_V, K_MAX = KVBLK * 192 * 2, QL_OFF = K_OFF + 2 * K_MAX, WS_OFF = 131072 + 2048;
constexpr float THR = 8.f;
#define ATT_KSWZ(row, colB, RB) ((row) * (RB) + ((colB) ^ (((row) & 7) << 4)))
#define ATT_SBAR() __builtin_amdgcn_sched_barrier(0)
__device__ __forceinline__ int crow(int r, int hi) { return (r & 3) + 8 * (r >> 2) + 4 * hi; }
__device__ __forceinline__ unsigned cvtpk(float lo, float hi) { unsigned r; asm volatile("v_cvt_pk_bf16_f32 %0, %1, %2" : "=v"(r) : "v"(lo), "v"(hi)); return r; }

__device__ __forceinline__ void partialSM(f32x16& p0, f32x16& p1, float& m_reg, float& mn, float& alpha, float C, float thr_raw) {
  float pmax = p0[0];
#pragma unroll
  for (int r = 1; r < 16; ++r) pmax = fmaxf(pmax, p0[r]);
#pragma unroll
  for (int r = 0; r < 16; ++r) pmax = fmaxf(pmax, p1[r]);
  { auto rr = __builtin_amdgcn_permlane32_swap(__float_as_uint(pmax), __float_as_uint(pmax), false, false);
    pmax = fmaxf(__uint_as_float(rr[0]), __uint_as_float(rr[1])); }
  if (__builtin_expect(__all(pmax - m_reg <= thr_raw), 1)) { mn = m_reg; alpha = 1.f; }
  else { mn = fmaxf(m_reg, pmax); alpha = __builtin_amdgcn_exp2f((m_reg - mn) * C); m_reg = mn; }
  const float mnC = -mn * C;
#pragma unroll
  for (int r = 0; r < 16; ++r) p0[r] = fmaf(p0[r], C, mnC);
#pragma unroll
  for (int r = 0; r < 16; ++r) p1[r] = fmaf(p1[r], C, mnC);
#pragma unroll
  for (int r = 0; r < 16; ++r) p0[r] = __builtin_amdgcn_exp2f(p0[r]);
}
__device__ __forceinline__ void finishSM(f32x16& p0, f32x16& p1, float alpha, float& l_reg, bf16x8& pa0, bf16x8& pa1, bf16x8& pa2, bf16x8& pa3) {
#pragma unroll
  for (int r = 0; r < 16; ++r) p1[r] = __builtin_amdgcn_exp2f(p1[r]);
  float ps = 0;
#pragma unroll
  for (int r = 0; r < 16; ++r) ps += p0[r];
#pragma unroll
  for (int r = 0; r < 16; ++r) ps += p1[r];
  { auto rr = __builtin_amdgcn_permlane32_swap(__float_as_uint(ps), __float_as_uint(ps), false, false);
    ps = __uint_as_float(rr[0]) + __uint_as_float(rr[1]); }
  l_reg = l_reg * alpha + ps;
#define ATT_PK4(P, BASE, OUT) do { unsigned a0 = cvtpk(P[BASE + 0], P[BASE + 1]), a1 = cvtpk(P[BASE + 2], P[BASE + 3]);   \
    unsigned b0 = cvtpk(P[BASE + 4], P[BASE + 5]), b1 = cvtpk(P[BASE + 6], P[BASE + 7]);                              \
    auto r0 = __builtin_amdgcn_permlane32_swap(a0, b0, false, false); auto r1 = __builtin_amdgcn_permlane32_swap(a1, b1, false, false); \
    u32x4 w = {r0[0], r1[0], r0[1], r1[1]}; OUT = *reinterpret_cast<bf16x8*>(&w); } while (0)
  ATT_PK4(p0, 0, pa0); ATT_PK4(p0, 8, pa1); ATT_PK4(p1, 0, pa2); ATT_PK4(p1, 8, pa3);
#undef ATT_PK4
}
template <int DQ, int NQT, int NQR, int QSB>
__device__ __forceinline__ void qkt(f32x16& p0, f32x16& p1, const char* Ks, const bf16x8 (&qr)[NQR], const char* qlds, const int (&kb)[4]) {
  p0 = f32x16{}; p1 = f32x16{};
#pragma unroll
  for (int d0 = 0; d0 < NQT; ++d0) {
    const bf16x8 b0 = *reinterpret_cast<const bf16x8*>(Ks + kb[d0 & 3] + (d0 >> 2) * 128);
    const bf16x8 b1 = *reinterpret_cast<const bf16x8*>(Ks + kb[d0 & 3] + (d0 >> 2) * 128 + 32 * DQ * 2);
    bf16x8 q; if (d0 < NQR) q = qr[d0 < NQR ? d0 : 0]; else q = *reinterpret_cast<const bf16x8*>(qlds + (d0 - NQR) * 1024);
    p0 = __builtin_amdgcn_mfma_f32_32x32x16_bf16(b0, q, p0, 0, 0, 0);
    p1 = __builtin_amdgcn_mfma_f32_32x32x16_bf16(b1, q, p1, 0, 0, 0);
    if (QSB > 0 && (d0 % (QSB > 0 ? QSB : 1)) == (QSB - 1) && d0 + 1 < NQT) ATT_SBAR(); }
}
__device__ __forceinline__ void mask_tile(f32x16& p0, f32x16& p1, int kp0, int qpos, int hi) {
#pragma unroll
  for (int r = 0; r < 16; ++r) { const int d = qpos - (kp0 + crow(r, hi));
    if (d > 128 || d < -128) p0[r] = -1e30f;
    if (d - 32 > 128 || d - 32 < -128) p1[r] = -1e30f; }
}
__device__ __forceinline__ int v_st(int k, int c) { const int kk = (k & ~0xC) | ((k & 4) << 1) | ((k & 8) >> 1); return ((kk >> 3) * 4 + (c >> 5)) * 512 + ((kk & 7) * 32 + (c & 31)) * 2; }
__device__ __forceinline__ int v_rd_base(int lane) { return ((lane & 3) << 3) | (((lane >> 2) & 3) << 6) | (((lane >> 4) & 1) << 5) | (((lane >> 5) & 1) << 8); }
constexpr int v_rd_off(int d0, int ks, int half) { return d0 * 512 + ks * 4096 + half * 2048; }
template <int OFF> __device__ __forceinline__ s16x4 tr_read(int vb) {
  s16x4 r; asm volatile("ds_read_b64_tr_b16 %0, %1 offset:%2" : "=&v"(r) : "v"(vb), "i"(OFF) : "memory"); return r;
}
template <int D0> __device__ __forceinline__ void pv_one(f32x16& od, int vb, bf16x8 pa0, bf16x8 pa1, bf16x8 pa2, bf16x8 pa3) {
  const s16x4 l0 = tr_read<v_rd_off(D0, 0, 0)>(vb), h0 = tr_read<v_rd_off(D0, 0, 1)>(vb), l1 = tr_read<v_rd_off(D0, 1, 0)>(vb), h1 = tr_read<v_rd_off(D0, 1, 1)>(vb);
  const s16x4 l2 = tr_read<v_rd_off(D0, 2, 0)>(vb), h2 = tr_read<v_rd_off(D0, 2, 1)>(vb), l3 = tr_read<v_rd_off(D0, 3, 0)>(vb), h3 = tr_read<v_rd_off(D0, 3, 1)>(vb);
  asm volatile("s_waitcnt lgkmcnt(0)" ::: "memory"); ATT_SBAR();
#define ATT_PK(L, H) (bf16x8){L[0], L[1], L[2], L[3], H[0], H[1], H[2], H[3]}
  od = __builtin_amdgcn_mfma_f32_32x32x16_bf16(pa0, ATT_PK(l0, h0), od, 0, 0, 0);
  od = __builtin_amdgcn_mfma_f32_32x32x16_bf16(pa1, ATT_PK(l1, h1), od, 0, 0, 0);
  od = __builtin_amdgcn_mfma_f32_32x32x16_bf16(pa2, ATT_PK(l2, h2), od, 0, 0, 0);
  od = __builtin_amdgcn_mfma_f32_32x32x16_bf16(pa3, ATT_PK(l3, h3), od, 0, 0, 0);
#undef ATT_PK
}
__device__ __forceinline__ void pv_d0(f32x16* o, int vb, bf16x8 pa0, bf16x8 pa1, bf16x8 pa2, bf16x8 pa3) {
  pv_one<0>(o[0], vb, pa0, pa1, pa2, pa3); pv_one<1>(o[1], vb, pa0, pa1, pa2, pa3); pv_one<2>(o[2], vb, pa0, pa1, pa2, pa3); pv_one<3>(o[3], vb, pa0, pa1, pa2, pa3);
}

template <int M> __device__ __forceinline__ float swz_xor(float v) { return __builtin_bit_cast(float, __builtin_amdgcn_ds_swizzle(__builtin_bit_cast(int, v), (M << 10) | 0x1F)); }
__device__ __forceinline__ float sum_xor32(float v) { auto rr = __builtin_amdgcn_permlane32_swap(__float_as_uint(v), __float_as_uint(v), false, false); return __uint_as_float(rr[0]) + __uint_as_float(rr[1]); }
__device__ __forceinline__ float bfx(short v) { return __builtin_bit_cast(float, ((unsigned)(unsigned short)v) << 16); }
template <int MODE, int NQ>
__device__ __forceinline__ void q_fix(bf16x8 (&q)[NQ], const float* gain, const float* tab  , int pos, int hi) {
  constexpr int DIM = NQ * 16;
  float x[NQ][8]; float ss = 0.f;
#pragma unroll
  for (int d0 = 0; d0 < NQ; ++d0)
#pragma unroll
    for (int j = 0; j < 8; ++j) { x[d0][j] = bfx(q[d0][j]); ss += x[d0][j] * x[d0][j]; }
  ss = sum_xor32(ss);
  const float r = 1.0f / sqrtf(ss * (1.0f / DIM) + 1e-6f);
#pragma unroll
  for (int d0 = 0; d0 < NQ; ++d0) { const float* g = gain + d0 * 16 + hi * 8;
#pragma unroll
    for (int j = 0; j < 8; ++j) x[d0][j] *= r * g[j]; }
  if (pos >= 0) {
    const int prow = pos >> 6, pcol = pos & 63;
    constexpr int RB0 = (MODE == 2) ? 8 : 0, NRB = (MODE == 1) ? 8 : 4, NF = (MODE == 1) ? 32 : 16, PX = (MODE == 1) ? 2 : 1;
    float y[NRB][8];
#pragma unroll
    for (int b = 0; b < NRB; ++b) { const int p = (b < NRB / 2) ? prow : pcol; const int f0 = (MODE == 1 ? (b & 1) * 16 : 0) + hi * 8; const float sg = (b & PX) ? 1.0f : -1.0f;
      const float* t = tab + (size_t)(p * NF + f0) * 2;
#pragma unroll
      for (int j = 0; j < 8; ++j) y[b][j] = x[RB0 + b][j] * t[2 * j] + sg * x[RB0 + (b ^ PX)][j] * t[2 * j + 1]; }
#pragma unroll
    for (int b = 0; b < NRB; ++b)
#pragma unroll
      for (int j = 0; j < 8; ++j) x[RB0 + b][j] = y[b][j];
  }
#pragma unroll
  for (int d0 = 0; d0 < NQ; ++d0) { u32x4 w; w.x = cvtpk(x[d0][0], x[d0][1]); w.y = cvtpk(x[d0][2], x[d0][3]); w.z = cvtpk(x[d0][4], x[d0][5]); w.w = cvtpk(x[d0][6], x[d0][7]); q[d0] = *reinterpret_cast<bf16x8*>(&w); }
}

template <int DQ, bool WINDOW, bool SINK, int LDQ, int LDK, int LDV, int SD, int QSB, int NQRMAX, bool DIFF = false, int QMODE = 0>
__device__ __forceinline__ void attn_unit(const bf16* __restrict__ Qb, const bf16* __restrict__ Kb, const bf16* __restrict__ Vb,
                                          bf16* __restrict__ Ob, int ntiles, int band_lo, int qpos0, float scale, float sink, char* lds, const float* gainp = nullptr,
                                          const float* qgain = nullptr, const float* qtab = nullptr, int qs0 = -1, int wv = 0) {
  constexpr int NQ = (DIFF ? DQ / 2 : DQ) / 16, NQR = NQ > NQRMAX ? NQRMAX : NQ, NCH = DQ / 64, RB = DQ * 2, SHM_K = KVBLK * DQ * 2, LDO = 2048;
  int tid = wv * 64 + lane_id_(); asm volatile("" : "+v"(tid));
  const int wid = tid >> 6, lane = tid & 63, r32 = lane & 31, hi = lane >> 5;
  const int comp = DIFF ? (wid >> 2) : 0, wrow = DIFF ? (wid & 3) : wid, kcomp = comp * 128;
  char* V_lds = lds; char* K_lds = lds + K_OFF;
  float* ws = (float*)(lds + WS_OFF) + wid * 64; float* li_l = ws; float* al_l = ws + 32;
  const float C = scale * 1.4426950408889634f, thr_raw = THR / scale;
  float m_reg = -1e30f, l_reg = 0; f32x16 o[4] = {}; bf16x8 qr[NQR];
  const unsigned qoff = (unsigned)((wrow * QBLK + r32) * LDQ + hi * 8 + comp * 64) * 2u;
  char* qlds = lds + QL_OFF + wid * ((NQ - NQR) * 1024) + lane * 16;
  if constexpr (QMODE == 0) {
#pragma unroll
    for (int d0 = 0; d0 < NQR; ++d0) qr[d0] = *reinterpret_cast<const bf16x8*>((const char*)Qb + qoff + d0 * 32);
    __syncthreads();
    if constexpr (NQ > NQR) {
#pragma unroll
      for (int d0 = NQR; d0 < NQ; ++d0) *reinterpret_cast<bf16x8*>(qlds + (d0 - NQR) * 1024) = *reinterpret_cast<const bf16x8*>((const char*)Qb + qoff + d0 * 32);
    }
  } else {
    bf16x8 qall[NQ];
#pragma unroll
    for (int d0 = 0; d0 < NQ; ++d0) qall[d0] = *reinterpret_cast<const bf16x8*>((const char*)Qb + qoff + d0 * 32);
    q_fix<QMODE, NQ>(qall, qgain, qtab, qs0 < 0 ? -1 : qs0 + wrow * QBLK + r32, hi);
#pragma unroll
    for (int d0 = 0; d0 < NQR; ++d0) qr[d0] = qall[d0];
    __syncthreads();
    if constexpr (NQ > NQR) {
#pragma unroll
      for (int d0 = NQR; d0 < NQ; ++d0) *reinterpret_cast<bf16x8*>(qlds + (d0 - NQR) * 1024) = qall[d0];
    }
  }
  const int sr = tid >> 4, sc = (tid & 15) * 8, vst0 = v_st(sr, sc);
  const unsigned voV = (unsigned)(sr * LDV + sc) * 2u;
  const int kr_ = tid >> 3, kc_ = (tid & 7) * 8;
  const unsigned voK = (unsigned)(kr_ * LDK + kc_) * 2u; const int kwr = ATT_KSWZ(kr_, kc_ * 2, RB);
  const int vb0 = (int)(uintptr_t)V_lds + v_rd_base(lane);
  int kb[4];
#pragma unroll
  for (int k = 0; k < 4; ++k) kb[k] = r32 * RB + ((k ^ ((r32 & 7) >> 1)) * 32) + ((hi ^ (r32 & 1)) * 16);
  const int qpos = qpos0 + wrow * QBLK + r32;
  struct { bf16x8 vs0, vs1, ks[NCH]; } sr_[SD];
#define ATT_KROW(j) (WINDOW ? ((j) < 4 ? (j) * KVBLK : 256 + band_lo + ((j) - 4) * KVBLK) : (j) * KVBLK)
#define ATT_SLOAD(i, j) do { const int k0_ = ATT_KROW(j); const char* vt_ = (const char*)Vb + (size_t)k0_ * (LDV * 2); const char* kt_ = (const char*)Kb + (size_t)k0_ * (LDK * 2); \
    sr_[i].vs0 = *reinterpret_cast<const bf16x8*>(vt_ + voV); sr_[i].vs1 = *reinterpret_cast<const bf16x8*>(vt_ + voV + 32 * LDV * 2); \
    _Pragma("unroll") for (int c_ = 0; c_ < NCH; ++c_) sr_[i].ks[c_] = *reinterpret_cast<const bf16x8*>(kt_ + voK + c_ * 128); } while (0)
#define ATT_SWRITE(b, i) do { *(bf16x8*)(V_lds + (b) * SHM_V + vst0) = sr_[i].vs0; *(bf16x8*)(V_lds + (b) * SHM_V + vst0 + 8192) = sr_[i].vs1; \
    _Pragma("unroll") for (int c_ = 0; c_ < NCH; ++c_) *(bf16x8*)(K_lds + (b) * SHM_K + kwr + c_ * 128) = sr_[i].ks[c_]; } while (0)
#define ATT_SWAIT() do { if constexpr (SD == 1) asm volatile("s_waitcnt vmcnt(0)" ::: "memory"); else if constexpr (NCH == 1) asm volatile("s_waitcnt vmcnt(3)" ::: "memory"); else if constexpr (NCH == 2) asm volatile("s_waitcnt vmcnt(4)" ::: "memory"); else asm volatile("s_waitcnt vmcnt(5)" ::: "memory"); } while (0)
#define ATT_RESC(a) do { if (__any((a) < 1.f)) { if (hi == 0) al_l[r32] = (a); asm volatile("s_waitcnt lgkmcnt(0)" ::: "memory"); \
    _Pragma("unroll") for (int d = 0; d < 4; ++d) _Pragma("unroll") for (int r = 0; r < 16; ++r) o[d][r] *= al_l[crow(r, hi)]; } } while (0)
#define ATT_MASK(P0, P1, j) do { if constexpr (WINDOW) { if ((j) >= 4) mask_tile(P0, P1, band_lo + ((j) - 4) * KVBLK, qpos, hi); } } while (0)
  f32x16 pA0, pA1, pB0, pB1; float mnA, mnB, alA, alB; bf16x8 pa0, pa1, pa2, pa3; const int NT = ntiles;
  constexpr int SE = 0, SO = SD - 1;
  ATT_SLOAD(SE, 0); asm volatile("s_waitcnt vmcnt(0)" ::: "memory"); ATT_SWRITE(0, SE); __syncthreads();
  qkt<DQ, NQ, NQR, QSB>(pA0, pA1, K_lds + kcomp, qr, qlds, kb); ATT_MASK(pA0, pA1, 0); partialSM(pA0, pA1, m_reg, mnA, alA, C, thr_raw);
  ATT_SLOAD(SO, 1); if constexpr (SD == 2) { if (2 < NT) ATT_SLOAD(SE, 2); }
  ATT_SWAIT(); ATT_SWRITE(1, SO); __syncthreads();
  for (int j = 1; j + 1 < NT; j += 2) {
    ATT_SBAR(); qkt<DQ, NQ, NQR, QSB>(pB0, pB1, K_lds + SHM_K + kcomp, qr, qlds, kb);
    finishSM(pA0, pA1, alA, l_reg, pa0, pa1, pa2, pa3); ATT_SBAR();
    ATT_SLOAD(SO, j + SD); ATT_SBAR();
    pv_d0(o, vb0, pa0, pa1, pa2, pa3); ATT_MASK(pB0, pB1, j); partialSM(pB0, pB1, m_reg, mnB, alB, C, thr_raw);
    __syncthreads(); ATT_SWAIT(); ATT_SWRITE(0, SE);
    ATT_RESC(alB); __syncthreads();
    ATT_SBAR(); qkt<DQ, NQ, NQR, QSB>(pA0, pA1, K_lds + kcomp, qr, qlds, kb);
    finishSM(pB0, pB1, alB, l_reg, pa0, pa1, pa2, pa3); ATT_SBAR();
    if (SD == 1 || j + 3 < NT) ATT_SLOAD(SE, j + 1 + SD); ATT_SBAR();
    pv_d0(o, vb0 + SHM_V, pa0, pa1, pa2, pa3); ATT_MASK(pA0, pA1, j + 1); partialSM(pA0, pA1, m_reg, mnA, alA, C, thr_raw);
    __syncthreads(); ATT_SWAIT(); ATT_SWRITE(1, SO);
    ATT_RESC(alA); __syncthreads();
  }
  ATT_SBAR(); qkt<DQ, NQ, NQR, QSB>(pB0, pB1, K_lds + SHM_K + kcomp, qr, qlds, kb);
  finishSM(pA0, pA1, alA, l_reg, pa0, pa1, pa2, pa3); ATT_SBAR();
  pv_d0(o, vb0, pa0, pa1, pa2, pa3); ATT_MASK(pB0, pB1, NT - 1); partialSM(pB0, pB1, m_reg, mnB, alB, C, thr_raw);
  __syncthreads(); ATT_RESC(alB);
  finishSM(pB0, pB1, alB, l_reg, pa0, pa1, pa2, pa3); ATT_SBAR();
  pv_d0(o, vb0 + SHM_V, pa0, pa1, pa2, pa3);
  if constexpr (SINK) l_reg += __builtin_amdgcn_exp2f(sink * 1.4426950408889634f - m_reg * C);
  if (hi == 0) li_l[r32] = l_reg; asm volatile("s_waitcnt lgkmcnt(0)" ::: "memory");
  float rli[16];
#pragma unroll
  for (int r = 0; r < 16; ++r) rli[r] = __builtin_amdgcn_rcpf(li_l[crow(r, hi)]);
  int tid2 = wv * 64 + lane_id_(); asm volatile("" : "+v"(tid2));
  if constexpr (!DIFF) {
    const bool odd = tid2 & 1;
    const unsigned ooff = (unsigned)(((tid2 >> 6) * QBLK + 4 * ((tid2 >> 5) & 1) + (tid2 & 1)) * LDO + (tid2 & 30)) * 2u;
#pragma unroll
    for (int rp = 0; rp < 8; ++rp) { const int orow = ((2 * rp) & 3) + 8 * ((2 * rp) >> 2);
#pragma unroll
      for (int d0 = 0; d0 < 4; ++d0) { const float a_ = o[d0][2 * rp] * rli[2 * rp], b_ = o[d0][2 * rp + 1] * rli[2 * rp + 1];
        const float rc = swz_xor<1>(odd ? a_ : b_);
        *reinterpret_cast<unsigned*>((char*)Ob + ooff + (orow * LDO + d0 * 32) * 2) = odd ? cvtpk(rc, b_) : cvtpk(a_, rc); } }
  } else {
    float* X = (float*)lds + ((tid2 >> 6) & 3) * 4096 + (tid2 & 63);
    __syncthreads();
    if (tid2 >= 256) {
#pragma unroll
      for (int d0 = 0; d0 < 4; ++d0)
#pragma unroll
        for (int r = 0; r < 16; ++r) X[(d0 * 16 + r) * 64] = sink * (o[d0][r] * rli[r]);
    }
    __syncthreads();
    if (tid2 < 256) {
      float g[4];
#pragma unroll
      for (int d0 = 0; d0 < 4; ++d0) g[d0] = gainp[d0 * 32 + (tid2 & 31)];
      const bool odd = tid2 & 1;
      const unsigned ooff = (unsigned)(((tid2 >> 6) * QBLK + 4 * ((tid2 >> 5) & 1) + (tid2 & 1)) * LDO + (tid2 & 30)) * 2u;
#pragma unroll
      for (int rp = 0; rp < 8; ++rp) { const int orow = ((2 * rp) & 3) + 8 * ((2 * rp) >> 2);
        float da[4], db[4], sa = 0.f, sb = 0.f;
#pragma unroll
        for (int d0 = 0; d0 < 4; ++d0) { da[d0] = o[d0][2 * rp] * rli[2 * rp] - X[(d0 * 16 + 2 * rp) * 64]; db[d0] = o[d0][2 * rp + 1] * rli[2 * rp + 1] - X[(d0 * 16 + 2 * rp + 1) * 64]; sa += da[d0] * da[d0]; sb += db[d0] * db[d0]; }
        sa += swz_xor<1>(sa); sa += swz_xor<2>(sa); sa += swz_xor<4>(sa); sa += swz_xor<8>(sa); sa += swz_xor<16>(sa);
        sb += swz_xor<1>(sb); sb += swz_xor<2>(sb); sb += swz_xor<4>(sb); sb += swz_xor<8>(sb); sb += swz_xor<16>(sb);
        const float ra = __builtin_amdgcn_rsqf(sa * (1.0f / 128.0f) + 1e-6f), rb = __builtin_amdgcn_rsqf(sb * (1.0f / 128.0f) + 1e-6f);
#pragma unroll
        for (int d0 = 0; d0 < 4; ++d0) { const float a_ = da[d0] * ra * g[d0], b_ = db[d0] * rb * g[d0];
          const float rc = swz_xor<1>(odd ? a_ : b_);
          *reinterpret_cast<unsigned*>((char*)Ob + ooff + (orow * LDO + d0 * 32) * 2) = odd ? cvtpk(rc, b_) : cvtpk(a_, rc); } }
    }
  }
#undef ATT_KROW
#undef ATT_SLOAD
#undef ATT_SWRITE
#undef ATT_SWAIT
#undef ATT_RESC
#undef ATT_MASK
}
}

__device__ __forceinline__ void p_even_attn(const Frame& F, const Args& a, char* lds) {
    const LocalId L_ = local_id(); (void)L_;
    const bf16* Y1 = (const bf16*)(F.ws + WS_Y1); const bf16* QB = (const bf16*)(F.ws + WS_QB); const bf16* KV = (const bf16*)(F.ws + WS_KV); const bf16* KB = (const bf16*)(F.ws + WS_KB);
    bf16* MIX = (bf16*)(F.ws + WS_MIX);
    const float* t128 = (const float*)(F.ws + WS_ROPE); const float* t64 = (const float*)(F.ws + WS_ROPE + 16384);
    for (int n = blockIdx.x; n < 512 + 64; n += F.G) {
        int b, h, row0, nt, qs0;
        if (n < 512) { const int i = n >> 8, c = n & 255, x = c & 7, lc = c >> 3, gi = i * 8 + x; b = gi >> 1; h = (gi & 1) * 4 + (lc >> 3); qs0 = (lc & 7) * 256; row0 = b * TPB + CTX + qs0; nt = 36; }
        else { const int m = n - 512; b = m >> 3; h = m & 7; row0 = b * TPB; nt = 4; qs0 = -1; }
        const size_t kb = (size_t)b * TPB;
        att::attn_unit<128, false, false, EVEN_IN_P, EVEN_IN_P, EVEN_IN_P, 2, 0, 8, false, 1>(Y1 + (size_t)row0 * EVEN_IN_P + h * 128, Y1 + kb * EVEN_IN_P + 1024 + (h >> 2) * 128, Y1 + kb * EVEN_IN_P + 1280 + (h >> 2) * 128,
                                                                                 MIX + (size_t)row0 * DM + h * 128, nt, 0, 0, 0.08838834764831845f, 0.f, lds, nullptr, a.in[I_AQN], t128, qs0, L_.wave);
    }
    for (int n = blockIdx.x; n < 512 + 64; n += F.G) {
        int b, h, row0, nt, qs0;
        if (n < 512) { const int i = n >> 8, c = n & 255, x = c & 7, lc = c >> 3, gi = i * 8 + x; b = gi >> 1; h = (gi & 1) * 4 + (lc >> 3); qs0 = (lc & 7) * 256; row0 = b * TPB + CTX + qs0; nt = 36; }
        else { const int m = n - 512; b = m >> 3; h = m & 7; row0 = b * TPB; nt = 4; qs0 = -1; }
        const size_t kb = (size_t)b * TPB;
        att::attn_unit<192, false, false, 1536, 1536, 2048, 1, 0, 8, false, 2>(QB + (size_t)row0 * 1536 + h * 192, KB + kb * 1536 + h * 192, KV + kb * 2048 + h * 256 + 128,
                                                                  MIX + (size_t)row0 * DM + 1024 + h * 128, nt, 0, 0, 0.07216878364870322f, 0.f, lds, nullptr, a.in[I_BQN], t64, qs0, L_.wave);
    }
    __syncthreads();
}
__device__ __forceinline__ void p_odd_attn(const Frame& F, const Args& a, char* lds) {
    const LocalId L_ = local_id(); (void)L_;
    const bf16* Y1 = (const bf16*)(F.ws + WS_Y1); bf16* O12 = (bf16*)(F.ws + WS_A1); bf16* MIX = (bf16*)(F.ws + WS_MIX);
#if ATT_DIFF_FUSED
    float d1 = 0.f, d2 = 0.f;
    for (int i = 0; i < 64; ++i) { d1 += a.in[I_LQ1][i] * a.in[I_LK1][i]; d2 += a.in[I_LQ2][i] * a.in[I_LK2][i]; }
    const float lam = expf(d1) - expf(d2) + LAMBDA_INIT;
    const float* gsub = (const float*)(F.ws + WS_ROPE + 32768);
    for (int n = blockIdx.x; n < 1024; n += F.G) {
        const int i = n >> 8, c = n & 255, x = c & 7, lc = c >> 3, gi = i * 8 + x, b = gi >> 2, h = (gi & 3) * 2 + (lc >> 4), row0 = b * TPB + CTX + (lc & 15) * 128;
        const size_t kb = (size_t)b * TPB * ODD_IN;
        att::attn_unit<128, false, false, ODD_IN, ODD_IN, ODD_IN, 2, 0, 8, true, 3>(Y1 + (size_t)row0 * ODD_IN + h * 128, Y1 + kb + 1024 + h * 128, Y1 + kb + 2048 + h * 128,
                                                                             MIX + (size_t)row0 * DM + h * 128, 36, 0, 0, 0.125f, lam, lds, gsub, a.in[I_CQN], (const float*)(F.ws + WS_ROPE + 16384), (lc & 15) * 128, L_.wave);
    }
#else
    for (int n = blockIdx.x; n < 1024; n += F.G) {
        const int i = n >> 8, c = n & 255, x = c & 7, lc = c >> 3, gi = i * 8 + x, b = gi >> 2, ch = (gi & 3) * 4 + (lc >> 3), row0 = b * TPB + CTX + (lc & 7) * 256;
        const size_t kb = (size_t)b * TPB * ODD_IN;
        att::attn_unit<64, false, false, ODD_IN, ODD_IN, ODD_IN, 2, 0, 8>(Y1 + (size_t)row0 * ODD_IN + ch * 64, Y1 + kb + 1024 + ch * 64, Y1 + kb + 2048 + (ch >> 1) * 128,
                                                                       O12 + (size_t)row0 * DM + ch * 128, 36, 0, 0, 0.125f, 0.f, lds, nullptr, nullptr, nullptr, -1, L_.wave);
    }
#endif
    for (int m = blockIdx.x; m < 512; m += F.G) {
        const int i = m >> 8, c = m & 255, x = c & 7, lc = c >> 3, gi = i * 8 + x, b = gi >> 1, kvh = gi & 1, h = kvh * 4 + (lc >> 3), s0 = (lc & 7) * 256, row0 = b * TPB + CTX + s0;
        const int lo = s0 - 128 < 0 ? 0 : s0 - 128, hie = s0 + 384 > SEQ ? SEQ : s0 + 384;
        const size_t kb = (size_t)b * TPB * ODD_IN;
        att::attn_unit<128, true, true, ODD_IN, ODD_IN, ODD_IN, 1, 0, 8, false, 1>(Y1 + (size_t)row0 * ODD_IN + 3072 + h * 128, Y1 + kb + 4096 + kvh * 128, Y1 + kb + 4352 + kvh * 128,
                                                                      MIX + (size_t)row0 * DM + 1024 + h * 128, 4 + (hie - lo) / 64, lo, s0, 0.08838834764831845f, a.in[I_SINK][h], lds, nullptr, a.in[I_DQN], (const float*)(F.ws + WS_ROPE), s0, L_.wave);
    }
    __syncthreads();
}
__device__ __forceinline__ void p_odd_combine(const Frame& F, const Args& a) {
    const LocalId L_ = local_id(); (void)L_;
    const int gw = F.vcu * NWAVES + L_.wave, NGW = F.G * NWAVES;
    const bf16* O12 = (const bf16*)(F.ws + WS_A1); bf16* MIX = (bf16*)(F.ws + WS_MIX);
    float d1 = 0.f, d2 = 0.f;
    for (int i = 0; i < 64; ++i) { d1 += a.in[I_LQ1][i] * a.in[I_LK1][i]; d2 += a.in[I_LQ2][i] * a.in[I_LK2][i]; }
    const float lam = expf(d1) - expf(d2) + LAMBDA_INIT;
    const float g0 = a.in[I_SUBLN][L_.lane] * (1.0f - LAMBDA_INIT), g1 = a.in[I_SUBLN][L_.lane + 64] * (1.0f - LAMBDA_INIT);
    for (int i = gw; i < NB * SEQ; i += NGW) {
        const int b = i / SEQ, row = b * TPB + CTX + (i - b * SEQ);
        const bf16* src = O12 + (size_t)row * DM; bf16* dst = MIX + (size_t)row * DM;
        for (int h = 0; h < 8; ++h) {
            const float x0 = bf2f(src[2 * h * 128 + L_.lane]) - lam * bf2f(src[(2 * h + 1) * 128 + L_.lane]);
            const float x1 = bf2f(src[2 * h * 128 + 64 + L_.lane]) - lam * bf2f(src[(2 * h + 1) * 128 + 64 + L_.lane]);
            const float ss = wave_sum(x0 * x0 + x1 * x1);
            const float r = 1.0f / sqrtf(ss * (1.0f / 128.0f) + NORM_EPS);
            dst[h * 128 + L_.lane] = (bf16)f2bf(x0 * r * g0); dst[h * 128 + 64 + L_.lane] = (bf16)f2bf(x1 * r * g1);
        }
    }
}

__global__ void __launch_bounds__(NWAVES * 64, 2) trunk_fwd(Args args) {
    extern __shared__ __attribute__((aligned(16))) unsigned char lds[];
    Frame F;
    F.lds = (LAS unsigned char*)lds;
    F.MISC = (volatile LAS unsigned*)(F.lds + MISC_OFF);
    F.tid = threadIdx.x; F.lane = F.tid & 63; F.wave = __builtin_amdgcn_readfirstlane(F.tid >> 6);
    F.G = gridDim.x; { const int bx = blockIdx.x; F.vcu = (F.G % 8 == 0) ? (bx % 8) * (F.G / 8) + bx / 8 : bx; }
    F.ws = args.ws; F.ctl = (gu32*)(args.ws + WS_CTL);
    for (int u = F.tid; u < (LDS_BYTES - LDSCTL_OFF) / 4; u += NWAVES * 64) ((LAS unsigned*)(F.lds + LDSCTL_OFF))[u] = 0u;
    __syncthreads();
    XcdBarrier bar; bar.bar = (unsigned*)(F.ctl + CW_BAR); bar.x = 0; bar.st = nullptr;
#if !MK_PER_PHASE
    bar = xcd_barrier_post((unsigned*)(F.ctl + CW_BAR), F.MISC + 8);
#endif
    const int lo = args.ph_lo, hi = args.ph_hi;
#define IN(k) (lo <= (k) && (k) < hi)
#if MK_PER_PHASE
#define SEAM(k) do { } while (0)
#else
#define SEAM(k) do { if (IN(k) && IN((k) + 1)) xcd_barrier(bar); } while (0)
#endif
    bf16* const A1 = (bf16*)(F.ws + WS_A1); bf16* const MIX = (bf16*)(F.ws + WS_MIX); bf16* const H = (bf16*)(F.ws + WS_H); const float* const MOD = (const float*)(F.ws + WS_MOD);
    PG8_LAS unsigned char* const ring = (PG8_LAS unsigned char*)(F.lds + RING_OFF);

#ifndef DUP_PHASE
#define DUP_PHASE (-1)
#endif
#ifndef PROBE_PHASE
#define PROBE_PHASE (-1)
#endif
constexpr size_t WS_DUMMY = 1600 * MiB;
#define PROBE(k, ...) do { if (PROBE_PHASE == (k) && IN(k)) { for (int r_ = 0; r_ < 3; ++r_) { __VA_ARGS__ xcd_barrier(bar); } } } while (0)
#define PH(k, ...) do { if (IN(k)) { __VA_ARGS__ if (DUP_PHASE == (k)) { for (int r_ = 0; r_ < 3; ++r_) { xcd_barrier(bar); __VA_ARGS__ } } } SEAM(k); } while (0)
#define GEMM_STATIC(EPI, Aptr, Bptr, N_, K_, ...) do { pg8::Gemm g{(const bf16*)(Aptr), (const bf16*)(Bptr), (K_), (K_), (K_), nullptr}; pg8::StaticOrder S; S.init(T, (N_), F.G, (int)blockIdx.x); \
        pg8::EPI E{__VA_ARGS__}; pg8::gemm_phase<pg8::EPI, pg8::StaticOrder, false>(ring, g, S, E, F.wave); } while (0)
#ifndef MOE_F32B
#define MOE_F32B 0
#endif
#define GEMM_MOE_F(EPI, GATH, Aptr, M0, M1, ESTR, LDN, COLMUL, HOFF, K_, layer, ...) do { const int nrt = __builtin_amdgcn_readfirstlane(*(const int*)(F.ctl + CW_NRT + (layer) * 64)); \
        pg8::Gemm g{(const bf16*)(Aptr), nullptr, (K_), 0, (K_), (const int*)(F.ctl + CW_SLOT + (layer) * MAXSLOT)}; pg8::BSrc bs{(M0), (M1), (size_t)(ESTR), (LDN), (COLMUL), (HOFF)}; \
        pg8::MoeOrder S; S.init((const int*)(F.ctl + CW_TEXP + (layer) * 256), nrt, F.G, (int)blockIdx.x); \
        pg8::EPI E{__VA_ARGS__}; pg8::gemm_phase_f32b<pg8::EPI, pg8::MoeOrder, GATH>(ring, g, bs, S, E, F.wave); } while (0)
#define GEMM_ORDER(EPI, ORDER, INIT, Aptr, Bptr, K_, ...) do { pg8::Gemm g{(const bf16*)(Aptr), (const bf16*)(Bptr), (K_), (K_), (K_), nullptr}; pg8::ORDER S; S.init INIT; \
        pg8::EPI E{__VA_ARGS__}; pg8::gemm_phase<pg8::EPI, pg8::ORDER, false>(ring, g, S, E, F.wave); } while (0)
#define GEMM_ROUTER_X(Bptr) do { pg8::Gemm g{(const bf16*)A1, (const bf16*)(Bptr), DM, DM, DM / RKS, nullptr}; pg8::SplitKXOrder S; S.init(RKS, DM / RKS, F.G, (int)blockIdx.x); \
        pg8::EpiLogits E{(float*)(ws + WS_LG), DM / RKS, (size_t)T * 64}; pg8::gemm_phase<pg8::EpiLogits, pg8::SplitKXOrder, false>(ring, g, S, E, F.wave); } while (0)
#define GEMM_ROUTER(Bptr) do { pg8::Gemm g{(const bf16*)A1, (const bf16*)(Bptr), DM, DM, DM / RKS, nullptr}; pg8::SplitKOrder S; S.init(T / 256, RKS, DM / RKS, F.G, (int)blockIdx.x); \
        pg8::EpiLogits E{(float*)(ws + WS_LG), DM / RKS, (size_t)T * 64}; pg8::gemm_phase<pg8::EpiLogits, pg8::SplitKOrder, false>(ring, g, S, E, F.wave); } while (0)
#define GEMM_MOE(EPI, GATH, Aptr, Bptr, K_, layer, ...) do { const int nrt = __builtin_amdgcn_readfirstlane(moe_tables(F, (layer), F.wave * 64 + lane_id_())); \
        pg8::Gemm g{(const bf16*)(Aptr), (const bf16*)(Bptr), (K_), (K_), (K_), (const int*)(ws + WS_POS) + (size_t)(layer) * NE * POSCAP}; pg8::MoeOrder S; \
        S.init((const PG8_LAS int*)(F.lds + LDS_TAB), (const PG8_LAS int*)(F.lds + LDS_TAB) + 256, nrt, POSCAP, F.G, (int)blockIdx.x); \
        pg8::EPI E{__VA_ARGS__}; pg8::gemm_phase<pg8::EPI, pg8::MoeOrder, GATH>(ring, g, S, E, F.wave); } while (0)
    unsigned char* const ws = F.ws;
    PH(0, p0_prologue(F, args););
    PH(1, p_l0_mod1(F, args););
#ifdef NEXTRA_BAR
    for (int i_ = 0; i_ < NEXTRA_BAR; ++i_) xcd_barrier(bar);
#endif
    PH(2, GEMM_STATIC(EpiStoreBf16, A1, ws + WS_WE_IN, EVEN_IN_P, DM, (bf16*)(ws + WS_Y1), EVEN_IN_P, 0x7fffffff););
    PROBE(3, p_even_post1(F, args, WS_DUMMY););
    PH(3, p_even_post1(F, args););
    PH(4, GEMM_ORDER(EpiProj2, Proj2Order, (T, F.G, (int)blockIdx.x), ws + WS_CQN, ws + WS_WE_UQ, 512, (bf16*)(ws + WS_QB), (bf16*)(ws + WS_KV)););
    PH(5, p_even_post2(F, args););
#if USE_NAIVE_ATTN
    PH(6, p_even_attn_naive(F););
#else
    PH(6, p_even_attn(F, args, (char*)lds););
#endif
    PH(7, GEMM_STATIC(EpiResidInit, MIX, ws + WS_WE_OUT, DM, DM, H, MOD + (size_t)0 * 9 * 12288 + 2 * 2048, args.in[I_X], args.in[I_CTX]););
#if FUSED_ROUTE
    PH(8, p_mod2_route(F, args, 0););
#else
    PH(8, p_mod2(F, 0););
    PH(9, GEMM_ROUTER(ws + WS_WR););
    PH(10, p_route(F, args, 0););
#endif
#if MOE_F32B
    PH(12, GEMM_MOE_F(EpiSwiGLU, true, A1, args.in[I_WG], args.in[I_WU], 2048 * 1024, 1024, 128, 0, DM, 0, (bf16*)(ws + WS_U), DE););
    PH(13, GEMM_MOE_F(EpiStoreBf16, false, ws + WS_U, args.in[I_WD], args.in[I_WD], 1024 * 2048, 2048, 256, 128, DE, 0, (bf16*)(ws + WS_YS), DM, 7););
#else
    PH(12, GEMM_MOE(EpiSwiGLU, true, A1, ws + WS_WGU, DM, 0, (bf16*)(ws + WS_U), DE););
    PH(13, GEMM_MOE(EpiStoreBf16, false, ws + WS_U, ws + WS_WDN, DE, 0, (bf16*)(ws + WS_YS), DM, 7););
#endif
    PROBE(14, p_l1_mod1(F, WS_DUMMY, WS_DUMMY + 160 * MiB););
    PH(14, p_l1_mod1(F););
    PH(15, GEMM_ORDER(EpiStoreBf16, OddInOrder, (F.G, (int)blockIdx.x), A1, ws + WS_WO_IN, DM, (bf16*)(ws + WS_Y1), ODD_IN, 0x7fffffff););
    PROBE(16, p_odd_post1(F, args, WS_DUMMY););
    PH(16, p_odd_post1(F, args););
#if USE_NAIVE_ATTN
    PH(17, p_odd_attn_naive(F, args););
    PH(18, ;);
#else
    PH(17, p_odd_attn(F, args, (char*)lds););
#if !ATT_DIFF_FUSED
    PH(18, p_odd_combine(F, args););
#endif
#endif
    PH(19, GEMM_ORDER(EpiResid, XOnlyOrder, (DM, F.G, (int)blockIdx.x), MIX, ws + WS_WO_OUT, DM, H, MOD + (size_t)1 * 9 * 12288 + 2 * 2048););
#if FUSED_ROUTE
    PH(20, p_mod2_route(F, args, 1););
#else
    PH(20, p_mod2(F, 1););
    PH(21, GEMM_ROUTER_X((const bf16*)(ws + WS_WR) + (size_t)256 * 2048););
    PH(22, p_route(F, args, 1););
#endif
#if MOE_F32B
    PH(24, GEMM_MOE_F(EpiSwiGLU, true, A1, args.in[I_WG] + (size_t)32 * 2048 * 1024, args.in[I_WU] + (size_t)32 * 2048 * 1024, 2048 * 1024, 1024, 128, 0, DM, 1, (bf16*)(ws + WS_U), DE););
    PH(25, GEMM_MOE_F(EpiStoreBf16, false, ws + WS_U, args.in[I_WD] + (size_t)32 * 1024 * 2048, args.in[I_WD] + (size_t)32 * 1024 * 2048, 1024 * 2048, 2048, 256, 128, DE, 1, (bf16*)(ws + WS_YS), DM, 7););
#else
    PH(24, GEMM_MOE(EpiSwiGLU, true, A1, (const bf16*)(ws + WS_WGU) + (size_t)32 * 2048 * 2048, DM, 1, (bf16*)(ws + WS_U), DE););
    PH(25, GEMM_MOE(EpiStoreBf16, false, ws + WS_U, (const bf16*)(ws + WS_WDN) + (size_t)32 * 2048 * 1024, DE, 1, (bf16*)(ws + WS_YS), DM, 7););
#endif
    PH(26, p_final(F, args.out););
#undef IN
#undef SEAM
}

extern "C" void kernel_launch(void* const* d_in, const int* in_sizes, int n_in, void* d_out, int out_size, void* d_ws, size_t ws_size, hipStream_t stream) {
    static int grid = 0;
    if (grid == 0) {
        if (n_in != 35 || out_size != NB * SEQ * DM || ws_size < WS_END) { fprintf(stderr, "kernel_launch: unexpected shapes: n_in %d out %d ws %zu (need %zu)\n", n_in, out_size, ws_size, (size_t)WS_END); grid = -1; return; }
        int dev = 0, cus = 0, per_cu = 0;
        if (hipGetDevice(&dev) != hipSuccess || hipDeviceGetAttribute(&cus, hipDeviceAttributeMultiprocessorCount, dev) != hipSuccess) { grid = -1; return; }
        if (hipFuncSetAttribute((const void*)trunk_fwd, hipFuncAttributeMaxDynamicSharedMemorySize, LDS_BYTES) != hipSuccess) { fprintf(stderr, "kernel_launch: hipFuncSetAttribute failed\n"); grid = -1; return; }
        if (hipOccupancyMaxActiveBlocksPerMultiprocessor(&per_cu, (const void*)trunk_fwd, NWAVES * 64, LDS_BYTES) != hipSuccess || per_cu < 1)
            fprintf(stderr, "kernel_launch: occupancy query reports %d workgroups per CU\n", per_cu);
        (void)hipGetLastError();
        grid = cus;
    }
    if (grid < 0) return;
    if (hipMemsetAsync((char*)d_ws + WS_CTL, 0, CTL_ZERO_BYTES, stream) != hipSuccess) { fprintf(stderr, "kernel_launch: memset failed\n"); return; }
    if (hipMemsetAsync((char*)d_ws + WS_POS, 0, (size_t)2 * NE * POSCAP * 4, stream) != hipSuccess) { fprintf(stderr, "kernel_launch: memset failed\n"); return; }
    Args a{};
    for (int i = 0; i < 35; ++i) a.in[i] = (const float*)d_in[i];
    a.out = (float*)d_out; a.ws = (unsigned char*)d_ws;
#if MK_PER_PHASE
    for (int p = 0; p < NPHASE; ++p) { a.ph_lo = p; a.ph_hi = p + 1; hipLaunchKernelGGL(trunk_fwd, dim3(grid), dim3(NWAVES * 64), LDS_BYTES, stream, a); }
#else
    a.ph_lo = 0; a.ph_hi = NPHASE; hipLaunchKernelGGL(trunk_fwd, dim3(grid), dim3(NWAVES * 64), LDS_BYTES, stream, a);
#endif
    const hipError_t le = hipPeekAtLastError();
    if (le != hipSuccess) fprintf(stderr, "kernel_launch: launch failed: %s\n", hipGetErrorName(le));
}
```

```cpp
#include <hip/hip_runtime.h>
#include <cstdio>
#include <cstdint>
__device__ __forceinline__ int lane_id_() { return (int)__builtin_amdgcn_mbcnt_hi(~0u, __builtin_amdgcn_mbcnt_lo(~0u, 0u)); }
#define MK_PER_PHASE 0
namespace pg8 {
#define PG8_LAS __attribute__((address_space(3)))
typedef unsigned short bf16_t;
typedef short bf16x8 __attribute__((ext_vector_type(8)));
typedef float f32x4 __attribute__((ext_vector_type(4)));
typedef unsigned u32x4 __attribute__((ext_vector_type(4)));
constexpr int BM = 256, BK = 64, HALF = 128, HTB = HALF * BK * 2  , STAGE_BYTES = 8 * HTB, NXCD = 8, WGM = 8;

__host__ __device__ __forceinline__ int lds_byte(int r, int c) { const int st = (r >> 4) * 2 + (c >> 5), rr = r & 15, cc = c & 31, ob = rr * 64 + cc * 2; return st * 1024 + (ob ^ (((ob >> 9) & 1) << 5)); }
__host__ __device__ __forceinline__ void stage_rc(int b, int& R, int& C) { const int st = b / 1024, sb = b % 1024, swz = sb ^ (((sb >> 9) & 1) << 5); R = (st >> 1) * 16 + swz / 64; C = (st & 1) * 32 + (swz % 64) / 2; }
__host__ __device__ __forceinline__ int perm32(int rho) { const int n = rho >> 4, i = rho & 15; return 8 * (i >> 2) + 4 * n + (i & 3); }

struct Unit { int pm, pn, ko, kt, gb; };
struct Gemm { const bf16_t* A; const bf16_t* Bt; int lda, ldb, K; const int* rowidx; };

struct StaticOrder {
    int nM, nN, nwg, G, c;
    __host__ __device__ void init(int M, int N, int G_, int c_) { nM = M / BM; nN = N / BM; nwg = nM * nN; G = G_; c = c_; }
    __host__ __device__ bool next(int i, Unit& u) const {
        const long L = (long)i * G + c; if (L >= nwg) return false;
        int wgid = (int)L; { const int q = nwg / NXCD, r = nwg % NXCD, xcd = wgid % NXCD, off = wgid / NXCD; wgid = (xcd < r ? xcd * (q + 1) : r * (q + 1) + (xcd - r) * q) + off; }
        const int nig = WGM * nN, gid = wgid / nig, fm = gid * WGM, gsz = (nM - fm) < WGM ? (nM - fm) : WGM;
        u.pm = fm + ((wgid % nig) % gsz); u.pn = (wgid % nig) / gsz; u.ko = 0; u.kt = 0; u.gb = u.pm * BM; return true;
    }
    __device__ __forceinline__ void a_ready(const Unit&) const {}
    __device__ __forceinline__ void done(const Unit&) const {}
};


__device__ __forceinline__ unsigned cvt_pk_bf16(float lo, float hi) { unsigned r; asm volatile("v_cvt_pk_bf16_f32 %0, %1, %2" : "=v"(r) : "v"(lo), "v"(hi)); return r; }

struct EpiStoreBf16 {
    static constexpr bool PERM = true, AFTER_DRAIN = false;
    bf16_t* O; int ldc; int pn_mask;
    __device__ __forceinline__ void operator()(const f32x4 (&acc)[2][2][4][2], const Unit& u, int wr, int wc, int fr, int fq) const {
        const int row0 = u.pm * BM + wr * 64 + fr, col0 = (u.pn & pn_mask) * BM + wc * 32 + 8 * fq;
#pragma unroll
        for (int ai = 0; ai < 2; ++ai)
#pragma unroll
            for (int m = 0; m < 4; ++m) { bf16_t* rowp = O + (size_t)(row0 + ai * HALF + m * 16) * ldc + col0;
#pragma unroll
                for (int bj = 0; bj < 2; ++bj) { const f32x4 v0 = acc[ai][bj][m][0], v1 = acc[ai][bj][m][1];
                    u32x4 w; w.x = cvt_pk_bf16(v0[0], v0[1]); w.y = cvt_pk_bf16(v0[2], v0[3]); w.z = cvt_pk_bf16(v1[0], v1[1]); w.w = cvt_pk_bf16(v1[2], v1[3]);
                    *(u32x4*)(rowp + bj * HALF) = w; } }
    }
};
__device__ __forceinline__ float silu_f(float x) { return x * __builtin_amdgcn_rcpf(1.0f + __builtin_amdgcn_exp2f(-1.4426950408889634f * x)); }
struct EpiSwiGLU {
    static constexpr bool PERM = true, AFTER_DRAIN = false;
    bf16_t* O; int ldc;
    __device__ __forceinline__ void operator()(const f32x4 (&acc)[2][2][4][2], const Unit& u, int wr, int wc, int fr, int fq) const {
        const int row0 = u.pm * BM + wr * 64 + fr, col0 = (u.pn & 7) * HALF + wc * 32 + 8 * fq;
#pragma unroll
        for (int ai = 0; ai < 2; ++ai)
#pragma unroll
            for (int m = 0; m < 4; ++m) { bf16_t* rowp = O + (size_t)(row0 + ai * HALF + m * 16) * ldc + col0;
                const f32x4 g0 = acc[ai][0][m][0], g1 = acc[ai][0][m][1], u0 = acc[ai][1][m][0], u1 = acc[ai][1][m][1];
                u32x4 w; w.x = cvt_pk_bf16(silu_f(g0[0]) * u0[0], silu_f(g0[1]) * u0[1]); w.y = cvt_pk_bf16(silu_f(g0[2]) * u0[2], silu_f(g0[3]) * u0[3]);
                w.z = cvt_pk_bf16(silu_f(g1[0]) * u1[0], silu_f(g1[1]) * u1[1]); w.w = cvt_pk_bf16(silu_f(g1[2]) * u1[2], silu_f(g1[3]) * u1[3]);
                *(u32x4*)rowp = w; }
    }
};
__device__ __forceinline__ float bf_lo(unsigned w) { return __builtin_bit_cast(float, w << 16); }
__device__ __forceinline__ float bf_hi(unsigned w) { return __builtin_bit_cast(float, w & 0xffff0000u); }
struct EpiResid {
    static constexpr bool PERM = true, AFTER_DRAIN = false;
    bf16_t* H; const float* modg;
    __device__ __forceinline__ void operator()(const f32x4 (&acc)[2][2][4][2], const Unit& u, int wr, int wc, int fr, int fq) const {
        const int row0 = u.pm * BM + wr * 64 + fr, col0 = u.pn * BM + wc * 32 + 8 * fq;
        const int j = (u.pm % 9 == 0) ? 8 : (u.pm / 9);
        const float* g = modg + (size_t)j * 12288 + col0;
        f32x4 gv[2][2];
#pragma unroll
        for (int bj = 0; bj < 2; ++bj)
#pragma unroll
            for (int n = 0; n < 2; ++n) gv[bj][n] = *(const f32x4*)(g + bj * HALF + 4 * n);
#pragma unroll
        for (int ai = 0; ai < 2; ++ai)
#pragma unroll
            for (int m = 0; m < 4; ++m) { bf16_t* rowp = H + (size_t)(row0 + ai * HALF + m * 16) * 2048 + col0;
#pragma unroll
                for (int bj = 0; bj < 2; ++bj) { u32x4* p = (u32x4*)(rowp + bj * HALF); const u32x4 h = *p;
                    const f32x4 a0 = gv[bj][0] * acc[ai][bj][m][0], a1 = gv[bj][1] * acc[ai][bj][m][1];
                    u32x4 w; w.x = cvt_pk_bf16(bf_lo(h.x) + a0[0], bf_hi(h.x) + a0[1]); w.y = cvt_pk_bf16(bf_lo(h.y) + a0[2], bf_hi(h.y) + a0[3]);
                    w.z = cvt_pk_bf16(bf_lo(h.z) + a1[0], bf_hi(h.z) + a1[1]); w.w = cvt_pk_bf16(bf_lo(h.w) + a1[2], bf_hi(h.w) + a1[3]);
                    *p = w; } }
    }
};
struct EpiResidInit {
    static constexpr bool PERM = true, AFTER_DRAIN = false;
    bf16_t* H; const float* modg; const float* xin; const float* ctxin;
    __device__ __forceinline__ void operator()(const f32x4 (&acc)[2][2][4][2], const Unit& u, int wr, int wc, int fr, int fq) const {
        const int rl0 = wr * 64 + fr, col0 = u.pn * BM + wc * 32 + 8 * fq;
        const int b = u.pm / 9, t = u.pm - 9 * b, j = (t == 0) ? 8 : b;
        const float* src = (t == 0) ? ctxin + (size_t)(b * 256) * 2048 : xin + (size_t)(b * 2048 + (t - 1) * 256) * 2048;
        const float* g = modg + (size_t)j * 12288 + col0;
        f32x4 gv[2][2];
#pragma unroll
        for (int bj = 0; bj < 2; ++bj)
#pragma unroll
            for (int n = 0; n < 2; ++n) gv[bj][n] = *(const f32x4*)(g + bj * HALF + 4 * n);
#pragma unroll
        for (int ai = 0; ai < 2; ++ai)
#pragma unroll
            for (int m = 0; m < 4; ++m) { const int rl = rl0 + ai * HALF + m * 16; bf16_t* rowp = H + (size_t)(u.pm * BM + rl) * 2048 + col0; const float* srow = src + (size_t)rl * 2048 + col0;
#pragma unroll
                for (int bj = 0; bj < 2; ++bj) { const f32x4 h0 = *(const f32x4*)(srow + bj * HALF), h1 = *(const f32x4*)(srow + bj * HALF + 4);
                    const f32x4 v0 = h0 + gv[bj][0] * acc[ai][bj][m][0], v1 = h1 + gv[bj][1] * acc[ai][bj][m][1];
                    u32x4 w; w.x = cvt_pk_bf16(v0[0], v0[1]); w.y = cvt_pk_bf16(v0[2], v0[3]); w.z = cvt_pk_bf16(v1[0], v1[1]); w.w = cvt_pk_bf16(v1[2], v1[3]);
                    *(u32x4*)(rowp + bj * HALF) = w; } }
    }
};
struct EpiLogits {
    static constexpr bool PERM = false, AFTER_DRAIN = false;
    float* LG; int kslice; size_t slice_stride;
    __device__ __forceinline__ void operator()(const f32x4 (&acc)[2][2][4][2], const Unit& u, int wr, int wc, int fr, int fq) const {
        if (wc >= 2) return;
        const int row0 = u.pm * BM + wr * 64 + fr, col0 = wc * 32 + 4 * fq;
        float* base = LG + (size_t)(u.ko / kslice) * slice_stride;
#pragma unroll
        for (int ai = 0; ai < 2; ++ai)
#pragma unroll
            for (int m = 0; m < 4; ++m) { float* rowp = base + (size_t)(row0 + ai * HALF + m * 16) * 64 + col0;
#pragma unroll
                for (int n = 0; n < 2; ++n) *(f32x4*)(rowp + n * 16) = acc[ai][0][m][n]; }
    }
};
struct SplitKOrder {
    int nM, KS, kslice, G, c;
    __device__ void init(int nM_, int KS_, int kslice_, int G_, int c_) { nM = nM_; KS = KS_; kslice = kslice_; G = G_; c = c_; }
    __device__ bool next(int i, Unit& u) const { const long L = (long)i * G + c; if (L >= (long)nM * KS) return false; const int ks = (int)L / nM; u.pm = (int)L - ks * nM; u.pn = 0; u.ko = ks * kslice; u.kt = 0; u.gb = 0; return true; }
    __device__ __forceinline__ void a_ready(const Unit&) const {}
    __device__ __forceinline__ void done(const Unit&) const {}
};
struct EvenInOrder {
    StaticOrder so; int G, c;
    __device__ void init(int M, int G_, int c_) { so.init(M, 2560, G_, c_); G = G_; c = c_; }
    __device__ bool next(int i, Unit& u) const {
        if (so.next(i, u)) return true;
        const long L = (long)i * G + c - so.nwg; if (L < 0 || L >= 72 * 4) return false;
        const int ks = (int)L / 72; u.pm = (int)L - ks * 72; u.pn = 10; u.ko = ks * 512; u.kt = 8; u.gb = 0; return true;
    }
    __device__ __forceinline__ void a_ready(const Unit&) const {}
    __device__ __forceinline__ void done(const Unit&) const {}
};
struct EpiEvenIn {
    static constexpr bool PERM = true, AFTER_DRAIN = false;
    bf16_t* Y; float* KRP;
    __device__ __forceinline__ void operator()(const f32x4 (&acc)[2][2][4][2], const Unit& u, int wr, int wc, int fr, int fq) const {
        if (u.pn < 10) { const EpiStoreBf16 e{Y, 2816, 0x7fffffff}; e(acc, u, wr, wc, fr, fq); return; }
        if (wc >= 2) return;
        const int row0 = u.pm * BM + wr * 64 + fr, col0 = wc * 32 + 8 * fq;
        float* base = KRP + (size_t)(u.ko >> 9) * ((size_t)18432 * 64);
#pragma unroll
        for (int ai = 0; ai < 2; ++ai)
#pragma unroll
            for (int m = 0; m < 4; ++m) { float* rowp = base + (size_t)(row0 + ai * HALF + m * 16) * 64 + col0;
#pragma unroll
                for (int n = 0; n < 2; ++n) *(f32x4*)(rowp + 4 * n) = acc[ai][0][m][n]; }
    }
};
struct Proj2Order {
    StaticOrder s1, s2; int G, c;
    __device__ void init(int M, int G_, int c_) { s1.init(M, 1536, G_, c_); s2.init(M, 2048, G_, c_); G = G_; c = c_; }
    __device__ bool next(int i, Unit& u) const {
        if (s1.next(i, u)) return true;
        StaticOrder t = s2; const long L = (long)i * G + c - s1.nwg; if (L < 0 || L >= s2.nwg) return false;
        t.G = 1; t.c = (int)L; if (!t.next(0, u)) return false;
        u.pm += 72; u.pn += 8; return true;
    }
    __device__ __forceinline__ void a_ready(const Unit&) const {}
    __device__ __forceinline__ void done(const Unit&) const {}
};
struct EpiProj2 {
    static constexpr bool PERM = true, AFTER_DRAIN = false;
    bf16_t* QB; bf16_t* KV;
    __device__ __forceinline__ void operator()(const f32x4 (&acc)[2][2][4][2], const Unit& u, int wr, int wc, int fr, int fq) const {
        if (u.pm < 72) { const EpiStoreBf16 e{QB, 1536, 0x7fffffff}; e(acc, u, wr, wc, fr, fq); }
        else { Unit v = u; v.pm -= 72; v.pn -= 8; const EpiStoreBf16 e{KV, 2048, 0x7fffffff}; e(acc, v, wr, wc, fr, fq); }
    }
};
struct XOnlyOrder {
    StaticOrder so;
    __device__ void init(int N, int G_, int c_) { so.init(64 * BM, N, G_, c_); }
    __device__ bool next(int i, Unit& u) const { if (!so.next(i, u)) return false; u.pm = 9 * (u.pm >> 3) + 1 + (u.pm & 7); return true; }
    __device__ __forceinline__ void a_ready(const Unit&) const {}
    __device__ __forceinline__ void done(const Unit&) const {}
};
struct OddInOrder {
    StaticOrder so; int G, c;
    __device__ void init(int G_, int c_) { so.init(64 * BM, 18 * BM, G_, c_); G = G_; c = c_; }
    __device__ bool next(int i, Unit& u) const {
        if (so.next(i, u)) { u.pm = 9 * (u.pm >> 3) + 1 + (u.pm & 7); return true; }
        const long L = (long)i * G + c - 64 * 18; if (L >= 80) return false;
        const int b = (int)L / 10, j = (int)L - b * 10; u.pm = 9 * b; u.pn = j < 8 ? 4 + j : 8 + j; u.ko = 0; u.kt = 0; u.gb = 0; return true;
    }
    __device__ __forceinline__ void a_ready(const Unit&) const {}
    __device__ __forceinline__ void done(const Unit&) const {}
};
struct SplitKXOrder {
    int KS, kslice, G, c;
    __device__ void init(int KS_, int kslice_, int G_, int c_) { KS = KS_; kslice = kslice_; G = G_; c = c_; }
    __device__ bool next(int i, Unit& u) const { const long L = (long)i * G + c; if (L >= 64L * KS) return false; const int ks = (int)L / 64, x = (int)L - ks * 64; u.pm = 9 * (x >> 3) + 1 + (x & 7); u.pn = 0; u.ko = ks * kslice; u.kt = 0; u.gb = 0; return true; }
    __device__ __forceinline__ void a_ready(const Unit&) const {}
    __device__ __forceinline__ void done(const Unit&) const {}
};
struct MoeOrder {
    const PG8_LAS int* texp; const PG8_LAS int* frt; int nunits, G, c, cap;
    __device__ void init(const PG8_LAS int* texp_, const PG8_LAS int* frt_, int n_row_tiles, int cap_, int G_, int c_) { texp = texp_; frt = frt_; nunits = n_row_tiles * 8; cap = cap_; G = G_; c = c_; }
    __device__ bool next(int i, Unit& u) const {
        const long L = (long)i * G + c; if (L >= nunits) return false;
        int wgid = (int)L; { const int q = nunits / NXCD, r = nunits % NXCD, xcd = wgid % NXCD, off = wgid / NXCD; wgid = (xcd < r ? xcd * (q + 1) : r * (q + 1) + (xcd - r) * q) + off; }
        const int rt = wgid >> 3, pn = wgid & 7, e = __builtin_amdgcn_readfirstlane(texp[rt]);
        u.pm = rt; u.pn = e * 8 + pn; u.ko = 0; u.kt = 0; u.gb = e * cap + (rt - __builtin_amdgcn_readfirstlane(frt[e])) * BM; return true;
    }
    __device__ __forceinline__ void a_ready(const Unit&) const {}
    __device__ __forceinline__ void done(const Unit&) const {}
};

struct MoePublishOrder : MoeOrder {
    unsigned* ready;
    __device__ __forceinline__ void done(const Unit& u) const {
        asm volatile("s_waitcnt vmcnt(0)" ::: "memory");
        if (lane_id_() == 0) __hip_atomic_fetch_add(ready + 64 * u.pm, 1u, __ATOMIC_RELAXED, __HIP_MEMORY_SCOPE_AGENT);
    }
};
struct MoeCountedOrder : MoeOrder {
    unsigned* ready; unsigned need; unsigned* tmo; int wv;
    __device__ bool next(int i, Unit& u) const {
        const int k0 = (nunits - c + G - 1) / G;
        const long l = (long)c + (long)(k0 + i) * G - nunits; if (l >= nunits) return false;
        int wgid = (int)l; { const int q = nunits / NXCD, r = nunits % NXCD, xcd = wgid % NXCD, off = wgid / NXCD; wgid = (xcd < r ? xcd * (q + 1) : r * (q + 1) + (xcd - r) * q) + off; }
        const int rt = wgid >> 3, pn = wgid & 7, e = __builtin_amdgcn_readfirstlane(texp[rt]);
        u.pm = rt; u.pn = e * 8 + pn; u.ko = 0; u.kt = 0; u.gb = 0; return true;
    }
    __device__ __forceinline__ void a_ready(const Unit& u) const {
        if (wv == 0) {
            const unsigned long long t0 = __builtin_amdgcn_s_memrealtime(); unsigned polls = 0;
            while ((unsigned)__builtin_amdgcn_readfirstlane(__hip_atomic_load(ready + 64 * u.pm, __ATOMIC_RELAXED, __HIP_MEMORY_SCOPE_AGENT)) < need) {
                if ((++polls & 255u) == 0u && __builtin_amdgcn_readfirstlane(__hip_atomic_load(tmo, __ATOMIC_RELAXED, __HIP_MEMORY_SCOPE_AGENT)) != 0u) break;
                if (__builtin_amdgcn_s_memrealtime() - t0 > 2000000ull) {
                    if (lane_id_() == 0) __hip_atomic_store(tmo, 1u, __ATOMIC_RELAXED, __HIP_MEMORY_SCOPE_AGENT);
                    break; }
                __builtin_amdgcn_s_sleep(2); }
            __builtin_amdgcn_fence(__ATOMIC_ACQUIRE, "agent");
            asm volatile("s_waitcnt vmcnt(0)" ::: "memory");
        }
        asm volatile("" ::: "memory"); __builtin_amdgcn_s_barrier(); asm volatile("" ::: "memory");
    }
};
struct EpiSwiGLUwt {
    static constexpr bool PERM = true, AFTER_DRAIN = false;
    bf16_t* O; int ldc;
    __device__ __forceinline__ void operator()(const f32x4 (&acc)[2][2][4][2], const Unit& u, int wr, int wc, int fr, int fq) const {
        const int row0 = u.pm * BM + wr * 64 + fr, col0 = (u.pn & 7) * HALF + wc * 32 + 8 * fq;
        const __amdgpu_buffer_rsrc_t rsrc = __builtin_amdgcn_make_buffer_rsrc((void*)O, 0, 0x7fffffff, 0x00020000);
#pragma unroll
        for (int ai = 0; ai < 2; ++ai)
#pragma unroll
            for (int m = 0; m < 4; ++m) { const unsigned off = (unsigned)(((size_t)(row0 + ai * HALF + m * 16) * ldc + col0) * 2);
                const f32x4 g0 = acc[ai][0][m][0], g1 = acc[ai][0][m][1], u0 = acc[ai][1][m][0], u1 = acc[ai][1][m][1];
                u32x4 w; w.x = cvt_pk_bf16(silu_f(g0[0]) * u0[0], silu_f(g0[1]) * u0[1]); w.y = cvt_pk_bf16(silu_f(g0[2]) * u0[2], silu_f(g0[3]) * u0[3]);
                w.z = cvt_pk_bf16(silu_f(g1[0]) * u1[0], silu_f(g1[1]) * u1[1]); w.w = cvt_pk_bf16(silu_f(g1[2]) * u1[2], silu_f(g1[3]) * u1[3]);
                __builtin_amdgcn_raw_buffer_store_b128(w, rsrc, (int)off, 0, 16  ); }
    }
};
}
namespace pg8 {
template <class Epi, class Sched, bool GATHER = false>
__device__ __forceinline__ void gemm_phase(PG8_LAS unsigned char* lds, const Gemm g, const Sched& S, const Epi& E, int wv) {
    int tid = wv * 64 + lane_id_(); asm volatile("" : "+v"(tid));
    const int wid = __builtin_amdgcn_readfirstlane(tid >> 6), lane = tid & 63, wr = wid >> 2, wc = wid & 3, fr = lane & 15, fq = lane >> 4;
    const int K = g.K, lda = g.lda, ldb = g.ldb;
    unsigned va[2][2], vn[2][2], voffB[2]; int sR[2], sC[2];
#pragma unroll
    for (int i = 0; i < 2; ++i) { int R, C; stage_rc(tid * 16 + i * 8192, R, C); const int Rb = Epi::PERM ? ((R & ~31) + perm32(R & 31)) : R; sR[i] = R; sC[i] = C;
        voffB[i] = (unsigned)(Rb * ldb + C) * 2u;
        va[0][i] = (unsigned)(R * lda + C) * 2u; va[1][i] = (unsigned)((R + HALF) * lda + C) * 2u; vn[0][i] = va[0][i]; vn[1][i] = va[1][i]; }
    const size_t kstep = (size_t)(BK * 2);
    const size_t hstepB = (size_t)HALF * ldb * 2;
    const size_t tstepA = (size_t)BM * lda * 2, tstepB = (size_t)BM * ldb * 2;
    const unsigned ldsw = (unsigned)wid * 1024u;
    const int aoff = lds_byte(wr * 64 + fr, fq * 8), boff = lds_byte(wc * 32 + fr, fq * 8);
#define PG8_SA(b, h) (((b) * 2 + (h)) * HTB)
#define PG8_SB(b, h) ((4 + (b) * 2 + (h)) * HTB)
#define PG8_STAGE(bufoff, gbase, voff) do { _Pragma("unroll") for (int _i = 0; _i < 2; ++_i) \
        __builtin_amdgcn_global_load_lds((const unsigned*)((const char*)(gbase) + (voff)[_i]), (PG8_LAS unsigned*)(lds + (bufoff) + ldsw + _i * 8192), 16, 0, 0); } while (0)
#define PG8_LDA(dst, b, h) do { _Pragma("unroll") for (int m = 0; m < 4; ++m) _Pragma("unroll") for (int k = 0; k < 2; ++k) dst[m][k] = *(const PG8_LAS bf16x8*)(lds + PG8_SA(b, h) + aoff + m * 2048 + k * 1024); } while (0)
#define PG8_LDB(dst, b, h) do { _Pragma("unroll") for (int n = 0; n < 2; ++n) _Pragma("unroll") for (int k = 0; k < 2; ++k) dst[n][k] = *(const PG8_LAS bf16x8*)(lds + PG8_SB(b, h) + boff + n * 2048 + k * 1024); } while (0)
#define PG8_MMA(ai, bj, At, Bt) do { __builtin_amdgcn_s_setprio(1); _Pragma("unroll") for (int m = 0; m < 4; ++m) _Pragma("unroll") for (int n = 0; n < 2; ++n) _Pragma("unroll") for (int k = 0; k < 2; ++k) \
        acc[ai][bj][m][n] = __builtin_amdgcn_mfma_f32_16x16x32_bf16(Bt[n][k], At[m][k], acc[ai][bj][m][n], 0, 0, 0); __builtin_amdgcn_s_setprio(0); } while (0)
#define PG8_WAIT_V(n) asm volatile("s_waitcnt vmcnt(" #n ")" ::: "memory")
#define PG8_WAIT_L(n) asm volatile("s_waitcnt lgkmcnt(" #n ")" ::: "memory")
#define PG8_BAR __builtin_amdgcn_s_barrier()
#define PG8_SCHED __builtin_amdgcn_sched_barrier(0)
#define PG8_GATHER_OFFS(dst, u) do { if constexpr (GATHER) { _Pragma("unroll") for (int _h = 0; _h < 2; ++_h) _Pragma("unroll") for (int _i = 0; _i < 2; ++_i) \
        dst[_h][_i] = (unsigned)(g.rowidx[(u).gb + _h * HALF + sR[_i]] * lda + sC[_i]) * 2u; } } while (0)
    Unit cur, nxt; int ui = 0;
    if (!S.next(0, cur)) return;
    f32x4 acc[2][2][4][2];
#pragma unroll
    for (int a = 0; a < 2; ++a)
#pragma unroll
        for (int b = 0; b < 2; ++b)
#pragma unroll
            for (int m = 0; m < 4; ++m)
#pragma unroll
                for (int n = 0; n < 2; ++n) acc[a][b][m][n] = (f32x4){0.f, 0.f, 0.f, 0.f};
    bf16x8 At[4][2], B0[2][2], B1[2][2];
    const char* cA = (const char*)g.A + (GATHER ? (size_t)0 : (size_t)cur.pm * tstepA) + (size_t)cur.ko * 2; const char* cB = (const char*)g.Bt + (size_t)cur.pn * tstepB + (size_t)cur.ko * 2;
    PG8_GATHER_OFFS(va, cur);
    S.a_ready(cur);
    PG8_STAGE(PG8_SB(0, 0), cB, voffB); PG8_STAGE(PG8_SB(0, 1), cB + hstepB, voffB); PG8_STAGE(PG8_SA(0, 0), cA, va[0]); PG8_STAGE(PG8_SA(0, 1), cA, va[1]);
    if (wr == 1) PG8_BAR;
    PG8_WAIT_V(2); PG8_BAR;
    PG8_STAGE(PG8_SB(1, 0), cB + kstep, voffB); PG8_STAGE(PG8_SA(1, 0), cA + kstep, va[0]); PG8_STAGE(PG8_SB(1, 1), cB + hstepB + kstep, voffB);
    PG8_WAIT_V(6); PG8_BAR;
    for (;;) {
        const bool has_next = S.next(ui + 1, nxt);
        const char* nA = has_next ? (const char*)g.A + (GATHER ? (size_t)0 : (size_t)nxt.pm * tstepA) + (size_t)nxt.ko * 2 : cA; const char* nB = has_next ? (const char*)g.Bt + (size_t)nxt.pn * tstepB + (size_t)nxt.ko * 2 : cB;
        if constexpr (GATHER) { if (has_next) PG8_GATHER_OFFS(vn, nxt); else { _Pragma("unroll") for (int _h = 0; _h < 2; ++_h) _Pragma("unroll") for (int _i = 0; _i < 2; ++_i) vn[_h][_i] = va[_h][_i]; } }
        const int nt = K / BK;
        for (int t = 0; t < nt; t += 2) {
            const bool last = (t == nt - 2);
            const char* a1 = cA + (size_t)(t + 1) * kstep;
            const char* a2 = last ? nA : cA + (size_t)(t + 2) * kstep; const char* b2 = last ? nB : cB + (size_t)(t + 2) * kstep;
            const char* a3 = a2 + kstep; const char* b3 = b2 + kstep;
            unsigned v2[2][2];
#pragma unroll
            for (int _h = 0; _h < 2; ++_h)
#pragma unroll
                for (int _i = 0; _i < 2; ++_i) v2[_h][_i] = (GATHER && last) ? vn[_h][_i] : va[_h][_i];
            if (last && has_next) S.a_ready(nxt);
            PG8_LDB(B0, 0, 0); PG8_LDB(B1, 0, 1); PG8_SCHED; PG8_LDA(At, 0, 0); PG8_STAGE(PG8_SA(1, 1), a1, va[1]);
            PG8_WAIT_V(8); PG8_WAIT_L(0); PG8_BAR; PG8_MMA(0, 0, At, B0); PG8_MMA(0, 1, At, B1); PG8_BAR; PG8_SCHED;
            PG8_LDA(At, 0, 1); PG8_STAGE(PG8_SB(0, 0), b2, voffB); PG8_STAGE(PG8_SB(0, 1), b2 + hstepB, voffB); PG8_STAGE(PG8_SA(0, 0), a2, v2[0]);
            PG8_WAIT_V(8); PG8_WAIT_L(0); PG8_BAR; PG8_MMA(1, 0, At, B0); PG8_MMA(1, 1, At, B1); PG8_BAR; PG8_SCHED;
            PG8_LDB(B0, 1, 0); PG8_LDB(B1, 1, 1); PG8_SCHED; PG8_LDA(At, 1, 0); PG8_STAGE(PG8_SA(0, 1), a2, v2[1]);
            PG8_WAIT_V(8); PG8_WAIT_L(0); PG8_BAR; PG8_MMA(0, 0, At, B0); PG8_MMA(0, 1, At, B1); PG8_BAR; PG8_SCHED;
            PG8_LDA(At, 1, 1); PG8_STAGE(PG8_SB(1, 0), b3, voffB); PG8_STAGE(PG8_SB(1, 1), b3 + hstepB, voffB); PG8_STAGE(PG8_SA(1, 0), a3, v2[0]);
            PG8_WAIT_V(8); PG8_WAIT_L(0); PG8_BAR; PG8_MMA(1, 0, At, B0); PG8_MMA(1, 1, At, B1); PG8_BAR; PG8_SCHED;
        }
        if (wr == 0) PG8_BAR;
        E(acc, cur, wr, wc, fr, fq); S.done(cur);
        if (!has_next) break;
#pragma unroll
        for (int a = 0; a < 2; ++a)
#pragma unroll
            for (int b = 0; b < 2; ++b)
#pragma unroll
                for (int m = 0; m < 4; ++m)
#pragma unroll
                    for (int n = 0; n < 2; ++n) acc[a][b][m][n] = (f32x4){0.f, 0.f, 0.f, 0.f};
        cur = nxt; cA = nA; cB = nB; ++ui;
        if constexpr (GATHER) { _Pragma("unroll") for (int _h = 0; _h < 2; ++_h) _Pragma("unroll") for (int _i = 0; _i < 2; ++_i) va[_h][_i] = vn[_h][_i]; }
        if (wr == 1) PG8_BAR;
    }
    PG8_WAIT_V(0);
    PG8_BAR;
#undef PG8_SA
#undef PG8_SB
#undef PG8_STAGE
#undef PG8_LDA
#undef PG8_LDB
#undef PG8_MMA
#undef PG8_WAIT_V
#undef PG8_WAIT_L
#undef PG8_BAR
#undef PG8_SCHED
#undef PG8_GATHER_OFFS
}
typedef unsigned u32x2 __attribute__((ext_vector_type(2)));
struct BSrc { const float* m0; const float* m1; size_t estride; int ldn, colmul, hoff; };
template <class Epi, class Sched, bool GATHER = false>
__device__ __forceinline__ void gemm_phase_f32b(PG8_LAS unsigned char* lds, const Gemm g, const BSrc bs, const Sched& S, const Epi& E, int wv) {
    int tid = wv * 64 + lane_id_(); asm volatile("" : "+v"(tid));
    const int wid = __builtin_amdgcn_readfirstlane(tid >> 6), lane = tid & 63, wr = wid >> 2, wc = wid & 3, fr = lane & 15, fq = lane >> 4;
    const int K = g.K, lda = g.lda;
    unsigned va00, va01, va10, va11, vn00, vn01, vn10, vn11;
#pragma unroll
    for (int i = 0; i < 2; ++i) { int R, C; stage_rc(tid * 16 + i * 8192, R, C);
        const unsigned o0_ = (unsigned)(R * lda + C) * 2u, o1_ = (unsigned)((R + HALF) * lda + C) * 2u; if (i == 0) { va00 = o0_; va10 = o1_; } else { va01 = o0_; va11 = o1_; } }
    vn00 = va00; vn01 = va01; vn10 = va10; vn11 = va11;
    const size_t kstep = (size_t)(BK * 2);
    const size_t tstepA = (size_t)BM * lda * 2;
    const int kq = lane & 15, nq = (lane >> 4) + 4 * wid;
    const int brow = (nq >> 3) * 32 + (Epi::PERM ? (16 * (nq & 1) + 4 * ((nq & 7) >> 1)) : (4 * (nq & 7)));
    const int bwr = lds_byte(brow, 4 * kq);
    const unsigned bvo = (unsigned)((4 * kq) * bs.ldn + 4 * nq) * 4u;
    const size_t bkstep = (size_t)BK * bs.ldn * 4, brstep = (size_t)bs.ldn * 4;
    f32x4 w0, w1, w2, w3;
    const unsigned ldsw = (unsigned)wid * 1024u;
    const int aoff = lds_byte(wr * 64 + fr, fq * 8), boff = lds_byte(wc * 32 + fr, fq * 8);
#define PG8_SA(b, h) (((b) * 2 + (h)) * HTB)
#define PG8_SB(b, h) ((4 + (b) * 2 + (h)) * HTB)
#define PG8_BLOAD(src) do { const char* p0_ = (const char*)(src); const char* p1_ = p0_ + brstep; const char* p2_ = p1_ + brstep; const char* p3_ = p2_ + brstep; \
        asm volatile("s_nop 4\n\tglobal_load_dwordx4 %0, %4, %5\n\tglobal_load_dwordx4 %1, %4, %6\n\tglobal_load_dwordx4 %2, %4, %7\n\tglobal_load_dwordx4 %3, %4, %8" \
                     : "=&v"(w0), "=&v"(w1), "=&v"(w2), "=&v"(w3) : "v"(bvo), "s"(p0_), "s"(p1_), "s"(p2_), "s"(p3_)); } while (0)
#define PG8_BWAIT(n) asm volatile("s_waitcnt vmcnt(" #n ")" : "+v"(w0), "+v"(w1), "+v"(w2), "+v"(w3))
#define PG8_BWRITE(bufoff) do { PG8_LAS unsigned char* d_ = lds + (bufoff) + bwr; \
        { u32x2 c_; c_.x = cvt_pk_bf16(w0[0], w1[0]); c_.y = cvt_pk_bf16(w2[0], w3[0]); *(PG8_LAS u32x2*)(d_) = c_; } \
        { u32x2 c_; c_.x = cvt_pk_bf16(w0[1], w1[1]); c_.y = cvt_pk_bf16(w2[1], w3[1]); *(PG8_LAS u32x2*)(d_ + 64) = c_; } \
        { u32x2 c_; c_.x = cvt_pk_bf16(w0[2], w1[2]); c_.y = cvt_pk_bf16(w2[2], w3[2]); *(PG8_LAS u32x2*)(d_ + 128) = c_; } \
        { u32x2 c_; c_.x = cvt_pk_bf16(w0[3], w1[3]); c_.y = cvt_pk_bf16(w2[3], w3[3]); *(PG8_LAS u32x2*)(d_ + 192) = c_; } } while (0)
#define PG8_BSRC(u, h) ((const char*)(((h) ? bs.m1 : bs.m0) + (size_t)((u).pn >> 3) * bs.estride + (size_t)((u).pn & 7) * bs.colmul + (h) * bs.hoff) + (size_t)(u).ko * brstep)
#define PG8_STAGE(bufoff, gbase, o0, o1) do { \
        __builtin_amdgcn_global_load_lds((const unsigned*)((const char*)(gbase) + (o0)), (PG8_LAS unsigned*)(lds + (bufoff) + ldsw), 16, 0, 0); \
        __builtin_amdgcn_global_load_lds((const unsigned*)((const char*)(gbase) + (o1)), (PG8_LAS unsigned*)(lds + (bufoff) + ldsw + 8192), 16, 0, 0); } while (0)
#define PG8_LDA(dst, b, h) do { _Pragma("unroll") for (int m = 0; m < 4; ++m) _Pragma("unroll") for (int k = 0; k < 2; ++k) dst[m][k] = *(const PG8_LAS bf16x8*)(lds + PG8_SA(b, h) + aoff + m * 2048 + k * 1024); } while (0)
#define PG8_LDB(dst, b, h) do { _Pragma("unroll") for (int n = 0; n < 2; ++n) _Pragma("unroll") for (int k = 0; k < 2; ++k) dst[n][k] = *(const PG8_LAS bf16x8*)(lds + PG8_SB(b, h) + boff + n * 2048 + k * 1024); } while (0)
#define PG8_MMA(ai, bj, At, Bt) do { __builtin_amdgcn_s_setprio(1); _Pragma("unroll") for (int m = 0; m < 4; ++m) _Pragma("unroll") for (int n = 0; n < 2; ++n) _Pragma("unroll") for (int k = 0; k < 2; ++k) \
        acc[ai][bj][m][n] = __builtin_amdgcn_mfma_f32_16x16x32_bf16(Bt[n][k], At[m][k], acc[ai][bj][m][n], 0, 0, 0); __builtin_amdgcn_s_setprio(0); } while (0)
#define PG8_WAIT_V(n) asm volatile("s_waitcnt vmcnt(" #n ")" ::: "memory")
#define PG8_WAIT_L(n) asm volatile("s_waitcnt lgkmcnt(" #n ")" ::: "memory")
#define PG8_BAR __builtin_amdgcn_s_barrier()
#define PG8_SCHED __builtin_amdgcn_sched_barrier(0)
#define PG8_GATHER_OFFS(d00, d01, d10, d11, u) do { if constexpr (GATHER) { const int* ri_ = g.rowidx + (u).gb; int t_ = wv * 64 + lane_id_(); asm volatile("" : "+v"(t_)); \
        int R0_, C0_, R1_, C1_; stage_rc(t_ * 16, R0_, C0_); stage_rc(t_ * 16 + 8192, R1_, C1_);     \
        d00 = (unsigned)(ri_[R0_] * lda + C0_) * 2u; d01 = (unsigned)(ri_[R1_] * lda + C1_) * 2u; \
        d10 = (unsigned)(ri_[HALF + R0_] * lda + C0_) * 2u; d11 = (unsigned)(ri_[HALF + R1_] * lda + C1_) * 2u; } } while (0)
    Unit cur, nxt; int ui = 0;
    if (!S.next(0, cur)) return;
    f32x4 acc[2][2][4][2];
#pragma unroll
    for (int a = 0; a < 2; ++a)
#pragma unroll
        for (int b = 0; b < 2; ++b)
#pragma unroll
            for (int m = 0; m < 4; ++m)
#pragma unroll
                for (int n = 0; n < 2; ++n) acc[a][b][m][n] = (f32x4){0.f, 0.f, 0.f, 0.f};
    bf16x8 At[4][2], B0[2][2], B1[2][2];
    const char* cA = (const char*)g.A + (GATHER ? (size_t)0 : (size_t)cur.pm * tstepA) + (size_t)cur.ko * 2; const char* cB0 = PG8_BSRC(cur, 0); const char* cB1 = PG8_BSRC(cur, 1);
    PG8_GATHER_OFFS(va00, va01, va10, va11, cur);
    S.a_ready(cur);
    PG8_STAGE(PG8_SA(0, 0), cA, va00, va01); PG8_STAGE(PG8_SA(0, 1), cA, va10, va11);
    PG8_BLOAD(cB0); PG8_BWAIT(0); PG8_BWRITE(PG8_SB(0, 0));
    PG8_BLOAD(cB1); PG8_BWAIT(0); PG8_BWRITE(PG8_SB(0, 1));
    PG8_BLOAD(cB0 + bkstep); PG8_BWAIT(0); PG8_BWRITE(PG8_SB(1, 0));
    PG8_BLOAD(cB1 + bkstep); PG8_STAGE(PG8_SA(1, 0), cA + kstep, va00, va01);
    PG8_WAIT_L(0);
    if (wr == 1) PG8_BAR;
    PG8_BAR;
    PG8_BAR;
    for (;;) {
        const bool has_next = S.next(ui + 1, nxt);
        const char* nA = has_next ? (const char*)g.A + (GATHER ? (size_t)0 : (size_t)nxt.pm * tstepA) + (size_t)nxt.ko * 2 : cA; const char* nB0 = has_next ? PG8_BSRC(nxt, 0) : cB0; const char* nB1 = has_next ? PG8_BSRC(nxt, 1) : cB1;
        const int nt = K / BK;
        for (int t = 0; t < nt; t += 2) {
            const bool last = (t == nt - 2);
            const char* a1 = cA + (size_t)(t + 1) * kstep;
            const char* a2 = last ? nA : cA + (size_t)(t + 2) * kstep;
            const char* b20 = last ? nB0 : cB0 + (size_t)(t + 2) * bkstep; const char* b21 = last ? nB1 : cB1 + (size_t)(t + 2) * bkstep;
            const char* a3 = a2 + kstep; const char* b30 = b20 + bkstep; const char* b31 = b21 + bkstep;
            if constexpr (GATHER) { if (last) { if (has_next) PG8_GATHER_OFFS(vn00, vn01, vn10, vn11, nxt); else { vn00 = va00; vn01 = va01; vn10 = va10; vn11 = va11; } } }
            const bool usen_ = GATHER && last;
            const unsigned v200 = usen_ ? vn00 : va00, v201 = usen_ ? vn01 : va01, v210 = usen_ ? vn10 : va10, v211 = usen_ ? vn11 : va11;
            if (last && has_next) S.a_ready(nxt);
            PG8_LDB(B0, 0, 0); PG8_LDB(B1, 0, 1); PG8_SCHED; PG8_LDA(At, 0, 0);
            PG8_BWAIT(2); PG8_BWRITE(PG8_SB(1, 1)); PG8_BLOAD(b20); PG8_STAGE(PG8_SA(1, 1), a1, va10, va11);
            PG8_WAIT_L(0); PG8_BAR; PG8_MMA(0, 0, At, B0); PG8_MMA(0, 1, At, B1); PG8_BAR; PG8_SCHED;
            PG8_LDA(At, 0, 1);
            PG8_BWAIT(2); PG8_BWRITE(PG8_SB(0, 0)); PG8_BLOAD(b21); PG8_STAGE(PG8_SA(0, 0), a2, v200, v201);
            PG8_WAIT_L(0); PG8_BAR; PG8_MMA(1, 0, At, B0); PG8_MMA(1, 1, At, B1); PG8_BAR; PG8_SCHED;
            PG8_LDB(B0, 1, 0); PG8_LDB(B1, 1, 1); PG8_SCHED; PG8_LDA(At, 1, 0);
            PG8_BWAIT(2); PG8_BWRITE(PG8_SB(0, 1)); PG8_BLOAD(b30); PG8_STAGE(PG8_SA(0, 1), a2, v210, v211);
            PG8_WAIT_L(0); PG8_BAR; PG8_MMA(0, 0, At, B0); PG8_MMA(0, 1, At, B1); PG8_BAR; PG8_SCHED;
            PG8_LDA(At, 1, 1);
            PG8_BWAIT(2); PG8_BWRITE(PG8_SB(1, 0)); PG8_BLOAD(b31); PG8_STAGE(PG8_SA(1, 0), a3, v200, v201);
            PG8_WAIT_L(0); PG8_BAR; PG8_MMA(1, 0, At, B0); PG8_MMA(1, 1, At, B1); PG8_BAR; PG8_SCHED;
        }
        if (wr == 0) PG8_BAR;
        E(acc, cur, wr, wc, fr, fq); S.done(cur);
        if (!has_next) break;
#pragma unroll
        for (int a = 0; a < 2; ++a)
#pragma unroll
            for (int b = 0; b < 2; ++b)
#pragma unroll
                for (int m = 0; m < 4; ++m)
#pragma unroll
                    for (int n = 0; n < 2; ++n) acc[a][b][m][n] = (f32x4){0.f, 0.f, 0.f, 0.f};
        cur = nxt; cA = nA; cB0 = nB0; cB1 = nB1; ++ui;
        if constexpr (GATHER) { va00 = vn00; va01 = vn01; va10 = vn10; va11 = vn11; }
        if (wr == 1) PG8_BAR;
    }
    PG8_WAIT_V(0);
    PG8_BAR;
#undef PG8_SA
#undef PG8_SB
#undef PG8_STAGE
#undef PG8_BLOAD
#undef PG8_BWAIT
#undef PG8_BWRITE
#undef PG8_BSRC
#undef PG8_LDA
#undef PG8_LDB
#undef PG8_MMA
#undef PG8_WAIT_V
#undef PG8_WAIT_L
#undef PG8_BAR
#undef PG8_SCHED
#undef PG8_GATHER_OFFS
}
}

#ifndef PG8_SP2
#define PG8_SP2 true
#endif
#ifndef PG8_ALIGN
#define PG8_ALIGN true
#endif
#ifndef MK_PER_PHASE
#define MK_PER_PHASE 0
#endif

constexpr int NWAVES = 8;
constexpr int DM = 2048, NB = 8, SEQ = 2048, CTX = 256, TPB = CTX + SEQ, T = NB * TPB;
constexpr int EVEN_IN_P = 2816, ODD_IN = 4608;
constexpr int NE = 32, DE = 1024, MAXSLOT = 45056;
constexpr float NORM_EPS = 1e-6f;
constexpr float LAMBDA_INIT = 0.35550906759f;
constexpr int NPHASE = 27;
#ifndef MOE_F32B
#define MOE_F32B 0
#endif
#ifndef KR_IN_POST1
#define KR_IN_POST1 1
#endif
#ifndef MOE_HANDOFF
#define MOE_HANDOFF 0
#endif
#ifndef FUSED_ROUTE
#define FUSED_ROUTE 1
#endif
#ifndef ATT_DIFF_FUSED
#define ATT_DIFF_FUSED 1
#endif
#ifndef BG_CONVERT
#define BG_CONVERT 1
#endif
#ifndef BG_FILL
#define BG_FILL 1
#endif
#ifndef BG_GEFF
#define BG_GEFF 1
#endif
#ifndef USE_NAIVE_ATTN
#define USE_NAIVE_ATTN 0
#endif

constexpr size_t MiB = 1u << 20;
constexpr size_t WS_CTL = 0, CTL_ZERO_BYTES = 1 * MiB;
constexpr size_t WS_MOD = 1 * MiB;
constexpr size_t WS_ROPE = 2 * MiB;
constexpr size_t WS_ROUTE = 3 * MiB;
constexpr size_t WS_WE_IN = 4 * MiB;
constexpr size_t WS_WE_UQ = 15 * MiB;
constexpr size_t WS_WE_UKV = 17 * MiB;
constexpr size_t WS_WE_OUT = 19 * MiB;
constexpr size_t WS_WO_IN = 27 * MiB;
constexpr size_t WS_WO_OUT = 45 * MiB;
constexpr size_t WS_WR = 53 * MiB;
constexpr size_t WS_WGU = 60 * MiB;
constexpr size_t WS_WDN = 572 * MiB;
constexpr size_t WS_H = 828 * MiB;
constexpr size_t WS_A1 = 972 * MiB;
constexpr size_t WS_MIX = 1044 * MiB;
constexpr size_t WS_R = 1116 * MiB;
constexpr size_t WS_Y1 = WS_R;
constexpr size_t WS_CQN = WS_R + 162 * MiB;
constexpr size_t WS_CKVN = WS_R + 180 * MiB;
constexpr size_t WS_QB = WS_R + 198 * MiB;
constexpr size_t WS_KV = WS_R + 252 * MiB;
constexpr size_t WS_KB = WS_R + 324 * MiB;
constexpr size_t WS_XS = WS_R;
constexpr size_t WS_U = WS_R + 176 * MiB;
constexpr size_t WS_YS = WS_R + 264 * MiB;
constexpr size_t WS_LG = WS_R + 440 * MiB;
constexpr size_t WS_POS = WS_R + 460 * MiB;
constexpr int POSCAP = 18432;
constexpr size_t WS_END = WS_R + 466 * MiB;
constexpr int RKS = 4;
constexpr int CW_CNT = 64;
constexpr int CW_NRT = 256;
constexpr int CW_TEXP = 512;
constexpr int CW_BAR = 4096;
constexpr int CW_RDY = 32768;
constexpr int CW_ITEM = 8192;
constexpr int CW_SLOT = 16384;

constexpr int RING_OFF = 0, RING_BYTES = 131072;
constexpr int LDSCTL_OFF = RING_BYTES, MISC_OFF = LDSCTL_OFF + 320;
constexpr int LDS_BYTES = 147456;
constexpr int LDS_TAB = 135168;

#define GAS __attribute__((address_space(1)))
#define LAS __attribute__((address_space(3)))
typedef unsigned short bf16;
typedef unsigned v4u __attribute__((ext_vector_type(4)));
typedef unsigned v2u __attribute__((ext_vector_type(2)));
typedef float f32x4 __attribute__((ext_vector_type(4)));
typedef GAS unsigned gu32;
#define RLX_AGENT __ATOMIC_RELAXED, __HIP_MEMORY_SCOPE_AGENT
#define LDS_WAIT() asm volatile("s_waitcnt lgkmcnt(0)" ::: "memory")
#define VM_WAIT() asm volatile("s_waitcnt vmcnt(0)" ::: "memory")
__device__ __forceinline__ unsigned f2bf(float f) { unsigned u = __builtin_bit_cast(unsigned, f); return (u + 0x7fffu + ((u >> 16) & 1u)) >> 16; }
__device__ __forceinline__ unsigned pk2(float lo, float hi) { return f2bf(lo) | (f2bf(hi) << 16); }
__device__ __forceinline__ float bf2f(unsigned short h) { return __builtin_bit_cast(float, (unsigned)h << 16); }
__device__ __forceinline__ float bflo(unsigned w) { return __builtin_bit_cast(float, w << 16); }
__device__ __forceinline__ float bfhi(unsigned w) { return __builtin_bit_cast(float, w & 0xffff0000u); }
__device__ __forceinline__ float wave_sum(float v) {
#pragma unroll
    for (int o = 1; o < 64; o <<= 1) v += __shfl_xor(v, o);
    return v;
}
__device__ __forceinline__ float wave_max(float v) {
#pragma unroll
    for (int o = 1; o < 64; o <<= 1) v = fmaxf(v, __shfl_xor(v, o));
    return v;
}
#define XB_TMO      128
#define XB_XCNT(j)  (256  + 64 * (j))
#define XB_XSUB(j)  (1280 + 64 * (j))
#define XB_XGEN(j)  (2304 + 64 * (j))
#define XB_TOP      3328
#define XB_TOPGEN   3392
#define XCD_BAR_WORDS 3456
#define XB_SPIN_CAP (1u << 18)

__device__ __forceinline__ unsigned xb_ld(unsigned* p)              { return __hip_atomic_load(p, __ATOMIC_RELAXED, __HIP_MEMORY_SCOPE_AGENT); }
__device__ __forceinline__ unsigned xb_add(unsigned* p, unsigned v) { return __hip_atomic_fetch_add(p, v, __ATOMIC_RELAXED, __HIP_MEMORY_SCOPE_AGENT); }
__device__ __forceinline__ unsigned xb_xcc_id() { return (unsigned)__builtin_amdgcn_s_getreg((3 << 11) | 20) & 0xFu; }
#define XB_SPIN(cond, bar) do { unsigned _sp = 0; while (cond) { __builtin_amdgcn_s_sleep(1); \
    if ((++_sp & 255u) == 0u) { if (xb_ld(&(bar)[XB_TMO])) break; if (_sp > XB_SPIN_CAP) { atomicAdd(&(bar)[XB_TMO], 1u); break; } } } } while (0)

struct XcdBarrier {
    unsigned* bar; unsigned x;
    volatile LAS unsigned* st;
};

__device__ __forceinline__ XcdBarrier xcd_barrier_post(unsigned* bar, volatile LAS unsigned* st) {
    XcdBarrier b; b.bar = bar; b.x = xb_xcc_id(); b.st = st;
    if (threadIdx.x == 0) (void)xb_add(&bar[XB_XCNT(b.x)], 1u);
    return b;
}
__device__ __forceinline__ void xcd_barrier_complete(unsigned* bar, unsigned x, unsigned& nloc, unsigned& nx) {
    const unsigned G = gridDim.x * gridDim.y * gridDim.z;
    unsigned sum, cnt, mine, sp = 0u;
    for (;;) {
        sum = 0u; cnt = 0u; mine = 0u;
#pragma unroll
        for (unsigned j = 0; j < 16; ++j) { const unsigned c = xb_ld(&bar[XB_XCNT(j)]); sum += c; cnt += (c > 0u) ? 1u : 0u; mine = (j == x) ? c : mine; }
        if (sum == G) break;
        __builtin_amdgcn_s_sleep(1);
        if ((++sp & 255u) == 0u) { if (xb_ld(&bar[XB_TMO])) break; if (sp > XB_SPIN_CAP) { atomicAdd(&bar[XB_TMO], 1u); break; } }
    }
    nloc = mine > 0u ? mine : 1u; nx = cnt > 0u ? cnt : 1u;
}

__device__ __forceinline__ void xcd_barrier(const XcdBarrier& b) {
    asm volatile("s_waitcnt vmcnt(0)" ::: "memory");
    __syncthreads();
    if (threadIdx.x == 0) {
        unsigned* bar = b.bar;
        __builtin_amdgcn_s_waitcnt(0);
        unsigned nloc = b.st[0], nx = b.st[1];
        if (nloc == 0u) { xcd_barrier_complete(bar, b.x, nloc, nx); b.st[0] = nloc; b.st[1] = nx; }
        const unsigned old = xb_add(&bar[XB_XSUB(b.x)], 1u);
        const unsigned gen = old / nloc;
        if (old + 1u == (gen + 1u) * nloc) {
            __builtin_amdgcn_fence(__ATOMIC_RELEASE, "agent");
            asm volatile("s_waitcnt vmcnt(0)" ::: "memory");
            const unsigned og = xb_add(&bar[XB_TOP], 1u);
            const unsigned tg = og / nx;
            if (og + 1u == (tg + 1u) * nx) xb_add(&bar[XB_TOPGEN], 1u);
            else XB_SPIN(xb_ld(&bar[XB_TOPGEN]) == tg, bar);
            __builtin_amdgcn_fence(__ATOMIC_ACQUIRE, "agent");
            xb_add(&bar[XB_XGEN(b.x)], 1u);
            asm volatile("s_waitcnt vmcnt(0)" ::: "memory");
        } else {
            XB_SPIN(xb_ld(&bar[XB_XGEN(b.x)]) == gen, bar);
            __builtin_amdgcn_fence(__ATOMIC_ACQUIRE, "agent");
            asm volatile("s_waitcnt vmcnt(0)" ::: "memory");
        }
    }
    __syncthreads();
}

struct Frame {
    LAS unsigned char* lds;
    volatile LAS unsigned* MISC;
    gu32* ctl;
    unsigned char* ws;
    int tid, lane, wave, vcu, G;
};
typedef short bf16x8_t __attribute__((ext_vector_type(8)));
struct LocalId { int tid, lane, wave; };
__device__ __forceinline__ LocalId local_id_w(int wave) { int t = wave * 64 + lane_id_(); asm volatile("" : "+v"(t)); LocalId l; l.tid = t; l.lane = t & 63; l.wave = wave; return l; }
#define local_id() local_id_w(F.wave)
struct Args { const float* in[35]; float* out; unsigned char* ws; int ph_lo, ph_hi; };
enum { I_X = 0, I_C, I_CTX, I_CCTX, I_MODW, I_MODB, I_EWIN, I_EWOUT, I_AQN, I_AKN, I_BCQN, I_BWUQ, I_BCKVN, I_BWUKV, I_BQN, I_BKN, I_OWIN, I_OWOUT,
       I_CQN, I_CKN, I_LQ1, I_LK1, I_LQ2, I_LK2, I_SUBLN, I_DQN, I_DKN, I_SINK, I_WRG, I_BRG, I_WRE, I_BRE, I_WG, I_WU, I_WD };

__device__ __forceinline__ int mod_index(int row) { const int b = row / TPB; return (row - b * TPB) < CTX ? 8 : b; }

__device__ __forceinline__ unsigned cvt_pk_bf16(float lo, float hi) { unsigned r; asm volatile("v_cvt_pk_bf16_f32 %0, %1, %2" : "=v"(r) : "v"(lo), "v"(hi)); return r; }
struct TrAddr { const float* src; bf16* dst; int N, Kd; };
__device__ __forceinline__ void tr_load(f32x4 (&v)[8], const TrAddr& t, int lane) {
    const int kr = lane >> 3, cq = lane & 7;
#pragma unroll
    for (int i = 0; i < 8; ++i) v[i] = *(const f32x4*)(t.src + (size_t)(8 * kr + i) * t.N + 4 * cq);
}
__device__ __forceinline__ void tr_store(const f32x4 (&v)[8], const TrAddr& t, int lane) {
    const int kr = lane >> 3, cq = lane & 7;
#pragma unroll
    for (int e = 0; e < 4; ++e) { v4u o; o.x = cvt_pk_bf16(v[0][e], v[1][e]); o.y = cvt_pk_bf16(v[2][e], v[3][e]); o.z = cvt_pk_bf16(v[4][e], v[5][e]); o.w = cvt_pk_bf16(v[6][e], v[7][e]);
        *(GAS v4u*)(t.dst + (size_t)(4 * cq + e) * t.Kd + 8 * kr) = o; }
}
__device__ __forceinline__ void transpose_item(const float* W, int N, int k0, int n0, bf16* dst, int Kd, LAS float* scr, int lane) {
    (void)scr; TrAddr t; t.src = W + (size_t)k0 * N + n0; t.dst = dst + k0; t.N = N; t.Kd = Kd;
    f32x4 v[8]; tr_load(v, t, lane); tr_store(v, t, lane);
}
__device__ __forceinline__ void small_transpose(const float* W, int K, int N, bf16* WT, int item, LAS float* scr, int lane) {
    const int nblk = N / 32, kb = item / nblk, nb = item - kb * nblk;
    transpose_item(W, N, kb * 64, nb * 32, WT + (size_t)(nb * 32) * K, K, scr, lane);
}
__device__ __forceinline__ TrAddr moe_item_addr(const Frame& F, const Args& a, int r) {
    int le, which, ri;
    if (r < 32 * 3072) { le = r / 3072; const int q = r - le * 3072; which = q >> 10; ri = q & 1023; }
    else if (r < 32 * 3072 + 32 * 2048) { const int r1 = r - 32 * 3072; le = 32 + (r1 >> 11); which = (r1 >> 10) & 1; ri = r1 & 1023; }
    else { const int r2 = r - (32 * 3072 + 32 * 2048); le = 32 + (r2 >> 10); which = 2; ri = r2 & 1023; }
    TrAddr t;
    if (which < 2) { const int kb = ri >> 5, n0 = (ri & 31) * 32;
        t.src = a.in[which == 0 ? I_WG : I_WU] + (size_t)le * 2048 * 1024 + (size_t)(kb * 64) * 1024 + n0; t.N = 1024;
        t.dst = (bf16*)(F.ws + WS_WGU) + (size_t)le * 2048 * 2048 + (size_t)((n0 >> 7) * 256 + which * 128 + (n0 & 127)) * 2048 + kb * 64; t.Kd = 2048;
    } else { const int kb = ri >> 6, n0 = (ri & 63) * 32;
        t.src = a.in[I_WD] + (size_t)le * 1024 * 2048 + (size_t)(kb * 64) * 2048 + n0; t.N = 2048;
        t.dst = (bf16*)(F.ws + WS_WDN) + (size_t)le * 2048 * 1024 + (size_t)n0 * 1024 + kb * 64; t.Kd = 1024; }
    return t;
}
__device__ __forceinline__ void moe_item(const Frame& F, const Args& a, int r, LAS float* scr, int lane) { (void)scr; const TrAddr t = moe_item_addr(F, a, r); f32x4 v[8]; tr_load(v, t, lane); tr_store(v, t, lane); }
__device__ __forceinline__ void p0_prologue(const Frame& F, const Args& a) {
    const LocalId L_ = local_id(); (void)L_;
    const int gt = F.vcu * 512 + L_.tid, NT = F.G * 512;
    {
        float2* t128 = (float2*)(F.ws + WS_ROPE); float2* t64 = (float2*)(F.ws + WS_ROPE + 16384);
        for (int i = gt; i < 3072; i += NT) {
            if (i < 2048) { const int pos = i >> 5, f = i & 31; const float inv = 1.0f / powf(10000.0f, (float)f / 32.0f); const float ang = (float)pos * inv; t128[i] = make_float2(cosf(ang), sinf(ang)); }
            else { const int k = i - 2048, pos = k >> 4, f = k & 15; const float inv = 1.0f / powf(10000.0f, (float)f / 16.0f); const float ang = (float)pos * inv; t64[k] = make_float2(cosf(ang), sinf(ang)); }
        }
    }
    { float* gsub = (float*)(F.ws + WS_ROPE + 32768); for (int i = gt; i < 128; i += NT) gsub[i] = a.in[I_SUBLN][i] * (1.0f - LAMBDA_INIT); }
    {
        bf16* WR = (bf16*)(F.ws + WS_WR);
        for (int i = gt; i < 2 * 256 * 2048; i += NT) { const int l = i >> 19, r = (i >> 11) & 255, k = i & 2047;
            float v = 0.f; if (r < 4) v = a.in[I_WRG][((size_t)l * 2048 + k) * 4 + r]; else if (r < 36) v = a.in[I_WRE][((size_t)l * 2048 + k) * 32 + (r - 4)];
            WR[i] = (bf16)f2bf(v); }
        v4u* z = (v4u*)((bf16*)(F.ws + WS_WE_IN) + (size_t)2624 * 2048);
        for (int i = gt; i < 192 * 2048 / 8; i += NT) z[i] = (v4u){0u, 0u, 0u, 0u};
    }
    {
        LAS float* sl = (LAS float*)(F.lds + RING_OFF);
        LAS float* red = (LAS float*)(F.lds + RING_OFF + 73728);
        for (int i = L_.tid; i < 9 * 2048; i += 512) { const int j = i >> 11, k = i & 2047; const float v = j < 8 ? a.in[I_C][j * 2048 + k] : a.in[I_CCTX][k]; sl[i] = v / (1.0f + expf(-v)); }
        __syncthreads();
        float* MOD = (float*)(F.ws + WS_MOD);
        const int cg = L_.lane & 31, ks = L_.lane >> 5;
        for (int item = blockIdx.x; item < 192; item += F.G) {
            const int layer = item / 96, chunk = item - layer * 96, col0 = chunk * 128;
            const float* W = a.in[I_MODW] + (size_t)layer * 2048 * 12288 + col0 + cg * 4;
            f32x4 acc[9];
#pragma unroll
            for (int j = 0; j < 9; ++j) acc[j] = (f32x4){0.f, 0.f, 0.f, 0.f};
#pragma unroll 8
            for (int it = 0; it < 128; ++it) { const int k = L_.wave * 256 + it * 2 + ks; const f32x4 w = *(const f32x4*)(W + (size_t)k * 12288);
#pragma unroll
                for (int j = 0; j < 9; ++j) { const float s = sl[j * 2048 + k]; acc[j] = acc[j] + w * s; } }
#pragma unroll
            for (int j = 0; j < 9; ++j)
#pragma unroll
                for (int e = 0; e < 4; ++e) { float v = acc[j][e]; v += __shfl_xor(v, 32); acc[j][e] = v; }
            if (L_.lane < 32) {
#pragma unroll
                for (int j = 0; j < 9; ++j)
#pragma unroll
                    for (int e = 0; e < 4; ++e) red[(L_.wave * 9 + j) * 128 + cg * 4 + e] = acc[j][e]; }
            __syncthreads();
            for (int t = L_.tid; t < 9 * 128; t += 512) { const int j = t >> 7, cc = t & 127; float s = a.in[I_MODB][layer * 12288 + col0 + cc];
#pragma unroll
                for (int w = 0; w < 8; ++w) s += red[(w * 9 + j) * 128 + cc];
                MOD[((size_t)layer * 9 + j) * 12288 + col0 + cc] = s; }
            __syncthreads();
        }
    }
    {
        LAS float* scr = (LAS float*)(F.lds + RING_OFF + L_.wave * 16384);
        const int gw = F.vcu * NWAVES + L_.wave, NGW = F.G * NWAVES;
        constexpr int I0 = 32 * 82, I1 = 8 * 48, I2 = 8 * 64, I3 = 32 * 64, I4 = 32 * 144, I5 = 32 * 64, NSMALL = I0 + I1 + I2 + I3 + I4 + I5;
#if MOE_F32B || BG_CONVERT
        constexpr int NMOE = 0;
#else
        constexpr int NMOE = 64 * 3072;
#endif
        for (int it = gw; it < NSMALL + NMOE; it += NGW) {
            int r = it;
            if (r < NSMALL) {
                if (r < I0) { small_transpose(a.in[I_EWIN], 2048, 2624, (bf16*)(F.ws + WS_WE_IN), r, scr, L_.lane); continue; } r -= I0;
                if (r < I1) { small_transpose(a.in[I_BWUQ], 512, 1536, (bf16*)(F.ws + WS_WE_UQ), r, scr, L_.lane); continue; } r -= I1;
                if (r < I2) { small_transpose(a.in[I_BWUKV], 512, 2048, (bf16*)(F.ws + WS_WE_UKV), r, scr, L_.lane); continue; } r -= I2;
                if (r < I3) { small_transpose(a.in[I_EWOUT], 2048, 2048, (bf16*)(F.ws + WS_WE_OUT), r, scr, L_.lane); continue; } r -= I3;
                if (r < I4) { small_transpose(a.in[I_OWIN], 2048, 4608, (bf16*)(F.ws + WS_WO_IN), r, scr, L_.lane); continue; } r -= I4;
                small_transpose(a.in[I_OWOUT], 2048, 2048, (bf16*)(F.ws + WS_WO_OUT), r, scr, L_.lane); continue;
            }
            moe_item(F, a, r - NSMALL, scr, L_.lane);
        }
    }
}

__device__ __forceinline__ void modulate_store(const f32x4 (&v)[8], const float* shift, const float* scale, bf16* orow, int lane) {
    float ss = 0.f;
#pragma unroll
    for (int j = 0; j < 8; ++j) ss += (v[j].x * v[j].x + v[j].y * v[j].y) + (v[j].z * v[j].z + v[j].w * v[j].w);
    ss = wave_sum(ss);
    const float r = 1.0f / sqrtf(ss * (1.0f / 2048.0f) + NORM_EPS);
#pragma unroll
    for (int j = 0; j < 8; ++j) { const f32x4 sh = ((const f32x4*)shift)[lane + 64 * j], sc = ((const f32x4*)scale)[lane + 64 * j];
        const f32x4 y = v[j] * r * (sc + 1.0f) + sh; v2u o; o.x = pk2(y.x, y.y); o.y = pk2(y.z, y.w); ((v2u*)orow)[lane + 64 * j] = o; }
}
__device__ __forceinline__ void moe_combine_load(const bf16* YS, const int* rec, const LAS int* offs, int lane, f32x4 (&y)[8]) {
    const int s0 = offs[rec[0]] + rec[2], s1 = offs[rec[1]] + rec[3]; const float w0 = __builtin_bit_cast(float, rec[4]), w1 = __builtin_bit_cast(float, rec[5]);
    const v2u* p0 = (const v2u*)(YS + (size_t)s0 * 2048); const v2u* p1 = (const v2u*)(YS + (size_t)s1 * 2048);
#pragma unroll
    for (int j = 0; j < 8; ++j) { const v2u a = p0[lane + 64 * j], b = p1[lane + 64 * j];
        y[j].x = w0 * bflo(a.x) + w1 * bflo(b.x); y[j].y = w0 * bfhi(a.x) + w1 * bfhi(b.x); y[j].z = w0 * bflo(a.y) + w1 * bflo(b.y); y[j].w = w0 * bfhi(a.y) + w1 * bfhi(b.y); }
}

__device__ __forceinline__ int moe_tables(const Frame& F, int layer, int tid) {
    LAS int* texp = (LAS int*)(F.lds + LDS_TAB); LAS int* frt = texp + 256; LAS int* offs = frt + 40;
    if (tid < 64) {
        const int e = tid & 31;
        const unsigned c = __hip_atomic_load((unsigned*)(F.ctl + CW_CNT + layer * 64 + e), RLX_AGENT);
        const int pad = (int)((c + 255u) & ~255u);
        int incl = pad;
#pragma unroll
        for (int d = 1; d < 32; d <<= 1) { const int v = __shfl_up(incl, d); if ((tid & 31) >= d) incl += v; }
        const int excl = incl - pad;
        if (tid < 32) { offs[e] = excl; frt[e] = excl >> 8; for (int r = excl >> 8; r < (incl >> 8); ++r) texp[r] = e; if (e == 31) { offs[NE] = incl; frt[NE] = incl >> 8; } }
    }
    __syncthreads();
    return frt[NE];
}
__device__ __forceinline__ void hrow_load(const bf16* hrow, int lane, f32x4 (&v)[8]) {
#pragma unroll
    for (int q = 0; q < 8; ++q) { const v2u w = ((const v2u*)hrow)[lane + 64 * q]; v[q].x = bflo(w.x); v[q].y = bfhi(w.x); v[q].z = bflo(w.y); v[q].w = bfhi(w.y); }
}
__device__ __forceinline__ void hrow_store(bf16* hrow, int lane, const f32x4 (&v)[8]) {
#pragma unroll
    for (int q = 0; q < 8; ++q) { v2u o; o.x = pk2(v[q].x, v[q].y); o.y = pk2(v[q].z, v[q].w); ((v2u*)hrow)[lane + 64 * q] = o; }
}
__device__ __forceinline__ void modulate_store_l(const f32x4 (&v)[8], const LAS float* shift, const LAS float* scale, bf16* orow, int lane) {
    float ss = 0.f;
#pragma unroll
    for (int j = 0; j < 8; ++j) ss += (v[j].x * v[j].x + v[j].y * v[j].y) + (v[j].z * v[j].z + v[j].w * v[j].w);
    ss = wave_sum(ss);
    const float r = 1.0f / sqrtf(ss * (1.0f / 2048.0f) + NORM_EPS);
#pragma unroll
    for (int j = 0; j < 8; ++j) { const f32x4 sh = ((const LAS f32x4*)shift)[lane + 64 * j], sc = ((const LAS f32x4*)scale)[lane + 64 * j];
        const f32x4 y = v[j] * r * (sc + 1.0f) + sh; v2u o; o.x = pk2(y.x, y.y); o.y = pk2(y.z, y.w); ((v2u*)orow)[lane + 64 * j] = o; }
}
__device__ __forceinline__ const float* l0_src_row(const Args& a, int row, int& j) {
    const int b = row / TPB, r = row - b * TPB; j = r < CTX ? 8 : b;
    return r < CTX ? a.in[I_CTX] + (size_t)(b * CTX + r) * DM : a.in[I_X] + (size_t)(b * SEQ + (r - CTX)) * DM;
}
__device__ __forceinline__ void p_l0_mod1(const Frame& F, const Args& a) {
    const LocalId L_ = local_id(); (void)L_;
    const int gw = F.vcu * NWAVES + L_.wave, NGW = F.G * NWAVES;
    const float* MOD = (const float*)(F.ws + WS_MOD); bf16* A1 = (bf16*)(F.ws + WS_A1);
    for (int r0 = gw; r0 < T; r0 += 2 * NGW) {
        const int r1 = r0 + NGW; const bool ok1 = r1 < T;
        int j0, j1 = 0; const float* s0 = l0_src_row(a, r0, j0); const float* s1 = ok1 ? l0_src_row(a, r1, j1) : s0;
        f32x4 v0[8], v1[8];
#pragma unroll
        for (int q = 0; q < 8; ++q) v0[q] = ((const f32x4*)s0)[L_.lane + 64 * q];
#pragma unroll
        for (int q = 0; q < 8; ++q) v1[q] = ((const f32x4*)s1)[L_.lane + 64 * q];
        const float* m0 = MOD + (size_t)(0 * 9 + j0) * 12288;
        modulate_store(v0, m0 + 0 * 2048, m0 + 1 * 2048, A1 + (size_t)r0 * DM, L_.lane);
        if (ok1) {
            const float* m1 = MOD + (size_t)(0 * 9 + j1) * 12288;
            modulate_store(v1, m1 + 0 * 2048, m1 + 1 * 2048, A1 + (size_t)r1 * DM, L_.lane);
        }
    }
}
__device__ __forceinline__ void p_mod2(const Frame& F, int layer) {
    const LocalId L_ = local_id(); (void)L_;
    const int gw = F.vcu * NWAVES + L_.wave, NGW = F.G * NWAVES;
    const float* MOD = (const float*)(F.ws + WS_MOD); const bf16* H = (const bf16*)(F.ws + WS_H); bf16* A1 = (bf16*)(F.ws + WS_A1);
    for (int r0 = gw; r0 < T; r0 += 2 * NGW) {
        const int r1 = r0 + NGW; const int j0 = mod_index(r0), j1 = r1 < T ? mod_index(r1) : 8;
        const bool ok0 = !(layer == 1 && j0 == 8), ok1 = r1 < T && !(layer == 1 && j1 == 8);
        f32x4 v0[8], v1[8];
        if (ok0) hrow_load(H + (size_t)r0 * DM, L_.lane, v0);
        if (ok1) hrow_load(H + (size_t)r1 * DM, L_.lane, v1);
        if (ok0) { const float* m = MOD + (size_t)(layer * 9 + j0) * 12288; modulate_store(v0, m + 3 * 2048, m + 4 * 2048, A1 + (size_t)r0 * DM, L_.lane); }
        if (ok1) { const float* m = MOD + (size_t)(layer * 9 + j1) * 12288; modulate_store(v1, m + 3 * 2048, m + 4 * 2048, A1 + (size_t)r1 * DM, L_.lane); }
    }
}
__device__ __forceinline__ void p_l1_mod1(const Frame& F, size_t hdst_off = WS_H, size_t adst_off = WS_A1) {
    const LocalId L_ = local_id(); (void)L_;
    const float* MOD = (const float*)(F.ws + WS_MOD); const bf16* H = (const bf16*)(F.ws + WS_H); bf16* Hd = (bf16*)(F.ws + hdst_off); bf16* A1 = (bf16*)(F.ws + adst_off);
    const bf16* YS = (const bf16*)(F.ws + WS_YS); const int* ROUTE = (const int*)(F.ws + WS_ROUTE);
    (void)moe_tables(F, 0, L_.tid); const LAS int* offs = (const LAS int*)(F.lds + LDS_TAB) + 296;
    const int RPB = (T + F.G - 1) / F.G, rb0 = F.vcu * RPB < T ? F.vcu * RPB : T, re0 = rb0 + RPB < T ? rb0 + RPB : T;
    LAS float* vec = (LAS float*)(F.lds + RING_OFF);
    for (int rb = rb0; rb < re0 || rb == rb0; rb += 256) {
      const int re = rb + 256 < re0 ? rb + 256 : re0;
      const int jlo = mod_index(rb < T ? rb : T - 1), jhi = mod_index(re > rb ? re - 1 : (rb < T ? rb : T - 1));
      for (int i = L_.tid; i < 2 * 3 * 512; i += 512) { const int st = i / 1536, rem = i - st * 1536, vv = rem >> 9, k = rem & 511; const int j = st ? jhi : jlo;
        const float* src = vv == 0 ? MOD + (size_t)(0 * 9 + j) * 12288 + 5 * 2048 : MOD + (size_t)(1 * 9 + j) * 12288 + (vv - 1) * 2048;
        ((LAS f32x4*)vec)[i] = ((const f32x4*)src)[k]; }
      __syncthreads();
      for (int r0 = rb + 2 * L_.wave; r0 < re; r0 += 16) {
        const int r1 = r0 + 1; const bool ok1 = r1 < re; const int rr1 = ok1 ? r1 : r0;
        const int j0 = mod_index(r0), j1 = mod_index(rr1);
        const LAS float* s0 = vec + (j0 == jlo ? 0 : 3 * 2048); const LAS float* s1 = vec + (j1 == jlo ? 0 : 3 * 2048);
        f32x4 v0[8], v1[8], y0[8], y1[8];
        moe_combine_load(YS, ROUTE + (size_t)r0 * 8, offs, L_.lane, y0);
        moe_combine_load(YS, ROUTE + (size_t)rr1 * 8, offs, L_.lane, y1);
        hrow_load(H + (size_t)r0 * DM, L_.lane, v0);
        hrow_load(H + (size_t)rr1 * DM, L_.lane, v1);
#pragma unroll
        for (int q = 0; q < 8; ++q) { v0[q] = v0[q] + ((const LAS f32x4*)s0)[L_.lane + 64 * q] * y0[q]; v1[q] = v1[q] + ((const LAS f32x4*)s1)[L_.lane + 64 * q] * y1[q]; }
        if (j0 != 8) hrow_store(Hd + (size_t)r0 * DM, L_.lane, v0);
        modulate_store_l(v0, s0 + 2048, s0 + 4096, A1 + (size_t)r0 * DM, L_.lane);
        if (ok1) {
            if (j1 != 8) hrow_store(Hd + (size_t)r1 * DM, L_.lane, v1);
            modulate_store_l(v1, s1 + 2048, s1 + 4096, A1 + (size_t)r1 * DM, L_.lane);
        }
      }
      __syncthreads();
    }
}
__device__ __forceinline__ void p_final(const Frame& F, float* out) {
    const LocalId L_ = local_id(); (void)L_;
    const float* MOD = (const float*)(F.ws + WS_MOD); const bf16* H = (const bf16*)(F.ws + WS_H);
    const bf16* YS = (const bf16*)(F.ws + WS_YS); const int* ROUTE = (const int*)(F.ws + WS_ROUTE);
    (void)moe_tables(F, 1, L_.tid); const LAS int* offs = (const LAS int*)(F.lds + LDS_TAB) + 296;
    constexpr int NX = NB * SEQ;
    const int RPB = (NX + F.G - 1) / F.G, ib0 = F.vcu * RPB < NX ? F.vcu * RPB : NX, ie0 = ib0 + RPB < NX ? ib0 + RPB : NX;
    LAS float* vec = (LAS float*)(F.lds + RING_OFF);
    for (int ib = ib0; ib < ie0 || ib == ib0; ib += 2048) {
      const int ie = ib + 2048 < ie0 ? ib + 2048 : ie0;
      const int blo = (ib < NX ? ib : NX - 1) / SEQ, bhi = (ie > ib ? ie - 1 : (ib < NX ? ib : NX - 1)) / SEQ;
      for (int i = L_.tid; i < 2 * 512; i += 512) { const int st = i >> 9, k = i & 511; const int b = st ? bhi : blo;
        ((LAS f32x4*)vec)[i] = ((const f32x4*)(MOD + (size_t)(1 * 9 + b) * 12288 + 5 * 2048))[k]; }
      __syncthreads();
      for (int i0 = ib + 2 * L_.wave; i0 < ie; i0 += 16) {
        const int i1 = i0 + 1; const bool ok1 = i1 < ie; const int ii1 = ok1 ? i1 : i0;
        const int b0 = i0 / SEQ, row0 = b0 * TPB + CTX + (i0 - b0 * SEQ), b1 = ii1 / SEQ, row1 = b1 * TPB + CTX + (ii1 - b1 * SEQ);
        const LAS float* g0 = vec + (b0 == blo ? 0 : 2048); const LAS float* g1 = vec + (b1 == blo ? 0 : 2048);
        f32x4 y0[8], y1[8], h0[8], h1[8];
        moe_combine_load(YS, ROUTE + (size_t)row0 * 8, offs, L_.lane, y0);
        moe_combine_load(YS, ROUTE + (size_t)row1 * 8, offs, L_.lane, y1);
        hrow_load(H + (size_t)row0 * DM, L_.lane, h0);
        hrow_load(H + (size_t)row1 * DM, L_.lane, h1);
#pragma unroll
        for (int q = 0; q < 8; ++q) ((f32x4*)(out + (size_t)i0 * DM))[L_.lane + 64 * q] = h0[q] + ((const LAS f32x4*)g0)[L_.lane + 64 * q] * y0[q];
        if (ok1) {
#pragma unroll
            for (int q = 0; q < 8; ++q) ((f32x4*)(out + (size_t)i1 * DM))[L_.lane + 64 * q] = h1[q] + ((const LAS f32x4*)g1)[L_.lane + 64 * q] * y1[q]; }
      }
      __syncthreads();
    }
}

__device__ __forceinline__ void head128_norm_rope(const bf16* p, bf16* pd, const float* gain, bool rope, int prow, int pcol, const float2* t128, int lane) {
    const float x0 = bf2f(p[lane]), x1 = bf2f(p[lane + 64]);
    const float ss = wave_sum(x0 * x0 + x1 * x1);
    const float r = 1.0f / sqrtf(ss * (1.0f / 128.0f) + NORM_EPS);
    float y0 = x0 * r * gain[lane], y1 = x1 * r * gain[lane + 64];
    if (rope) {
        const int f = lane & 31; const float2 cr = t128[prow * 32 + f], cc = t128[pcol * 32 + f];
        const float p0 = __shfl_xor(y0, 32), p1 = __shfl_xor(y1, 32); const float sg = (lane & 32) ? 1.0f : -1.0f;
        y0 = y0 * cr.x + sg * p0 * cr.y; y1 = y1 * cc.x + sg * p1 * cc.y;
    }
    pd[lane] = (bf16)f2bf(y0); pd[lane + 64] = (bf16)f2bf(y1);
}
__device__ __forceinline__ float rope64_apply(float y, int prow, int pcol, const float2* t64, int lane) {
    const int f = lane & 15, pos = (lane & 32) ? pcol : prow; const float2 cs = t64[pos * 16 + f];
    const float pr = __shfl_xor(y, 16); const float sg = (lane & 16) ? 1.0f : -1.0f;
    return y * cs.x + sg * pr * cs.y;
}
__device__ __forceinline__ void head64_norm_rope(const bf16* p, bf16* pd, const float* gain, bool rope, int prow, int pcol, const float2* t64, int lane) {
    const float x = bf2f(p[lane]);
    const float ss = wave_sum(x * x);
    const float r = 1.0f / sqrtf(ss * (1.0f / 64.0f) + NORM_EPS);
    float y = x * r * gain[lane];
    if (rope) y = rope64_apply(y, prow, pcol, t64, lane);
    pd[lane] = (bf16)f2bf(y);
}
__device__ __forceinline__ void norm512(const bf16* src, const float* gain, bf16* dst, int lane) {
    const v4u w = ((const v4u*)src)[lane];
    float x[8] = {bflo(w.x), bfhi(w.x), bflo(w.y), bfhi(w.y), bflo(w.z), bfhi(w.z), bflo(w.w), bfhi(w.w)};
    float ss = 0.f;
#pragma unroll
    for (int i = 0; i < 8; ++i) ss += x[i] * x[i];
    ss = wave_sum(ss);
    const float r = 1.0f / sqrtf(ss * (1.0f / 512.0f) + NORM_EPS);
    const f32x4 g0 = ((const f32x4*)gain)[2 * lane], g1 = ((const f32x4*)gain)[2 * lane + 1];
    v4u o; o.x = pk2(x[0] * r * g0.x, x[1] * r * g0.y); o.y = pk2(x[2] * r * g0.z, x[3] * r * g0.w); o.z = pk2(x[4] * r * g1.x, x[5] * r * g1.y); o.w = pk2(x[6] * r * g1.z, x[7] * r * g1.w);
    ((v4u*)dst)[lane] = o;
}

__device__ __forceinline__ void unpack8(const v4u w, float (&x)[8]) { x[0] = bflo(w.x); x[1] = bfhi(w.x); x[2] = bflo(w.y); x[3] = bfhi(w.y); x[4] = bflo(w.z); x[5] = bfhi(w.z); x[6] = bflo(w.w); x[7] = bfhi(w.w); }
__device__ __forceinline__ v4u pack8(const float (&y)[8]) { v4u o; o.x = pk2(y[0], y[1]); o.y = pk2(y[2], y[3]); o.z = pk2(y[4], y[5]); o.w = pk2(y[6], y[7]); return o; }
__device__ __forceinline__ float sumsq8(const float (&x)[8]) { return ((x[0] * x[0] + x[1] * x[1]) + (x[2] * x[2] + x[3] * x[3])) + ((x[4] * x[4] + x[5] * x[5]) + (x[6] * x[6] + x[7] * x[7])); }
template <int GS> __device__ __forceinline__ float group_sum(float v) {
    v += __shfl_xor(v, 1); v += __shfl_xor(v, 2); v += __shfl_xor(v, 4); if (GS == 16) v += __shfl_xor(v, 8); return v;
}
template <int RD> __device__ __forceinline__ void rope8(float (&y)[8], int l, int prow, int pcol, const float2* tab) {
    constexpr int NF = RD / 4, LQ = NF / 8;
    const int quarter = l / LQ, f0 = (l % LQ) * 8, pos = (quarter >= 2) ? pcol : prow;
    const float sg = (quarter & 1) ? 1.0f : -1.0f;
    const f32x4* t = (const f32x4*)(tab + pos * NF + f0);
    const f32x4 c0 = t[0], c1 = t[1], c2 = t[2], c3 = t[3];
    float p[8];
#pragma unroll
    for (int j = 0; j < 8; ++j) p[j] = __shfl_xor(y[j], LQ);
    y[0] = y[0] * c0.x + sg * p[0] * c0.y; y[1] = y[1] * c0.z + sg * p[1] * c0.w; y[2] = y[2] * c1.x + sg * p[2] * c1.y; y[3] = y[3] * c1.z + sg * p[3] * c1.w;
    y[4] = y[4] * c2.x + sg * p[4] * c2.y; y[5] = y[5] * c2.z + sg * p[5] * c2.w; y[6] = y[6] * c3.x + sg * p[6] * c3.y; y[7] = y[7] * c3.z + sg * p[7] * c3.w;
}
template <int DIM> __device__ __forceinline__ v4u head_chunk(const v4u w, const float* gain, bool rope, int prow, int pcol, const float2* tab, int lane) {
    constexpr int GS = DIM / 8; const int l = lane & (GS - 1);
    float x[8]; unpack8(w, x);
    const float ss = group_sum<GS>(sumsq8(x));
    const float r = 1.0f / sqrtf(ss * (1.0f / DIM) + NORM_EPS);
    const f32x4 g0 = ((const f32x4*)gain)[2 * l], g1 = ((const f32x4*)gain)[2 * l + 1];
    x[0] *= r * g0.x; x[1] *= r * g0.y; x[2] *= r * g0.z; x[3] *= r * g0.w; x[4] *= r * g1.x; x[5] *= r * g1.y; x[6] *= r * g1.z; x[7] *= r * g1.w;
    if (rope) rope8<DIM>(x, l, prow, pcol, tab);
    return pack8(x);
}
__device__ __forceinline__ v4u norm512_chunk(const v4u w, const float* gain, int lane) {
    float x[8]; unpack8(w, x);
    const float ss = wave_sum(sumsq8(x));
    const float r = 1.0f / sqrtf(ss * (1.0f / 512.0f) + NORM_EPS);
    const f32x4 g0 = ((const f32x4*)gain)[2 * lane], g1 = ((const f32x4*)gain)[2 * lane + 1];
    x[0] *= r * g0.x; x[1] *= r * g0.y; x[2] *= r * g0.z; x[3] *= r * g0.w; x[4] *= r * g1.x; x[5] *= r * g1.y; x[6] *= r * g1.z; x[7] *= r * g1.w;
    return pack8(x);
}

__device__ __forceinline__ void p_even_post1(const Frame& F, const Args& a, size_t ydst_off = WS_Y1) {
    const LocalId L_ = local_id(); (void)L_;
    const int gw = F.vcu * NWAVES + L_.wave, NGW = F.G * NWAVES, lane = L_.lane;
    const bf16* Y1 = (const bf16*)(F.ws + WS_Y1); bf16* CQN = (bf16*)(F.ws + WS_CQN); bf16* CKVN = (bf16*)(F.ws + WS_CKVN);
    const float2* t128 = (const float2*)(F.ws + WS_ROPE);
    for (int row = gw; row < T; row += NGW) {
        const int b = row / TPB, r = row - b * TPB; const bool xr = r >= CTX; const int s = r - CTX, prow = xr ? (s >> 6) : 0, pcol = xr ? (s & 63) : 0;
        const v4u* y = (const v4u*)(Y1 + (size_t)row * EVEN_IN_P); v4u* yd = (v4u*)((bf16*)(F.ws + ydst_off) + (size_t)row * EVEN_IN_P);
        const v4u k0 = y[128 + (lane & 31)], cq = y[192 + lane], ckv = y[256 + lane];
        const v4u ok0 = head_chunk<128>(k0, a.in[I_AKN], xr, prow, pcol, t128, lane);
        const v4u ocq = norm512_chunk(cq, a.in[I_BCQN], lane), ockv = norm512_chunk(ckv, a.in[I_BCKVN], lane);
        if (lane < 32) yd[128 + lane] = ok0;
        ((v4u*)(CQN + (size_t)row * 512))[lane] = ocq; ((v4u*)(CKVN + (size_t)row * 512))[lane] = ockv;
    }
#if KR_IN_POST1
    {
        constexpr int FPITCH = 4112;
        LAS unsigned char* Fs = F.lds + RING_OFF; LAS float* P = (LAS float*)(F.lds + RING_OFF + 16 * FPITCH + 256);
        const bf16* A1 = (const bf16*)(F.ws + WS_A1); const bf16* WK = (const bf16*)(F.ws + WS_WE_IN) + (size_t)2560 * 2048; bf16* KR = (bf16*)(F.ws + WS_LG);
        const int wave = L_.wave;
        bf16x8_t bfr[4][8];
#pragma unroll
        for (int nb = 0; nb < 4; ++nb)
#pragma unroll
            for (int ks = 0; ks < 8; ++ks) bfr[nb][ks] = *(const bf16x8_t*)(WK + (size_t)(nb * 16 + (lane & 15)) * 2048 + wave * 256 + ks * 32 + (lane >> 4) * 8);
        __syncthreads();
        for (int g = F.vcu; g < T / 16; g += F.G) {
            const int row0 = g * 16;
#pragma unroll
            for (int rr = 0; rr < 2; ++rr) { const int r = 2 * wave + rr; const v4u* src = (const v4u*)(A1 + (size_t)(row0 + r) * DM);
#pragma unroll
                for (int q = 0; q < 4; ++q) *(LAS v4u*)(Fs + r * FPITCH + (lane + 64 * q) * 16) = src[lane + 64 * q]; }
            __syncthreads();
            f32x4 acc[4];
#pragma unroll
            for (int nb = 0; nb < 4; ++nb) acc[nb] = (f32x4){0.f, 0.f, 0.f, 0.f};
#pragma unroll
            for (int ks = 0; ks < 8; ++ks) { const bf16x8_t af = *(const LAS bf16x8_t*)(Fs + (lane & 15) * FPITCH + (wave * 256 + ks * 32 + (lane >> 4) * 8) * 2);
#pragma unroll
                for (int nb = 0; nb < 4; ++nb) acc[nb] = __builtin_amdgcn_mfma_f32_16x16x32_bf16(af, bfr[nb][ks], acc[nb], 0, 0, 0); }
#pragma unroll
            for (int nb = 0; nb < 4; ++nb)
#pragma unroll
                for (int rg = 0; rg < 4; ++rg) P[(wave * 16 + 4 * (lane >> 4) + rg) * 64 + nb * 16 + (lane & 15)] = acc[nb][rg];
            __syncthreads();
#pragma unroll
            for (int o = 0; o < 2; ++o) { const int idx = L_.tid + 512 * o, r = idx >> 6, c = idx & 63; float sacc = 0.f;
#pragma unroll
                for (int w = 0; w < 8; ++w) sacc += P[(w * 16 + r) * 64 + c];
                KR[(size_t)(row0 + r) * 64 + c] = (bf16)f2bf(sacc); }
            __syncthreads();
        }
    }
#endif
}
__device__ __forceinline__ void p_even_post2(const Frame& F, const Args& a, size_t qdst_off = WS_QB, size_t kdst_off = WS_KB) {
    const LocalId L_ = local_id(); (void)L_;
    const int gw = F.vcu * NWAVES + L_.wave, NGW = F.G * NWAVES, lane = L_.lane;
    const bf16* Y1 = (const bf16*)(F.ws + WS_Y1); const bf16* QB = (const bf16*)(F.ws + WS_QB); const bf16* KV = (const bf16*)(F.ws + WS_KV);
    bf16* KB = (bf16*)(F.ws + kdst_off); bf16* QBd = (bf16*)(F.ws + qdst_off);
    const float2* t64 = (const float2*)(F.ws + WS_ROPE + 16384);
    const float* gq = a.in[I_BQN]; const float* gk = a.in[I_BKN]; const float* KRP = (const float*)(F.ws + WS_LG);
    const int l16 = lane & 15, l8 = lane & 7, hn = lane >> 4, hr = lane >> 3;
    const f32x4 gqn0 = ((const f32x4*)gq)[2 * l16], gqn1 = ((const f32x4*)gq)[2 * l16 + 1], gqr0 = ((const f32x4*)(gq + 128))[2 * l8], gqr1 = ((const f32x4*)(gq + 128))[2 * l8 + 1];
    const f32x4 gkn0 = ((const f32x4*)gk)[2 * l16], gkn1 = ((const f32x4*)gk)[2 * l16 + 1], gkr0 = ((const f32x4*)(gk + 128))[2 * l8], gkr1 = ((const f32x4*)(gk + 128))[2 * l8 + 1];
    for (int row = gw; row < T; row += NGW) {
        const int b = row / TPB, r = row - b * TPB; const bool xr = r >= CTX; const int s = r - CTX, prow = xr ? (s >> 6) : 0, pcol = xr ? (s & 63) : 0;
        const bf16* q = QB + (size_t)row * 1536; const bf16* kv = KV + (size_t)row * 2048;
        const v4u wk0 = *(const v4u*)(kv + hn * 256 + l16 * 8), wk1 = *(const v4u*)(kv + (hn + 4) * 256 + l16 * 8);
#if KR_IN_POST1
        const v4u wkr = *(const v4u*)((const bf16*)(F.ws + WS_LG) + (size_t)row * 64 + l8 * 8);
#else
        const v4u wkr = *(const v4u*)(Y1 + (size_t)row * EVEN_IN_P + 2560 + l8 * 8);
#endif
#define POST2_ONE(W0, W1, WR, GN0, GN1, GR0, GR1, DST) do { \
        float x0[8], x1[8], xr_[8]; unpack8(W0, x0); unpack8(W1, x1); unpack8(WR, xr_); \
        const float n0 = group_sum<16>(sumsq8(x0)), n1 = group_sum<16>(sumsq8(x1)), rs = group_sum<8>(sumsq8(xr_));     \
        const float rs0 = __shfl(rs, 8 * hn), rs1 = __shfl(rs, 8 * (hn + 4));                                         \
        const float t0 = __shfl(n0, 16 * (hr & 3)), t1 = __shfl(n1, 16 * (hr & 3)); const float nr = (hr >> 2) ? t1 : t0;    \
        const float r0 = 1.0f / sqrtf((n0 + rs0) * (1.0f / 192.0f) + NORM_EPS), r1 = 1.0f / sqrtf((n1 + rs1) * (1.0f / 192.0f) + NORM_EPS), rr = 1.0f / sqrtf((nr + rs) * (1.0f / 192.0f) + NORM_EPS); \
        x0[0] *= r0 * GN0.x; x0[1] *= r0 * GN0.y; x0[2] *= r0 * GN0.z; x0[3] *= r0 * GN0.w; x0[4] *= r0 * GN1.x; x0[5] *= r0 * GN1.y; x0[6] *= r0 * GN1.z; x0[7] *= r0 * GN1.w; \
        x1[0] *= r1 * GN0.x; x1[1] *= r1 * GN0.y; x1[2] *= r1 * GN0.z; x1[3] *= r1 * GN0.w; x1[4] *= r1 * GN1.x; x1[5] *= r1 * GN1.y; x1[6] *= r1 * GN1.z; x1[7] *= r1 * GN1.w; \
        xr_[0] *= rr * GR0.x; xr_[1] *= rr * GR0.y; xr_[2] *= rr * GR0.z; xr_[3] *= rr * GR0.w; xr_[4] *= rr * GR1.x; xr_[5] *= rr * GR1.y; xr_[6] *= rr * GR1.z; xr_[7] *= rr * GR1.w; \
        if (xr) rope8<64>(xr_, l8, prow, pcol, t64); \
        *(v4u*)((DST) + hn * 192 + l16 * 8) = pack8(x0); *(v4u*)((DST) + (hn + 4) * 192 + l16 * 8) = pack8(x1); *(v4u*)((DST) + hr * 192 + 128 + l8 * 8) = pack8(xr_); } while (0)
        POST2_ONE(wk0, wk1, wkr, gkn0, gkn1, gkr0, gkr1, KB + (size_t)row * 1536);
#undef POST2_ONE
    }
}
__device__ __forceinline__ void p_odd_post1(const Frame& F, const Args& a, size_t ydst_off = WS_Y1) {
    const LocalId L_ = local_id(); (void)L_;
    const int gw = F.vcu * NWAVES + L_.wave, NGW = F.G * NWAVES, lane = L_.lane;
    const bf16* Y1 = (const bf16*)(F.ws + WS_Y1);
    const float2* t128 = (const float2*)(F.ws + WS_ROPE); const float2* t64 = (const float2*)(F.ws + WS_ROPE + 16384);
    for (int row = gw; row < T; row += NGW) {
        const int b = row / TPB, r = row - b * TPB; const bool xr = r >= CTX; const int s = r - CTX, prow = xr ? (s >> 6) : 0, pcol = xr ? (s & 63) : 0;
        const v4u* y = (const v4u*)(Y1 + (size_t)row * ODD_IN); v4u* yd = (v4u*)((bf16*)(F.ws + ydst_off) + (size_t)row * ODD_IN);
        const v4u kc0 = y[128 + lane], kc1 = y[192 + lane], kd0 = y[512 + (lane & 31)];
        const v4u p0 = head_chunk<64>(kc0, a.in[I_CKN], xr, prow, pcol, t64, lane), p1 = head_chunk<64>(kc1, a.in[I_CKN], xr, prow, pcol, t64, lane);
        const v4u p2 = head_chunk<128>(kd0, a.in[I_DKN], xr, prow, pcol, t128, lane);
        yd[128 + lane] = p0; yd[192 + lane] = p1; if (lane < 32) yd[512 + lane] = p2;
    }
}

__device__ __forceinline__ void p_route(const Frame& F, const Args& a, int layer) {
    const LocalId L_ = local_id(); (void)L_;
    const float* LG = (const float*)(F.ws + WS_LG); int* ROUTE = (int*)(F.ws + WS_ROUTE);
    unsigned* cnt = (unsigned*)(F.ctl + CW_CNT + layer * 64);
    const float* brg = a.in[I_BRG] + layer * 4; const float* bre = a.in[I_BRE] + layer * 32;
    const int NT = F.G * 512;
    for (int base = F.vcu * 512 + L_.wave * 64; base < T; base += NT) {
        const int t = base + L_.lane;
        bool valid = t < T; if (valid && layer == 1) valid = (t % TPB) >= CTX;
        int e0 = -1, e1 = -1; float w0 = 0.f, w1 = 0.f;
        if (valid) {
            const float* lg = LG + (size_t)t * 64;
            float g[4]; for (int i = 0; i < 4; ++i) { float v = brg[i]; for (int ks = 0; ks < RKS; ++ks) v += lg[(size_t)ks * T * 64 + i]; g[i] = v; }
            int gi = 0; float gm = g[0]; for (int i = 1; i < 4; ++i) if (g[i] > gm) { gm = g[i]; gi = i; }
            float den = 0.f; for (int i = 0; i < 4; ++i) den += expf(g[i] - gm);
            const float ptop = 1.0f / den;
            float el[8]; for (int i = 0; i < 8; ++i) { float v = bre[gi * 8 + i]; for (int ks = 0; ks < RKS; ++ks) v += lg[(size_t)ks * T * 64 + 4 + gi * 8 + i]; el[i] = v; }
            int i1 = 0; float l1 = el[0]; for (int i = 1; i < 8; ++i) if (el[i] > l1) { l1 = el[i]; i1 = i; }
            int i2 = -1; float l2 = -3.0e38f; for (int i = 0; i < 8; ++i) if (i != i1 && el[i] > l2) { l2 = el[i]; i2 = i; }
            const float ex = expf(l2 - l1), inv = 1.0f / (1.0f + ex);
            w0 = ptop * inv; w1 = ptop * ex * inv; e0 = gi * 8 + i1; e1 = gi * 8 + i2;
        }
        int pos0 = 0, pos1 = 0;
        const unsigned long long lt = (1ull << L_.lane) - 1ull;
        for (int e = 0; e < NE; ++e) {
            const unsigned long long m0 = __ballot(e0 == e), m1 = __ballot(e1 == e);
            const int n0 = __popcll(m0), n1 = __popcll(m1);
            if (n0 + n1 == 0) continue;
            unsigned basev = 0;
            if (L_.lane == 0) basev = __hip_atomic_fetch_add(cnt + e, (unsigned)(n0 + n1), RLX_AGENT);
            basev = (unsigned)__builtin_amdgcn_readfirstlane((int)basev);
            if (e0 == e) pos0 = (int)basev + __popcll(m0 & lt);
            if (e1 == e) pos1 = (int)basev + n0 + __popcll(m1 & lt);
        }
        if (valid) { int* rec = ROUTE + (size_t)t * 8; rec[0] = e0; rec[1] = e1; rec[2] = pos0; rec[3] = pos1; rec[4] = __builtin_bit_cast(int, w0); rec[5] = __builtin_bit_cast(int, w1); }
    }
}
__device__ __forceinline__ void p_mod2_route(const Frame& F, const Args& a, int layer) {
    const LocalId L_ = local_id(); (void)L_;
    const int lane = L_.lane, wave = L_.wave;
    constexpr int FPITCH = 4112;
    LAS unsigned char* Fs = F.lds + RING_OFF; LAS float* P = (LAS float*)(F.lds + RING_OFF + 16 * FPITCH + 256);
    const float* MOD = (const float*)(F.ws + WS_MOD); const bf16* H = (const bf16*)(F.ws + WS_H); bf16* A1 = (bf16*)(F.ws + WS_A1);
    const bf16* WR = (const bf16*)(F.ws + WS_WR) + (size_t)layer * 256 * 2048;
    int* ROUTE = (int*)(F.ws + WS_ROUTE); unsigned* cnt = (unsigned*)(F.ctl + CW_CNT + layer * 64); int* postok = (int*)(F.ws + WS_POS) + (size_t)layer * NE * POSCAP;
    const float* brg = a.in[I_BRG] + layer * 4; const float* bre = a.in[I_BRE] + layer * 32;
    bf16x8_t bfr[3][8];
#pragma unroll
    for (int nb = 0; nb < 3; ++nb)
#pragma unroll
        for (int ks = 0; ks < 8; ++ks) bfr[nb][ks] = *(const bf16x8_t*)(WR + (size_t)(nb * 16 + (lane & 15)) * 2048 + wave * 256 + ks * 32 + (lane >> 4) * 8);
    const int NG = layer == 1 ? NB * SEQ / 16 : T / 16;
    int it = 0;
    for (int g = F.vcu; g < NG; g += F.G, ++it) {
        int row0; if (layer == 1) { const int b = g >> 7; row0 = b * TPB + CTX + (g & 127) * 16; } else row0 = g * 16;
        const int j = mod_index(row0);
        const float* m = MOD + (size_t)(layer * 9 + j) * 12288;
        f32x4 v0[8], v1[8];
        const int r0 = 2 * wave, r1 = r0 + 1;
        hrow_load(H + (size_t)(row0 + r0) * DM, lane, v0);
        hrow_load(H + (size_t)(row0 + r1) * DM, lane, v1);
#define M2R_ROW(V, R) do { float ss = 0.f; \
        _Pragma("unroll") for (int q = 0; q < 8; ++q) ss += (V[q].x * V[q].x + V[q].y * V[q].y) + (V[q].z * V[q].z + V[q].w * V[q].w); \
        ss = wave_sum(ss); const float rn = 1.0f / sqrtf(ss * (1.0f / 2048.0f) + NORM_EPS); \
        _Pragma("unroll") for (int q = 0; q < 8; ++q) { const f32x4 sh = ((const f32x4*)(m + 3 * 2048))[lane + 64 * q], sc = ((const f32x4*)(m + 4 * 2048))[lane + 64 * q]; \
            const f32x4 y = V[q] * rn * (sc + 1.0f) + sh; v2u o; o.x = pk2(y.x, y.y); o.y = pk2(y.z, y.w); \
            ((v2u*)(A1 + (size_t)(row0 + (R)) * DM))[lane + 64 * q] = o; *(LAS v2u*)(Fs + (R) * FPITCH + (lane + 64 * q) * 8) = o; } } while (0)
        M2R_ROW(v0, r0); M2R_ROW(v1, r1);
#undef M2R_ROW
        __syncthreads();
        f32x4 acc[3];
#pragma unroll
        for (int nb = 0; nb < 3; ++nb) acc[nb] = (f32x4){0.f, 0.f, 0.f, 0.f};
#pragma unroll
        for (int ks = 0; ks < 8; ++ks) { const bf16x8_t af = *(const LAS bf16x8_t*)(Fs + (lane & 15) * FPITCH + (wave * 256 + ks * 32 + (lane >> 4) * 8) * 2);
#pragma unroll
            for (int nb = 0; nb < 3; ++nb) acc[nb] = __builtin_amdgcn_mfma_f32_16x16x32_bf16(af, bfr[nb][ks], acc[nb], 0, 0, 0); }
        LAS float* Pb = P + (it & 1) * (8 * 16 * 48);
#pragma unroll
        for (int nb = 0; nb < 3; ++nb)
#pragma unroll
            for (int rg = 0; rg < 4; ++rg) Pb[(wave * 16 + 4 * (lane >> 4) + rg) * 48 + nb * 16 + (lane & 15)] = acc[nb][rg];
        __syncthreads();
        if (wave == 0) {
            const bool valid = lane < 16; const int t = row0 + (lane & 15);
            int e0 = -1, e1 = -1; float w0 = 0.f, w1 = 0.f;
            if (valid) {
                const LAS float* pr = Pb + lane * 48;
                float gg[4];
#pragma unroll
                for (int i = 0; i < 4; ++i) { float sacc = brg[i];
#pragma unroll
                    for (int w = 0; w < 8; ++w) sacc += pr[w * 768 + i];
                    gg[i] = sacc; }
                int gi = 0; float gm = gg[0];
#pragma unroll
                for (int i = 1; i < 4; ++i) if (gg[i] > gm) { gm = gg[i]; gi = i; }
                float den = 0.f;
#pragma unroll
                for (int i = 0; i < 4; ++i) den += expf(gg[i] - gm);
                const float ptop = 1.0f / den;
                float el[8];
#pragma unroll
                for (int i = 0; i < 8; ++i) { float sacc = bre[gi * 8 + i];
#pragma unroll
                    for (int w = 0; w < 8; ++w) sacc += pr[w * 768 + 4 + gi * 8 + i];
                    el[i] = sacc; }
                int i1 = 0; float l1 = el[0];
#pragma unroll
                for (int i = 1; i < 8; ++i) if (el[i] > l1) { l1 = el[i]; i1 = i; }
                int i2 = -1; float l2 = -3.0e38f;
#pragma unroll
                for (int i = 0; i < 8; ++i) if (i != i1 && el[i] > l2) { l2 = el[i]; i2 = i; }
                const float ex = expf(l2 - l1), inv = 1.0f / (1.0f + ex);
                w0 = ptop * inv; w1 = ptop * ex * inv; e0 = gi * 8 + i1; e1 = gi * 8 + i2;
            }
            int rank0 = 0, rank1 = 0, mycnt = 0;
            const unsigned long long lt = (1ull << lane) - 1ull;
            for (int e = 0; e < NE; ++e) {
                const unsigned long long m0 = __ballot(e0 == e), m1 = __ballot(e1 == e);
                const int n0 = __popcll(m0), n1 = __popcll(m1);
                if (lane == e) mycnt = n0 + n1;
                if (e0 == e) rank0 = __popcll(m0 & lt);
                if (e1 == e) rank1 = n0 + __popcll(m1 & lt);
            }
            int basev = 0;
            if (lane < NE && mycnt > 0) basev = (int)__hip_atomic_fetch_add(cnt + lane, (unsigned)mycnt, RLX_AGENT);
            const int pos0 = __shfl(basev, e0 & 31) + rank0, pos1 = __shfl(basev, e1 & 31) + rank1;
            if (valid) { int* rec = ROUTE + (size_t)t * 8; rec[0] = e0; rec[1] = e1; rec[2] = pos0; rec[3] = pos1; rec[4] = __builtin_bit_cast(int, w0); rec[5] = __builtin_bit_cast(int, w1);
                         postok[(size_t)e0 * POSCAP + pos0] = t; postok[(size_t)e1 * POSCAP + pos1] = t; }
        }
    }
    __syncthreads();
}
__device__ __forceinline__ void p_gather(const Frame& F, int layer) {
    const LocalId L_ = local_id(); (void)L_;
    LAS int* offs = (LAS int*)(F.lds + RING_OFF);
    if (L_.tid == 0) { int o = 0; for (int e = 0; e < NE; ++e) { offs[e] = o; const unsigned c = __hip_atomic_load((unsigned*)(F.ctl + CW_CNT + layer * 64 + e), RLX_AGENT); o += (int)((c + 255u) & ~255u); } offs[NE] = o; }
    __syncthreads();
    if (blockIdx.x == 0 && L_.tid < NE) { const int e = L_.tid; int* texp = (int*)(F.ctl + CW_TEXP + layer * 256);
        for (int r = offs[e] >> 8; r < (offs[e + 1] >> 8); ++r) texp[r] = e;
        if (e == 0) *(int*)(F.ctl + CW_NRT + layer * 64) = offs[NE] >> 8; }
    int* ROUTE = (int*)(F.ws + WS_ROUTE); int* slot_tok = (int*)(F.ctl + CW_SLOT + layer * MAXSLOT);
    for (int t = F.vcu * 512 + L_.tid; t < T; t += F.G * 512) {
        if (layer == 1 && (t % TPB) < CTX) continue;
        int* rec = ROUTE + (size_t)t * 8;
        const int s0 = offs[rec[0]] + rec[2], s1 = offs[rec[1]] + rec[3];
        slot_tok[s0] = t; slot_tok[s1] = t; rec[6] = s0; rec[7] = s1;
    }
    __syncthreads();
}

constexpr int SLD = 2304;
template <int DQ, int QR>
__device__ __forceinline__ void naive_scores_softmax(LAS float* S, LAS float* qf, const bf16* Q, int ldq, const bf16* K, int ldk, int lo, int nk, float scale,
                                                     bool window, int qpos0, bool has_sink, float sink, int tid, int lane, int wave) {
    for (int i = tid; i < QR * DQ; i += 512) { const int r = i / DQ, d = i - r * DQ; qf[i] = bf2f(Q[(size_t)r * ldq + d]); }
    __syncthreads();
    for (int t = tid; t < nk; t += 512) {
        const int kr = t < CTX ? t : CTX + lo + (t - CTX);
        const bf16* kp = K + (size_t)kr * ldk;
        float acc[QR];
#pragma unroll
        for (int r = 0; r < QR; ++r) acc[r] = 0.f;
        for (int d = 0; d < DQ; d += 8) {
            const v4u kv = *(const v4u*)(kp + d);
            const float k0 = bflo(kv.x), k1 = bfhi(kv.x), k2 = bflo(kv.y), k3 = bfhi(kv.y), k4 = bflo(kv.z), k5 = bfhi(kv.z), k6 = bflo(kv.w), k7 = bfhi(kv.w);
#pragma unroll
            for (int r = 0; r < QR; ++r) { const LAS float* qp = qf + r * DQ + d;
                acc[r] += (k0 * qp[0] + k1 * qp[1]) + (k2 * qp[2] + k3 * qp[3]) + (k4 * qp[4] + k5 * qp[5]) + (k6 * qp[6] + k7 * qp[7]); }
        }
#pragma unroll
        for (int r = 0; r < QR; ++r) { float s = acc[r] * scale;
            if (window && t >= CTX) { const int dd = (qpos0 + r) - (lo + t - CTX); if (dd > 128 || dd < -128) s = -1e30f; }
            S[r * SLD + t] = s; }
    }
    __syncthreads();
    if (wave < QR) {
        LAS float* row = S + wave * SLD;
        float m = -1e30f; for (int t = lane; t < nk; t += 64) m = fmaxf(m, row[t]);
        m = wave_max(m); if (has_sink) m = fmaxf(m, sink);
        float sum = 0.f; for (int t = lane; t < nk; t += 64) { const float e = expf(row[t] - m); row[t] = e; sum += e; }
        sum = wave_sum(sum); if (has_sink) sum += expf(sink - m);
        const float inv = 1.0f / sum;
        for (int t = lane; t < nk; t += 64) row[t] *= inv;
    }
    __syncthreads();
}
template <int QR>
__device__ __forceinline__ void naive_pv(const LAS float* S, const bf16* V, int ldv, int lo, int nk, int tid, float (&o)[QR / 4]) {
    const int c = tid & 127, rg = tid >> 7; constexpr int RPT = QR / 4;
#pragma unroll
    for (int i = 0; i < RPT; ++i) o[i] = 0.f;
#pragma unroll 4
    for (int t = 0; t < nk; ++t) { const int kr = t < CTX ? t : CTX + lo + (t - CTX); const float v = bf2f(V[(size_t)kr * ldv + c]);
#pragma unroll
        for (int i = 0; i < RPT; ++i) o[i] += S[(rg * RPT + i) * SLD + t] * v; }
}
__device__ __forceinline__ void p_even_attn_naive(const Frame& F) {
    const LocalId L_ = local_id(); (void)L_;
    LAS float* S = (LAS float*)(F.lds + RING_OFF); LAS float* qf = (LAS float*)(F.lds + RING_OFF + 8 * SLD * 4);
    const bf16* Y1 = (const bf16*)(F.ws + WS_Y1); const bf16* QB = (const bf16*)(F.ws + WS_QB); const bf16* KV = (const bf16*)(F.ws + WS_KV); const bf16* KB = (const bf16*)(F.ws + WS_KB);
    bf16* MIX = (bf16*)(F.ws + WS_MIX);
    constexpr int UPV = NB * 8 * 288;
    for (int u = blockIdx.x; u < 2 * UPV; u += F.G) {
        const int var = u / UPV, rem = u - var * UPV, b = rem / 2304, rem2 = rem - b * 2304, h = rem2 / 288, ch = rem2 - h * 288;
        const int r0 = ch * 8, row0 = b * TPB + r0; const int nk = r0 < CTX ? CTX : TPB;
        float o[2];
        if (var == 0) {
            naive_scores_softmax<128, 8>(S, qf, Y1 + (size_t)row0 * EVEN_IN_P + h * 128, EVEN_IN_P, Y1 + (size_t)(b * TPB) * EVEN_IN_P + 1024 + (h >> 2) * 128, EVEN_IN_P, 0, nk,
                                         0.08838834764831845f, false, 0, false, 0.f, L_.tid, L_.lane, L_.wave);
            naive_pv<8>(S, Y1 + (size_t)(b * TPB) * EVEN_IN_P + 1280 + (h >> 2) * 128, EVEN_IN_P, 0, nk, L_.tid, o);
        } else {
            naive_scores_softmax<192, 8>(S, qf, QB + (size_t)row0 * 1536 + h * 192, 1536, KB + (size_t)(b * TPB) * 1536 + h * 192, 1536, 0, nk,
                                         0.07216878364870322f, false, 0, false, 0.f, L_.tid, L_.lane, L_.wave);
            naive_pv<8>(S, KV + (size_t)(b * TPB) * 2048 + h * 256 + 128, 2048, 0, nk, L_.tid, o);
        }
        const int c = L_.tid & 127, rg = L_.tid >> 7;
#pragma unroll
        for (int i = 0; i < 2; ++i) MIX[(size_t)(row0 + rg * 2 + i) * DM + var * 1024 + h * 128 + c] = (bf16)f2bf(o[i]);
        __syncthreads();
    }
}
__device__ __forceinline__ void p_odd_attn_naive(const Frame& F, const Args& a) {
    const LocalId L_ = local_id(); (void)L_;
    LAS float* S = (LAS float*)(F.lds + RING_OFF); LAS float* qf = (LAS float*)(F.lds + RING_OFF + 8 * SLD * 4); LAS float* ob = qf + 8 * 192;
    const bf16* Y1 = (const bf16*)(F.ws + WS_Y1); bf16* MIX = (bf16*)(F.ws + WS_MIX);
    float d1 = 0.f, d2 = 0.f;
    for (int i = 0; i < 64; ++i) { d1 += a.in[I_LQ1][i] * a.in[I_LK1][i]; d2 += a.in[I_LQ2][i] * a.in[I_LK2][i]; }
    const float lam = expf(d1) - expf(d2) + LAMBDA_INIT;
    constexpr int UC = NB * 8 * 512, UD = NB * 8 * 256;
    for (int u = blockIdx.x; u < UC + UD; u += F.G) {
        const int c = L_.tid & 127, rg = L_.tid >> 7;
        if (u < UC) {
            const int b = u / 4096, rem = u - b * 4096, h = rem / 512, ch = rem - h * 512;
            const int r0 = CTX + ch * 4, row0 = b * TPB + r0; const int nk = TPB;
            const bf16* kb = Y1 + (size_t)(b * TPB) * ODD_IN;
            naive_scores_softmax<64, 4>(S, qf, Y1 + (size_t)row0 * ODD_IN + (2 * h) * 64, ODD_IN, kb + 1024 + (2 * h) * 64, ODD_IN, 0, nk, 0.125f, false, 0, false, 0.f, L_.tid, L_.lane, L_.wave);
            naive_scores_softmax<64, 4>(S + 4 * SLD, qf, Y1 + (size_t)row0 * ODD_IN + (2 * h + 1) * 64, ODD_IN, kb + 1024 + (2 * h + 1) * 64, ODD_IN, 0, nk, 0.125f, false, 0, false, 0.f, L_.tid, L_.lane, L_.wave);
            for (int i = L_.tid; i < 4 * SLD; i += 512) S[i] = S[i] - lam * S[4 * SLD + i];
            __syncthreads();
            float o[1];
            naive_pv<4>(S, kb + 2048 + h * 128, ODD_IN, 0, nk, L_.tid, o);
            ob[rg * 128 + c] = o[0];
            __syncthreads();
            float ss = 0.f; for (int i = 0; i < 128; ++i) { const float v = ob[rg * 128 + i]; ss += v * v; }
            const float r = 1.0f / sqrtf(ss * (1.0f / 128.0f) + NORM_EPS);
            MIX[(size_t)(row0 + rg) * DM + h * 128 + c] = (bf16)f2bf(o[0] * r * a.in[I_SUBLN][c] * (1.0f - LAMBDA_INIT));
        } else {
            const int v = u - UC, b = v / 2048, rem = v - b * 2048, h = rem / 256, ch = rem - h * 256;
            const int s0 = ch * 8, row0 = b * TPB + CTX + s0;
            const int lo = s0 - 128 < 0 ? 0 : s0 - 128, hi = s0 + 7 + 128 > SEQ - 1 ? SEQ - 1 : s0 + 7 + 128; const int nk = CTX + (hi - lo + 1);
            const bf16* kb = Y1 + (size_t)(b * TPB) * ODD_IN;
            naive_scores_softmax<128, 8>(S, qf, Y1 + (size_t)row0 * ODD_IN + 3072 + h * 128, ODD_IN, kb + 4096 + (h >> 2) * 128, ODD_IN, lo, nk, 0.08838834764831845f, true, s0, true, a.in[I_SINK][h], L_.tid, L_.lane, L_.wave);
            float o[2];
            naive_pv<8>(S, kb + 4352 + (h >> 2) * 128, ODD_IN, lo, nk, L_.tid, o);
#pragma unroll
            for (int i = 0; i < 2; ++i) MIX[(size_t)(row0 + rg * 2 + i) * DM + 1024 + h * 128 + c] = (bf16)f2bf(o[i]);
        }
        __syncthreads();
    }
}

namespace att {
using bf16x8 = __attribute__((ext_vector_type(8))) short;
using s16x4  = __attribute__((ext_vector_type(4))) short;
using f32x16 = __attribute__((ext_vector_type(16))) float;
using u32x4  = __attribute__((ext_vector_type(4))) unsigned;
using f32x2  = __attribute__((ext_vector_type(2))) float;
#ifndef ATT_PK_SM
#define ATT_PK_SM 1
#endif
constexpr int KVBLK = 64, QBLK = 32;
constexpr int SHM_V = KVBLK * 128 * 2;
constexpr int K_OFF = 2 * SHM_V, K_MAX = KVBLK * 192 * 2, QL_OFF = K_OFF + 2 * K_MAX, WS_OFF = 131072 + 2048;
constexpr float THR = 8.f;
#define ATT_KSWZ(row, colB, RB) ((row) * (RB) + ((colB) ^ (((row) & 7) << 4)))
#define ATT_SBAR() __builtin_amdgcn_sched_barrier(0)
__device__ __forceinline__ int crow(int r, int hi) { return (r & 3) + 8 * (r >> 2) + 4 * hi; }
__device__ __forceinline__ unsigned cvtpk(float lo, float hi) { unsigned r; asm volatile("v_cvt_pk_bf16_f32 %0, %1, %2" : "=v"(r) : "v"(lo), "v"(hi)); return r; }

__device__ __forceinline__ void partialSM(f32x16& p0, f32x16& p1, float& m_reg, float& mn, float& alpha, float C, float thr_raw) {
  float pmax = p0[0];
#pragma unroll
  for (int r = 1; r < 16; ++r) pmax = fmaxf(pmax, p0[r]);
#pragma unroll
  for (int r = 0; r < 16; ++r) pmax = fmaxf(pmax, p1[r]);
  { auto rr = __builtin_amdgcn_permlane32_swap(__float_as_uint(pmax), __float_as_uint(pmax), false, false);
    pmax = fmaxf(__uint_as_float(rr[0]), __uint_as_float(rr[1])); }
  if (__builtin_expect(__all(pmax - m_reg <= thr_raw), 1)) { mn = m_reg; alpha = 1.f; }
  else { mn = fmaxf(m_reg, pmax); alpha = __builtin_amdgcn_exp2f((m_reg - mn) * C); m_reg = mn; }
  const float mnC = -mn * C;
#if ATT_PK_SM
  { const f32x2 C2 = {C, C}, M2 = {mnC, mnC};
#pragma unroll
    for (int r = 0; r < 16; r += 2) { f32x2 t = {p0[r], p0[r + 1]}; t = __builtin_elementwise_fma(t, C2, M2); p0[r] = t.x; p0[r + 1] = t.y; }
#pragma unroll
    for (int r = 0; r < 16; r += 2) { f32x2 t = {p1[r], p1[r + 1]}; t = __builtin_elementwise_fma(t, C2, M2); p1[r] = t.x; p1[r + 1] = t.y; } }
#else
#pragma unroll
  for (int r = 0; r < 16; ++r) p0[r] = fmaf(p0[r], C, mnC);
#pragma unroll
  for (int r = 0; r < 16; ++r) p1[r] = fmaf(p1[r], C, mnC);
#endif
#pragma unroll
  for (int r = 0; r < 16; ++r) p0[r] = __builtin_amdgcn_exp2f(p0[r]);
}
__device__ __forceinline__ void finishSM(f32x16& p0, f32x16& p1, float alpha, float& l_reg, bf16x8& pa0, bf16x8& pa1, bf16x8& pa2, bf16x8& pa3) {
#pragma unroll
  for (int r = 0; r < 16; ++r) p1[r] = __builtin_amdgcn_exp2f(p1[r]);
#if ATT_PK_SM
  f32x2 ps2 = {p0[0], p0[1]};
#pragma unroll
  for (int r = 2; r < 16; r += 2) ps2 += (f32x2){p0[r], p0[r + 1]};
#pragma unroll
  for (int r = 0; r < 16; r += 2) ps2 += (f32x2){p1[r], p1[r + 1]};
  float ps = ps2.x + ps2.y;
#else
  float ps = 0;
#pragma unroll
  for (int r = 0; r < 16; ++r) ps += p0[r];
#pragma unroll
  for (int r = 0; r < 16; ++r) ps += p1[r];
#endif
  { auto rr = __builtin_amdgcn_permlane32_swap(__float_as_uint(ps), __float_as_uint(ps), false, false);
    ps = __uint_as_float(rr[0]) + __uint_as_float(rr[1]); }
  l_reg = l_reg * alpha + ps;
#define ATT_PK4(P, BASE, OUT) do { unsigned a0 = cvtpk(P[BASE + 0], P[BASE + 1]), a1 = cvtpk(P[BASE + 2], P[BASE + 3]);   \
    unsigned b0 = cvtpk(P[BASE + 4], P[BASE + 5]), b1 = cvtpk(P[BASE + 6], P[BASE + 7]);                              \
    auto r0 = __builtin_amdgcn_permlane32_swap(a0, b0, false, false); auto r1 = __builtin_amdgcn_permlane32_swap(a1, b1, false, false); \
    u32x4 w = {r0[0], r1[0], r0[1], r1[1]}; OUT = *reinterpret_cast<bf16x8*>(&w); } while (0)
  ATT_PK4(p0, 0, pa0); ATT_PK4(p0, 8, pa1); ATT_PK4(p1, 0, pa2); ATT_PK4(p1, 8, pa3);
#undef ATT_PK4
}
template <int DQ, int NQT, int NQR, int QSB>
__device__ __forceinline__ void qkt(f32x16& p0, f32x16& p1, const char* Ks, const bf16x8 (&qr)[NQR], const char* qlds, const int (&kb)[4]) {
  p0 = f32x16{}; p1 = f32x16{};
#pragma unroll
  for (int d0 = 0; d0 < NQT; ++d0) {
    const bf16x8 b0 = *reinterpret_cast<const bf16x8*>(Ks + kb[d0 & 3] + (d0 >> 2) * 128);
    const bf16x8 b1 = *reinterpret_cast<const bf16x8*>(Ks + kb[d0 & 3] + (d0 >> 2) * 128 + 32 * DQ * 2);
    bf16x8 q; if (d0 < NQR) q = qr[d0 < NQR ? d0 : 0]; else q = *reinterpret_cast<const bf16x8*>(qlds + (d0 - NQR) * 1024);
    p0 = __builtin_amdgcn_mfma_f32_32x32x16_bf16(b0, q, p0, 0, 0, 0);
    p1 = __builtin_amdgcn_mfma_f32_32x32x16_bf16(b1, q, p1, 0, 0, 0);
    if (QSB > 0 && (d0 % (QSB > 0 ? QSB : 1)) == (QSB - 1) && d0 + 1 < NQT) ATT_SBAR(); }
}
__device__ __forceinline__ void mask_tile(f32x16& p0, f32x16& p1, int kp0, int qpos, int hi) {
#pragma unroll
  for (int r = 0; r < 16; ++r) { const int d = qpos - (kp0 + crow(r, hi));
    if (d > 128 || d < -128) p0[r] = -1e30f;
    if (d - 32 > 128 || d - 32 < -128) p1[r] = -1e30f; }
}
__device__ __forceinline__ int v_st(int k, int c) { const int kk = (k & ~0xC) | ((k & 4) << 1) | ((k & 8) >> 1); return ((kk >> 3) * 4 + (c >> 5)) * 512 + ((kk & 7) * 32 + (c & 31)) * 2; }
__device__ __forceinline__ int v_rd_base(int lane) { return ((lane & 3) << 3) | (((lane >> 2) & 3) << 6) | (((lane >> 4) & 1) << 5) | (((lane >> 5) & 1) << 8); }
constexpr int v_rd_off(int d0, int ks, int half) { return d0 * 512 + ks * 4096 + half * 2048; }
template <int OFF> __device__ __forceinline__ s16x4 tr_read(int vb) {
  s16x4 r; asm volatile("ds_read_b64_tr_b16 %0, %1 offset:%2" : "=&v"(r) : "v"(vb), "i"(OFF) : "memory"); return r;
}
template <int D0> __device__ __forceinline__ void pv_one(f32x16& od, int vb, bf16x8 pa0, bf16x8 pa1, bf16x8 pa2, bf16x8 pa3) {
  const s16x4 l0 = tr_read<v_rd_off(D0, 0, 0)>(vb), h0 = tr_read<v_rd_off(D0, 0, 1)>(vb), l1 = tr_read<v_rd_off(D0, 1, 0)>(vb), h1 = tr_read<v_rd_off(D0, 1, 1)>(vb);
  const s16x4 l2 = tr_read<v_rd_off(D0, 2, 0)>(vb), h2 = tr_read<v_rd_off(D0, 2, 1)>(vb), l3 = tr_read<v_rd_off(D0, 3, 0)>(vb), h3 = tr_read<v_rd_off(D0, 3, 1)>(vb);
  asm volatile("s_waitcnt lgkmcnt(0)" ::: "memory"); ATT_SBAR();
#define ATT_PK(L, H) (bf16x8){L[0], L[1], L[2], L[3], H[0], H[1], H[2], H[3]}
  od = __builtin_amdgcn_mfma_f32_32x32x16_bf16(pa0, ATT_PK(l0, h0), od, 0, 0, 0);
  od = __builtin_amdgcn_mfma_f32_32x32x16_bf16(pa1, ATT_PK(l1, h1), od, 0, 0, 0);
  od = __builtin_amdgcn_mfma_f32_32x32x16_bf16(pa2, ATT_PK(l2, h2), od, 0, 0, 0);
  od = __builtin_amdgcn_mfma_f32_32x32x16_bf16(pa3, ATT_PK(l3, h3), od, 0, 0, 0);
#undef ATT_PK
}
__device__ __forceinline__ void pv_d0(f32x16* o, int vb, bf16x8 pa0, bf16x8 pa1, bf16x8 pa2, bf16x8 pa3) {
  pv_one<0>(o[0], vb, pa0, pa1, pa2, pa3); pv_one<1>(o[1], vb, pa0, pa1, pa2, pa3); pv_one<2>(o[2], vb, pa0, pa1, pa2, pa3); pv_one<3>(o[3], vb, pa0, pa1, pa2, pa3);
}

template <int M> __device__ __forceinline__ float swz_xor(float v) { return __builtin_bit_cast(float, __builtin_amdgcn_ds_swizzle(__builtin_bit_cast(int, v), (M << 10) | 0x1F)); }
__device__ __forceinline__ float sum_xor32(float v) { auto rr = __builtin_amdgcn_permlane32_swap(__float_as_uint(v), __float_as_uint(v), false, false); return __uint_as_float(rr[0]) + __uint_as_float(rr[1]); }
__device__ __forceinline__ float bfx(short v) { return __builtin_bit_cast(float, ((unsigned)(unsigned short)v) << 16); }
template <int MODE, int NQ>
__device__ __forceinline__ void q_fix(bf16x8 (&q)[NQ], const float* gain, const float* tab  , int pos, int hi) {
  constexpr int DIM = NQ * 16;
  float x[NQ][8]; float ss = 0.f;
#pragma unroll
  for (int d0 = 0; d0 < NQ; ++d0)
#pragma unroll
    for (int j = 0; j < 8; ++j) { x[d0][j] = bfx(q[d0][j]); ss += x[d0][j] * x[d0][j]; }
  ss = sum_xor32(ss);
  const float r = 1.0f / sqrtf(ss * (1.0f / DIM) + 1e-6f);
#pragma unroll
  for (int d0 = 0; d0 < NQ; ++d0) { const float* g = gain + d0 * 16 + hi * 8;
#pragma unroll
    for (int j = 0; j < 8; ++j) x[d0][j] *= r * g[j]; }
  if (pos >= 0) {
    const int prow = pos >> 6, pcol = pos & 63;
    constexpr int RB0 = (MODE == 2) ? 8 : 0, NRB = (MODE == 1) ? 8 : 4, NF = (MODE == 1) ? 32 : 16, PX = (MODE == 1) ? 2 : 1;
    float y[NRB][8];
#pragma unroll
    for (int b = 0; b < NRB; ++b) { const int p = (b < NRB / 2) ? prow : pcol; const int f0 = (MODE == 1 ? (b & 1) * 16 : 0) + hi * 8; const float sg = (b & PX) ? 1.0f : -1.0f;
      const float* t = tab + (size_t)(p * NF + f0) * 2;
#pragma unroll
      for (int j = 0; j < 8; ++j) y[b][j] = x[RB0 + b][j] * t[2 * j] + sg * x[RB0 + (b ^ PX)][j] * t[2 * j + 1]; }
#pragma unroll
    for (int b = 0; b < NRB; ++b)
#pragma unroll
      for (int j = 0; j < 8; ++j) x[RB0 + b][j] = y[b][j];
  }
#pragma unroll
  for (int d0 = 0; d0 < NQ; ++d0) { u32x4 w; w.x = cvtpk(x[d0][0], x[d0][1]); w.y = cvtpk(x[d0][2], x[d0][3]); w.z = cvtpk(x[d0][4], x[d0][5]); w.w = cvtpk(x[d0][6], x[d0][7]); q[d0] = *reinterpret_cast<bf16x8*>(&w); }
}

template <int DQ, bool WINDOW, bool SINK, int LDQ, int LDK, int LDV, int SD, int QSB, int NQRMAX, bool DIFF = false, int QMODE = 0>
__device__ __forceinline__ void attn_unit(const bf16* __restrict__ Qb, const bf16* __restrict__ Kb, const bf16* __restrict__ Vb,
                                          bf16* __restrict__ Ob, int ntiles, int band_lo, int qpos0, float scale, float sink, char* lds, const float* gainp = nullptr,
                                          const float* qgain = nullptr, const float* qtab = nullptr, int qs0 = -1, int wv = 0) {
  constexpr int NQ = (DIFF ? DQ / 2 : DQ) / 16, NQR = NQ > NQRMAX ? NQRMAX : NQ, NCH = DQ / 64, RB = DQ * 2, SHM_K = KVBLK * DQ * 2, LDO = 2048;
  int tid = wv * 64 + lane_id_(); asm volatile("" : "+v"(tid));
  const int wid = tid >> 6, lane = tid & 63, r32 = lane & 31, hi = lane >> 5;
  const int comp = DIFF ? (wid >> 2) : 0, wrow = DIFF ? (wid & 3) : wid, kcomp = comp * 128;
  char* V_lds = lds; char* K_lds = lds + K_OFF;
  float* ws = (float*)(lds + WS_OFF) + wid * 64; float* li_l = ws; float* al_l = ws + 32;
  const float C = scale * 1.4426950408889634f, thr_raw = THR / scale;
  float m_reg = -1e30f, l_reg = 0; f32x16 o[4] = {}; bf16x8 qr[NQR];
  const unsigned qoff = (unsigned)((wrow * QBLK + r32) * LDQ + hi * 8 + comp * 64) * 2u;
  char* qlds = lds + QL_OFF + wid * ((NQ - NQR) * 1024) + lane * 16;
  if constexpr (QMODE == 0) {
#pragma unroll
    for (int d0 = 0; d0 < NQR; ++d0) qr[d0] = *reinterpret_cast<const bf16x8*>((const char*)Qb + qoff + d0 * 32);
    __syncthreads();
    if constexpr (NQ > NQR) {
#pragma unroll
      for (int d0 = NQR; d0 < NQ; ++d0) *reinterpret_cast<bf16x8*>(qlds + (d0 - NQR) * 1024) = *reinterpret_cast<const bf16x8*>((const char*)Qb + qoff + d0 * 32);
    }
  } else {
    bf16x8 qall[NQ];
#pragma unroll
    for (int d0 = 0; d0 < NQ; ++d0) qall[d0] = *reinterpret_cast<const bf16x8*>((const char*)Qb + qoff + d0 * 32);
    q_fix<QMODE, NQ>(qall, qgain, qtab, qs0 < 0 ? -1 : qs0 + wrow * QBLK + r32, hi);
#pragma unroll
    for (int d0 = 0; d0 < NQR; ++d0) qr[d0] = qall[d0];
    __syncthreads();
    if constexpr (NQ > NQR) {
#pragma unroll
      for (int d0 = NQR; d0 < NQ; ++d0) *reinterpret_cast<bf16x8*>(qlds + (d0 - NQR) * 1024) = qall[d0];
    }
  }
  const int sr = tid >> 4, sc = (tid & 15) * 8, vst0 = v_st(sr, sc);
  const unsigned voV = (unsigned)(sr * LDV + sc) * 2u;
  const int kr_ = tid >> 3, kc_ = (tid & 7) * 8;
  const unsigned voK = (unsigned)(kr_ * LDK + kc_) * 2u; const int kwr = ATT_KSWZ(kr_, kc_ * 2, RB);
  const int vb0 = (int)(uintptr_t)V_lds + v_rd_base(lane);
  int kb[4];
#pragma unroll
  for (int k = 0; k < 4; ++k) kb[k] = r32 * RB + ((k ^ ((r32 & 7) >> 1)) * 32) + ((hi ^ (r32 & 1)) * 16);
  const int qpos = qpos0 + wrow * QBLK + r32;
  struct { bf16x8 vs0, vs1, ks[NCH]; } sr_[SD];
#define ATT_KROW(j) (WINDOW ? ((j) < 4 ? (j) * KVBLK : 256 + band_lo + ((j) - 4) * KVBLK) : (j) * KVBLK)
#define ATT_SLOAD(i, j) do { const int k0_ = ATT_KROW(j); const char* vt_ = (const char*)Vb + (size_t)k0_ * (LDV * 2); const char* kt_ = (const char*)Kb + (size_t)k0_ * (LDK * 2); \
    sr_[i].vs0 = *reinterpret_cast<const bf16x8*>(vt_ + voV); sr_[i].vs1 = *reinterpret_cast<const bf16x8*>(vt_ + voV + 32 * LDV * 2); \
    _Pragma("unroll") for (int c_ = 0; c_ < NCH; ++c_) sr_[i].ks[c_] = *reinterpret_cast<const bf16x8*>(kt_ + voK + c_ * 128); } while (0)
#define ATT_SWRITE(b, i) do { *(bf16x8*)(V_lds + (b) * SHM_V + vst0) = sr_[i].vs0; *(bf16x8*)(V_lds + (b) * SHM_V + vst0 + 8192) = sr_[i].vs1; \
    _Pragma("unroll") for (int c_ = 0; c_ < NCH; ++c_) *(bf16x8*)(K_lds + (b) * SHM_K + kwr + c_ * 128) = sr_[i].ks[c_]; } while (0)
#define ATT_SWAIT() do { if constexpr (SD == 1) asm volatile("s_waitcnt vmcnt(0)" ::: "memory"); else if constexpr (NCH == 1) asm volatile("s_waitcnt vmcnt(3)" ::: "memory"); else if constexpr (NCH == 2) asm volatile("s_waitcnt vmcnt(4)" ::: "memory"); else asm volatile("s_waitcnt vmcnt(5)" ::: "memory"); } while (0)
#define ATT_RESC(a) do { if (__any((a) < 1.f)) { if (hi == 0) al_l[r32] = (a); asm volatile("s_waitcnt lgkmcnt(0)" ::: "memory"); \
    _Pragma("unroll") for (int d = 0; d < 4; ++d) _Pragma("unroll") for (int r = 0; r < 16; ++r) o[d][r] *= al_l[crow(r, hi)]; } } while (0)
#define ATT_MASK(P0, P1, j) do { if constexpr (WINDOW) { if ((j) >= 4) mask_tile(P0, P1, band_lo + ((j) - 4) * KVBLK, qpos, hi); } } while (0)
  f32x16 pA0, pA1, pB0, pB1; float mnA, mnB, alA, alB; bf16x8 pa0, pa1, pa2, pa3; const int NT = ntiles;
  constexpr int SE = 0, SO = SD - 1;
  ATT_SLOAD(SE, 0); asm volatile("s_waitcnt vmcnt(0)" ::: "memory"); ATT_SWRITE(0, SE); __syncthreads();
  qkt<DQ, NQ, NQR, QSB>(pA0, pA1, K_lds + kcomp, qr, qlds, kb); ATT_MASK(pA0, pA1, 0); partialSM(pA0, pA1, m_reg, mnA, alA, C, thr_raw);
  ATT_SLOAD(SO, 1); if constexpr (SD == 2) { if (2 < NT) ATT_SLOAD(SE, 2); }
  ATT_SWAIT(); ATT_SWRITE(1, SO); __syncthreads();
  for (int j = 1; j + 1 < NT; j += 2) {
    ATT_SBAR(); qkt<DQ, NQ, NQR, QSB>(pB0, pB1, K_lds + SHM_K + kcomp, qr, qlds, kb);
    finishSM(pA0, pA1, alA, l_reg, pa0, pa1, pa2, pa3); ATT_SBAR();
    ATT_SLOAD(SO, j + SD); ATT_SBAR();
    pv_d0(o, vb0, pa0, pa1, pa2, pa3); ATT_MASK(pB0, pB1, j); partialSM(pB0, pB1, m_reg, mnB, alB, C, thr_raw);
    __syncthreads(); ATT_SWAIT(); ATT_SWRITE(0, SE);
    ATT_RESC(alB); __syncthreads();
    ATT_SBAR(); qkt<DQ, NQ, NQR, QSB>(pA0, pA1, K_lds + kcomp, qr, qlds, kb);
    finishSM(pB0, pB1, alB, l_reg, pa0, pa1, pa2, pa3); ATT_SBAR();
    if (SD == 1 || j + 3 < NT) ATT_SLOAD(SE, j + 1 + SD); ATT_SBAR();
    pv_d0(o, vb0 + SHM_V, pa0, pa1, pa2, pa3); ATT_MASK(pA0, pA1, j + 1); partialSM(pA0, pA1, m_reg, mnA, alA, C, thr_raw);
    __syncthreads(); ATT_SWAIT(); ATT_SWRITE(1, SO);
    ATT_RESC(alA); __syncthreads();
  }
  ATT_SBAR(); qkt<DQ, NQ, NQR, QSB>(pB0, pB1, K_lds + SHM_K + kcomp, qr, qlds, kb);
  finishSM(pA0, pA1, alA, l_reg, pa0, pa1, pa2, pa3); ATT_SBAR();
  pv_d0(o, vb0, pa0, pa1, pa2, pa3); ATT_MASK(pB0, pB1, NT - 1); partialSM(pB0, pB1, m_reg, mnB, alB, C, thr_raw);
  __syncthreads(); ATT_RESC(alB);
  finishSM(pB0, pB1, alB, l_reg, pa0, pa1, pa2, pa3); ATT_SBAR();
  pv_d0(o, vb0 + SHM_V, pa0, pa1, pa2, pa3);
  if constexpr (SINK) l_reg += __builtin_amdgcn_exp2f(sink * 1.4426950408889634f - m_reg * C);
  if (hi == 0) li_l[r32] = l_reg; asm volatile("s_waitcnt lgkmcnt(0)" ::: "memory");
  float rli[16];
#pragma unroll
  for (int r = 0; r < 16; ++r) rli[r] = __builtin_amdgcn_rcpf(li_l[crow(r, hi)]);
  int tid2 = wv * 64 + lane_id_(); asm volatile("" : "+v"(tid2));
  if constexpr (!DIFF) {
    const bool odd = tid2 & 1;
    const unsigned ooff = (unsigned)(((tid2 >> 6) * QBLK + 4 * ((tid2 >> 5) & 1) + (tid2 & 1)) * LDO + (tid2 & 30)) * 2u;
#pragma unroll
    for (int rp = 0; rp < 8; ++rp) { const int orow = ((2 * rp) & 3) + 8 * ((2 * rp) >> 2);
#pragma unroll
      for (int d0 = 0; d0 < 4; ++d0) { const float a_ = o[d0][2 * rp] * rli[2 * rp], b_ = o[d0][2 * rp + 1] * rli[2 * rp + 1];
        const float rc = swz_xor<1>(odd ? a_ : b_);
        *reinterpret_cast<unsigned*>((char*)Ob + ooff + (orow * LDO + d0 * 32) * 2) = odd ? cvtpk(rc, b_) : cvtpk(a_, rc); } }
  } else {
    float* X = (float*)lds + ((tid2 >> 6) & 3) * 4096 + (tid2 & 63);
    __syncthreads();
    if (tid2 >= 256) {
#pragma unroll
      for (int d0 = 0; d0 < 4; ++d0)
#pragma unroll
        for (int r = 0; r < 16; ++r) X[(d0 * 16 + r) * 64] = sink * (o[d0][r] * rli[r]);
    }
    __syncthreads();
    if (tid2 < 256) {
      float g[4];
#pragma unroll
      for (int d0 = 0; d0 < 4; ++d0) g[d0] = gainp[d0 * 32 + (tid2 & 31)];
      const bool odd = tid2 & 1;
      const unsigned ooff = (unsigned)(((tid2 >> 6) * QBLK + 4 * ((tid2 >> 5) & 1) + (tid2 & 1)) * LDO + (tid2 & 30)) * 2u;
#pragma unroll
      for (int rp = 0; rp < 8; ++rp) { const int orow = ((2 * rp) & 3) + 8 * ((2 * rp) >> 2);
        float da[4], db[4], sa = 0.f, sb = 0.f;
#pragma unroll
        for (int d0 = 0; d0 < 4; ++d0) { da[d0] = o[d0][2 * rp] * rli[2 * rp] - X[(d0 * 16 + 2 * rp) * 64]; db[d0] = o[d0][2 * rp + 1] * rli[2 * rp + 1] - X[(d0 * 16 + 2 * rp + 1) * 64]; sa += da[d0] * da[d0]; sb += db[d0] * db[d0]; }
        sa += swz_xor<1>(sa); sa += swz_xor<2>(sa); sa += swz_xor<4>(sa); sa += swz_xor<8>(sa); sa += swz_xor<16>(sa);
        sb += swz_xor<1>(sb); sb += swz_xor<2>(sb); sb += swz_xor<4>(sb); sb += swz_xor<8>(sb); sb += swz_xor<16>(sb);
        const float ra = __builtin_amdgcn_rsqf(sa * (1.0f / 128.0f) + 1e-6f), rb = __builtin_amdgcn_rsqf(sb * (1.0f / 128.0f) + 1e-6f);
#pragma unroll
        for (int d0 = 0; d0 < 4; ++d0) { const float a_ = da[d0] * ra * g[d0], b_ = db[d0] * rb * g[d0];
          const float rc = swz_xor<1>(odd ? a_ : b_);
          *reinterpret_cast<unsigned*>((char*)Ob + ooff + (orow * LDO + d0 * 32) * 2) = odd ? cvtpk(rc, b_) : cvtpk(a_, rc); } }
    }
  }
#undef ATT_KROW
#undef ATT_SLOAD
#undef ATT_SWRITE
#undef ATT_SWAIT
#undef ATT_RESC
#undef ATT_MASK
}
}

__device__ __forceinline__ void p_even_attn(const Frame& F, const Args& a, char* lds) {
    const LocalId L_ = local_id(); (void)L_;
    const bf16* Y1 = (const bf16*)(F.ws + WS_Y1); const bf16* QB = (const bf16*)(F.ws + WS_QB); const bf16* KV = (const bf16*)(F.ws + WS_KV); const bf16* KB = (const bf16*)(F.ws + WS_KB);
    bf16* MIX = (bf16*)(F.ws + WS_MIX);
    const float* t128 = (const float*)(F.ws + WS_ROPE); const float* t64 = (const float*)(F.ws + WS_ROPE + 16384);
    for (int n = blockIdx.x; n < 512 + 64; n += F.G) {
        int b, h, row0, nt, qs0;
        if (n < 512) { const int i = n >> 8, c = n & 255, x = c & 7, lc = c >> 3, gi = i * 8 + x; b = gi >> 1; h = (gi & 1) * 4 + (lc >> 3); qs0 = (lc & 7) * 256; row0 = b * TPB + CTX + qs0; nt = 36; }
        else { const int m = n - 512; b = m >> 3; h = m & 7; row0 = b * TPB; nt = 4; qs0 = -1; }
        const size_t kb = (size_t)b * TPB;
        att::attn_unit<128, false, false, EVEN_IN_P, EVEN_IN_P, EVEN_IN_P, 2, 0, 8, false, 1>(Y1 + (size_t)row0 * EVEN_IN_P + h * 128, Y1 + kb * EVEN_IN_P + 1024 + (h >> 2) * 128, Y1 + kb * EVEN_IN_P + 1280 + (h >> 2) * 128,
                                                                                 MIX + (size_t)row0 * DM + h * 128, nt, 0, 0, 0.08838834764831845f, 0.f, lds, nullptr, a.in[I_AQN], t128, qs0, L_.wave);
    }
    for (int n = blockIdx.x; n < 512 + 64; n += F.G) {
        int b, h, row0, nt, qs0;
        if (n < 512) { const int i = n >> 8, c = n & 255, x = c & 7, lc = c >> 3, gi = i * 8 + x; b = gi >> 1; h = (gi & 1) * 4 + (lc >> 3); qs0 = (lc & 7) * 256; row0 = b * TPB + CTX + qs0; nt = 36; }
        else { const int m = n - 512; b = m >> 3; h = m & 7; row0 = b * TPB; nt = 4; qs0 = -1; }
        const size_t kb = (size_t)b * TPB;
        att::attn_unit<192, false, false, 1536, 1536, 2048, 1, 0, 8, false, 2>(QB + (size_t)row0 * 1536 + h * 192, KB + kb * 1536 + h * 192, KV + kb * 2048 + h * 256 + 128,
                                                                  MIX + (size_t)row0 * DM + 1024 + h * 128, nt, 0, 0, 0.07216878364870322f, 0.f, lds, nullptr, a.in[I_BQN], t64, qs0, L_.wave);
    }
    __syncthreads();
}
__device__ __forceinline__ void p_odd_attn(const Frame& F, const Args& a, char* lds) {
    const LocalId L_ = local_id(); (void)L_;
    const bf16* Y1 = (const bf16*)(F.ws + WS_Y1); bf16* O12 = (bf16*)(F.ws + WS_A1); bf16* MIX = (bf16*)(F.ws + WS_MIX);
#if ATT_DIFF_FUSED
    float d1 = 0.f, d2 = 0.f;
    for (int i = 0; i < 64; ++i) { d1 += a.in[I_LQ1][i] * a.in[I_LK1][i]; d2 += a.in[I_LQ2][i] * a.in[I_LK2][i]; }
    const float lam = expf(d1) - expf(d2) + LAMBDA_INIT;
    const float* gsub = (const float*)(F.ws + WS_ROPE + 32768);
    for (int n = blockIdx.x; n < 1024; n += F.G) {
        const int i = n >> 8, c = n & 255, x = c & 7, lc = c >> 3, gi = i * 8 + x, b = gi >> 2, h = (gi & 3) * 2 + (lc >> 4), row0 = b * TPB + CTX + (lc & 15) * 128;
        const size_t kb = (size_t)b * TPB * ODD_IN;
        att::attn_unit<128, false, false, ODD_IN, ODD_IN, ODD_IN, 2, 0, 8, true, 3>(Y1 + (size_t)row0 * ODD_IN + h * 128, Y1 + kb + 1024 + h * 128, Y1 + kb + 2048 + h * 128,
                                                                             MIX + (size_t)row0 * DM + h * 128, 36, 0, 0, 0.125f, lam, lds, gsub, a.in[I_CQN], (const float*)(F.ws + WS_ROPE + 16384), (lc & 15) * 128, L_.wave);
    }
#else
    for (int n = blockIdx.x; n < 1024; n += F.G) {
        const int i = n >> 8, c = n & 255, x = c & 7, lc = c >> 3, gi = i * 8 + x, b = gi >> 2, ch = (gi & 3) * 4 + (lc >> 3), row0 = b * TPB + CTX + (lc & 7) * 256;
        const size_t kb = (size_t)b * TPB * ODD_IN;
        att::attn_unit<64, false, false, ODD_IN, ODD_IN, ODD_IN, 2, 0, 8>(Y1 + (size_t)row0 * ODD_IN + ch * 64, Y1 + kb + 1024 + ch * 64, Y1 + kb + 2048 + (ch >> 1) * 128,
                                                                       O12 + (size_t)row0 * DM + ch * 128, 36, 0, 0, 0.125f, 0.f, lds, nullptr, nullptr, nullptr, -1, L_.wave);
    }
#endif
    for (int m = blockIdx.x; m < 512; m += F.G) {
        const int i = m >> 8, c = m & 255, x = c & 7, lc = c >> 3, gi = i * 8 + x, b = gi >> 1, kvh = gi & 1, h = kvh * 4 + (lc >> 3), s0 = (lc & 7) * 256, row0 = b * TPB + CTX + s0;
        const int lo = s0 - 128 < 0 ? 0 : s0 - 128, hie = s0 + 384 > SEQ ? SEQ : s0 + 384;
        const size_t kb = (size_t)b * TPB * ODD_IN;
        att::attn_unit<128, true, true, ODD_IN, ODD_IN, ODD_IN, 1, 0, 8, false, 1>(Y1 + (size_t)row0 * ODD_IN + 3072 + h * 128, Y1 + kb + 4096 + kvh * 128, Y1 + kb + 4352 + kvh * 128,
                                                                      MIX + (size_t)row0 * DM + 1024 + h * 128, 4 + (hie - lo) / 64, lo, s0, 0.08838834764831845f, a.in[I_SINK][h], lds, nullptr, a.in[I_DQN], (const float*)(F.ws + WS_ROPE), s0, L_.wave);
    }
    __syncthreads();
}
__device__ __forceinline__ void p_odd_combine(const Frame& F, const Args& a) {
    const LocalId L_ = local_id(); (void)L_;
    const int gw = F.vcu * NWAVES + L_.wave, NGW = F.G * NWAVES;
    const bf16* O12 = (const bf16*)(F.ws + WS_A1); bf16* MIX = (bf16*)(F.ws + WS_MIX);
    float d1 = 0.f, d2 = 0.f;
    for (int i = 0; i < 64; ++i) { d1 += a.in[I_LQ1][i] * a.in[I_LK1][i]; d2 += a.in[I_LQ2][i] * a.in[I_LK2][i]; }
    const float lam = expf(d1) - expf(d2) + LAMBDA_INIT;
    const float g0 = a.in[I_SUBLN][L_.lane] * (1.0f - LAMBDA_INIT), g1 = a.in[I_SUBLN][L_.lane + 64] * (1.0f - LAMBDA_INIT);
    for (int i = gw; i < NB * SEQ; i += NGW) {
        const int b = i / SEQ, row = b * TPB + CTX + (i - b * SEQ);
        const bf16* src = O12 + (size_t)row * DM; bf16* dst = MIX + (size_t)row * DM;
        for (int h = 0; h < 8; ++h) {
            const float x0 = bf2f(src[2 * h * 128 + L_.lane]) - lam * bf2f(src[(2 * h + 1) * 128 + L_.lane]);
            const float x1 = bf2f(src[2 * h * 128 + 64 + L_.lane]) - lam * bf2f(src[(2 * h + 1) * 128 + 64 + L_.lane]);
            const float ss = wave_sum(x0 * x0 + x1 * x1);
            const float r = 1.0f / sqrtf(ss * (1.0f / 128.0f) + NORM_EPS);
            dst[h * 128 + L_.lane] = (bf16)f2bf(x0 * r * g0); dst[h * 128 + 64 + L_.lane] = (bf16)f2bf(x1 * r * g1);
        }
    }
}

#ifndef FILL_S
#define FILL_S 2
#endif
#ifndef FILL_B
#define FILL_B 2
#endif
constexpr unsigned NCHUNK = 64u * 3072u / (8u * FILL_S), NCHUNK_L0 = NCHUNK / 2u, NCHUNK_L1GU = NCHUNK / 6u * 5u, FILL_NONE = 0xffffffffu;
template <bool BARRIER>
__device__ __forceinline__ void fill_loop(const Frame& F, const Args& a, unsigned* xgen, unsigned gen, unsigned lim) {
    const LocalId L_ = local_id();
    volatile LAS unsigned* st = F.MISC + 8;
    unsigned* ctr = (unsigned*)(F.ctl + CW_ITEM);
    unsigned cur = st[6] - 1u, nxt = st[7] - 1u; int s0 = (int)(st[16 + L_.wave] & 255u);
    __syncthreads();
    if (cur == FILL_NONE) { cur = nxt; nxt = FILL_NONE; s0 = 0; }
    if (cur == FILL_NONE) {
        if (L_.tid == 0) { const bool rel = BARRIER && xb_ld(xgen) != gen; st[5] = rel ? FILL_NONE : xb_add(ctr, 1u); }
        __syncthreads();
        cur = st[5];
        __syncthreads();
    }
    for (;;) {
        if (cur >= NCHUNK) { cur = FILL_NONE; nxt = FILL_NONE; s0 = 0; break; }
        if (!BARRIER && cur >= lim) break;
        unsigned nid = nxt;
        if (nxt == FILL_NONE && L_.tid == 0) nid = xb_add(ctr, 1u);
        int sN = s0; bool relw = false;
#pragma unroll 1
        for (; sN < FILL_S && !relw; sN += FILL_B) {
            const int r = (int)cur * (8 * FILL_S) + 8 * sN + L_.wave;
            TrAddr t[FILL_B]; f32x4 v[FILL_B][8];
#pragma unroll
            for (int j = 0; j < FILL_B; ++j) { t[j] = moe_item_addr(F, a, r + 8 * j); tr_load(v[j], t[j], L_.lane); }
            unsigned g = gen; if (BARRIER) g = (unsigned)__builtin_amdgcn_readfirstlane(xb_ld(xgen));
#pragma unroll
            for (int j = 0; j < FILL_B; ++j) tr_store(v[j], t[j], L_.lane);
            relw = (g != gen);
        }
        if (L_.lane == 0) st[16 + L_.wave] = (unsigned)sN | (relw ? 256u : 0u);
        if (L_.tid == 0) st[5] = nid;
        __syncthreads();
        nid = st[5]; bool partial = false, rel = false;
#pragma unroll
        for (int w = 0; w < NWAVES; ++w) { const unsigned x = st[16 + w]; partial = partial || ((x & 255u) < (unsigned)FILL_S); rel = rel || (x >= 256u); }
        __syncthreads();
        if (partial) { nxt = nid; s0 = sN; break; }
        cur = nid; nxt = FILL_NONE; s0 = 0;
        if (rel) break;
    }
    if (nxt != FILL_NONE && nxt >= NCHUNK) nxt = FILL_NONE;
    if (L_.lane == 0) st[16 + L_.wave] = (unsigned)s0;
    if (L_.tid == 0) { st[6] = cur + 1u; st[7] = nxt + 1u; }
    __syncthreads();
}
__device__ __forceinline__ void fill_until(const Frame& F, const Args& a, unsigned lim) { __syncthreads(); fill_loop<false>(F, a, nullptr, 0u, lim); }
__device__ __forceinline__ void xcd_barrier_fill(const XcdBarrier& b, const Frame& F, const Args& a) {
    asm volatile("s_waitcnt vmcnt(0)" ::: "memory");
    __syncthreads();
    volatile LAS unsigned* st = b.st;
    if (threadIdx.x == 0) {
        unsigned* bar = b.bar;
        __builtin_amdgcn_s_waitcnt(0);
        unsigned nloc = st[0], nx = st[1];
        if (nloc == 0u) { xcd_barrier_complete(bar, b.x, nloc, nx); st[0] = nloc; st[1] = nx; }
        const unsigned old = xb_add(&bar[XB_XSUB(b.x)], 1u);
        const unsigned gen = old / nloc;
        if (old + 1u == (gen + 1u) * nloc) {
            __builtin_amdgcn_fence(__ATOMIC_RELEASE, "agent");
            asm volatile("s_waitcnt vmcnt(0)" ::: "memory");
            const unsigned og = xb_add(&bar[XB_TOP], 1u);
            const unsigned tg = og / nx;
            if (og + 1u == (tg + 1u) * nx) xb_add(&bar[XB_TOPGEN], 1u);
            else XB_SPIN(xb_ld(&bar[XB_TOPGEN]) == tg, bar);
            __builtin_amdgcn_fence(__ATOMIC_ACQUIRE, "agent");
            xb_add(&bar[XB_XGEN(b.x)], 1u);
            asm volatile("s_waitcnt vmcnt(0)" ::: "memory");
            st[2] = 1u;
        } else { st[2] = 0u; st[3] = gen; }
    }
    __syncthreads();
    if (st[2] == 0u) {
        const unsigned gen = st[3];
        unsigned* xgen = &b.bar[XB_XGEN(b.x)];
        fill_loop<true>(F, a, xgen, gen, 0u);
        if (threadIdx.x == 0) {
            XB_SPIN(xb_ld(xgen) == gen, b.bar);
            __builtin_amdgcn_fence(__ATOMIC_ACQUIRE, "agent");
            asm volatile("s_waitcnt vmcnt(0)" ::: "memory");
        }
    }
    __syncthreads();
}

__device__ __forceinline__ int geff(int n, int G, int xr = 0) {
#if BG_CONVERT && !MK_PER_PHASE && BG_GEFF
    if (G % 8 != 0 || n <= 0) return G;
    const int rounds = (n + G - 1) / G + xr, g = ((n + rounds - 1) / rounds + 7) & ~7;
    return g < G ? g : G;
#else
    return G;
#endif
}
#ifndef XR_GEMM1E
#define XR_GEMM1E 0
#endif
#ifndef XR_GEMM3E
#define XR_GEMM3E 0
#endif
#ifndef XR_MOE_UP0
#define XR_MOE_UP0 0
#endif
#ifndef XR_MOE_DN0
#define XR_MOE_DN0 0
#endif
#ifndef XR_GEMM1O
#define XR_GEMM1O 0
#endif

__global__ void __launch_bounds__(NWAVES * 64, 2) trunk_fwd(Args args) {
    extern __shared__ __attribute__((aligned(16))) unsigned char lds[];
    Frame F;
    F.lds = (LAS unsigned char*)lds;
    F.MISC = (volatile LAS unsigned*)(F.lds + MISC_OFF);
    F.tid = threadIdx.x; F.lane = F.tid & 63; F.wave = __builtin_amdgcn_readfirstlane(F.tid >> 6);
    F.G = gridDim.x; { const int bx = blockIdx.x; F.vcu = (F.G % 8 == 0) ? (bx % 8) * (F.G / 8) + bx / 8 : bx; }
    F.ws = args.ws; F.ctl = (gu32*)(args.ws + WS_CTL);
    for (int u = F.tid; u < (LDS_BYTES - LDSCTL_OFF) / 4; u += NWAVES * 64) ((LAS unsigned*)(F.lds + LDSCTL_OFF))[u] = 0u;
    __syncthreads();
    XcdBarrier bar; bar.bar = (unsigned*)(F.ctl + CW_BAR); bar.x = 0; bar.st = nullptr;
#if !MK_PER_PHASE
    bar = xcd_barrier_post((unsigned*)(F.ctl + CW_BAR), F.MISC + 8);
#endif
    const int lo = args.ph_lo, hi = args.ph_hi;
#define IN(k) (lo <= (k) && (k) < hi)
#if MK_PER_PHASE
#define SEAM(k) do { } while (0)
#else
#define SEAM(k) do { if (IN(k) && IN((k) + 1)) xcd_barrier(bar); } while (0)
#endif
#if BG_CONVERT && !MK_PER_PHASE && BG_FILL
#define SEAMF(k) do { if (IN(k) && IN((k) + 1)) xcd_barrier_fill(bar, F, args); } while (0)
#else
#define SEAMF(k) SEAM(k)
#endif
    bf16* const A1 = (bf16*)(F.ws + WS_A1); bf16* const MIX = (bf16*)(F.ws + WS_MIX); bf16* const H = (bf16*)(F.ws + WS_H); const float* const MOD = (const float*)(F.ws + WS_MOD);
    PG8_LAS unsigned char* const ring = (PG8_LAS unsigned char*)(F.lds + RING_OFF);

#ifndef DUP_PHASE
#define DUP_PHASE (-1)
#endif
#ifndef PROBE_PHASE
#define PROBE_PHASE (-1)
#endif
constexpr size_t WS_DUMMY = 1600 * MiB;
#define PROBE(k, ...) do { if (PROBE_PHASE == (k) && IN(k)) { for (int r_ = 0; r_ < 3; ++r_) { __VA_ARGS__ xcd_barrier(bar); } } } while (0)
#define PH(k, ...) do { if (IN(k)) { __VA_ARGS__ if (DUP_PHASE == (k)) { for (int r_ = 0; r_ < 3; ++r_) { xcd_barrier(bar); __VA_ARGS__ } } } SEAM(k); } while (0)
#if BG_CONVERT
#define FILL_UNTIL(lim) fill_until(F, args, (lim))
#else
#define FILL_UNTIL(lim) do { } while (0)
#endif
#define PHF(k, ...) do { if (IN(k)) { __VA_ARGS__ if (DUP_PHASE == (k)) { for (int r_ = 0; r_ < 3; ++r_) { xcd_barrier(bar); __VA_ARGS__ } } } SEAMF(k); } while (0)
#define GEMM_STATIC(GE, EPI, Aptr, Bptr, N_, K_, ...) do { if ((int)blockIdx.x < (GE)) { pg8::Gemm g{(const bf16*)(Aptr), (const bf16*)(Bptr), (K_), (K_), (K_), nullptr}; pg8::StaticOrder S; S.init(T, (N_), (GE), (int)blockIdx.x); \
        pg8::EPI E{__VA_ARGS__}; pg8::gemm_phase<pg8::EPI, pg8::StaticOrder, false>(ring, g, S, E, F.wave); } } while (0)
#ifndef MOE_F32B
#define MOE_F32B 0
#endif
#define GEMM_MOE_F(EPI, GATH, Aptr, M0, M1, ESTR, LDN, COLMUL, HOFF, K_, layer, ...) do { const int nrt = __builtin_amdgcn_readfirstlane(*(const int*)(F.ctl + CW_NRT + (layer) * 64)); \
        pg8::Gemm g{(const bf16*)(Aptr), nullptr, (K_), 0, (K_), (const int*)(F.ctl + CW_SLOT + (layer) * MAXSLOT)}; pg8::BSrc bs{(M0), (M1), (size_t)(ESTR), (LDN), (COLMUL), (HOFF)}; \
        pg8::MoeOrder S; S.init((const int*)(F.ctl + CW_TEXP + (layer) * 256), nrt, F.G, (int)blockIdx.x); \
        pg8::EPI E{__VA_ARGS__}; pg8::gemm_phase_f32b<pg8::EPI, pg8::MoeOrder, GATH>(ring, g, bs, S, E, F.wave); } while (0)
#define GEMM_MOE_CHAIN(layer, Bgu, Bdn) do { const int nrt = __builtin_amdgcn_readfirstlane(moe_tables(F, (layer), F.wave * 64 + lane_id_())); \
        const PG8_LAS int* texp_ = (const PG8_LAS int*)(F.lds + LDS_TAB); unsigned* rdy_ = (unsigned*)(F.ctl + CW_RDY + (layer) * 16384); \
        { pg8::Gemm g{(const bf16*)A1, (const bf16*)(Bgu), DM, DM, DM, (const int*)(ws + WS_POS) + (size_t)(layer) * NE * POSCAP}; pg8::MoePublishOrder S; S.init(texp_, texp_ + 256, nrt, POSCAP, F.G, (int)blockIdx.x); S.ready = rdy_; \
          pg8::EpiSwiGLUwt E{(bf16*)(ws + WS_U), DE}; pg8::gemm_phase<pg8::EpiSwiGLUwt, pg8::MoePublishOrder, true>(ring, g, S, E, F.wave); } \
        { pg8::Gemm g{(const bf16*)(ws + WS_U), (const bf16*)(Bdn), DE, DE, DE, nullptr}; pg8::MoeCountedOrder S; S.init(texp_, texp_ + 256, nrt, POSCAP, F.G, (int)blockIdx.x); S.ready = rdy_; S.need = 64u; S.tmo = (unsigned*)F.ctl; S.wv = F.wave; \
          pg8::EpiStoreBf16 E{(bf16*)(ws + WS_YS), DM, 7}; pg8::gemm_phase<pg8::EpiStoreBf16, pg8::MoeCountedOrder, false>(ring, g, S, E, F.wave); } } while (0)
#define GEMM_ORDER(EPI, ORDER, INIT, Aptr, Bptr, K_, ...) do { pg8::Gemm g{(const bf16*)(Aptr), (const bf16*)(Bptr), (K_), (K_), (K_), nullptr}; pg8::ORDER S; S.init INIT; \
        pg8::EPI E{__VA_ARGS__}; pg8::gemm_phase<pg8::EPI, pg8::ORDER, false>(ring, g, S, E, F.wave); } while (0)
#define GEMM_ORDER_G(GE, EPI, ORDER, INIT, Aptr, Bptr, K_, ...) do { const int ge_ = (GE); if ((int)blockIdx.x < ge_) { pg8::Gemm g{(const bf16*)(Aptr), (const bf16*)(Bptr), (K_), (K_), (K_), nullptr}; pg8::ORDER S; S.init INIT; \
        pg8::EPI E{__VA_ARGS__}; pg8::gemm_phase<pg8::EPI, pg8::ORDER, false>(ring, g, S, E, F.wave); } } while (0)
#define GEMM_ROUTER_X(Bptr) do { pg8::Gemm g{(const bf16*)A1, (const bf16*)(Bptr), DM, DM, DM / RKS, nullptr}; pg8::SplitKXOrder S; S.init(RKS, DM / RKS, F.G, (int)blockIdx.x); \
        pg8::EpiLogits E{(float*)(ws + WS_LG), DM / RKS, (size_t)T * 64}; pg8::gemm_phase<pg8::EpiLogits, pg8::SplitKXOrder, false>(ring, g, S, E, F.wave); } while (0)
#define GEMM_ROUTER(Bptr) do { pg8::Gemm g{(const bf16*)A1, (const bf16*)(Bptr), DM, DM, DM / RKS, nullptr}; pg8::SplitKOrder S; S.init(T / 256, RKS, DM / RKS, F.G, (int)blockIdx.x); \
        pg8::EpiLogits E{(float*)(ws + WS_LG), DM / RKS, (size_t)T * 64}; pg8::gemm_phase<pg8::EpiLogits, pg8::SplitKOrder, false>(ring, g, S, E, F.wave); } while (0)
#define GEMM_MOE(XR, EPI, GATH, Aptr, Bptr, K_, layer, ...) do { const int nrt = __builtin_amdgcn_readfirstlane(moe_tables(F, (layer), F.wave * 64 + lane_id_())); \
        const int ge_ = geff(nrt * 8, F.G, (XR)); if ((int)blockIdx.x < ge_) { \
        pg8::Gemm g{(const bf16*)(Aptr), (const bf16*)(Bptr), (K_), (K_), (K_), (const int*)(ws + WS_POS) + (size_t)(layer) * NE * POSCAP}; pg8::MoeOrder S; \
        S.init((const PG8_LAS int*)(F.lds + LDS_TAB), (const PG8_LAS int*)(F.lds + LDS_TAB) + 256, nrt, POSCAP, ge_, (int)blockIdx.x); \
        pg8::EPI E{__VA_ARGS__}; pg8::gemm_phase<pg8::EPI, pg8::MoeOrder, GATH>(ring, g, S, E, F.wave); } } while (0)
    unsigned char* const ws = F.ws;
    PH(0, p0_prologue(F, args););
    PH(1, p_l0_mod1(F, args););
#ifdef NEXTRA_BAR
    for (int i_ = 0; i_ < NEXTRA_BAR; ++i_) xcd_barrier(bar);
#endif
    PHF(2, GEMM_STATIC(geff(72 * (KR_IN_POST1 ? 10 : 11), F.G, XR_GEMM1E), EpiStoreBf16, A1, ws + WS_WE_IN, (KR_IN_POST1 ? 2560 : EVEN_IN_P), DM, (bf16*)(ws + WS_Y1), EVEN_IN_P, 0x7fffffff););
    PROBE(3, p_even_post1(F, args, WS_DUMMY););
    PH(3, p_even_post1(F, args););
    PHF(4, GEMM_ORDER(EpiProj2, Proj2Order, (T, F.G, (int)blockIdx.x), ws + WS_CQN, ws + WS_WE_UQ, 512, (bf16*)(ws + WS_QB), (bf16*)(ws + WS_KV)););
    PH(5, p_even_post2(F, args););
#if USE_NAIVE_ATTN
    PH(6, p_even_attn_naive(F););
#else
    PHF(6, p_even_attn(F, args, (char*)lds););
#endif
    PHF(7, GEMM_STATIC(geff(72 * 8, F.G, XR_GEMM3E), EpiResidInit, MIX, ws + WS_WE_OUT, DM, DM, H, MOD + (size_t)0 * 9 * 12288 + 2 * 2048, args.in[I_X], args.in[I_CTX]););
#if FUSED_ROUTE
    PH(8, p_mod2_route(F, args, 0); FILL_UNTIL(NCHUNK_L0););
#else
    PH(8, p_mod2(F, 0););
    PH(9, GEMM_ROUTER(ws + WS_WR););
    PH(10, p_route(F, args, 0););
#endif
#if MOE_HANDOFF
    PH(12, GEMM_MOE_CHAIN(0, ws + WS_WGU, ws + WS_WDN););
#elif MOE_F32B
    PH(12, GEMM_MOE_F(EpiSwiGLU, true, A1, args.in[I_WG], args.in[I_WU], 2048 * 1024, 1024, 128, 0, DM, 0, (bf16*)(ws + WS_U), DE););
    PH(13, GEMM_MOE_F(EpiStoreBf16, false, ws + WS_U, args.in[I_WD], args.in[I_WD], 1024 * 2048, 2048, 256, 128, DE, 0, (bf16*)(ws + WS_YS), DM, 7););
#else
    PHF(12, GEMM_MOE(XR_MOE_UP0, EpiSwiGLU, true, A1, ws + WS_WGU, DM, 0, (bf16*)(ws + WS_U), DE););
    PHF(13, GEMM_MOE(XR_MOE_DN0, EpiStoreBf16, false, ws + WS_U, ws + WS_WDN, DE, 0, (bf16*)(ws + WS_YS), DM, 7););
#endif
    PROBE(14, p_l1_mod1(F, WS_DUMMY, WS_DUMMY + 160 * MiB););
    PH(14, p_l1_mod1(F););
    PHF(15, GEMM_ORDER_G(geff(64 * 18 + 80, F.G, XR_GEMM1O), EpiStoreBf16, OddInOrder, (ge_, (int)blockIdx.x), A1, ws + WS_WO_IN, DM, (bf16*)(ws + WS_Y1), ODD_IN, 0x7fffffff););
    PROBE(16, p_odd_post1(F, args, WS_DUMMY););
    PH(16, p_odd_post1(F, args););
#if USE_NAIVE_ATTN
    PH(17, p_odd_attn_naive(F, args););
    PH(18, ;);
#else
    PHF(17, p_odd_attn(F, args, (char*)lds););
#if !ATT_DIFF_FUSED
    PH(18, p_odd_combine(F, args););
#endif
#endif
    PHF(19, GEMM_ORDER(EpiResid, XOnlyOrder, (DM, F.G, (int)blockIdx.x), MIX, ws + WS_WO_OUT, DM, H, MOD + (size_t)1 * 9 * 12288 + 2 * 2048););
#if FUSED_ROUTE
    PH(20, p_mod2_route(F, args, 1); FILL_UNTIL(NCHUNK_L1GU););
#else
    PH(20, p_mod2(F, 1););
    PH(21, GEMM_ROUTER_X((const bf16*)(ws + WS_WR) + (size_t)256 * 2048););
    PH(22, p_route(F, args, 1););
#endif
#if MOE_HANDOFF
    PH(24, GEMM_MOE_CHAIN(1, (const bf16*)(ws + WS_WGU) + (size_t)32 * 2048 * 2048, (const bf16*)(ws + WS_WDN) + (size_t)32 * 2048 * 1024););
#elif MOE_F32B
    PH(24, GEMM_MOE_F(EpiSwiGLU, true, A1, args.in[I_WG] + (size_t)32 * 2048 * 1024, args.in[I_WU] + (size_t)32 * 2048 * 1024, 2048 * 1024, 1024, 128, 0, DM, 1, (bf16*)(ws + WS_U), DE););
    PH(25, GEMM_MOE_F(EpiStoreBf16, false, ws + WS_U, args.in[I_WD] + (size_t)32 * 1024 * 2048, args.in[I_WD] + (size_t)32 * 1024 * 2048, 1024 * 2048, 2048, 256, 128, DE, 1, (bf16*)(ws + WS_YS), DM, 7););
#else
    PHF(24, GEMM_MOE(0, EpiSwiGLU, true, A1, (const bf16*)(ws + WS_WGU) + (size_t)32 * 2048 * 2048, DM, 1, (bf16*)(ws + WS_U), DE); FILL_UNTIL(NCHUNK););
    PH(25, GEMM_MOE(0, EpiStoreBf16, false, ws + WS_U, (const bf16*)(ws + WS_WDN) + (size_t)32 * 2048 * 1024, DE, 1, (bf16*)(ws + WS_YS), DM, 7););
#endif
    PH(26, p_final(F, args.out););
#undef IN
#undef SEAM
}

extern "C" void kernel_launch(void* const* d_in, const int* in_sizes, int n_in, void* d_out, int out_size, void* d_ws, size_t ws_size, hipStream_t stream) {
    static int grid = 0;
    if (grid == 0) {
        if (n_in != 35 || out_size != NB * SEQ * DM || ws_size < WS_END) { fprintf(stderr, "kernel_launch: unexpected shapes: n_in %d out %d ws %zu (need %zu)\n", n_in, out_size, ws_size, (size_t)WS_END); grid = -1; return; }
        int dev = 0, cus = 0, per_cu = 0;
        if (hipGetDevice(&dev) != hipSuccess || hipDeviceGetAttribute(&cus, hipDeviceAttributeMultiprocessorCount, dev) != hipSuccess) { grid = -1; return; }
        if (hipFuncSetAttribute((const void*)trunk_fwd, hipFuncAttributeMaxDynamicSharedMemorySize, LDS_BYTES) != hipSuccess) { fprintf(stderr, "kernel_launch: hipFuncSetAttribute failed\n"); grid = -1; return; }
        if (hipOccupancyMaxActiveBlocksPerMultiprocessor(&per_cu, (const void*)trunk_fwd, NWAVES * 64, LDS_BYTES) != hipSuccess || per_cu < 1)
            fprintf(stderr, "kernel_launch: occupancy query reports %d workgroups per CU\n", per_cu);
        (void)hipGetLastError();
        grid = cus;
    }
    if (grid < 0) return;
    if (hipMemsetAsync((char*)d_ws + WS_CTL, 0, CTL_ZERO_BYTES, stream) != hipSuccess) { fprintf(stderr, "kernel_launch: memset failed\n"); return; }
    if (hipMemsetAsync((char*)d_ws + WS_POS, 0, (size_t)2 * NE * POSCAP * 4, stream) != hipSuccess) { fprintf(stderr, "kernel_launch: memset failed\n"); return; }
    Args a{};
    for (int i = 0; i < 35; ++i) a.in[i] = (const float*)d_in[i];
    a.out = (float*)d_out; a.ws = (unsigned char*)d_ws;
#if MK_PER_PHASE
    for (int p = 0; p < NPHASE; ++p) { a.ph_lo = p; a.ph_hi = p + 1; hipLaunchKernelGGL(trunk_fwd, dim3(grid), dim3(NWAVES * 64), LDS_BYTES, stream, a); }
#else
    a.ph_lo = 0; a.ph_hi = NPHASE; hipLaunchKernelGGL(trunk_fwd, dim3(grid), dim3(NWAVES * 64), LDS_BYTES, stream, a);
#endif
    const hipError_t le = hipPeekAtLastError();
    if (le != hipSuccess) fprintf(stderr, "kernel_launch: launch failed: %s\n", hipGetErrorName(le));
}
```

```cpp
#include <hip/hip_runtime.h>
#include <cstdio>
#include <cstdint>
__device__ __forceinline__ int lane_id_() { return (int)__builtin_amdgcn_mbcnt_hi(~0u, __builtin_amdgcn_mbcnt_lo(~0u, 0u)); }
#define MK_PER_PHASE 0
#define TR_NT_LOAD 1
namespace pg8 {
#define PG8_LAS __attribute__((address_space(3)))
typedef unsigned short bf16_t;
typedef short bf16x8 __attribute__((ext_vector_type(8)));
typedef float f32x4 __attribute__((ext_vector_type(4)));
typedef unsigned u32x4 __attribute__((ext_vector_type(4)));
constexpr int BM = 256, BK = 64, HALF = 128, HTB = HALF * BK * 2  , STAGE_BYTES = 8 * HTB, NXCD = 8, WGM = 8;

__host__ __device__ __forceinline__ int lds_byte(int r, int c) { const int st = (r >> 4) * 2 + (c >> 5), rr = r & 15, cc = c & 31, ob = rr * 64 + cc * 2; return st * 1024 + (ob ^ (((ob >> 9) & 1) << 5)); }
__host__ __device__ __forceinline__ void stage_rc(int b, int& R, int& C) { const int st = b / 1024, sb = b % 1024, swz = sb ^ (((sb >> 9) & 1) << 5); R = (st >> 1) * 16 + swz / 64; C = (st & 1) * 32 + (swz % 64) / 2; }
__host__ __device__ __forceinline__ int perm32(int rho) { const int n = rho >> 4, i = rho & 15; return 8 * (i >> 2) + 4 * n + (i & 3); }

struct Unit { int pm, pn, ko, kt, gb; };
struct Gemm { const bf16_t* A; const bf16_t* Bt; int lda, ldb, K; const int* rowidx; };

struct StaticOrder {
    int nM, nN, nwg, G, c;
    __host__ __device__ void init(int M, int N, int G_, int c_) { nM = M / BM; nN = N / BM; nwg = nM * nN; G = G_; c = c_; }
    __host__ __device__ bool next(int i, Unit& u) const {
        const long L = (long)i * G + c; if (L >= nwg) return false;
        int wgid = (int)L; { const int q = nwg / NXCD, r = nwg % NXCD, xcd = wgid % NXCD, off = wgid / NXCD; wgid = (xcd < r ? xcd * (q + 1) : r * (q + 1) + (xcd - r) * q) + off; }
        const int nig = WGM * nN, gid = wgid / nig, fm = gid * WGM, gsz = (nM - fm) < WGM ? (nM - fm) : WGM;
        u.pm = fm + ((wgid % nig) % gsz); u.pn = (wgid % nig) / gsz; u.ko = 0; u.kt = 0; u.gb = u.pm * BM; return true;
    }
    __device__ __forceinline__ void a_ready(const Unit&) const {}
    __device__ __forceinline__ void done(const Unit&) const {}
};


__device__ __forceinline__ unsigned cvt_pk_bf16(float lo, float hi) { unsigned r; asm volatile("v_cvt_pk_bf16_f32 %0, %1, %2" : "=v"(r) : "v"(lo), "v"(hi)); return r; }

struct EpiStoreBf16 {
    static constexpr bool PERM = true, AFTER_DRAIN = false;
    bf16_t* O; int ldc; int pn_mask;
    __device__ __forceinline__ void operator()(const f32x4 (&acc)[2][2][4][2], const Unit& u, int wr, int wc, int fr, int fq) const {
        const int row0 = u.pm * BM + wr * 64 + fr, col0 = (u.pn & pn_mask) * BM + wc * 32 + 8 * fq;
#pragma unroll
        for (int ai = 0; ai < 2; ++ai)
#pragma unroll
            for (int m = 0; m < 4; ++m) { bf16_t* rowp = O + (size_t)(row0 + ai * HALF + m * 16) * ldc + col0;
#pragma unroll
                for (int bj = 0; bj < 2; ++bj) { const f32x4 v0 = acc[ai][bj][m][0], v1 = acc[ai][bj][m][1];
                    u32x4 w; w.x = cvt_pk_bf16(v0[0], v0[1]); w.y = cvt_pk_bf16(v0[2], v0[3]); w.z = cvt_pk_bf16(v1[0], v1[1]); w.w = cvt_pk_bf16(v1[2], v1[3]);
                    *(u32x4*)(rowp + bj * HALF) = w; } }
    }
};
__device__ __forceinline__ float silu_f(float x) { return x * __builtin_amdgcn_rcpf(1.0f + __builtin_amdgcn_exp2f(-1.4426950408889634f * x)); }
struct EpiSwiGLU {
    static constexpr bool PERM = true, AFTER_DRAIN = false;
    bf16_t* O; int ldc;
    __device__ __forceinline__ void operator()(const f32x4 (&acc)[2][2][4][2], const Unit& u, int wr, int wc, int fr, int fq) const {
        const int row0 = u.pm * BM + wr * 64 + fr, col0 = (u.pn & 7) * HALF + wc * 32 + 8 * fq;
#pragma unroll
        for (int ai = 0; ai < 2; ++ai)
#pragma unroll
            for (int m = 0; m < 4; ++m) { bf16_t* rowp = O + (size_t)(row0 + ai * HALF + m * 16) * ldc + col0;
                const f32x4 g0 = acc[ai][0][m][0], g1 = acc[ai][0][m][1], u0 = acc[ai][1][m][0], u1 = acc[ai][1][m][1];
                u32x4 w; w.x = cvt_pk_bf16(silu_f(g0[0]) * u0[0], silu_f(g0[1]) * u0[1]); w.y = cvt_pk_bf16(silu_f(g0[2]) * u0[2], silu_f(g0[3]) * u0[3]);
                w.z = cvt_pk_bf16(silu_f(g1[0]) * u1[0], silu_f(g1[1]) * u1[1]); w.w = cvt_pk_bf16(silu_f(g1[2]) * u1[2], silu_f(g1[3]) * u1[3]);
                *(u32x4*)rowp = w; }
    }
};
__device__ __forceinline__ float bf_lo(unsigned w) { return __builtin_bit_cast(float, w << 16); }
__device__ __forceinline__ float bf_hi(unsigned w) { return __builtin_bit_cast(float, w & 0xffff0000u); }
struct EpiResid {
    static constexpr bool PERM = true, AFTER_DRAIN = false;
    bf16_t* H; const float* modg;
    __device__ __forceinline__ void operator()(const f32x4 (&acc)[2][2][4][2], const Unit& u, int wr, int wc, int fr, int fq) const {
        const int row0 = u.pm * BM + wr * 64 + fr, col0 = u.pn * BM + wc * 32 + 8 * fq;
        const int j = (u.pm % 9 == 0) ? 8 : (u.pm / 9);
        const float* g = modg + (size_t)j * 12288 + col0;
        f32x4 gv[2][2];
#pragma unroll
        for (int bj = 0; bj < 2; ++bj)
#pragma unroll
            for (int n = 0; n < 2; ++n) gv[bj][n] = *(const f32x4*)(g + bj * HALF + 4 * n);
#pragma unroll
        for (int ai = 0; ai < 2; ++ai)
#pragma unroll
            for (int m = 0; m < 4; ++m) { bf16_t* rowp = H + (size_t)(row0 + ai * HALF + m * 16) * 2048 + col0;
#pragma unroll
                for (int bj = 0; bj < 2; ++bj) { u32x4* p = (u32x4*)(rowp + bj * HALF); const u32x4 h = *p;
                    const f32x4 a0 = gv[bj][0] * acc[ai][bj][m][0], a1 = gv[bj][1] * acc[ai][bj][m][1];
                    u32x4 w; w.x = cvt_pk_bf16(bf_lo(h.x) + a0[0], bf_hi(h.x) + a0[1]); w.y = cvt_pk_bf16(bf_lo(h.y) + a0[2], bf_hi(h.y) + a0[3]);
                    w.z = cvt_pk_bf16(bf_lo(h.z) + a1[0], bf_hi(h.z) + a1[1]); w.w = cvt_pk_bf16(bf_lo(h.w) + a1[2], bf_hi(h.w) + a1[3]);
                    *p = w; } }
    }
};
struct EpiResidInit {
    static constexpr bool PERM = true, AFTER_DRAIN = false;
    bf16_t* H; const float* modg; const float* xin; const float* ctxin;
    __device__ __forceinline__ void operator()(const f32x4 (&acc)[2][2][4][2], const Unit& u, int wr, int wc, int fr, int fq) const {
        const int rl0 = wr * 64 + fr, col0 = u.pn * BM + wc * 32 + 8 * fq;
        const int b = u.pm / 9, t = u.pm - 9 * b, j = (t == 0) ? 8 : b;
        const float* src = (t == 0) ? ctxin + (size_t)(b * 256) * 2048 : xin + (size_t)(b * 2048 + (t - 1) * 256) * 2048;
        const float* g = modg + (size_t)j * 12288 + col0;
        f32x4 gv[2][2];
#pragma unroll
        for (int bj = 0; bj < 2; ++bj)
#pragma unroll
            for (int n = 0; n < 2; ++n) gv[bj][n] = *(const f32x4*)(g + bj * HALF + 4 * n);
#pragma unroll
        for (int ai = 0; ai < 2; ++ai)
#pragma unroll
            for (int m = 0; m < 4; ++m) { const int rl = rl0 + ai * HALF + m * 16; bf16_t* rowp = H + (size_t)(u.pm * BM + rl) * 2048 + col0; const float* srow = src + (size_t)rl * 2048 + col0;
#pragma unroll
                for (int bj = 0; bj < 2; ++bj) { const f32x4 h0 = *(const f32x4*)(srow + bj * HALF), h1 = *(const f32x4*)(srow + bj * HALF + 4);
                    const f32x4 v0 = h0 + gv[bj][0] * acc[ai][bj][m][0], v1 = h1 + gv[bj][1] * acc[ai][bj][m][1];
                    u32x4 w; w.x = cvt_pk_bf16(v0[0], v0[1]); w.y = cvt_pk_bf16(v0[2], v0[3]); w.z = cvt_pk_bf16(v1[0], v1[1]); w.w = cvt_pk_bf16(v1[2], v1[3]);
                    *(u32x4*)(rowp + bj * HALF) = w; } }
    }
};
struct EpiLogits {
    static constexpr bool PERM = false, AFTER_DRAIN = false;
    float* LG; int kslice; size_t slice_stride;
    __device__ __forceinline__ void operator()(const f32x4 (&acc)[2][2][4][2], const Unit& u, int wr, int wc, int fr, int fq) const {
        if (wc >= 2) return;
        const int row0 = u.pm * BM + wr * 64 + fr, col0 = wc * 32 + 4 * fq;
        float* base = LG + (size_t)(u.ko / kslice) * slice_stride;
#pragma unroll
        for (int ai = 0; ai < 2; ++ai)
#pragma unroll
            for (int m = 0; m < 4; ++m) { float* rowp = base + (size_t)(row0 + ai * HALF + m * 16) * 64 + col0;
#pragma unroll
                for (int n = 0; n < 2; ++n) *(f32x4*)(rowp + n * 16) = acc[ai][0][m][n]; }
    }
};
struct SplitKOrder {
    int nM, KS, kslice, G, c;
    __device__ void init(int nM_, int KS_, int kslice_, int G_, int c_) { nM = nM_; KS = KS_; kslice = kslice_; G = G_; c = c_; }
    __device__ bool next(int i, Unit& u) const { const long L = (long)i * G + c; if (L >= (long)nM * KS) return false; const int ks = (int)L / nM; u.pm = (int)L - ks * nM; u.pn = 0; u.ko = ks * kslice; u.kt = 0; u.gb = 0; return true; }
    __device__ __forceinline__ void a_ready(const Unit&) const {}
    __device__ __forceinline__ void done(const Unit&) const {}
};
struct EvenInOrder {
    StaticOrder so; int G, c;
    __device__ void init(int M, int G_, int c_) { so.init(M, 2560, G_, c_); G = G_; c = c_; }
    __device__ bool next(int i, Unit& u) const {
        if (so.next(i, u)) return true;
        const long L = (long)i * G + c - so.nwg; if (L < 0 || L >= 72 * 4) return false;
        const int ks = (int)L / 72; u.pm = (int)L - ks * 72; u.pn = 10; u.ko = ks * 512; u.kt = 8; u.gb = 0; return true;
    }
    __device__ __forceinline__ void a_ready(const Unit&) const {}
    __device__ __forceinline__ void done(const Unit&) const {}
};
struct EpiEvenIn {
    static constexpr bool PERM = true, AFTER_DRAIN = false;
    bf16_t* Y; float* KRP;
    __device__ __forceinline__ void operator()(const f32x4 (&acc)[2][2][4][2], const Unit& u, int wr, int wc, int fr, int fq) const {
        if (u.pn < 10) { const EpiStoreBf16 e{Y, 2816, 0x7fffffff}; e(acc, u, wr, wc, fr, fq); return; }
        if (wc >= 2) return;
        const int row0 = u.pm * BM + wr * 64 + fr, col0 = wc * 32 + 8 * fq;
        float* base = KRP + (size_t)(u.ko >> 9) * ((size_t)18432 * 64);
#pragma unroll
        for (int ai = 0; ai < 2; ++ai)
#pragma unroll
            for (int m = 0; m < 4; ++m) { float* rowp = base + (size_t)(row0 + ai * HALF + m * 16) * 64 + col0;
#pragma unroll
                for (int n = 0; n < 2; ++n) *(f32x4*)(rowp + 4 * n) = acc[ai][0][m][n]; }
    }
};
struct Proj2Order {
    StaticOrder s1, s2; int G, c;
    __device__ void init(int M, int G_, int c_) { s1.init(M, 1536, G_, c_); s2.init(M, 2048, G_, c_); G = G_; c = c_; }
    __device__ bool next(int i, Unit& u) const {
        if (s1.next(i, u)) return true;
        StaticOrder t = s2; const long L = (long)i * G + c - s1.nwg; if (L < 0 || L >= s2.nwg) return false;
        t.G = 1; t.c = (int)L; if (!t.next(0, u)) return false;
        u.pm += 72; u.pn += 8; return true;
    }
    __device__ __forceinline__ void a_ready(const Unit&) const {}
    __device__ __forceinline__ void done(const Unit&) const {}
};
struct EpiProj2 {
    static constexpr bool PERM = true, AFTER_DRAIN = false;
    bf16_t* QB; bf16_t* KV;
    __device__ __forceinline__ void operator()(const f32x4 (&acc)[2][2][4][2], const Unit& u, int wr, int wc, int fr, int fq) const {
        if (u.pm < 72) { const EpiStoreBf16 e{QB, 1536, 0x7fffffff}; e(acc, u, wr, wc, fr, fq); }
        else { Unit v = u; v.pm -= 72; v.pn -= 8; const EpiStoreBf16 e{KV, 2048, 0x7fffffff}; e(acc, v, wr, wc, fr, fq); }
    }
};
struct XOnlyOrder {
    StaticOrder so;
    __device__ void init(int N, int G_, int c_) { so.init(64 * BM, N, G_, c_); }
    __device__ bool next(int i, Unit& u) const { if (!so.next(i, u)) return false; u.pm = 9 * (u.pm >> 3) + 1 + (u.pm & 7); return true; }
    __device__ __forceinline__ void a_ready(const Unit&) const {}
    __device__ __forceinline__ void done(const Unit&) const {}
};
struct OddInOrder {
    StaticOrder so; int G, c;
    __device__ void init(int G_, int c_) { so.init(64 * BM, 18 * BM, G_, c_); G = G_; c = c_; }
    __device__ bool next(int i, Unit& u) const {
        if (so.next(i, u)) { u.pm = 9 * (u.pm >> 3) + 1 + (u.pm & 7); return true; }
        const long L = (long)i * G + c - 64 * 18; if (L >= 80) return false;
        const int b = (int)L / 10, j = (int)L - b * 10; u.pm = 9 * b; u.pn = j < 8 ? 4 + j : 8 + j; u.ko = 0; u.kt = 0; u.gb = 0; return true;
    }
    __device__ __forceinline__ void a_ready(const Unit&) const {}
    __device__ __forceinline__ void done(const Unit&) const {}
};
struct SplitKXOrder {
    int KS, kslice, G, c;
    __device__ void init(int KS_, int kslice_, int G_, int c_) { KS = KS_; kslice = kslice_; G = G_; c = c_; }
    __device__ bool next(int i, Unit& u) const { const long L = (long)i * G + c; if (L >= 64L * KS) return false; const int ks = (int)L / 64, x = (int)L - ks * 64; u.pm = 9 * (x >> 3) + 1 + (x & 7); u.pn = 0; u.ko = ks * kslice; u.kt = 0; u.gb = 0; return true; }
    __device__ __forceinline__ void a_ready(const Unit&) const {}
    __device__ __forceinline__ void done(const Unit&) const {}
};
struct MoeOrder {
    const PG8_LAS int* texp; const PG8_LAS int* frt; int nunits, G, c, cap;
    __device__ void init(const PG8_LAS int* texp_, const PG8_LAS int* frt_, int n_row_tiles, int cap_, int G_, int c_) { texp = texp_; frt = frt_; nunits = n_row_tiles * 8; cap = cap_; G = G_; c = c_; }
    __device__ bool next(int i, Unit& u) const {
        const long L = (long)i * G + c; if (L >= nunits) return false;
        int wgid = (int)L; { const int q = nunits / NXCD, r = nunits % NXCD, xcd = wgid % NXCD, off = wgid / NXCD; wgid = (xcd < r ? xcd * (q + 1) : r * (q + 1) + (xcd - r) * q) + off; }
        const int rt = wgid >> 3, pn = wgid & 7, e = __builtin_amdgcn_readfirstlane(texp[rt]);
        u.pm = rt; u.pn = e * 8 + pn; u.ko = 0; u.kt = 0; u.gb = e * cap + (rt - __builtin_amdgcn_readfirstlane(frt[e])) * BM; return true;
    }
    __device__ __forceinline__ void a_ready(const Unit&) const {}
    __device__ __forceinline__ void done(const Unit&) const {}
};

struct MoePublishOrder : MoeOrder {
    unsigned* ready;
    __device__ __forceinline__ void done(const Unit& u) const {
        asm volatile("s_waitcnt vmcnt(0)" ::: "memory");
        if (lane_id_() == 0) __hip_atomic_fetch_add(ready + 64 * u.pm, 1u, __ATOMIC_RELAXED, __HIP_MEMORY_SCOPE_AGENT);
    }
};
struct MoeCountedOrder : MoeOrder {
    unsigned* ready; unsigned need; unsigned* tmo; int wv;
    __device__ bool next(int i, Unit& u) const {
        const int k0 = (nunits - c + G - 1) / G;
        const long l = (long)c + (long)(k0 + i) * G - nunits; if (l >= nunits) return false;
        int wgid = (int)l; { const int q = nunits / NXCD, r = nunits % NXCD, xcd = wgid % NXCD, off = wgid / NXCD; wgid = (xcd < r ? xcd * (q + 1) : r * (q + 1) + (xcd - r) * q) + off; }
        const int rt = wgid >> 3, pn = wgid & 7, e = __builtin_amdgcn_readfirstlane(texp[rt]);
        u.pm = rt; u.pn = e * 8 + pn; u.ko = 0; u.kt = 0; u.gb = 0; return true;
    }
    __device__ __forceinline__ void a_ready(const Unit& u) const {
        if (wv == 0) {
            const unsigned long long t0 = __builtin_amdgcn_s_memrealtime(); unsigned polls = 0;
            while ((unsigned)__builtin_amdgcn_readfirstlane(__hip_atomic_load(ready + 64 * u.pm, __ATOMIC_RELAXED, __HIP_MEMORY_SCOPE_AGENT)) < need) {
                if ((++polls & 255u) == 0u && __builtin_amdgcn_readfirstlane(__hip_atomic_load(tmo, __ATOMIC_RELAXED, __HIP_MEMORY_SCOPE_AGENT)) != 0u) break;
                if (__builtin_amdgcn_s_memrealtime() - t0 > 2000000ull) {
                    if (lane_id_() == 0) __hip_atomic_store(tmo, 1u, __ATOMIC_RELAXED, __HIP_MEMORY_SCOPE_AGENT);
                    break; }
                __builtin_amdgcn_s_sleep(2); }
            __builtin_amdgcn_fence(__ATOMIC_ACQUIRE, "agent");
            asm volatile("s_waitcnt vmcnt(0)" ::: "memory");
        }
        asm volatile("" ::: "memory"); __builtin_amdgcn_s_barrier(); asm volatile("" ::: "memory");
    }
};
struct EpiSwiGLUwt {
    static constexpr bool PERM = true, AFTER_DRAIN = false;
    bf16_t* O; int ldc;
    __device__ __forceinline__ void operator()(const f32x4 (&acc)[2][2][4][2], const Unit& u, int wr, int wc, int fr, int fq) const {
        const int row0 = u.pm * BM + wr * 64 + fr, col0 = (u.pn & 7) * HALF + wc * 32 + 8 * fq;
        const __amdgpu_buffer_rsrc_t rsrc = __builtin_amdgcn_make_buffer_rsrc((void*)O, 0, 0x7fffffff, 0x00020000);
#pragma unroll
        for (int ai = 0; ai < 2; ++ai)
#pragma unroll
            for (int m = 0; m < 4; ++m) { const unsigned off = (unsigned)(((size_t)(row0 + ai * HALF + m * 16) * ldc + col0) * 2);
                const f32x4 g0 = acc[ai][0][m][0], g1 = acc[ai][0][m][1], u0 = acc[ai][1][m][0], u1 = acc[ai][1][m][1];
                u32x4 w; w.x = cvt_pk_bf16(silu_f(g0[0]) * u0[0], silu_f(g0[1]) * u0[1]); w.y = cvt_pk_bf16(silu_f(g0[2]) * u0[2], silu_f(g0[3]) * u0[3]);
                w.z = cvt_pk_bf16(silu_f(g1[0]) * u1[0], silu_f(g1[1]) * u1[1]); w.w = cvt_pk_bf16(silu_f(g1[2]) * u1[2], silu_f(g1[3]) * u1[3]);
                __builtin_amdgcn_raw_buffer_store_b128(w, rsrc, (int)off, 0, 16  ); }
    }
};
}
namespace pg8 {
template <class Epi, class Sched, bool GATHER = false>
__device__ __forceinline__ void gemm_phase(PG8_LAS unsigned char* lds, const Gemm g, const Sched& S, const Epi& E, int wv) {
    int tid = wv * 64 + lane_id_(); asm volatile("" : "+v"(tid));
    const int wid = __builtin_amdgcn_readfirstlane(tid >> 6), lane = tid & 63, wr = wid >> 2, wc = wid & 3, fr = lane & 15, fq = lane >> 4;
    const int K = g.K, lda = g.lda, ldb = g.ldb;
    unsigned va[2][2], vn[2][2], voffB[2]; int sR[2], sC[2];
#pragma unroll
    for (int i = 0; i < 2; ++i) { int R, C; stage_rc(tid * 16 + i * 8192, R, C); const int Rb = Epi::PERM ? ((R & ~31) + perm32(R & 31)) : R; sR[i] = R; sC[i] = C;
        voffB[i] = (unsigned)(Rb * ldb + C) * 2u;
        va[0][i] = (unsigned)(R * lda + C) * 2u; va[1][i] = (unsigned)((R + HALF) * lda + C) * 2u; vn[0][i] = va[0][i]; vn[1][i] = va[1][i]; }
    const size_t kstep = (size_t)(BK * 2);
    const size_t hstepB = (size_t)HALF * ldb * 2;
    const size_t tstepA = (size_t)BM * lda * 2, tstepB = (size_t)BM * ldb * 2;
    const unsigned ldsw = (unsigned)wid * 1024u;
    const int aoff = lds_byte(wr * 64 + fr, fq * 8), boff = lds_byte(wc * 32 + fr, fq * 8);
#define PG8_SA(b, h) (((b) * 2 + (h)) * HTB)
#define PG8_SB(b, h) ((4 + (b) * 2 + (h)) * HTB)
#define PG8_STAGE(bufoff, gbase, voff) do { _Pragma("unroll") for (int _i = 0; _i < 2; ++_i) \
        __builtin_amdgcn_global_load_lds((const unsigned*)((const char*)(gbase) + (voff)[_i]), (PG8_LAS unsigned*)(lds + (bufoff) + ldsw + _i * 8192), 16, 0, 0); } while (0)
#define PG8_LDA(dst, b, h) do { _Pragma("unroll") for (int m = 0; m < 4; ++m) _Pragma("unroll") for (int k = 0; k < 2; ++k) dst[m][k] = *(const PG8_LAS bf16x8*)(lds + PG8_SA(b, h) + aoff + m * 2048 + k * 1024); } while (0)
#define PG8_LDB(dst, b, h) do { _Pragma("unroll") for (int n = 0; n < 2; ++n) _Pragma("unroll") for (int k = 0; k < 2; ++k) dst[n][k] = *(const PG8_LAS bf16x8*)(lds + PG8_SB(b, h) + boff + n * 2048 + k * 1024); } while (0)
#define PG8_MMA(ai, bj, At, Bt) do { __builtin_amdgcn_s_setprio(1); _Pragma("unroll") for (int m = 0; m < 4; ++m) _Pragma("unroll") for (int n = 0; n < 2; ++n) _Pragma("unroll") for (int k = 0; k < 2; ++k) \
        acc[ai][bj][m][n] = __builtin_amdgcn_mfma_f32_16x16x32_bf16(Bt[n][k], At[m][k], acc[ai][bj][m][n], 0, 0, 0); __builtin_amdgcn_s_setprio(0); } while (0)
#define PG8_WAIT_V(n) asm volatile("s_waitcnt vmcnt(" #n ")" ::: "memory")
#define PG8_WAIT_L(n) asm volatile("s_waitcnt lgkmcnt(" #n ")" ::: "memory")
#define PG8_BAR __builtin_amdgcn_s_barrier()
#define PG8_SCHED __builtin_amdgcn_sched_barrier(0)
#define PG8_GATHER_OFFS(dst, u) do { if constexpr (GATHER) { _Pragma("unroll") for (int _h = 0; _h < 2; ++_h) _Pragma("unroll") for (int _i = 0; _i < 2; ++_i) \
        dst[_h][_i] = (unsigned)(g.rowidx[(u).gb + _h * HALF + sR[_i]] * lda + sC[_i]) * 2u; } } while (0)
    Unit cur, nxt; int ui = 0;
    if (!S.next(0, cur)) return;
    f32x4 acc[2][2][4][2];
#pragma unroll
    for (int a = 0; a < 2; ++a)
#pragma unroll
        for (int b = 0; b < 2; ++b)
#pragma unroll
            for (int m = 0; m < 4; ++m)
#pragma unroll
                for (int n = 0; n < 2; ++n) acc[a][b][m][n] = (f32x4){0.f, 0.f, 0.f, 0.f};
    bf16x8 At[4][2], B0[2][2], B1[2][2];
    const char* cA = (const char*)g.A + (GATHER ? (size_t)0 : (size_t)cur.pm * tstepA) + (size_t)cur.ko * 2; const char* cB = (const char*)g.Bt + (size_t)cur.pn * tstepB + (size_t)cur.ko * 2;
    PG8_GATHER_OFFS(va, cur);
    S.a_ready(cur);
    PG8_STAGE(PG8_SB(0, 0), cB, voffB); PG8_STAGE(PG8_SB(0, 1), cB + hstepB, voffB); PG8_STAGE(PG8_SA(0, 0), cA, va[0]); PG8_STAGE(PG8_SA(0, 1), cA, va[1]);
    if (wr == 1) PG8_BAR;
    PG8_WAIT_V(2); PG8_BAR;
    PG8_STAGE(PG8_SB(1, 0), cB + kstep, voffB); PG8_STAGE(PG8_SA(1, 0), cA + kstep, va[0]); PG8_STAGE(PG8_SB(1, 1), cB + hstepB + kstep, voffB);
    PG8_WAIT_V(6); PG8_BAR;
    for (;;) {
        const bool has_next = S.next(ui + 1, nxt);
        const char* nA = has_next ? (const char*)g.A + (GATHER ? (size_t)0 : (size_t)nxt.pm * tstepA) + (size_t)nxt.ko * 2 : cA; const char* nB = has_next ? (const char*)g.Bt + (size_t)nxt.pn * tstepB + (size_t)nxt.ko * 2 : cB;
        if constexpr (GATHER) { if (has_next) PG8_GATHER_OFFS(vn, nxt); else { _Pragma("unroll") for (int _h = 0; _h < 2; ++_h) _Pragma("unroll") for (int _i = 0; _i < 2; ++_i) vn[_h][_i] = va[_h][_i]; } }
        const int nt = K / BK;
        for (int t = 0; t < nt; t += 2) {
            const bool last = (t == nt - 2);
            const char* a1 = cA + (size_t)(t + 1) * kstep;
            const char* a2 = last ? nA : cA + (size_t)(t + 2) * kstep; const char* b2 = last ? nB : cB + (size_t)(t + 2) * kstep;
            const char* a3 = a2 + kstep; const char* b3 = b2 + kstep;
            unsigned v2[2][2];
#pragma unroll
            for (int _h = 0; _h < 2; ++_h)
#pragma unroll
                for (int _i = 0; _i < 2; ++_i) v2[_h][_i] = (GATHER && last) ? vn[_h][_i] : va[_h][_i];
            if (last && has_next) S.a_ready(nxt);
            PG8_LDB(B0, 0, 0); PG8_LDB(B1, 0, 1); PG8_SCHED; PG8_LDA(At, 0, 0); PG8_STAGE(PG8_SA(1, 1), a1, va[1]);
            PG8_WAIT_V(8); PG8_WAIT_L(0); PG8_BAR; PG8_MMA(0, 0, At, B0); PG8_MMA(0, 1, At, B1); PG8_BAR; PG8_SCHED;
            PG8_LDA(At, 0, 1); PG8_STAGE(PG8_SB(0, 0), b2, voffB); PG8_STAGE(PG8_SB(0, 1), b2 + hstepB, voffB); PG8_STAGE(PG8_SA(0, 0), a2, v2[0]);
            PG8_WAIT_V(8); PG8_WAIT_L(0); PG8_BAR; PG8_MMA(1, 0, At, B0); PG8_MMA(1, 1, At, B1); PG8_BAR; PG8_SCHED;
            PG8_LDB(B0, 1, 0); PG8_LDB(B1, 1, 1); PG8_SCHED; PG8_LDA(At, 1, 0); PG8_STAGE(PG8_SA(0, 1), a2, v2[1]);
            PG8_WAIT_V(8); PG8_WAIT_L(0); PG8_BAR; PG8_MMA(0, 0, At, B0); PG8_MMA(0, 1, At, B1); PG8_BAR; PG8_SCHED;
            PG8_LDA(At, 1, 1); PG8_STAGE(PG8_SB(1, 0), b3, voffB); PG8_STAGE(PG8_SB(1, 1), b3 + hstepB, voffB); PG8_STAGE(PG8_SA(1, 0), a3, v2[0]);
            PG8_WAIT_V(8); PG8_WAIT_L(0); PG8_BAR; PG8_MMA(1, 0, At, B0); PG8_MMA(1, 1, At, B1); PG8_BAR; PG8_SCHED;
        }
        if (wr == 0) PG8_BAR;
        E(acc, cur, wr, wc, fr, fq); S.done(cur);
        if (!has_next) break;
#pragma unroll
        for (int a = 0; a < 2; ++a)
#pragma unroll
            for (int b = 0; b < 2; ++b)
#pragma unroll
                for (int m = 0; m < 4; ++m)
#pragma unroll
                    for (int n = 0; n < 2; ++n) acc[a][b][m][n] = (f32x4){0.f, 0.f, 0.f, 0.f};
        cur = nxt; cA = nA; cB = nB; ++ui;
        if constexpr (GATHER) { _Pragma("unroll") for (int _h = 0; _h < 2; ++_h) _Pragma("unroll") for (int _i = 0; _i < 2; ++_i) va[_h][_i] = vn[_h][_i]; }
        if (wr == 1) PG8_BAR;
    }
    PG8_WAIT_V(0);
    PG8_BAR;
#undef PG8_SA
#undef PG8_SB
#undef PG8_STAGE
#undef PG8_LDA
#undef PG8_LDB
#undef PG8_MMA
#undef PG8_WAIT_V
#undef PG8_WAIT_L
#undef PG8_BAR
#undef PG8_SCHED
#undef PG8_GATHER_OFFS
}
typedef unsigned u32x2 __attribute__((ext_vector_type(2)));
struct BSrc { const float* m0; const float* m1; size_t estride; int ldn, colmul, hoff; };
template <class Epi, class Sched, bool GATHER = false>
__device__ __forceinline__ void gemm_phase_f32b(PG8_LAS unsigned char* lds, const Gemm g, const BSrc bs, const Sched& S, const Epi& E, int wv) {
    int tid = wv * 64 + lane_id_(); asm volatile("" : "+v"(tid));
    const int wid = __builtin_amdgcn_readfirstlane(tid >> 6), lane = tid & 63, wr = wid >> 2, wc = wid & 3, fr = lane & 15, fq = lane >> 4;
    const int K = g.K, lda = g.lda;
    unsigned va00, va01, va10, va11, vn00, vn01, vn10, vn11;
#pragma unroll
    for (int i = 0; i < 2; ++i) { int R, C; stage_rc(tid * 16 + i * 8192, R, C);
        const unsigned o0_ = (unsigned)(R * lda + C) * 2u, o1_ = (unsigned)((R + HALF) * lda + C) * 2u; if (i == 0) { va00 = o0_; va10 = o1_; } else { va01 = o0_; va11 = o1_; } }
    vn00 = va00; vn01 = va01; vn10 = va10; vn11 = va11;
    const size_t kstep = (size_t)(BK * 2);
    const size_t tstepA = (size_t)BM * lda * 2;
    const int kq = lane & 15, nq = (lane >> 4) + 4 * wid;
    const int brow = (nq >> 3) * 32 + (Epi::PERM ? (16 * (nq & 1) + 4 * ((nq & 7) >> 1)) : (4 * (nq & 7)));
    const int bwr = lds_byte(brow, 4 * kq);
    const unsigned bvo = (unsigned)((4 * kq) * bs.ldn + 4 * nq) * 4u;
    const size_t bkstep = (size_t)BK * bs.ldn * 4, brstep = (size_t)bs.ldn * 4;
    f32x4 w0, w1, w2, w3;
    const unsigned ldsw = (unsigned)wid * 1024u;
    const int aoff = lds_byte(wr * 64 + fr, fq * 8), boff = lds_byte(wc * 32 + fr, fq * 8);
#define PG8_SA(b, h) (((b) * 2 + (h)) * HTB)
#define PG8_SB(b, h) ((4 + (b) * 2 + (h)) * HTB)
#define PG8_BLOAD(src) do { const char* p0_ = (const char*)(src); const char* p1_ = p0_ + brstep; const char* p2_ = p1_ + brstep; const char* p3_ = p2_ + brstep; \
        asm volatile("s_nop 4\n\tglobal_load_dwordx4 %0, %4, %5\n\tglobal_load_dwordx4 %1, %4, %6\n\tglobal_load_dwordx4 %2, %4, %7\n\tglobal_load_dwordx4 %3, %4, %8" \
                     : "=&v"(w0), "=&v"(w1), "=&v"(w2), "=&v"(w3) : "v"(bvo), "s"(p0_), "s"(p1_), "s"(p2_), "s"(p3_)); } while (0)
#define PG8_BWAIT(n) asm volatile("s_waitcnt vmcnt(" #n ")" : "+v"(w0), "+v"(w1), "+v"(w2), "+v"(w3))
#define PG8_BWRITE(bufoff) do { PG8_LAS unsigned char* d_ = lds + (bufoff) + bwr; \
        { u32x2 c_; c_.x = cvt_pk_bf16(w0[0], w1[0]); c_.y = cvt_pk_bf16(w2[0], w3[0]); *(PG8_LAS u32x2*)(d_) = c_; } \
        { u32x2 c_; c_.x = cvt_pk_bf16(w0[1], w1[1]); c_.y = cvt_pk_bf16(w2[1], w3[1]); *(PG8_LAS u32x2*)(d_ + 64) = c_; } \
        { u32x2 c_; c_.x = cvt_pk_bf16(w0[2], w1[2]); c_.y = cvt_pk_bf16(w2[2], w3[2]); *(PG8_LAS u32x2*)(d_ + 128) = c_; } \
        { u32x2 c_; c_.x = cvt_pk_bf16(w0[3], w1[3]); c_.y = cvt_pk_bf16(w2[3], w3[3]); *(PG8_LAS u32x2*)(d_ + 192) = c_; } } while (0)
#define PG8_BSRC(u, h) ((const char*)(((h) ? bs.m1 : bs.m0) + (size_t)((u).pn >> 3) * bs.estride + (size_t)((u).pn & 7) * bs.colmul + (h) * bs.hoff) + (size_t)(u).ko * brstep)
#define PG8_STAGE(bufoff, gbase, o0, o1) do { \
        __builtin_amdgcn_global_load_lds((const unsigned*)((const char*)(gbase) + (o0)), (PG8_LAS unsigned*)(lds + (bufoff) + ldsw), 16, 0, 0); \
        __builtin_amdgcn_global_load_lds((const unsigned*)((const char*)(gbase) + (o1)), (PG8_LAS unsigned*)(lds + (bufoff) + ldsw + 8192), 16, 0, 0); } while (0)
#define PG8_LDA(dst, b, h) do { _Pragma("unroll") for (int m = 0; m < 4; ++m) _Pragma("unroll") for (int k = 0; k < 2; ++k) dst[m][k] = *(const PG8_LAS bf16x8*)(lds + PG8_SA(b, h) + aoff + m * 2048 + k * 1024); } while (0)
#define PG8_LDB(dst, b, h) do { _Pragma("unroll") for (int n = 0; n < 2; ++n) _Pragma("unroll") for (int k = 0; k < 2; ++k) dst[n][k] = *(const PG8_LAS bf16x8*)(lds + PG8_SB(b, h) + boff + n * 2048 + k * 1024); } while (0)
#define PG8_MMA(ai, bj, At, Bt) do { __builtin_amdgcn_s_setprio(1); _Pragma("unroll") for (int m = 0; m < 4; ++m) _Pragma("unroll") for (int n = 0; n < 2; ++n) _Pragma("unroll") for (int k = 0; k < 2; ++k) \
        acc[ai][bj][m][n] = __builtin_amdgcn_mfma_f32_16x16x32_bf16(Bt[n][k], At[m][k], acc[ai][bj][m][n], 0, 0, 0); __builtin_amdgcn_s_setprio(0); } while (0)
#define PG8_WAIT_V(n) asm volatile("s_waitcnt vmcnt(" #n ")" ::: "memory")
#define PG8_WAIT_L(n) asm volatile("s_waitcnt lgkmcnt(" #n ")" ::: "memory")
#define PG8_BAR __builtin_amdgcn_s_barrier()
#define PG8_SCHED __builtin_amdgcn_sched_barrier(0)
#define PG8_GATHER_OFFS(d00, d01, d10, d11, u) do { if constexpr (GATHER) { const int* ri_ = g.rowidx + (u).gb; int t_ = wv * 64 + lane_id_(); asm volatile("" : "+v"(t_)); \
        int R0_, C0_, R1_, C1_; stage_rc(t_ * 16, R0_, C0_); stage_rc(t_ * 16 + 8192, R1_, C1_);     \
        d00 = (unsigned)(ri_[R0_] * lda + C0_) * 2u; d01 = (unsigned)(ri_[R1_] * lda + C1_) * 2u; \
        d10 = (unsigned)(ri_[HALF + R0_] * lda + C0_) * 2u; d11 = (unsigned)(ri_[HALF + R1_] * lda + C1_) * 2u; } } while (0)
    Unit cur, nxt; int ui = 0;
    if (!S.next(0, cur)) return;
    f32x4 acc[2][2][4][2];
#pragma unroll
    for (int a = 0; a < 2; ++a)
#pragma unroll
        for (int b = 0; b < 2; ++b)
#pragma unroll
            for (int m = 0; m < 4; ++m)
#pragma unroll
                for (int n = 0; n < 2; ++n) acc[a][b][m][n] = (f32x4){0.f, 0.f, 0.f, 0.f};
    bf16x8 At[4][2], B0[2][2], B1[2][2];
    const char* cA = (const char*)g.A + (GATHER ? (size_t)0 : (size_t)cur.pm * tstepA) + (size_t)cur.ko * 2; const char* cB0 = PG8_BSRC(cur, 0); const char* cB1 = PG8_BSRC(cur, 1);
    PG8_GATHER_OFFS(va00, va01, va10, va11, cur);
    S.a_ready(cur);
    PG8_STAGE(PG8_SA(0, 0), cA, va00, va01); PG8_STAGE(PG8_SA(0, 1), cA, va10, va11);
    PG8_BLOAD(cB0); PG8_BWAIT(0); PG8_BWRITE(PG8_SB(0, 0));
    PG8_BLOAD(cB1); PG8_BWAIT(0); PG8_BWRITE(PG8_SB(0, 1));
    PG8_BLOAD(cB0 + bkstep); PG8_BWAIT(0); PG8_BWRITE(PG8_SB(1, 0));
    PG8_BLOAD(cB1 + bkstep); PG8_STAGE(PG8_SA(1, 0), cA + kstep, va00, va01);
    PG8_WAIT_L(0);
    if (wr == 1) PG8_BAR;
    PG8_BAR;
    PG8_BAR;
    for (;;) {
        const bool has_next = S.next(ui + 1, nxt);
        const char* nA = has_next ? (const char*)g.A + (GATHER ? (size_t)0 : (size_t)nxt.pm * tstepA) + (size_t)nxt.ko * 2 : cA; const char* nB0 = has_next ? PG8_BSRC(nxt, 0) : cB0; const char* nB1 = has_next ? PG8_BSRC(nxt, 1) : cB1;
        const int nt = K / BK;
        for (int t = 0; t < nt; t += 2) {
            const bool last = (t == nt - 2);
            const char* a1 = cA + (size_t)(t + 1) * kstep;
            const char* a2 = last ? nA : cA + (size_t)(t + 2) * kstep;
            const char* b20 = last ? nB0 : cB0 + (size_t)(t + 2) * bkstep; const char* b21 = last ? nB1 : cB1 + (size_t)(t + 2) * bkstep;
            const char* a3 = a2 + kstep; const char* b30 = b20 + bkstep; const char* b31 = b21 + bkstep;
            if constexpr (GATHER) { if (last) { if (has_next) PG8_GATHER_OFFS(vn00, vn01, vn10, vn11, nxt); else { vn00 = va00; vn01 = va01; vn10 = va10; vn11 = va11; } } }
            const bool usen_ = GATHER && last;
            const unsigned v200 = usen_ ? vn00 : va00, v201 = usen_ ? vn01 : va01, v210 = usen_ ? vn10 : va10, v211 = usen_ ? vn11 : va11;
            if (last && has_next) S.a_ready(nxt);
            PG8_LDB(B0, 0, 0); PG8_LDB(B1, 0, 1); PG8_SCHED; PG8_LDA(At, 0, 0);
            PG8_BWAIT(2); PG8_BWRITE(PG8_SB(1, 1)); PG8_BLOAD(b20); PG8_STAGE(PG8_SA(1, 1), a1, va10, va11);
            PG8_WAIT_L(0); PG8_BAR; PG8_MMA(0, 0, At, B0); PG8_MMA(0, 1, At, B1); PG8_BAR; PG8_SCHED;
            PG8_LDA(At, 0, 1);
            PG8_BWAIT(2); PG8_BWRITE(PG8_SB(0, 0)); PG8_BLOAD(b21); PG8_STAGE(PG8_SA(0, 0), a2, v200, v201);
            PG8_WAIT_L(0); PG8_BAR; PG8_MMA(1, 0, At, B0); PG8_MMA(1, 1, At, B1); PG8_BAR; PG8_SCHED;
            PG8_LDB(B0, 1, 0); PG8_LDB(B1, 1, 1); PG8_SCHED; PG8_LDA(At, 1, 0);
            PG8_BWAIT(2); PG8_BWRITE(PG8_SB(0, 1)); PG8_BLOAD(b30); PG8_STAGE(PG8_SA(0, 1), a2, v210, v211);
            PG8_WAIT_L(0); PG8_BAR; PG8_MMA(0, 0, At, B0); PG8_MMA(0, 1, At, B1); PG8_BAR; PG8_SCHED;
            PG8_LDA(At, 1, 1);
            PG8_BWAIT(2); PG8_BWRITE(PG8_SB(1, 0)); PG8_BLOAD(b31); PG8_STAGE(PG8_SA(1, 0), a3, v200, v201);
            PG8_WAIT_L(0); PG8_BAR; PG8_MMA(1, 0, At, B0); PG8_MMA(1, 1, At, B1); PG8_BAR; PG8_SCHED;
        }
        if (wr == 0) PG8_BAR;
        E(acc, cur, wr, wc, fr, fq); S.done(cur);
        if (!has_next) break;
#pragma unroll
        for (int a = 0; a < 2; ++a)
#pragma unroll
            for (int b = 0; b < 2; ++b)
#pragma unroll
                for (int m = 0; m < 4; ++m)
#pragma unroll
                    for (int n = 0; n < 2; ++n) acc[a][b][m][n] = (f32x4){0.f, 0.f, 0.f, 0.f};
        cur = nxt; cA = nA; cB0 = nB0; cB1 = nB1; ++ui;
        if constexpr (GATHER) { va00 = vn00; va01 = vn01; va10 = vn10; va11 = vn11; }
        if (wr == 1) PG8_BAR;
    }
    PG8_WAIT_V(0);
    PG8_BAR;
#undef PG8_SA
#undef PG8_SB
#undef PG8_STAGE
#undef PG8_BLOAD
#undef PG8_BWAIT
#undef PG8_BWRITE
#undef PG8_BSRC
#undef PG8_LDA
#undef PG8_LDB
#undef PG8_MMA
#undef PG8_WAIT_V
#undef PG8_WAIT_L
#undef PG8_BAR
#undef PG8_SCHED
#undef PG8_GATHER_OFFS
}
}

#ifndef PG8_SP2
#define PG8_SP2 true
#endif
#ifndef PG8_ALIGN
#define PG8_ALIGN true
#endif
#ifndef MK_PER_PHASE
#define MK_PER_PHASE 0
#endif

constexpr int NWAVES = 8;
constexpr int DM = 2048, NB = 8, SEQ = 2048, CTX = 256, TPB = CTX + SEQ, T = NB * TPB;
constexpr int EVEN_IN_P = 2816, ODD_IN = 4608;
constexpr int NE = 32, DE = 1024, MAXSLOT = 45056;
constexpr float NORM_EPS = 1e-6f;
constexpr float LAMBDA_INIT = 0.35550906759f;
constexpr int NPHASE = 27;
#ifndef MOE_F32B
#define MOE_F32B 0
#endif
#ifndef KR_IN_POST1
#define KR_IN_POST1 1
#endif
#ifndef MOE_HANDOFF
#define MOE_HANDOFF 0
#endif
#ifndef FUSED_ROUTE
#define FUSED_ROUTE 1
#endif
#ifndef ATT_DIFF_FUSED
#define ATT_DIFF_FUSED 1
#endif
#ifndef BG_CONVERT
#define BG_CONVERT 1
#endif
#ifndef BG_FILL
#define BG_FILL 1
#endif
#ifndef BG_GEFF
#define BG_GEFF 1
#endif
#ifndef USE_NAIVE_ATTN
#define USE_NAIVE_ATTN 0
#endif

constexpr size_t MiB = 1u << 20;
constexpr size_t WS_CTL = 0, CTL_ZERO_BYTES = 1 * MiB;
constexpr size_t WS_MOD = 1 * MiB;
constexpr size_t WS_ROPE = 2 * MiB;
constexpr size_t WS_ROUTE = 3 * MiB;
constexpr size_t WS_WE_IN = 4 * MiB;
constexpr size_t WS_WE_UQ = 15 * MiB;
constexpr size_t WS_WE_UKV = 17 * MiB;
constexpr size_t WS_WE_OUT = 19 * MiB;
constexpr size_t WS_WO_IN = 27 * MiB;
constexpr size_t WS_WO_OUT = 45 * MiB;
constexpr size_t WS_WR = 53 * MiB;
constexpr size_t WS_WGU = 60 * MiB;
constexpr size_t WS_WDN = 572 * MiB;
constexpr size_t WS_H = 828 * MiB;
constexpr size_t WS_A1 = 972 * MiB;
constexpr size_t WS_MIX = 1044 * MiB;
constexpr size_t WS_R = 1116 * MiB;
constexpr size_t WS_Y1 = WS_R;
constexpr size_t WS_CQN = WS_R + 162 * MiB;
constexpr size_t WS_CKVN = WS_R + 180 * MiB;
constexpr size_t WS_QB = WS_R + 198 * MiB;
constexpr size_t WS_KV = WS_R + 252 * MiB;
constexpr size_t WS_KB = WS_R + 324 * MiB;
constexpr size_t WS_XS = WS_R;
constexpr size_t WS_U = WS_R + 176 * MiB;
constexpr size_t WS_YS = WS_R + 264 * MiB;
constexpr size_t WS_LG = WS_R + 440 * MiB;
constexpr size_t WS_POS = WS_R + 460 * MiB;
constexpr int POSCAP = 18432;
constexpr size_t WS_END = WS_R + 466 * MiB;
constexpr int RKS = 4;
constexpr int CW_CNT = 64;
constexpr int CW_NRT = 256;
constexpr int CW_TEXP = 512;
constexpr int CW_BAR = 4096;
constexpr int CW_RDY = 32768;
constexpr int CW_ITEM = 8192;
constexpr int CW_SLOT = 16384;

constexpr int RING_OFF = 0, RING_BYTES = 131072;
constexpr int LDSCTL_OFF = RING_BYTES, MISC_OFF = LDSCTL_OFF + 320;
constexpr int LDS_BYTES = 147456;
constexpr int LDS_TAB = 135168;

#define GAS __attribute__((address_space(1)))
#define LAS __attribute__((address_space(3)))
typedef unsigned short bf16;
typedef unsigned v4u __attribute__((ext_vector_type(4)));
typedef unsigned v2u __attribute__((ext_vector_type(2)));
typedef float f32x4 __attribute__((ext_vector_type(4)));
typedef GAS unsigned gu32;
#define RLX_AGENT __ATOMIC_RELAXED, __HIP_MEMORY_SCOPE_AGENT
#define LDS_WAIT() asm volatile("s_waitcnt lgkmcnt(0)" ::: "memory")
#define VM_WAIT() asm volatile("s_waitcnt vmcnt(0)" ::: "memory")
__device__ __forceinline__ unsigned f2bf(float f) { unsigned u = __builtin_bit_cast(unsigned, f); return (u + 0x7fffu + ((u >> 16) & 1u)) >> 16; }
__device__ __forceinline__ unsigned pk2(float lo, float hi) { return f2bf(lo) | (f2bf(hi) << 16); }
__device__ __forceinline__ float bf2f(unsigned short h) { return __builtin_bit_cast(float, (unsigned)h << 16); }
__device__ __forceinline__ float bflo(unsigned w) { return __builtin_bit_cast(float, w << 16); }
__device__ __forceinline__ float bfhi(unsigned w) { return __builtin_bit_cast(float, w & 0xffff0000u); }
__device__ __forceinline__ float wave_sum(float v) {
#pragma unroll
    for (int o = 1; o < 64; o <<= 1) v += __shfl_xor(v, o);
    return v;
}
__device__ __forceinline__ float wave_max(float v) {
#pragma unroll
    for (int o = 1; o < 64; o <<= 1) v = fmaxf(v, __shfl_xor(v, o));
    return v;
}
#define XB_TMO      128
#define XB_XCNT(j)  (256  + 64 * (j))
#define XB_XSUB(j)  (1280 + 64 * (j))
#define XB_XGEN(j)  (2304 + 64 * (j))
#define XB_TOP      3328
#define XB_TOPGEN   3392
#define XCD_BAR_WORDS 3456
#define XB_SPIN_CAP (1u << 18)

__device__ __forceinline__ unsigned xb_ld(unsigned* p)              { return __hip_atomic_load(p, __ATOMIC_RELAXED, __HIP_MEMORY_SCOPE_AGENT); }
__device__ __forceinline__ unsigned xb_add(unsigned* p, unsigned v) { return __hip_atomic_fetch_add(p, v, __ATOMIC_RELAXED, __HIP_MEMORY_SCOPE_AGENT); }
__device__ __forceinline__ unsigned xb_xcc_id() { return (unsigned)__builtin_amdgcn_s_getreg((3 << 11) | 20) & 0xFu; }
#define XB_SPIN(cond, bar) do { unsigned _sp = 0; while (cond) { __builtin_amdgcn_s_sleep(1); \
    if ((++_sp & 255u) == 0u) { if (xb_ld(&(bar)[XB_TMO])) break; if (_sp > XB_SPIN_CAP) { atomicAdd(&(bar)[XB_TMO], 1u); break; } } } } while (0)

struct XcdBarrier {
    unsigned* bar; unsigned x;
    volatile LAS unsigned* st;
};

__device__ __forceinline__ XcdBarrier xcd_barrier_post(unsigned* bar, volatile LAS unsigned* st) {
    XcdBarrier b; b.bar = bar; b.x = xb_xcc_id(); b.st = st;
    if (threadIdx.x == 0) (void)xb_add(&bar[XB_XCNT(b.x)], 1u);
    return b;
}
__device__ __forceinline__ void xcd_barrier_complete(unsigned* bar, unsigned x, unsigned& nloc, unsigned& nx) {
    const unsigned G = gridDim.x * gridDim.y * gridDim.z;
    unsigned sum, cnt, mine, sp = 0u;
    for (;;) {
        sum = 0u; cnt = 0u; mine = 0u;
#pragma unroll
        for (unsigned j = 0; j < 16; ++j) { const unsigned c = xb_ld(&bar[XB_XCNT(j)]); sum += c; cnt += (c > 0u) ? 1u : 0u; mine = (j == x) ? c : mine; }
        if (sum == G) break;
        __builtin_amdgcn_s_sleep(1);
        if ((++sp & 255u) == 0u) { if (xb_ld(&bar[XB_TMO])) break; if (sp > XB_SPIN_CAP) { atomicAdd(&bar[XB_TMO], 1u); break; } }
    }
    nloc = mine > 0u ? mine : 1u; nx = cnt > 0u ? cnt : 1u;
}

__device__ __forceinline__ void xcd_barrier(const XcdBarrier& b) {
    asm volatile("s_waitcnt vmcnt(0)" ::: "memory");
    __syncthreads();
    if (threadIdx.x == 0) {
        unsigned* bar = b.bar;
        __builtin_amdgcn_s_waitcnt(0);
        unsigned nloc = b.st[0], nx = b.st[1];
        if (nloc == 0u) { xcd_barrier_complete(bar, b.x, nloc, nx); b.st[0] = nloc; b.st[1] = nx; }
        const unsigned old = xb_add(&bar[XB_XSUB(b.x)], 1u);
        const unsigned gen = old / nloc;
        if (old + 1u == (gen + 1u) * nloc) {
            __builtin_amdgcn_fence(__ATOMIC_RELEASE, "agent");
            asm volatile("s_waitcnt vmcnt(0)" ::: "memory");
            const unsigned og = xb_add(&bar[XB_TOP], 1u);
            const unsigned tg = og / nx;
            if (og + 1u == (tg + 1u) * nx) xb_add(&bar[XB_TOPGEN], 1u);
            else XB_SPIN(xb_ld(&bar[XB_TOPGEN]) == tg, bar);
            __builtin_amdgcn_fence(__ATOMIC_ACQUIRE, "agent");
            xb_add(&bar[XB_XGEN(b.x)], 1u);
            asm volatile("s_waitcnt vmcnt(0)" ::: "memory");
        } else {
            XB_SPIN(xb_ld(&bar[XB_XGEN(b.x)]) == gen, bar);
            __builtin_amdgcn_fence(__ATOMIC_ACQUIRE, "agent");
            asm volatile("s_waitcnt vmcnt(0)" ::: "memory");
        }
    }
    __syncthreads();
}

struct Frame {
    LAS unsigned char* lds;
    volatile LAS unsigned* MISC;
    gu32* ctl;
    unsigned char* ws;
    int tid, lane, wave, vcu, G;
};
typedef short bf16x8_t __attribute__((ext_vector_type(8)));
struct LocalId { int tid, lane, wave; };
__device__ __forceinline__ LocalId local_id_w(int wave) { int t = wave * 64 + lane_id_(); asm volatile("" : "+v"(t)); LocalId l; l.tid = t; l.lane = t & 63; l.wave = wave; return l; }
#define local_id() local_id_w(F.wave)
struct Args { const float* in[35]; float* out; unsigned char* ws; int ph_lo, ph_hi; };
enum { I_X = 0, I_C, I_CTX, I_CCTX, I_MODW, I_MODB, I_EWIN, I_EWOUT, I_AQN, I_AKN, I_BCQN, I_BWUQ, I_BCKVN, I_BWUKV, I_BQN, I_BKN, I_OWIN, I_OWOUT,
       I_CQN, I_CKN, I_LQ1, I_LK1, I_LQ2, I_LK2, I_SUBLN, I_DQN, I_DKN, I_SINK, I_WRG, I_BRG, I_WRE, I_BRE, I_WG, I_WU, I_WD };

__device__ __forceinline__ int mod_index(int row) { const int b = row / TPB; return (row - b * TPB) < CTX ? 8 : b; }

__device__ __forceinline__ unsigned cvt_pk_bf16(float lo, float hi) { unsigned r; asm volatile("v_cvt_pk_bf16_f32 %0, %1, %2" : "=v"(r) : "v"(lo), "v"(hi)); return r; }
#ifndef TR_NT_LOAD
#define TR_NT_LOAD 0
#endif
struct TrAddr { const float* src; bf16* dst; int N, Kd; };
__device__ __forceinline__ void tr_load(f32x4 (&v)[8], const TrAddr& t, int lane) {
    const int kr = lane >> 3, cq = lane & 7;
#pragma unroll
#if TR_NT_LOAD
    for (int i = 0; i < 8; ++i) v[i] = __builtin_nontemporal_load((const f32x4*)(t.src + (size_t)(8 * kr + i) * t.N + 4 * cq));
#else
    for (int i = 0; i < 8; ++i) v[i] = *(const f32x4*)(t.src + (size_t)(8 * kr + i) * t.N + 4 * cq);
#endif
}
__device__ __forceinline__ void tr_store(const f32x4 (&v)[8], const TrAddr& t, int lane) {
    const int kr = lane >> 3, cq = lane & 7;
#pragma unroll
    for (int e = 0; e < 4; ++e) { v4u o; o.x = cvt_pk_bf16(v[0][e], v[1][e]); o.y = cvt_pk_bf16(v[2][e], v[3][e]); o.z = cvt_pk_bf16(v[4][e], v[5][e]); o.w = cvt_pk_bf16(v[6][e], v[7][e]);
        *(GAS v4u*)(t.dst + (size_t)(4 * cq + e) * t.Kd + 8 * kr) = o; }
}
__device__ __forceinline__ void transpose_item(const float* W, int N, int k0, int n0, bf16* dst, int Kd, LAS float* scr, int lane) {
    (void)scr; TrAddr t; t.src = W + (size_t)k0 * N + n0; t.dst = dst + k0; t.N = N; t.Kd = Kd;
    f32x4 v[8]; tr_load(v, t, lane); tr_store(v, t, lane);
}
__device__ __forceinline__ void small_transpose(const float* W, int K, int N, bf16* WT, int item, LAS float* scr, int lane) {
    const int nblk = N / 32, kb = item / nblk, nb = item - kb * nblk;
    transpose_item(W, N, kb * 64, nb * 32, WT + (size_t)(nb * 32) * K, K, scr, lane);
}
__device__ __forceinline__ TrAddr moe_item_addr(const Frame& F, const Args& a, int r) {
    int le, which, ri;
    if (r < 32 * 3072) { le = r / 3072; const int q = r - le * 3072; which = q >> 10; ri = q & 1023; }
    else if (r < 32 * 3072 + 32 * 2048) { const int r1 = r - 32 * 3072; le = 32 + (r1 >> 11); which = (r1 >> 10) & 1; ri = r1 & 1023; }
    else { const int r2 = r - (32 * 3072 + 32 * 2048); le = 32 + (r2 >> 10); which = 2; ri = r2 & 1023; }
    TrAddr t;
    if (which < 2) { const int kb = ri >> 5, n0 = (ri & 31) * 32;
        t.src = a.in[which == 0 ? I_WG : I_WU] + (size_t)le * 2048 * 1024 + (size_t)(kb * 64) * 1024 + n0; t.N = 1024;
        t.dst = (bf16*)(F.ws + WS_WGU) + (size_t)le * 2048 * 2048 + (size_t)((n0 >> 7) * 256 + which * 128 + (n0 & 127)) * 2048 + kb * 64; t.Kd = 2048;
    } else { const int kb = ri >> 6, n0 = (ri & 63) * 32;
        t.src = a.in[I_WD] + (size_t)le * 1024 * 2048 + (size_t)(kb * 64) * 2048 + n0; t.N = 2048;
        t.dst = (bf16*)(F.ws + WS_WDN) + (size_t)le * 2048 * 1024 + (size_t)n0 * 1024 + kb * 64; t.Kd = 1024; }
    return t;
}
__device__ __forceinline__ void moe_item(const Frame& F, const Args& a, int r, LAS float* scr, int lane) { (void)scr; const TrAddr t = moe_item_addr(F, a, r); f32x4 v[8]; tr_load(v, t, lane); tr_store(v, t, lane); }
__device__ __forceinline__ void p0_prologue(const Frame& F, const Args& a) {
    const LocalId L_ = local_id(); (void)L_;
    const int gt = F.vcu * 512 + L_.tid, NT = F.G * 512;
    {
        float2* t128 = (float2*)(F.ws + WS_ROPE); float2* t64 = (float2*)(F.ws + WS_ROPE + 16384);
        for (int i = gt; i < 3072; i += NT) {
            if (i < 2048) { const int pos = i >> 5, f = i & 31; const float inv = 1.0f / powf(10000.0f, (float)f / 32.0f); const float ang = (float)pos * inv; t128[i] = make_float2(cosf(ang), sinf(ang)); }
            else { const int k = i - 2048, pos = k >> 4, f = k & 15; const float inv = 1.0f / powf(10000.0f, (float)f / 16.0f); const float ang = (float)pos * inv; t64[k] = make_float2(cosf(ang), sinf(ang)); }
        }
    }
    { float* gsub = (float*)(F.ws + WS_ROPE + 32768); for (int i = gt; i < 128; i += NT) gsub[i] = a.in[I_SUBLN][i] * (1.0f - LAMBDA_INIT); }
    {
        bf16* WR = (bf16*)(F.ws + WS_WR);
        for (int i = gt; i < 2 * 256 * 2048; i += NT) { const int l = i >> 19, r = (i >> 11) & 255, k = i & 2047;
            float v = 0.f; if (r < 4) v = a.in[I_WRG][((size_t)l * 2048 + k) * 4 + r]; else if (r < 36) v = a.in[I_WRE][((size_t)l * 2048 + k) * 32 + (r - 4)];
            WR[i] = (bf16)f2bf(v); }
        v4u* z = (v4u*)((bf16*)(F.ws + WS_WE_IN) + (size_t)2624 * 2048);
        for (int i = gt; i < 192 * 2048 / 8; i += NT) z[i] = (v4u){0u, 0u, 0u, 0u};
    }
    {
        LAS float* sl = (LAS float*)(F.lds + RING_OFF);
        LAS float* red = (LAS float*)(F.lds + RING_OFF + 73728);
        for (int i = L_.tid; i < 9 * 2048; i += 512) { const int j = i >> 11, k = i & 2047; const float v = j < 8 ? a.in[I_C][j * 2048 + k] : a.in[I_CCTX][k]; sl[i] = v / (1.0f + expf(-v)); }
        __syncthreads();
        float* MOD = (float*)(F.ws + WS_MOD);
        const int cg = L_.lane & 31, ks = L_.lane >> 5;
        for (int item = blockIdx.x; item < 192; item += F.G) {
            const int layer = item / 96, chunk = item - layer * 96, col0 = chunk * 128;
            const float* W = a.in[I_MODW] + (size_t)layer * 2048 * 12288 + col0 + cg * 4;
            f32x4 acc[9];
#pragma unroll
            for (int j = 0; j < 9; ++j) acc[j] = (f32x4){0.f, 0.f, 0.f, 0.f};
#pragma unroll 8
            for (int it = 0; it < 128; ++it) { const int k = L_.wave * 256 + it * 2 + ks; const f32x4 w = *(const f32x4*)(W + (size_t)k * 12288);
#pragma unroll
                for (int j = 0; j < 9; ++j) { const float s = sl[j * 2048 + k]; acc[j] = acc[j] + w * s; } }
#pragma unroll
            for (int j = 0; j < 9; ++j)
#pragma unroll
                for (int e = 0; e < 4; ++e) { float v = acc[j][e]; v += __shfl_xor(v, 32); acc[j][e] = v; }
            if (L_.lane < 32) {
#pragma unroll
                for (int j = 0; j < 9; ++j)
#pragma unroll
                    for (int e = 0; e < 4; ++e) red[(L_.wave * 9 + j) * 128 + cg * 4 + e] = acc[j][e]; }
            __syncthreads();
            for (int t = L_.tid; t < 9 * 128; t += 512) { const int j = t >> 7, cc = t & 127; float s = a.in[I_MODB][layer * 12288 + col0 + cc];
#pragma unroll
                for (int w = 0; w < 8; ++w) s += red[(w * 9 + j) * 128 + cc];
                MOD[((size_t)layer * 9 + j) * 12288 + col0 + cc] = s; }
            __syncthreads();
        }
    }
    {
        LAS float* scr = (LAS float*)(F.lds + RING_OFF + L_.wave * 16384);
        const int gw = F.vcu * NWAVES + L_.wave, NGW = F.G * NWAVES;
        constexpr int I0 = 32 * 82, I1 = 8 * 48, I2 = 8 * 64, I3 = 32 * 64, I4 = 32 * 144, I5 = 32 * 64, NSMALL = I0 + I1 + I2 + I3 + I4 + I5;
#if MOE_F32B || BG_CONVERT
        constexpr int NMOE = 0;
#else
        constexpr int NMOE = 64 * 3072;
#endif
        for (int it = gw; it < NSMALL + NMOE; it += NGW) {
            int r = it;
            if (r < NSMALL) {
                if (r < I0) { small_transpose(a.in[I_EWIN], 2048, 2624, (bf16*)(F.ws + WS_WE_IN), r, scr, L_.lane); continue; } r -= I0;
                if (r < I1) { small_transpose(a.in[I_BWUQ], 512, 1536, (bf16*)(F.ws + WS_WE_UQ), r, scr, L_.lane); continue; } r -= I1;
                if (r < I2) { small_transpose(a.in[I_BWUKV], 512, 2048, (bf16*)(F.ws + WS_WE_UKV), r, scr, L_.lane); continue; } r -= I2;
                if (r < I3) { small_transpose(a.in[I_EWOUT], 2048, 2048, (bf16*)(F.ws + WS_WE_OUT), r, scr, L_.lane); continue; } r -= I3;
                if (r < I4) { small_transpose(a.in[I_OWIN], 2048, 4608, (bf16*)(F.ws + WS_WO_IN), r, scr, L_.lane); continue; } r -= I4;
                small_transpose(a.in[I_OWOUT], 2048, 2048, (bf16*)(F.ws + WS_WO_OUT), r, scr, L_.lane); continue;
            }
            moe_item(F, a, r - NSMALL, scr, L_.lane);
        }
    }
}

__device__ __forceinline__ void modulate_store(const f32x4 (&v)[8], const float* shift, const float* scale, bf16* orow, int lane) {
    float ss = 0.f;
#pragma unroll
    for (int j = 0; j < 8; ++j) ss += (v[j].x * v[j].x + v[j].y * v[j].y) + (v[j].z * v[j].z + v[j].w * v[j].w);
    ss = wave_sum(ss);
    const float r = 1.0f / sqrtf(ss * (1.0f / 2048.0f) + NORM_EPS);
#pragma unroll
    for (int j = 0; j < 8; ++j) { const f32x4 sh = ((const f32x4*)shift)[lane + 64 * j], sc = ((const f32x4*)scale)[lane + 64 * j];
        const f32x4 y = v[j] * r * (sc + 1.0f) + sh; v2u o; o.x = pk2(y.x, y.y); o.y = pk2(y.z, y.w); ((v2u*)orow)[lane + 64 * j] = o; }
}
__device__ __forceinline__ void moe_combine_load(const bf16* YS, const int* rec, const LAS int* offs, int lane, f32x4 (&y)[8]) {
    const int s0 = offs[rec[0]] + rec[2], s1 = offs[rec[1]] + rec[3]; const float w0 = __builtin_bit_cast(float, rec[4]), w1 = __builtin_bit_cast(float, rec[5]);
    const v2u* p0 = (const v2u*)(YS + (size_t)s0 * 2048); const v2u* p1 = (const v2u*)(YS + (size_t)s1 * 2048);
#pragma unroll
    for (int j = 0; j < 8; ++j) { const v2u a = p0[lane + 64 * j], b = p1[lane + 64 * j];
        y[j].x = w0 * bflo(a.x) + w1 * bflo(b.x); y[j].y = w0 * bfhi(a.x) + w1 * bfhi(b.x); y[j].z = w0 * bflo(a.y) + w1 * bflo(b.y); y[j].w = w0 * bfhi(a.y) + w1 * bfhi(b.y); }
}

__device__ __forceinline__ int moe_tables(const Frame& F, int layer, int tid) {
    LAS int* texp = (LAS int*)(F.lds + LDS_TAB); LAS int* frt = texp + 256; LAS int* offs = frt + 40;
    if (tid < 64) {
        const int e = tid & 31;
        const unsigned c = __hip_atomic_load((unsigned*)(F.ctl + CW_CNT + layer * 64 + e), RLX_AGENT);
        const int pad = (int)((c + 255u) & ~255u);
        int incl = pad;
#pragma unroll
        for (int d = 1; d < 32; d <<= 1) { const int v = __shfl_up(incl, d); if ((tid & 31) >= d) incl += v; }
        const int excl = incl - pad;
        if (tid < 32) { offs[e] = excl; frt[e] = excl >> 8; for (int r = excl >> 8; r < (incl >> 8); ++r) texp[r] = e; if (e == 31) { offs[NE] = incl; frt[NE] = incl >> 8; } }
    }
    __syncthreads();
    return frt[NE];
}
__device__ __forceinline__ void hrow_load(const bf16* hrow, int lane, f32x4 (&v)[8]) {
#pragma unroll
    for (int q = 0; q < 8; ++q) { const v2u w = ((const v2u*)hrow)[lane + 64 * q]; v[q].x = bflo(w.x); v[q].y = bfhi(w.x); v[q].z = bflo(w.y); v[q].w = bfhi(w.y); }
}
__device__ __forceinline__ void hrow_store(bf16* hrow, int lane, const f32x4 (&v)[8]) {
#pragma unroll
    for (int q = 0; q < 8; ++q) { v2u o; o.x = pk2(v[q].x, v[q].y); o.y = pk2(v[q].z, v[q].w); ((v2u*)hrow)[lane + 64 * q] = o; }
}
__device__ __forceinline__ void modulate_store_l(const f32x4 (&v)[8], const LAS float* shift, const LAS float* scale, bf16* orow, int lane) {
    float ss = 0.f;
#pragma unroll
    for (int j = 0; j < 8; ++j) ss += (v[j].x * v[j].x + v[j].y * v[j].y) + (v[j].z * v[j].z + v[j].w * v[j].w);
    ss = wave_sum(ss);
    const float r = 1.0f / sqrtf(ss * (1.0f / 2048.0f) + NORM_EPS);
#pragma unroll
    for (int j = 0; j < 8; ++j) { const f32x4 sh = ((const LAS f32x4*)shift)[lane + 64 * j], sc = ((const LAS f32x4*)scale)[lane + 64 * j];
        const f32x4 y = v[j] * r * (sc + 1.0f) + sh; v2u o; o.x = pk2(y.x, y.y); o.y = pk2(y.z, y.w); ((v2u*)orow)[lane + 64 * j] = o; }
}
__device__ __forceinline__ const float* l0_src_row(const Args& a, int row, int& j) {
    const int b = row / TPB, r = row - b * TPB; j = r < CTX ? 8 : b;
    return r < CTX ? a.in[I_CTX] + (size_t)(b * CTX + r) * DM : a.in[I_X] + (size_t)(b * SEQ + (r - CTX)) * DM;
}
__device__ __forceinline__ void p_l0_mod1(const Frame& F, const Args& a) {
    const LocalId L_ = local_id(); (void)L_;
    const int gw = F.vcu * NWAVES + L_.wave, NGW = F.G * NWAVES;
    const float* MOD = (const float*)(F.ws + WS_MOD); bf16* A1 = (bf16*)(F.ws + WS_A1);
    for (int r0 = gw; r0 < T; r0 += 2 * NGW) {
        const int r1 = r0 + NGW; const bool ok1 = r1 < T;
        int j0, j1 = 0; const float* s0 = l0_src_row(a, r0, j0); const float* s1 = ok1 ? l0_src_row(a, r1, j1) : s0;
        f32x4 v0[8], v1[8];
#pragma unroll
        for (int q = 0; q < 8; ++q) v0[q] = ((const f32x4*)s0)[L_.lane + 64 * q];
#pragma unroll
        for (int q = 0; q < 8; ++q) v1[q] = ((const f32x4*)s1)[L_.lane + 64 * q];
        const float* m0 = MOD + (size_t)(0 * 9 + j0) * 12288;
        modulate_store(v0, m0 + 0 * 2048, m0 + 1 * 2048, A1 + (size_t)r0 * DM, L_.lane);
        if (ok1) {
            const float* m1 = MOD + (size_t)(0 * 9 + j1) * 12288;
            modulate_store(v1, m1 + 0 * 2048, m1 + 1 * 2048, A1 + (size_t)r1 * DM, L_.lane);
        }
    }
}
__device__ __forceinline__ void p_mod2(const Frame& F, int layer) {
    const LocalId L_ = local_id(); (void)L_;
    const int gw = F.vcu * NWAVES + L_.wave, NGW = F.G * NWAVES;
    const float* MOD = (const float*)(F.ws + WS_MOD); const bf16* H = (const bf16*)(F.ws + WS_H); bf16* A1 = (bf16*)(F.ws + WS_A1);
    for (int r0 = gw; r0 < T; r0 += 2 * NGW) {
        const int r1 = r0 + NGW; const int j0 = mod_index(r0), j1 = r1 < T ? mod_index(r1) : 8;
        const bool ok0 = !(layer == 1 && j0 == 8), ok1 = r1 < T && !(layer == 1 && j1 == 8);
        f32x4 v0[8], v1[8];
        if (ok0) hrow_load(H + (size_t)r0 * DM, L_.lane, v0);
        if (ok1) hrow_load(H + (size_t)r1 * DM, L_.lane, v1);
        if (ok0) { const float* m = MOD + (size_t)(layer * 9 + j0) * 12288; modulate_store(v0, m + 3 * 2048, m + 4 * 2048, A1 + (size_t)r0 * DM, L_.lane); }
        if (ok1) { const float* m = MOD + (size_t)(layer * 9 + j1) * 12288; modulate_store(v1, m + 3 * 2048, m + 4 * 2048, A1 + (size_t)r1 * DM, L_.lane); }
    }
}
__device__ __forceinline__ void p_l1_mod1(const Frame& F, size_t hdst_off = WS_H, size_t adst_off = WS_A1) {
    const LocalId L_ = local_id(); (void)L_;
    const float* MOD = (const float*)(F.ws + WS_MOD); const bf16* H = (const bf16*)(F.ws + WS_H); bf16* Hd = (bf16*)(F.ws + hdst_off); bf16* A1 = (bf16*)(F.ws + adst_off);
    const bf16* YS = (const bf16*)(F.ws + WS_YS); const int* ROUTE = (const int*)(F.ws + WS_ROUTE);
    (void)moe_tables(F, 0, L_.tid); const LAS int* offs = (const LAS int*)(F.lds + LDS_TAB) + 296;
    const int RPB = (T + F.G - 1) / F.G, rb0 = F.vcu * RPB < T ? F.vcu * RPB : T, re0 = rb0 + RPB < T ? rb0 + RPB : T;
    LAS float* vec = (LAS float*)(F.lds + RING_OFF);
    for (int rb = rb0; rb < re0 || rb == rb0; rb += 256) {
      const int re = rb + 256 < re0 ? rb + 256 : re0;
      const int jlo = mod_index(rb < T ? rb : T - 1), jhi = mod_index(re > rb ? re - 1 : (rb < T ? rb : T - 1));
      for (int i = L_.tid; i < 2 * 3 * 512; i += 512) { const int st = i / 1536, rem = i - st * 1536, vv = rem >> 9, k = rem & 511; const int j = st ? jhi : jlo;
        const float* src = vv == 0 ? MOD + (size_t)(0 * 9 + j) * 12288 + 5 * 2048 : MOD + (size_t)(1 * 9 + j) * 12288 + (vv - 1) * 2048;
        ((LAS f32x4*)vec)[i] = ((const f32x4*)src)[k]; }
      __syncthreads();
      for (int r0 = rb + 2 * L_.wave; r0 < re; r0 += 16) {
        const int r1 = r0 + 1; const bool ok1 = r1 < re; const int rr1 = ok1 ? r1 : r0;
        const int j0 = mod_index(r0), j1 = mod_index(rr1);
        const LAS float* s0 = vec + (j0 == jlo ? 0 : 3 * 2048); const LAS float* s1 = vec + (j1 == jlo ? 0 : 3 * 2048);
        f32x4 v0[8], v1[8], y0[8], y1[8];
        moe_combine_load(YS, ROUTE + (size_t)r0 * 8, offs, L_.lane, y0);
        moe_combine_load(YS, ROUTE + (size_t)rr1 * 8, offs, L_.lane, y1);
        hrow_load(H + (size_t)r0 * DM, L_.lane, v0);
        hrow_load(H + (size_t)rr1 * DM, L_.lane, v1);
#pragma unroll
        for (int q = 0; q < 8; ++q) { v0[q] = v0[q] + ((const LAS f32x4*)s0)[L_.lane + 64 * q] * y0[q]; v1[q] = v1[q] + ((const LAS f32x4*)s1)[L_.lane + 64 * q] * y1[q]; }
        if (j0 != 8) hrow_store(Hd + (size_t)r0 * DM, L_.lane, v0);
        modulate_store_l(v0, s0 + 2048, s0 + 4096, A1 + (size_t)r0 * DM, L_.lane);
        if (ok1) {
            if (j1 != 8) hrow_store(Hd + (size_t)r1 * DM, L_.lane, v1);
            modulate_store_l(v1, s1 + 2048, s1 + 4096, A1 + (size_t)r1 * DM, L_.lane);
        }
      }
      __syncthreads();
    }
}
__device__ __forceinline__ void p_final(const Frame& F, float* out) {
    const LocalId L_ = local_id(); (void)L_;
    const float* MOD = (const float*)(F.ws + WS_MOD); const bf16* H = (const bf16*)(F.ws + WS_H);
    const bf16* YS = (const bf16*)(F.ws + WS_YS); const int* ROUTE = (const int*)(F.ws + WS_ROUTE);
    (void)moe_tables(F, 1, L_.tid); const LAS int* offs = (const LAS int*)(F.lds + LDS_TAB) + 296;
    constexpr int NX = NB * SEQ;
    const int RPB = (NX + F.G - 1) / F.G, ib0 = F.vcu * RPB < NX ? F.vcu * RPB : NX, ie0 = ib0 + RPB < NX ? ib0 + RPB : NX;
    LAS float* vec = (LAS float*)(F.lds + RING_OFF);
    for (int ib = ib0; ib < ie0 || ib == ib0; ib += 2048) {
      const int ie = ib + 2048 < ie0 ? ib + 2048 : ie0;
      const int blo = (ib < NX ? ib : NX - 1) / SEQ, bhi = (ie > ib ? ie - 1 : (ib < NX ? ib : NX - 1)) / SEQ;
      for (int i = L_.tid; i < 2 * 512; i += 512) { const int st = i >> 9, k = i & 511; const int b = st ? bhi : blo;
        ((LAS f32x4*)vec)[i] = ((const f32x4*)(MOD + (size_t)(1 * 9 + b) * 12288 + 5 * 2048))[k]; }
      __syncthreads();
      for (int i0 = ib + 2 * L_.wave; i0 < ie; i0 += 16) {
        const int i1 = i0 + 1; const bool ok1 = i1 < ie; const int ii1 = ok1 ? i1 : i0;
        const int b0 = i0 / SEQ, row0 = b0 * TPB + CTX + (i0 - b0 * SEQ), b1 = ii1 / SEQ, row1 = b1 * TPB + CTX + (ii1 - b1 * SEQ);
        const LAS float* g0 = vec + (b0 == blo ? 0 : 2048); const LAS float* g1 = vec + (b1 == blo ? 0 : 2048);
        f32x4 y0[8], y1[8], h0[8], h1[8];
        moe_combine_load(YS, ROUTE + (size_t)row0 * 8, offs, L_.lane, y0);
        moe_combine_load(YS, ROUTE + (size_t)row1 * 8, offs, L_.lane, y1);
        hrow_load(H + (size_t)row0 * DM, L_.lane, h0);
        hrow_load(H + (size_t)row1 * DM, L_.lane, h1);
#pragma unroll
        for (int q = 0; q < 8; ++q) ((f32x4*)(out + (size_t)i0 * DM))[L_.lane + 64 * q] = h0[q] + ((const LAS f32x4*)g0)[L_.lane + 64 * q] * y0[q];
        if (ok1) {
#pragma unroll
            for (int q = 0; q < 8; ++q) ((f32x4*)(out + (size_t)i1 * DM))[L_.lane + 64 * q] = h1[q] + ((const LAS f32x4*)g1)[L_.lane + 64 * q] * y1[q]; }
      }
      __syncthreads();
    }
}

__device__ __forceinline__ void head128_norm_rope(const bf16* p, bf16* pd, const float* gain, bool rope, int prow, int pcol, const float2* t128, int lane) {
    const float x0 = bf2f(p[lane]), x1 = bf2f(p[lane + 64]);
    const float ss = wave_sum(x0 * x0 + x1 * x1);
    const float r = 1.0f / sqrtf(ss * (1.0f / 128.0f) + NORM_EPS);
    float y0 = x0 * r * gain[lane], y1 = x1 * r * gain[lane + 64];
    if (rope) {
        const int f = lane & 31; const float2 cr = t128[prow * 32 + f], cc = t128[pcol * 32 + f];
        const float p0 = __shfl_xor(y0, 32), p1 = __shfl_xor(y1, 32); const float sg = (lane & 32) ? 1.0f : -1.0f;
        y0 = y0 * cr.x + sg * p0 * cr.y; y1 = y1 * cc.x + sg * p1 * cc.y;
    }
    pd[lane] = (bf16)f2bf(y0); pd[lane + 64] = (bf16)f2bf(y1);
}
__device__ __forceinline__ float rope64_apply(float y, int prow, int pcol, const float2* t64, int lane) {
    const int f = lane & 15, pos = (lane & 32) ? pcol : prow; const float2 cs = t64[pos * 16 + f];
    const float pr = __shfl_xor(y, 16); const float sg = (lane & 16) ? 1.0f : -1.0f;
    return y * cs.x + sg * pr * cs.y;
}
__device__ __forceinline__ void head64_norm_rope(const bf16* p, bf16* pd, const float* gain, bool rope, int prow, int pcol, const float2* t64, int lane) {
    const float x = bf2f(p[lane]);
    const float ss = wave_sum(x * x);
    const float r = 1.0f / sqrtf(ss * (1.0f / 64.0f) + NORM_EPS);
    float y = x * r * gain[lane];
    if (rope) y = rope64_apply(y, prow, pcol, t64, lane);
    pd[lane] = (bf16)f2bf(y);
}
__device__ __forceinline__ void norm512(const bf16* src, const float* gain, bf16* dst, int lane) {
    const v4u w = ((const v4u*)src)[lane];
    float x[8] = {bflo(w.x), bfhi(w.x), bflo(w.y), bfhi(w.y), bflo(w.z), bfhi(w.z), bflo(w.w), bfhi(w.w)};
    float ss = 0.f;
#pragma unroll
    for (int i = 0; i < 8; ++i) ss += x[i] * x[i];
    ss = wave_sum(ss);
    const float r = 1.0f / sqrtf(ss * (1.0f / 512.0f) + NORM_EPS);
    const f32x4 g0 = ((const f32x4*)gain)[2 * lane], g1 = ((const f32x4*)gain)[2 * lane + 1];
    v4u o; o.x = pk2(x[0] * r * g0.x, x[1] * r * g0.y); o.y = pk2(x[2] * r * g0.z, x[3] * r * g0.w); o.z = pk2(x[4] * r * g1.x, x[5] * r * g1.y); o.w = pk2(x[6] * r * g1.z, x[7] * r * g1.w);
    ((v4u*)dst)[lane] = o;
}

__device__ __forceinline__ void unpack8(const v4u w, float (&x)[8]) { x[0] = bflo(w.x); x[1] = bfhi(w.x); x[2] = bflo(w.y); x[3] = bfhi(w.y); x[4] = bflo(w.z); x[5] = bfhi(w.z); x[6] = bflo(w.w); x[7] = bfhi(w.w); }
__device__ __forceinline__ v4u pack8(const float (&y)[8]) { v4u o; o.x = pk2(y[0], y[1]); o.y = pk2(y[2], y[3]); o.z = pk2(y[4], y[5]); o.w = pk2(y[6], y[7]); return o; }
__device__ __forceinline__ float sumsq8(const float (&x)[8]) { return ((x[0] * x[0] + x[1] * x[1]) + (x[2] * x[2] + x[3] * x[3])) + ((x[4] * x[4] + x[5] * x[5]) + (x[6] * x[6] + x[7] * x[7])); }
template <int GS> __device__ __forceinline__ float group_sum(float v) {
    v += __shfl_xor(v, 1); v += __shfl_xor(v, 2); v += __shfl_xor(v, 4); if (GS == 16) v += __shfl_xor(v, 8); return v;
}
template <int RD> __device__ __forceinline__ void rope8(float (&y)[8], int l, int prow, int pcol, const float2* tab) {
    constexpr int NF = RD / 4, LQ = NF / 8;
    const int quarter = l / LQ, f0 = (l % LQ) * 8, pos = (quarter >= 2) ? pcol : prow;
    const float sg = (quarter & 1) ? 1.0f : -1.0f;
    const f32x4* t = (const f32x4*)(tab + pos * NF + f0);
    const f32x4 c0 = t[0], c1 = t[1], c2 = t[2], c3 = t[3];
    float p[8];
#pragma unroll
    for (int j = 0; j < 8; ++j) p[j] = __shfl_xor(y[j], LQ);
    y[0] = y[0] * c0.x + sg * p[0] * c0.y; y[1] = y[1] * c0.z + sg * p[1] * c0.w; y[2] = y[2] * c1.x + sg * p[2] * c1.y; y[3] = y[3] * c1.z + sg * p[3] * c1.w;
    y[4] = y[4] * c2.x + sg * p[4] * c2.y; y[5] = y[5] * c2.z + sg * p[5] * c2.w; y[6] = y[6] * c3.x + sg * p[6] * c3.y; y[7] = y[7] * c3.z + sg * p[7] * c3.w;
}
template <int DIM> __device__ __forceinline__ v4u head_chunk(const v4u w, const float* gain, bool rope, int prow, int pcol, const float2* tab, int lane) {
    constexpr int GS = DIM / 8; const int l = lane & (GS - 1);
    float x[8]; unpack8(w, x);
    const float ss = group_sum<GS>(sumsq8(x));
    const float r = 1.0f / sqrtf(ss * (1.0f / DIM) + NORM_EPS);
    const f32x4 g0 = ((const f32x4*)gain)[2 * l], g1 = ((const f32x4*)gain)[2 * l + 1];
    x[0] *= r * g0.x; x[1] *= r * g0.y; x[2] *= r * g0.z; x[3] *= r * g0.w; x[4] *= r * g1.x; x[5] *= r * g1.y; x[6] *= r * g1.z; x[7] *= r * g1.w;
    if (rope) rope8<DIM>(x, l, prow, pcol, tab);
    return pack8(x);
}
__device__ __forceinline__ v4u norm512_chunk(const v4u w, const float* gain, int lane) {
    float x[8]; unpack8(w, x);
    const float ss = wave_sum(sumsq8(x));
    const float r = 1.0f / sqrtf(ss * (1.0f / 512.0f) + NORM_EPS);
    const f32x4 g0 = ((const f32x4*)gain)[2 * lane], g1 = ((const f32x4*)gain)[2 * lane + 1];
    x[0] *= r * g0.x; x[1] *= r * g0.y; x[2] *= r * g0.z; x[3] *= r * g0.w; x[4] *= r * g1.x; x[5] *= r * g1.y; x[6] *= r * g1.z; x[7] *= r * g1.w;
    return pack8(x);
}

__device__ __forceinline__ void p_even_post1(const Frame& F, const Args& a, size_t ydst_off = WS_Y1) {
    const LocalId L_ = local_id(); (void)L_;
    const int gw = F.vcu * NWAVES + L_.wave, NGW = F.G * NWAVES, lane = L_.lane;
    const bf16* Y1 = (const bf16*)(F.ws + WS_Y1); bf16* CQN = (bf16*)(F.ws + WS_CQN); bf16* CKVN = (bf16*)(F.ws + WS_CKVN);
    const float2* t128 = (const float2*)(F.ws + WS_ROPE);
    for (int row = gw; row < T; row += NGW) {
        const int b = row / TPB, r = row - b * TPB; const bool xr = r >= CTX; const int s = r - CTX, prow = xr ? (s >> 6) : 0, pcol = xr ? (s & 63) : 0;
        const v4u* y = (const v4u*)(Y1 + (size_t)row * EVEN_IN_P); v4u* yd = (v4u*)((bf16*)(F.ws + ydst_off) + (size_t)row * EVEN_IN_P);
        const v4u k0 = y[128 + (lane & 31)], cq = y[192 + lane], ckv = y[256 + lane];
        const v4u ok0 = head_chunk<128>(k0, a.in[I_AKN], xr, prow, pcol, t128, lane);
        const v4u ocq = norm512_chunk(cq, a.in[I_BCQN], lane), ockv = norm512_chunk(ckv, a.in[I_BCKVN], lane);
        if (lane < 32) yd[128 + lane] = ok0;
        ((v4u*)(CQN + (size_t)row * 512))[lane] = ocq; ((v4u*)(CKVN + (size_t)row * 512))[lane] = ockv;
    }
#if KR_IN_POST1
    {
        constexpr int FPITCH = 4112;
        LAS unsigned char* Fs = F.lds + RING_OFF; LAS float* P = (LAS float*)(F.lds + RING_OFF + 16 * FPITCH + 256);
        const bf16* A1 = (const bf16*)(F.ws + WS_A1); const bf16* WK = (const bf16*)(F.ws + WS_WE_IN) + (size_t)2560 * 2048; bf16* KR = (bf16*)(F.ws + WS_LG);
        const int wave = L_.wave;
        bf16x8_t bfr[4][8];
#pragma unroll
        for (int nb = 0; nb < 4; ++nb)
#pragma unroll
            for (int ks = 0; ks < 8; ++ks) bfr[nb][ks] = *(const bf16x8_t*)(WK + (size_t)(nb * 16 + (lane & 15)) * 2048 + wave * 256 + ks * 32 + (lane >> 4) * 8);
        __syncthreads();
        for (int g = F.vcu; g < T / 16; g += F.G) {
            const int row0 = g * 16;
#pragma unroll
            for (int rr = 0; rr < 2; ++rr) { const int r = 2 * wave + rr; const v4u* src = (const v4u*)(A1 + (size_t)(row0 + r) * DM);
#pragma unroll
                for (int q = 0; q < 4; ++q) *(LAS v4u*)(Fs + r * FPITCH + (lane + 64 * q) * 16) = src[lane + 64 * q]; }
            __syncthreads();
            f32x4 acc[4];
#pragma unroll
            for (int nb = 0; nb < 4; ++nb) acc[nb] = (f32x4){0.f, 0.f, 0.f, 0.f};
#pragma unroll
            for (int ks = 0; ks < 8; ++ks) { const bf16x8_t af = *(const LAS bf16x8_t*)(Fs + (lane & 15) * FPITCH + (wave * 256 + ks * 32 + (lane >> 4) * 8) * 2);
#pragma unroll
                for (int nb = 0; nb < 4; ++nb) acc[nb] = __builtin_amdgcn_mfma_f32_16x16x32_bf16(af, bfr[nb][ks], acc[nb], 0, 0, 0); }
#pragma unroll
            for (int nb = 0; nb < 4; ++nb)
#pragma unroll
                for (int rg = 0; rg < 4; ++rg) P[(wave * 16 + 4 * (lane >> 4) + rg) * 64 + nb * 16 + (lane & 15)] = acc[nb][rg];
            __syncthreads();
#pragma unroll
            for (int o = 0; o < 2; ++o) { const int idx = L_.tid + 512 * o, r = idx >> 6, c = idx & 63; float sacc = 0.f;
#pragma unroll
                for (int w = 0; w < 8; ++w) sacc += P[(w * 16 + r) * 64 + c];
                KR[(size_t)(row0 + r) * 64 + c] = (bf16)f2bf(sacc); }
            __syncthreads();
        }
    }
#endif
}
__device__ __forceinline__ void p_even_post2(const Frame& F, const Args& a, size_t qdst_off = WS_QB, size_t kdst_off = WS_KB) {
    const LocalId L_ = local_id(); (void)L_;
    const int gw = F.vcu * NWAVES + L_.wave, NGW = F.G * NWAVES, lane = L_.lane;
    const bf16* Y1 = (const bf16*)(F.ws + WS_Y1); const bf16* QB = (const bf16*)(F.ws + WS_QB); const bf16* KV = (const bf16*)(F.ws + WS_KV);
    bf16* KB = (bf16*)(F.ws + kdst_off); bf16* QBd = (bf16*)(F.ws + qdst_off);
    const float2* t64 = (const float2*)(F.ws + WS_ROPE + 16384);
    const float* gq = a.in[I_BQN]; const float* gk = a.in[I_BKN]; const float* KRP = (const float*)(F.ws + WS_LG);
    const int l16 = lane & 15, l8 = lane & 7, hn = lane >> 4, hr = lane >> 3;
    const f32x4 gqn0 = ((const f32x4*)gq)[2 * l16], gqn1 = ((const f32x4*)gq)[2 * l16 + 1], gqr0 = ((const f32x4*)(gq + 128))[2 * l8], gqr1 = ((const f32x4*)(gq + 128))[2 * l8 + 1];
    const f32x4 gkn0 = ((const f32x4*)gk)[2 * l16], gkn1 = ((const f32x4*)gk)[2 * l16 + 1], gkr0 = ((const f32x4*)(gk + 128))[2 * l8], gkr1 = ((const f32x4*)(gk + 128))[2 * l8 + 1];
    for (int row = gw; row < T; row += NGW) {
        const int b = row / TPB, r = row - b * TPB; const bool xr = r >= CTX; const int s = r - CTX, prow = xr ? (s >> 6) : 0, pcol = xr ? (s & 63) : 0;
        const bf16* q = QB + (size_t)row * 1536; const bf16* kv = KV + (size_t)row * 2048;
        const v4u wk0 = *(const v4u*)(kv + hn * 256 + l16 * 8), wk1 = *(const v4u*)(kv + (hn + 4) * 256 + l16 * 8);
#if KR_IN_POST1
        const v4u wkr = *(const v4u*)((const bf16*)(F.ws + WS_LG) + (size_t)row * 64 + l8 * 8);
#else
        const v4u wkr = *(const v4u*)(Y1 + (size_t)row * EVEN_IN_P + 2560 + l8 * 8);
#endif
#define POST2_ONE(W0, W1, WR, GN0, GN1, GR0, GR1, DST) do { \
        float x0[8], x1[8], xr_[8]; unpack8(W0, x0); unpack8(W1, x1); unpack8(WR, xr_); \
        const float n0 = group_sum<16>(sumsq8(x0)), n1 = group_sum<16>(sumsq8(x1)), rs = group_sum<8>(sumsq8(xr_));     \
        const float rs0 = __shfl(rs, 8 * hn), rs1 = __shfl(rs, 8 * (hn + 4));                                         \
        const float t0 = __shfl(n0, 16 * (hr & 3)), t1 = __shfl(n1, 16 * (hr & 3)); const float nr = (hr >> 2) ? t1 : t0;    \
        const float r0 = 1.0f / sqrtf((n0 + rs0) * (1.0f / 192.0f) + NORM_EPS), r1 = 1.0f / sqrtf((n1 + rs1) * (1.0f / 192.0f) + NORM_EPS), rr = 1.0f / sqrtf((nr + rs) * (1.0f / 192.0f) + NORM_EPS); \
        x0[0] *= r0 * GN0.x; x0[1] *= r0 * GN0.y; x0[2] *= r0 * GN0.z; x0[3] *= r0 * GN0.w; x0[4] *= r0 * GN1.x; x0[5] *= r0 * GN1.y; x0[6] *= r0 * GN1.z; x0[7] *= r0 * GN1.w; \
        x1[0] *= r1 * GN0.x; x1[1] *= r1 * GN0.y; x1[2] *= r1 * GN0.z; x1[3] *= r1 * GN0.w; x1[4] *= r1 * GN1.x; x1[5] *= r1 * GN1.y; x1[6] *= r1 * GN1.z; x1[7] *= r1 * GN1.w; \
        xr_[0] *= rr * GR0.x; xr_[1] *= rr * GR0.y; xr_[2] *= rr * GR0.z; xr_[3] *= rr * GR0.w; xr_[4] *= rr * GR1.x; xr_[5] *= rr * GR1.y; xr_[6] *= rr * GR1.z; xr_[7] *= rr * GR1.w; \
        if (xr) rope8<64>(xr_, l8, prow, pcol, t64); \
        *(v4u*)((DST) + hn * 192 + l16 * 8) = pack8(x0); *(v4u*)((DST) + (hn + 4) * 192 + l16 * 8) = pack8(x1); *(v4u*)((DST) + hr * 192 + 128 + l8 * 8) = pack8(xr_); } while (0)
        POST2_ONE(wk0, wk1, wkr, gkn0, gkn1, gkr0, gkr1, KB + (size_t)row * 1536);
#undef POST2_ONE
    }
}
__device__ __forceinline__ void p_odd_post1(const Frame& F, const Args& a, size_t ydst_off = WS_Y1) {
    const LocalId L_ = local_id(); (void)L_;
    const int gw = F.vcu * NWAVES + L_.wave, NGW = F.G * NWAVES, lane = L_.lane;
    const bf16* Y1 = (const bf16*)(F.ws + WS_Y1);
    const float2* t128 = (const float2*)(F.ws + WS_ROPE); const float2* t64 = (const float2*)(F.ws + WS_ROPE + 16384);
    for (int row = gw; row < T; row += NGW) {
        const int b = row / TPB, r = row - b * TPB; const bool xr = r >= CTX; const int s = r - CTX, prow = xr ? (s >> 6) : 0, pcol = xr ? (s & 63) : 0;
        const v4u* y = (const v4u*)(Y1 + (size_t)row * ODD_IN); v4u* yd = (v4u*)((bf16*)(F.ws + ydst_off) + (size_t)row * ODD_IN);
        const v4u kc0 = y[128 + lane], kc1 = y[192 + lane], kd0 = y[512 + (lane & 31)];
        const v4u p0 = head_chunk<64>(kc0, a.in[I_CKN], xr, prow, pcol, t64, lane), p1 = head_chunk<64>(kc1, a.in[I_CKN], xr, prow, pcol, t64, lane);
        const v4u p2 = head_chunk<128>(kd0, a.in[I_DKN], xr, prow, pcol, t128, lane);
        yd[128 + lane] = p0; yd[192 + lane] = p1; if (lane < 32) yd[512 + lane] = p2;
    }
}

__device__ __forceinline__ void p_route(const Frame& F, const Args& a, int layer) {
    const LocalId L_ = local_id(); (void)L_;
    const float* LG = (const float*)(F.ws + WS_LG); int* ROUTE = (int*)(F.ws + WS_ROUTE);
    unsigned* cnt = (unsigned*)(F.ctl + CW_CNT + layer * 64);
    const float* brg = a.in[I_BRG] + layer * 4; const float* bre = a.in[I_BRE] + layer * 32;
    const int NT = F.G * 512;
    for (int base = F.vcu * 512 + L_.wave * 64; base < T; base += NT) {
        const int t = base + L_.lane;
        bool valid = t < T; if (valid && layer == 1) valid = (t % TPB) >= CTX;
        int e0 = -1, e1 = -1; float w0 = 0.f, w1 = 0.f;
        if (valid) {
            const float* lg = LG + (size_t)t * 64;
            float g[4]; for (int i = 0; i < 4; ++i) { float v = brg[i]; for (int ks = 0; ks < RKS; ++ks) v += lg[(size_t)ks * T * 64 + i]; g[i] = v; }
            int gi = 0; float gm = g[0]; for (int i = 1; i < 4; ++i) if (g[i] > gm) { gm = g[i]; gi = i; }
            float den = 0.f; for (int i = 0; i < 4; ++i) den += expf(g[i] - gm);
            const float ptop = 1.0f / den;
            float el[8]; for (int i = 0; i < 8; ++i) { float v = bre[gi * 8 + i]; for (int ks = 0; ks < RKS; ++ks) v += lg[(size_t)ks * T * 64 + 4 + gi * 8 + i]; el[i] = v; }
            int i1 = 0; float l1 = el[0]; for (int i = 1; i < 8; ++i) if (el[i] > l1) { l1 = el[i]; i1 = i; }
            int i2 = -1; float l2 = -3.0e38f; for (int i = 0; i < 8; ++i) if (i != i1 && el[i] > l2) { l2 = el[i]; i2 = i; }
            const float ex = expf(l2 - l1), inv = 1.0f / (1.0f + ex);
            w0 = ptop * inv; w1 = ptop * ex * inv; e0 = gi * 8 + i1; e1 = gi * 8 + i2;
        }
        int pos0 = 0, pos1 = 0;
        const unsigned long long lt = (1ull << L_.lane) - 1ull;
        for (int e = 0; e < NE; ++e) {
            const unsigned long long m0 = __ballot(e0 == e), m1 = __ballot(e1 == e);
            const int n0 = __popcll(m0), n1 = __popcll(m1);
            if (n0 + n1 == 0) continue;
            unsigned basev = 0;
            if (L_.lane == 0) basev = __hip_atomic_fetch_add(cnt + e, (unsigned)(n0 + n1), RLX_AGENT);
            basev = (unsigned)__builtin_amdgcn_readfirstlane((int)basev);
            if (e0 == e) pos0 = (int)basev + __popcll(m0 & lt);
            if (e1 == e) pos1 = (int)basev + n0 + __popcll(m1 & lt);
        }
        if (valid) { int* rec = ROUTE + (size_t)t * 8; rec[0] = e0; rec[1] = e1; rec[2] = pos0; rec[3] = pos1; rec[4] = __builtin_bit_cast(int, w0); rec[5] = __builtin_bit_cast(int, w1); }
    }
}
__device__ __forceinline__ void p_mod2_route(const Frame& F, const Args& a, int layer) {
    const LocalId L_ = local_id(); (void)L_;
    const int lane = L_.lane, wave = L_.wave;
    constexpr int FPITCH = 4112;
    LAS unsigned char* Fs = F.lds + RING_OFF; LAS float* P = (LAS float*)(F.lds + RING_OFF + 16 * FPITCH + 256);
    const float* MOD = (const float*)(F.ws + WS_MOD); const bf16* H = (const bf16*)(F.ws + WS_H); bf16* A1 = (bf16*)(F.ws + WS_A1);
    const bf16* WR = (const bf16*)(F.ws + WS_WR) + (size_t)layer * 256 * 2048;
    int* ROUTE = (int*)(F.ws + WS_ROUTE); unsigned* cnt = (unsigned*)(F.ctl + CW_CNT + layer * 64); int* postok = (int*)(F.ws + WS_POS) + (size_t)layer * NE * POSCAP;
    const float* brg = a.in[I_BRG] + layer * 4; const float* bre = a.in[I_BRE] + layer * 32;
    bf16x8_t bfr[3][8];
#pragma unroll
    for (int nb = 0; nb < 3; ++nb)
#pragma unroll
        for (int ks = 0; ks < 8; ++ks) bfr[nb][ks] = *(const bf16x8_t*)(WR + (size_t)(nb * 16 + (lane & 15)) * 2048 + wave * 256 + ks * 32 + (lane >> 4) * 8);
    const int NG = layer == 1 ? NB * SEQ / 16 : T / 16;
    int it = 0;
    for (int g = F.vcu; g < NG; g += F.G, ++it) {
        int row0; if (layer == 1) { const int b = g >> 7; row0 = b * TPB + CTX + (g & 127) * 16; } else row0 = g * 16;
        const int j = mod_index(row0);
        const float* m = MOD + (size_t)(layer * 9 + j) * 12288;
        f32x4 v0[8], v1[8];
        const int r0 = 2 * wave, r1 = r0 + 1;
        hrow_load(H + (size_t)(row0 + r0) * DM, lane, v0);
        hrow_load(H + (size_t)(row0 + r1) * DM, lane, v1);
#define M2R_ROW(V, R) do { float ss = 0.f; \
        _Pragma("unroll") for (int q = 0; q < 8; ++q) ss += (V[q].x * V[q].x + V[q].y * V[q].y) + (V[q].z * V[q].z + V[q].w * V[q].w); \
        ss = wave_sum(ss); const float rn = 1.0f / sqrtf(ss * (1.0f / 2048.0f) + NORM_EPS); \
        _Pragma("unroll") for (int q = 0; q < 8; ++q) { const f32x4 sh = ((const f32x4*)(m + 3 * 2048))[lane + 64 * q], sc = ((const f32x4*)(m + 4 * 2048))[lane + 64 * q]; \
            const f32x4 y = V[q] * rn * (sc + 1.0f) + sh; v2u o; o.x = pk2(y.x, y.y); o.y = pk2(y.z, y.w); \
            ((v2u*)(A1 + (size_t)(row0 + (R)) * DM))[lane + 64 * q] = o; *(LAS v2u*)(Fs + (R) * FPITCH + (lane + 64 * q) * 8) = o; } } while (0)
        M2R_ROW(v0, r0); M2R_ROW(v1, r1);
#undef M2R_ROW
        __syncthreads();
        f32x4 acc[3];
#pragma unroll
        for (int nb = 0; nb < 3; ++nb) acc[nb] = (f32x4){0.f, 0.f, 0.f, 0.f};
#pragma unroll
        for (int ks = 0; ks < 8; ++ks) { const bf16x8_t af = *(const LAS bf16x8_t*)(Fs + (lane & 15) * FPITCH + (wave * 256 + ks * 32 + (lane >> 4) * 8) * 2);
#pragma unroll
            for (int nb = 0; nb < 3; ++nb) acc[nb] = __builtin_amdgcn_mfma_f32_16x16x32_bf16(af, bfr[nb][ks], acc[nb], 0, 0, 0); }
        LAS float* Pb = P + (it & 1) * (8 * 16 * 48);
#pragma unroll
        for (int nb = 0; nb < 3; ++nb)
#pragma unroll
            for (int rg = 0; rg < 4; ++rg) Pb[(wave * 16 + 4 * (lane >> 4) + rg) * 48 + nb * 16 + (lane & 15)] = acc[nb][rg];
        __syncthreads();
        if (wave == 0) {
            const bool valid = lane < 16; const int t = row0 + (lane & 15);
            int e0 = -1, e1 = -1; float w0 = 0.f, w1 = 0.f;
            if (valid) {
                const LAS float* pr = Pb + lane * 48;
                float gg[4];
#pragma unroll
                for (int i = 0; i < 4; ++i) { float sacc = brg[i];
#pragma unroll
                    for (int w = 0; w < 8; ++w) sacc += pr[w * 768 + i];
                    gg[i] = sacc; }
                int gi = 0; float gm = gg[0];
#pragma unroll
                for (int i = 1; i < 4; ++i) if (gg[i] > gm) { gm = gg[i]; gi = i; }
                float den = 0.f;
#pragma unroll
                for (int i = 0; i < 4; ++i) den += expf(gg[i] - gm);
                const float ptop = 1.0f / den;
                float el[8];
#pragma unroll
                for (int i = 0; i < 8; ++i) { float sacc = bre[gi * 8 + i];
#pragma unroll
                    for (int w = 0; w < 8; ++w) sacc += pr[w * 768 + 4 + gi * 8 + i];
                    el[i] = sacc; }
                int i1 = 0; float l1 = el[0];
#pragma unroll
                for (int i = 1; i < 8; ++i) if (el[i] > l1) { l1 = el[i]; i1 = i; }
                int i2 = -1; float l2 = -3.0e38f;
#pragma unroll
                for (int i = 0; i < 8; ++i) if (i != i1 && el[i] > l2) { l2 = el[i]; i2 = i; }
                const float ex = expf(l2 - l1), inv = 1.0f / (1.0f + ex);
                w0 = ptop * inv; w1 = ptop * ex * inv; e0 = gi * 8 + i1; e1 = gi * 8 + i2;
            }
            int rank0 = 0, rank1 = 0, mycnt = 0;
            const unsigned long long lt = (1ull << lane) - 1ull;
            for (int e = 0; e < NE; ++e) {
                const unsigned long long m0 = __ballot(e0 == e), m1 = __ballot(e1 == e);
                const int n0 = __popcll(m0), n1 = __popcll(m1);
                if (lane == e) mycnt = n0 + n1;
                if (e0 == e) rank0 = __popcll(m0 & lt);
                if (e1 == e) rank1 = n0 + __popcll(m1 & lt);
            }
            int basev = 0;
            if (lane < NE && mycnt > 0) basev = (int)__hip_atomic_fetch_add(cnt + lane, (unsigned)mycnt, RLX_AGENT);
            const int pos0 = __shfl(basev, e0 & 31) + rank0, pos1 = __shfl(basev, e1 & 31) + rank1;
            if (valid) { int* rec = ROUTE + (size_t)t * 8; rec[0] = e0; rec[1] = e1; rec[2] = pos0; rec[3] = pos1; rec[4] = __builtin_bit_cast(int, w0); rec[5] = __builtin_bit_cast(int, w1);
                         postok[(size_t)e0 * POSCAP + pos0] = t; postok[(size_t)e1 * POSCAP + pos1] = t; }
        }
    }
    __syncthreads();
}
__device__ __forceinline__ void p_gather(const Frame& F, int layer) {
    const LocalId L_ = local_id(); (void)L_;
    LAS int* offs = (LAS int*)(F.lds + RING_OFF);
    if (L_.tid == 0) { int o = 0; for (int e = 0; e < NE; ++e) { offs[e] = o; const unsigned c = __hip_atomic_load((unsigned*)(F.ctl + CW_CNT + layer * 64 + e), RLX_AGENT); o += (int)((c + 255u) & ~255u); } offs[NE] = o; }
    __syncthreads();
    if (blockIdx.x == 0 && L_.tid < NE) { const int e = L_.tid; int* texp = (int*)(F.ctl + CW_TEXP + layer * 256);
        for (int r = offs[e] >> 8; r < (offs[e + 1] >> 8); ++r) texp[r] = e;
        if (e == 0) *(int*)(F.ctl + CW_NRT + layer * 64) = offs[NE] >> 8; }
    int* ROUTE = (int*)(F.ws + WS_ROUTE); int* slot_tok = (int*)(F.ctl + CW_SLOT + layer * MAXSLOT);
    for (int t = F.vcu * 512 + L_.tid; t < T; t += F.G * 512) {
        if (layer == 1 && (t % TPB) < CTX) continue;
        int* rec = ROUTE + (size_t)t * 8;
        const int s0 = offs[rec[0]] + rec[2], s1 = offs[rec[1]] + rec[3];
        slot_tok[s0] = t; slot_tok[s1] = t; rec[6] = s0; rec[7] = s1;
    }
    __syncthreads();
}

constexpr int SLD = 2304;
template <int DQ, int QR>
__device__ __forceinline__ void naive_scores_softmax(LAS float* S, LAS float* qf, const bf16* Q, int ldq, const bf16* K, int ldk, int lo, int nk, float scale,
                                                     bool window, int qpos0, bool has_sink, float sink, int tid, int lane, int wave) {
    for (int i = tid; i < QR * DQ; i += 512) { const int r = i / DQ, d = i - r * DQ; qf[i] = bf2f(Q[(size_t)r * ldq + d]); }
    __syncthreads();
    for (int t = tid; t < nk; t += 512) {
        const int kr = t < CTX ? t : CTX + lo + (t - CTX);
        const bf16* kp = K + (size_t)kr * ldk;
        float acc[QR];
#pragma unroll
        for (int r = 0; r < QR; ++r) acc[r] = 0.f;
        for (int d = 0; d < DQ; d += 8) {
            const v4u kv = *(const v4u*)(kp + d);
            const float k0 = bflo(kv.x), k1 = bfhi(kv.x), k2 = bflo(kv.y), k3 = bfhi(kv.y), k4 = bflo(kv.z), k5 = bfhi(kv.z), k6 = bflo(kv.w), k7 = bfhi(kv.w);
#pragma unroll
            for (int r = 0; r < QR; ++r) { const LAS float* qp = qf + r * DQ + d;
                acc[r] += (k0 * qp[0] + k1 * qp[1]) + (k2 * qp[2] + k3 * qp[3]) + (k4 * qp[4] + k5 * qp[5]) + (k6 * qp[6] + k7 * qp[7]); }
        }
#pragma unroll
        for (int r = 0; r < QR; ++r) { float s = acc[r] * scale;
            if (window && t >= CTX) { const int dd = (qpos0 + r) - (lo + t - CTX); if (dd > 128 || dd < -128) s = -1e30f; }
            S[r * SLD + t] = s; }
    }
    __syncthreads();
    if (wave < QR) {
        LAS float* row = S + wave * SLD;
        float m = -1e30f; for (int t = lane; t < nk; t += 64) m = fmaxf(m, row[t]);
        m = wave_max(m); if (has_sink) m = fmaxf(m, sink);
        float sum = 0.f; for (int t = lane; t < nk; t += 64) { const float e = expf(row[t] - m); row[t] = e; sum += e; }
        sum = wave_sum(sum); if (has_sink) sum += expf(sink - m);
        const float inv = 1.0f / sum;
        for (int t = lane; t < nk; t += 64) row[t] *= inv;
    }
    __syncthreads();
}
template <int QR>
__device__ __forceinline__ void naive_pv(const LAS float* S, const bf16* V, int ldv, int lo, int nk, int tid, float (&o)[QR / 4]) {
    const int c = tid & 127, rg = tid >> 7; constexpr int RPT = QR / 4;
#pragma unroll
    for (int i = 0; i < RPT; ++i) o[i] = 0.f;
#pragma unroll 4
    for (int t = 0; t < nk; ++t) { const int kr = t < CTX ? t : CTX + lo + (t - CTX); const float v = bf2f(V[(size_t)kr * ldv + c]);
#pragma unroll
        for (int i = 0; i < RPT; ++i) o[i] += S[(rg * RPT + i) * SLD + t] * v; }
}
__device__ __forceinline__ void p_even_attn_naive(const Frame& F) {
    const LocalId L_ = local_id(); (void)L_;
    LAS float* S = (LAS float*)(F.lds + RING_OFF); LAS float* qf = (LAS float*)(F.lds + RING_OFF + 8 * SLD * 4);
    const bf16* Y1 = (const bf16*)(F.ws + WS_Y1); const bf16* QB = (const bf16*)(F.ws + WS_QB); const bf16* KV = (const bf16*)(F.ws + WS_KV); const bf16* KB = (const bf16*)(F.ws + WS_KB);
    bf16* MIX = (bf16*)(F.ws + WS_MIX);
    constexpr int UPV = NB * 8 * 288;
    for (int u = blockIdx.x; u < 2 * UPV; u += F.G) {
        const int var = u / UPV, rem = u - var * UPV, b = rem / 2304, rem2 = rem - b * 2304, h = rem2 / 288, ch = rem2 - h * 288;
        const int r0 = ch * 8, row0 = b * TPB + r0; const int nk = r0 < CTX ? CTX : TPB;
        float o[2];
        if (var == 0) {
            naive_scores_softmax<128, 8>(S, qf, Y1 + (size_t)row0 * EVEN_IN_P + h * 128, EVEN_IN_P, Y1 + (size_t)(b * TPB) * EVEN_IN_P + 1024 + (h >> 2) * 128, EVEN_IN_P, 0, nk,
                                         0.08838834764831845f, false, 0, false, 0.f, L_.tid, L_.lane, L_.wave);
            naive_pv<8>(S, Y1 + (size_t)(b * TPB) * EVEN_IN_P + 1280 + (h >> 2) * 128, EVEN_IN_P, 0, nk, L_.tid, o);
        } else {
            naive_scores_softmax<192, 8>(S, qf, QB + (size_t)row0 * 1536 + h * 192, 1536, KB + (size_t)(b * TPB) * 1536 + h * 192, 1536, 0, nk,
                                         0.07216878364870322f, false, 0, false, 0.f, L_.tid, L_.lane, L_.wave);
            naive_pv<8>(S, KV + (size_t)(b * TPB) * 2048 + h * 256 + 128, 2048, 0, nk, L_.tid, o);
        }
        const int c = L_.tid & 127, rg = L_.tid >> 7;
#pragma unroll
        for (int i = 0; i < 2; ++i) MIX[(size_t)(row0 + rg * 2 + i) * DM + var * 1024 + h * 128 + c] = (bf16)f2bf(o[i]);
        __syncthreads();
    }
}
__device__ __forceinline__ void p_odd_attn_naive(const Frame& F, const Args& a) {
    const LocalId L_ = local_id(); (void)L_;
    LAS float* S = (LAS float*)(F.lds + RING_OFF); LAS float* qf = (LAS float*)(F.lds + RING_OFF + 8 * SLD * 4); LAS float* ob = qf + 8 * 192;
    const bf16* Y1 = (const bf16*)(F.ws + WS_Y1); bf16* MIX = (bf16*)(F.ws + WS_MIX);
    float d1 = 0.f, d2 = 0.f;
    for (int i = 0; i < 64; ++i) { d1 += a.in[I_LQ1][i] * a.in[I_LK1][i]; d2 += a.in[I_LQ2][i] * a.in[I_LK2][i]; }
    const float lam = expf(d1) - expf(d2) + LAMBDA_INIT;
    constexpr int UC = NB * 8 * 512, UD = NB * 8 * 256;
    for (int u = blockIdx.x; u < UC + UD; u += F.G) {
        const int c = L_.tid & 127, rg = L_.tid >> 7;
        if (u < UC) {
            const int b = u / 4096, rem = u - b * 4096, h = rem / 512, ch = rem - h * 512;
            const int r0 = CTX + ch * 4, row0 = b * TPB + r0; const int nk = TPB;
            const bf16* kb = Y1 + (size_t)(b * TPB) * ODD_IN;
            naive_scores_softmax<64, 4>(S, qf, Y1 + (size_t)row0 * ODD_IN + (2 * h) * 64, ODD_IN, kb + 1024 + (2 * h) * 64, ODD_IN, 0, nk, 0.125f, false, 0, false, 0.f, L_.tid, L_.lane, L_.wave);
            naive_scores_softmax<64, 4>(S + 4 * SLD, qf, Y1 + (size_t)row0 * ODD_IN + (2 * h + 1) * 64, ODD_IN, kb + 1024 + (2 * h + 1) * 64, ODD_IN, 0, nk, 0.125f, false, 0, false, 0.f, L_.tid, L_.lane, L_.wave);
            for (int i = L_.tid; i < 4 * SLD; i += 512) S[i] = S[i] - lam * S[4 * SLD + i];
            __syncthreads();
            float o[1];
            naive_pv<4>(S, kb + 2048 + h * 128, ODD_IN, 0, nk, L_.tid, o);
            ob[rg * 128 + c] = o[0];
            __syncthreads();
            float ss = 0.f; for (int i = 0; i < 128; ++i) { const float v = ob[rg * 128 + i]; ss += v * v; }
            const float r = 1.0f / sqrtf(ss * (1.0f / 128.0f) + NORM_EPS);
            MIX[(size_t)(row0 + rg) * DM + h * 128 + c] = (bf16)f2bf(o[0] * r * a.in[I_SUBLN][c] * (1.0f - LAMBDA_INIT));
        } else {
            const int v = u - UC, b = v / 2048, rem = v - b * 2048, h = rem / 256, ch = rem - h * 256;
            const int s0 = ch * 8, row0 = b * TPB + CTX + s0;
            const int lo = s0 - 128 < 0 ? 0 : s0 - 128, hi = s0 + 7 + 128 > SEQ - 1 ? SEQ - 1 : s0 + 7 + 128; const int nk = CTX + (hi - lo + 1);
            const bf16* kb = Y1 + (size_t)(b * TPB) * ODD_IN;
            naive_scores_softmax<128, 8>(S, qf, Y1 + (size_t)row0 * ODD_IN + 3072 + h * 128, ODD_IN, kb + 4096 + (h >> 2) * 128, ODD_IN, lo, nk, 0.08838834764831845f, true, s0, true, a.in[I_SINK][h], L_.tid, L_.lane, L_.wave);
            float o[2];
            naive_pv<8>(S, kb + 4352 + (h >> 2) * 128, ODD_IN, lo, nk, L_.tid, o);
#pragma unroll
            for (int i = 0; i < 2; ++i) MIX[(size_t)(row0 + rg * 2 + i) * DM + 1024 + h * 128 + c] = (bf16)f2bf(o[i]);
        }
        __syncthreads();
    }
}

namespace att {
using bf16x8 = __attribute__((ext_vector_type(8))) short;
using s16x4  = __attribute__((ext_vector_type(4))) short;
using f32x16 = __attribute__((ext_vector_type(16))) float;
using u32x4  = __attribute__((ext_vector_type(4))) unsigned;
using f32x2  = __attribute__((ext_vector_type(2))) float;
#ifndef ATT_PK_SM
#define ATT_PK_SM 1
#endif
constexpr int KVBLK = 64, QBLK = 32;
constexpr int SHM_V = KVBLK * 128 * 2;
constexpr int K_OFF = 2 * SHM_V, K_MAX = KVBLK * 192 * 2, QL_OFF = K_OFF + 2 * K_MAX, WS_OFF = 131072 + 2048;
constexpr float THR = 8.f;
#define ATT_KSWZ(row, colB, RB) ((row) * (RB) + ((colB) ^ (((row) & 7) << 4)))
#define ATT_SBAR() __builtin_amdgcn_sched_barrier(0)
__device__ __forceinline__ int crow(int r, int hi) { return (r & 3) + 8 * (r >> 2) + 4 * hi; }
__device__ __forceinline__ unsigned cvtpk(float lo, float hi) { unsigned r; asm volatile("v_cvt_pk_bf16_f32 %0, %1, %2" : "=v"(r) : "v"(lo), "v"(hi)); return r; }

__device__ __forceinline__ void partialSM(f32x16& p0, f32x16& p1, float& m_reg, float& mn, float& alpha, float C, float thr_raw) {
  float pmax = p0[0];
#pragma unroll
  for (int r = 1; r < 16; ++r) pmax = fmaxf(pmax, p0[r]);
#pragma unroll
  for (int r = 0; r < 16; ++r) pmax = fmaxf(pmax, p1[r]);
  { auto rr = __builtin_amdgcn_permlane32_swap(__float_as_uint(pmax), __float_as_uint(pmax), false, false);
    pmax = fmaxf(__uint_as_float(rr[0]), __uint_as_float(rr[1])); }
  if (__builtin_expect(__all(pmax - m_reg <= thr_raw), 1)) { mn = m_reg; alpha = 1.f; }
  else { mn = fmaxf(m_reg, pmax); alpha = __builtin_amdgcn_exp2f((m_reg - mn) * C); m_reg = mn; }
  const float mnC = -mn * C;
#if ATT_PK_SM
  { const f32x2 C2 = {C, C}, M2 = {mnC, mnC};
#pragma unroll
    for (int r = 0; r < 16; r += 2) { f32x2 t = {p0[r], p0[r + 1]}; t = __builtin_elementwise_fma(t, C2, M2); p0[r] = t.x; p0[r + 1] = t.y; }
#pragma unroll
    for (int r = 0; r < 16; r += 2) { f32x2 t = {p1[r], p1[r + 1]}; t = __builtin_elementwise_fma(t, C2, M2); p1[r] = t.x; p1[r + 1] = t.y; } }
#else
#pragma unroll
  for (int r = 0; r < 16; ++r) p0[r] = fmaf(p0[r], C, mnC);
#pragma unroll
  for (int r = 0; r < 16; ++r) p1[r] = fmaf(p1[r], C, mnC);
#endif
#pragma unroll
  for (int r = 0; r < 16; ++r) p0[r] = __builtin_amdgcn_exp2f(p0[r]);
}
__device__ __forceinline__ void finishSM(f32x16& p0, f32x16& p1, float alpha, float& l_reg, bf16x8& pa0, bf16x8& pa1, bf16x8& pa2, bf16x8& pa3) {
#pragma unroll
  for (int r = 0; r < 16; ++r) p1[r] = __builtin_amdgcn_exp2f(p1[r]);
#if ATT_PK_SM
  f32x2 ps2 = {p0[0], p0[1]};
#pragma unroll
  for (int r = 2; r < 16; r += 2) ps2 += (f32x2){p0[r], p0[r + 1]};
#pragma unroll
  for (int r = 0; r < 16; r += 2) ps2 += (f32x2){p1[r], p1[r + 1]};
  float ps = ps2.x + ps2.y;
#else
  float ps = 0;
#pragma unroll
  for (int r = 0; r < 16; ++r) ps += p0[r];
#pragma unroll
  for (int r = 0; r < 16; ++r) ps += p1[r];
#endif
  { auto rr = __builtin_amdgcn_permlane32_swap(__float_as_uint(ps), __float_as_uint(ps), false, false);
    ps = __uint_as_float(rr[0]) + __uint_as_float(rr[1]); }
  l_reg = l_reg * alpha + ps;
#define ATT_PK4(P, BASE, OUT) do { unsigned a0 = cvtpk(P[BASE + 0], P[BASE + 1]), a1 = cvtpk(P[BASE + 2], P[BASE + 3]);   \
    unsigned b0 = cvtpk(P[BASE + 4], P[BASE + 5]), b1 = cvtpk(P[BASE + 6], P[BASE + 7]);                              \
    auto r0 = __builtin_amdgcn_permlane32_swap(a0, b0, false, false); auto r1 = __builtin_amdgcn_permlane32_swap(a1, b1, false, false); \
    u32x4 w = {r0[0], r1[0], r0[1], r1[1]}; OUT = *reinterpret_cast<bf16x8*>(&w); } while (0)
  ATT_PK4(p0, 0, pa0); ATT_PK4(p0, 8, pa1); ATT_PK4(p1, 0, pa2); ATT_PK4(p1, 8, pa3);
#undef ATT_PK4
}
template <int DQ, int NQT, int NQR, int QSB>
__device__ __forceinline__ void qkt(f32x16& p0, f32x16& p1, const char* Ks, const bf16x8 (&qr)[NQR], const char* qlds, const int (&kb)[4]) {
  p0 = f32x16{}; p1 = f32x16{};
#pragma unroll
  for (int d0 = 0; d0 < NQT; ++d0) {
    const bf16x8 b0 = *reinterpret_cast<const bf16x8*>(Ks + kb[d0 & 3] + (d0 >> 2) * 128);
    const bf16x8 b1 = *reinterpret_cast<const bf16x8*>(Ks + kb[d0 & 3] + (d0 >> 2) * 128 + 32 * DQ * 2);
    bf16x8 q; if (d0 < NQR) q = qr[d0 < NQR ? d0 : 0]; else q = *reinterpret_cast<const bf16x8*>(qlds + (d0 - NQR) * 1024);
    p0 = __builtin_amdgcn_mfma_f32_32x32x16_bf16(b0, q, p0, 0, 0, 0);
    p1 = __builtin_amdgcn_mfma_f32_32x32x16_bf16(b1, q, p1, 0, 0, 0);
    if (QSB > 0 && (d0 % (QSB > 0 ? QSB : 1)) == (QSB - 1) && d0 + 1 < NQT) ATT_SBAR(); }
}
__device__ __forceinline__ void mask_tile(f32x16& p0, f32x16& p1, int kp0, int qpos, int hi) {
#pragma unroll
  for (int r = 0; r < 16; ++r) { const int d = qpos - (kp0 + crow(r, hi));
    if (d > 128 || d < -128) p0[r] = -1e30f;
    if (d - 32 > 128 || d - 32 < -128) p1[r] = -1e30f; }
}
__device__ __forceinline__ int v_st(int k, int c) { const int kk = (k & ~0xC) | ((k & 4) << 1) | ((k & 8) >> 1); return ((kk >> 3) * 4 + (c >> 5)) * 512 + ((kk & 7) * 32 + (c & 31)) * 2; }
__device__ __forceinline__ int v_rd_base(int lane) { return ((lane & 3) << 3) | (((lane >> 2) & 3) << 6) | (((lane >> 4) & 1) << 5) | (((lane >> 5) & 1) << 8); }
constexpr int v_rd_off(int d0, int ks, int half) { return d0 * 512 + ks * 4096 + half * 2048; }
template <int OFF> __device__ __forceinline__ s16x4 tr_read(int vb) {
  s16x4 r; asm volatile("ds_read_b64_tr_b16 %0, %1 offset:%2" : "=&v"(r) : "v"(vb), "i"(OFF) : "memory"); return r;
}
template <int D0> __device__ __forceinline__ void pv_one(f32x16& od, int vb, bf16x8 pa0, bf16x8 pa1, bf16x8 pa2, bf16x8 pa3) {
  const s16x4 l0 = tr_read<v_rd_off(D0, 0, 0)>(vb), h0 = tr_read<v_rd_off(D0, 0, 1)>(vb), l1 = tr_read<v_rd_off(D0, 1, 0)>(vb), h1 = tr_read<v_rd_off(D0, 1, 1)>(vb);
  const s16x4 l2 = tr_read<v_rd_off(D0, 2, 0)>(vb), h2 = tr_read<v_rd_off(D0, 2, 1)>(vb), l3 = tr_read<v_rd_off(D0, 3, 0)>(vb), h3 = tr_read<v_rd_off(D0, 3, 1)>(vb);
  asm volatile("s_waitcnt lgkmcnt(0)" ::: "memory"); ATT_SBAR();
#define ATT_PK(L, H) (bf16x8){L[0], L[1], L[2], L[3], H[0], H[1], H[2], H[3]}
  od = __builtin_amdgcn_mfma_f32_32x32x16_bf16(pa0, ATT_PK(l0, h0), od, 0, 0, 0);
  od = __builtin_amdgcn_mfma_f32_32x32x16_bf16(pa1, ATT_PK(l1, h1), od, 0, 0, 0);
  od = __builtin_amdgcn_mfma_f32_32x32x16_bf16(pa2, ATT_PK(l2, h2), od, 0, 0, 0);
  od = __builtin_amdgcn_mfma_f32_32x32x16_bf16(pa3, ATT_PK(l3, h3), od, 0, 0, 0);
#undef ATT_PK
}
__device__ __forceinline__ void pv_d0(f32x16* o, int vb, bf16x8 pa0, bf16x8 pa1, bf16x8 pa2, bf16x8 pa3) {
  pv_one<0>(o[0], vb, pa0, pa1, pa2, pa3); pv_one<1>(o[1], vb, pa0, pa1, pa2, pa3); pv_one<2>(o[2], vb, pa0, pa1, pa2, pa3); pv_one<3>(o[3], vb, pa0, pa1, pa2, pa3);
}

template <int M> __device__ __forceinline__ float swz_xor(float v) { return __builtin_bit_cast(float, __builtin_amdgcn_ds_swizzle(__builtin_bit_cast(int, v), (M << 10) | 0x1F)); }
__device__ __forceinline__ float sum_xor32(float v) { auto rr = __builtin_amdgcn_permlane32_swap(__float_as_uint(v), __float_as_uint(v), false, false); return __uint_as_float(rr[0]) + __uint_as_float(rr[1]); }
__device__ __forceinline__ float bfx(short v) { return __builtin_bit_cast(float, ((unsigned)(unsigned short)v) << 16); }
template <int MODE, int NQ>
__device__ __forceinline__ void q_fix(bf16x8 (&q)[NQ], const float* gain, const float* tab  , int pos, int hi) {
  constexpr int DIM = NQ * 16;
  float x[NQ][8]; float ss = 0.f;
#pragma unroll
  for (int d0 = 0; d0 < NQ; ++d0)
#pragma unroll
    for (int j = 0; j < 8; ++j) { x[d0][j] = bfx(q[d0][j]); ss += x[d0][j] * x[d0][j]; }
  ss = sum_xor32(ss);
  const float r = 1.0f / sqrtf(ss * (1.0f / DIM) + 1e-6f);
#pragma unroll
  for (int d0 = 0; d0 < NQ; ++d0) { const float* g = gain + d0 * 16 + hi * 8;
#pragma unroll
    for (int j = 0; j < 8; ++j) x[d0][j] *= r * g[j]; }
  if (pos >= 0) {
    const int prow = pos >> 6, pcol = pos & 63;
    constexpr int RB0 = (MODE == 2) ? 8 : 0, NRB = (MODE == 1) ? 8 : 4, NF = (MODE == 1) ? 32 : 16, PX = (MODE == 1) ? 2 : 1;
    float y[NRB][8];
#pragma unroll
    for (int b = 0; b < NRB; ++b) { const int p = (b < NRB / 2) ? prow : pcol; const int f0 = (MODE == 1 ? (b & 1) * 16 : 0) + hi * 8; const float sg = (b & PX) ? 1.0f : -1.0f;
      const float* t = tab + (size_t)(p * NF + f0) * 2;
#pragma unroll
      for (int j = 0; j < 8; ++j) y[b][j] = x[RB0 + b][j] * t[2 * j] + sg * x[RB0 + (b ^ PX)][j] * t[2 * j + 1]; }
#pragma unroll
    for (int b = 0; b < NRB; ++b)
#pragma unroll
      for (int j = 0; j < 8; ++j) x[RB0 + b][j] = y[b][j];
  }
#pragma unroll
  for (int d0 = 0; d0 < NQ; ++d0) { u32x4 w; w.x = cvtpk(x[d0][0], x[d0][1]); w.y = cvtpk(x[d0][2], x[d0][3]); w.z = cvtpk(x[d0][4], x[d0][5]); w.w = cvtpk(x[d0][6], x[d0][7]); q[d0] = *reinterpret_cast<bf16x8*>(&w); }
}

template <int DQ, bool WINDOW, bool SINK, int LDQ, int LDK, int LDV, int SD, int QSB, int NQRMAX, bool DIFF = false, int QMODE = 0>
__device__ __forceinline__ void attn_unit(const bf16* __restrict__ Qb, const bf16* __restrict__ Kb, const bf16* __restrict__ Vb,
                                          bf16* __restrict__ Ob, int ntiles, int band_lo, int qpos0, float scale, float sink, char* lds, const float* gainp = nullptr,
                                          const float* qgain = nullptr, const float* qtab = nullptr, int qs0 = -1, int wv = 0) {
  constexpr int NQ = (DIFF ? DQ / 2 : DQ) / 16, NQR = NQ > NQRMAX ? NQRMAX : NQ, NCH = DQ / 64, RB = DQ * 2, SHM_K = KVBLK * DQ * 2, LDO = 2048;
  int tid = wv * 64 + lane_id_(); asm volatile("" : "+v"(tid));
  const int wid = tid >> 6, lane = tid & 63, r32 = lane & 31, hi = lane >> 5;
  const int comp = DIFF ? (wid >> 2) : 0, wrow = DIFF ? (wid & 3) : wid, kcomp = comp * 128;
  char* V_lds = lds; char* K_lds = lds + K_OFF;
  float* ws = (float*)(lds + WS_OFF) + wid * 64; float* li_l = ws; float* al_l = ws + 32;
  const float C = scale * 1.4426950408889634f, thr_raw = THR / scale;
  float m_reg = -1e30f, l_reg = 0; f32x16 o[4] = {}; bf16x8 qr[NQR];
  const unsigned qoff = (unsigned)((wrow * QBLK + r32) * LDQ + hi * 8 + comp * 64) * 2u;
  char* qlds = lds + QL_OFF + wid * ((NQ - NQR) * 1024) + lane * 16;
  if constexpr (QMODE == 0) {
#pragma unroll
    for (int d0 = 0; d0 < NQR; ++d0) qr[d0] = *reinterpret_cast<const bf16x8*>((const char*)Qb + qoff + d0 * 32);
    __syncthreads();
    if constexpr (NQ > NQR) {
#pragma unroll
      for (int d0 = NQR; d0 < NQ; ++d0) *reinterpret_cast<bf16x8*>(qlds + (d0 - NQR) * 1024) = *reinterpret_cast<const bf16x8*>((const char*)Qb + qoff + d0 * 32);
    }
  } else {
    bf16x8 qall[NQ];
#pragma unroll
    for (int d0 = 0; d0 < NQ; ++d0) qall[d0] = *reinterpret_cast<const bf16x8*>((const char*)Qb + qoff + d0 * 32);
    q_fix<QMODE, NQ>(qall, qgain, qtab, qs0 < 0 ? -1 : qs0 + wrow * QBLK + r32, hi);
#pragma unroll
    for (int d0 = 0; d0 < NQR; ++d0) qr[d0] = qall[d0];
    __syncthreads();
    if constexpr (NQ > NQR) {
#pragma unroll
      for (int d0 = NQR; d0 < NQ; ++d0) *reinterpret_cast<bf16x8*>(qlds + (d0 - NQR) * 1024) = qall[d0];
    }
  }
  const int sr = tid >> 4, sc = (tid & 15) * 8, vst0 = v_st(sr, sc);
  const unsigned voV = (unsigned)(sr * LDV + sc) * 2u;
  const int kr_ = tid >> 3, kc_ = (tid & 7) * 8;
  const unsigned voK = (unsigned)(kr_ * LDK + kc_) * 2u; const int kwr = ATT_KSWZ(kr_, kc_ * 2, RB);
  const int vb0 = (int)(uintptr_t)V_lds + v_rd_base(lane);
  int kb[4];
#pragma unroll
  for (int k = 0; k < 4; ++k) kb[k] = r32 * RB + ((k ^ ((r32 & 7) >> 1)) * 32) + ((hi ^ (r32 & 1)) * 16);
  const int qpos = qpos0 + wrow * QBLK + r32;
  struct { bf16x8 vs0, vs1, ks[NCH]; } sr_[SD];
#define ATT_KROW(j) (WINDOW ? ((j) < 4 ? (j) * KVBLK : 256 + band_lo + ((j) - 4) * KVBLK) : (j) * KVBLK)
#define ATT_SLOAD(i, j) do { const int k0_ = ATT_KROW(j); const char* vt_ = (const char*)Vb + (size_t)k0_ * (LDV * 2); const char* kt_ = (const char*)Kb + (size_t)k0_ * (LDK * 2); \
    sr_[i].vs0 = *reinterpret_cast<const bf16x8*>(vt_ + voV); sr_[i].vs1 = *reinterpret_cast<const bf16x8*>(vt_ + voV + 32 * LDV * 2); \
    _Pragma("unroll") for (int c_ = 0; c_ < NCH; ++c_) sr_[i].ks[c_] = *reinterpret_cast<const bf16x8*>(kt_ + voK + c_ * 128); } while (0)
#define ATT_SWRITE(b, i) do { *(bf16x8*)(V_lds + (b) * SHM_V + vst0) = sr_[i].vs0; *(bf16x8*)(V_lds + (b) * SHM_V + vst0 + 8192) = sr_[i].vs1; \
    _Pragma("unroll") for (int c_ = 0; c_ < NCH; ++c_) *(bf16x8*)(K_lds + (b) * SHM_K + kwr + c_ * 128) = sr_[i].ks[c_]; } while (0)
#define ATT_SWAIT() do { if constexpr (SD == 1) asm volatile("s_waitcnt vmcnt(0)" ::: "memory"); else if constexpr (NCH == 1) asm volatile("s_waitcnt vmcnt(3)" ::: "memory"); else if constexpr (NCH == 2) asm volatile("s_waitcnt vmcnt(4)" ::: "memory"); else asm volatile("s_waitcnt vmcnt(5)" ::: "memory"); } while (0)
#define ATT_RESC(a) do { if (__any((a) < 1.f)) { if (hi == 0) al_l[r32] = (a); asm volatile("s_waitcnt lgkmcnt(0)" ::: "memory"); \
    _Pragma("unroll") for (int d = 0; d < 4; ++d) _Pragma("unroll") for (int r = 0; r < 16; ++r) o[d][r] *= al_l[crow(r, hi)]; } } while (0)
#define ATT_MASK(P0, P1, j) do { if constexpr (WINDOW) { if ((j) >= 4) mask_tile(P0, P1, band_lo + ((j) - 4) * KVBLK, qpos, hi); } } while (0)
  f32x16 pA0, pA1, pB0, pB1; float mnA, mnB, alA, alB; bf16x8 pa0, pa1, pa2, pa3; const int NT = ntiles;
  constexpr int SE = 0, SO = SD - 1;
  ATT_SLOAD(SE, 0); asm volatile("s_waitcnt vmcnt(0)" ::: "memory"); ATT_SWRITE(0, SE); __syncthreads();
  qkt<DQ, NQ, NQR, QSB>(pA0, pA1, K_lds + kcomp, qr, qlds, kb); ATT_MASK(pA0, pA1, 0); partialSM(pA0, pA1, m_reg, mnA, alA, C, thr_raw);
  ATT_SLOAD(SO, 1); if constexpr (SD == 2) { if (2 < NT) ATT_SLOAD(SE, 2); }
  ATT_SWAIT(); ATT_SWRITE(1, SO); __syncthreads();
  for (int j = 1; j + 1 < NT; j += 2) {
    ATT_SBAR(); qkt<DQ, NQ, NQR, QSB>(pB0, pB1, K_lds + SHM_K + kcomp, qr, qlds, kb);
    finishSM(pA0, pA1, alA, l_reg, pa0, pa1, pa2, pa3); ATT_SBAR();
    ATT_SLOAD(SO, j + SD); ATT_SBAR();
    pv_d0(o, vb0, pa0, pa1, pa2, pa3); ATT_MASK(pB0, pB1, j); partialSM(pB0, pB1, m_reg, mnB, alB, C, thr_raw);
    __syncthreads(); ATT_SWAIT(); ATT_SWRITE(0, SE);
    ATT_RESC(alB); __syncthreads();
    ATT_SBAR(); qkt<DQ, NQ, NQR, QSB>(pA0, pA1, K_lds + kcomp, qr, qlds, kb);
    finishSM(pB0, pB1, alB, l_reg, pa0, pa1, pa2, pa3); ATT_SBAR();
    if (SD == 1 || j + 3 < NT) ATT_SLOAD(SE, j + 1 + SD); ATT_SBAR();
    pv_d0(o, vb0 + SHM_V, pa0, pa1, pa2, pa3); ATT_MASK(pA0, pA1, j + 1); partialSM(pA0, pA1, m_reg, mnA, alA, C, thr_raw);
    __syncthreads(); ATT_SWAIT(); ATT_SWRITE(1, SO);
    ATT_RESC(alA); __syncthreads();
  }
  ATT_SBAR(); qkt<DQ, NQ, NQR, QSB>(pB0, pB1, K_lds + SHM_K + kcomp, qr, qlds, kb);
  finishSM(pA0, pA1, alA, l_reg, pa0, pa1, pa2, pa3); ATT_SBAR();
  pv_d0(o, vb0, pa0, pa1, pa2, pa3); ATT_MASK(pB0, pB1, NT - 1); partialSM(pB0, pB1, m_reg, mnB, alB, C, thr_raw);
  __syncthreads(); ATT_RESC(alB);
  finishSM(pB0, pB1, alB, l_reg, pa0, pa1, pa2, pa3); ATT_SBAR();
  pv_d0(o, vb0 + SHM_V, pa0, pa1, pa2, pa3);
  if constexpr (SINK) l_reg += __builtin_amdgcn_exp2f(sink * 1.4426950408889634f - m_reg * C);
  if (hi == 0) li_l[r32] = l_reg; asm volatile("s_waitcnt lgkmcnt(0)" ::: "memory");
  float rli[16];
#pragma unroll
  for (int r = 0; r < 16; ++r) rli[r] = __builtin_amdgcn_rcpf(li_l[crow(r, hi)]);
  int tid2 = wv * 64 + lane_id_(); asm volatile("" : "+v"(tid2));
  if constexpr (!DIFF) {
    const bool odd = tid2 & 1;
    const unsigned ooff = (unsigned)(((tid2 >> 6) * QBLK + 4 * ((tid2 >> 5) & 1) + (tid2 & 1)) * LDO + (tid2 & 30)) * 2u;
#pragma unroll
    for (int rp = 0; rp < 8; ++rp) { const int orow = ((2 * rp) & 3) + 8 * ((2 * rp) >> 2);
#pragma unroll
      for (int d0 = 0; d0 < 4; ++d0) { const float a_ = o[d0][2 * rp] * rli[2 * rp], b_ = o[d0][2 * rp + 1] * rli[2 * rp + 1];
        const float rc = swz_xor<1>(odd ? a_ : b_);
        *reinterpret_cast<unsigned*>((char*)Ob + ooff + (orow * LDO + d0 * 32) * 2) = odd ? cvtpk(rc, b_) : cvtpk(a_, rc); } }
  } else {
    float* X = (float*)lds + ((tid2 >> 6) & 3) * 4096 + (tid2 & 63);
    __syncthreads();
    if (tid2 >= 256) {
#pragma unroll
      for (int d0 = 0; d0 < 4; ++d0)
#pragma unroll
        for (int r = 0; r < 16; ++r) X[(d0 * 16 + r) * 64] = sink * (o[d0][r] * rli[r]);
    }
    __syncthreads();
    if (tid2 < 256) {
      float g[4];
#pragma unroll
      for (int d0 = 0; d0 < 4; ++d0) g[d0] = gainp[d0 * 32 + (tid2 & 31)];
      const bool odd = tid2 & 1;
      const unsigned ooff = (unsigned)(((tid2 >> 6) * QBLK + 4 * ((tid2 >> 5) & 1) + (tid2 & 1)) * LDO + (tid2 & 30)) * 2u;
#pragma unroll
      for (int rp = 0; rp < 8; ++rp) { const int orow = ((2 * rp) & 3) + 8 * ((2 * rp) >> 2);
        float da[4], db[4], sa = 0.f, sb = 0.f;
#pragma unroll
        for (int d0 = 0; d0 < 4; ++d0) { da[d0] = o[d0][2 * rp] * rli[2 * rp] - X[(d0 * 16 + 2 * rp) * 64]; db[d0] = o[d0][2 * rp + 1] * rli[2 * rp + 1] - X[(d0 * 16 + 2 * rp + 1) * 64]; sa += da[d0] * da[d0]; sb += db[d0] * db[d0]; }
        sa += swz_xor<1>(sa); sa += swz_xor<2>(sa); sa += swz_xor<4>(sa); sa += swz_xor<8>(sa); sa += swz_xor<16>(sa);
        sb += swz_xor<1>(sb); sb += swz_xor<2>(sb); sb += swz_xor<4>(sb); sb += swz_xor<8>(sb); sb += swz_xor<16>(sb);
        const float ra = __builtin_amdgcn_rsqf(sa * (1.0f / 128.0f) + 1e-6f), rb = __builtin_amdgcn_rsqf(sb * (1.0f / 128.0f) + 1e-6f);
#pragma unroll
        for (int d0 = 0; d0 < 4; ++d0) { const float a_ = da[d0] * ra * g[d0], b_ = db[d0] * rb * g[d0];
          const float rc = swz_xor<1>(odd ? a_ : b_);
          *reinterpret_cast<unsigned*>((char*)Ob + ooff + (orow * LDO + d0 * 32) * 2) = odd ? cvtpk(rc, b_) : cvtpk(a_, rc); } }
    }
  }
#undef ATT_KROW
#undef ATT_SLOAD
#undef ATT_SWRITE
#undef ATT_SWAIT
#undef ATT_RESC
#undef ATT_MASK
}
}

__device__ __forceinline__ void p_even_attn(const Frame& F, const Args& a, char* lds) {
    const LocalId L_ = local_id(); (void)L_;
    const bf16* Y1 = (const bf16*)(F.ws + WS_Y1); const bf16* QB = (const bf16*)(F.ws + WS_QB); const bf16* KV = (const bf16*)(F.ws + WS_KV); const bf16* KB = (const bf16*)(F.ws + WS_KB);
    bf16* MIX = (bf16*)(F.ws + WS_MIX);
    const float* t128 = (const float*)(F.ws + WS_ROPE); const float* t64 = (const float*)(F.ws + WS_ROPE + 16384);
    for (int n = blockIdx.x; n < 512 + 64; n += F.G) {
        int b, h, row0, nt, qs0;
        if (n < 512) { const int i = n >> 8, c = n & 255, x = c & 7, lc = c >> 3, gi = i * 8 + x; b = gi >> 1; h = (gi & 1) * 4 + (lc >> 3); qs0 = (lc & 7) * 256; row0 = b * TPB + CTX + qs0; nt = 36; }
        else { const int m = n - 512; b = m >> 3; h = m & 7; row0 = b * TPB; nt = 4; qs0 = -1; }
        const size_t kb = (size_t)b * TPB;
        att::attn_unit<128, false, false, EVEN_IN_P, EVEN_IN_P, EVEN_IN_P, 2, 0, 8, false, 1>(Y1 + (size_t)row0 * EVEN_IN_P + h * 128, Y1 + kb * EVEN_IN_P + 1024 + (h >> 2) * 128, Y1 + kb * EVEN_IN_P + 1280 + (h >> 2) * 128,
                                                                                 MIX + (size_t)row0 * DM + h * 128, nt, 0, 0, 0.08838834764831845f, 0.f, lds, nullptr, a.in[I_AQN], t128, qs0, L_.wave);
    }
    for (int n = blockIdx.x; n < 512 + 64; n += F.G) {
        int b, h, row0, nt, qs0;
        if (n < 512) { const int i = n >> 8, c = n & 255, x = c & 7, lc = c >> 3, gi = i * 8 + x; b = gi >> 1; h = (gi & 1) * 4 + (lc >> 3); qs0 = (lc & 7) * 256; row0 = b * TPB + CTX + qs0; nt = 36; }
        else { const int m = n - 512; b = m >> 3; h = m & 7; row0 = b * TPB; nt = 4; qs0 = -1; }
        const size_t kb = (size_t)b * TPB;
        att::attn_unit<192, false, false, 1536, 1536, 2048, 1, 0, 8, false, 2>(QB + (size_t)row0 * 1536 + h * 192, KB + kb * 1536 + h * 192, KV + kb * 2048 + h * 256 + 128,
                                                                  MIX + (size_t)row0 * DM + 1024 + h * 128, nt, 0, 0, 0.07216878364870322f, 0.f, lds, nullptr, a.in[I_BQN], t64, qs0, L_.wave);
    }
    __syncthreads();
}
__device__ __forceinline__ void p_odd_attn(const Frame& F, const Args& a, char* lds) {
    const LocalId L_ = local_id(); (void)L_;
    const bf16* Y1 = (const bf16*)(F.ws + WS_Y1); bf16* O12 = (bf16*)(F.ws + WS_A1); bf16* MIX = (bf16*)(F.ws + WS_MIX);
#if ATT_DIFF_FUSED
    float d1 = 0.f, d2 = 0.f;
    for (int i = 0; i < 64; ++i) { d1 += a.in[I_LQ1][i] * a.in[I_LK1][i]; d2 += a.in[I_LQ2][i] * a.in[I_LK2][i]; }
    const float lam = expf(d1) - expf(d2) + LAMBDA_INIT;
    const float* gsub = (const float*)(F.ws + WS_ROPE + 32768);
    for (int n = blockIdx.x; n < 1024; n += F.G) {
        const int i = n >> 8, c = n & 255, x = c & 7, lc = c >> 3, gi = i * 8 + x, b = gi >> 2, h = (gi & 3) * 2 + (lc >> 4), row0 = b * TPB + CTX + (lc & 15) * 128;
        const size_t kb = (size_t)b * TPB * ODD_IN;
        att::attn_unit<128, false, false, ODD_IN, ODD_IN, ODD_IN, 2, 0, 8, true, 3>(Y1 + (size_t)row0 * ODD_IN + h * 128, Y1 + kb + 1024 + h * 128, Y1 + kb + 2048 + h * 128,
                                                                             MIX + (size_t)row0 * DM + h * 128, 36, 0, 0, 0.125f, lam, lds, gsub, a.in[I_CQN], (const float*)(F.ws + WS_ROPE + 16384), (lc & 15) * 128, L_.wave);
    }
#else
    for (int n = blockIdx.x; n < 1024; n += F.G) {
        const int i = n >> 8, c = n & 255, x = c & 7, lc = c >> 3, gi = i * 8 + x, b = gi >> 2, ch = (gi & 3) * 4 + (lc >> 3), row0 = b * TPB + CTX + (lc & 7) * 256;
        const size_t kb = (size_t)b * TPB * ODD_IN;
        att::attn_unit<64, false, false, ODD_IN, ODD_IN, ODD_IN, 2, 0, 8>(Y1 + (size_t)row0 * ODD_IN + ch * 64, Y1 + kb + 1024 + ch * 64, Y1 + kb + 2048 + (ch >> 1) * 128,
                                                                       O12 + (size_t)row0 * DM + ch * 128, 36, 0, 0, 0.125f, 0.f, lds, nullptr, nullptr, nullptr, -1, L_.wave);
    }
#endif
    for (int m = blockIdx.x; m < 512; m += F.G) {
        const int i = m >> 8, c = m & 255, x = c & 7, lc = c >> 3, gi = i * 8 + x, b = gi >> 1, kvh = gi & 1, h = kvh * 4 + (lc >> 3), s0 = (lc & 7) * 256, row0 = b * TPB + CTX + s0;
        const int lo = s0 - 128 < 0 ? 0 : s0 - 128, hie = s0 + 384 > SEQ ? SEQ : s0 + 384;
        const size_t kb = (size_t)b * TPB * ODD_IN;
        att::attn_unit<128, true, true, ODD_IN, ODD_IN, ODD_IN, 1, 0, 8, false, 1>(Y1 + (size_t)row0 * ODD_IN + 3072 + h * 128, Y1 + kb + 4096 + kvh * 128, Y1 + kb + 4352 + kvh * 128,
                                                                      MIX + (size_t)row0 * DM + 1024 + h * 128, 4 + (hie - lo) / 64, lo, s0, 0.08838834764831845f, a.in[I_SINK][h], lds, nullptr, a.in[I_DQN], (const float*)(F.ws + WS_ROPE), s0, L_.wave);
    }
    __syncthreads();
}
__device__ __forceinline__ void p_odd_combine(const Frame& F, const Args& a) {
    const LocalId L_ = local_id(); (void)L_;
    const int gw = F.vcu * NWAVES + L_.wave, NGW = F.G * NWAVES;
    const bf16* O12 = (const bf16*)(F.ws + WS_A1); bf16* MIX = (bf16*)(F.ws + WS_MIX);
    float d1 = 0.f, d2 = 0.f;
    for (int i = 0; i < 64; ++i) { d1 += a.in[I_LQ1][i] * a.in[I_LK1][i]; d2 += a.in[I_LQ2][i] * a.in[I_LK2][i]; }
    const float lam = expf(d1) - expf(d2) + LAMBDA_INIT;
    const float g0 = a.in[I_SUBLN][L_.lane] * (1.0f - LAMBDA_INIT), g1 = a.in[I_SUBLN][L_.lane + 64] * (1.0f - LAMBDA_INIT);
    for (int i = gw; i < NB * SEQ; i += NGW) {
        const int b = i / SEQ, row = b * TPB + CTX + (i - b * SEQ);
        const bf16* src = O12 + (size_t)row * DM; bf16* dst = MIX + (size_t)row * DM;
        for (int h = 0; h < 8; ++h) {
            const float x0 = bf2f(src[2 * h * 128 + L_.lane]) - lam * bf2f(src[(2 * h + 1) * 128 + L_.lane]);
            const float x1 = bf2f(src[2 * h * 128 + 64 + L_.lane]) - lam * bf2f(src[(2 * h + 1) * 128 + 64 + L_.lane]);
            const float ss = wave_sum(x0 * x0 + x1 * x1);
            const float r = 1.0f / sqrtf(ss * (1.0f / 128.0f) + NORM_EPS);
            dst[h * 128 + L_.lane] = (bf16)f2bf(x0 * r * g0); dst[h * 128 + 64 + L_.lane] = (bf16)f2bf(x1 * r * g1);
        }
    }
}

#ifndef FILL_S
#define FILL_S 2
#endif
#ifndef FILL_B
#define FILL_B 2
#endif
constexpr unsigned NCHUNK = 64u * 3072u / (8u * FILL_S), NCHUNK_L0 = NCHUNK / 2u, NCHUNK_L1GU = NCHUNK / 6u * 5u, FILL_NONE = 0xffffffffu;
template <bool BARRIER>
__device__ __forceinline__ void fill_loop(const Frame& F, const Args& a, unsigned* xgen, unsigned gen, unsigned lim) {
    const LocalId L_ = local_id();
    volatile LAS unsigned* st = F.MISC + 8;
    unsigned* ctr = (unsigned*)(F.ctl + CW_ITEM);
    unsigned cur = st[6] - 1u, nxt = st[7] - 1u; int s0 = (int)(st[16 + L_.wave] & 255u);
    __syncthreads();
    if (cur == FILL_NONE) { cur = nxt; nxt = FILL_NONE; s0 = 0; }
    if (cur == FILL_NONE) {
        if (L_.tid == 0) { const bool rel = BARRIER && xb_ld(xgen) != gen; st[5] = rel ? FILL_NONE : xb_add(ctr, 1u); }
        __syncthreads();
        cur = st[5];
        __syncthreads();
    }
    for (;;) {
        if (cur >= NCHUNK) { cur = FILL_NONE; nxt = FILL_NONE; s0 = 0; break; }
        if (!BARRIER && cur >= lim) break;
        unsigned nid = nxt;
        if (nxt == FILL_NONE && L_.tid == 0) nid = xb_add(ctr, 1u);
        int sN = s0; bool relw = false;
#pragma unroll 1
        for (; sN < FILL_S && !relw; sN += FILL_B) {
            const int r = (int)cur * (8 * FILL_S) + 8 * sN + L_.wave;
            TrAddr t[FILL_B]; f32x4 v[FILL_B][8];
#pragma unroll
            for (int j = 0; j < FILL_B; ++j) { t[j] = moe_item_addr(F, a, r + 8 * j); tr_load(v[j], t[j], L_.lane); }
            unsigned g = gen; if (BARRIER) g = (unsigned)__builtin_amdgcn_readfirstlane(xb_ld(xgen));
#pragma unroll
            for (int j = 0; j < FILL_B; ++j) tr_store(v[j], t[j], L_.lane);
            relw = (g != gen);
        }
        if (L_.lane == 0) st[16 + L_.wave] = (unsigned)sN | (relw ? 256u : 0u);
        if (L_.tid == 0) st[5] = nid;
        __syncthreads();
        nid = st[5]; bool partial = false, rel = false;
#pragma unroll
        for (int w = 0; w < NWAVES; ++w) { const unsigned x = st[16 + w]; partial = partial || ((x & 255u) < (unsigned)FILL_S); rel = rel || (x >= 256u); }
        __syncthreads();
        if (partial) { nxt = nid; s0 = sN; break; }
        cur = nid; nxt = FILL_NONE; s0 = 0;
        if (rel) break;
    }
    if (nxt != FILL_NONE && nxt >= NCHUNK) nxt = FILL_NONE;
    if (L_.lane == 0) st[16 + L_.wave] = (unsigned)s0;
    if (L_.tid == 0) { st[6] = cur + 1u; st[7] = nxt + 1u; }
    __syncthreads();
}
__device__ __forceinline__ void fill_until(const Frame& F, const Args& a, unsigned lim) { __syncthreads(); fill_loop<false>(F, a, nullptr, 0u, lim); }
__device__ __forceinline__ void xcd_barrier_fill(const XcdBarrier& b, const Frame& F, const Args& a) {
    asm volatile("s_waitcnt vmcnt(0)" ::: "memory");
    __syncthreads();
    volatile LAS unsigned* st = b.st;
    if (threadIdx.x == 0) {
        unsigned* bar = b.bar;
        __builtin_amdgcn_s_waitcnt(0);
        unsigned nloc = st[0], nx = st[1];
        if (nloc == 0u) { xcd_barrier_complete(bar, b.x, nloc, nx); st[0] = nloc; st[1] = nx; }
        const unsigned old = xb_add(&bar[XB_XSUB(b.x)], 1u);
        const unsigned gen = old / nloc;
        if (old + 1u == (gen + 1u) * nloc) {
            __builtin_amdgcn_fence(__ATOMIC_RELEASE, "agent");
            asm volatile("s_waitcnt vmcnt(0)" ::: "memory");
            const unsigned og = xb_add(&bar[XB_TOP], 1u);
            const unsigned tg = og / nx;
            if (og + 1u == (tg + 1u) * nx) xb_add(&bar[XB_TOPGEN], 1u);
            else XB_SPIN(xb_ld(&bar[XB_TOPGEN]) == tg, bar);
            __builtin_amdgcn_fence(__ATOMIC_ACQUIRE, "agent");
            xb_add(&bar[XB_XGEN(b.x)], 1u);
            asm volatile("s_waitcnt vmcnt(0)" ::: "memory");
            st[2] = 1u;
        } else { st[2] = 0u; st[3] = gen; }
    }
    __syncthreads();
    if (st[2] == 0u) {
        const unsigned gen = st[3];
        unsigned* xgen = &b.bar[XB_XGEN(b.x)];
        fill_loop<true>(F, a, xgen, gen, 0u);
        if (threadIdx.x == 0) {
            XB_SPIN(xb_ld(xgen) == gen, b.bar);
            __builtin_amdgcn_fence(__ATOMIC_ACQUIRE, "agent");
            asm volatile("s_waitcnt vmcnt(0)" ::: "memory");
        }
    }
    __syncthreads();
}

__device__ __forceinline__ int geff(int n, int G, int xr = 0) {
#if BG_CONVERT && !MK_PER_PHASE && BG_GEFF
    if (G % 8 != 0 || n <= 0) return G;
    const int rounds = (n + G - 1) / G + xr, g = ((n + rounds - 1) / rounds + 7) & ~7;
    return g < G ? g : G;
#else
    return G;
#endif
}
#ifndef XR_GEMM1E
#define XR_GEMM1E 0
#endif
#ifndef XR_GEMM3E
#define XR_GEMM3E 0
#endif
#ifndef XR_MOE_UP0
#define XR_MOE_UP0 0
#endif
#ifndef XR_MOE_DN0
#define XR_MOE_DN0 0
#endif
#ifndef XR_GEMM1O
#define XR_GEMM1O 0
#endif

__global__ void __launch_bounds__(NWAVES * 64, 2) trunk_fwd(Args args) {
    extern __shared__ __attribute__((aligned(16))) unsigned char lds[];
    Frame F;
    F.lds = (LAS unsigned char*)lds;
    F.MISC = (volatile LAS unsigned*)(F.lds + MISC_OFF);
    F.tid = threadIdx.x; F.lane = F.tid & 63; F.wave = __builtin_amdgcn_readfirstlane(F.tid >> 6);
    F.G = gridDim.x; { const int bx = blockIdx.x; F.vcu = (F.G % 8 == 0) ? (bx % 8) * (F.G / 8) + bx / 8 : bx; }
    F.ws = args.ws; F.ctl = (gu32*)(args.ws + WS_CTL);
    for (int u = F.tid; u < (LDS_BYTES - LDSCTL_OFF) / 4; u += NWAVES * 64) ((LAS unsigned*)(F.lds + LDSCTL_OFF))[u] = 0u;
    __syncthreads();
    XcdBarrier bar; bar.bar = (unsigned*)(F.ctl + CW_BAR); bar.x = 0; bar.st = nullptr;
#if !MK_PER_PHASE
    bar = xcd_barrier_post((unsigned*)(F.ctl + CW_BAR), F.MISC + 8);
#endif
    const int lo = args.ph_lo, hi = args.ph_hi;
#define IN(k) (lo <= (k) && (k) < hi)
#if MK_PER_PHASE
#define SEAM(k) do { } while (0)
#else
#define SEAM(k) do { if (IN(k) && IN((k) + 1)) xcd_barrier(bar); } while (0)
#endif
#if BG_CONVERT && !MK_PER_PHASE && BG_FILL
#define SEAMF(k) do { if (IN(k) && IN((k) + 1)) xcd_barrier_fill(bar, F, args); } while (0)
#else
#define SEAMF(k) SEAM(k)
#endif
    bf16* const A1 = (bf16*)(F.ws + WS_A1); bf16* const MIX = (bf16*)(F.ws + WS_MIX); bf16* const H = (bf16*)(F.ws + WS_H); const float* const MOD = (const float*)(F.ws + WS_MOD);
    PG8_LAS unsigned char* const ring = (PG8_LAS unsigned char*)(F.lds + RING_OFF);

#ifndef DUP_PHASE
#define DUP_PHASE (-1)
#endif
#ifndef PROBE_PHASE
#define PROBE_PHASE (-1)
#endif
constexpr size_t WS_DUMMY = 1600 * MiB;
#define PROBE(k, ...) do { if (PROBE_PHASE == (k) && IN(k)) { for (int r_ = 0; r_ < 3; ++r_) { __VA_ARGS__ xcd_barrier(bar); } } } while (0)
#define PH(k, ...) do { if (IN(k)) { __VA_ARGS__ if (DUP_PHASE == (k)) { for (int r_ = 0; r_ < 3; ++r_) { xcd_barrier(bar); __VA_ARGS__ } } } SEAM(k); } while (0)
#if BG_CONVERT
#define FILL_UNTIL(lim) fill_until(F, args, (lim))
#else
#define FILL_UNTIL(lim) do { } while (0)
#endif
#define PHF(k, ...) do { if (IN(k)) { __VA_ARGS__ if (DUP_PHASE == (k)) { for (int r_ = 0; r_ < 3; ++r_) { xcd_barrier(bar); __VA_ARGS__ } } } SEAMF(k); } while (0)
#define GEMM_STATIC(GE, EPI, Aptr, Bptr, N_, K_, ...) do { if ((int)blockIdx.x < (GE)) { pg8::Gemm g{(const bf16*)(Aptr), (const bf16*)(Bptr), (K_), (K_), (K_), nullptr}; pg8::StaticOrder S; S.init(T, (N_), (GE), (int)blockIdx.x); \
        pg8::EPI E{__VA_ARGS__}; pg8::gemm_phase<pg8::EPI, pg8::StaticOrder, false>(ring, g, S, E, F.wave); } } while (0)
#ifndef MOE_F32B
#define MOE_F32B 0
#endif
#define GEMM_MOE_F(EPI, GATH, Aptr, M0, M1, ESTR, LDN, COLMUL, HOFF, K_, layer, ...) do { const int nrt = __builtin_amdgcn_readfirstlane(*(const int*)(F.ctl + CW_NRT + (layer) * 64)); \
        pg8::Gemm g{(const bf16*)(Aptr), nullptr, (K_), 0, (K_), (const int*)(F.ctl + CW_SLOT + (layer) * MAXSLOT)}; pg8::BSrc bs{(M0), (M1), (size_t)(ESTR), (LDN), (COLMUL), (HOFF)}; \
        pg8::MoeOrder S; S.init((const int*)(F.ctl + CW_TEXP + (layer) * 256), nrt, F.G, (int)blockIdx.x); \
        pg8::EPI E{__VA_ARGS__}; pg8::gemm_phase_f32b<pg8::EPI, pg8::MoeOrder, GATH>(ring, g, bs, S, E, F.wave); } while (0)
#define GEMM_MOE_CHAIN(layer, Bgu, Bdn) do { const int nrt = __builtin_amdgcn_readfirstlane(moe_tables(F, (layer), F.wave * 64 + lane_id_())); \
        const PG8_LAS int* texp_ = (const PG8_LAS int*)(F.lds + LDS_TAB); unsigned* rdy_ = (unsigned*)(F.ctl + CW_RDY + (layer) * 16384); \
        { pg8::Gemm g{(const bf16*)A1, (const bf16*)(Bgu), DM, DM, DM, (const int*)(ws + WS_POS) + (size_t)(layer) * NE * POSCAP}; pg8::MoePublishOrder S; S.init(texp_, texp_ + 256, nrt, POSCAP, F.G, (int)blockIdx.x); S.ready = rdy_; \
          pg8::EpiSwiGLUwt E{(bf16*)(ws + WS_U), DE}; pg8::gemm_phase<pg8::EpiSwiGLUwt, pg8::MoePublishOrder, true>(ring, g, S, E, F.wave); } \
        { pg8::Gemm g{(const bf16*)(ws + WS_U), (const bf16*)(Bdn), DE, DE, DE, nullptr}; pg8::MoeCountedOrder S; S.init(texp_, texp_ + 256, nrt, POSCAP, F.G, (int)blockIdx.x); S.ready = rdy_; S.need = 64u; S.tmo = (unsigned*)F.ctl; S.wv = F.wave; \
          pg8::EpiStoreBf16 E{(bf16*)(ws + WS_YS), DM, 7}; pg8::gemm_phase<pg8::EpiStoreBf16, pg8::MoeCountedOrder, false>(ring, g, S, E, F.wave); } } while (0)
#define GEMM_ORDER(EPI, ORDER, INIT, Aptr, Bptr, K_, ...) do { pg8::Gemm g{(const bf16*)(Aptr), (const bf16*)(Bptr), (K_), (K_), (K_), nullptr}; pg8::ORDER S; S.init INIT; \
        pg8::EPI E{__VA_ARGS__}; pg8::gemm_phase<pg8::EPI, pg8::ORDER, false>(ring, g, S, E, F.wave); } while (0)
#define GEMM_ORDER_G(GE, EPI, ORDER, INIT, Aptr, Bptr, K_, ...) do { const int ge_ = (GE); if ((int)blockIdx.x < ge_) { pg8::Gemm g{(const bf16*)(Aptr), (const bf16*)(Bptr), (K_), (K_), (K_), nullptr}; pg8::ORDER S; S.init INIT; \
        pg8::EPI E{__VA_ARGS__}; pg8::gemm_phase<pg8::EPI, pg8::ORDER, false>(ring, g, S, E, F.wave); } } while (0)
#define GEMM_ROUTER_X(Bptr) do { pg8::Gemm g{(const bf16*)A1, (const bf16*)(Bptr), DM, DM, DM / RKS, nullptr}; pg8::SplitKXOrder S; S.init(RKS, DM / RKS, F.G, (int)blockIdx.x); \
        pg8::EpiLogits E{(float*)(ws + WS_LG), DM / RKS, (size_t)T * 64}; pg8::gemm_phase<pg8::EpiLogits, pg8::SplitKXOrder, false>(ring, g, S, E, F.wave); } while (0)
#define GEMM_ROUTER(Bptr) do { pg8::Gemm g{(const bf16*)A1, (const bf16*)(Bptr), DM, DM, DM / RKS, nullptr}; pg8::SplitKOrder S; S.init(T / 256, RKS, DM / RKS, F.G, (int)blockIdx.x); \
        pg8::EpiLogits E{(float*)(ws + WS_LG), DM / RKS, (size_t)T * 64}; pg8::gemm_phase<pg8::EpiLogits, pg8::SplitKOrder, false>(ring, g, S, E, F.wave); } while (0)
#define GEMM_MOE(XR, EPI, GATH, Aptr, Bptr, K_, layer, ...) do { const int nrt = __builtin_amdgcn_readfirstlane(moe_tables(F, (layer), F.wave * 64 + lane_id_())); \
        const int ge_ = geff(nrt * 8, F.G, (XR)); if ((int)blockIdx.x < ge_) { \
        pg8::Gemm g{(const bf16*)(Aptr), (const bf16*)(Bptr), (K_), (K_), (K_), (const int*)(ws + WS_POS) + (size_t)(layer) * NE * POSCAP}; pg8::MoeOrder S; \
        S.init((const PG8_LAS int*)(F.lds + LDS_TAB), (const PG8_LAS int*)(F.lds + LDS_TAB) + 256, nrt, POSCAP, ge_, (int)blockIdx.x); \
        pg8::EPI E{__VA_ARGS__}; pg8::gemm_phase<pg8::EPI, pg8::MoeOrder, GATH>(ring, g, S, E, F.wave); } } while (0)
    unsigned char* const ws = F.ws;
    PH(0, p0_prologue(F, args););
    PH(1, p_l0_mod1(F, args););
#ifdef NEXTRA_BAR
    for (int i_ = 0; i_ < NEXTRA_BAR; ++i_) xcd_barrier(bar);
#endif
    PHF(2, GEMM_STATIC(geff(72 * (KR_IN_POST1 ? 10 : 11), F.G, XR_GEMM1E), EpiStoreBf16, A1, ws + WS_WE_IN, (KR_IN_POST1 ? 2560 : EVEN_IN_P), DM, (bf16*)(ws + WS_Y1), EVEN_IN_P, 0x7fffffff););
    PROBE(3, p_even_post1(F, args, WS_DUMMY););
    PH(3, p_even_post1(F, args););
    PHF(4, GEMM_ORDER(EpiProj2, Proj2Order, (T, F.G, (int)blockIdx.x), ws + WS_CQN, ws + WS_WE_UQ, 512, (bf16*)(ws + WS_QB), (bf16*)(ws + WS_KV)););
    PH(5, p_even_post2(F, args););
#if USE_NAIVE_ATTN
    PH(6, p_even_attn_naive(F););
#else
    PHF(6, p_even_attn(F, args, (char*)lds););
#endif
    PHF(7, GEMM_STATIC(geff(72 * 8, F.G, XR_GEMM3E), EpiResidInit, MIX, ws + WS_WE_OUT, DM, DM, H, MOD + (size_t)0 * 9 * 12288 + 2 * 2048, args.in[I_X], args.in[I_CTX]););
#if FUSED_ROUTE
    PH(8, p_mod2_route(F, args, 0); FILL_UNTIL(NCHUNK_L0););
#else
    PH(8, p_mod2(F, 0););
    PH(9, GEMM_ROUTER(ws + WS_WR););
    PH(10, p_route(F, args, 0););
#endif
#if MOE_HANDOFF
    PH(12, GEMM_MOE_CHAIN(0, ws + WS_WGU, ws + WS_WDN););
#elif MOE_F32B
    PH(12, GEMM_MOE_F(EpiSwiGLU, true, A1, args.in[I_WG], args.in[I_WU], 2048 * 1024, 1024, 128, 0, DM, 0, (bf16*)(ws + WS_U), DE););
    PH(13, GEMM_MOE_F(EpiStoreBf16, false, ws + WS_U, args.in[I_WD], args.in[I_WD], 1024 * 2048, 2048, 256, 128, DE, 0, (bf16*)(ws + WS_YS), DM, 7););
#else
    PHF(12, GEMM_MOE(XR_MOE_UP0, EpiSwiGLU, true, A1, ws + WS_WGU, DM, 0, (bf16*)(ws + WS_U), DE););
    PHF(13, GEMM_MOE(XR_MOE_DN0, EpiStoreBf16, false, ws + WS_U, ws + WS_WDN, DE, 0, (bf16*)(ws + WS_YS), DM, 7););
#endif
    PROBE(14, p_l1_mod1(F, WS_DUMMY, WS_DUMMY + 160 * MiB););
    PH(14, p_l1_mod1(F););
    PHF(15, GEMM_ORDER_G(geff(64 * 18 + 80, F.G, XR_GEMM1O), EpiStoreBf16, OddInOrder, (ge_, (int)blockIdx.x), A1, ws + WS_WO_IN, DM, (bf16*)(ws + WS_Y1), ODD_IN, 0x7fffffff););
    PROBE(16, p_odd_post1(F, args, WS_DUMMY););
    PH(16, p_odd_post1(F, args););
#if USE_NAIVE_ATTN
    PH(17, p_odd_attn_naive(F, args););
    PH(18, ;);
#else
    PHF(17, p_odd_attn(F, args, (char*)lds););
#if !ATT_DIFF_FUSED
    PH(18, p_odd_combine(F, args););
#endif
#endif
    PHF(19, GEMM_ORDER(EpiResid, XOnlyOrder, (DM, F.G, (int)blockIdx.x), MIX, ws + WS_WO_OUT, DM, H, MOD + (size_t)1 * 9 * 12288 + 2 * 2048););
#if FUSED_ROUTE
    PH(20, p_mod2_route(F, args, 1); FILL_UNTIL(NCHUNK_L1GU););
#else
    PH(20, p_mod2(F, 1););
    PH(21, GEMM_ROUTER_X((const bf16*)(ws + WS_WR) + (size_t)256 * 2048););
    PH(22, p_route(F, args, 1););
#endif
#if MOE_HANDOFF
    PH(24, GEMM_MOE_CHAIN(1, (const bf16*)(ws + WS_WGU) + (size_t)32 * 2048 * 2048, (const bf16*)(ws + WS_WDN) + (size_t)32 * 2048 * 1024););
#elif MOE_F32B
    PH(24, GEMM_MOE_F(EpiSwiGLU, true, A1, args.in[I_WG] + (size_t)32 * 2048 * 1024, args.in[I_WU] + (size_t)32 * 2048 * 1024, 2048 * 1024, 1024, 128, 0, DM, 1, (bf16*)(ws + WS_U), DE););
    PH(25, GEMM_MOE_F(EpiStoreBf16, false, ws + WS_U, args.in[I_WD] + (size_t)32 * 1024 * 2048, args.in[I_WD] + (size_t)32 * 1024 * 2048, 1024 * 2048, 2048, 256, 128, DE, 1, (bf16*)(ws + WS_YS), DM, 7););
#else
    PHF(24, GEMM_MOE(0, EpiSwiGLU, true, A1, (const bf16*)(ws + WS_WGU) + (size_t)32 * 2048 * 2048, DM, 1, (bf16*)(ws + WS_U), DE); FILL_UNTIL(NCHUNK););
    PH(25, GEMM_MOE(0, EpiStoreBf16, false, ws + WS_U, (const bf16*)(ws + WS_WDN) + (size_t)32 * 2048 * 1024, DE, 1, (bf16*)(ws + WS_YS), DM, 7););
#endif
    PH(26, p_final(F, args.out););
#undef IN
#undef SEAM
}

extern "C" void kernel_launch(void* const* d_in, const int* in_sizes, int n_in, void* d_out, int out_size, void* d_ws, size_t ws_size, hipStream_t stream) {
    static int grid = 0;
    if (grid == 0) {
        if (n_in != 35 || out_size != NB * SEQ * DM || ws_size < WS_END) { fprintf(stderr, "kernel_launch: unexpected shapes: n_in %d out %d ws %zu (need %zu)\n", n_in, out_size, ws_size, (size_t)WS_END); grid = -1; return; }
        int dev = 0, cus = 0, per_cu = 0;
        if (hipGetDevice(&dev) != hipSuccess || hipDeviceGetAttribute(&cus, hipDeviceAttributeMultiprocessorCount, dev) != hipSuccess) { grid = -1; return; }
        if (hipFuncSetAttribute((const void*)trunk_fwd, hipFuncAttributeMaxDynamicSharedMemorySize, LDS_BYTES) != hipSuccess) { fprintf(stderr, "kernel_launch: hipFuncSetAttribute failed\n"); grid = -1; return; }
        if (hipOccupancyMaxActiveBlocksPerMultiprocessor(&per_cu, (const void*)trunk_fwd, NWAVES * 64, LDS_BYTES) != hipSuccess || per_cu < 1)
            fprintf(stderr, "kernel_launch: occupancy query reports %d workgroups per CU\n", per_cu);
        (void)hipGetLastError();
        grid = cus;
    }
    if (grid < 0) return;
    if (hipMemsetAsync((char*)d_ws + WS_CTL, 0, CTL_ZERO_BYTES, stream) != hipSuccess) { fprintf(stderr, "kernel_launch: memset failed\n"); return; }
    if (hipMemsetAsync((char*)d_ws + WS_POS, 0, (size_t)2 * NE * POSCAP * 4, stream) != hipSuccess) { fprintf(stderr, "kernel_launch: memset failed\n"); return; }
    Args a{};
    for (int i = 0; i < 35; ++i) a.in[i] = (const float*)d_in[i];
    a.out = (float*)d_out; a.ws = (unsigned char*)d_ws;
#if MK_PER_PHASE
    for (int p = 0; p < NPHASE; ++p) { a.ph_lo = p; a.ph_hi = p + 1; hipLaunchKernelGGL(trunk_fwd, dim3(grid), dim3(NWAVES * 64), LDS_BYTES, stream, a); }
#else
    a.ph_lo = 0; a.ph_hi = NPHASE; hipLaunchKernelGGL(trunk_fwd, dim3(grid), dim3(NWAVES * 64), LDS_BYTES, stream, a);
#endif
    const hipError_t le = hipPeekAtLastError();
    if (le != hipSuccess) fprintf(stderr, "kernel_launch: launch failed: %s\n", hipGetErrorName(le));
}
```

```cpp
#include <hip/hip_runtime.h>
#include <cstdio>
#include <cstdint>
__device__ __forceinline__ int lane_id_() { return (int)__builtin_amdgcn_mbcnt_hi(~0u, __builtin_amdgcn_mbcnt_lo(~0u, 0u)); }
#define MK_PER_PHASE 0
#define TR_NT_STORE 1
namespace pg8 {
#define PG8_LAS __attribute__((address_space(3)))
typedef unsigned short bf16_t;
typedef short bf16x8 __attribute__((ext_vector_type(8)));
typedef float f32x4 __attribute__((ext_vector_type(4)));
typedef unsigned u32x4 __attribute__((ext_vector_type(4)));
constexpr int BM = 256, BK = 64, HALF = 128, HTB = HALF * BK * 2  , STAGE_BYTES = 8 * HTB, NXCD = 8, WGM = 8;

__host__ __device__ __forceinline__ int lds_byte(int r, int c) { const int st = (r >> 4) * 2 + (c >> 5), rr = r & 15, cc = c & 31, ob = rr * 64 + cc * 2; return st * 1024 + (ob ^ (((ob >> 9) & 1) << 5)); }
__host__ __device__ __forceinline__ void stage_rc(int b, int& R, int& C) { const int st = b / 1024, sb = b % 1024, swz = sb ^ (((sb >> 9) & 1) << 5); R = (st >> 1) * 16 + swz / 64; C = (st & 1) * 32 + (swz % 64) / 2; }
__host__ __device__ __forceinline__ int perm32(int rho) { const int n = rho >> 4, i = rho & 15; return 8 * (i >> 2) + 4 * n + (i & 3); }

struct Unit { int pm, pn, ko, kt, gb; };
struct Gemm { const bf16_t* A; const bf16_t* Bt; int lda, ldb, K; const int* rowidx; };

struct StaticOrder {
    int nM, nN, nwg, G, c;
    __host__ __device__ void init(int M, int N, int G_, int c_) { nM = M / BM; nN = N / BM; nwg = nM * nN; G = G_; c = c_; }
    __host__ __device__ bool next(int i, Unit& u) const {
        const long L = (long)i * G + c; if (L >= nwg) return false;
        int wgid = (int)L; { const int q = nwg / NXCD, r = nwg % NXCD, xcd = wgid % NXCD, off = wgid / NXCD; wgid = (xcd < r ? xcd * (q + 1) : r * (q + 1) + (xcd - r) * q) + off; }
        const int nig = WGM * nN, gid = wgid / nig, fm = gid * WGM, gsz = (nM - fm) < WGM ? (nM - fm) : WGM;
        u.pm = fm + ((wgid % nig) % gsz); u.pn = (wgid % nig) / gsz; u.ko = 0; u.kt = 0; u.gb = u.pm * BM; return true;
    }
    __device__ __forceinline__ void a_ready(const Unit&) const {}
    __device__ __forceinline__ void done(const Unit&) const {}
};


__device__ __forceinline__ unsigned cvt_pk_bf16(float lo, float hi) { unsigned r; asm volatile("v_cvt_pk_bf16_f32 %0, %1, %2" : "=v"(r) : "v"(lo), "v"(hi)); return r; }

struct EpiStoreBf16 {
    static constexpr bool PERM = true, AFTER_DRAIN = false;
    bf16_t* O; int ldc; int pn_mask;
    __device__ __forceinline__ void operator()(const f32x4 (&acc)[2][2][4][2], const Unit& u, int wr, int wc, int fr, int fq) const {
        const int row0 = u.pm * BM + wr * 64 + fr, col0 = (u.pn & pn_mask) * BM + wc * 32 + 8 * fq;
#pragma unroll
        for (int ai = 0; ai < 2; ++ai)
#pragma unroll
            for (int m = 0; m < 4; ++m) { bf16_t* rowp = O + (size_t)(row0 + ai * HALF + m * 16) * ldc + col0;
#pragma unroll
                for (int bj = 0; bj < 2; ++bj) { const f32x4 v0 = acc[ai][bj][m][0], v1 = acc[ai][bj][m][1];
                    u32x4 w; w.x = cvt_pk_bf16(v0[0], v0[1]); w.y = cvt_pk_bf16(v0[2], v0[3]); w.z = cvt_pk_bf16(v1[0], v1[1]); w.w = cvt_pk_bf16(v1[2], v1[3]);
                    *(u32x4*)(rowp + bj * HALF) = w; } }
    }
};
__device__ __forceinline__ float silu_f(float x) { return x * __builtin_amdgcn_rcpf(1.0f + __builtin_amdgcn_exp2f(-1.4426950408889634f * x)); }
struct EpiSwiGLU {
    static constexpr bool PERM = true, AFTER_DRAIN = false;
    bf16_t* O; int ldc;
    __device__ __forceinline__ void operator()(const f32x4 (&acc)[2][2][4][2], const Unit& u, int wr, int wc, int fr, int fq) const {
        const int row0 = u.pm * BM + wr * 64 + fr, col0 = (u.pn & 7) * HALF + wc * 32 + 8 * fq;
#pragma unroll
        for (int ai = 0; ai < 2; ++ai)
#pragma unroll
            for (int m = 0; m < 4; ++m) { bf16_t* rowp = O + (size_t)(row0 + ai * HALF + m * 16) * ldc + col0;
                const f32x4 g0 = acc[ai][0][m][0], g1 = acc[ai][0][m][1], u0 = acc[ai][1][m][0], u1 = acc[ai][1][m][1];
                u32x4 w; w.x = cvt_pk_bf16(silu_f(g0[0]) * u0[0], silu_f(g0[1]) * u0[1]); w.y = cvt_pk_bf16(silu_f(g0[2]) * u0[2], silu_f(g0[3]) * u0[3]);
                w.z = cvt_pk_bf16(silu_f(g1[0]) * u1[0], silu_f(g1[1]) * u1[1]); w.w = cvt_pk_bf16(silu_f(g1[2]) * u1[2], silu_f(g1[3]) * u1[3]);
                *(u32x4*)rowp = w; }
    }
};
__device__ __forceinline__ float bf_lo(unsigned w) { return __builtin_bit_cast(float, w << 16); }
__device__ __forceinline__ float bf_hi(unsigned w) { return __builtin_bit_cast(float, w & 0xffff0000u); }
struct EpiResid {
    static constexpr bool PERM = true, AFTER_DRAIN = false;
    bf16_t* H; const float* modg;
    __device__ __forceinline__ void operator()(const f32x4 (&acc)[2][2][4][2], const Unit& u, int wr, int wc, int fr, int fq) const {
        const int row0 = u.pm * BM + wr * 64 + fr, col0 = u.pn * BM + wc * 32 + 8 * fq;
        const int j = (u.pm % 9 == 0) ? 8 : (u.pm / 9);
        const float* g = modg + (size_t)j * 12288 + col0;
        f32x4 gv[2][2];
#pragma unroll
        for (int bj = 0; bj < 2; ++bj)
#pragma unroll
            for (int n = 0; n < 2; ++n) gv[bj][n] = *(const f32x4*)(g + bj * HALF + 4 * n);
#pragma unroll
        for (int ai = 0; ai < 2; ++ai)
#pragma unroll
            for (int m = 0; m < 4; ++m) { bf16_t* rowp = H + (size_t)(row0 + ai * HALF + m * 16) * 2048 + col0;
#pragma unroll
                for (int bj = 0; bj < 2; ++bj) { u32x4* p = (u32x4*)(rowp + bj * HALF); const u32x4 h = *p;
                    const f32x4 a0 = gv[bj][0] * acc[ai][bj][m][0], a1 = gv[bj][1] * acc[ai][bj][m][1];
                    u32x4 w; w.x = cvt_pk_bf16(bf_lo(h.x) + a0[0], bf_hi(h.x) + a0[1]); w.y = cvt_pk_bf16(bf_lo(h.y) + a0[2], bf_hi(h.y) + a0[3]);
                    w.z = cvt_pk_bf16(bf_lo(h.z) + a1[0], bf_hi(h.z) + a1[1]); w.w = cvt_pk_bf16(bf_lo(h.w) + a1[2], bf_hi(h.w) + a1[3]);
                    *p = w; } }
    }
};
struct EpiResidInit {
    static constexpr bool PERM = true, AFTER_DRAIN = false;
    bf16_t* H; const float* modg; const float* xin; const float* ctxin;
    __device__ __forceinline__ void operator()(const f32x4 (&acc)[2][2][4][2], const Unit& u, int wr, int wc, int fr, int fq) const {
        const int rl0 = wr * 64 + fr, col0 = u.pn * BM + wc * 32 + 8 * fq;
        const int b = u.pm / 9, t = u.pm - 9 * b, j = (t == 0) ? 8 : b;
        const float* src = (t == 0) ? ctxin + (size_t)(b * 256) * 2048 : xin + (size_t)(b * 2048 + (t - 1) * 256) * 2048;
        const float* g = modg + (size_t)j * 12288 + col0;
        f32x4 gv[2][2];
#pragma unroll
        for (int bj = 0; bj < 2; ++bj)
#pragma unroll
            for (int n = 0; n < 2; ++n) gv[bj][n] = *(const f32x4*)(g + bj * HALF + 4 * n);
#pragma unroll
        for (int ai = 0; ai < 2; ++ai)
#pragma unroll
            for (int m = 0; m < 4; ++m) { const int rl = rl0 + ai * HALF + m * 16; bf16_t* rowp = H + (size_t)(u.pm * BM + rl) * 2048 + col0; const float* srow = src + (size_t)rl * 2048 + col0;
#pragma unroll
                for (int bj = 0; bj < 2; ++bj) { const f32x4 h0 = *(const f32x4*)(srow + bj * HALF), h1 = *(const f32x4*)(srow + bj * HALF + 4);
                    const f32x4 v0 = h0 + gv[bj][0] * acc[ai][bj][m][0], v1 = h1 + gv[bj][1] * acc[ai][bj][m][1];
                    u32x4 w; w.x = cvt_pk_bf16(v0[0], v0[1]); w.y = cvt_pk_bf16(v0[2], v0[3]); w.z = cvt_pk_bf16(v1[0], v1[1]); w.w = cvt_pk_bf16(v1[2], v1[3]);
                    *(u32x4*)(rowp + bj * HALF) = w; } }
    }
};
struct EpiLogits {
    static constexpr bool PERM = false, AFTER_DRAIN = false;
    float* LG; int kslice; size_t slice_stride;
    __device__ __forceinline__ void operator()(const f32x4 (&acc)[2][2][4][2], const Unit& u, int wr, int wc, int fr, int fq) const {
        if (wc >= 2) return;
        const int row0 = u.pm * BM + wr * 64 + fr, col0 = wc * 32 + 4 * fq;
        float* base = LG + (size_t)(u.ko / kslice) * slice_stride;
#pragma unroll
        for (int ai = 0; ai < 2; ++ai)
#pragma unroll
            for (int m = 0; m < 4; ++m) { float* rowp = base + (size_t)(row0 + ai * HALF + m * 16) * 64 + col0;
#pragma unroll
                for (int n = 0; n < 2; ++n) *(f32x4*)(rowp + n * 16) = acc[ai][0][m][n]; }
    }
};
struct SplitKOrder {
    int nM, KS, kslice, G, c;
    __device__ void init(int nM_, int KS_, int kslice_, int G_, int c_) { nM = nM_; KS = KS_; kslice = kslice_; G = G_; c = c_; }
    __device__ bool next(int i, Unit& u) const { const long L = (long)i * G + c; if (L >= (long)nM * KS) return false; const int ks = (int)L / nM; u.pm = (int)L - ks * nM; u.pn = 0; u.ko = ks * kslice; u.kt = 0; u.gb = 0; return true; }
    __device__ __forceinline__ void a_ready(const Unit&) const {}
    __device__ __forceinline__ void done(const Unit&) const {}
};
struct EvenInOrder {
    StaticOrder so; int G, c;
    __device__ void init(int M, int G_, int c_) { so.init(M, 2560, G_, c_); G = G_; c = c_; }
    __device__ bool next(int i, Unit& u) const {
        if (so.next(i, u)) return true;
        const long L = (long)i * G + c - so.nwg; if (L < 0 || L >= 72 * 4) return false;
        const int ks = (int)L / 72; u.pm = (int)L - ks * 72; u.pn = 10; u.ko = ks * 512; u.kt = 8; u.gb = 0; return true;
    }
    __device__ __forceinline__ void a_ready(const Unit&) const {}
    __device__ __forceinline__ void done(const Unit&) const {}
};
struct EpiEvenIn {
    static constexpr bool PERM = true, AFTER_DRAIN = false;
    bf16_t* Y; float* KRP;
    __device__ __forceinline__ void operator()(const f32x4 (&acc)[2][2][4][2], const Unit& u, int wr, int wc, int fr, int fq) const {
        if (u.pn < 10) { const EpiStoreBf16 e{Y, 2816, 0x7fffffff}; e(acc, u, wr, wc, fr, fq); return; }
        if (wc >= 2) return;
        const int row0 = u.pm * BM + wr * 64 + fr, col0 = wc * 32 + 8 * fq;
        float* base = KRP + (size_t)(u.ko >> 9) * ((size_t)18432 * 64);
#pragma unroll
        for (int ai = 0; ai < 2; ++ai)
#pragma unroll
            for (int m = 0; m < 4; ++m) { float* rowp = base + (size_t)(row0 + ai * HALF + m * 16) * 64 + col0;
#pragma unroll
                for (int n = 0; n < 2; ++n) *(f32x4*)(rowp + 4 * n) = acc[ai][0][m][n]; }
    }
};
struct Proj2Order {
    StaticOrder s1, s2; int G, c;
    __device__ void init(int M, int G_, int c_) { s1.init(M, 1536, G_, c_); s2.init(M, 2048, G_, c_); G = G_; c = c_; }
    __device__ bool next(int i, Unit& u) const {
        if (s1.next(i, u)) return true;
        StaticOrder t = s2; const long L = (long)i * G + c - s1.nwg; if (L < 0 || L >= s2.nwg) return false;
        t.G = 1; t.c = (int)L; if (!t.next(0, u)) return false;
        u.pm += 72; u.pn += 8; return true;
    }
    __device__ __forceinline__ void a_ready(const Unit&) const {}
    __device__ __forceinline__ void done(const Unit&) const {}
};
struct EpiProj2 {
    static constexpr bool PERM = true, AFTER_DRAIN = false;
    bf16_t* QB; bf16_t* KV;
    __device__ __forceinline__ void operator()(const f32x4 (&acc)[2][2][4][2], const Unit& u, int wr, int wc, int fr, int fq) const {
        if (u.pm < 72) { const EpiStoreBf16 e{QB, 1536, 0x7fffffff}; e(acc, u, wr, wc, fr, fq); }
        else { Unit v = u; v.pm -= 72; v.pn -= 8; const EpiStoreBf16 e{KV, 2048, 0x7fffffff}; e(acc, v, wr, wc, fr, fq); }
    }
};
struct XOnlyOrder {
    StaticOrder so;
    __device__ void init(int N, int G_, int c_) { so.init(64 * BM, N, G_, c_); }
    __device__ bool next(int i, Unit& u) const { if (!so.next(i, u)) return false; u.pm = 9 * (u.pm >> 3) + 1 + (u.pm & 7); return true; }
    __device__ __forceinline__ void a_ready(const Unit&) const {}
    __device__ __forceinline__ void done(const Unit&) const {}
};
struct OddInOrder {
    StaticOrder so; int G, c;
    __device__ void init(int G_, int c_) { so.init(64 * BM, 18 * BM, G_, c_); G = G_; c = c_; }
    __device__ bool next(int i, Unit& u) const {
        if (so.next(i, u)) { u.pm = 9 * (u.pm >> 3) + 1 + (u.pm & 7); return true; }
        const long L = (long)i * G + c - 64 * 18; if (L >= 80) return false;
        const int b = (int)L / 10, j = (int)L - b * 10; u.pm = 9 * b; u.pn = j < 8 ? 4 + j : 8 + j; u.ko = 0; u.kt = 0; u.gb = 0; return true;
    }
    __device__ __forceinline__ void a_ready(const Unit&) const {}
    __device__ __forceinline__ void done(const Unit&) const {}
};
struct SplitKXOrder {
    int KS, kslice, G, c;
    __device__ void init(int KS_, int kslice_, int G_, int c_) { KS = KS_; kslice = kslice_; G = G_; c = c_; }
    __device__ bool next(int i, Unit& u) const { const long L = (long)i * G + c; if (L >= 64L * KS) return false; const int ks = (int)L / 64, x = (int)L - ks * 64; u.pm = 9 * (x >> 3) + 1 + (x & 7); u.pn = 0; u.ko = ks * kslice; u.kt = 0; u.gb = 0; return true; }
    __device__ __forceinline__ void a_ready(const Unit&) const {}
    __device__ __forceinline__ void done(const Unit&) const {}
};
struct MoeOrder {
    const PG8_LAS int* texp; const PG8_LAS int* frt; int nunits, G, c, cap;
    __device__ void init(const PG8_LAS int* texp_, const PG8_LAS int* frt_, int n_row_tiles, int cap_, int G_, int c_) { texp = texp_; frt = frt_; nunits = n_row_tiles * 8; cap = cap_; G = G_; c = c_; }
    __device__ bool next(int i, Unit& u) const {
        const long L = (long)i * G + c; if (L >= nunits) return false;
        int wgid = (int)L; { const int q = nunits / NXCD, r = nunits % NXCD, xcd = wgid % NXCD, off = wgid / NXCD; wgid = (xcd < r ? xcd * (q + 1) : r * (q + 1) + (xcd - r) * q) + off; }
        const int rt = wgid >> 3, pn = wgid & 7, e = __builtin_amdgcn_readfirstlane(texp[rt]);
        u.pm = rt; u.pn = e * 8 + pn; u.ko = 0; u.kt = 0; u.gb = e * cap + (rt - __builtin_amdgcn_readfirstlane(frt[e])) * BM; return true;
    }
    __device__ __forceinline__ void a_ready(const Unit&) const {}
    __device__ __forceinline__ void done(const Unit&) const {}
};

struct MoePublishOrder : MoeOrder {
    unsigned* ready;
    __device__ __forceinline__ void done(const Unit& u) const {
        asm volatile("s_waitcnt vmcnt(0)" ::: "memory");
        if (lane_id_() == 0) __hip_atomic_fetch_add(ready + 64 * u.pm, 1u, __ATOMIC_RELAXED, __HIP_MEMORY_SCOPE_AGENT);
    }
};
struct MoeCountedOrder : MoeOrder {
    unsigned* ready; unsigned need; unsigned* tmo; int wv;
    __device__ bool next(int i, Unit& u) const {
        const int k0 = (nunits - c + G - 1) / G;
        const long l = (long)c + (long)(k0 + i) * G - nunits; if (l >= nunits) return false;
        int wgid = (int)l; { const int q = nunits / NXCD, r = nunits % NXCD, xcd = wgid % NXCD, off = wgid / NXCD; wgid = (xcd < r ? xcd * (q + 1) : r * (q + 1) + (xcd - r) * q) + off; }
        const int rt = wgid >> 3, pn = wgid & 7, e = __builtin_amdgcn_readfirstlane(texp[rt]);
        u.pm = rt; u.pn = e * 8 + pn; u.ko = 0; u.kt = 0; u.gb = 0; return true;
    }
    __device__ __forceinline__ void a_ready(const Unit& u) const {
        if (wv == 0) {
            const unsigned long long t0 = __builtin_amdgcn_s_memrealtime(); unsigned polls = 0;
            while ((unsigned)__builtin_amdgcn_readfirstlane(__hip_atomic_load(ready + 64 * u.pm, __ATOMIC_RELAXED, __HIP_MEMORY_SCOPE_AGENT)) < need) {
                if ((++polls & 255u) == 0u && __builtin_amdgcn_readfirstlane(__hip_atomic_load(tmo, __ATOMIC_RELAXED, __HIP_MEMORY_SCOPE_AGENT)) != 0u) break;
                if (__builtin_amdgcn_s_memrealtime() - t0 > 2000000ull) {
                    if (lane_id_() == 0) __hip_atomic_store(tmo, 1u, __ATOMIC_RELAXED, __HIP_MEMORY_SCOPE_AGENT);
                    break; }
                __builtin_amdgcn_s_sleep(2); }
            __builtin_amdgcn_fence(__ATOMIC_ACQUIRE, "agent");
            asm volatile("s_waitcnt vmcnt(0)" ::: "memory");
        }
        asm volatile("" ::: "memory"); __builtin_amdgcn_s_barrier(); asm volatile("" ::: "memory");
    }
};
struct EpiSwiGLUwt {
    static constexpr bool PERM = true, AFTER_DRAIN = false;
    bf16_t* O; int ldc;
    __device__ __forceinline__ void operator()(const f32x4 (&acc)[2][2][4][2], const Unit& u, int wr, int wc, int fr, int fq) const {
        const int row0 = u.pm * BM + wr * 64 + fr, col0 = (u.pn & 7) * HALF + wc * 32 + 8 * fq;
        const __amdgpu_buffer_rsrc_t rsrc = __builtin_amdgcn_make_buffer_rsrc((void*)O, 0, 0x7fffffff, 0x00020000);
#pragma unroll
        for (int ai = 0; ai < 2; ++ai)
#pragma unroll
            for (int m = 0; m < 4; ++m) { const unsigned off = (unsigned)(((size_t)(row0 + ai * HALF + m * 16) * ldc + col0) * 2);
                const f32x4 g0 = acc[ai][0][m][0], g1 = acc[ai][0][m][1], u0 = acc[ai][1][m][0], u1 = acc[ai][1][m][1];
                u32x4 w; w.x = cvt_pk_bf16(silu_f(g0[0]) * u0[0], silu_f(g0[1]) * u0[1]); w.y = cvt_pk_bf16(silu_f(g0[2]) * u0[2], silu_f(g0[3]) * u0[3]);
                w.z = cvt_pk_bf16(silu_f(g1[0]) * u1[0], silu_f(g1[1]) * u1[1]); w.w = cvt_pk_bf16(silu_f(g1[2]) * u1[2], silu_f(g1[3]) * u1[3]);
                __builtin_amdgcn_raw_buffer_store_b128(w, rsrc, (int)off, 0, 16  ); }
    }
};
}
namespace pg8 {
template <class Epi, class Sched, bool GATHER = false>
__device__ __forceinline__ void gemm_phase(PG8_LAS unsigned char* lds, const Gemm g, const Sched& S, const Epi& E, int wv) {
    int tid = wv * 64 + lane_id_(); asm volatile("" : "+v"(tid));
    const int wid = __builtin_amdgcn_readfirstlane(tid >> 6), lane = tid & 63, wr = wid >> 2, wc = wid & 3, fr = lane & 15, fq = lane >> 4;
    const int K = g.K, lda = g.lda, ldb = g.ldb;
    unsigned va[2][2], vn[2][2], voffB[2]; int sR[2], sC[2];
#pragma unroll
    for (int i = 0; i < 2; ++i) { int R, C; stage_rc(tid * 16 + i * 8192, R, C); const int Rb = Epi::PERM ? ((R & ~31) + perm32(R & 31)) : R; sR[i] = R; sC[i] = C;
        voffB[i] = (unsigned)(Rb * ldb + C) * 2u;
        va[0][i] = (unsigned)(R * lda + C) * 2u; va[1][i] = (unsigned)((R + HALF) * lda + C) * 2u; vn[0][i] = va[0][i]; vn[1][i] = va[1][i]; }
    const size_t kstep = (size_t)(BK * 2);
    const size_t hstepB = (size_t)HALF * ldb * 2;
    const size_t tstepA = (size_t)BM * lda * 2, tstepB = (size_t)BM * ldb * 2;
    const unsigned ldsw = (unsigned)wid * 1024u;
    const int aoff = lds_byte(wr * 64 + fr, fq * 8), boff = lds_byte(wc * 32 + fr, fq * 8);
#define PG8_SA(b, h) (((b) * 2 + (h)) * HTB)
#define PG8_SB(b, h) ((4 + (b) * 2 + (h)) * HTB)
#define PG8_STAGE(bufoff, gbase, voff) do { _Pragma("unroll") for (int _i = 0; _i < 2; ++_i) \
        __builtin_amdgcn_global_load_lds((const unsigned*)((const char*)(gbase) + (voff)[_i]), (PG8_LAS unsigned*)(lds + (bufoff) + ldsw + _i * 8192), 16, 0, 0); } while (0)
#define PG8_LDA(dst, b, h) do { _Pragma("unroll") for (int m = 0; m < 4; ++m) _Pragma("unroll") for (int k = 0; k < 2; ++k) dst[m][k] = *(const PG8_LAS bf16x8*)(lds + PG8_SA(b, h) + aoff + m * 2048 + k * 1024); } while (0)
#define PG8_LDB(dst, b, h) do { _Pragma("unroll") for (int n = 0; n < 2; ++n) _Pragma("unroll") for (int k = 0; k < 2; ++k) dst[n][k] = *(const PG8_LAS bf16x8*)(lds + PG8_SB(b, h) + boff + n * 2048 + k * 1024); } while (0)
#define PG8_MMA(ai, bj, At, Bt) do { __builtin_amdgcn_s_setprio(1); _Pragma("unroll") for (int m = 0; m < 4; ++m) _Pragma("unroll") for (int n = 0; n < 2; ++n) _Pragma("unroll") for (int k = 0; k < 2; ++k) \
        acc[ai][bj][m][n] = __builtin_amdgcn_mfma_f32_16x16x32_bf16(Bt[n][k], At[m][k], acc[ai][bj][m][n], 0, 0, 0); __builtin_amdgcn_s_setprio(0); } while (0)
#define PG8_WAIT_V(n) asm volatile("s_waitcnt vmcnt(" #n ")" ::: "memory")
#define PG8_WAIT_L(n) asm volatile("s_waitcnt lgkmcnt(" #n ")" ::: "memory")
#define PG8_BAR __builtin_amdgcn_s_barrier()
#define PG8_SCHED __builtin_amdgcn_sched_barrier(0)
#define PG8_GATHER_OFFS(dst, u) do { if constexpr (GATHER) { _Pragma("unroll") for (int _h = 0; _h < 2; ++_h) _Pragma("unroll") for (int _i = 0; _i < 2; ++_i) \
        dst[_h][_i] = (unsigned)(g.rowidx[(u).gb + _h * HALF + sR[_i]] * lda + sC[_i]) * 2u; } } while (0)
    Unit cur, nxt; int ui = 0;
    if (!S.next(0, cur)) return;
    f32x4 acc[2][2][4][2];
#pragma unroll
    for (int a = 0; a < 2; ++a)
#pragma unroll
        for (int b = 0; b < 2; ++b)
#pragma unroll
            for (int m = 0; m < 4; ++m)
#pragma unroll
                for (int n = 0; n < 2; ++n) acc[a][b][m][n] = (f32x4){0.f, 0.f, 0.f, 0.f};
    bf16x8 At[4][2], B0[2][2], B1[2][2];
    const char* cA = (const char*)g.A + (GATHER ? (size_t)0 : (size_t)cur.pm * tstepA) + (size_t)cur.ko * 2; const char* cB = (const char*)g.Bt + (size_t)cur.pn * tstepB + (size_t)cur.ko * 2;
    PG8_GATHER_OFFS(va, cur);
    S.a_ready(cur);
    PG8_STAGE(PG8_SB(0, 0), cB, voffB); PG8_STAGE(PG8_SB(0, 1), cB + hstepB, voffB); PG8_STAGE(PG8_SA(0, 0), cA, va[0]); PG8_STAGE(PG8_SA(0, 1), cA, va[1]);
    if (wr == 1) PG8_BAR;
    PG8_WAIT_V(2); PG8_BAR;
    PG8_STAGE(PG8_SB(1, 0), cB + kstep, voffB); PG8_STAGE(PG8_SA(1, 0), cA + kstep, va[0]); PG8_STAGE(PG8_SB(1, 1), cB + hstepB + kstep, voffB);
    PG8_WAIT_V(6); PG8_BAR;
    for (;;) {
        const bool has_next = S.next(ui + 1, nxt);
        const char* nA = has_next ? (const char*)g.A + (GATHER ? (size_t)0 : (size_t)nxt.pm * tstepA) + (size_t)nxt.ko * 2 : cA; const char* nB = has_next ? (const char*)g.Bt + (size_t)nxt.pn * tstepB + (size_t)nxt.ko * 2 : cB;
        if constexpr (GATHER) { if (has_next) PG8_GATHER_OFFS(vn, nxt); else { _Pragma("unroll") for (int _h = 0; _h < 2; ++_h) _Pragma("unroll") for (int _i = 0; _i < 2; ++_i) vn[_h][_i] = va[_h][_i]; } }
        const int nt = K / BK;
        for (int t = 0; t < nt; t += 2) {
            const bool last = (t == nt - 2);
            const char* a1 = cA + (size_t)(t + 1) * kstep;
            const char* a2 = last ? nA : cA + (size_t)(t + 2) * kstep; const char* b2 = last ? nB : cB + (size_t)(t + 2) * kstep;
            const char* a3 = a2 + kstep; const char* b3 = b2 + kstep;
            unsigned v2[2][2];
#pragma unroll
            for (int _h = 0; _h < 2; ++_h)
#pragma unroll
                for (int _i = 0; _i < 2; ++_i) v2[_h][_i] = (GATHER && last) ? vn[_h][_i] : va[_h][_i];
            if (last && has_next) S.a_ready(nxt);
            PG8_LDB(B0, 0, 0); PG8_LDB(B1, 0, 1); PG8_SCHED; PG8_LDA(At, 0, 0); PG8_STAGE(PG8_SA(1, 1), a1, va[1]);
            PG8_WAIT_V(8); PG8_WAIT_L(0); PG8_BAR; PG8_MMA(0, 0, At, B0); PG8_MMA(0, 1, At, B1); PG8_BAR; PG8_SCHED;
            PG8_LDA(At, 0, 1); PG8_STAGE(PG8_SB(0, 0), b2, voffB); PG8_STAGE(PG8_SB(0, 1), b2 + hstepB, voffB); PG8_STAGE(PG8_SA(0, 0), a2, v2[0]);
            PG8_WAIT_V(8); PG8_WAIT_L(0); PG8_BAR; PG8_MMA(1, 0, At, B0); PG8_MMA(1, 1, At, B1); PG8_BAR; PG8_SCHED;
            PG8_LDB(B0, 1, 0); PG8_LDB(B1, 1, 1); PG8_SCHED; PG8_LDA(At, 1, 0); PG8_STAGE(PG8_SA(0, 1), a2, v2[1]);
            PG8_WAIT_V(8); PG8_WAIT_L(0); PG8_BAR; PG8_MMA(0, 0, At, B0); PG8_MMA(0, 1, At, B1); PG8_BAR; PG8_SCHED;
            PG8_LDA(At, 1, 1); PG8_STAGE(PG8_SB(1, 0), b3, voffB); PG8_STAGE(PG8_SB(1, 1), b3 + hstepB, voffB); PG8_STAGE(PG8_SA(1, 0), a3, v2[0]);
            PG8_WAIT_V(8); PG8_WAIT_L(0); PG8_BAR; PG8_MMA(1, 0, At, B0); PG8_MMA(1, 1, At, B1); PG8_BAR; PG8_SCHED;
        }
        if (wr == 0) PG8_BAR;
        E(acc, cur, wr, wc, fr, fq); S.done(cur);
        if (!has_next) break;
#pragma unroll
        for (int a = 0; a < 2; ++a)
#pragma unroll
            for (int b = 0; b < 2; ++b)
#pragma unroll
                for (int m = 0; m < 4; ++m)
#pragma unroll
                    for (int n = 0; n < 2; ++n) acc[a][b][m][n] = (f32x4){0.f, 0.f, 0.f, 0.f};
        cur = nxt; cA = nA; cB = nB; ++ui;
        if constexpr (GATHER) { _Pragma("unroll") for (int _h = 0; _h < 2; ++_h) _Pragma("unroll") for (int _i = 0; _i < 2; ++_i) va[_h][_i] = vn[_h][_i]; }
        if (wr == 1) PG8_BAR;
    }
    PG8_WAIT_V(0);
    PG8_BAR;
#undef PG8_SA
#undef PG8_SB
#undef PG8_STAGE
#undef PG8_LDA
#undef PG8_LDB
#undef PG8_MMA
#undef PG8_WAIT_V
#undef PG8_WAIT_L
#undef PG8_BAR
#undef PG8_SCHED
#undef PG8_GATHER_OFFS
}
typedef unsigned u32x2 __attribute__((ext_vector_type(2)));
struct BSrc { const float* m0; const float* m1; size_t estride; int ldn, colmul, hoff; };
template <class Epi, class Sched, bool GATHER = false>
__device__ __forceinline__ void gemm_phase_f32b(PG8_LAS unsigned char* lds, const Gemm g, const BSrc bs, const Sched& S, const Epi& E, int wv) {
    int tid = wv * 64 + lane_id_(); asm volatile("" : "+v"(tid));
    const int wid = __builtin_amdgcn_readfirstlane(tid >> 6), lane = tid & 63, wr = wid >> 2, wc = wid & 3, fr = lane & 15, fq = lane >> 4;
    const int K = g.K, lda = g.lda;
    unsigned va00, va01, va10, va11, vn00, vn01, vn10, vn11;
#pragma unroll
    for (int i = 0; i < 2; ++i) { int R, C; stage_rc(tid * 16 + i * 8192, R, C);
        const unsigned o0_ = (unsigned)(R * lda + C) * 2u, o1_ = (unsigned)((R + HALF) * lda + C) * 2u; if (i == 0) { va00 = o0_; va10 = o1_; } else { va01 = o0_; va11 = o1_; } }
    vn00 = va00; vn01 = va01; vn10 = va10; vn11 = va11;
    const size_t kstep = (size_t)(BK * 2);
    const size_t tstepA = (size_t)BM * lda * 2;
    const int kq = lane & 15, nq = (lane >> 4) + 4 * wid;
    const int brow = (nq >> 3) * 32 + (Epi::PERM ? (16 * (nq & 1) + 4 * ((nq & 7) >> 1)) : (4 * (nq & 7)));
    const int bwr = lds_byte(brow, 4 * kq);
    const unsigned bvo = (unsigned)((4 * kq) * bs.ldn + 4 * nq) * 4u;
    const size_t bkstep = (size_t)BK * bs.ldn * 4, brstep = (size_t)bs.ldn * 4;
    f32x4 w0, w1, w2, w3;
    const unsigned ldsw = (unsigned)wid * 1024u;
    const int aoff = lds_byte(wr * 64 + fr, fq * 8), boff = lds_byte(wc * 32 + fr, fq * 8);
#define PG8_SA(b, h) (((b) * 2 + (h)) * HTB)
#define PG8_SB(b, h) ((4 + (b) * 2 + (h)) * HTB)
#define PG8_BLOAD(src) do { const char* p0_ = (const char*)(src); const char* p1_ = p0_ + brstep; const char* p2_ = p1_ + brstep; const char* p3_ = p2_ + brstep; \
        asm volatile("s_nop 4\n\tglobal_load_dwordx4 %0, %4, %5\n\tglobal_load_dwordx4 %1, %4, %6\n\tglobal_load_dwordx4 %2, %4, %7\n\tglobal_load_dwordx4 %3, %4, %8" \
                     : "=&v"(w0), "=&v"(w1), "=&v"(w2), "=&v"(w3) : "v"(bvo), "s"(p0_), "s"(p1_), "s"(p2_), "s"(p3_)); } while (0)
#define PG8_BWAIT(n) asm volatile("s_waitcnt vmcnt(" #n ")" : "+v"(w0), "+v"(w1), "+v"(w2), "+v"(w3))
#define PG8_BWRITE(bufoff) do { PG8_LAS unsigned char* d_ = lds + (bufoff) + bwr; \
        { u32x2 c_; c_.x = cvt_pk_bf16(w0[0], w1[0]); c_.y = cvt_pk_bf16(w2[0], w3[0]); *(PG8_LAS u32x2*)(d_) = c_; } \
        { u32x2 c_; c_.x = cvt_pk_bf16(w0[1], w1[1]); c_.y = cvt_pk_bf16(w2[1], w3[1]); *(PG8_LAS u32x2*)(d_ + 64) = c_; } \
        { u32x2 c_; c_.x = cvt_pk_bf16(w0[2], w1[2]); c_.y = cvt_pk_bf16(w2[2], w3[2]); *(PG8_LAS u32x2*)(d_ + 128) = c_; } \
        { u32x2 c_; c_.x = cvt_pk_bf16(w0[3], w1[3]); c_.y = cvt_pk_bf16(w2[3], w3[3]); *(PG8_LAS u32x2*)(d_ + 192) = c_; } } while (0)
#define PG8_BSRC(u, h) ((const char*)(((h) ? bs.m1 : bs.m0) + (size_t)((u).pn >> 3) * bs.estride + (size_t)((u).pn & 7) * bs.colmul + (h) * bs.hoff) + (size_t)(u).ko * brstep)
#define PG8_STAGE(bufoff, gbase, o0, o1) do { \
        __builtin_amdgcn_global_load_lds((const unsigned*)((const char*)(gbase) + (o0)), (PG8_LAS unsigned*)(lds + (bufoff) + ldsw), 16, 0, 0); \
        __builtin_amdgcn_global_load_lds((const unsigned*)((const char*)(gbase) + (o1)), (PG8_LAS unsigned*)(lds + (bufoff) + ldsw + 8192), 16, 0, 0); } while (0)
#define PG8_LDA(dst, b, h) do { _Pragma("unroll") for (int m = 0; m < 4; ++m) _Pragma("unroll") for (int k = 0; k < 2; ++k) dst[m][k] = *(const PG8_LAS bf16x8*)(lds + PG8_SA(b, h) + aoff + m * 2048 + k * 1024); } while (0)
#define PG8_LDB(dst, b, h) do { _Pragma("unroll") for (int n = 0; n < 2; ++n) _Pragma("unroll") for (int k = 0; k < 2; ++k) dst[n][k] = *(const PG8_LAS bf16x8*)(lds + PG8_SB(b, h) + boff + n * 2048 + k * 1024); } while (0)
#define PG8_MMA(ai, bj, At, Bt) do { __builtin_amdgcn_s_setprio(1); _Pragma("unroll") for (int m = 0; m < 4; ++m) _Pragma("unroll") for (int n = 0; n < 2; ++n) _Pragma("unroll") for (int k = 0; k < 2; ++k) \
        acc[ai][bj][m][n] = __builtin_amdgcn_mfma_f32_16x16x32_bf16(Bt[n][k], At[m][k], acc[ai][bj][m][n], 0, 0, 0); __builtin_amdgcn_s_setprio(0); } while (0)
#define PG8_WAIT_V(n) asm volatile("s_waitcnt vmcnt(" #n ")" ::: "memory")
#define PG8_WAIT_L(n) asm volatile("s_waitcnt lgkmcnt(" #n ")" ::: "memory")
#define PG8_BAR __builtin_amdgcn_s_barrier()
#define PG8_SCHED __builtin_amdgcn_sched_barrier(0)
#define PG8_GATHER_OFFS(d00, d01, d10, d11, u) do { if constexpr (GATHER) { const int* ri_ = g.rowidx + (u).gb; int t_ = wv * 64 + lane_id_(); asm volatile("" : "+v"(t_)); \
        int R0_, C0_, R1_, C1_; stage_rc(t_ * 16, R0_, C0_); stage_rc(t_ * 16 + 8192, R1_, C1_);     \
        d00 = (unsigned)(ri_[R0_] * lda + C0_) * 2u; d01 = (unsigned)(ri_[R1_] * lda + C1_) * 2u; \
        d10 = (unsigned)(ri_[HALF + R0_] * lda + C0_) * 2u; d11 = (unsigned)(ri_[HALF + R1_] * lda + C1_) * 2u; } } while (0)
    Unit cur, nxt; int ui = 0;
    if (!S.next(0, cur)) return;
    f32x4 acc[2][2][4][2];
#pragma unroll
    for (int a = 0; a < 2; ++a)
#pragma unroll
        for (int b = 0; b < 2; ++b)
#pragma unroll
            for (int m = 0; m < 4; ++m)
#pragma unroll
                for (int n = 0; n < 2; ++n) acc[a][b][m][n] = (f32x4){0.f, 0.f, 0.f, 0.f};
    bf16x8 At[4][2], B0[2][2], B1[2][2];
    const char* cA = (const char*)g.A + (GATHER ? (size_t)0 : (size_t)cur.pm * tstepA) + (size_t)cur.ko * 2; const char* cB0 = PG8_BSRC(cur, 0); const char* cB1 = PG8_BSRC(cur, 1);
    PG8_GATHER_OFFS(va00, va01, va10, va11, cur);
    S.a_ready(cur);
    PG8_STAGE(PG8_SA(0, 0), cA, va00, va01); PG8_STAGE(PG8_SA(0, 1), cA, va10, va11);
    PG8_BLOAD(cB0); PG8_BWAIT(0); PG8_BWRITE(PG8_SB(0, 0));
    PG8_BLOAD(cB1); PG8_BWAIT(0); PG8_BWRITE(PG8_SB(0, 1));
    PG8_BLOAD(cB0 + bkstep); PG8_BWAIT(0); PG8_BWRITE(PG8_SB(1, 0));
    PG8_BLOAD(cB1 + bkstep); PG8_STAGE(PG8_SA(1, 0), cA + kstep, va00, va01);
    PG8_WAIT_L(0);
    if (wr == 1) PG8_BAR;
    PG8_BAR;
    PG8_BAR;
    for (;;) {
        const bool has_next = S.next(ui + 1, nxt);
        const char* nA = has_next ? (const char*)g.A + (GATHER ? (size_t)0 : (size_t)nxt.pm * tstepA) + (size_t)nxt.ko * 2 : cA; const char* nB0 = has_next ? PG8_BSRC(nxt, 0) : cB0; const char* nB1 = has_next ? PG8_BSRC(nxt, 1) : cB1;
        const int nt = K / BK;
        for (int t = 0; t < nt; t += 2) {
            const bool last = (t == nt - 2);
            const char* a1 = cA + (size_t)(t + 1) * kstep;
            const char* a2 = last ? nA : cA + (size_t)(t + 2) * kstep;
            const char* b20 = last ? nB0 : cB0 + (size_t)(t + 2) * bkstep; const char* b21 = last ? nB1 : cB1 + (size_t)(t + 2) * bkstep;
            const char* a3 = a2 + kstep; const char* b30 = b20 + bkstep; const char* b31 = b21 + bkstep;
            if constexpr (GATHER) { if (last) { if (has_next) PG8_GATHER_OFFS(vn00, vn01, vn10, vn11, nxt); else { vn00 = va00; vn01 = va01; vn10 = va10; vn11 = va11; } } }
            const bool usen_ = GATHER && last;
            const unsigned v200 = usen_ ? vn00 : va00, v201 = usen_ ? vn01 : va01, v210 = usen_ ? vn10 : va10, v211 = usen_ ? vn11 : va11;
            if (last && has_next) S.a_ready(nxt);
            PG8_LDB(B0, 0, 0); PG8_LDB(B1, 0, 1); PG8_SCHED; PG8_LDA(At, 0, 0);
            PG8_BWAIT(2); PG8_BWRITE(PG8_SB(1, 1)); PG8_BLOAD(b20); PG8_STAGE(PG8_SA(1, 1), a1, va10, va11);
            PG8_WAIT_L(0); PG8_BAR; PG8_MMA(0, 0, At, B0); PG8_MMA(0, 1, At, B1); PG8_BAR; PG8_SCHED;
            PG8_LDA(At, 0, 1);
            PG8_BWAIT(2); PG8_BWRITE(PG8_SB(0, 0)); PG8_BLOAD(b21); PG8_STAGE(PG8_SA(0, 0), a2, v200, v201);
            PG8_WAIT_L(0); PG8_BAR; PG8_MMA(1, 0, At, B0); PG8_MMA(1, 1, At, B1); PG8_BAR; PG8_SCHED;
            PG8_LDB(B0, 1, 0); PG8_LDB(B1, 1, 1); PG8_SCHED; PG8_LDA(At, 1, 0);
            PG8_BWAIT(2); PG8_BWRITE(PG8_SB(0, 1)); PG8_BLOAD(b30); PG8_STAGE(PG8_SA(0, 1), a2, v210, v211);
            PG8_WAIT_L(0); PG8_BAR; PG8_MMA(0, 0, At, B0); PG8_MMA(0, 1, At, B1); PG8_BAR; PG8_SCHED;
            PG8_LDA(At, 1, 1);
            PG8_BWAIT(2); PG8_BWRITE(PG8_SB(1, 0)); PG8_BLOAD(b31); PG8_STAGE(PG8_SA(1, 0), a3, v200, v201);
            PG8_WAIT_L(0); PG8_BAR; PG8_MMA(1, 0, At, B0); PG8_MMA(1, 1, At, B1); PG8_BAR; PG8_SCHED;
        }
        if (wr == 0) PG8_BAR;
        E(acc, cur, wr, wc, fr, fq); S.done(cur);
        if (!has_next) break;
#pragma unroll
        for (int a = 0; a < 2; ++a)
#pragma unroll
            for (int b = 0; b < 2; ++b)
#pragma unroll
                for (int m = 0; m < 4; ++m)
#pragma unroll
                    for (int n = 0; n < 2; ++n) acc[a][b][m][n] = (f32x4){0.f, 0.f, 0.f, 0.f};
        cur = nxt; cA = nA; cB0 = nB0; cB1 = nB1; ++ui;
        if constexpr (GATHER) { va00 = vn00; va01 = vn01; va10 = vn10; va11 = vn11; }
        if (wr == 1) PG8_BAR;
    }
    PG8_WAIT_V(0);
    PG8_BAR;
#undef PG8_SA
#undef PG8_SB
#undef PG8_STAGE
#undef PG8_BLOAD
#undef PG8_BWAIT
#undef PG8_BWRITE
#undef PG8_BSRC
#undef PG8_LDA
#undef PG8_LDB
#undef PG8_MMA
#undef PG8_WAIT_V
#undef PG8_WAIT_L
#undef PG8_BAR
#undef PG8_SCHED
#undef PG8_GATHER_OFFS
}
}

#ifndef PG8_SP2
#define PG8_SP2 true
#endif
#ifndef PG8_ALIGN
#define PG8_ALIGN true
#endif
#ifndef MK_PER_PHASE
#define MK_PER_PHASE 0
#endif

constexpr int NWAVES = 8;
constexpr int DM = 2048, NB = 8, SEQ = 2048, CTX = 256, TPB = CTX + SEQ, T = NB * TPB;
constexpr int EVEN_IN_P = 2816, ODD_IN = 4608;
constexpr int NE = 32, DE = 1024, MAXSLOT = 45056;
constexpr float NORM_EPS = 1e-6f;
constexpr float LAMBDA_INIT = 0.35550906759f;
constexpr int NPHASE = 27;
#ifndef MOE_F32B
#define MOE_F32B 0
#endif
#ifndef KR_IN_POST1
#define KR_IN_POST1 1
#endif
#ifndef MOE_HANDOFF
#define MOE_HANDOFF 0
#endif
#ifndef FUSED_ROUTE
#define FUSED_ROUTE 1
#endif
#ifndef ATT_DIFF_FUSED
#define ATT_DIFF_FUSED 1
#endif
#ifndef BG_CONVERT
#define BG_CONVERT 1
#endif
#ifndef BG_FILL
#define BG_FILL 1
#endif
#ifndef BG_GEFF
#define BG_GEFF 1
#endif
#ifndef USE_NAIVE_ATTN
#define USE_NAIVE_ATTN 0
#endif

constexpr size_t MiB = 1u << 20;
constexpr size_t WS_CTL = 0, CTL_ZERO_BYTES = 1 * MiB;
constexpr size_t WS_MOD = 1 * MiB;
constexpr size_t WS_ROPE = 2 * MiB;
constexpr size_t WS_ROUTE = 3 * MiB;
constexpr size_t WS_WE_IN = 4 * MiB;
constexpr size_t WS_WE_UQ = 15 * MiB;
constexpr size_t WS_WE_UKV = 17 * MiB;
constexpr size_t WS_WE_OUT = 19 * MiB;
constexpr size_t WS_WO_IN = 27 * MiB;
constexpr size_t WS_WO_OUT = 45 * MiB;
constexpr size_t WS_WR = 53 * MiB;
constexpr size_t WS_WGU = 60 * MiB;
constexpr size_t WS_WDN = 572 * MiB;
constexpr size_t WS_H = 828 * MiB;
constexpr size_t WS_A1 = 972 * MiB;
constexpr size_t WS_MIX = 1044 * MiB;
constexpr size_t WS_R = 1116 * MiB;
constexpr size_t WS_Y1 = WS_R;
constexpr size_t WS_CQN = WS_R + 162 * MiB;
constexpr size_t WS_CKVN = WS_R + 180 * MiB;
constexpr size_t WS_QB = WS_R + 198 * MiB;
constexpr size_t WS_KV = WS_R + 252 * MiB;
constexpr size_t WS_KB = WS_R + 324 * MiB;
constexpr size_t WS_XS = WS_R;
constexpr size_t WS_U = WS_R + 176 * MiB;
constexpr size_t WS_YS = WS_R + 264 * MiB;
constexpr size_t WS_LG = WS_R + 440 * MiB;
constexpr size_t WS_POS = WS_R + 460 * MiB;
constexpr int POSCAP = 18432;
constexpr size_t WS_END = WS_R + 466 * MiB;
constexpr int RKS = 4;
constexpr int CW_CNT = 64;
constexpr int CW_NRT = 256;
constexpr int CW_TEXP = 512;
constexpr int CW_BAR = 4096;
constexpr int CW_RDY = 32768;
constexpr int CW_ITEM = 8192;
constexpr int CW_SLOT = 16384;

constexpr int RING_OFF = 0, RING_BYTES = 131072;
constexpr int LDSCTL_OFF = RING_BYTES, MISC_OFF = LDSCTL_OFF + 320;
constexpr int LDS_BYTES = 147456;
constexpr int LDS_TAB = 135168;

#define GAS __attribute__((address_space(1)))
#define LAS __attribute__((address_space(3)))
typedef unsigned short bf16;
typedef unsigned v4u __attribute__((ext_vector_type(4)));
typedef unsigned v2u __attribute__((ext_vector_type(2)));
typedef float f32x4 __attribute__((ext_vector_type(4)));
typedef GAS unsigned gu32;
#define RLX_AGENT __ATOMIC_RELAXED, __HIP_MEMORY_SCOPE_AGENT
#define LDS_WAIT() asm volatile("s_waitcnt lgkmcnt(0)" ::: "memory")
#define VM_WAIT() asm volatile("s_waitcnt vmcnt(0)" ::: "memory")
__device__ __forceinline__ unsigned f2bf(float f) { unsigned u = __builtin_bit_cast(unsigned, f); return (u + 0x7fffu + ((u >> 16) & 1u)) >> 16; }
__device__ __forceinline__ unsigned pk2(float lo, float hi) { return f2bf(lo) | (f2bf(hi) << 16); }
__device__ __forceinline__ float bf2f(unsigned short h) { return __builtin_bit_cast(float, (unsigned)h << 16); }
__device__ __forceinline__ float bflo(unsigned w) { return __builtin_bit_cast(float, w << 16); }
__device__ __forceinline__ float bfhi(unsigned w) { return __builtin_bit_cast(float, w & 0xffff0000u); }
__device__ __forceinline__ float wave_sum(float v) {
#pragma unroll
    for (int o = 1; o < 64; o <<= 1) v += __shfl_xor(v, o);
    return v;
}
__device__ __forceinline__ float wave_max(float v) {
#pragma unroll
    for (int o = 1; o < 64; o <<= 1) v = fmaxf(v, __shfl_xor(v, o));
    return v;
}
#define XB_TMO      128
#define XB_XCNT(j)  (256  + 64 * (j))
#define XB_XSUB(j)  (1280 + 64 * (j))
#define XB_XGEN(j)  (2304 + 64 * (j))
#define XB_TOP      3328
#define XB_TOPGEN   3392
#define XCD_BAR_WORDS 3456
#define XB_SPIN_CAP (1u << 18)

__device__ __forceinline__ unsigned xb_ld(unsigned* p)              { return __hip_atomic_load(p, __ATOMIC_RELAXED, __HIP_MEMORY_SCOPE_AGENT); }
__device__ __forceinline__ unsigned xb_add(unsigned* p, unsigned v) { return __hip_atomic_fetch_add(p, v, __ATOMIC_RELAXED, __HIP_MEMORY_SCOPE_AGENT); }
__device__ __forceinline__ unsigned xb_xcc_id() { return (unsigned)__builtin_amdgcn_s_getreg((3 << 11) | 20) & 0xFu; }
#define XB_SPIN(cond, bar) do { unsigned _sp = 0; while (cond) { __builtin_amdgcn_s_sleep(1); \
    if ((++_sp & 255u) == 0u) { if (xb_ld(&(bar)[XB_TMO])) break; if (_sp > XB_SPIN_CAP) { atomicAdd(&(bar)[XB_TMO], 1u); break; } } } } while (0)

struct XcdBarrier {
    unsigned* bar; unsigned x;
    volatile LAS unsigned* st;
};

__device__ __forceinline__ XcdBarrier xcd_barrier_post(unsigned* bar, volatile LAS unsigned* st) {
    XcdBarrier b; b.bar = bar; b.x = xb_xcc_id(); b.st = st;
    if (threadIdx.x == 0) (void)xb_add(&bar[XB_XCNT(b.x)], 1u);
    return b;
}
__device__ __forceinline__ void xcd_barrier_complete(unsigned* bar, unsigned x, unsigned& nloc, unsigned& nx) {
    const unsigned G = gridDim.x * gridDim.y * gridDim.z;
    unsigned sum, cnt, mine, sp = 0u;
    for (;;) {
        sum = 0u; cnt = 0u; mine = 0u;
#pragma unroll
        for (unsigned j = 0; j < 16; ++j) { const unsigned c = xb_ld(&bar[XB_XCNT(j)]); sum += c; cnt += (c > 0u) ? 1u : 0u; mine = (j == x) ? c : mine; }
        if (sum == G) break;
        __builtin_amdgcn_s_sleep(1);
        if ((++sp & 255u) == 0u) { if (xb_ld(&bar[XB_TMO])) break; if (sp > XB_SPIN_CAP) { atomicAdd(&bar[XB_TMO], 1u); break; } }
    }
    nloc = mine > 0u ? mine : 1u; nx = cnt > 0u ? cnt : 1u;
}

__device__ __forceinline__ void xcd_barrier(const XcdBarrier& b) {
    asm volatile("s_waitcnt vmcnt(0)" ::: "memory");
    __syncthreads();
    if (threadIdx.x == 0) {
        unsigned* bar = b.bar;
        __builtin_amdgcn_s_waitcnt(0);
        unsigned nloc = b.st[0], nx = b.st[1];
        if (nloc == 0u) { xcd_barrier_complete(bar, b.x, nloc, nx); b.st[0] = nloc; b.st[1] = nx; }
        const unsigned old = xb_add(&bar[XB_XSUB(b.x)], 1u);
        const unsigned gen = old / nloc;
        if (old + 1u == (gen + 1u) * nloc) {
            __builtin_amdgcn_fence(__ATOMIC_RELEASE, "agent");
            asm volatile("s_waitcnt vmcnt(0)" ::: "memory");
            const unsigned og = xb_add(&bar[XB_TOP], 1u);
            const unsigned tg = og / nx;
            if (og + 1u == (tg + 1u) * nx) xb_add(&bar[XB_TOPGEN], 1u);
            else XB_SPIN(xb_ld(&bar[XB_TOPGEN]) == tg, bar);
            __builtin_amdgcn_fence(__ATOMIC_ACQUIRE, "agent");
            xb_add(&bar[XB_XGEN(b.x)], 1u);
            asm volatile("s_waitcnt vmcnt(0)" ::: "memory");
        } else {
            XB_SPIN(xb_ld(&bar[XB_XGEN(b.x)]) == gen, bar);
            __builtin_amdgcn_fence(__ATOMIC_ACQUIRE, "agent");
            asm volatile("s_waitcnt vmcnt(0)" ::: "memory");
        }
    }
    __syncthreads();
}

struct Frame {
    LAS unsigned char* lds;
    volatile LAS unsigned* MISC;
    gu32* ctl;
    unsigned char* ws;
    int tid, lane, wave, vcu, G;
};
typedef short bf16x8_t __attribute__((ext_vector_type(8)));
struct LocalId { int tid, lane, wave; };
__device__ __forceinline__ LocalId local_id_w(int wave) { int t = wave * 64 + lane_id_(); asm volatile("" : "+v"(t)); LocalId l; l.tid = t; l.lane = t & 63; l.wave = wave; return l; }
#define local_id() local_id_w(F.wave)
struct Args { const float* in[35]; float* out; unsigned char* ws; int ph_lo, ph_hi; };
enum { I_X = 0, I_C, I_CTX, I_CCTX, I_MODW, I_MODB, I_EWIN, I_EWOUT, I_AQN, I_AKN, I_BCQN, I_BWUQ, I_BCKVN, I_BWUKV, I_BQN, I_BKN, I_OWIN, I_OWOUT,
       I_CQN, I_CKN, I_LQ1, I_LK1, I_LQ2, I_LK2, I_SUBLN, I_DQN, I_DKN, I_SINK, I_WRG, I_BRG, I_WRE, I_BRE, I_WG, I_WU, I_WD };

__device__ __forceinline__ int mod_index(int row) { const int b = row / TPB; return (row - b * TPB) < CTX ? 8 : b; }

__device__ __forceinline__ unsigned cvt_pk_bf16(float lo, float hi) { unsigned r; asm volatile("v_cvt_pk_bf16_f32 %0, %1, %2" : "=v"(r) : "v"(lo), "v"(hi)); return r; }
#ifndef TR_NT_LOAD
#define TR_NT_LOAD 1
#endif
#ifndef TR_NT_STORE
#define TR_NT_STORE 0
#endif
struct TrAddr { const float* src; bf16* dst; int N, Kd; };
__device__ __forceinline__ void tr_load(f32x4 (&v)[8], const TrAddr& t, int lane) {
    const int kr = lane >> 3, cq = lane & 7;
#pragma unroll
#if TR_NT_LOAD
    for (int i = 0; i < 8; ++i) v[i] = __builtin_nontemporal_load((const f32x4*)(t.src + (size_t)(8 * kr + i) * t.N + 4 * cq));
#else
    for (int i = 0; i < 8; ++i) v[i] = *(const f32x4*)(t.src + (size_t)(8 * kr + i) * t.N + 4 * cq);
#endif
}
__device__ __forceinline__ void tr_store(const f32x4 (&v)[8], const TrAddr& t, int lane) {
    const int kr = lane >> 3, cq = lane & 7;
#pragma unroll
    for (int e = 0; e < 4; ++e) { v4u o; o.x = cvt_pk_bf16(v[0][e], v[1][e]); o.y = cvt_pk_bf16(v[2][e], v[3][e]); o.z = cvt_pk_bf16(v[4][e], v[5][e]); o.w = cvt_pk_bf16(v[6][e], v[7][e]);
#if TR_NT_STORE
        __builtin_nontemporal_store(o, (v4u*)(t.dst + (size_t)(4 * cq + e) * t.Kd + 8 * kr)); }
#else
        *(GAS v4u*)(t.dst + (size_t)(4 * cq + e) * t.Kd + 8 * kr) = o; }
#endif
}
__device__ __forceinline__ void transpose_item(const float* W, int N, int k0, int n0, bf16* dst, int Kd, LAS float* scr, int lane) {
    (void)scr; TrAddr t; t.src = W + (size_t)k0 * N + n0; t.dst = dst + k0; t.N = N; t.Kd = Kd;
    f32x4 v[8]; tr_load(v, t, lane); tr_store(v, t, lane);
}
__device__ __forceinline__ void small_transpose(const float* W, int K, int N, bf16* WT, int item, LAS float* scr, int lane) {
    const int nblk = N / 32, kb = item / nblk, nb = item - kb * nblk;
    transpose_item(W, N, kb * 64, nb * 32, WT + (size_t)(nb * 32) * K, K, scr, lane);
}
__device__ __forceinline__ TrAddr moe_item_addr(const Frame& F, const Args& a, int r) {
    int le, which, ri;
    if (r < 32 * 3072) { le = r / 3072; const int q = r - le * 3072; which = q >> 10; ri = q & 1023; }
    else if (r < 32 * 3072 + 32 * 2048) { const int r1 = r - 32 * 3072; le = 32 + (r1 >> 11); which = (r1 >> 10) & 1; ri = r1 & 1023; }
    else { const int r2 = r - (32 * 3072 + 32 * 2048); le = 32 + (r2 >> 10); which = 2; ri = r2 & 1023; }
    TrAddr t;
    if (which < 2) { const int kb = ri >> 5, n0 = (ri & 31) * 32;
        t.src = a.in[which == 0 ? I_WG : I_WU] + (size_t)le * 2048 * 1024 + (size_t)(kb * 64) * 1024 + n0; t.N = 1024;
        t.dst = (bf16*)(F.ws + WS_WGU) + (size_t)le * 2048 * 2048 + (size_t)((n0 >> 7) * 256 + which * 128 + (n0 & 127)) * 2048 + kb * 64; t.Kd = 2048;
    } else { const int kb = ri >> 6, n0 = (ri & 63) * 32;
        t.src = a.in[I_WD] + (size_t)le * 1024 * 2048 + (size_t)(kb * 64) * 2048 + n0; t.N = 2048;
        t.dst = (bf16*)(F.ws + WS_WDN) + (size_t)le * 2048 * 1024 + (size_t)n0 * 1024 + kb * 64; t.Kd = 1024; }
    return t;
}
__device__ __forceinline__ void moe_item(const Frame& F, const Args& a, int r, LAS float* scr, int lane) { (void)scr; const TrAddr t = moe_item_addr(F, a, r); f32x4 v[8]; tr_load(v, t, lane); tr_store(v, t, lane); }
__device__ __forceinline__ void p0_prologue(const Frame& F, const Args& a) {
    const LocalId L_ = local_id(); (void)L_;
    const int gt = F.vcu * 512 + L_.tid, NT = F.G * 512;
    {
        float2* t128 = (float2*)(F.ws + WS_ROPE); float2* t64 = (float2*)(F.ws + WS_ROPE + 16384);
        for (int i = gt; i < 3072; i += NT) {
            if (i < 2048) { const int pos = i >> 5, f = i & 31; const float inv = 1.0f / powf(10000.0f, (float)f / 32.0f); const float ang = (float)pos * inv; t128[i] = make_float2(cosf(ang), sinf(ang)); }
            else { const int k = i - 2048, pos = k >> 4, f = k & 15; const float inv = 1.0f / powf(10000.0f, (float)f / 16.0f); const float ang = (float)pos * inv; t64[k] = make_float2(cosf(ang), sinf(ang)); }
        }
    }
    { float* gsub = (float*)(F.ws + WS_ROPE + 32768); for (int i = gt; i < 128; i += NT) gsub[i] = a.in[I_SUBLN][i] * (1.0f - LAMBDA_INIT); }
    {
        bf16* WR = (bf16*)(F.ws + WS_WR);
        for (int i = gt; i < 2 * 256 * 2048; i += NT) { const int l = i >> 19, r = (i >> 11) & 255, k = i & 2047;
            float v = 0.f; if (r < 4) v = a.in[I_WRG][((size_t)l * 2048 + k) * 4 + r]; else if (r < 36) v = a.in[I_WRE][((size_t)l * 2048 + k) * 32 + (r - 4)];
            WR[i] = (bf16)f2bf(v); }
        v4u* z = (v4u*)((bf16*)(F.ws + WS_WE_IN) + (size_t)2624 * 2048);
        for (int i = gt; i < 192 * 2048 / 8; i += NT) z[i] = (v4u){0u, 0u, 0u, 0u};
    }
    {
        LAS float* sl = (LAS float*)(F.lds + RING_OFF);
        LAS float* red = (LAS float*)(F.lds + RING_OFF + 73728);
        for (int i = L_.tid; i < 9 * 2048; i += 512) { const int j = i >> 11, k = i & 2047; const float v = j < 8 ? a.in[I_C][j * 2048 + k] : a.in[I_CCTX][k]; sl[i] = v / (1.0f + expf(-v)); }
        __syncthreads();
        float* MOD = (float*)(F.ws + WS_MOD);
        const int cg = L_.lane & 31, ks = L_.lane >> 5;
        for (int item = blockIdx.x; item < 192; item += F.G) {
            const int layer = item / 96, chunk = item - layer * 96, col0 = chunk * 128;
            const float* W = a.in[I_MODW] + (size_t)layer * 2048 * 12288 + col0 + cg * 4;
            f32x4 acc[9];
#pragma unroll
            for (int j = 0; j < 9; ++j) acc[j] = (f32x4){0.f, 0.f, 0.f, 0.f};
#pragma unroll 8
            for (int it = 0; it < 128; ++it) { const int k = L_.wave * 256 + it * 2 + ks; const f32x4 w = *(const f32x4*)(W + (size_t)k * 12288);
#pragma unroll
                for (int j = 0; j < 9; ++j) { const float s = sl[j * 2048 + k]; acc[j] = acc[j] + w * s; } }
#pragma unroll
            for (int j = 0; j < 9; ++j)
#pragma unroll
                for (int e = 0; e < 4; ++e) { float v = acc[j][e]; v += __shfl_xor(v, 32); acc[j][e] = v; }
            if (L_.lane < 32) {
#pragma unroll
                for (int j = 0; j < 9; ++j)
#pragma unroll
                    for (int e = 0; e < 4; ++e) red[(L_.wave * 9 + j) * 128 + cg * 4 + e] = acc[j][e]; }
            __syncthreads();
            for (int t = L_.tid; t < 9 * 128; t += 512) { const int j = t >> 7, cc = t & 127; float s = a.in[I_MODB][layer * 12288 + col0 + cc];
#pragma unroll
                for (int w = 0; w < 8; ++w) s += red[(w * 9 + j) * 128 + cc];
                MOD[((size_t)layer * 9 + j) * 12288 + col0 + cc] = s; }
            __syncthreads();
        }
    }
    {
        LAS float* scr = (LAS float*)(F.lds + RING_OFF + L_.wave * 16384);
        const int gw = F.vcu * NWAVES + L_.wave, NGW = F.G * NWAVES;
        constexpr int I0 = 32 * 82, I1 = 8 * 48, I2 = 8 * 64, I3 = 32 * 64, I4 = 32 * 144, I5 = 32 * 64, NSMALL = I0 + I1 + I2 + I3 + I4 + I5;
#if MOE_F32B || BG_CONVERT
        constexpr int NMOE = 0;
#else
        constexpr int NMOE = 64 * 3072;
#endif
        for (int it = gw; it < NSMALL + NMOE; it += NGW) {
            int r = it;
            if (r < NSMALL) {
                if (r < I0) { small_transpose(a.in[I_EWIN], 2048, 2624, (bf16*)(F.ws + WS_WE_IN), r, scr, L_.lane); continue; } r -= I0;
                if (r < I1) { small_transpose(a.in[I_BWUQ], 512, 1536, (bf16*)(F.ws + WS_WE_UQ), r, scr, L_.lane); continue; } r -= I1;
                if (r < I2) { small_transpose(a.in[I_BWUKV], 512, 2048, (bf16*)(F.ws + WS_WE_UKV), r, scr, L_.lane); continue; } r -= I2;
                if (r < I3) { small_transpose(a.in[I_EWOUT], 2048, 2048, (bf16*)(F.ws + WS_WE_OUT), r, scr, L_.lane); continue; } r -= I3;
                if (r < I4) { small_transpose(a.in[I_OWIN], 2048, 4608, (bf16*)(F.ws + WS_WO_IN), r, scr, L_.lane); continue; } r -= I4;
                small_transpose(a.in[I_OWOUT], 2048, 2048, (bf16*)(F.ws + WS_WO_OUT), r, scr, L_.lane); continue;
            }
            moe_item(F, a, r - NSMALL, scr, L_.lane);
        }
    }
}

__device__ __forceinline__ void modulate_store(const f32x4 (&v)[8], const float* shift, const float* scale, bf16* orow, int lane) {
    float ss = 0.f;
#pragma unroll
    for (int j = 0; j < 8; ++j) ss += (v[j].x * v[j].x + v[j].y * v[j].y) + (v[j].z * v[j].z + v[j].w * v[j].w);
    ss = wave_sum(ss);
    const float r = 1.0f / sqrtf(ss * (1.0f / 2048.0f) + NORM_EPS);
#pragma unroll
    for (int j = 0; j < 8; ++j) { const f32x4 sh = ((const f32x4*)shift)[lane + 64 * j], sc = ((const f32x4*)scale)[lane + 64 * j];
        const f32x4 y = v[j] * r * (sc + 1.0f) + sh; v2u o; o.x = pk2(y.x, y.y); o.y = pk2(y.z, y.w); ((v2u*)orow)[lane + 64 * j] = o; }
}
__device__ __forceinline__ void moe_combine_load(const bf16* YS, const int* rec, const LAS int* offs, int lane, f32x4 (&y)[8]) {
    const int s0 = offs[rec[0]] + rec[2], s1 = offs[rec[1]] + rec[3]; const float w0 = __builtin_bit_cast(float, rec[4]), w1 = __builtin_bit_cast(float, rec[5]);
    const v2u* p0 = (const v2u*)(YS + (size_t)s0 * 2048); const v2u* p1 = (const v2u*)(YS + (size_t)s1 * 2048);
#pragma unroll
    for (int j = 0; j < 8; ++j) { const v2u a = p0[lane + 64 * j], b = p1[lane + 64 * j];
        y[j].x = w0 * bflo(a.x) + w1 * bflo(b.x); y[j].y = w0 * bfhi(a.x) + w1 * bfhi(b.x); y[j].z = w0 * bflo(a.y) + w1 * bflo(b.y); y[j].w = w0 * bfhi(a.y) + w1 * bfhi(b.y); }
}

__device__ __forceinline__ int moe_tables(const Frame& F, int layer, int tid) {
    LAS int* texp = (LAS int*)(F.lds + LDS_TAB); LAS int* frt = texp + 256; LAS int* offs = frt + 40;
    if (tid < 64) {
        const int e = tid & 31;
        const unsigned c = __hip_atomic_load((unsigned*)(F.ctl + CW_CNT + layer * 64 + e), RLX_AGENT);
        const int pad = (int)((c + 255u) & ~255u);
        int incl = pad;
#pragma unroll
        for (int d = 1; d < 32; d <<= 1) { const int v = __shfl_up(incl, d); if ((tid & 31) >= d) incl += v; }
        const int excl = incl - pad;
        if (tid < 32) { offs[e] = excl; frt[e] = excl >> 8; for (int r = excl >> 8; r < (incl >> 8); ++r) texp[r] = e; if (e == 31) { offs[NE] = incl; frt[NE] = incl >> 8; } }
    }
    __syncthreads();
    return frt[NE];
}
__device__ __forceinline__ void hrow_load(const bf16* hrow, int lane, f32x4 (&v)[8]) {
#pragma unroll
    for (int q = 0; q < 8; ++q) { const v2u w = ((const v2u*)hrow)[lane + 64 * q]; v[q].x = bflo(w.x); v[q].y = bfhi(w.x); v[q].z = bflo(w.y); v[q].w = bfhi(w.y); }
}
__device__ __forceinline__ void hrow_store(bf16* hrow, int lane, const f32x4 (&v)[8]) {
#pragma unroll
    for (int q = 0; q < 8; ++q) { v2u o; o.x = pk2(v[q].x, v[q].y); o.y = pk2(v[q].z, v[q].w); ((v2u*)hrow)[lane + 64 * q] = o; }
}
__device__ __forceinline__ void modulate_store_l(const f32x4 (&v)[8], const LAS float* shift, const LAS float* scale, bf16* orow, int lane) {
    float ss = 0.f;
#pragma unroll
    for (int j = 0; j < 8; ++j) ss += (v[j].x * v[j].x + v[j].y * v[j].y) + (v[j].z * v[j].z + v[j].w * v[j].w);
    ss = wave_sum(ss);
    const float r = 1.0f / sqrtf(ss * (1.0f / 2048.0f) + NORM_EPS);
#pragma unroll
    for (int j = 0; j < 8; ++j) { const f32x4 sh = ((const LAS f32x4*)shift)[lane + 64 * j], sc = ((const LAS f32x4*)scale)[lane + 64 * j];
        const f32x4 y = v[j] * r * (sc + 1.0f) + sh; v2u o; o.x = pk2(y.x, y.y); o.y = pk2(y.z, y.w); ((v2u*)orow)[lane + 64 * j] = o; }
}
__device__ __forceinline__ const float* l0_src_row(const Args& a, int row, int& j) {
    const int b = row / TPB, r = row - b * TPB; j = r < CTX ? 8 : b;
    return r < CTX ? a.in[I_CTX] + (size_t)(b * CTX + r) * DM : a.in[I_X] + (size_t)(b * SEQ + (r - CTX)) * DM;
}
__device__ __forceinline__ void p_l0_mod1(const Frame& F, const Args& a) {
    const LocalId L_ = local_id(); (void)L_;
    const int gw = F.vcu * NWAVES + L_.wave, NGW = F.G * NWAVES;
    const float* MOD = (const float*)(F.ws + WS_MOD); bf16* A1 = (bf16*)(F.ws + WS_A1);
    for (int r0 = gw; r0 < T; r0 += 2 * NGW) {
        const int r1 = r0 + NGW; const bool ok1 = r1 < T;
        int j0, j1 = 0; const float* s0 = l0_src_row(a, r0, j0); const float* s1 = ok1 ? l0_src_row(a, r1, j1) : s0;
        f32x4 v0[8], v1[8];
#pragma unroll
        for (int q = 0; q < 8; ++q) v0[q] = ((const f32x4*)s0)[L_.lane + 64 * q];
#pragma unroll
        for (int q = 0; q < 8; ++q) v1[q] = ((const f32x4*)s1)[L_.lane + 64 * q];
        const float* m0 = MOD + (size_t)(0 * 9 + j0) * 12288;
        modulate_store(v0, m0 + 0 * 2048, m0 + 1 * 2048, A1 + (size_t)r0 * DM, L_.lane);
        if (ok1) {
            const float* m1 = MOD + (size_t)(0 * 9 + j1) * 12288;
            modulate_store(v1, m1 + 0 * 2048, m1 + 1 * 2048, A1 + (size_t)r1 * DM, L_.lane);
        }
    }
}
__device__ __forceinline__ void p_mod2(const Frame& F, int layer) {
    const LocalId L_ = local_id(); (void)L_;
    const int gw = F.vcu * NWAVES + L_.wave, NGW = F.G * NWAVES;
    const float* MOD = (const float*)(F.ws + WS_MOD); const bf16* H = (const bf16*)(F.ws + WS_H); bf16* A1 = (bf16*)(F.ws + WS_A1);
    for (int r0 = gw; r0 < T; r0 += 2 * NGW) {
        const int r1 = r0 + NGW; const int j0 = mod_index(r0), j1 = r1 < T ? mod_index(r1) : 8;
        const bool ok0 = !(layer == 1 && j0 == 8), ok1 = r1 < T && !(layer == 1 && j1 == 8);
        f32x4 v0[8], v1[8];
        if (ok0) hrow_load(H + (size_t)r0 * DM, L_.lane, v0);
        if (ok1) hrow_load(H + (size_t)r1 * DM, L_.lane, v1);
        if (ok0) { const float* m = MOD + (size_t)(layer * 9 + j0) * 12288; modulate_store(v0, m + 3 * 2048, m + 4 * 2048, A1 + (size_t)r0 * DM, L_.lane); }
        if (ok1) { const float* m = MOD + (size_t)(layer * 9 + j1) * 12288; modulate_store(v1, m + 3 * 2048, m + 4 * 2048, A1 + (size_t)r1 * DM, L_.lane); }
    }
}
__device__ __forceinline__ void p_l1_mod1(const Frame& F, size_t hdst_off = WS_H, size_t adst_off = WS_A1) {
    const LocalId L_ = local_id(); (void)L_;
    const float* MOD = (const float*)(F.ws + WS_MOD); const bf16* H = (const bf16*)(F.ws + WS_H); bf16* Hd = (bf16*)(F.ws + hdst_off); bf16* A1 = (bf16*)(F.ws + adst_off);
    const bf16* YS = (const bf16*)(F.ws + WS_YS); const int* ROUTE = (const int*)(F.ws + WS_ROUTE);
    (void)moe_tables(F, 0, L_.tid); const LAS int* offs = (const LAS int*)(F.lds + LDS_TAB) + 296;
    const int RPB = (T + F.G - 1) / F.G, rb0 = F.vcu * RPB < T ? F.vcu * RPB : T, re0 = rb0 + RPB < T ? rb0 + RPB : T;
    LAS float* vec = (LAS float*)(F.lds + RING_OFF);
    for (int rb = rb0; rb < re0 || rb == rb0; rb += 256) {
      const int re = rb + 256 < re0 ? rb + 256 : re0;
      const int jlo = mod_index(rb < T ? rb : T - 1), jhi = mod_index(re > rb ? re - 1 : (rb < T ? rb : T - 1));
      for (int i = L_.tid; i < 2 * 3 * 512; i += 512) { const int st = i / 1536, rem = i - st * 1536, vv = rem >> 9, k = rem & 511; const int j = st ? jhi : jlo;
        const float* src = vv == 0 ? MOD + (size_t)(0 * 9 + j) * 12288 + 5 * 2048 : MOD + (size_t)(1 * 9 + j) * 12288 + (vv - 1) * 2048;
        ((LAS f32x4*)vec)[i] = ((const f32x4*)src)[k]; }
      __syncthreads();
      for (int r0 = rb + 2 * L_.wave; r0 < re; r0 += 16) {
        const int r1 = r0 + 1; const bool ok1 = r1 < re; const int rr1 = ok1 ? r1 : r0;
        const int j0 = mod_index(r0), j1 = mod_index(rr1);
        const LAS float* s0 = vec + (j0 == jlo ? 0 : 3 * 2048); const LAS float* s1 = vec + (j1 == jlo ? 0 : 3 * 2048);
        f32x4 v0[8], v1[8], y0[8], y1[8];
        moe_combine_load(YS, ROUTE + (size_t)r0 * 8, offs, L_.lane, y0);
        moe_combine_load(YS, ROUTE + (size_t)rr1 * 8, offs, L_.lane, y1);
        hrow_load(H + (size_t)r0 * DM, L_.lane, v0);
        hrow_load(H + (size_t)rr1 * DM, L_.lane, v1);
#pragma unroll
        for (int q = 0; q < 8; ++q) { v0[q] = v0[q] + ((const LAS f32x4*)s0)[L_.lane + 64 * q] * y0[q]; v1[q] = v1[q] + ((const LAS f32x4*)s1)[L_.lane + 64 * q] * y1[q]; }
        if (j0 != 8) hrow_store(Hd + (size_t)r0 * DM, L_.lane, v0);
        modulate_store_l(v0, s0 + 2048, s0 + 4096, A1 + (size_t)r0 * DM, L_.lane);
        if (ok1) {
            if (j1 != 8) hrow_store(Hd + (size_t)r1 * DM, L_.lane, v1);
            modulate_store_l(v1, s1 + 2048, s1 + 4096, A1 + (size_t)r1 * DM, L_.lane);
        }
      }
      __syncthreads();
    }
}
__device__ __forceinline__ void p_final(const Frame& F, float* out) {
    const LocalId L_ = local_id(); (void)L_;
    const float* MOD = (const float*)(F.ws + WS_MOD); const bf16* H = (const bf16*)(F.ws + WS_H);
    const bf16* YS = (const bf16*)(F.ws + WS_YS); const int* ROUTE = (const int*)(F.ws + WS_ROUTE);
    (void)moe_tables(F, 1, L_.tid); const LAS int* offs = (const LAS int*)(F.lds + LDS_TAB) + 296;
    constexpr int NX = NB * SEQ;
    const int RPB = (NX + F.G - 1) / F.G, ib0 = F.vcu * RPB < NX ? F.vcu * RPB : NX, ie0 = ib0 + RPB < NX ? ib0 + RPB : NX;
    LAS float* vec = (LAS float*)(F.lds + RING_OFF);
    for (int ib = ib0; ib < ie0 || ib == ib0; ib += 2048) {
      const int ie = ib + 2048 < ie0 ? ib + 2048 : ie0;
      const int blo = (ib < NX ? ib : NX - 1) / SEQ, bhi = (ie > ib ? ie - 1 : (ib < NX ? ib : NX - 1)) / SEQ;
      for (int i = L_.tid; i < 2 * 512; i += 512) { const int st = i >> 9, k = i & 511; const int b = st ? bhi : blo;
        ((LAS f32x4*)vec)[i] = ((const f32x4*)(MOD + (size_t)(1 * 9 + b) * 12288 + 5 * 2048))[k]; }
      __syncthreads();
      for (int i0 = ib + 2 * L_.wave; i0 < ie; i0 += 16) {
        const int i1 = i0 + 1; const bool ok1 = i1 < ie; const int ii1 = ok1 ? i1 : i0;
        const int b0 = i0 / SEQ, row0 = b0 * TPB + CTX + (i0 - b0 * SEQ), b1 = ii1 / SEQ, row1 = b1 * TPB + CTX + (ii1 - b1 * SEQ);
        const LAS float* g0 = vec + (b0 == blo ? 0 : 2048); const LAS float* g1 = vec + (b1 == blo ? 0 : 2048);
        f32x4 y0[8], y1[8], h0[8], h1[8];
        moe_combine_load(YS, ROUTE + (size_t)row0 * 8, offs, L_.lane, y0);
        moe_combine_load(YS, ROUTE + (size_t)row1 * 8, offs, L_.lane, y1);
        hrow_load(H + (size_t)row0 * DM, L_.lane, h0);
        hrow_load(H + (size_t)row1 * DM, L_.lane, h1);
#pragma unroll
        for (int q = 0; q < 8; ++q) ((f32x4*)(out + (size_t)i0 * DM))[L_.lane + 64 * q] = h0[q] + ((const LAS f32x4*)g0)[L_.lane + 64 * q] * y0[q];
        if (ok1) {
#pragma unroll
            for (int q = 0; q < 8; ++q) ((f32x4*)(out + (size_t)i1 * DM))[L_.lane + 64 * q] = h1[q] + ((const LAS f32x4*)g1)[L_.lane + 64 * q] * y1[q]; }
      }
      __syncthreads();
    }
}

__device__ __forceinline__ void head128_norm_rope(const bf16* p, bf16* pd, const float* gain, bool rope, int prow, int pcol, const float2* t128, int lane) {
    const float x0 = bf2f(p[lane]), x1 = bf2f(p[lane + 64]);
    const float ss = wave_sum(x0 * x0 + x1 * x1);
    const float r = 1.0f / sqrtf(ss * (1.0f / 128.0f) + NORM_EPS);
    float y0 = x0 * r * gain[lane], y1 = x1 * r * gain[lane + 64];
    if (rope) {
        const int f = lane & 31; const float2 cr = t128[prow * 32 + f], cc = t128[pcol * 32 + f];
        const float p0 = __shfl_xor(y0, 32), p1 = __shfl_xor(y1, 32); const float sg = (lane & 32) ? 1.0f : -1.0f;
        y0 = y0 * cr.x + sg * p0 * cr.y; y1 = y1 * cc.x + sg * p1 * cc.y;
    }
    pd[lane] = (bf16)f2bf(y0); pd[lane + 64] = (bf16)f2bf(y1);
}
__device__ __forceinline__ float rope64_apply(float y, int prow, int pcol, const float2* t64, int lane) {
    const int f = lane & 15, pos = (lane & 32) ? pcol : prow; const float2 cs = t64[pos * 16 + f];
    const float pr = __shfl_xor(y, 16); const float sg = (lane & 16) ? 1.0f : -1.0f;
    return y * cs.x + sg * pr * cs.y;
}
__device__ __forceinline__ void head64_norm_rope(const bf16* p, bf16* pd, const float* gain, bool rope, int prow, int pcol, const float2* t64, int lane) {
    const float x = bf2f(p[lane]);
    const float ss = wave_sum(x * x);
    const float r = 1.0f / sqrtf(ss * (1.0f / 64.0f) + NORM_EPS);
    float y = x * r * gain[lane];
    if (rope) y = rope64_apply(y, prow, pcol, t64, lane);
    pd[lane] = (bf16)f2bf(y);
}
__device__ __forceinline__ void norm512(const bf16* src, const float* gain, bf16* dst, int lane) {
    const v4u w = ((const v4u*)src)[lane];
    float x[8] = {bflo(w.x), bfhi(w.x), bflo(w.y), bfhi(w.y), bflo(w.z), bfhi(w.z), bflo(w.w), bfhi(w.w)};
    float ss = 0.f;
#pragma unroll
    for (int i = 0; i < 8; ++i) ss += x[i] * x[i];
    ss = wave_sum(ss);
    const float r = 1.0f / sqrtf(ss * (1.0f / 512.0f) + NORM_EPS);
    const f32x4 g0 = ((const f32x4*)gain)[2 * lane], g1 = ((const f32x4*)gain)[2 * lane + 1];
    v4u o; o.x = pk2(x[0] * r * g0.x, x[1] * r * g0.y); o.y = pk2(x[2] * r * g0.z, x[3] * r * g0.w); o.z = pk2(x[4] * r * g1.x, x[5] * r * g1.y); o.w = pk2(x[6] * r * g1.z, x[7] * r * g1.w);
    ((v4u*)dst)[lane] = o;
}

__device__ __forceinline__ void unpack8(const v4u w, float (&x)[8]) { x[0] = bflo(w.x); x[1] = bfhi(w.x); x[2] = bflo(w.y); x[3] = bfhi(w.y); x[4] = bflo(w.z); x[5] = bfhi(w.z); x[6] = bflo(w.w); x[7] = bfhi(w.w); }
__device__ __forceinline__ v4u pack8(const float (&y)[8]) { v4u o; o.x = pk2(y[0], y[1]); o.y = pk2(y[2], y[3]); o.z = pk2(y[4], y[5]); o.w = pk2(y[6], y[7]); return o; }
__device__ __forceinline__ float sumsq8(const float (&x)[8]) { return ((x[0] * x[0] + x[1] * x[1]) + (x[2] * x[2] + x[3] * x[3])) + ((x[4] * x[4] + x[5] * x[5]) + (x[6] * x[6] + x[7] * x[7])); }
template <int GS> __device__ __forceinline__ float group_sum(float v) {
    v += __shfl_xor(v, 1); v += __shfl_xor(v, 2); v += __shfl_xor(v, 4); if (GS == 16) v += __shfl_xor(v, 8); return v;
}
template <int RD> __device__ __forceinline__ void rope8(float (&y)[8], int l, int prow, int pcol, const float2* tab) {
    constexpr int NF = RD / 4, LQ = NF / 8;
    const int quarter = l / LQ, f0 = (l % LQ) * 8, pos = (quarter >= 2) ? pcol : prow;
    const float sg = (quarter & 1) ? 1.0f : -1.0f;
    const f32x4* t = (const f32x4*)(tab + pos * NF + f0);
    const f32x4 c0 = t[0], c1 = t[1], c2 = t[2], c3 = t[3];
    float p[8];
#pragma unroll
    for (int j = 0; j < 8; ++j) p[j] = __shfl_xor(y[j], LQ);
    y[0] = y[0] * c0.x + sg * p[0] * c0.y; y[1] = y[1] * c0.z + sg * p[1] * c0.w; y[2] = y[2] * c1.x + sg * p[2] * c1.y; y[3] = y[3] * c1.z + sg * p[3] * c1.w;
    y[4] = y[4] * c2.x + sg * p[4] * c2.y; y[5] = y[5] * c2.z + sg * p[5] * c2.w; y[6] = y[6] * c3.x + sg * p[6] * c3.y; y[7] = y[7] * c3.z + sg * p[7] * c3.w;
}
template <int DIM> __device__ __forceinline__ v4u head_chunk(const v4u w, const float* gain, bool rope, int prow, int pcol, const float2* tab, int lane) {
    constexpr int GS = DIM / 8; const int l = lane & (GS - 1);
    float x[8]; unpack8(w, x);
    const float ss = group_sum<GS>(sumsq8(x));
    const float r = 1.0f / sqrtf(ss * (1.0f / DIM) + NORM_EPS);
    const f32x4 g0 = ((const f32x4*)gain)[2 * l], g1 = ((const f32x4*)gain)[2 * l + 1];
    x[0] *= r * g0.x; x[1] *= r * g0.y; x[2] *= r * g0.z; x[3] *= r * g0.w; x[4] *= r * g1.x; x[5] *= r * g1.y; x[6] *= r * g1.z; x[7] *= r * g1.w;
    if (rope) rope8<DIM>(x, l, prow, pcol, tab);
    return pack8(x);
}
__device__ __forceinline__ v4u norm512_chunk(const v4u w, const float* gain, int lane) {
    float x[8]; unpack8(w, x);
    const float ss = wave_sum(sumsq8(x));
    const float r = 1.0f / sqrtf(ss * (1.0f / 512.0f) + NORM_EPS);
    const f32x4 g0 = ((const f32x4*)gain)[2 * lane], g1 = ((const f32x4*)gain)[2 * lane + 1];
    x[0] *= r * g0.x; x[1] *= r * g0.y; x[2] *= r * g0.z; x[3] *= r * g0.w; x[4] *= r * g1.x; x[5] *= r * g1.y; x[6] *= r * g1.z; x[7] *= r * g1.w;
    return pack8(x);
}

__device__ __forceinline__ void p_even_post1(const Frame& F, const Args& a, size_t ydst_off = WS_Y1) {
    const LocalId L_ = local_id(); (void)L_;
    const int gw = F.vcu * NWAVES + L_.wave, NGW = F.G * NWAVES, lane = L_.lane;
    const bf16* Y1 = (const bf16*)(F.ws + WS_Y1); bf16* CQN = (bf16*)(F.ws + WS_CQN); bf16* CKVN = (bf16*)(F.ws + WS_CKVN);
    const float2* t128 = (const float2*)(F.ws + WS_ROPE);
    for (int row = gw; row < T; row += NGW) {
        const int b = row / TPB, r = row - b * TPB; const bool xr = r >= CTX; const int s = r - CTX, prow = xr ? (s >> 6) : 0, pcol = xr ? (s & 63) : 0;
        const v4u* y = (const v4u*)(Y1 + (size_t)row * EVEN_IN_P); v4u* yd = (v4u*)((bf16*)(F.ws + ydst_off) + (size_t)row * EVEN_IN_P);
        const v4u k0 = y[128 + (lane & 31)], cq = y[192 + lane], ckv = y[256 + lane];
        const v4u ok0 = head_chunk<128>(k0, a.in[I_AKN], xr, prow, pcol, t128, lane);
        const v4u ocq = norm512_chunk(cq, a.in[I_BCQN], lane), ockv = norm512_chunk(ckv, a.in[I_BCKVN], lane);
        if (lane < 32) yd[128 + lane] = ok0;
        ((v4u*)(CQN + (size_t)row * 512))[lane] = ocq; ((v4u*)(CKVN + (size_t)row * 512))[lane] = ockv;
    }
#if KR_IN_POST1
    {
        constexpr int FPITCH = 4112;
        LAS unsigned char* Fs = F.lds + RING_OFF; LAS float* P = (LAS float*)(F.lds + RING_OFF + 16 * FPITCH + 256);
        const bf16* A1 = (const bf16*)(F.ws + WS_A1); const bf16* WK = (const bf16*)(F.ws + WS_WE_IN) + (size_t)2560 * 2048; bf16* KR = (bf16*)(F.ws + WS_LG);
        const int wave = L_.wave;
        bf16x8_t bfr[4][8];
#pragma unroll
        for (int nb = 0; nb < 4; ++nb)
#pragma unroll
            for (int ks = 0; ks < 8; ++ks) bfr[nb][ks] = *(const bf16x8_t*)(WK + (size_t)(nb * 16 + (lane & 15)) * 2048 + wave * 256 + ks * 32 + (lane >> 4) * 8);
        __syncthreads();
        for (int g = F.vcu; g < T / 16; g += F.G) {
            const int row0 = g * 16;
#pragma unroll
            for (int rr = 0; rr < 2; ++rr) { const int r = 2 * wave + rr; const v4u* src = (const v4u*)(A1 + (size_t)(row0 + r) * DM);
#pragma unroll
                for (int q = 0; q < 4; ++q) *(LAS v4u*)(Fs + r * FPITCH + (lane + 64 * q) * 16) = src[lane + 64 * q]; }
            __syncthreads();
            f32x4 acc[4];
#pragma unroll
            for (int nb = 0; nb < 4; ++nb) acc[nb] = (f32x4){0.f, 0.f, 0.f, 0.f};
#pragma unroll
            for (int ks = 0; ks < 8; ++ks) { const bf16x8_t af = *(const LAS bf16x8_t*)(Fs + (lane & 15) * FPITCH + (wave * 256 + ks * 32 + (lane >> 4) * 8) * 2);
#pragma unroll
                for (int nb = 0; nb < 4; ++nb) acc[nb] = __builtin_amdgcn_mfma_f32_16x16x32_bf16(af, bfr[nb][ks], acc[nb], 0, 0, 0); }
#pragma unroll
            for (int nb = 0; nb < 4; ++nb)
#pragma unroll
                for (int rg = 0; rg < 4; ++rg) P[(wave * 16 + 4 * (lane >> 4) + rg) * 64 + nb * 16 + (lane & 15)] = acc[nb][rg];
            __syncthreads();
#pragma unroll
            for (int o = 0; o < 2; ++o) { const int idx = L_.tid + 512 * o, r = idx >> 6, c = idx & 63; float sacc = 0.f;
#pragma unroll
                for (int w = 0; w < 8; ++w) sacc += P[(w * 16 + r) * 64 + c];
                KR[(size_t)(row0 + r) * 64 + c] = (bf16)f2bf(sacc); }
            __syncthreads();
        }
    }
#endif
}
__device__ __forceinline__ void p_even_post2(const Frame& F, const Args& a, size_t qdst_off = WS_QB, size_t kdst_off = WS_KB) {
    const LocalId L_ = local_id(); (void)L_;
    const int gw = F.vcu * NWAVES + L_.wave, NGW = F.G * NWAVES, lane = L_.lane;
    const bf16* Y1 = (const bf16*)(F.ws + WS_Y1); const bf16* QB = (const bf16*)(F.ws + WS_QB); const bf16* KV = (const bf16*)(F.ws + WS_KV);
    bf16* KB = (bf16*)(F.ws + kdst_off); bf16* QBd = (bf16*)(F.ws + qdst_off);
    const float2* t64 = (const float2*)(F.ws + WS_ROPE + 16384);
    const float* gq = a.in[I_BQN]; const float* gk = a.in[I_BKN]; const float* KRP = (const float*)(F.ws + WS_LG);
    const int l16 = lane & 15, l8 = lane & 7, hn = lane >> 4, hr = lane >> 3;
    const f32x4 gqn0 = ((const f32x4*)gq)[2 * l16], gqn1 = ((const f32x4*)gq)[2 * l16 + 1], gqr0 = ((const f32x4*)(gq + 128))[2 * l8], gqr1 = ((const f32x4*)(gq + 128))[2 * l8 + 1];
    const f32x4 gkn0 = ((const f32x4*)gk)[2 * l16], gkn1 = ((const f32x4*)gk)[2 * l16 + 1], gkr0 = ((const f32x4*)(gk + 128))[2 * l8], gkr1 = ((const f32x4*)(gk + 128))[2 * l8 + 1];
    for (int row = gw; row < T; row += NGW) {
        const int b = row / TPB, r = row - b * TPB; const bool xr = r >= CTX; const int s = r - CTX, prow = xr ? (s >> 6) : 0, pcol = xr ? (s & 63) : 0;
        const bf16* q = QB + (size_t)row * 1536; const bf16* kv = KV + (size_t)row * 2048;
        const v4u wk0 = *(const v4u*)(kv + hn * 256 + l16 * 8), wk1 = *(const v4u*)(kv + (hn + 4) * 256 + l16 * 8);
#if KR_IN_POST1
        const v4u wkr = *(const v4u*)((const bf16*)(F.ws + WS_LG) + (size_t)row * 64 + l8 * 8);
#else
        const v4u wkr = *(const v4u*)(Y1 + (size_t)row * EVEN_IN_P + 2560 + l8 * 8);
#endif
#define POST2_ONE(W0, W1, WR, GN0, GN1, GR0, GR1, DST) do { \
        float x0[8], x1[8], xr_[8]; unpack8(W0, x0); unpack8(W1, x1); unpack8(WR, xr_); \
        const float n0 = group_sum<16>(sumsq8(x0)), n1 = group_sum<16>(sumsq8(x1)), rs = group_sum<8>(sumsq8(xr_));     \
        const float rs0 = __shfl(rs, 8 * hn), rs1 = __shfl(rs, 8 * (hn + 4));                                         \
        const float t0 = __shfl(n0, 16 * (hr & 3)), t1 = __shfl(n1, 16 * (hr & 3)); const float nr = (hr >> 2) ? t1 : t0;    \
        const float r0 = 1.0f / sqrtf((n0 + rs0) * (1.0f / 192.0f) + NORM_EPS), r1 = 1.0f / sqrtf((n1 + rs1) * (1.0f / 192.0f) + NORM_EPS), rr = 1.0f / sqrtf((nr + rs) * (1.0f / 192.0f) + NORM_EPS); \
        x0[0] *= r0 * GN0.x; x0[1] *= r0 * GN0.y; x0[2] *= r0 * GN0.z; x0[3] *= r0 * GN0.w; x0[4] *= r0 * GN1.x; x0[5] *= r0 * GN1.y; x0[6] *= r0 * GN1.z; x0[7] *= r0 * GN1.w; \
        x1[0] *= r1 * GN0.x; x1[1] *= r1 * GN0.y; x1[2] *= r1 * GN0.z; x1[3] *= r1 * GN0.w; x1[4] *= r1 * GN1.x; x1[5] *= r1 * GN1.y; x1[6] *= r1 * GN1.z; x1[7] *= r1 * GN1.w; \
        xr_[0] *= rr * GR0.x; xr_[1] *= rr * GR0.y; xr_[2] *= rr * GR0.z; xr_[3] *= rr * GR0.w; xr_[4] *= rr * GR1.x; xr_[5] *= rr * GR1.y; xr_[6] *= rr * GR1.z; xr_[7] *= rr * GR1.w; \
        if (xr) rope8<64>(xr_, l8, prow, pcol, t64); \
        *(v4u*)((DST) + hn * 192 + l16 * 8) = pack8(x0); *(v4u*)((DST) + (hn + 4) * 192 + l16 * 8) = pack8(x1); *(v4u*)((DST) + hr * 192 + 128 + l8 * 8) = pack8(xr_); } while (0)
        POST2_ONE(wk0, wk1, wkr, gkn0, gkn1, gkr0, gkr1, KB + (size_t)row * 1536);
#undef POST2_ONE
    }
}
__device__ __forceinline__ void p_odd_post1(const Frame& F, const Args& a, size_t ydst_off = WS_Y1) {
    const LocalId L_ = local_id(); (void)L_;
    const int gw = F.vcu * NWAVES + L_.wave, NGW = F.G * NWAVES, lane = L_.lane;
    const bf16* Y1 = (const bf16*)(F.ws + WS_Y1);
    const float2* t128 = (const float2*)(F.ws + WS_ROPE); const float2* t64 = (const float2*)(F.ws + WS_ROPE + 16384);
    for (int row = gw; row < T; row += NGW) {
        const int b = row / TPB, r = row - b * TPB; const bool xr = r >= CTX; const int s = r - CTX, prow = xr ? (s >> 6) : 0, pcol = xr ? (s & 63) : 0;
        const v4u* y = (const v4u*)(Y1 + (size_t)row * ODD_IN); v4u* yd = (v4u*)((bf16*)(F.ws + ydst_off) + (size_t)row * ODD_IN);
        const v4u kc0 = y[128 + lane], kc1 = y[192 + lane], kd0 = y[512 + (lane & 31)];
        const v4u p0 = head_chunk<64>(kc0, a.in[I_CKN], xr, prow, pcol, t64, lane), p1 = head_chunk<64>(kc1, a.in[I_CKN], xr, prow, pcol, t64, lane);
        const v4u p2 = head_chunk<128>(kd0, a.in[I_DKN], xr, prow, pcol, t128, lane);
        yd[128 + lane] = p0; yd[192 + lane] = p1; if (lane < 32) yd[512 + lane] = p2;
    }
}

__device__ __forceinline__ void p_route(const Frame& F, const Args& a, int layer) {
    const LocalId L_ = local_id(); (void)L_;
    const float* LG = (const float*)(F.ws + WS_LG); int* ROUTE = (int*)(F.ws + WS_ROUTE);
    unsigned* cnt = (unsigned*)(F.ctl + CW_CNT + layer * 64);
    const float* brg = a.in[I_BRG] + layer * 4; const float* bre = a.in[I_BRE] + layer * 32;
    const int NT = F.G * 512;
    for (int base = F.vcu * 512 + L_.wave * 64; base < T; base += NT) {
        const int t = base + L_.lane;
        bool valid = t < T; if (valid && layer == 1) valid = (t % TPB) >= CTX;
        int e0 = -1, e1 = -1; float w0 = 0.f, w1 = 0.f;
        if (valid) {
            const float* lg = LG + (size_t)t * 64;
            float g[4]; for (int i = 0; i < 4; ++i) { float v = brg[i]; for (int ks = 0; ks < RKS; ++ks) v += lg[(size_t)ks * T * 64 + i]; g[i] = v; }
            int gi = 0; float gm = g[0]; for (int i = 1; i < 4; ++i) if (g[i] > gm) { gm = g[i]; gi = i; }
            float den = 0.f; for (int i = 0; i < 4; ++i) den += expf(g[i] - gm);
            const float ptop = 1.0f / den;
            float el[8]; for (int i = 0; i < 8; ++i) { float v = bre[gi * 8 + i]; for (int ks = 0; ks < RKS; ++ks) v += lg[(size_t)ks * T * 64 + 4 + gi * 8 + i]; el[i] = v; }
            int i1 = 0; float l1 = el[0]; for (int i = 1; i < 8; ++i) if (el[i] > l1) { l1 = el[i]; i1 = i; }
            int i2 = -1; float l2 = -3.0e38f; for (int i = 0; i < 8; ++i) if (i != i1 && el[i] > l2) { l2 = el[i]; i2 = i; }
            const float ex = expf(l2 - l1), inv = 1.0f / (1.0f + ex);
            w0 = ptop * inv; w1 = ptop * ex * inv; e0 = gi * 8 + i1; e1 = gi * 8 + i2;
        }
        int pos0 = 0, pos1 = 0;
        const unsigned long long lt = (1ull << L_.lane) - 1ull;
        for (int e = 0; e < NE; ++e) {
            const unsigned long long m0 = __ballot(e0 == e), m1 = __ballot(e1 == e);
            const int n0 = __popcll(m0), n1 = __popcll(m1);
            if (n0 + n1 == 0) continue;
            unsigned basev = 0;
            if (L_.lane == 0) basev = __hip_atomic_fetch_add(cnt + e, (unsigned)(n0 + n1), RLX_AGENT);
            basev = (unsigned)__builtin_amdgcn_readfirstlane((int)basev);
            if (e0 == e) pos0 = (int)basev + __popcll(m0 & lt);
            if (e1 == e) pos1 = (int)basev + n0 + __popcll(m1 & lt);
        }
        if (valid) { int* rec = ROUTE + (size_t)t * 8; rec[0] = e0; rec[1] = e1; rec[2] = pos0; rec[3] = pos1; rec[4] = __builtin_bit_cast(int, w0); rec[5] = __builtin_bit_cast(int, w1); }
    }
}
__device__ __forceinline__ void p_mod2_route(const Frame& F, const Args& a, int layer) {
    const LocalId L_ = local_id(); (void)L_;
    const int lane = L_.lane, wave = L_.wave;
    constexpr int FPITCH = 4112;
    LAS unsigned char* Fs = F.lds + RING_OFF; LAS float* P = (LAS float*)(F.lds + RING_OFF + 16 * FPITCH + 256);
    const float* MOD = (const float*)(F.ws + WS_MOD); const bf16* H = (const bf16*)(F.ws + WS_H); bf16* A1 = (bf16*)(F.ws + WS_A1);
    const bf16* WR = (const bf16*)(F.ws + WS_WR) + (size_t)layer * 256 * 2048;
    int* ROUTE = (int*)(F.ws + WS_ROUTE); unsigned* cnt = (unsigned*)(F.ctl + CW_CNT + layer * 64); int* postok = (int*)(F.ws + WS_POS) + (size_t)layer * NE * POSCAP;
    const float* brg = a.in[I_BRG] + layer * 4; const float* bre = a.in[I_BRE] + layer * 32;
    bf16x8_t bfr[3][8];
#pragma unroll
    for (int nb = 0; nb < 3; ++nb)
#pragma unroll
        for (int ks = 0; ks < 8; ++ks) bfr[nb][ks] = *(const bf16x8_t*)(WR + (size_t)(nb * 16 + (lane & 15)) * 2048 + wave * 256 + ks * 32 + (lane >> 4) * 8);
    const int NG = layer == 1 ? NB * SEQ / 16 : T / 16;
    int it = 0;
    for (int g = F.vcu; g < NG; g += F.G, ++it) {
        int row0; if (layer == 1) { const int b = g >> 7; row0 = b * TPB + CTX + (g & 127) * 16; } else row0 = g * 16;
        const int j = mod_index(row0);
        const float* m = MOD + (size_t)(layer * 9 + j) * 12288;
        f32x4 v0[8], v1[8];
        const int r0 = 2 * wave, r1 = r0 + 1;
        hrow_load(H + (size_t)(row0 + r0) * DM, lane, v0);
        hrow_load(H + (size_t)(row0 + r1) * DM, lane, v1);
#define M2R_ROW(V, R) do { float ss = 0.f; \
        _Pragma("unroll") for (int q = 0; q < 8; ++q) ss += (V[q].x * V[q].x + V[q].y * V[q].y) + (V[q].z * V[q].z + V[q].w * V[q].w); \
        ss = wave_sum(ss); const float rn = 1.0f / sqrtf(ss * (1.0f / 2048.0f) + NORM_EPS); \
        _Pragma("unroll") for (int q = 0; q < 8; ++q) { const f32x4 sh = ((const f32x4*)(m + 3 * 2048))[lane + 64 * q], sc = ((const f32x4*)(m + 4 * 2048))[lane + 64 * q]; \
            const f32x4 y = V[q] * rn * (sc + 1.0f) + sh; v2u o; o.x = pk2(y.x, y.y); o.y = pk2(y.z, y.w); \
            ((v2u*)(A1 + (size_t)(row0 + (R)) * DM))[lane + 64 * q] = o; *(LAS v2u*)(Fs + (R) * FPITCH + (lane + 64 * q) * 8) = o; } } while (0)
        M2R_ROW(v0, r0); M2R_ROW(v1, r1);
#undef M2R_ROW
        __syncthreads();
        f32x4 acc[3];
#pragma unroll
        for (int nb = 0; nb < 3; ++nb) acc[nb] = (f32x4){0.f, 0.f, 0.f, 0.f};
#pragma unroll
        for (int ks = 0; ks < 8; ++ks) { const bf16x8_t af = *(const LAS bf16x8_t*)(Fs + (lane & 15) * FPITCH + (wave * 256 + ks * 32 + (lane >> 4) * 8) * 2);
#pragma unroll
            for (int nb = 0; nb < 3; ++nb) acc[nb] = __builtin_amdgcn_mfma_f32_16x16x32_bf16(af, bfr[nb][ks], acc[nb], 0, 0, 0); }
        LAS float* Pb = P + (it & 1) * (8 * 16 * 48);
#pragma unroll
        for (int nb = 0; nb < 3; ++nb)
#pragma unroll
            for (int rg = 0; rg < 4; ++rg) Pb[(wave * 16 + 4 * (lane >> 4) + rg) * 48 + nb * 16 + (lane & 15)] = acc[nb][rg];
        __syncthreads();
        if (wave == 0) {
            const bool valid = lane < 16; const int t = row0 + (lane & 15);
            int e0 = -1, e1 = -1; float w0 = 0.f, w1 = 0.f;
            if (valid) {
                const LAS float* pr = Pb + lane * 48;
                float gg[4];
#pragma unroll
                for (int i = 0; i < 4; ++i) { float sacc = brg[i];
#pragma unroll
                    for (int w = 0; w < 8; ++w) sacc += pr[w * 768 + i];
                    gg[i] = sacc; }
                int gi = 0; float gm = gg[0];
#pragma unroll
                for (int i = 1; i < 4; ++i) if (gg[i] > gm) { gm = gg[i]; gi = i; }
                float den = 0.f;
#pragma unroll
                for (int i = 0; i < 4; ++i) den += expf(gg[i] - gm);
                const float ptop = 1.0f / den;
                float el[8];
#pragma unroll
                for (int i = 0; i < 8; ++i) { float sacc = bre[gi * 8 + i];
#pragma unroll
                    for (int w = 0; w < 8; ++w) sacc += pr[w * 768 + 4 + gi * 8 + i];
                    el[i] = sacc; }
                int i1 = 0; float l1 = el[0];
#pragma unroll
                for (int i = 1; i < 8; ++i) if (el[i] > l1) { l1 = el[i]; i1 = i; }
                int i2 = -1; float l2 = -3.0e38f;
#pragma unroll
                for (int i = 0; i < 8; ++i) if (i != i1 && el[i] > l2) { l2 = el[i]; i2 = i; }
                const float ex = expf(l2 - l1), inv = 1.0f / (1.0f + ex);
                w0 = ptop * inv; w1 = ptop * ex * inv; e0 = gi * 8 + i1; e1 = gi * 8 + i2;
            }
            int rank0 = 0, rank1 = 0, mycnt = 0;
            const unsigned long long lt = (1ull << lane) - 1ull;
            for (int e = 0; e < NE; ++e) {
                const unsigned long long m0 = __ballot(e0 == e), m1 = __ballot(e1 == e);
                const int n0 = __popcll(m0), n1 = __popcll(m1);
                if (lane == e) mycnt = n0 + n1;
                if (e0 == e) rank0 = __popcll(m0 & lt);
                if (e1 == e) rank1 = n0 + __popcll(m1 & lt);
            }
            int basev = 0;
            if (lane < NE && mycnt > 0) basev = (int)__hip_atomic_fetch_add(cnt + lane, (unsigned)mycnt, RLX_AGENT);
            const int pos0 = __shfl(basev, e0 & 31) + rank0, pos1 = __shfl(basev, e1 & 31) + rank1;
            if (valid) { int* rec = ROUTE + (size_t)t * 8; rec[0] = e0; rec[1] = e1; rec[2] = pos0; rec[3] = pos1; rec[4] = __builtin_bit_cast(int, w0); rec[5] = __builtin_bit_cast(int, w1);
                         postok[(size_t)e0 * POSCAP + pos0] = t; postok[(size_t)e1 * POSCAP + pos1] = t; }
        }
    }
    __syncthreads();
}
__device__ __forceinline__ void p_gather(const Frame& F, int layer) {
    const LocalId L_ = local_id(); (void)L_;
    LAS int* offs = (LAS int*)(F.lds + RING_OFF);
    if (L_.tid == 0) { int o = 0; for (int e = 0; e < NE; ++e) { offs[e] = o; const unsigned c = __hip_atomic_load((unsigned*)(F.ctl + CW_CNT + layer * 64 + e), RLX_AGENT); o += (int)((c + 255u) & ~255u); } offs[NE] = o; }
    __syncthreads();
    if (blockIdx.x == 0 && L_.tid < NE) { const int e = L_.tid; int* texp = (int*)(F.ctl + CW_TEXP + layer * 256);
        for (int r = offs[e] >> 8; r < (offs[e + 1] >> 8); ++r) texp[r] = e;
        if (e == 0) *(int*)(F.ctl + CW_NRT + layer * 64) = offs[NE] >> 8; }
    int* ROUTE = (int*)(F.ws + WS_ROUTE); int* slot_tok = (int*)(F.ctl + CW_SLOT + layer * MAXSLOT);
    for (int t = F.vcu * 512 + L_.tid; t < T; t += F.G * 512) {
        if (layer == 1 && (t % TPB) < CTX) continue;
        int* rec = ROUTE + (size_t)t * 8;
        const int s0 = offs[rec[0]] + rec[2], s1 = offs[rec[1]] + rec[3];
        slot_tok[s0] = t; slot_tok[s1] = t; rec[6] = s0; rec[7] = s1;
    }
    __syncthreads();
}

constexpr int SLD = 2304;
template <int DQ, int QR>
__device__ __forceinline__ void naive_scores_softmax(LAS float* S, LAS float* qf, const bf16* Q, int ldq, const bf16* K, int ldk, int lo, int nk, float scale,
                                                     bool window, int qpos0, bool has_sink, float sink, int tid, int lane, int wave) {
    for (int i = tid; i < QR * DQ; i += 512) { const int r = i / DQ, d = i - r * DQ; qf[i] = bf2f(Q[(size_t)r * ldq + d]); }
    __syncthreads();
    for (int t = tid; t < nk; t += 512) {
        const int kr = t < CTX ? t : CTX + lo + (t - CTX);
        const bf16* kp = K + (size_t)kr * ldk;
        float acc[QR];
#pragma unroll
        for (int r = 0; r < QR; ++r) acc[r] = 0.f;
        for (int d = 0; d < DQ; d += 8) {
            const v4u kv = *(const v4u*)(kp + d);
            const float k0 = bflo(kv.x), k1 = bfhi(kv.x), k2 = bflo(kv.y), k3 = bfhi(kv.y), k4 = bflo(kv.z), k5 = bfhi(kv.z), k6 = bflo(kv.w), k7 = bfhi(kv.w);
#pragma unroll
            for (int r = 0; r < QR; ++r) { const LAS float* qp = qf + r * DQ + d;
                acc[r] += (k0 * qp[0] + k1 * qp[1]) + (k2 * qp[2] + k3 * qp[3]) + (k4 * qp[4] + k5 * qp[5]) + (k6 * qp[6] + k7 * qp[7]); }
        }
#pragma unroll
        for (int r = 0; r < QR; ++r) { float s = acc[r] * scale;
            if (window && t >= CTX) { const int dd = (qpos0 + r) - (lo + t - CTX); if (dd > 128 || dd < -128) s = -1e30f; }
            S[r * SLD + t] = s; }
    }
    __syncthreads();
    if (wave < QR) {
        LAS float* row = S + wave * SLD;
        float m = -1e30f; for (int t = lane; t < nk; t += 64) m = fmaxf(m, row[t]);
        m = wave_max(m); if (has_sink) m = fmaxf(m, sink);
        float sum = 0.f; for (int t = lane; t < nk; t += 64) { const float e = expf(row[t] - m); row[t] = e; sum += e; }
        sum = wave_sum(sum); if (has_sink) sum += expf(sink - m);
        const float inv = 1.0f / sum;
        for (int t = lane; t < nk; t += 64) row[t] *= inv;
    }
    __syncthreads();
}
template <int QR>
__device__ __forceinline__ void naive_pv(const LAS float* S, const bf16* V, int ldv, int lo, int nk, int tid, float (&o)[QR / 4]) {
    const int c = tid & 127, rg = tid >> 7; constexpr int RPT = QR / 4;
#pragma unroll
    for (int i = 0; i < RPT; ++i) o[i] = 0.f;
#pragma unroll 4
    for (int t = 0; t < nk; ++t) { const int kr = t < CTX ? t : CTX + lo + (t - CTX); const float v = bf2f(V[(size_t)kr * ldv + c]);
#pragma unroll
        for (int i = 0; i < RPT; ++i) o[i] += S[(rg * RPT + i) * SLD + t] * v; }
}
__device__ __forceinline__ void p_even_attn_naive(const Frame& F) {
    const LocalId L_ = local_id(); (void)L_;
    LAS float* S = (LAS float*)(F.lds + RING_OFF); LAS float* qf = (LAS float*)(F.lds + RING_OFF + 8 * SLD * 4);
    const bf16* Y1 = (const bf16*)(F.ws + WS_Y1); const bf16* QB = (const bf16*)(F.ws + WS_QB); const bf16* KV = (const bf16*)(F.ws + WS_KV); const bf16* KB = (const bf16*)(F.ws + WS_KB);
    bf16* MIX = (bf16*)(F.ws + WS_MIX);
    constexpr int UPV = NB * 8 * 288;
    for (int u = blockIdx.x; u < 2 * UPV; u += F.G) {
        const int var = u / UPV, rem = u - var * UPV, b = rem / 2304, rem2 = rem - b * 2304, h = rem2 / 288, ch = rem2 - h * 288;
        const int r0 = ch * 8, row0 = b * TPB + r0; const int nk = r0 < CTX ? CTX : TPB;
        float o[2];
        if (var == 0) {
            naive_scores_softmax<128, 8>(S, qf, Y1 + (size_t)row0 * EVEN_IN_P + h * 128, EVEN_IN_P, Y1 + (size_t)(b * TPB) * EVEN_IN_P + 1024 + (h >> 2) * 128, EVEN_IN_P, 0, nk,
                                         0.08838834764831845f, false, 0, false, 0.f, L_.tid, L_.lane, L_.wave);
            naive_pv<8>(S, Y1 + (size_t)(b * TPB) * EVEN_IN_P + 1280 + (h >> 2) * 128, EVEN_IN_P, 0, nk, L_.tid, o);
        } else {
            naive_scores_softmax<192, 8>(S, qf, QB + (size_t)row0 * 1536 + h * 192, 1536, KB + (size_t)(b * TPB) * 1536 + h * 192, 1536, 0, nk,
                                         0.07216878364870322f, false, 0, false, 0.f, L_.tid, L_.lane, L_.wave);
            naive_pv<8>(S, KV + (size_t)(b * TPB) * 2048 + h * 256 + 128, 2048, 0, nk, L_.tid, o);
        }
        const int c = L_.tid & 127, rg = L_.tid >> 7;
#pragma unroll
        for (int i = 0; i < 2; ++i) MIX[(size_t)(row0 + rg * 2 + i) * DM + var * 1024 + h * 128 + c] = (bf16)f2bf(o[i]);
        __syncthreads();
    }
}
__device__ __forceinline__ void p_odd_attn_naive(const Frame& F, const Args& a) {
    const LocalId L_ = local_id(); (void)L_;
    LAS float* S = (LAS float*)(F.lds + RING_OFF); LAS float* qf = (LAS float*)(F.lds + RING_OFF + 8 * SLD * 4); LAS float* ob = qf + 8 * 192;
    const bf16* Y1 = (const bf16*)(F.ws + WS_Y1); bf16* MIX = (bf16*)(F.ws + WS_MIX);
    float d1 = 0.f, d2 = 0.f;
    for (int i = 0; i < 64; ++i) { d1 += a.in[I_LQ1][i] * a.in[I_LK1][i]; d2 += a.in[I_LQ2][i] * a.in[I_LK2][i]; }
    const float lam = expf(d1) - expf(d2) + LAMBDA_INIT;
    constexpr int UC = NB * 8 * 512, UD = NB * 8 * 256;
    for (int u = blockIdx.x; u < UC + UD; u += F.G) {
        const int c = L_.tid & 127, rg = L_.tid >> 7;
        if (u < UC) {
            const int b = u / 4096, rem = u - b * 4096, h = rem / 512, ch = rem - h * 512;
            const int r0 = CTX + ch * 4, row0 = b * TPB + r0; const int nk = TPB;
            const bf16* kb = Y1 + (size_t)(b * TPB) * ODD_IN;
            naive_scores_softmax<64, 4>(S, qf, Y1 + (size_t)row0 * ODD_IN + (2 * h) * 64, ODD_IN, kb + 1024 + (2 * h) * 64, ODD_IN, 0, nk, 0.125f, false, 0, false, 0.f, L_.tid, L_.lane, L_.wave);
            naive_scores_softmax<64, 4>(S + 4 * SLD, qf, Y1 + (size_t)row0 * ODD_IN + (2 * h + 1) * 64, ODD_IN, kb + 1024 + (2 * h + 1) * 64, ODD_IN, 0, nk, 0.125f, false, 0, false, 0.f, L_.tid, L_.lane, L_.wave);
            for (int i = L_.tid; i < 4 * SLD; i += 512) S[i] = S[i] - lam * S[4 * SLD + i];
            __syncthreads();
            float o[1];
            naive_pv<4>(S, kb + 2048 + h * 128, ODD_IN, 0, nk, L_.tid, o);
            ob[rg * 128 + c] = o[0];
            __syncthreads();
            float ss = 0.f; for (int i = 0; i < 128; ++i) { const float v = ob[rg * 128 + i]; ss += v * v; }
            const float r = 1.0f / sqrtf(ss * (1.0f / 128.0f) + NORM_EPS);
            MIX[(size_t)(row0 + rg) * DM + h * 128 + c] = (bf16)f2bf(o[0] * r * a.in[I_SUBLN][c] * (1.0f - LAMBDA_INIT));
        } else {
            const int v = u - UC, b = v / 2048, rem = v - b * 2048, h = rem / 256, ch = rem - h * 256;
            const int s0 = ch * 8, row0 = b * TPB + CTX + s0;
            const int lo = s0 - 128 < 0 ? 0 : s0 - 128, hi = s0 + 7 + 128 > SEQ - 1 ? SEQ - 1 : s0 + 7 + 128; const int nk = CTX + (hi - lo + 1);
            const bf16* kb = Y1 + (size_t)(b * TPB) * ODD_IN;
            naive_scores_softmax<128, 8>(S, qf, Y1 + (size_t)row0 * ODD_IN + 3072 + h * 128, ODD_IN, kb + 4096 + (h >> 2) * 128, ODD_IN, lo, nk, 0.08838834764831845f, true, s0, true, a.in[I_SINK][h], L_.tid, L_.lane, L_.wave);
            float o[2];
            naive_pv<8>(S, kb + 4352 + (h >> 2) * 128, ODD_IN, lo, nk, L_.tid, o);
#pragma unroll
            for (int i = 0; i < 2; ++i) MIX[(size_t)(row0 + rg * 2 + i) * DM + 1024 + h * 128 + c] = (bf16)f2bf(o[i]);
        }
        __syncthreads();
    }
}

namespace att {
using bf16x8 = __attribute__((ext_vector_type(8))) short;
using s16x4  = __attribute__((ext_vector_type(4))) short;
using f32x16 = __attribute__((ext_vector_type(16))) float;
using u32x4  = __attribute__((ext_vector_type(4))) unsigned;
using f32x2  = __attribute__((ext_vector_type(2))) float;
#ifndef ATT_PK_SM
#define ATT_PK_SM 1
#endif
constexpr int KVBLK = 64, QBLK = 32;
constexpr int SHM_V = KVBLK * 128 * 2;
constexpr int K_OFF = 2 * SHM_V, K_MAX = KVBLK * 192 * 2, QL_OFF = K_OFF + 2 * K_MAX, WS_OFF = 131072 + 2048;
constexpr float THR = 8.f;
#define ATT_KSWZ(row, colB, RB) ((row) * (RB) + ((colB) ^ (((row) & 7) << 4)))
#define ATT_SBAR() __builtin_amdgcn_sched_barrier(0)
__device__ __forceinline__ int crow(int r, int hi) { return (r & 3) + 8 * (r >> 2) + 4 * hi; }
__device__ __forceinline__ unsigned cvtpk(float lo, float hi) { unsigned r; asm volatile("v_cvt_pk_bf16_f32 %0, %1, %2" : "=v"(r) : "v"(lo), "v"(hi)); return r; }

__device__ __forceinline__ void partialSM(f32x16& p0, f32x16& p1, float& m_reg, float& mn, float& alpha, float C, float thr_raw) {
  float pmax = p0[0];
#pragma unroll
  for (int r = 1; r < 16; ++r) pmax = fmaxf(pmax, p0[r]);
#pragma unroll
  for (int r = 0; r < 16; ++r) pmax = fmaxf(pmax, p1[r]);
  { auto rr = __builtin_amdgcn_permlane32_swap(__float_as_uint(pmax), __float_as_uint(pmax), false, false);
    pmax = fmaxf(__uint_as_float(rr[0]), __uint_as_float(rr[1])); }
  if (__builtin_expect(__all(pmax - m_reg <= thr_raw), 1)) { mn = m_reg; alpha = 1.f; }
  else { mn = fmaxf(m_reg, pmax); alpha = __builtin_amdgcn_exp2f((m_reg - mn) * C); m_reg = mn; }
  const float mnC = -mn * C;
#if ATT_PK_SM
  { const f32x2 C2 = {C, C}, M2 = {mnC, mnC};
#pragma unroll
    for (int r = 0; r < 16; r += 2) { f32x2 t = {p0[r], p0[r + 1]}; t = __builtin_elementwise_fma(t, C2, M2); p0[r] = t.x; p0[r + 1] = t.y; }
#pragma unroll
    for (int r = 0; r < 16; r += 2) { f32x2 t = {p1[r], p1[r + 1]}; t = __builtin_elementwise_fma(t, C2, M2); p1[r] = t.x; p1[r + 1] = t.y; } }
#else
#pragma unroll
  for (int r = 0; r < 16; ++r) p0[r] = fmaf(p0[r], C, mnC);
#pragma unroll
  for (int r = 0; r < 16; ++r) p1[r] = fmaf(p1[r], C, mnC);
#endif
#pragma unroll
  for (int r = 0; r < 16; ++r) p0[r] = __builtin_amdgcn_exp2f(p0[r]);
}
__device__ __forceinline__ void finishSM(f32x16& p0, f32x16& p1, float alpha, float& l_reg, bf16x8& pa0, bf16x8& pa1, bf16x8& pa2, bf16x8& pa3) {
#pragma unroll
  for (int r = 0; r < 16; ++r) p1[r] = __builtin_amdgcn_exp2f(p1[r]);
#if ATT_PK_SM
  f32x2 ps2 = {p0[0], p0[1]};
#pragma unroll
  for (int r = 2; r < 16; r += 2) ps2 += (f32x2){p0[r], p0[r + 1]};
#pragma unroll
  for (int r = 0; r < 16; r += 2) ps2 += (f32x2){p1[r], p1[r + 1]};
  float ps = ps2.x + ps2.y;
#else
  float ps = 0;
#pragma unroll
  for (int r = 0; r < 16; ++r) ps += p0[r];
#pragma unroll
  for (int r = 0; r < 16; ++r) ps += p1[r];
#endif
  { auto rr = __builtin_amdgcn_permlane32_swap(__float_as_uint(ps), __float_as_uint(ps), false, false);
    ps = __uint_as_float(rr[0]) + __uint_as_float(rr[1]); }
  l_reg = l_reg * alpha + ps;
#define ATT_PK4(P, BASE, OUT) do { unsigned a0 = cvtpk(P[BASE + 0], P[BASE + 1]), a1 = cvtpk(P[BASE + 2], P[BASE + 3]);   \
    unsigned b0 = cvtpk(P[BASE + 4], P[BASE + 5]), b1 = cvtpk(P[BASE + 6], P[BASE + 7]);                              \
    auto r0 = __builtin_amdgcn_permlane32_swap(a0, b0, false, false); auto r1 = __builtin_amdgcn_permlane32_swap(a1, b1, false, false); \
    u32x4 w = {r0[0], r1[0], r0[1], r1[1]}; OUT = *reinterpret_cast<bf16x8*>(&w); } while (0)
  ATT_PK4(p0, 0, pa0); ATT_PK4(p0, 8, pa1); ATT_PK4(p1, 0, pa2); ATT_PK4(p1, 8, pa3);
#undef ATT_PK4
}
template <int DQ, int NQT, int NQR, int QSB>
__device__ __forceinline__ void qkt(f32x16& p0, f32x16& p1, const char* Ks, const bf16x8 (&qr)[NQR], const char* qlds, const int (&kb)[4]) {
  p0 = f32x16{}; p1 = f32x16{};
#pragma unroll
  for (int d0 = 0; d0 < NQT; ++d0) {
    const bf16x8 b0 = *reinterpret_cast<const bf16x8*>(Ks + kb[d0 & 3] + (d0 >> 2) * 128);
    const bf16x8 b1 = *reinterpret_cast<const bf16x8*>(Ks + kb[d0 & 3] + (d0 >> 2) * 128 + 32 * DQ * 2);
    bf16x8 q; if (d0 < NQR) q = qr[d0 < NQR ? d0 : 0]; else q = *reinterpret_cast<const bf16x8*>(qlds + (d0 - NQR) * 1024);
    p0 = __builtin_amdgcn_mfma_f32_32x32x16_bf16(b0, q, p0, 0, 0, 0);
    p1 = __builtin_amdgcn_mfma_f32_32x32x16_bf16(b1, q, p1, 0, 0, 0);
    if (QSB > 0 && (d0 % (QSB > 0 ? QSB : 1)) == (QSB - 1) && d0 + 1 < NQT) ATT_SBAR(); }
}
__device__ __forceinline__ void mask_tile(f32x16& p0, f32x16& p1, int kp0, int qpos, int hi) {
#pragma unroll
  for (int r = 0; r < 16; ++r) { const int d = qpos - (kp0 + crow(r, hi));
    if (d > 128 || d < -128) p0[r] = -1e30f;
    if (d - 32 > 128 || d - 32 < -128) p1[r] = -1e30f; }
}
__device__ __forceinline__ int v_st(int k, int c) { const int kk = (k & ~0xC) | ((k & 4) << 1) | ((k & 8) >> 1); return ((kk >> 3) * 4 + (c >> 5)) * 512 + ((kk & 7) * 32 + (c & 31)) * 2; }
__device__ __forceinline__ int v_rd_base(int lane) { return ((lane & 3) << 3) | (((lane >> 2) & 3) << 6) | (((lane >> 4) & 1) << 5) | (((lane >> 5) & 1) << 8); }
constexpr int v_rd_off(int d0, int ks, int half) { return d0 * 512 + ks * 4096 + half * 2048; }
template <int OFF> __device__ __forceinline__ s16x4 tr_read(int vb) {
  s16x4 r; asm volatile("ds_read_b64_tr_b16 %0, %1 offset:%2" : "=&v"(r) : "v"(vb), "i"(OFF) : "memory"); return r;
}
template <int D0> __device__ __forceinline__ void pv_one(f32x16& od, int vb, bf16x8 pa0, bf16x8 pa1, bf16x8 pa2, bf16x8 pa3) {
  const s16x4 l0 = tr_read<v_rd_off(D0, 0, 0)>(vb), h0 = tr_read<v_rd_off(D0, 0, 1)>(vb), l1 = tr_read<v_rd_off(D0, 1, 0)>(vb), h1 = tr_read<v_rd_off(D0, 1, 1)>(vb);
  const s16x4 l2 = tr_read<v_rd_off(D0, 2, 0)>(vb), h2 = tr_read<v_rd_off(D0, 2, 1)>(vb), l3 = tr_read<v_rd_off(D0, 3, 0)>(vb), h3 = tr_read<v_rd_off(D0, 3, 1)>(vb);
  asm volatile("s_waitcnt lgkmcnt(0)" ::: "memory"); ATT_SBAR();
#define ATT_PK(L, H) (bf16x8){L[0], L[1], L[2], L[3], H[0], H[1], H[2], H[3]}
  od = __builtin_amdgcn_mfma_f32_32x32x16_bf16(pa0, ATT_PK(l0, h0), od, 0, 0, 0);
  od = __builtin_amdgcn_mfma_f32_32x32x16_bf16(pa1, ATT_PK(l1, h1), od, 0, 0, 0);
  od = __builtin_amdgcn_mfma_f32_32x32x16_bf16(pa2, ATT_PK(l2, h2), od, 0, 0, 0);
  od = __builtin_amdgcn_mfma_f32_32x32x16_bf16(pa3, ATT_PK(l3, h3), od, 0, 0, 0);
#undef ATT_PK
}
__device__ __forceinline__ void pv_d0(f32x16* o, int vb, bf16x8 pa0, bf16x8 pa1, bf16x8 pa2, bf16x8 pa3) {
  pv_one<0>(o[0], vb, pa0, pa1, pa2, pa3); pv_one<1>(o[1], vb, pa0, pa1, pa2, pa3); pv_one<2>(o[2], vb, pa0, pa1, pa2, pa3); pv_one<3>(o[3], vb, pa0, pa1, pa2, pa3);
}

template <int M> __device__ __forceinline__ float swz_xor(float v) { return __builtin_bit_cast(float, __builtin_amdgcn_ds_swizzle(__builtin_bit_cast(int, v), (M << 10) | 0x1F)); }
__device__ __forceinline__ float sum_xor32(float v) { auto rr = __builtin_amdgcn_permlane32_swap(__float_as_uint(v), __float_as_uint(v), false, false); return __uint_as_float(rr[0]) + __uint_as_float(rr[1]); }
__device__ __forceinline__ float bfx(short v) { return __builtin_bit_cast(float, ((unsigned)(unsigned short)v) << 16); }
template <int MODE, int NQ>
__device__ __forceinline__ void q_fix(bf16x8 (&q)[NQ], const float* gain, const float* tab  , int pos, int hi) {
  constexpr int DIM = NQ * 16;
  float x[NQ][8]; float ss = 0.f;
#pragma unroll
  for (int d0 = 0; d0 < NQ; ++d0)
#pragma unroll
    for (int j = 0; j < 8; ++j) { x[d0][j] = bfx(q[d0][j]); ss += x[d0][j] * x[d0][j]; }
  ss = sum_xor32(ss);
  const float r = 1.0f / sqrtf(ss * (1.0f / DIM) + 1e-6f);
#pragma unroll
  for (int d0 = 0; d0 < NQ; ++d0) { const float* g = gain + d0 * 16 + hi * 8;
#pragma unroll
    for (int j = 0; j < 8; ++j) x[d0][j] *= r * g[j]; }
  if (pos >= 0) {
    const int prow = pos >> 6, pcol = pos & 63;
    constexpr int RB0 = (MODE == 2) ? 8 : 0, NRB = (MODE == 1) ? 8 : 4, NF = (MODE == 1) ? 32 : 16, PX = (MODE == 1) ? 2 : 1;
    float y[NRB][8];
#pragma unroll
    for (int b = 0; b < NRB; ++b) { const int p = (b < NRB / 2) ? prow : pcol; const int f0 = (MODE == 1 ? (b & 1) * 16 : 0) + hi * 8; const float sg = (b & PX) ? 1.0f : -1.0f;
      const float* t = tab + (size_t)(p * NF + f0) * 2;
#pragma unroll
      for (int j = 0; j < 8; ++j) y[b][j] = x[RB0 + b][j] * t[2 * j] + sg * x[RB0 + (b ^ PX)][j] * t[2 * j + 1]; }
#pragma unroll
    for (int b = 0; b < NRB; ++b)
#pragma unroll
      for (int j = 0; j < 8; ++j) x[RB0 + b][j] = y[b][j];
  }
#pragma unroll
  for (int d0 = 0; d0 < NQ; ++d0) { u32x4 w; w.x = cvtpk(x[d0][0], x[d0][1]); w.y = cvtpk(x[d0][2], x[d0][3]); w.z = cvtpk(x[d0][4], x[d0][5]); w.w = cvtpk(x[d0][6], x[d0][7]); q[d0] = *reinterpret_cast<bf16x8*>(&w); }
}

template <int DQ, bool WINDOW, bool SINK, int LDQ, int LDK, int LDV, int SD, int QSB, int NQRMAX, bool DIFF = false, int QMODE = 0>
__device__ __forceinline__ void attn_unit(const bf16* __restrict__ Qb, const bf16* __restrict__ Kb, const bf16* __restrict__ Vb,
                                          bf16* __restrict__ Ob, int ntiles, int band_lo, int qpos0, float scale, float sink, char* lds, const float* gainp = nullptr,
                                          const float* qgain = nullptr, const float* qtab = nullptr, int qs0 = -1, int wv = 0) {
  constexpr int NQ = (DIFF ? DQ / 2 : DQ) / 16, NQR = NQ > NQRMAX ? NQRMAX : NQ, NCH = DQ / 64, RB = DQ * 2, SHM_K = KVBLK * DQ * 2, LDO = 2048;
  int tid = wv * 64 + lane_id_(); asm volatile("" : "+v"(tid));
  const int wid = tid >> 6, lane = tid & 63, r32 = lane & 31, hi = lane >> 5;
  const int comp = DIFF ? (wid >> 2) : 0, wrow = DIFF ? (wid & 3) : wid, kcomp = comp * 128;
  char* V_lds = lds; char* K_lds = lds + K_OFF;
  float* ws = (float*)(lds + WS_OFF) + wid * 64; float* li_l = ws; float* al_l = ws + 32;
  const float C = scale * 1.4426950408889634f, thr_raw = THR / scale;
  float m_reg = -1e30f, l_reg = 0; f32x16 o[4] = {}; bf16x8 qr[NQR];
  const unsigned qoff = (unsigned)((wrow * QBLK + r32) * LDQ + hi * 8 + comp * 64) * 2u;
  char* qlds = lds + QL_OFF + wid * ((NQ - NQR) * 1024) + lane * 16;
  if constexpr (QMODE == 0) {
#pragma unroll
    for (int d0 = 0; d0 < NQR; ++d0) qr[d0] = *reinterpret_cast<const bf16x8*>((const char*)Qb + qoff + d0 * 32);
    __syncthreads();
    if constexpr (NQ > NQR) {
#pragma unroll
      for (int d0 = NQR; d0 < NQ; ++d0) *reinterpret_cast<bf16x8*>(qlds + (d0 - NQR) * 1024) = *reinterpret_cast<const bf16x8*>((const char*)Qb + qoff + d0 * 32);
    }
  } else {
    bf16x8 qall[NQ];
#pragma unroll
    for (int d0 = 0; d0 < NQ; ++d0) qall[d0] = *reinterpret_cast<const bf16x8*>((const char*)Qb + qoff + d0 * 32);
    q_fix<QMODE, NQ>(qall, qgain, qtab, qs0 < 0 ? -1 : qs0 + wrow * QBLK + r32, hi);
#pragma unroll
    for (int d0 = 0; d0 < NQR; ++d0) qr[d0] = qall[d0];
    __syncthreads();
    if constexpr (NQ > NQR) {
#pragma unroll
      for (int d0 = NQR; d0 < NQ; ++d0) *reinterpret_cast<bf16x8*>(qlds + (d0 - NQR) * 1024) = qall[d0];
    }
  }
  const int sr = tid >> 4, sc = (tid & 15) * 8, vst0 = v_st(sr, sc);
  const unsigned voV = (unsigned)(sr * LDV + sc) * 2u;
  const int kr_ = tid >> 3, kc_ = (tid & 7) * 8;
  const unsigned voK = (unsigned)(kr_ * LDK + kc_) * 2u; const int kwr = ATT_KSWZ(kr_, kc_ * 2, RB);
  const int vb0 = (int)(uintptr_t)V_lds + v_rd_base(lane);
  int kb[4];
#pragma unroll
  for (int k = 0; k < 4; ++k) kb[k] = r32 * RB + ((k ^ ((r32 & 7) >> 1)) * 32) + ((hi ^ (r32 & 1)) * 16);
  const int qpos = qpos0 + wrow * QBLK + r32;
  struct { bf16x8 vs0, vs1, ks[NCH]; } sr_[SD];
#define ATT_KROW(j) (WINDOW ? ((j) < 4 ? (j) * KVBLK : 256 + band_lo + ((j) - 4) * KVBLK) : (j) * KVBLK)
#define ATT_SLOAD(i, j) do { const int k0_ = ATT_KROW(j); const char* vt_ = (const char*)Vb + (size_t)k0_ * (LDV * 2); const char* kt_ = (const char*)Kb + (size_t)k0_ * (LDK * 2); \
    sr_[i].vs0 = *reinterpret_cast<const bf16x8*>(vt_ + voV); sr_[i].vs1 = *reinterpret_cast<const bf16x8*>(vt_ + voV + 32 * LDV * 2); \
    _Pragma("unroll") for (int c_ = 0; c_ < NCH; ++c_) sr_[i].ks[c_] = *reinterpret_cast<const bf16x8*>(kt_ + voK + c_ * 128); } while (0)
#define ATT_SWRITE(b, i) do { *(bf16x8*)(V_lds + (b) * SHM_V + vst0) = sr_[i].vs0; *(bf16x8*)(V_lds + (b) * SHM_V + vst0 + 8192) = sr_[i].vs1; \
    _Pragma("unroll") for (int c_ = 0; c_ < NCH; ++c_) *(bf16x8*)(K_lds + (b) * SHM_K + kwr + c_ * 128) = sr_[i].ks[c_]; } while (0)
#define ATT_SWAIT() do { if constexpr (SD == 1) asm volatile("s_waitcnt vmcnt(0)" ::: "memory"); else if constexpr (NCH == 1) asm volatile("s_waitcnt vmcnt(3)" ::: "memory"); else if constexpr (NCH == 2) asm volatile("s_waitcnt vmcnt(4)" ::: "memory"); else asm volatile("s_waitcnt vmcnt(5)" ::: "memory"); } while (0)
#define ATT_RESC(a) do { if (__any((a) < 1.f)) { if (hi == 0) al_l[r32] = (a); asm volatile("s_waitcnt lgkmcnt(0)" ::: "memory"); \
    _Pragma("unroll") for (int d = 0; d < 4; ++d) _Pragma("unroll") for (int r = 0; r < 16; ++r) o[d][r] *= al_l[crow(r, hi)]; } } while (0)
#define ATT_MASK(P0, P1, j) do { if constexpr (WINDOW) { if ((j) >= 4) mask_tile(P0, P1, band_lo + ((j) - 4) * KVBLK, qpos, hi); } } while (0)
  f32x16 pA0, pA1, pB0, pB1; float mnA, mnB, alA, alB; bf16x8 pa0, pa1, pa2, pa3; const int NT = ntiles;
  constexpr int SE = 0, SO = SD - 1;
  ATT_SLOAD(SE, 0); asm volatile("s_waitcnt vmcnt(0)" ::: "memory"); ATT_SWRITE(0, SE); __syncthreads();
  qkt<DQ, NQ, NQR, QSB>(pA0, pA1, K_lds + kcomp, qr, qlds, kb); ATT_MASK(pA0, pA1, 0); partialSM(pA0, pA1, m_reg, mnA, alA, C, thr_raw);
  ATT_SLOAD(SO, 1); if constexpr (SD == 2) { if (2 < NT) ATT_SLOAD(SE, 2); }
  ATT_SWAIT(); ATT_SWRITE(1, SO); __syncthreads();
  for (int j = 1; j + 1 < NT; j += 2) {
    ATT_SBAR(); qkt<DQ, NQ, NQR, QSB>(pB0, pB1, K_lds + SHM_K + kcomp, qr, qlds, kb);
    finishSM(pA0, pA1, alA, l_reg, pa0, pa1, pa2, pa3); ATT_SBAR();
    ATT_SLOAD(SO, j + SD); ATT_SBAR();
    pv_d0(o, vb0, pa0, pa1, pa2, pa3); ATT_MASK(pB0, pB1, j); partialSM(pB0, pB1, m_reg, mnB, alB, C, thr_raw);
    __syncthreads(); ATT_SWAIT(); ATT_SWRITE(0, SE);
    ATT_RESC(alB); __syncthreads();
    ATT_SBAR(); qkt<DQ, NQ, NQR, QSB>(pA0, pA1, K_lds + kcomp, qr, qlds, kb);
    finishSM(pB0, pB1, alB, l_reg, pa0, pa1, pa2, pa3); ATT_SBAR();
    if (SD == 1 || j + 3 < NT) ATT_SLOAD(SE, j + 1 + SD); ATT_SBAR();
    pv_d0(o, vb0 + SHM_V, pa0, pa1, pa2, pa3); ATT_MASK(pA0, pA1, j + 1); partialSM(pA0, pA1, m_reg, mnA, alA, C, thr_raw);
    __syncthreads(); ATT_SWAIT(); ATT_SWRITE(1, SO);
    ATT_RESC(alA); __syncthreads();
  }
  ATT_SBAR(); qkt<DQ, NQ, NQR, QSB>(pB0, pB1, K_lds + SHM_K + kcomp, qr, qlds, kb);
  finishSM(pA0, pA1, alA, l_reg, pa0, pa1, pa2, pa3); ATT_SBAR();
  pv_d0(o, vb0, pa0, pa1, pa2, pa3); ATT_MASK(pB0, pB1, NT - 1); partialSM(pB0, pB1, m_reg, mnB, alB, C, thr_raw);
  __syncthreads(); ATT_RESC(alB);
  finishSM(pB0, pB1, alB, l_reg, pa0, pa1, pa2, pa3); ATT_SBAR();
  pv_d0(o, vb0 + SHM_V, pa0, pa1, pa2, pa3);
  if constexpr (SINK) l_reg += __builtin_amdgcn_exp2f(sink * 1.4426950408889634f - m_reg * C);
  if (hi == 0) li_l[r32] = l_reg; asm volatile("s_waitcnt lgkmcnt(0)" ::: "memory");
  float rli[16];
#pragma unroll
  for (int r = 0; r < 16; ++r) rli[r] = __builtin_amdgcn_rcpf(li_l[crow(r, hi)]);
  int tid2 = wv * 64 + lane_id_(); asm volatile("" : "+v"(tid2));
  if constexpr (!DIFF) {
    const bool odd = tid2 & 1;
    const unsigned ooff = (unsigned)(((tid2 >> 6) * QBLK + 4 * ((tid2 >> 5) & 1) + (tid2 & 1)) * LDO + (tid2 & 30)) * 2u;
#pragma unroll
    for (int rp = 0; rp < 8; ++rp) { const int orow = ((2 * rp) & 3) + 8 * ((2 * rp) >> 2);
#pragma unroll
      for (int d0 = 0; d0 < 4; ++d0) { const float a_ = o[d0][2 * rp] * rli[2 * rp], b_ = o[d0][2 * rp + 1] * rli[2 * rp + 1];
        const float rc = swz_xor<1>(odd ? a_ : b_);
        *reinterpret_cast<unsigned*>((char*)Ob + ooff + (orow * LDO + d0 * 32) * 2) = odd ? cvtpk(rc, b_) : cvtpk(a_, rc); } }
  } else {
    float* X = (float*)lds + ((tid2 >> 6) & 3) * 4096 + (tid2 & 63);
    __syncthreads();
    if (tid2 >= 256) {
#pragma unroll
      for (int d0 = 0; d0 < 4; ++d0)
#pragma unroll
        for (int r = 0; r < 16; ++r) X[(d0 * 16 + r) * 64] = sink * (o[d0][r] * rli[r]);
    }
    __syncthreads();
    if (tid2 < 256) {
      float g[4];
#pragma unroll
      for (int d0 = 0; d0 < 4; ++d0) g[d0] = gainp[d0 * 32 + (tid2 & 31)];
      const bool odd = tid2 & 1;
      const unsigned ooff = (unsigned)(((tid2 >> 6) * QBLK + 4 * ((tid2 >> 5) & 1) + (tid2 & 1)) * LDO + (tid2 & 30)) * 2u;
#pragma unroll
      for (int rp = 0; rp < 8; ++rp) { const int orow = ((2 * rp) & 3) + 8 * ((2 * rp) >> 2);
        float da[4], db[4], sa = 0.f, sb = 0.f;
#pragma unroll
        for (int d0 = 0; d0 < 4; ++d0) { da[d0] = o[d0][2 * rp] * rli[2 * rp] - X[(d0 * 16 + 2 * rp) * 64]; db[d0] = o[d0][2 * rp + 1] * rli[2 * rp + 1] - X[(d0 * 16 + 2 * rp + 1) * 64]; sa += da[d0] * da[d0]; sb += db[d0] * db[d0]; }
        sa += swz_xor<1>(sa); sa += swz_xor<2>(sa); sa += swz_xor<4>(sa); sa += swz_xor<8>(sa); sa += swz_xor<16>(sa);
        sb += swz_xor<1>(sb); sb += swz_xor<2>(sb); sb += swz_xor<4>(sb); sb += swz_xor<8>(sb); sb += swz_xor<16>(sb);
        const float ra = __builtin_amdgcn_rsqf(sa * (1.0f / 128.0f) + 1e-6f), rb = __builtin_amdgcn_rsqf(sb * (1.0f / 128.0f) + 1e-6f);
#pragma unroll
        for (int d0 = 0; d0 < 4; ++d0) { const float a_ = da[d0] * ra * g[d0], b_ = db[d0] * rb * g[d0];
          const float rc = swz_xor<1>(odd ? a_ : b_);
          *reinterpret_cast<unsigned*>((char*)Ob + ooff + (orow * LDO + d0 * 32) * 2) = odd ? cvtpk(rc, b_) : cvtpk(a_, rc); } }
    }
  }
#undef ATT_KROW
#undef ATT_SLOAD
#undef ATT_SWRITE
#undef ATT_SWAIT
#undef ATT_RESC
#undef ATT_MASK
}
}

__device__ __forceinline__ void p_even_attn(const Frame& F, const Args& a, char* lds) {
    const LocalId L_ = local_id(); (void)L_;
    const bf16* Y1 = (const bf16*)(F.ws + WS_Y1); const bf16* QB = (const bf16*)(F.ws + WS_QB); const bf16* KV = (const bf16*)(F.ws + WS_KV); const bf16* KB = (const bf16*)(F.ws + WS_KB);
    bf16* MIX = (bf16*)(F.ws + WS_MIX);
    const float* t128 = (const float*)(F.ws + WS_ROPE); const float* t64 = (const float*)(F.ws + WS_ROPE + 16384);
    for (int n = blockIdx.x; n < 512 + 64; n += F.G) {
        int b, h, row0, nt, qs0;
        if (n < 512) { const int i = n >> 8, c = n & 255, x = c & 7, lc = c >> 3, gi = i * 8 + x; b = gi >> 1; h = (gi & 1) * 4 + (lc >> 3); qs0 = (lc & 7) * 256; row0 = b * TPB + CTX + qs0; nt = 36; }
        else { const int m = n - 512; b = m >> 3; h = m & 7; row0 = b * TPB; nt = 4; qs0 = -1; }
        const size_t kb = (size_t)b * TPB;
        att::attn_unit<128, false, false, EVEN_IN_P, EVEN_IN_P, EVEN_IN_P, 2, 0, 8, false, 1>(Y1 + (size_t)row0 * EVEN_IN_P + h * 128, Y1 + kb * EVEN_IN_P + 1024 + (h >> 2) * 128, Y1 + kb * EVEN_IN_P + 1280 + (h >> 2) * 128,
                                                                                 MIX + (size_t)row0 * DM + h * 128, nt, 0, 0, 0.08838834764831845f, 0.f, lds, nullptr, a.in[I_AQN], t128, qs0, L_.wave);
    }
    for (int n = blockIdx.x; n < 512 + 64; n += F.G) {
        int b, h, row0, nt, qs0;
        if (n < 512) { const int i = n >> 8, c = n & 255, x = c & 7, lc = c >> 3, gi = i * 8 + x; b = gi >> 1; h = (gi & 1) * 4 + (lc >> 3); qs0 = (lc & 7) * 256; row0 = b * TPB + CTX + qs0; nt = 36; }
        else { const int m = n - 512; b = m >> 3; h = m & 7; row0 = b * TPB; nt = 4; qs0 = -1; }
        const size_t kb = (size_t)b * TPB;
        att::attn_unit<192, false, false, 1536, 1536, 2048, 1, 0, 8, false, 2>(QB + (size_t)row0 * 1536 + h * 192, KB + kb * 1536 + h * 192, KV + kb * 2048 + h * 256 + 128,
                                                                  MIX + (size_t)row0 * DM + 1024 + h * 128, nt, 0, 0, 0.07216878364870322f, 0.f, lds, nullptr, a.in[I_BQN], t64, qs0, L_.wave);
    }
    __syncthreads();
}
__device__ __forceinline__ void p_odd_attn(const Frame& F, const Args& a, char* lds) {
    const LocalId L_ = local_id(); (void)L_;
    const bf16* Y1 = (const bf16*)(F.ws + WS_Y1); bf16* O12 = (bf16*)(F.ws + WS_A1); bf16* MIX = (bf16*)(F.ws + WS_MIX);
#if ATT_DIFF_FUSED
    float d1 = 0.f, d2 = 0.f;
    for (int i = 0; i < 64; ++i) { d1 += a.in[I_LQ1][i] * a.in[I_LK1][i]; d2 += a.in[I_LQ2][i] * a.in[I_LK2][i]; }
    const float lam = expf(d1) - expf(d2) + LAMBDA_INIT;
    const float* gsub = (const float*)(F.ws + WS_ROPE + 32768);
    for (int n = blockIdx.x; n < 1024; n += F.G) {
        const int i = n >> 8, c = n & 255, x = c & 7, lc = c >> 3, gi = i * 8 + x, b = gi >> 2, h = (gi & 3) * 2 + (lc >> 4), row0 = b * TPB + CTX + (lc & 15) * 128;
        const size_t kb = (size_t)b * TPB * ODD_IN;
        att::attn_unit<128, false, false, ODD_IN, ODD_IN, ODD_IN, 2, 0, 8, true, 3>(Y1 + (size_t)row0 * ODD_IN + h * 128, Y1 + kb + 1024 + h * 128, Y1 + kb + 2048 + h * 128,
                                                                             MIX + (size_t)row0 * DM + h * 128, 36, 0, 0, 0.125f, lam, lds, gsub, a.in[I_CQN], (const float*)(F.ws + WS_ROPE + 16384), (lc & 15) * 128, L_.wave);
    }
#else
    for (int n = blockIdx.x; n < 1024; n += F.G) {
        const int i = n >> 8, c = n & 255, x = c & 7, lc = c >> 3, gi = i * 8 + x, b = gi >> 2, ch = (gi & 3) * 4 + (lc >> 3), row0 = b * TPB + CTX + (lc & 7) * 256;
        const size_t kb = (size_t)b * TPB * ODD_IN;
        att::attn_unit<64, false, false, ODD_IN, ODD_IN, ODD_IN, 2, 0, 8>(Y1 + (size_t)row0 * ODD_IN + ch * 64, Y1 + kb + 1024 + ch * 64, Y1 + kb + 2048 + (ch >> 1) * 128,
                                                                       O12 + (size_t)row0 * DM + ch * 128, 36, 0, 0, 0.125f, 0.f, lds, nullptr, nullptr, nullptr, -1, L_.wave);
    }
#endif
    for (int m = blockIdx.x; m < 512; m += F.G) {
        const int i = m >> 8, c = m & 255, x = c & 7, lc = c >> 3, gi = i * 8 + x, b = gi >> 1, kvh = gi & 1, h = kvh * 4 + (lc >> 3), s0 = (lc & 7) * 256, row0 = b * TPB + CTX + s0;
        const int lo = s0 - 128 < 0 ? 0 : s0 - 128, hie = s0 + 384 > SEQ ? SEQ : s0 + 384;
        const size_t kb = (size_t)b * TPB * ODD_IN;
        att::attn_unit<128, true, true, ODD_IN, ODD_IN, ODD_IN, 1, 0, 8, false, 1>(Y1 + (size_t)row0 * ODD_IN + 3072 + h * 128, Y1 + kb + 4096 + kvh * 128, Y1 + kb + 4352 + kvh * 128,
                                                                      MIX + (size_t)row0 * DM + 1024 + h * 128, 4 + (hie - lo) / 64, lo, s0, 0.08838834764831845f, a.in[I_SINK][h], lds, nullptr, a.in[I_DQN], (const float*)(F.ws + WS_ROPE), s0, L_.wave);
    }
    __syncthreads();
}
__device__ __forceinline__ void p_odd_combine(const Frame& F, const Args& a) {
    const LocalId L_ = local_id(); (void)L_;
    const int gw = F.vcu * NWAVES + L_.wave, NGW = F.G * NWAVES;
    const bf16* O12 = (const bf16*)(F.ws + WS_A1); bf16* MIX = (bf16*)(F.ws + WS_MIX);
    float d1 = 0.f, d2 = 0.f;
    for (int i = 0; i < 64; ++i) { d1 += a.in[I_LQ1][i] * a.in[I_LK1][i]; d2 += a.in[I_LQ2][i] * a.in[I_LK2][i]; }
    const float lam = expf(d1) - expf(d2) + LAMBDA_INIT;
    const float g0 = a.in[I_SUBLN][L_.lane] * (1.0f - LAMBDA_INIT), g1 = a.in[I_SUBLN][L_.lane + 64] * (1.0f - LAMBDA_INIT);
    for (int i = gw; i < NB * SEQ; i += NGW) {
        const int b = i / SEQ, row = b * TPB + CTX + (i - b * SEQ);
        const bf16* src = O12 + (size_t)row * DM; bf16* dst = MIX + (size_t)row * DM;
        for (int h = 0; h < 8; ++h) {
            const float x0 = bf2f(src[2 * h * 128 + L_.lane]) - lam * bf2f(src[(2 * h + 1) * 128 + L_.lane]);
            const float x1 = bf2f(src[2 * h * 128 + 64 + L_.lane]) - lam * bf2f(src[(2 * h + 1) * 128 + 64 + L_.lane]);
            const float ss = wave_sum(x0 * x0 + x1 * x1);
            const float r = 1.0f / sqrtf(ss * (1.0f / 128.0f) + NORM_EPS);
            dst[h * 128 + L_.lane] = (bf16)f2bf(x0 * r * g0); dst[h * 128 + 64 + L_.lane] = (bf16)f2bf(x1 * r * g1);
        }
    }
}

#ifndef FILL_S
#define FILL_S 2
#endif
#ifndef FILL_B
#define FILL_B 2
#endif
constexpr unsigned NCHUNK = 64u * 3072u / (8u * FILL_S), NCHUNK_L0 = NCHUNK / 2u, NCHUNK_L1GU = NCHUNK / 6u * 5u, FILL_NONE = 0xffffffffu;
template <bool BARRIER>
__device__ __forceinline__ void fill_loop(const Frame& F, const Args& a, unsigned* xgen, unsigned gen, unsigned lim) {
    const LocalId L_ = local_id();
    volatile LAS unsigned* st = F.MISC + 8;
    unsigned* ctr = (unsigned*)(F.ctl + CW_ITEM);
    unsigned cur = st[6] - 1u, nxt = st[7] - 1u; int s0 = (int)(st[16 + L_.wave] & 255u);
    __syncthreads();
    if (cur == FILL_NONE) { cur = nxt; nxt = FILL_NONE; s0 = 0; }
    if (cur == FILL_NONE) {
        if (L_.tid == 0) { const bool rel = BARRIER && xb_ld(xgen) != gen; st[5] = rel ? FILL_NONE : xb_add(ctr, 1u); }
        __syncthreads();
        cur = st[5];
        __syncthreads();
    }
    for (;;) {
        if (cur >= NCHUNK) { cur = FILL_NONE; nxt = FILL_NONE; s0 = 0; break; }
        if (!BARRIER && cur >= lim) break;
        unsigned nid = nxt;
        if (nxt == FILL_NONE && L_.tid == 0) nid = xb_add(ctr, 1u);
        int sN = s0; bool relw = false;
#pragma unroll 1
        for (; sN < FILL_S && !relw; sN += FILL_B) {
            const int r = (int)cur * (8 * FILL_S) + 8 * sN + L_.wave;
            TrAddr t[FILL_B]; f32x4 v[FILL_B][8];
#pragma unroll
            for (int j = 0; j < FILL_B; ++j) { t[j] = moe_item_addr(F, a, r + 8 * j); tr_load(v[j], t[j], L_.lane); }
            unsigned g = gen; if (BARRIER) g = (unsigned)__builtin_amdgcn_readfirstlane(xb_ld(xgen));
#pragma unroll
            for (int j = 0; j < FILL_B; ++j) tr_store(v[j], t[j], L_.lane);
            relw = (g != gen);
        }
        if (L_.lane == 0) st[16 + L_.wave] = (unsigned)sN | (relw ? 256u : 0u);
        if (L_.tid == 0) st[5] = nid;
        __syncthreads();
        nid = st[5]; bool partial = false, rel = false;
#pragma unroll
        for (int w = 0; w < NWAVES; ++w) { const unsigned x = st[16 + w]; partial = partial || ((x & 255u) < (unsigned)FILL_S); rel = rel || (x >= 256u); }
        __syncthreads();
        if (partial) { nxt = nid; s0 = sN; break; }
        cur = nid; nxt = FILL_NONE; s0 = 0;
        if (rel) break;
    }
    if (nxt != FILL_NONE && nxt >= NCHUNK) nxt = FILL_NONE;
    if (L_.lane == 0) st[16 + L_.wave] = (unsigned)s0;
    if (L_.tid == 0) { st[6] = cur + 1u; st[7] = nxt + 1u; }
    __syncthreads();
}
__device__ __forceinline__ void fill_until(const Frame& F, const Args& a, unsigned lim) { __syncthreads(); fill_loop<false>(F, a, nullptr, 0u, lim); }
__device__ __forceinline__ void xcd_barrier_fill(const XcdBarrier& b, const Frame& F, const Args& a) {
    asm volatile("s_waitcnt vmcnt(0)" ::: "memory");
    __syncthreads();
    volatile LAS unsigned* st = b.st;
    if (threadIdx.x == 0) {
        unsigned* bar = b.bar;
        __builtin_amdgcn_s_waitcnt(0);
        unsigned nloc = st[0], nx = st[1];
        if (nloc == 0u) { xcd_barrier_complete(bar, b.x, nloc, nx); st[0] = nloc; st[1] = nx; }
        const unsigned old = xb_add(&bar[XB_XSUB(b.x)], 1u);
        const unsigned gen = old / nloc;
        if (old + 1u == (gen + 1u) * nloc) {
            __builtin_amdgcn_fence(__ATOMIC_RELEASE, "agent");
            asm volatile("s_waitcnt vmcnt(0)" ::: "memory");
            const unsigned og = xb_add(&bar[XB_TOP], 1u);
            const unsigned tg = og / nx;
            if (og + 1u == (tg + 1u) * nx) xb_add(&bar[XB_TOPGEN], 1u);
            else XB_SPIN(xb_ld(&bar[XB_TOPGEN]) == tg, bar);
            __builtin_amdgcn_fence(__ATOMIC_ACQUIRE, "agent");
            xb_add(&bar[XB_XGEN(b.x)], 1u);
            asm volatile("s_waitcnt vmcnt(0)" ::: "memory");
            st[2] = 1u;
        } else { st[2] = 0u; st[3] = gen; }
    }
    __syncthreads();
    if (st[2] == 0u) {
        const unsigned gen = st[3];
        unsigned* xgen = &b.bar[XB_XGEN(b.x)];
        fill_loop<true>(F, a, xgen, gen, 0u);
        if (threadIdx.x == 0) {
            XB_SPIN(xb_ld(xgen) == gen, b.bar);
            __builtin_amdgcn_fence(__ATOMIC_ACQUIRE, "agent");
            asm volatile("s_waitcnt vmcnt(0)" ::: "memory");
        }
    }
    __syncthreads();
}

__device__ __forceinline__ int geff(int n, int G, int xr = 0) {
#if BG_CONVERT && !MK_PER_PHASE && BG_GEFF
    if (G % 8 != 0 || n <= 0) return G;
    const int rounds = (n + G - 1) / G + xr, g = ((n + rounds - 1) / rounds + 7) & ~7;
    return g < G ? g : G;
#else
    return G;
#endif
}
#ifndef XR_GEMM1E
#define XR_GEMM1E 0
#endif
#ifndef XR_GEMM3E
#define XR_GEMM3E 0
#endif
#ifndef XR_MOE_UP0
#define XR_MOE_UP0 0
#endif
#ifndef XR_MOE_DN0
#define XR_MOE_DN0 0
#endif
#ifndef XR_GEMM1O
#define XR_GEMM1O 0
#endif

__global__ void __launch_bounds__(NWAVES * 64, 2) trunk_fwd(Args args) {
    extern __shared__ __attribute__((aligned(16))) unsigned char lds[];
    Frame F;
    F.lds = (LAS unsigned char*)lds;
    F.MISC = (volatile LAS unsigned*)(F.lds + MISC_OFF);
    F.tid = threadIdx.x; F.lane = F.tid & 63; F.wave = __builtin_amdgcn_readfirstlane(F.tid >> 6);
    F.G = gridDim.x; { const int bx = blockIdx.x; F.vcu = (F.G % 8 == 0) ? (bx % 8) * (F.G / 8) + bx / 8 : bx; }
    F.ws = args.ws; F.ctl = (gu32*)(args.ws + WS_CTL);
    for (int u = F.tid; u < (LDS_BYTES - LDSCTL_OFF) / 4; u += NWAVES * 64) ((LAS unsigned*)(F.lds + LDSCTL_OFF))[u] = 0u;
    __syncthreads();
    XcdBarrier bar; bar.bar = (unsigned*)(F.ctl + CW_BAR); bar.x = 0; bar.st = nullptr;
#if !MK_PER_PHASE
    bar = xcd_barrier_post((unsigned*)(F.ctl + CW_BAR), F.MISC + 8);
#endif
    const int lo = args.ph_lo, hi = args.ph_hi;
#define IN(k) (lo <= (k) && (k) < hi)
#if MK_PER_PHASE
#define SEAM(k) do { } while (0)
#else
#define SEAM(k) do { if (IN(k) && IN((k) + 1)) xcd_barrier(bar); } while (0)
#endif
#if BG_CONVERT && !MK_PER_PHASE && BG_FILL
#define SEAMF(k) do { if (IN(k) && IN((k) + 1)) xcd_barrier_fill(bar, F, args); } while (0)
#else
#define SEAMF(k) SEAM(k)
#endif
    bf16* const A1 = (bf16*)(F.ws + WS_A1); bf16* const MIX = (bf16*)(F.ws + WS_MIX); bf16* const H = (bf16*)(F.ws + WS_H); const float* const MOD = (const float*)(F.ws + WS_MOD);
    PG8_LAS unsigned char* const ring = (PG8_LAS unsigned char*)(F.lds + RING_OFF);

#ifndef DUP_PHASE
#define DUP_PHASE (-1)
#endif
#ifndef PROBE_PHASE
#define PROBE_PHASE (-1)
#endif
constexpr size_t WS_DUMMY = 1600 * MiB;
#define PROBE(k, ...) do { if (PROBE_PHASE == (k) && IN(k)) { for (int r_ = 0; r_ < 3; ++r_) { __VA_ARGS__ xcd_barrier(bar); } } } while (0)
#define PH(k, ...) do { if (IN(k)) { __VA_ARGS__ if (DUP_PHASE == (k)) { for (int r_ = 0; r_ < 3; ++r_) { xcd_barrier(bar); __VA_ARGS__ } } } SEAM(k); } while (0)
#if BG_CONVERT
#define FILL_UNTIL(lim) fill_until(F, args, (lim))
#else
#define FILL_UNTIL(lim) do { } while (0)
#endif
#define PHF(k, ...) do { if (IN(k)) { __VA_ARGS__ if (DUP_PHASE == (k)) { for (int r_ = 0; r_ < 3; ++r_) { xcd_barrier(bar); __VA_ARGS__ } } } SEAMF(k); } while (0)
#define GEMM_STATIC(GE, EPI, Aptr, Bptr, N_, K_, ...) do { if ((int)blockIdx.x < (GE)) { pg8::Gemm g{(const bf16*)(Aptr), (const bf16*)(Bptr), (K_), (K_), (K_), nullptr}; pg8::StaticOrder S; S.init(T, (N_), (GE), (int)blockIdx.x); \
        pg8::EPI E{__VA_ARGS__}; pg8::gemm_phase<pg8::EPI, pg8::StaticOrder, false>(ring, g, S, E, F.wave); } } while (0)
#ifndef MOE_F32B
#define MOE_F32B 0
#endif
#define GEMM_MOE_F(EPI, GATH, Aptr, M0, M1, ESTR, LDN, COLMUL, HOFF, K_, layer, ...) do { const int nrt = __builtin_amdgcn_readfirstlane(*(const int*)(F.ctl + CW_NRT + (layer) * 64)); \
        pg8::Gemm g{(const bf16*)(Aptr), nullptr, (K_), 0, (K_), (const int*)(F.ctl + CW_SLOT + (layer) * MAXSLOT)}; pg8::BSrc bs{(M0), (M1), (size_t)(ESTR), (LDN), (COLMUL), (HOFF)}; \
        pg8::MoeOrder S; S.init((const int*)(F.ctl + CW_TEXP + (layer) * 256), nrt, F.G, (int)blockIdx.x); \
        pg8::EPI E{__VA_ARGS__}; pg8::gemm_phase_f32b<pg8::EPI, pg8::MoeOrder, GATH>(ring, g, bs, S, E, F.wave); } while (0)
#define GEMM_MOE_CHAIN(layer, Bgu, Bdn) do { const int nrt = __builtin_amdgcn_readfirstlane(moe_tables(F, (layer), F.wave * 64 + lane_id_())); \
        const PG8_LAS int* texp_ = (const PG8_LAS int*)(F.lds + LDS_TAB); unsigned* rdy_ = (unsigned*)(F.ctl + CW_RDY + (layer) * 16384); \
        { pg8::Gemm g{(const bf16*)A1, (const bf16*)(Bgu), DM, DM, DM, (const int*)(ws + WS_POS) + (size_t)(layer) * NE * POSCAP}; pg8::MoePublishOrder S; S.init(texp_, texp_ + 256, nrt, POSCAP, F.G, (int)blockIdx.x); S.ready = rdy_; \
          pg8::EpiSwiGLUwt E{(bf16*)(ws + WS_U), DE}; pg8::gemm_phase<pg8::EpiSwiGLUwt, pg8::MoePublishOrder, true>(ring, g, S, E, F.wave); } \
        { pg8::Gemm g{(const bf16*)(ws + WS_U), (const bf16*)(Bdn), DE, DE, DE, nullptr}; pg8::MoeCountedOrder S; S.init(texp_, texp_ + 256, nrt, POSCAP, F.G, (int)blockIdx.x); S.ready = rdy_; S.need = 64u; S.tmo = (unsigned*)F.ctl; S.wv = F.wave; \
          pg8::EpiStoreBf16 E{(bf16*)(ws + WS_YS), DM, 7}; pg8::gemm_phase<pg8::EpiStoreBf16, pg8::MoeCountedOrder, false>(ring, g, S, E, F.wave); } } while (0)
#define GEMM_ORDER(EPI, ORDER, INIT, Aptr, Bptr, K_, ...) do { pg8::Gemm g{(const bf16*)(Aptr), (const bf16*)(Bptr), (K_), (K_), (K_), nullptr}; pg8::ORDER S; S.init INIT; \
        pg8::EPI E{__VA_ARGS__}; pg8::gemm_phase<pg8::EPI, pg8::ORDER, false>(ring, g, S, E, F.wave); } while (0)
#define GEMM_ORDER_G(GE, EPI, ORDER, INIT, Aptr, Bptr, K_, ...) do { const int ge_ = (GE); if ((int)blockIdx.x < ge_) { pg8::Gemm g{(const bf16*)(Aptr), (const bf16*)(Bptr), (K_), (K_), (K_), nullptr}; pg8::ORDER S; S.init INIT; \
        pg8::EPI E{__VA_ARGS__}; pg8::gemm_phase<pg8::EPI, pg8::ORDER, false>(ring, g, S, E, F.wave); } } while (0)
#define GEMM_ROUTER_X(Bptr) do { pg8::Gemm g{(const bf16*)A1, (const bf16*)(Bptr), DM, DM, DM / RKS, nullptr}; pg8::SplitKXOrder S; S.init(RKS, DM / RKS, F.G, (int)blockIdx.x); \
        pg8::EpiLogits E{(float*)(ws + WS_LG), DM / RKS, (size_t)T * 64}; pg8::gemm_phase<pg8::EpiLogits, pg8::SplitKXOrder, false>(ring, g, S, E, F.wave); } while (0)
#define GEMM_ROUTER(Bptr) do { pg8::Gemm g{(const bf16*)A1, (const bf16*)(Bptr), DM, DM, DM / RKS, nullptr}; pg8::SplitKOrder S; S.init(T / 256, RKS, DM / RKS, F.G, (int)blockIdx.x); \
        pg8::EpiLogits E{(float*)(ws + WS_LG), DM / RKS, (size_t)T * 64}; pg8::gemm_phase<pg8::EpiLogits, pg8::SplitKOrder, false>(ring, g, S, E, F.wave); } while (0)
#define GEMM_MOE(XR, EPI, GATH, Aptr, Bptr, K_, layer, ...) do { const int nrt = __builtin_amdgcn_readfirstlane(moe_tables(F, (layer), F.wave * 64 + lane_id_())); \
        const int ge_ = geff(nrt * 8, F.G, (XR)); if ((int)blockIdx.x < ge_) { \
        pg8::Gemm g{(const bf16*)(Aptr), (const bf16*)(Bptr), (K_), (K_), (K_), (const int*)(ws + WS_POS) + (size_t)(layer) * NE * POSCAP}; pg8::MoeOrder S; \
        S.init((const PG8_LAS int*)(F.lds + LDS_TAB), (const PG8_LAS int*)(F.lds + LDS_TAB) + 256, nrt, POSCAP, ge_, (int)blockIdx.x); \
        pg8::EPI E{__VA_ARGS__}; pg8::gemm_phase<pg8::EPI, pg8::MoeOrder, GATH>(ring, g, S, E, F.wave); } } while (0)
    unsigned char* const ws = F.ws;
    PH(0, p0_prologue(F, args););
    PH(1, p_l0_mod1(F, args););
#ifdef NEXTRA_BAR
    for (int i_ = 0; i_ < NEXTRA_BAR; ++i_) xcd_barrier(bar);
#endif
    PHF(2, GEMM_STATIC(geff(72 * (KR_IN_POST1 ? 10 : 11), F.G, XR_GEMM1E), EpiStoreBf16, A1, ws + WS_WE_IN, (KR_IN_POST1 ? 2560 : EVEN_IN_P), DM, (bf16*)(ws + WS_Y1), EVEN_IN_P, 0x7fffffff););
    PROBE(3, p_even_post1(F, args, WS_DUMMY););
    PH(3, p_even_post1(F, args););
    PHF(4, GEMM_ORDER(EpiProj2, Proj2Order, (T, F.G, (int)blockIdx.x), ws + WS_CQN, ws + WS_WE_UQ, 512, (bf16*)(ws + WS_QB), (bf16*)(ws + WS_KV)););
    PH(5, p_even_post2(F, args););
#if USE_NAIVE_ATTN
    PH(6, p_even_attn_naive(F););
#else
    PHF(6, p_even_attn(F, args, (char*)lds););
#endif
    PHF(7, GEMM_STATIC(geff(72 * 8, F.G, XR_GEMM3E), EpiResidInit, MIX, ws + WS_WE_OUT, DM, DM, H, MOD + (size_t)0 * 9 * 12288 + 2 * 2048, args.in[I_X], args.in[I_CTX]););
#if FUSED_ROUTE
    PH(8, p_mod2_route(F, args, 0); FILL_UNTIL(NCHUNK_L0););
#else
    PH(8, p_mod2(F, 0););
    PH(9, GEMM_ROUTER(ws + WS_WR););
    PH(10, p_route(F, args, 0););
#endif
#if MOE_HANDOFF
    PH(12, GEMM_MOE_CHAIN(0, ws + WS_WGU, ws + WS_WDN););
#elif MOE_F32B
    PH(12, GEMM_MOE_F(EpiSwiGLU, true, A1, args.in[I_WG], args.in[I_WU], 2048 * 1024, 1024, 128, 0, DM, 0, (bf16*)(ws + WS_U), DE););
    PH(13, GEMM_MOE_F(EpiStoreBf16, false, ws + WS_U, args.in[I_WD], args.in[I_WD], 1024 * 2048, 2048, 256, 128, DE, 0, (bf16*)(ws + WS_YS), DM, 7););
#else
    PHF(12, GEMM_MOE(XR_MOE_UP0, EpiSwiGLU, true, A1, ws + WS_WGU, DM, 0, (bf16*)(ws + WS_U), DE););
    PHF(13, GEMM_MOE(XR_MOE_DN0, EpiStoreBf16, false, ws + WS_U, ws + WS_WDN, DE, 0, (bf16*)(ws + WS_YS), DM, 7););
#endif
    PROBE(14, p_l1_mod1(F, WS_DUMMY, WS_DUMMY + 160 * MiB););
    PH(14, p_l1_mod1(F););
    PHF(15, GEMM_ORDER_G(geff(64 * 18 + 80, F.G, XR_GEMM1O), EpiStoreBf16, OddInOrder, (ge_, (int)blockIdx.x), A1, ws + WS_WO_IN, DM, (bf16*)(ws + WS_Y1), ODD_IN, 0x7fffffff););
    PROBE(16, p_odd_post1(F, args, WS_DUMMY););
    PH(16, p_odd_post1(F, args););
#if USE_NAIVE_ATTN
    PH(17, p_odd_attn_naive(F, args););
    PH(18, ;);
#else
    PHF(17, p_odd_attn(F, args, (char*)lds););
#if !ATT_DIFF_FUSED
    PH(18, p_odd_combine(F, args););
#endif
#endif
    PHF(19, GEMM_ORDER(EpiResid, XOnlyOrder, (DM, F.G, (int)blockIdx.x), MIX, ws + WS_WO_OUT, DM, H, MOD + (size_t)1 * 9 * 12288 + 2 * 2048););
#if FUSED_ROUTE
    PH(20, p_mod2_route(F, args, 1); FILL_UNTIL(NCHUNK_L1GU););
#else
    PH(20, p_mod2(F, 1););
    PH(21, GEMM_ROUTER_X((const bf16*)(ws + WS_WR) + (size_t)256 * 2048););
    PH(22, p_route(F, args, 1););
#endif
#if MOE_HANDOFF
    PH(24, GEMM_MOE_CHAIN(1, (const bf16*)(ws + WS_WGU) + (size_t)32 * 2048 * 2048, (const bf16*)(ws + WS_WDN) + (size_t)32 * 2048 * 1024););
#elif MOE_F32B
    PH(24, GEMM_MOE_F(EpiSwiGLU, true, A1, args.in[I_WG] + (size_t)32 * 2048 * 1024, args.in[I_WU] + (size_t)32 * 2048 * 1024, 2048 * 1024, 1024, 128, 0, DM, 1, (bf16*)(ws + WS_U), DE););
    PH(25, GEMM_MOE_F(EpiStoreBf16, false, ws + WS_U, args.in[I_WD] + (size_t)32 * 1024 * 2048, args.in[I_WD] + (size_t)32 * 1024 * 2048, 1024 * 2048, 2048, 256, 128, DE, 1, (bf16*)(ws + WS_YS), DM, 7););
#else
    PHF(24, GEMM_MOE(0, EpiSwiGLU, true, A1, (const bf16*)(ws + WS_WGU) + (size_t)32 * 2048 * 2048, DM, 1, (bf16*)(ws + WS_U), DE); FILL_UNTIL(NCHUNK););
    PH(25, GEMM_MOE(0, EpiStoreBf16, false, ws + WS_U, (const bf16*)(ws + WS_WDN) + (size_t)32 * 2048 * 1024, DE, 1, (bf16*)(ws + WS_YS), DM, 7););
#endif
    PH(26, p_final(F, args.out););
#undef IN
#undef SEAM
}

extern "C" void kernel_launch(void* const* d_in, const int* in_sizes, int n_in, void* d_out, int out_size, void* d_ws, size_t ws_size, hipStream_t stream) {
    static int grid = 0;
    if (grid == 0) {
        if (n_in != 35 || out_size != NB * SEQ * DM || ws_size < WS_END) { fprintf(stderr, "kernel_launch: unexpected shapes: n_in %d out %d ws %zu (need %zu)\n", n_in, out_size, ws_size, (size_t)WS_END); grid = -1; return; }
        int dev = 0, cus = 0, per_cu = 0;
        if (hipGetDevice(&dev) != hipSuccess || hipDeviceGetAttribute(&cus, hipDeviceAttributeMultiprocessorCount, dev) != hipSuccess) { grid = -1; return; }
        if (hipFuncSetAttribute((const void*)trunk_fwd, hipFuncAttributeMaxDynamicSharedMemorySize, LDS_BYTES) != hipSuccess) { fprintf(stderr, "kernel_launch: hipFuncSetAttribute failed\n"); grid = -1; return; }
        if (hipOccupancyMaxActiveBlocksPerMultiprocessor(&per_cu, (const void*)trunk_fwd, NWAVES * 64, LDS_BYTES) != hipSuccess || per_cu < 1)
            fprintf(stderr, "kernel_launch: occupancy query reports %d workgroups per CU\n", per_cu);
        (void)hipGetLastError();
        grid = cus;
    }
    if (grid < 0) return;
    if (hipMemsetAsync((char*)d_ws + WS_CTL, 0, CTL_ZERO_BYTES, stream) != hipSuccess) { fprintf(stderr, "kernel_launch: memset failed\n"); return; }
    if (hipMemsetAsync((char*)d_ws + WS_POS, 0, (size_t)2 * NE * POSCAP * 4, stream) != hipSuccess) { fprintf(stderr, "kernel_launch: memset failed\n"); return; }
    Args a{};
    for (int i = 0; i < 35; ++i) a.in[i] = (const float*)d_in[i];
    a.out = (float*)d_out; a.ws = (unsigned char*)d_ws;
#if MK_PER_PHASE
    for (int p = 0; p < NPHASE; ++p) { a.ph_lo = p; a.ph_hi = p + 1; hipLaunchKernelGGL(trunk_fwd, dim3(grid), dim3(NWAVES * 64), LDS_BYTES, stream, a); }
#else
    a.ph_lo = 0; a.ph_hi = NPHASE; hipLaunchKernelGGL(trunk_fwd, dim3(grid), dim3(NWAVES * 64), LDS_BYTES, stream, a);
#endif
    const hipError_t le = hipPeekAtLastError();
    if (le != hipSuccess) fprintf(stderr, "kernel_launch: launch failed: %s\n", hipGetErrorName(le));
}
```

```cpp
#include <hip/hip_runtime.h>
#include <cstdio>
#include <cstdint>
__device__ __forceinline__ int lane_id_() { return (int)__builtin_amdgcn_mbcnt_hi(~0u, __builtin_amdgcn_mbcnt_lo(~0u, 0u)); }
#define MK_PER_PHASE 0
namespace pg8 {
#define PG8_LAS __attribute__((address_space(3)))
typedef unsigned short bf16_t;
typedef short bf16x8 __attribute__((ext_vector_type(8)));
typedef float f32x4 __attribute__((ext_vector_type(4)));
typedef unsigned u32x4 __attribute__((ext_vector_type(4)));
constexpr int BM = 256, BK = 64, HALF = 128, HTB = HALF * BK * 2  , STAGE_BYTES = 8 * HTB, NXCD = 8, WGM = 8;

__host__ __device__ __forceinline__ int lds_byte(int r, int c) { const int st = (r >> 4) * 2 + (c >> 5), rr = r & 15, cc = c & 31, ob = rr * 64 + cc * 2; return st * 1024 + (ob ^ (((ob >> 9) & 1) << 5)); }
__host__ __device__ __forceinline__ void stage_rc(int b, int& R, int& C) { const int st = b / 1024, sb = b % 1024, swz = sb ^ (((sb >> 9) & 1) << 5); R = (st >> 1) * 16 + swz / 64; C = (st & 1) * 32 + (swz % 64) / 2; }
__host__ __device__ __forceinline__ int perm32(int rho) { const int n = rho >> 4, i = rho & 15; return 8 * (i >> 2) + 4 * n + (i & 3); }

struct Unit { int pm, pn, ko, kt, gb; };
struct Gemm { const bf16_t* A; const bf16_t* Bt; int lda, ldb, K; const int* rowidx; };

struct StaticOrder {
    int nM, nN, nwg, G, c;
    __host__ __device__ void init(int M, int N, int G_, int c_) { nM = M / BM; nN = N / BM; nwg = nM * nN; G = G_; c = c_; }
    __host__ __device__ bool next(int i, Unit& u) const {
        const long L = (long)i * G + c; if (L >= nwg) return false;
        int wgid = (int)L; { const int q = nwg / NXCD, r = nwg % NXCD, xcd = wgid % NXCD, off = wgid / NXCD; wgid = (xcd < r ? xcd * (q + 1) : r * (q + 1) + (xcd - r) * q) + off; }
        const int nig = WGM * nN, gid = wgid / nig, fm = gid * WGM, gsz = (nM - fm) < WGM ? (nM - fm) : WGM;
        u.pm = fm + ((wgid % nig) % gsz); u.pn = (wgid % nig) / gsz; u.ko = 0; u.kt = 0; u.gb = u.pm * BM; return true;
    }
    __device__ __forceinline__ void a_ready(const Unit&) const {}
    __device__ __forceinline__ void done(const Unit&) const {}
};


__device__ __forceinline__ unsigned cvt_pk_bf16(float lo, float hi) { unsigned r; asm volatile("v_cvt_pk_bf16_f32 %0, %1, %2" : "=v"(r) : "v"(lo), "v"(hi)); return r; }

#ifndef EPI_NT_STORE
#define EPI_NT_STORE 0
#endif
struct EpiStoreBf16 {
    static constexpr bool PERM = true, AFTER_DRAIN = false;
    bf16_t* O; int ldc; int pn_mask;
    __device__ __forceinline__ void operator()(const f32x4 (&acc)[2][2][4][2], const Unit& u, int wr, int wc, int fr, int fq) const {
        const int row0 = u.pm * BM + wr * 64 + fr, col0 = (u.pn & pn_mask) * BM + wc * 32 + 8 * fq;
#pragma unroll
        for (int ai = 0; ai < 2; ++ai)
#pragma unroll
            for (int m = 0; m < 4; ++m) { bf16_t* rowp = O + (size_t)(row0 + ai * HALF + m * 16) * ldc + col0;
#pragma unroll
                for (int bj = 0; bj < 2; ++bj) { const f32x4 v0 = acc[ai][bj][m][0], v1 = acc[ai][bj][m][1];
                    u32x4 w; w.x = cvt_pk_bf16(v0[0], v0[1]); w.y = cvt_pk_bf16(v0[2], v0[3]); w.z = cvt_pk_bf16(v1[0], v1[1]); w.w = cvt_pk_bf16(v1[2], v1[3]);
#if EPI_NT_STORE
                    __builtin_nontemporal_store(w, (u32x4*)(rowp + bj * HALF)); } }
#else
                    *(u32x4*)(rowp + bj * HALF) = w; } }
#endif
    }
};
__device__ __forceinline__ float silu_f(float x) { return x * __builtin_amdgcn_rcpf(1.0f + __builtin_amdgcn_exp2f(-1.4426950408889634f * x)); }
struct EpiSwiGLU {
    static constexpr bool PERM = true, AFTER_DRAIN = false;
    bf16_t* O; int ldc;
    __device__ __forceinline__ void operator()(const f32x4 (&acc)[2][2][4][2], const Unit& u, int wr, int wc, int fr, int fq) const {
        const int row0 = u.pm * BM + wr * 64 + fr, col0 = (u.pn & 7) * HALF + wc * 32 + 8 * fq;
#pragma unroll
        for (int ai = 0; ai < 2; ++ai)
#pragma unroll
            for (int m = 0; m < 4; ++m) { bf16_t* rowp = O + (size_t)(row0 + ai * HALF + m * 16) * ldc + col0;
                const f32x4 g0 = acc[ai][0][m][0], g1 = acc[ai][0][m][1], u0 = acc[ai][1][m][0], u1 = acc[ai][1][m][1];
                u32x4 w; w.x = cvt_pk_bf16(silu_f(g0[0]) * u0[0], silu_f(g0[1]) * u0[1]); w.y = cvt_pk_bf16(silu_f(g0[2]) * u0[2], silu_f(g0[3]) * u0[3]);
                w.z = cvt_pk_bf16(silu_f(g1[0]) * u1[0], silu_f(g1[1]) * u1[1]); w.w = cvt_pk_bf16(silu_f(g1[2]) * u1[2], silu_f(g1[3]) * u1[3]);
                *(u32x4*)rowp = w; }
    }
};
__device__ __forceinline__ float bf_lo(unsigned w) { return __builtin_bit_cast(float, w << 16); }
__device__ __forceinline__ float bf_hi(unsigned w) { return __builtin_bit_cast(float, w & 0xffff0000u); }
struct EpiResid {
    static constexpr bool PERM = true, AFTER_DRAIN = false;
    bf16_t* H; const float* modg;
    __device__ __forceinline__ void operator()(const f32x4 (&acc)[2][2][4][2], const Unit& u, int wr, int wc, int fr, int fq) const {
        const int row0 = u.pm * BM + wr * 64 + fr, col0 = u.pn * BM + wc * 32 + 8 * fq;
        const int j = (u.pm % 9 == 0) ? 8 : (u.pm / 9);
        const float* g = modg + (size_t)j * 12288 + col0;
        f32x4 gv[2][2];
#pragma unroll
        for (int bj = 0; bj < 2; ++bj)
#pragma unroll
            for (int n = 0; n < 2; ++n) gv[bj][n] = *(const f32x4*)(g + bj * HALF + 4 * n);
#pragma unroll
        for (int ai = 0; ai < 2; ++ai)
#pragma unroll
            for (int m = 0; m < 4; ++m) { bf16_t* rowp = H + (size_t)(row0 + ai * HALF + m * 16) * 2048 + col0;
#pragma unroll
                for (int bj = 0; bj < 2; ++bj) { u32x4* p = (u32x4*)(rowp + bj * HALF); const u32x4 h = *p;
                    const f32x4 a0 = gv[bj][0] * acc[ai][bj][m][0], a1 = gv[bj][1] * acc[ai][bj][m][1];
                    u32x4 w; w.x = cvt_pk_bf16(bf_lo(h.x) + a0[0], bf_hi(h.x) + a0[1]); w.y = cvt_pk_bf16(bf_lo(h.y) + a0[2], bf_hi(h.y) + a0[3]);
                    w.z = cvt_pk_bf16(bf_lo(h.z) + a1[0], bf_hi(h.z) + a1[1]); w.w = cvt_pk_bf16(bf_lo(h.w) + a1[2], bf_hi(h.w) + a1[3]);
                    *p = w; } }
    }
};
struct EpiResidInit {
    static constexpr bool PERM = true, AFTER_DRAIN = false;
    bf16_t* H; const float* modg; const float* xin; const float* ctxin;
    __device__ __forceinline__ void operator()(const f32x4 (&acc)[2][2][4][2], const Unit& u, int wr, int wc, int fr, int fq) const {
        const int rl0 = wr * 64 + fr, col0 = u.pn * BM + wc * 32 + 8 * fq;
        const int b = u.pm / 9, t = u.pm - 9 * b, j = (t == 0) ? 8 : b;
        const float* src = (t == 0) ? ctxin + (size_t)(b * 256) * 2048 : xin + (size_t)(b * 2048 + (t - 1) * 256) * 2048;
        const float* g = modg + (size_t)j * 12288 + col0;
        f32x4 gv[2][2];
#pragma unroll
        for (int bj = 0; bj < 2; ++bj)
#pragma unroll
            for (int n = 0; n < 2; ++n) gv[bj][n] = *(const f32x4*)(g + bj * HALF + 4 * n);
#pragma unroll
        for (int ai = 0; ai < 2; ++ai)
#pragma unroll
            for (int m = 0; m < 4; ++m) { const int rl = rl0 + ai * HALF + m * 16; bf16_t* rowp = H + (size_t)(u.pm * BM + rl) * 2048 + col0; const float* srow = src + (size_t)rl * 2048 + col0;
#pragma unroll
                for (int bj = 0; bj < 2; ++bj) { const f32x4 h0 = *(const f32x4*)(srow + bj * HALF), h1 = *(const f32x4*)(srow + bj * HALF + 4);
                    const f32x4 v0 = h0 + gv[bj][0] * acc[ai][bj][m][0], v1 = h1 + gv[bj][1] * acc[ai][bj][m][1];
                    u32x4 w; w.x = cvt_pk_bf16(v0[0], v0[1]); w.y = cvt_pk_bf16(v0[2], v0[3]); w.z = cvt_pk_bf16(v1[0], v1[1]); w.w = cvt_pk_bf16(v1[2], v1[3]);
                    *(u32x4*)(rowp + bj * HALF) = w; } }
    }
};
struct EpiLogits {
    static constexpr bool PERM = false, AFTER_DRAIN = false;
    float* LG; int kslice; size_t slice_stride;
    __device__ __forceinline__ void operator()(const f32x4 (&acc)[2][2][4][2], const Unit& u, int wr, int wc, int fr, int fq) const {
        if (wc >= 2) return;
        const int row0 = u.pm * BM + wr * 64 + fr, col0 = wc * 32 + 4 * fq;
        float* base = LG + (size_t)(u.ko / kslice) * slice_stride;
#pragma unroll
        for (int ai = 0; ai < 2; ++ai)
#pragma unroll
            for (int m = 0; m < 4; ++m) { float* rowp = base + (size_t)(row0 + ai * HALF + m * 16) * 64 + col0;
#pragma unroll
                for (int n = 0; n < 2; ++n) *(f32x4*)(rowp + n * 16) = acc[ai][0][m][n]; }
    }
};
struct SplitKOrder {
    int nM, KS, kslice, G, c;
    __device__ void init(int nM_, int KS_, int kslice_, int G_, int c_) { nM = nM_; KS = KS_; kslice = kslice_; G = G_; c = c_; }
    __device__ bool next(int i, Unit& u) const { const long L = (long)i * G + c; if (L >= (long)nM * KS) return false; const int ks = (int)L / nM; u.pm = (int)L - ks * nM; u.pn = 0; u.ko = ks * kslice; u.kt = 0; u.gb = 0; return true; }
    __device__ __forceinline__ void a_ready(const Unit&) const {}
    __device__ __forceinline__ void done(const Unit&) const {}
};
struct EvenInOrder {
    StaticOrder so; int G, c;
    __device__ void init(int M, int G_, int c_) { so.init(M, 2560, G_, c_); G = G_; c = c_; }
    __device__ bool next(int i, Unit& u) const {
        if (so.next(i, u)) return true;
        const long L = (long)i * G + c - so.nwg; if (L < 0 || L >= 72 * 4) return false;
        const int ks = (int)L / 72; u.pm = (int)L - ks * 72; u.pn = 10; u.ko = ks * 512; u.kt = 8; u.gb = 0; return true;
    }
    __device__ __forceinline__ void a_ready(const Unit&) const {}
    __device__ __forceinline__ void done(const Unit&) const {}
};
struct EpiEvenIn {
    static constexpr bool PERM = true, AFTER_DRAIN = false;
    bf16_t* Y; float* KRP;
    __device__ __forceinline__ void operator()(const f32x4 (&acc)[2][2][4][2], const Unit& u, int wr, int wc, int fr, int fq) const {
        if (u.pn < 10) { const EpiStoreBf16 e{Y, 2816, 0x7fffffff}; e(acc, u, wr, wc, fr, fq); return; }
        if (wc >= 2) return;
        const int row0 = u.pm * BM + wr * 64 + fr, col0 = wc * 32 + 8 * fq;
        float* base = KRP + (size_t)(u.ko >> 9) * ((size_t)18432 * 64);
#pragma unroll
        for (int ai = 0; ai < 2; ++ai)
#pragma unroll
            for (int m = 0; m < 4; ++m) { float* rowp = base + (size_t)(row0 + ai * HALF + m * 16) * 64 + col0;
#pragma unroll
                for (int n = 0; n < 2; ++n) *(f32x4*)(rowp + 4 * n) = acc[ai][0][m][n]; }
    }
};
struct Proj2Order {
    StaticOrder s1, s2; int G, c;
    __device__ void init(int M, int G_, int c_) { s1.init(M, 1536, G_, c_); s2.init(M, 2048, G_, c_); G = G_; c = c_; }
    __device__ bool next(int i, Unit& u) const {
        if (s1.next(i, u)) return true;
        StaticOrder t = s2; const long L = (long)i * G + c - s1.nwg; if (L < 0 || L >= s2.nwg) return false;
        t.G = 1; t.c = (int)L; if (!t.next(0, u)) return false;
        u.pm += 72; u.pn += 8; return true;
    }
    __device__ __forceinline__ void a_ready(const Unit&) const {}
    __device__ __forceinline__ void done(const Unit&) const {}
};
struct EpiProj2 {
    static constexpr bool PERM = true, AFTER_DRAIN = false;
    bf16_t* QB; bf16_t* KV;
    __device__ __forceinline__ void operator()(const f32x4 (&acc)[2][2][4][2], const Unit& u, int wr, int wc, int fr, int fq) const {
        if (u.pm < 72) { const EpiStoreBf16 e{QB, 1536, 0x7fffffff}; e(acc, u, wr, wc, fr, fq); }
        else { Unit v = u; v.pm -= 72; v.pn -= 8; const EpiStoreBf16 e{KV, 2048, 0x7fffffff}; e(acc, v, wr, wc, fr, fq); }
    }
};
struct XOnlyOrder {
    StaticOrder so;
    __device__ void init(int N, int G_, int c_) { so.init(64 * BM, N, G_, c_); }
    __device__ bool next(int i, Unit& u) const { if (!so.next(i, u)) return false; u.pm = 9 * (u.pm >> 3) + 1 + (u.pm & 7); return true; }
    __device__ __forceinline__ void a_ready(const Unit&) const {}
    __device__ __forceinline__ void done(const Unit&) const {}
};
struct OddInOrder {
    StaticOrder so; int G, c;
    __device__ void init(int G_, int c_) { so.init(64 * BM, 18 * BM, G_, c_); G = G_; c = c_; }
    __device__ bool next(int i, Unit& u) const {
        if (so.next(i, u)) { u.pm = 9 * (u.pm >> 3) + 1 + (u.pm & 7); return true; }
        const long L = (long)i * G + c - 64 * 18; if (L >= 80) return false;
        const int b = (int)L / 10, j = (int)L - b * 10; u.pm = 9 * b; u.pn = j < 8 ? 4 + j : 8 + j; u.ko = 0; u.kt = 0; u.gb = 0; return true;
    }
    __device__ __forceinline__ void a_ready(const Unit&) const {}
    __device__ __forceinline__ void done(const Unit&) const {}
};
struct SplitKXOrder {
    int KS, kslice, G, c;
    __device__ void init(int KS_, int kslice_, int G_, int c_) { KS = KS_; kslice = kslice_; G = G_; c = c_; }
    __device__ bool next(int i, Unit& u) const { const long L = (long)i * G + c; if (L >= 64L * KS) return false; const int ks = (int)L / 64, x = (int)L - ks * 64; u.pm = 9 * (x >> 3) + 1 + (x & 7); u.pn = 0; u.ko = ks * kslice; u.kt = 0; u.gb = 0; return true; }
    __device__ __forceinline__ void a_ready(const Unit&) const {}
    __device__ __forceinline__ void done(const Unit&) const {}
};
struct MoeOrder {
    const PG8_LAS int* texp; const PG8_LAS int* frt; int nunits, G, c, cap;
    __device__ void init(const PG8_LAS int* texp_, const PG8_LAS int* frt_, int n_row_tiles, int cap_, int G_, int c_) { texp = texp_; frt = frt_; nunits = n_row_tiles * 8; cap = cap_; G = G_; c = c_; }
    __device__ bool next(int i, Unit& u) const {
        const long L = (long)i * G + c; if (L >= nunits) return false;
        int wgid = (int)L; { const int q = nunits / NXCD, r = nunits % NXCD, xcd = wgid % NXCD, off = wgid / NXCD; wgid = (xcd < r ? xcd * (q + 1) : r * (q + 1) + (xcd - r) * q) + off; }
        const int rt = wgid >> 3, pn = wgid & 7, e = __builtin_amdgcn_readfirstlane(texp[rt]);
        u.pm = rt; u.pn = e * 8 + pn; u.ko = 0; u.kt = 0; u.gb = e * cap + (rt - __builtin_amdgcn_readfirstlane(frt[e])) * BM; return true;
    }
    __device__ __forceinline__ void a_ready(const Unit&) const {}
    __device__ __forceinline__ void done(const Unit&) const {}
};

struct MoePublishOrder : MoeOrder {
    unsigned* ready;
    __device__ __forceinline__ void done(const Unit& u) const {
        asm volatile("s_waitcnt vmcnt(0)" ::: "memory");
        if (lane_id_() == 0) __hip_atomic_fetch_add(ready + 64 * u.pm, 1u, __ATOMIC_RELAXED, __HIP_MEMORY_SCOPE_AGENT);
    }
};
struct MoeCountedOrder : MoeOrder {
    unsigned* ready; unsigned need; unsigned* tmo; int wv;
    __device__ bool next(int i, Unit& u) const {
        const int k0 = (nunits - c + G - 1) / G;
        const long l = (long)c + (long)(k0 + i) * G - nunits; if (l >= nunits) return false;
        int wgid = (int)l; { const int q = nunits / NXCD, r = nunits % NXCD, xcd = wgid % NXCD, off = wgid / NXCD; wgid = (xcd < r ? xcd * (q + 1) : r * (q + 1) + (xcd - r) * q) + off; }
        const int rt = wgid >> 3, pn = wgid & 7, e = __builtin_amdgcn_readfirstlane(texp[rt]);
        u.pm = rt; u.pn = e * 8 + pn; u.ko = 0; u.kt = 0; u.gb = 0; return true;
    }
    __device__ __forceinline__ void a_ready(const Unit& u) const {
        if (wv == 0) {
            const unsigned long long t0 = __builtin_amdgcn_s_memrealtime(); unsigned polls = 0;
            while ((unsigned)__builtin_amdgcn_readfirstlane(__hip_atomic_load(ready + 64 * u.pm, __ATOMIC_RELAXED, __HIP_MEMORY_SCOPE_AGENT)) < need) {
                if ((++polls & 255u) == 0u && __builtin_amdgcn_readfirstlane(__hip_atomic_load(tmo, __ATOMIC_RELAXED, __HIP_MEMORY_SCOPE_AGENT)) != 0u) break;
                if (__builtin_amdgcn_s_memrealtime() - t0 > 2000000ull) {
                    if (lane_id_() == 0) __hip_atomic_store(tmo, 1u, __ATOMIC_RELAXED, __HIP_MEMORY_SCOPE_AGENT);
                    break; }
                __builtin_amdgcn_s_sleep(2); }
            __builtin_amdgcn_fence(__ATOMIC_ACQUIRE, "agent");
            asm volatile("s_waitcnt vmcnt(0)" ::: "memory");
        }
        asm volatile("" ::: "memory"); __builtin_amdgcn_s_barrier(); asm volatile("" ::: "memory");
    }
};
struct EpiSwiGLUwt {
    static constexpr bool PERM = true, AFTER_DRAIN = false;
    bf16_t* O; int ldc;
    __device__ __forceinline__ void operator()(const f32x4 (&acc)[2][2][4][2], const Unit& u, int wr, int wc, int fr, int fq) const {
        const int row0 = u.pm * BM + wr * 64 + fr, col0 = (u.pn & 7) * HALF + wc * 32 + 8 * fq;
        const __amdgpu_buffer_rsrc_t rsrc = __builtin_amdgcn_make_buffer_rsrc((void*)O, 0, 0x7fffffff, 0x00020000);
#pragma unroll
        for (int ai = 0; ai < 2; ++ai)
#pragma unroll
            for (int m = 0; m < 4; ++m) { const unsigned off = (unsigned)(((size_t)(row0 + ai * HALF + m * 16) * ldc + col0) * 2);
                const f32x4 g0 = acc[ai][0][m][0], g1 = acc[ai][0][m][1], u0 = acc[ai][1][m][0], u1 = acc[ai][1][m][1];
                u32x4 w; w.x = cvt_pk_bf16(silu_f(g0[0]) * u0[0], silu_f(g0[1]) * u0[1]); w.y = cvt_pk_bf16(silu_f(g0[2]) * u0[2], silu_f(g0[3]) * u0[3]);
                w.z = cvt_pk_bf16(silu_f(g1[0]) * u1[0], silu_f(g1[1]) * u1[1]); w.w = cvt_pk_bf16(silu_f(g1[2]) * u1[2], silu_f(g1[3]) * u1[3]);
                __builtin_amdgcn_raw_buffer_store_b128(w, rsrc, (int)off, 0, 16  ); }
    }
};
}
namespace pg8 {
template <class Epi, class Sched, bool GATHER = false>
__device__ __forceinline__ void gemm_phase(PG8_LAS unsigned char* lds, const Gemm g, const Sched& S, const Epi& E, int wv) {
    int tid = wv * 64 + lane_id_(); asm volatile("" : "+v"(tid));
    const int wid = __builtin_amdgcn_readfirstlane(tid >> 6), lane = tid & 63, wr = wid >> 2, wc = wid & 3, fr = lane & 15, fq = lane >> 4;
    const int K = g.K, lda = g.lda, ldb = g.ldb;
    unsigned va[2][2], vn[2][2], voffB[2]; int sR[2], sC[2];
#pragma unroll
    for (int i = 0; i < 2; ++i) { int R, C; stage_rc(tid * 16 + i * 8192, R, C); const int Rb = Epi::PERM ? ((R & ~31) + perm32(R & 31)) : R; sR[i] = R; sC[i] = C;
        voffB[i] = (unsigned)(Rb * ldb + C) * 2u;
        va[0][i] = (unsigned)(R * lda + C) * 2u; va[1][i] = (unsigned)((R + HALF) * lda + C) * 2u; vn[0][i] = va[0][i]; vn[1][i] = va[1][i]; }
    const size_t kstep = (size_t)(BK * 2);
    const size_t hstepB = (size_t)HALF * ldb * 2;
    const size_t tstepA = (size_t)BM * lda * 2, tstepB = (size_t)BM * ldb * 2;
    const unsigned ldsw = (unsigned)wid * 1024u;
    const int aoff = lds_byte(wr * 64 + fr, fq * 8), boff = lds_byte(wc * 32 + fr, fq * 8);
#define PG8_SA(b, h) (((b) * 2 + (h)) * HTB)
#define PG8_SB(b, h) ((4 + (b) * 2 + (h)) * HTB)
#define PG8_STAGE(bufoff, gbase, voff) do { _Pragma("unroll") for (int _i = 0; _i < 2; ++_i) \
        __builtin_amdgcn_global_load_lds((const unsigned*)((const char*)(gbase) + (voff)[_i]), (PG8_LAS unsigned*)(lds + (bufoff) + ldsw + _i * 8192), 16, 0, 0); } while (0)
#define PG8_LDA(dst, b, h) do { _Pragma("unroll") for (int m = 0; m < 4; ++m) _Pragma("unroll") for (int k = 0; k < 2; ++k) dst[m][k] = *(const PG8_LAS bf16x8*)(lds + PG8_SA(b, h) + aoff + m * 2048 + k * 1024); } while (0)
#define PG8_LDB(dst, b, h) do { _Pragma("unroll") for (int n = 0; n < 2; ++n) _Pragma("unroll") for (int k = 0; k < 2; ++k) dst[n][k] = *(const PG8_LAS bf16x8*)(lds + PG8_SB(b, h) + boff + n * 2048 + k * 1024); } while (0)
#define PG8_MMA(ai, bj, At, Bt) do { __builtin_amdgcn_s_setprio(1); _Pragma("unroll") for (int m = 0; m < 4; ++m) _Pragma("unroll") for (int n = 0; n < 2; ++n) _Pragma("unroll") for (int k = 0; k < 2; ++k) \
        acc[ai][bj][m][n] = __builtin_amdgcn_mfma_f32_16x16x32_bf16(Bt[n][k], At[m][k], acc[ai][bj][m][n], 0, 0, 0); __builtin_amdgcn_s_setprio(0); } while (0)
#define PG8_WAIT_V(n) asm volatile("s_waitcnt vmcnt(" #n ")" ::: "memory")
#define PG8_WAIT_L(n) asm volatile("s_waitcnt lgkmcnt(" #n ")" ::: "memory")
#define PG8_BAR __builtin_amdgcn_s_barrier()
#define PG8_SCHED __builtin_amdgcn_sched_barrier(0)
#define PG8_GATHER_OFFS(dst, u) do { if constexpr (GATHER) { _Pragma("unroll") for (int _h = 0; _h < 2; ++_h) _Pragma("unroll") for (int _i = 0; _i < 2; ++_i) \
        dst[_h][_i] = (unsigned)(g.rowidx[(u).gb + _h * HALF + sR[_i]] * lda + sC[_i]) * 2u; } } while (0)
    Unit cur, nxt; int ui = 0;
    if (!S.next(0, cur)) return;
    f32x4 acc[2][2][4][2];
#pragma unroll
    for (int a = 0; a < 2; ++a)
#pragma unroll
        for (int b = 0; b < 2; ++b)
#pragma unroll
            for (int m = 0; m < 4; ++m)
#pragma unroll
                for (int n = 0; n < 2; ++n) acc[a][b][m][n] = (f32x4){0.f, 0.f, 0.f, 0.f};
    bf16x8 At[4][2], B0[2][2], B1[2][2];
    const char* cA = (const char*)g.A + (GATHER ? (size_t)0 : (size_t)cur.pm * tstepA) + (size_t)cur.ko * 2; const char* cB = (const char*)g.Bt + (size_t)cur.pn * tstepB + (size_t)cur.ko * 2;
    PG8_GATHER_OFFS(va, cur);
    S.a_ready(cur);
    PG8_STAGE(PG8_SB(0, 0), cB, voffB); PG8_STAGE(PG8_SB(0, 1), cB + hstepB, voffB); PG8_STAGE(PG8_SA(0, 0), cA, va[0]); PG8_STAGE(PG8_SA(0, 1), cA, va[1]);
    if (wr == 1) PG8_BAR;
    PG8_WAIT_V(2); PG8_BAR;
    PG8_STAGE(PG8_SB(1, 0), cB + kstep, voffB); PG8_STAGE(PG8_SA(1, 0), cA + kstep, va[0]); PG8_STAGE(PG8_SB(1, 1), cB + hstepB + kstep, voffB);
    PG8_WAIT_V(6); PG8_BAR;
    for (;;) {
        const bool has_next = S.next(ui + 1, nxt);
        const char* nA = has_next ? (const char*)g.A + (GATHER ? (size_t)0 : (size_t)nxt.pm * tstepA) + (size_t)nxt.ko * 2 : cA; const char* nB = has_next ? (const char*)g.Bt + (size_t)nxt.pn * tstepB + (size_t)nxt.ko * 2 : cB;
        if constexpr (GATHER) { if (has_next) PG8_GATHER_OFFS(vn, nxt); else { _Pragma("unroll") for (int _h = 0; _h < 2; ++_h) _Pragma("unroll") for (int _i = 0; _i < 2; ++_i) vn[_h][_i] = va[_h][_i]; } }
        const int nt = K / BK;
        for (int t = 0; t < nt; t += 2) {
            const bool last = (t == nt - 2);
            const char* a1 = cA + (size_t)(t + 1) * kstep;
            const char* a2 = last ? nA : cA + (size_t)(t + 2) * kstep; const char* b2 = last ? nB : cB + (size_t)(t + 2) * kstep;
            const char* a3 = a2 + kstep; const char* b3 = b2 + kstep;
            unsigned v2[2][2];
#pragma unroll
            for (int _h = 0; _h < 2; ++_h)
#pragma unroll
                for (int _i = 0; _i < 2; ++_i) v2[_h][_i] = (GATHER && last) ? vn[_h][_i] : va[_h][_i];
            if (last && has_next) S.a_ready(nxt);
            PG8_LDB(B0, 0, 0); PG8_LDB(B1, 0, 1); PG8_SCHED; PG8_LDA(At, 0, 0); PG8_STAGE(PG8_SA(1, 1), a1, va[1]);
            PG8_WAIT_V(8); PG8_WAIT_L(0); PG8_BAR; PG8_MMA(0, 0, At, B0); PG8_MMA(0, 1, At, B1); PG8_BAR; PG8_SCHED;
            PG8_LDA(At, 0, 1); PG8_STAGE(PG8_SB(0, 0), b2, voffB); PG8_STAGE(PG8_SB(0, 1), b2 + hstepB, voffB); PG8_STAGE(PG8_SA(0, 0), a2, v2[0]);
            PG8_WAIT_V(8); PG8_WAIT_L(0); PG8_BAR; PG8_MMA(1, 0, At, B0); PG8_MMA(1, 1, At, B1); PG8_BAR; PG8_SCHED;
            PG8_LDB(B0, 1, 0); PG8_LDB(B1, 1, 1); PG8_SCHED; PG8_LDA(At, 1, 0); PG8_STAGE(PG8_SA(0, 1), a2, v2[1]);
            PG8_WAIT_V(8); PG8_WAIT_L(0); PG8_BAR; PG8_MMA(0, 0, At, B0); PG8_MMA(0, 1, At, B1); PG8_BAR; PG8_SCHED;
            PG8_LDA(At, 1, 1); PG8_STAGE(PG8_SB(1, 0), b3, voffB); PG8_STAGE(PG8_SB(1, 1), b3 + hstepB, voffB); PG8_STAGE(PG8_SA(1, 0), a3, v2[0]);
            PG8_WAIT_V(8); PG8_WAIT_L(0); PG8_BAR; PG8_MMA(1, 0, At, B0); PG8_MMA(1, 1, At, B1); PG8_BAR; PG8_SCHED;
        }
        if (wr == 0) PG8_BAR;
        E(acc, cur, wr, wc, fr, fq); S.done(cur);
        if (!has_next) break;
#pragma unroll
        for (int a = 0; a < 2; ++a)
#pragma unroll
            for (int b = 0; b < 2; ++b)
#pragma unroll
                for (int m = 0; m < 4; ++m)
#pragma unroll
                    for (int n = 0; n < 2; ++n) acc[a][b][m][n] = (f32x4){0.f, 0.f, 0.f, 0.f};
        cur = nxt; cA = nA; cB = nB; ++ui;
        if constexpr (GATHER) { _Pragma("unroll") for (int _h = 0; _h < 2; ++_h) _Pragma("unroll") for (int _i = 0; _i < 2; ++_i) va[_h][_i] = vn[_h][_i]; }
        if (wr == 1) PG8_BAR;
    }
    PG8_WAIT_V(0);
    PG8_BAR;
#undef PG8_SA
#undef PG8_SB
#undef PG8_STAGE
#undef PG8_LDA
#undef PG8_LDB
#undef PG8_MMA
#undef PG8_WAIT_V
#undef PG8_WAIT_L
#undef PG8_BAR
#undef PG8_SCHED
#undef PG8_GATHER_OFFS
}
typedef unsigned u32x2 __attribute__((ext_vector_type(2)));
struct BSrc { const float* m0; const float* m1; size_t estride; int ldn, colmul, hoff; };
template <class Epi, class Sched, bool GATHER = false>
__device__ __forceinline__ void gemm_phase_f32b(PG8_LAS unsigned char* lds, const Gemm g, const BSrc bs, const Sched& S, const Epi& E, int wv) {
    int tid = wv * 64 + lane_id_(); asm volatile("" : "+v"(tid));
    const int wid = __builtin_amdgcn_readfirstlane(tid >> 6), lane = tid & 63, wr = wid >> 2, wc = wid & 3, fr = lane & 15, fq = lane >> 4;
    const int K = g.K, lda = g.lda;
    unsigned va00, va01, va10, va11, vn00, vn01, vn10, vn11;
#pragma unroll
    for (int i = 0; i < 2; ++i) { int R, C; stage_rc(tid * 16 + i * 8192, R, C);
        const unsigned o0_ = (unsigned)(R * lda + C) * 2u, o1_ = (unsigned)((R + HALF) * lda + C) * 2u; if (i == 0) { va00 = o0_; va10 = o1_; } else { va01 = o0_; va11 = o1_; } }
    vn00 = va00; vn01 = va01; vn10 = va10; vn11 = va11;
    const size_t kstep = (size_t)(BK * 2);
    const size_t tstepA = (size_t)BM * lda * 2;
    const int kq = lane & 15, nq = (lane >> 4) + 4 * wid;
    const int brow = (nq >> 3) * 32 + (Epi::PERM ? (16 * (nq & 1) + 4 * ((nq & 7) >> 1)) : (4 * (nq & 7)));
    const int bwr = lds_byte(brow, 4 * kq);
    const unsigned bvo = (unsigned)((4 * kq) * bs.ldn + 4 * nq) * 4u;
    const size_t bkstep = (size_t)BK * bs.ldn * 4, brstep = (size_t)bs.ldn * 4;
    f32x4 w0, w1, w2, w3;
    const unsigned ldsw = (unsigned)wid * 1024u;
    const int aoff = lds_byte(wr * 64 + fr, fq * 8), boff = lds_byte(wc * 32 + fr, fq * 8);
#define PG8_SA(b, h) (((b) * 2 + (h)) * HTB)
#define PG8_SB(b, h) ((4 + (b) * 2 + (h)) * HTB)
#define PG8_BLOAD(src) do { const char* p0_ = (const char*)(src); const char* p1_ = p0_ + brstep; const char* p2_ = p1_ + brstep; const char* p3_ = p2_ + brstep; \
        asm volatile("s_nop 4\n\tglobal_load_dwordx4 %0, %4, %5\n\tglobal_load_dwordx4 %1, %4, %6\n\tglobal_load_dwordx4 %2, %4, %7\n\tglobal_load_dwordx4 %3, %4, %8" \
                     : "=&v"(w0), "=&v"(w1), "=&v"(w2), "=&v"(w3) : "v"(bvo), "s"(p0_), "s"(p1_), "s"(p2_), "s"(p3_)); } while (0)
#define PG8_BWAIT(n) asm volatile("s_waitcnt vmcnt(" #n ")" : "+v"(w0), "+v"(w1), "+v"(w2), "+v"(w3))
#define PG8_BWRITE(bufoff) do { PG8_LAS unsigned char* d_ = lds + (bufoff) + bwr; \
        { u32x2 c_; c_.x = cvt_pk_bf16(w0[0], w1[0]); c_.y = cvt_pk_bf16(w2[0], w3[0]); *(PG8_LAS u32x2*)(d_) = c_; } \
        { u32x2 c_; c_.x = cvt_pk_bf16(w0[1], w1[1]); c_.y = cvt_pk_bf16(w2[1], w3[1]); *(PG8_LAS u32x2*)(d_ + 64) = c_; } \
        { u32x2 c_; c_.x = cvt_pk_bf16(w0[2], w1[2]); c_.y = cvt_pk_bf16(w2[2], w3[2]); *(PG8_LAS u32x2*)(d_ + 128) = c_; } \
        { u32x2 c_; c_.x = cvt_pk_bf16(w0[3], w1[3]); c_.y = cvt_pk_bf16(w2[3], w3[3]); *(PG8_LAS u32x2*)(d_ + 192) = c_; } } while (0)
#define PG8_BSRC(u, h) ((const char*)(((h) ? bs.m1 : bs.m0) + (size_t)((u).pn >> 3) * bs.estride + (size_t)((u).pn & 7) * bs.colmul + (h) * bs.hoff) + (size_t)(u).ko * brstep)
#define PG8_STAGE(bufoff, gbase, o0, o1) do { \
        __builtin_amdgcn_global_load_lds((const unsigned*)((const char*)(gbase) + (o0)), (PG8_LAS unsigned*)(lds + (bufoff) + ldsw), 16, 0, 0); \
        __builtin_amdgcn_global_load_lds((const unsigned*)((const char*)(gbase) + (o1)), (PG8_LAS unsigned*)(lds + (bufoff) + ldsw + 8192), 16, 0, 0); } while (0)
#define PG8_LDA(dst, b, h) do { _Pragma("unroll") for (int m = 0; m < 4; ++m) _Pragma("unroll") for (int k = 0; k < 2; ++k) dst[m][k] = *(const PG8_LAS bf16x8*)(lds + PG8_SA(b, h) + aoff + m * 2048 + k * 1024); } while (0)
#define PG8_LDB(dst, b, h) do { _Pragma("unroll") for (int n = 0; n < 2; ++n) _Pragma("unroll") for (int k = 0; k < 2; ++k) dst[n][k] = *(const PG8_LAS bf16x8*)(lds + PG8_SB(b, h) + boff + n * 2048 + k * 1024); } while (0)
#define PG8_MMA(ai, bj, At, Bt) do { __builtin_amdgcn_s_setprio(1); _Pragma("unroll") for (int m = 0; m < 4; ++m) _Pragma("unroll") for (int n = 0; n < 2; ++n) _Pragma("unroll") for (int k = 0; k < 2; ++k) \
        acc[ai][bj][m][n] = __builtin_amdgcn_mfma_f32_16x16x32_bf16(Bt[n][k], At[m][k], acc[ai][bj][m][n], 0, 0, 0); __builtin_amdgcn_s_setprio(0); } while (0)
#define PG8_WAIT_V(n) asm volatile("s_waitcnt vmcnt(" #n ")" ::: "memory")
#define PG8_WAIT_L(n) asm volatile("s_waitcnt lgkmcnt(" #n ")" ::: "memory")
#define PG8_BAR __builtin_amdgcn_s_barrier()
#define PG8_SCHED __builtin_amdgcn_sched_barrier(0)
#define PG8_GATHER_OFFS(d00, d01, d10, d11, u) do { if constexpr (GATHER) { const int* ri_ = g.rowidx + (u).gb; int t_ = wv * 64 + lane_id_(); asm volatile("" : "+v"(t_)); \
        int R0_, C0_, R1_, C1_; stage_rc(t_ * 16, R0_, C0_); stage_rc(t_ * 16 + 8192, R1_, C1_);     \
        d00 = (unsigned)(ri_[R0_] * lda + C0_) * 2u; d01 = (unsigned)(ri_[R1_] * lda + C1_) * 2u; \
        d10 = (unsigned)(ri_[HALF + R0_] * lda + C0_) * 2u; d11 = (unsigned)(ri_[HALF + R1_] * lda + C1_) * 2u; } } while (0)
    Unit cur, nxt; int ui = 0;
    if (!S.next(0, cur)) return;
    f32x4 acc[2][2][4][2];
#pragma unroll
    for (int a = 0; a < 2; ++a)
#pragma unroll
        for (int b = 0; b < 2; ++b)
#pragma unroll
            for (int m = 0; m < 4; ++m)
#pragma unroll
                for (int n = 0; n < 2; ++n) acc[a][b][m][n] = (f32x4){0.f, 0.f, 0.f, 0.f};
    bf16x8 At[4][2], B0[2][2], B1[2][2];
    const char* cA = (const char*)g.A + (GATHER ? (size_t)0 : (size_t)cur.pm * tstepA) + (size_t)cur.ko * 2; const char* cB0 = PG8_BSRC(cur, 0); const char* cB1 = PG8_BSRC(cur, 1);
    PG8_GATHER_OFFS(va00, va01, va10, va11, cur);
    S.a_ready(cur);
    PG8_STAGE(PG8_SA(0, 0), cA, va00, va01); PG8_STAGE(PG8_SA(0, 1), cA, va10, va11);
    PG8_BLOAD(cB0); PG8_BWAIT(0); PG8_BWRITE(PG8_SB(0, 0));
    PG8_BLOAD(cB1); PG8_BWAIT(0); PG8_BWRITE(PG8_SB(0, 1));
    PG8_BLOAD(cB0 + bkstep); PG8_BWAIT(0); PG8_BWRITE(PG8_SB(1, 0));
    PG8_BLOAD(cB1 + bkstep); PG8_STAGE(PG8_SA(1, 0), cA + kstep, va00, va01);
    PG8_WAIT_L(0);
    if (wr == 1) PG8_BAR;
    PG8_BAR;
    PG8_BAR;
    for (;;) {
        const bool has_next = S.next(ui + 1, nxt);
        const char* nA = has_next ? (const char*)g.A + (GATHER ? (size_t)0 : (size_t)nxt.pm * tstepA) + (size_t)nxt.ko * 2 : cA; const char* nB0 = has_next ? PG8_BSRC(nxt, 0) : cB0; const char* nB1 = has_next ? PG8_BSRC(nxt, 1) : cB1;
        const int nt = K / BK;
        for (int t = 0; t < nt; t += 2) {
            const bool last = (t == nt - 2);
            const char* a1 = cA + (size_t)(t + 1) * kstep;
            const char* a2 = last ? nA : cA + (size_t)(t + 2) * kstep;
            const char* b20 = last ? nB0 : cB0 + (size_t)(t + 2) * bkstep; const char* b21 = last ? nB1 : cB1 + (size_t)(t + 2) * bkstep;
            const char* a3 = a2 + kstep; const char* b30 = b20 + bkstep; const char* b31 = b21 + bkstep;
            if constexpr (GATHER) { if (last) { if (has_next) PG8_GATHER_OFFS(vn00, vn01, vn10, vn11, nxt); else { vn00 = va00; vn01 = va01; vn10 = va10; vn11 = va11; } } }
            const bool usen_ = GATHER && last;
            const unsigned v200 = usen_ ? vn00 : va00, v201 = usen_ ? vn01 : va01, v210 = usen_ ? vn10 : va10, v211 = usen_ ? vn11 : va11;
            if (last && has_next) S.a_ready(nxt);
            PG8_LDB(B0, 0, 0); PG8_LDB(B1, 0, 1); PG8_SCHED; PG8_LDA(At, 0, 0);
            PG8_BWAIT(2); PG8_BWRITE(PG8_SB(1, 1)); PG8_BLOAD(b20); PG8_STAGE(PG8_SA(1, 1), a1, va10, va11);
            PG8_WAIT_L(0); PG8_BAR; PG8_MMA(0, 0, At, B0); PG8_MMA(0, 1, At, B1); PG8_BAR; PG8_SCHED;
            PG8_LDA(At, 0, 1);
            PG8_BWAIT(2); PG8_BWRITE(PG8_SB(0, 0)); PG8_BLOAD(b21); PG8_STAGE(PG8_SA(0, 0), a2, v200, v201);
            PG8_WAIT_L(0); PG8_BAR; PG8_MMA(1, 0, At, B0); PG8_MMA(1, 1, At, B1); PG8_BAR; PG8_SCHED;
            PG8_LDB(B0, 1, 0); PG8_LDB(B1, 1, 1); PG8_SCHED; PG8_LDA(At, 1, 0);
            PG8_BWAIT(2); PG8_BWRITE(PG8_SB(0, 1)); PG8_BLOAD(b30); PG8_STAGE(PG8_SA(0, 1), a2, v210, v211);
            PG8_WAIT_L(0); PG8_BAR; PG8_MMA(0, 0, At, B0); PG8_MMA(0, 1, At, B1); PG8_BAR; PG8_SCHED;
            PG8_LDA(At, 1, 1);
            PG8_BWAIT(2); PG8_BWRITE(PG8_SB(1, 0)); PG8_BLOAD(b31); PG8_STAGE(PG8_SA(1, 0), a3, v200, v201);
            PG8_WAIT_L(0); PG8_BAR; PG8_MMA(1, 0, At, B0); PG8_MMA(1, 1, At, B1); PG8_BAR; PG8_SCHED;
        }
        if (wr == 0) PG8_BAR;
        E(acc, cur, wr, wc, fr, fq); S.done(cur);
        if (!has_next) break;
#pragma unroll
        for (int a = 0; a < 2; ++a)
#pragma unroll
            for (int b = 0; b < 2; ++b)
#pragma unroll
                for (int m = 0; m < 4; ++m)
#pragma unroll
                    for (int n = 0; n < 2; ++n) acc[a][b][m][n] = (f32x4){0.f, 0.f, 0.f, 0.f};
        cur = nxt; cA = nA; cB0 = nB0; cB1 = nB1; ++ui;
        if constexpr (GATHER) { va00 = vn00; va01 = vn01; va10 = vn10; va11 = vn11; }
        if (wr == 1) PG8_BAR;
    }
    PG8_WAIT_V(0);
    PG8_BAR;
#undef PG8_SA
#undef PG8_SB
#undef PG8_STAGE
#undef PG8_BLOAD
#undef PG8_BWAIT
#undef PG8_BWRITE
#undef PG8_BSRC
#undef PG8_LDA
#undef PG8_LDB
#undef PG8_MMA
#undef PG8_WAIT_V
#undef PG8_WAIT_L
#undef PG8_BAR
#undef PG8_SCHED
#undef PG8_GATHER_OFFS
}
}

#ifndef PG8_SP2
#define PG8_SP2 true
#endif
#ifndef PG8_ALIGN
#define PG8_ALIGN true
#endif
#ifndef MK_PER_PHASE
#define MK_PER_PHASE 0
#endif

constexpr int NWAVES = 8;
constexpr int DM = 2048, NB = 8, SEQ = 2048, CTX = 256, TPB = CTX + SEQ, T = NB * TPB;
constexpr int EVEN_IN_P = 2816, ODD_IN = 4608;
constexpr int NE = 32, DE = 1024, MAXSLOT = 45056;
constexpr float NORM_EPS = 1e-6f;
constexpr float LAMBDA_INIT = 0.35550906759f;
constexpr int NPHASE = 27;
#ifndef MOE_F32B
#define MOE_F32B 0
#endif
#ifndef KR_IN_POST1
#define KR_IN_POST1 1
#endif
#ifndef MOE_HANDOFF
#define MOE_HANDOFF 0
#endif
#ifndef FUSED_ROUTE
#define FUSED_ROUTE 1
#endif
#ifndef ATT_DIFF_FUSED
#define ATT_DIFF_FUSED 1
#endif
#ifndef BG_CONVERT
#define BG_CONVERT 1
#endif
#ifndef BG_FILL
#define BG_FILL 1
#endif
#ifndef BG_GEFF
#define BG_GEFF 1
#endif
#ifndef USE_NAIVE_ATTN
#define USE_NAIVE_ATTN 0
#endif

constexpr size_t MiB = 1u << 20;
constexpr size_t WS_CTL = 0, CTL_ZERO_BYTES = 1 * MiB;
constexpr size_t WS_MOD = 1 * MiB;
constexpr size_t WS_ROPE = 2 * MiB;
constexpr size_t WS_ROUTE = 3 * MiB;
constexpr size_t WS_WE_IN = 4 * MiB;
constexpr size_t WS_WE_UQ = 15 * MiB;
constexpr size_t WS_WE_UKV = 17 * MiB;
constexpr size_t WS_WE_OUT = 19 * MiB;
constexpr size_t WS_WO_IN = 27 * MiB;
constexpr size_t WS_WO_OUT = 45 * MiB;
constexpr size_t WS_WR = 53 * MiB;
constexpr size_t WS_WGU = 60 * MiB;
constexpr size_t WS_WDN = 572 * MiB;
constexpr size_t WS_H = 828 * MiB;
constexpr size_t WS_A1 = 972 * MiB;
constexpr size_t WS_MIX = 1044 * MiB;
constexpr size_t WS_R = 1116 * MiB;
constexpr size_t WS_Y1 = WS_R;
constexpr size_t WS_CQN = WS_R + 162 * MiB;
constexpr size_t WS_CKVN = WS_R + 180 * MiB;
constexpr size_t WS_QB = WS_R + 198 * MiB;
constexpr size_t WS_KV = WS_R + 252 * MiB;
constexpr size_t WS_KB = WS_R + 324 * MiB;
constexpr size_t WS_XS = WS_R;
constexpr size_t WS_U = WS_R + 176 * MiB;
constexpr size_t WS_YS = WS_R + 264 * MiB;
constexpr size_t WS_LG = WS_R + 440 * MiB;
constexpr size_t WS_POS = WS_R + 460 * MiB;
constexpr int POSCAP = 18432;
constexpr size_t WS_END = WS_R + 466 * MiB;
constexpr int RKS = 4;
constexpr int CW_CNT = 64;
constexpr int CW_NRT = 256;
constexpr int CW_TEXP = 512;
constexpr int CW_BAR = 4096;
constexpr int CW_RDY = 32768;
constexpr int CW_ITEM = 8192;
constexpr int CW_SLOT = 16384;

constexpr int RING_OFF = 0, RING_BYTES = 131072;
constexpr int LDSCTL_OFF = RING_BYTES, MISC_OFF = LDSCTL_OFF + 320;
constexpr int LDS_BYTES = 147456;
constexpr int LDS_TAB = 135168;

#define GAS __attribute__((address_space(1)))
#define LAS __attribute__((address_space(3)))
typedef unsigned short bf16;
typedef unsigned v4u __attribute__((ext_vector_type(4)));
typedef unsigned v2u __attribute__((ext_vector_type(2)));
typedef float f32x4 __attribute__((ext_vector_type(4)));
typedef GAS unsigned gu32;
#define RLX_AGENT __ATOMIC_RELAXED, __HIP_MEMORY_SCOPE_AGENT
#define LDS_WAIT() asm volatile("s_waitcnt lgkmcnt(0)" ::: "memory")
#define VM_WAIT() asm volatile("s_waitcnt vmcnt(0)" ::: "memory")
__device__ __forceinline__ unsigned f2bf(float f) { unsigned u = __builtin_bit_cast(unsigned, f); return (u + 0x7fffu + ((u >> 16) & 1u)) >> 16; }
__device__ __forceinline__ unsigned pk2(float lo, float hi) { return f2bf(lo) | (f2bf(hi) << 16); }
__device__ __forceinline__ float bf2f(unsigned short h) { return __builtin_bit_cast(float, (unsigned)h << 16); }
__device__ __forceinline__ float bflo(unsigned w) { return __builtin_bit_cast(float, w << 16); }
__device__ __forceinline__ float bfhi(unsigned w) { return __builtin_bit_cast(float, w & 0xffff0000u); }
__device__ __forceinline__ float wave_sum(float v) {
#pragma unroll
    for (int o = 1; o < 64; o <<= 1) v += __shfl_xor(v, o);
    return v;
}
__device__ __forceinline__ float wave_max(float v) {
#pragma unroll
    for (int o = 1; o < 64; o <<= 1) v = fmaxf(v, __shfl_xor(v, o));
    return v;
}
#define XB_TMO      128
#define XB_XCNT(j)  (256  + 64 * (j))
#define XB_XSUB(j)  (1280 + 64 * (j))
#define XB_XGEN(j)  (2304 + 64 * (j))
#define XB_TOP      3328
#define XB_TOPGEN   3392
#define XCD_BAR_WORDS 3456
#define XB_SPIN_CAP (1u << 18)

__device__ __forceinline__ unsigned xb_ld(unsigned* p)              { return __hip_atomic_load(p, __ATOMIC_RELAXED, __HIP_MEMORY_SCOPE_AGENT); }
__device__ __forceinline__ unsigned xb_add(unsigned* p, unsigned v) { return __hip_atomic_fetch_add(p, v, __ATOMIC_RELAXED, __HIP_MEMORY_SCOPE_AGENT); }
__device__ __forceinline__ unsigned xb_xcc_id() { return (unsigned)__builtin_amdgcn_s_getreg((3 << 11) | 20) & 0xFu; }
#define XB_SPIN(cond, bar) do { unsigned _sp = 0; while (cond) { __builtin_amdgcn_s_sleep(1); \
    if ((++_sp & 255u) == 0u) { if (xb_ld(&(bar)[XB_TMO])) break; if (_sp > XB_SPIN_CAP) { atomicAdd(&(bar)[XB_TMO], 1u); break; } } } } while (0)

struct XcdBarrier {
    unsigned* bar; unsigned x;
    volatile LAS unsigned* st;
};

__device__ __forceinline__ XcdBarrier xcd_barrier_post(unsigned* bar, volatile LAS unsigned* st) {
    XcdBarrier b; b.bar = bar; b.x = xb_xcc_id(); b.st = st;
    if (threadIdx.x == 0) (void)xb_add(&bar[XB_XCNT(b.x)], 1u);
    return b;
}
__device__ __forceinline__ void xcd_barrier_complete(unsigned* bar, unsigned x, unsigned& nloc, unsigned& nx) {
    const unsigned G = gridDim.x * gridDim.y * gridDim.z;
    unsigned sum, cnt, mine, sp = 0u;
    for (;;) {
        sum = 0u; cnt = 0u; mine = 0u;
#pragma unroll
        for (unsigned j = 0; j < 16; ++j) { const unsigned c = xb_ld(&bar[XB_XCNT(j)]); sum += c; cnt += (c > 0u) ? 1u : 0u; mine = (j == x) ? c : mine; }
        if (sum == G) break;
        __builtin_amdgcn_s_sleep(1);
        if ((++sp & 255u) == 0u) { if (xb_ld(&bar[XB_TMO])) break; if (sp > XB_SPIN_CAP) { atomicAdd(&bar[XB_TMO], 1u); break; } }
    }
    nloc = mine > 0u ? mine : 1u; nx = cnt > 0u ? cnt : 1u;
}

__device__ __forceinline__ void xcd_barrier(const XcdBarrier& b) {
    asm volatile("s_waitcnt vmcnt(0)" ::: "memory");
    __syncthreads();
    if (threadIdx.x == 0) {
        unsigned* bar = b.bar;
        __builtin_amdgcn_s_waitcnt(0);
        unsigned nloc = b.st[0], nx = b.st[1];
        if (nloc == 0u) { xcd_barrier_complete(bar, b.x, nloc, nx); b.st[0] = nloc; b.st[1] = nx; }
        const unsigned old = xb_add(&bar[XB_XSUB(b.x)], 1u);
        const unsigned gen = old / nloc;
        if (old + 1u == (gen + 1u) * nloc) {
            __builtin_amdgcn_fence(__ATOMIC_RELEASE, "agent");
            asm volatile("s_waitcnt vmcnt(0)" ::: "memory");
            const unsigned og = xb_add(&bar[XB_TOP], 1u);
            const unsigned tg = og / nx;
            if (og + 1u == (tg + 1u) * nx) xb_add(&bar[XB_TOPGEN], 1u);
            else XB_SPIN(xb_ld(&bar[XB_TOPGEN]) == tg, bar);
            __builtin_amdgcn_fence(__ATOMIC_ACQUIRE, "agent");
            xb_add(&bar[XB_XGEN(b.x)], 1u);
            asm volatile("s_waitcnt vmcnt(0)" ::: "memory");
        } else {
            XB_SPIN(xb_ld(&bar[XB_XGEN(b.x)]) == gen, bar);
            __builtin_amdgcn_fence(__ATOMIC_ACQUIRE, "agent");
            asm volatile("s_waitcnt vmcnt(0)" ::: "memory");
        }
    }
    __syncthreads();
}

struct Frame {
    LAS unsigned char* lds;
    volatile LAS unsigned* MISC;
    gu32* ctl;
    unsigned char* ws;
    int tid, lane, wave, vcu, G;
};
typedef short bf16x8_t __attribute__((ext_vector_type(8)));
struct LocalId { int tid, lane, wave; };
__device__ __forceinline__ LocalId local_id_w(int wave) { int t = wave * 64 + lane_id_(); asm volatile("" : "+v"(t)); LocalId l; l.tid = t; l.lane = t & 63; l.wave = wave; return l; }
#define local_id() local_id_w(F.wave)
struct Args { const float* in[35]; float* out; unsigned char* ws; int ph_lo, ph_hi; };
enum { I_X = 0, I_C, I_CTX, I_CCTX, I_MODW, I_MODB, I_EWIN, I_EWOUT, I_AQN, I_AKN, I_BCQN, I_BWUQ, I_BCKVN, I_BWUKV, I_BQN, I_BKN, I_OWIN, I_OWOUT,
       I_CQN, I_CKN, I_LQ1, I_LK1, I_LQ2, I_LK2, I_SUBLN, I_DQN, I_DKN, I_SINK, I_WRG, I_BRG, I_WRE, I_BRE, I_WG, I_WU, I_WD };

__device__ __forceinline__ int mod_index(int row) { const int b = row / TPB; return (row - b * TPB) < CTX ? 8 : b; }

__device__ __forceinline__ unsigned cvt_pk_bf16(float lo, float hi) { unsigned r; asm volatile("v_cvt_pk_bf16_f32 %0, %1, %2" : "=v"(r) : "v"(lo), "v"(hi)); return r; }
#ifndef NT_THIN
#define NT_THIN 1
#endif
#if NT_THIN
#define NT_LD(p) __builtin_nontemporal_load(p)
#define NT_ST(v, p) __builtin_nontemporal_store((v), (p))
#else
#define NT_LD(p) (*(p))
#define NT_ST(v, p) (*(p) = (v))
#endif
#ifndef TR_NT_LOAD
#define TR_NT_LOAD 1
#endif
#ifndef TR_NT_STORE
#define TR_NT_STORE 1
#endif
struct TrAddr { const float* src; bf16* dst; int N, Kd; };
__device__ __forceinline__ void tr_load(f32x4 (&v)[8], const TrAddr& t, int lane) {
    const int kr = lane >> 3, cq = lane & 7;
#pragma unroll
#if TR_NT_LOAD
    for (int i = 0; i < 8; ++i) v[i] = __builtin_nontemporal_load((const f32x4*)(t.src + (size_t)(8 * kr + i) * t.N + 4 * cq));
#else
    for (int i = 0; i < 8; ++i) v[i] = *(const f32x4*)(t.src + (size_t)(8 * kr + i) * t.N + 4 * cq);
#endif
}
__device__ __forceinline__ void tr_store(const f32x4 (&v)[8], const TrAddr& t, int lane) {
    const int kr = lane >> 3, cq = lane & 7;
#pragma unroll
    for (int e = 0; e < 4; ++e) { v4u o; o.x = cvt_pk_bf16(v[0][e], v[1][e]); o.y = cvt_pk_bf16(v[2][e], v[3][e]); o.z = cvt_pk_bf16(v[4][e], v[5][e]); o.w = cvt_pk_bf16(v[6][e], v[7][e]);
#if TR_NT_STORE
        __builtin_nontemporal_store(o, (v4u*)(t.dst + (size_t)(4 * cq + e) * t.Kd + 8 * kr)); }
#else
        *(GAS v4u*)(t.dst + (size_t)(4 * cq + e) * t.Kd + 8 * kr) = o; }
#endif
}
__device__ __forceinline__ void transpose_item(const float* W, int N, int k0, int n0, bf16* dst, int Kd, LAS float* scr, int lane) {
    (void)scr; TrAddr t; t.src = W + (size_t)k0 * N + n0; t.dst = dst + k0; t.N = N; t.Kd = Kd;
    f32x4 v[8]; tr_load(v, t, lane); tr_store(v, t, lane);
}
__device__ __forceinline__ void small_transpose(const float* W, int K, int N, bf16* WT, int item, LAS float* scr, int lane) {
    const int nblk = N / 32, kb = item / nblk, nb = item - kb * nblk;
    transpose_item(W, N, kb * 64, nb * 32, WT + (size_t)(nb * 32) * K, K, scr, lane);
}
__device__ __forceinline__ TrAddr moe_item_addr(const Frame& F, const Args& a, int r) {
    int le, which, ri;
    if (r < 32 * 3072) { le = r / 3072; const int q = r - le * 3072; which = q >> 10; ri = q & 1023; }
    else if (r < 32 * 3072 + 32 * 2048) { const int r1 = r - 32 * 3072; le = 32 + (r1 >> 11); which = (r1 >> 10) & 1; ri = r1 & 1023; }
    else { const int r2 = r - (32 * 3072 + 32 * 2048); le = 32 + (r2 >> 10); which = 2; ri = r2 & 1023; }
    TrAddr t;
    if (which < 2) { const int kb = ri >> 5, n0 = (ri & 31) * 32;
        t.src = a.in[which == 0 ? I_WG : I_WU] + (size_t)le * 2048 * 1024 + (size_t)(kb * 64) * 1024 + n0; t.N = 1024;
        t.dst = (bf16*)(F.ws + WS_WGU) + (size_t)le * 2048 * 2048 + (size_t)((n0 >> 7) * 256 + which * 128 + (n0 & 127)) * 2048 + kb * 64; t.Kd = 2048;
    } else { const int kb = ri >> 6, n0 = (ri & 63) * 32;
        t.src = a.in[I_WD] + (size_t)le * 1024 * 2048 + (size_t)(kb * 64) * 2048 + n0; t.N = 2048;
        t.dst = (bf16*)(F.ws + WS_WDN) + (size_t)le * 2048 * 1024 + (size_t)n0 * 1024 + kb * 64; t.Kd = 1024; }
    return t;
}
__device__ __forceinline__ void moe_item(const Frame& F, const Args& a, int r, LAS float* scr, int lane) { (void)scr; const TrAddr t = moe_item_addr(F, a, r); f32x4 v[8]; tr_load(v, t, lane); tr_store(v, t, lane); }
__device__ __forceinline__ void p0_prologue(const Frame& F, const Args& a) {
    const LocalId L_ = local_id(); (void)L_;
    const int gt = F.vcu * 512 + L_.tid, NT = F.G * 512;
    {
        float2* t128 = (float2*)(F.ws + WS_ROPE); float2* t64 = (float2*)(F.ws + WS_ROPE + 16384);
        for (int i = gt; i < 3072; i += NT) {
            if (i < 2048) { const int pos = i >> 5, f = i & 31; const float inv = 1.0f / powf(10000.0f, (float)f / 32.0f); const float ang = (float)pos * inv; t128[i] = make_float2(cosf(ang), sinf(ang)); }
            else { const int k = i - 2048, pos = k >> 4, f = k & 15; const float inv = 1.0f / powf(10000.0f, (float)f / 16.0f); const float ang = (float)pos * inv; t64[k] = make_float2(cosf(ang), sinf(ang)); }
        }
    }
    { float* gsub = (float*)(F.ws + WS_ROPE + 32768); for (int i = gt; i < 128; i += NT) gsub[i] = a.in[I_SUBLN][i] * (1.0f - LAMBDA_INIT); }
    {
        bf16* WR = (bf16*)(F.ws + WS_WR);
        for (int i = gt; i < 2 * 256 * 2048; i += NT) { const int l = i >> 19, r = (i >> 11) & 255, k = i & 2047;
            float v = 0.f; if (r < 4) v = a.in[I_WRG][((size_t)l * 2048 + k) * 4 + r]; else if (r < 36) v = a.in[I_WRE][((size_t)l * 2048 + k) * 32 + (r - 4)];
            WR[i] = (bf16)f2bf(v); }
        v4u* z = (v4u*)((bf16*)(F.ws + WS_WE_IN) + (size_t)2624 * 2048);
        for (int i = gt; i < 192 * 2048 / 8; i += NT) z[i] = (v4u){0u, 0u, 0u, 0u};
    }
    {
        LAS float* sl = (LAS float*)(F.lds + RING_OFF);
        LAS float* red = (LAS float*)(F.lds + RING_OFF + 73728);
        for (int i = L_.tid; i < 9 * 2048; i += 512) { const int j = i >> 11, k = i & 2047; const float v = j < 8 ? a.in[I_C][j * 2048 + k] : a.in[I_CCTX][k]; sl[i] = v / (1.0f + expf(-v)); }
        __syncthreads();
        float* MOD = (float*)(F.ws + WS_MOD);
        const int cg = L_.lane & 31, ks = L_.lane >> 5;
        for (int item = blockIdx.x; item < 192; item += F.G) {
            const int layer = item / 96, chunk = item - layer * 96, col0 = chunk * 128;
            const float* W = a.in[I_MODW] + (size_t)layer * 2048 * 12288 + col0 + cg * 4;
            f32x4 acc[9];
#pragma unroll
            for (int j = 0; j < 9; ++j) acc[j] = (f32x4){0.f, 0.f, 0.f, 0.f};
#pragma unroll 8
            for (int it = 0; it < 128; ++it) { const int k = L_.wave * 256 + it * 2 + ks; const f32x4 w = *(const f32x4*)(W + (size_t)k * 12288);
#pragma unroll
                for (int j = 0; j < 9; ++j) { const float s = sl[j * 2048 + k]; acc[j] = acc[j] + w * s; } }
#pragma unroll
            for (int j = 0; j < 9; ++j)
#pragma unroll
                for (int e = 0; e < 4; ++e) { float v = acc[j][e]; v += __shfl_xor(v, 32); acc[j][e] = v; }
            if (L_.lane < 32) {
#pragma unroll
                for (int j = 0; j < 9; ++j)
#pragma unroll
                    for (int e = 0; e < 4; ++e) red[(L_.wave * 9 + j) * 128 + cg * 4 + e] = acc[j][e]; }
            __syncthreads();
            for (int t = L_.tid; t < 9 * 128; t += 512) { const int j = t >> 7, cc = t & 127; float s = a.in[I_MODB][layer * 12288 + col0 + cc];
#pragma unroll
                for (int w = 0; w < 8; ++w) s += red[(w * 9 + j) * 128 + cc];
                MOD[((size_t)layer * 9 + j) * 12288 + col0 + cc] = s; }
            __syncthreads();
        }
    }
    {
        LAS float* scr = (LAS float*)(F.lds + RING_OFF + L_.wave * 16384);
        const int gw = F.vcu * NWAVES + L_.wave, NGW = F.G * NWAVES;
        constexpr int I0 = 32 * 82, I1 = 8 * 48, I2 = 8 * 64, I3 = 32 * 64, I4 = 32 * 144, I5 = 32 * 64, NSMALL = I0 + I1 + I2 + I3 + I4 + I5;
#if MOE_F32B || BG_CONVERT
        constexpr int NMOE = 0;
#else
        constexpr int NMOE = 64 * 3072;
#endif
        for (int it = gw; it < NSMALL + NMOE; it += NGW) {
            int r = it;
            if (r < NSMALL) {
                if (r < I0) { small_transpose(a.in[I_EWIN], 2048, 2624, (bf16*)(F.ws + WS_WE_IN), r, scr, L_.lane); continue; } r -= I0;
                if (r < I1) { small_transpose(a.in[I_BWUQ], 512, 1536, (bf16*)(F.ws + WS_WE_UQ), r, scr, L_.lane); continue; } r -= I1;
                if (r < I2) { small_transpose(a.in[I_BWUKV], 512, 2048, (bf16*)(F.ws + WS_WE_UKV), r, scr, L_.lane); continue; } r -= I2;
                if (r < I3) { small_transpose(a.in[I_EWOUT], 2048, 2048, (bf16*)(F.ws + WS_WE_OUT), r, scr, L_.lane); continue; } r -= I3;
                if (r < I4) { small_transpose(a.in[I_OWIN], 2048, 4608, (bf16*)(F.ws + WS_WO_IN), r, scr, L_.lane); continue; } r -= I4;
                small_transpose(a.in[I_OWOUT], 2048, 2048, (bf16*)(F.ws + WS_WO_OUT), r, scr, L_.lane); continue;
            }
            moe_item(F, a, r - NSMALL, scr, L_.lane);
        }
    }
}

__device__ __forceinline__ void modulate_store(const f32x4 (&v)[8], const float* shift, const float* scale, bf16* orow, int lane) {
    float ss = 0.f;
#pragma unroll
    for (int j = 0; j < 8; ++j) ss += (v[j].x * v[j].x + v[j].y * v[j].y) + (v[j].z * v[j].z + v[j].w * v[j].w);
    ss = wave_sum(ss);
    const float r = 1.0f / sqrtf(ss * (1.0f / 2048.0f) + NORM_EPS);
#pragma unroll
    for (int j = 0; j < 8; ++j) { const f32x4 sh = ((const f32x4*)shift)[lane + 64 * j], sc = ((const f32x4*)scale)[lane + 64 * j];
        const f32x4 y = v[j] * r * (sc + 1.0f) + sh; v2u o; o.x = pk2(y.x, y.y); o.y = pk2(y.z, y.w); ((v2u*)orow)[lane + 64 * j] = o; }
}
__device__ __forceinline__ void moe_combine_load(const bf16* YS, const int* rec, const LAS int* offs, int lane, f32x4 (&y)[8]) {
    const int s0 = offs[rec[0]] + rec[2], s1 = offs[rec[1]] + rec[3]; const float w0 = __builtin_bit_cast(float, rec[4]), w1 = __builtin_bit_cast(float, rec[5]);
    const v2u* p0 = (const v2u*)(YS + (size_t)s0 * 2048); const v2u* p1 = (const v2u*)(YS + (size_t)s1 * 2048);
#pragma unroll
    for (int j = 0; j < 8; ++j) { const v2u a = NT_LD(p0 + lane + 64 * j), b = NT_LD(p1 + lane + 64 * j);
        y[j].x = w0 * bflo(a.x) + w1 * bflo(b.x); y[j].y = w0 * bfhi(a.x) + w1 * bfhi(b.x); y[j].z = w0 * bflo(a.y) + w1 * bflo(b.y); y[j].w = w0 * bfhi(a.y) + w1 * bfhi(b.y); }
}

__device__ __forceinline__ int moe_tables(const Frame& F, int layer, int tid) {
    LAS int* texp = (LAS int*)(F.lds + LDS_TAB); LAS int* frt = texp + 256; LAS int* offs = frt + 40;
    if (tid < 64) {
        const int e = tid & 31;
        const unsigned c = __hip_atomic_load((unsigned*)(F.ctl + CW_CNT + layer * 64 + e), RLX_AGENT);
        const int pad = (int)((c + 255u) & ~255u);
        int incl = pad;
#pragma unroll
        for (int d = 1; d < 32; d <<= 1) { const int v = __shfl_up(incl, d); if ((tid & 31) >= d) incl += v; }
        const int excl = incl - pad;
        if (tid < 32) { offs[e] = excl; frt[e] = excl >> 8; for (int r = excl >> 8; r < (incl >> 8); ++r) texp[r] = e; if (e == 31) { offs[NE] = incl; frt[NE] = incl >> 8; } }
    }
    __syncthreads();
    return frt[NE];
}
__device__ __forceinline__ void hrow_load(const bf16* hrow, int lane, f32x4 (&v)[8]) {
#pragma unroll
    for (int q = 0; q < 8; ++q) { const v2u w = ((const v2u*)hrow)[lane + 64 * q]; v[q].x = bflo(w.x); v[q].y = bfhi(w.x); v[q].z = bflo(w.y); v[q].w = bfhi(w.y); }
}
__device__ __forceinline__ void hrow_store(bf16* hrow, int lane, const f32x4 (&v)[8]) {
#pragma unroll
    for (int q = 0; q < 8; ++q) { v2u o; o.x = pk2(v[q].x, v[q].y); o.y = pk2(v[q].z, v[q].w); ((v2u*)hrow)[lane + 64 * q] = o; }
}
__device__ __forceinline__ void modulate_store_l(const f32x4 (&v)[8], const LAS float* shift, const LAS float* scale, bf16* orow, int lane) {
    float ss = 0.f;
#pragma unroll
    for (int j = 0; j < 8; ++j) ss += (v[j].x * v[j].x + v[j].y * v[j].y) + (v[j].z * v[j].z + v[j].w * v[j].w);
    ss = wave_sum(ss);
    const float r = 1.0f / sqrtf(ss * (1.0f / 2048.0f) + NORM_EPS);
#pragma unroll
    for (int j = 0; j < 8; ++j) { const f32x4 sh = ((const LAS f32x4*)shift)[lane + 64 * j], sc = ((const LAS f32x4*)scale)[lane + 64 * j];
        const f32x4 y = v[j] * r * (sc + 1.0f) + sh; v2u o; o.x = pk2(y.x, y.y); o.y = pk2(y.z, y.w); ((v2u*)orow)[lane + 64 * j] = o; }
}
__device__ __forceinline__ const float* l0_src_row(const Args& a, int row, int& j) {
    const int b = row / TPB, r = row - b * TPB; j = r < CTX ? 8 : b;
    return r < CTX ? a.in[I_CTX] + (size_t)(b * CTX + r) * DM : a.in[I_X] + (size_t)(b * SEQ + (r - CTX)) * DM;
}
__device__ __forceinline__ void p_l0_mod1(const Frame& F, const Args& a) {
    const LocalId L_ = local_id(); (void)L_;
    const int gw = F.vcu * NWAVES + L_.wave, NGW = F.G * NWAVES;
    const float* MOD = (const float*)(F.ws + WS_MOD); bf16* A1 = (bf16*)(F.ws + WS_A1);
    for (int r0 = gw; r0 < T; r0 += 2 * NGW) {
        const int r1 = r0 + NGW; const bool ok1 = r1 < T;
        int j0, j1 = 0; const float* s0 = l0_src_row(a, r0, j0); const float* s1 = ok1 ? l0_src_row(a, r1, j1) : s0;
        f32x4 v0[8], v1[8];
#pragma unroll
        for (int q = 0; q < 8; ++q) v0[q] = NT_LD((const f32x4*)s0 + L_.lane + 64 * q);
#pragma unroll
        for (int q = 0; q < 8; ++q) v1[q] = NT_LD((const f32x4*)s1 + L_.lane + 64 * q);
        const float* m0 = MOD + (size_t)(0 * 9 + j0) * 12288;
        modulate_store(v0, m0 + 0 * 2048, m0 + 1 * 2048, A1 + (size_t)r0 * DM, L_.lane);
        if (ok1) {
            const float* m1 = MOD + (size_t)(0 * 9 + j1) * 12288;
            modulate_store(v1, m1 + 0 * 2048, m1 + 1 * 2048, A1 + (size_t)r1 * DM, L_.lane);
        }
    }
}
__device__ __forceinline__ void p_mod2(const Frame& F, int layer) {
    const LocalId L_ = local_id(); (void)L_;
    const int gw = F.vcu * NWAVES + L_.wave, NGW = F.G * NWAVES;
    const float* MOD = (const float*)(F.ws + WS_MOD); const bf16* H = (const bf16*)(F.ws + WS_H); bf16* A1 = (bf16*)(F.ws + WS_A1);
    for (int r0 = gw; r0 < T; r0 += 2 * NGW) {
        const int r1 = r0 + NGW; const int j0 = mod_index(r0), j1 = r1 < T ? mod_index(r1) : 8;
        const bool ok0 = !(layer == 1 && j0 == 8), ok1 = r1 < T && !(layer == 1 && j1 == 8);
        f32x4 v0[8], v1[8];
        if (ok0) hrow_load(H + (size_t)r0 * DM, L_.lane, v0);
        if (ok1) hrow_load(H + (size_t)r1 * DM, L_.lane, v1);
        if (ok0) { const float* m = MOD + (size_t)(layer * 9 + j0) * 12288; modulate_store(v0, m + 3 * 2048, m + 4 * 2048, A1 + (size_t)r0 * DM, L_.lane); }
        if (ok1) { const float* m = MOD + (size_t)(layer * 9 + j1) * 12288; modulate_store(v1, m + 3 * 2048, m + 4 * 2048, A1 + (size_t)r1 * DM, L_.lane); }
    }
}
__device__ __forceinline__ void p_l1_mod1(const Frame& F, size_t hdst_off = WS_H, size_t adst_off = WS_A1) {
    const LocalId L_ = local_id(); (void)L_;
    const float* MOD = (const float*)(F.ws + WS_MOD); const bf16* H = (const bf16*)(F.ws + WS_H); bf16* Hd = (bf16*)(F.ws + hdst_off); bf16* A1 = (bf16*)(F.ws + adst_off);
    const bf16* YS = (const bf16*)(F.ws + WS_YS); const int* ROUTE = (const int*)(F.ws + WS_ROUTE);
    (void)moe_tables(F, 0, L_.tid); const LAS int* offs = (const LAS int*)(F.lds + LDS_TAB) + 296;
    const int RPB = (T + F.G - 1) / F.G, rb0 = F.vcu * RPB < T ? F.vcu * RPB : T, re0 = rb0 + RPB < T ? rb0 + RPB : T;
    LAS float* vec = (LAS float*)(F.lds + RING_OFF);
    for (int rb = rb0; rb < re0 || rb == rb0; rb += 256) {
      const int re = rb + 256 < re0 ? rb + 256 : re0;
      const int jlo = mod_index(rb < T ? rb : T - 1), jhi = mod_index(re > rb ? re - 1 : (rb < T ? rb : T - 1));
      for (int i = L_.tid; i < 2 * 3 * 512; i += 512) { const int st = i / 1536, rem = i - st * 1536, vv = rem >> 9, k = rem & 511; const int j = st ? jhi : jlo;
        const float* src = vv == 0 ? MOD + (size_t)(0 * 9 + j) * 12288 + 5 * 2048 : MOD + (size_t)(1 * 9 + j) * 12288 + (vv - 1) * 2048;
        ((LAS f32x4*)vec)[i] = ((const f32x4*)src)[k]; }
      __syncthreads();
      for (int r0 = rb + 2 * L_.wave; r0 < re; r0 += 16) {
        const int r1 = r0 + 1; const bool ok1 = r1 < re; const int rr1 = ok1 ? r1 : r0;
        const int j0 = mod_index(r0), j1 = mod_index(rr1);
        const LAS float* s0 = vec + (j0 == jlo ? 0 : 3 * 2048); const LAS float* s1 = vec + (j1 == jlo ? 0 : 3 * 2048);
        f32x4 v0[8], v1[8], y0[8], y1[8];
        moe_combine_load(YS, ROUTE + (size_t)r0 * 8, offs, L_.lane, y0);
        moe_combine_load(YS, ROUTE + (size_t)rr1 * 8, offs, L_.lane, y1);
        hrow_load(H + (size_t)r0 * DM, L_.lane, v0);
        hrow_load(H + (size_t)rr1 * DM, L_.lane, v1);
#pragma unroll
        for (int q = 0; q < 8; ++q) { v0[q] = v0[q] + ((const LAS f32x4*)s0)[L_.lane + 64 * q] * y0[q]; v1[q] = v1[q] + ((const LAS f32x4*)s1)[L_.lane + 64 * q] * y1[q]; }
        if (j0 != 8) hrow_store(Hd + (size_t)r0 * DM, L_.lane, v0);
        modulate_store_l(v0, s0 + 2048, s0 + 4096, A1 + (size_t)r0 * DM, L_.lane);
        if (ok1) {
            if (j1 != 8) hrow_store(Hd + (size_t)r1 * DM, L_.lane, v1);
            modulate_store_l(v1, s1 + 2048, s1 + 4096, A1 + (size_t)r1 * DM, L_.lane);
        }
      }
      __syncthreads();
    }
}
__device__ __forceinline__ void p_final(const Frame& F, float* out) {
    const LocalId L_ = local_id(); (void)L_;
    const float* MOD = (const float*)(F.ws + WS_MOD); const bf16* H = (const bf16*)(F.ws + WS_H);
    const bf16* YS = (const bf16*)(F.ws + WS_YS); const int* ROUTE = (const int*)(F.ws + WS_ROUTE);
    (void)moe_tables(F, 1, L_.tid); const LAS int* offs = (const LAS int*)(F.lds + LDS_TAB) + 296;
    constexpr int NX = NB * SEQ;
    const int RPB = (NX + F.G - 1) / F.G, ib0 = F.vcu * RPB < NX ? F.vcu * RPB : NX, ie0 = ib0 + RPB < NX ? ib0 + RPB : NX;
    LAS float* vec = (LAS float*)(F.lds + RING_OFF);
    for (int ib = ib0; ib < ie0 || ib == ib0; ib += 2048) {
      const int ie = ib + 2048 < ie0 ? ib + 2048 : ie0;
      const int blo = (ib < NX ? ib : NX - 1) / SEQ, bhi = (ie > ib ? ie - 1 : (ib < NX ? ib : NX - 1)) / SEQ;
      for (int i = L_.tid; i < 2 * 512; i += 512) { const int st = i >> 9, k = i & 511; const int b = st ? bhi : blo;
        ((LAS f32x4*)vec)[i] = ((const f32x4*)(MOD + (size_t)(1 * 9 + b) * 12288 + 5 * 2048))[k]; }
      __syncthreads();
      for (int i0 = ib + 2 * L_.wave; i0 < ie; i0 += 16) {
        const int i1 = i0 + 1; const bool ok1 = i1 < ie; const int ii1 = ok1 ? i1 : i0;
        const int b0 = i0 / SEQ, row0 = b0 * TPB + CTX + (i0 - b0 * SEQ), b1 = ii1 / SEQ, row1 = b1 * TPB + CTX + (ii1 - b1 * SEQ);
        const LAS float* g0 = vec + (b0 == blo ? 0 : 2048); const LAS float* g1 = vec + (b1 == blo ? 0 : 2048);
        f32x4 y0[8], y1[8], h0[8], h1[8];
        moe_combine_load(YS, ROUTE + (size_t)row0 * 8, offs, L_.lane, y0);
        moe_combine_load(YS, ROUTE + (size_t)row1 * 8, offs, L_.lane, y1);
        hrow_load(H + (size_t)row0 * DM, L_.lane, h0);
        hrow_load(H + (size_t)row1 * DM, L_.lane, h1);
#pragma unroll
        for (int q = 0; q < 8; ++q) NT_ST(h0[q] + ((const LAS f32x4*)g0)[L_.lane + 64 * q] * y0[q], (f32x4*)(out + (size_t)i0 * DM) + L_.lane + 64 * q);
        if (ok1) {
#pragma unroll
            for (int q = 0; q < 8; ++q) NT_ST(h1[q] + ((const LAS f32x4*)g1)[L_.lane + 64 * q] * y1[q], (f32x4*)(out + (size_t)i1 * DM) + L_.lane + 64 * q); }
      }
      __syncthreads();
    }
}

__device__ __forceinline__ void head128_norm_rope(const bf16* p, bf16* pd, const float* gain, bool rope, int prow, int pcol, const float2* t128, int lane) {
    const float x0 = bf2f(p[lane]), x1 = bf2f(p[lane + 64]);
    const float ss = wave_sum(x0 * x0 + x1 * x1);
    const float r = 1.0f / sqrtf(ss * (1.0f / 128.0f) + NORM_EPS);
    float y0 = x0 * r * gain[lane], y1 = x1 * r * gain[lane + 64];
    if (rope) {
        const int f = lane & 31; const float2 cr = t128[prow * 32 + f], cc = t128[pcol * 32 + f];
        const float p0 = __shfl_xor(y0, 32), p1 = __shfl_xor(y1, 32); const float sg = (lane & 32) ? 1.0f : -1.0f;
        y0 = y0 * cr.x + sg * p0 * cr.y; y1 = y1 * cc.x + sg * p1 * cc.y;
    }
    pd[lane] = (bf16)f2bf(y0); pd[lane + 64] = (bf16)f2bf(y1);
}
__device__ __forceinline__ float rope64_apply(float y, int prow, int pcol, const float2* t64, int lane) {
    const int f = lane & 15, pos = (lane & 32) ? pcol : prow; const float2 cs = t64[pos * 16 + f];
    const float pr = __shfl_xor(y, 16); const float sg = (lane & 16) ? 1.0f : -1.0f;
    return y * cs.x + sg * pr * cs.y;
}
__device__ __forceinline__ void head64_norm_rope(const bf16* p, bf16* pd, const float* gain, bool rope, int prow, int pcol, const float2* t64, int lane) {
    const float x = bf2f(p[lane]);
    const float ss = wave_sum(x * x);
    const float r = 1.0f / sqrtf(ss * (1.0f / 64.0f) + NORM_EPS);
    float y = x * r * gain[lane];
    if (rope) y = rope64_apply(y, prow, pcol, t64, lane);
    pd[lane] = (bf16)f2bf(y);
}
__device__ __forceinline__ void norm512(const bf16* src, const float* gain, bf16* dst, int lane) {
    const v4u w = ((const v4u*)src)[lane];
    float x[8] = {bflo(w.x), bfhi(w.x), bflo(w.y), bfhi(w.y), bflo(w.z), bfhi(w.z), bflo(w.w), bfhi(w.w)};
    float ss = 0.f;
#pragma unroll
    for (int i = 0; i < 8; ++i) ss += x[i] * x[i];
    ss = wave_sum(ss);
    const float r = 1.0f / sqrtf(ss * (1.0f / 512.0f) + NORM_EPS);
    const f32x4 g0 = ((const f32x4*)gain)[2 * lane], g1 = ((const f32x4*)gain)[2 * lane + 1];
    v4u o; o.x = pk2(x[0] * r * g0.x, x[1] * r * g0.y); o.y = pk2(x[2] * r * g0.z, x[3] * r * g0.w); o.z = pk2(x[4] * r * g1.x, x[5] * r * g1.y); o.w = pk2(x[6] * r * g1.z, x[7] * r * g1.w);
    ((v4u*)dst)[lane] = o;
}

__device__ __forceinline__ void unpack8(const v4u w, float (&x)[8]) { x[0] = bflo(w.x); x[1] = bfhi(w.x); x[2] = bflo(w.y); x[3] = bfhi(w.y); x[4] = bflo(w.z); x[5] = bfhi(w.z); x[6] = bflo(w.w); x[7] = bfhi(w.w); }
__device__ __forceinline__ v4u pack8(const float (&y)[8]) { v4u o; o.x = pk2(y[0], y[1]); o.y = pk2(y[2], y[3]); o.z = pk2(y[4], y[5]); o.w = pk2(y[6], y[7]); return o; }
__device__ __forceinline__ float sumsq8(const float (&x)[8]) { return ((x[0] * x[0] + x[1] * x[1]) + (x[2] * x[2] + x[3] * x[3])) + ((x[4] * x[4] + x[5] * x[5]) + (x[6] * x[6] + x[7] * x[7])); }
template <int GS> __device__ __forceinline__ float group_sum(float v) {
    v += __shfl_xor(v, 1); v += __shfl_xor(v, 2); v += __shfl_xor(v, 4); if (GS == 16) v += __shfl_xor(v, 8); return v;
}
template <int RD> __device__ __forceinline__ void rope8(float (&y)[8], int l, int prow, int pcol, const float2* tab) {
    constexpr int NF = RD / 4, LQ = NF / 8;
    const int quarter = l / LQ, f0 = (l % LQ) * 8, pos = (quarter >= 2) ? pcol : prow;
    const float sg = (quarter & 1) ? 1.0f : -1.0f;
    const f32x4* t = (const f32x4*)(tab + pos * NF + f0);
    const f32x4 c0 = t[0], c1 = t[1], c2 = t[2], c3 = t[3];
    float p[8];
#pragma unroll
    for (int j = 0; j < 8; ++j) p[j] = __shfl_xor(y[j], LQ);
    y[0] = y[0] * c0.x + sg * p[0] * c0.y; y[1] = y[1] * c0.z + sg * p[1] * c0.w; y[2] = y[2] * c1.x + sg * p[2] * c1.y; y[3] = y[3] * c1.z + sg * p[3] * c1.w;
    y[4] = y[4] * c2.x + sg * p[4] * c2.y; y[5] = y[5] * c2.z + sg * p[5] * c2.w; y[6] = y[6] * c3.x + sg * p[6] * c3.y; y[7] = y[7] * c3.z + sg * p[7] * c3.w;
}
template <int DIM> __device__ __forceinline__ v4u head_chunk(const v4u w, const float* gain, bool rope, int prow, int pcol, const float2* tab, int lane) {
    constexpr int GS = DIM / 8; const int l = lane & (GS - 1);
    float x[8]; unpack8(w, x);
    const float ss = group_sum<GS>(sumsq8(x));
    const float r = 1.0f / sqrtf(ss * (1.0f / DIM) + NORM_EPS);
    const f32x4 g0 = ((const f32x4*)gain)[2 * l], g1 = ((const f32x4*)gain)[2 * l + 1];
    x[0] *= r * g0.x; x[1] *= r * g0.y; x[2] *= r * g0.z; x[3] *= r * g0.w; x[4] *= r * g1.x; x[5] *= r * g1.y; x[6] *= r * g1.z; x[7] *= r * g1.w;
    if (rope) rope8<DIM>(x, l, prow, pcol, tab);
    return pack8(x);
}
__device__ __forceinline__ v4u norm512_chunk(const v4u w, const float* gain, int lane) {
    float x[8]; unpack8(w, x);
    const float ss = wave_sum(sumsq8(x));
    const float r = 1.0f / sqrtf(ss * (1.0f / 512.0f) + NORM_EPS);
    const f32x4 g0 = ((const f32x4*)gain)[2 * lane], g1 = ((const f32x4*)gain)[2 * lane + 1];
    x[0] *= r * g0.x; x[1] *= r * g0.y; x[2] *= r * g0.z; x[3] *= r * g0.w; x[4] *= r * g1.x; x[5] *= r * g1.y; x[6] *= r * g1.z; x[7] *= r * g1.w;
    return pack8(x);
}

__device__ __forceinline__ void p_even_post1(const Frame& F, const Args& a, size_t ydst_off = WS_Y1) {
    const LocalId L_ = local_id(); (void)L_;
    const int gw = F.vcu * NWAVES + L_.wave, NGW = F.G * NWAVES, lane = L_.lane;
    const bf16* Y1 = (const bf16*)(F.ws + WS_Y1); bf16* CQN = (bf16*)(F.ws + WS_CQN); bf16* CKVN = (bf16*)(F.ws + WS_CKVN);
    const float2* t128 = (const float2*)(F.ws + WS_ROPE);
    for (int row = gw; row < T; row += NGW) {
        const int b = row / TPB, r = row - b * TPB; const bool xr = r >= CTX; const int s = r - CTX, prow = xr ? (s >> 6) : 0, pcol = xr ? (s & 63) : 0;
        const v4u* y = (const v4u*)(Y1 + (size_t)row * EVEN_IN_P); v4u* yd = (v4u*)((bf16*)(F.ws + ydst_off) + (size_t)row * EVEN_IN_P);
        const v4u k0 = y[128 + (lane & 31)], cq = y[192 + lane], ckv = y[256 + lane];
        const v4u ok0 = head_chunk<128>(k0, a.in[I_AKN], xr, prow, pcol, t128, lane);
        const v4u ocq = norm512_chunk(cq, a.in[I_BCQN], lane), ockv = norm512_chunk(ckv, a.in[I_BCKVN], lane);
        if (lane < 32) yd[128 + lane] = ok0;
        ((v4u*)(CQN + (size_t)row * 512))[lane] = ocq; ((v4u*)(CKVN + (size_t)row * 512))[lane] = ockv;
    }
#if KR_IN_POST1
    {
        constexpr int FPITCH = 4112;
        LAS unsigned char* Fs = F.lds + RING_OFF; LAS float* P = (LAS float*)(F.lds + RING_OFF + 16 * FPITCH + 256);
        const bf16* A1 = (const bf16*)(F.ws + WS_A1); const bf16* WK = (const bf16*)(F.ws + WS_WE_IN) + (size_t)2560 * 2048; bf16* KR = (bf16*)(F.ws + WS_LG);
        const int wave = L_.wave;
        bf16x8_t bfr[4][8];
#pragma unroll
        for (int nb = 0; nb < 4; ++nb)
#pragma unroll
            for (int ks = 0; ks < 8; ++ks) bfr[nb][ks] = *(const bf16x8_t*)(WK + (size_t)(nb * 16 + (lane & 15)) * 2048 + wave * 256 + ks * 32 + (lane >> 4) * 8);
        __syncthreads();
        for (int g = F.vcu; g < T / 16; g += F.G) {
            const int row0 = g * 16;
#pragma unroll
            for (int rr = 0; rr < 2; ++rr) { const int r = 2 * wave + rr; const v4u* src = (const v4u*)(A1 + (size_t)(row0 + r) * DM);
#pragma unroll
                for (int q = 0; q < 4; ++q) *(LAS v4u*)(Fs + r * FPITCH + (lane + 64 * q) * 16) = src[lane + 64 * q]; }
            __syncthreads();
            f32x4 acc[4];
#pragma unroll
            for (int nb = 0; nb < 4; ++nb) acc[nb] = (f32x4){0.f, 0.f, 0.f, 0.f};
#pragma unroll
            for (int ks = 0; ks < 8; ++ks) { const bf16x8_t af = *(const LAS bf16x8_t*)(Fs + (lane & 15) * FPITCH + (wave * 256 + ks * 32 + (lane >> 4) * 8) * 2);
#pragma unroll
                for (int nb = 0; nb < 4; ++nb) acc[nb] = __builtin_amdgcn_mfma_f32_16x16x32_bf16(af, bfr[nb][ks], acc[nb], 0, 0, 0); }
#pragma unroll
            for (int nb = 0; nb < 4; ++nb)
#pragma unroll
                for (int rg = 0; rg < 4; ++rg) P[(wave * 16 + 4 * (lane >> 4) + rg) * 64 + nb * 16 + (lane & 15)] = acc[nb][rg];
            __syncthreads();
#pragma unroll
            for (int o = 0; o < 2; ++o) { const int idx = L_.tid + 512 * o, r = idx >> 6, c = idx & 63; float sacc = 0.f;
#pragma unroll
                for (int w = 0; w < 8; ++w) sacc += P[(w * 16 + r) * 64 + c];
                KR[(size_t)(row0 + r) * 64 + c] = (bf16)f2bf(sacc); }
            __syncthreads();
        }
    }
#endif
}
__device__ __forceinline__ void p_even_post2(const Frame& F, const Args& a, size_t qdst_off = WS_QB, size_t kdst_off = WS_KB) {
    const LocalId L_ = local_id(); (void)L_;
    const int gw = F.vcu * NWAVES + L_.wave, NGW = F.G * NWAVES, lane = L_.lane;
    const bf16* Y1 = (const bf16*)(F.ws + WS_Y1); const bf16* QB = (const bf16*)(F.ws + WS_QB); const bf16* KV = (const bf16*)(F.ws + WS_KV);
    bf16* KB = (bf16*)(F.ws + kdst_off); bf16* QBd = (bf16*)(F.ws + qdst_off);
    const float2* t64 = (const float2*)(F.ws + WS_ROPE + 16384);
    const float* gq = a.in[I_BQN]; const float* gk = a.in[I_BKN]; const float* KRP = (const float*)(F.ws + WS_LG);
    const int l16 = lane & 15, l8 = lane & 7, hn = lane >> 4, hr = lane >> 3;
    const f32x4 gqn0 = ((const f32x4*)gq)[2 * l16], gqn1 = ((const f32x4*)gq)[2 * l16 + 1], gqr0 = ((const f32x4*)(gq + 128))[2 * l8], gqr1 = ((const f32x4*)(gq + 128))[2 * l8 + 1];
    const f32x4 gkn0 = ((const f32x4*)gk)[2 * l16], gkn1 = ((const f32x4*)gk)[2 * l16 + 1], gkr0 = ((const f32x4*)(gk + 128))[2 * l8], gkr1 = ((const f32x4*)(gk + 128))[2 * l8 + 1];
    for (int row = gw; row < T; row += NGW) {
        const int b = row / TPB, r = row - b * TPB; const bool xr = r >= CTX; const int s = r - CTX, prow = xr ? (s >> 6) : 0, pcol = xr ? (s & 63) : 0;
        const bf16* q = QB + (size_t)row * 1536; const bf16* kv = KV + (size_t)row * 2048;
        const v4u wk0 = *(const v4u*)(kv + hn * 256 + l16 * 8), wk1 = *(const v4u*)(kv + (hn + 4) * 256 + l16 * 8);
#if KR_IN_POST1
        const v4u wkr = *(const v4u*)((const bf16*)(F.ws + WS_LG) + (size_t)row * 64 + l8 * 8);
#else
        const v4u wkr = *(const v4u*)(Y1 + (size_t)row * EVEN_IN_P + 2560 + l8 * 8);
#endif
#define POST2_ONE(W0, W1, WR, GN0, GN1, GR0, GR1, DST) do { \
        float x0[8], x1[8], xr_[8]; unpack8(W0, x0); unpack8(W1, x1); unpack8(WR, xr_); \
        const float n0 = group_sum<16>(sumsq8(x0)), n1 = group_sum<16>(sumsq8(x1)), rs = group_sum<8>(sumsq8(xr_));     \
        const float rs0 = __shfl(rs, 8 * hn), rs1 = __shfl(rs, 8 * (hn + 4));                                         \
        const float t0 = __shfl(n0, 16 * (hr & 3)), t1 = __shfl(n1, 16 * (hr & 3)); const float nr = (hr >> 2) ? t1 : t0;    \
        const float r0 = 1.0f / sqrtf((n0 + rs0) * (1.0f / 192.0f) + NORM_EPS), r1 = 1.0f / sqrtf((n1 + rs1) * (1.0f / 192.0f) + NORM_EPS), rr = 1.0f / sqrtf((nr + rs) * (1.0f / 192.0f) + NORM_EPS); \
        x0[0] *= r0 * GN0.x; x0[1] *= r0 * GN0.y; x0[2] *= r0 * GN0.z; x0[3] *= r0 * GN0.w; x0[4] *= r0 * GN1.x; x0[5] *= r0 * GN1.y; x0[6] *= r0 * GN1.z; x0[7] *= r0 * GN1.w; \
        x1[0] *= r1 * GN0.x; x1[1] *= r1 * GN0.y; x1[2] *= r1 * GN0.z; x1[3] *= r1 * GN0.w; x1[4] *= r1 * GN1.x; x1[5] *= r1 * GN1.y; x1[6] *= r1 * GN1.z; x1[7] *= r1 * GN1.w; \
        xr_[0] *= rr * GR0.x; xr_[1] *= rr * GR0.y; xr_[2] *= rr * GR0.z; xr_[3] *= rr * GR0.w; xr_[4] *= rr * GR1.x; xr_[5] *= rr * GR1.y; xr_[6] *= rr * GR1.z; xr_[7] *= rr * GR1.w; \
        if (xr) rope8<64>(xr_, l8, prow, pcol, t64); \
        *(v4u*)((DST) + hn * 192 + l16 * 8) = pack8(x0); *(v4u*)((DST) + (hn + 4) * 192 + l16 * 8) = pack8(x1); *(v4u*)((DST) + hr * 192 + 128 + l8 * 8) = pack8(xr_); } while (0)
        POST2_ONE(wk0, wk1, wkr, gkn0, gkn1, gkr0, gkr1, KB + (size_t)row * 1536);
#undef POST2_ONE
    }
}
__device__ __forceinline__ void p_odd_post1(const Frame& F, const Args& a, size_t ydst_off = WS_Y1) {
    const LocalId L_ = local_id(); (void)L_;
    const int gw = F.vcu * NWAVES + L_.wave, NGW = F.G * NWAVES, lane = L_.lane;
    const bf16* Y1 = (const bf16*)(F.ws + WS_Y1);
    const float2* t128 = (const float2*)(F.ws + WS_ROPE); const float2* t64 = (const float2*)(F.ws + WS_ROPE + 16384);
    for (int row = gw; row < T; row += NGW) {
        const int b = row / TPB, r = row - b * TPB; const bool xr = r >= CTX; const int s = r - CTX, prow = xr ? (s >> 6) : 0, pcol = xr ? (s & 63) : 0;
        const v4u* y = (const v4u*)(Y1 + (size_t)row * ODD_IN); v4u* yd = (v4u*)((bf16*)(F.ws + ydst_off) + (size_t)row * ODD_IN);
        const v4u kc0 = y[128 + lane], kc1 = y[192 + lane], kd0 = y[512 + (lane & 31)];
        const v4u p0 = head_chunk<64>(kc0, a.in[I_CKN], xr, prow, pcol, t64, lane), p1 = head_chunk<64>(kc1, a.in[I_CKN], xr, prow, pcol, t64, lane);
        const v4u p2 = head_chunk<128>(kd0, a.in[I_DKN], xr, prow, pcol, t128, lane);
        yd[128 + lane] = p0; yd[192 + lane] = p1; if (lane < 32) yd[512 + lane] = p2;
    }
}

__device__ __forceinline__ void p_route(const Frame& F, const Args& a, int layer) {
    const LocalId L_ = local_id(); (void)L_;
    const float* LG = (const float*)(F.ws + WS_LG); int* ROUTE = (int*)(F.ws + WS_ROUTE);
    unsigned* cnt = (unsigned*)(F.ctl + CW_CNT + layer * 64);
    const float* brg = a.in[I_BRG] + layer * 4; const float* bre = a.in[I_BRE] + layer * 32;
    const int NT = F.G * 512;
    for (int base = F.vcu * 512 + L_.wave * 64; base < T; base += NT) {
        const int t = base + L_.lane;
        bool valid = t < T; if (valid && layer == 1) valid = (t % TPB) >= CTX;
        int e0 = -1, e1 = -1; float w0 = 0.f, w1 = 0.f;
        if (valid) {
            const float* lg = LG + (size_t)t * 64;
            float g[4]; for (int i = 0; i < 4; ++i) { float v = brg[i]; for (int ks = 0; ks < RKS; ++ks) v += lg[(size_t)ks * T * 64 + i]; g[i] = v; }
            int gi = 0; float gm = g[0]; for (int i = 1; i < 4; ++i) if (g[i] > gm) { gm = g[i]; gi = i; }
            float den = 0.f; for (int i = 0; i < 4; ++i) den += expf(g[i] - gm);
            const float ptop = 1.0f / den;
            float el[8]; for (int i = 0; i < 8; ++i) { float v = bre[gi * 8 + i]; for (int ks = 0; ks < RKS; ++ks) v += lg[(size_t)ks * T * 64 + 4 + gi * 8 + i]; el[i] = v; }
            int i1 = 0; float l1 = el[0]; for (int i = 1; i < 8; ++i) if (el[i] > l1) { l1 = el[i]; i1 = i; }
            int i2 = -1; float l2 = -3.0e38f; for (int i = 0; i < 8; ++i) if (i != i1 && el[i] > l2) { l2 = el[i]; i2 = i; }
            const float ex = expf(l2 - l1), inv = 1.0f / (1.0f + ex);
            w0 = ptop * inv; w1 = ptop * ex * inv; e0 = gi * 8 + i1; e1 = gi * 8 + i2;
        }
        int pos0 = 0, pos1 = 0;
        const unsigned long long lt = (1ull << L_.lane) - 1ull;
        for (int e = 0; e < NE; ++e) {
            const unsigned long long m0 = __ballot(e0 == e), m1 = __ballot(e1 == e);
            const int n0 = __popcll(m0), n1 = __popcll(m1);
            if (n0 + n1 == 0) continue;
            unsigned basev = 0;
            if (L_.lane == 0) basev = __hip_atomic_fetch_add(cnt + e, (unsigned)(n0 + n1), RLX_AGENT);
            basev = (unsigned)__builtin_amdgcn_readfirstlane((int)basev);
            if (e0 == e) pos0 = (int)basev + __popcll(m0 & lt);
            if (e1 == e) pos1 = (int)basev + n0 + __popcll(m1 & lt);
        }
        if (valid) { int* rec = ROUTE + (size_t)t * 8; rec[0] = e0; rec[1] = e1; rec[2] = pos0; rec[3] = pos1; rec[4] = __builtin_bit_cast(int, w0); rec[5] = __builtin_bit_cast(int, w1); }
    }
}
__device__ __forceinline__ void p_mod2_route(const Frame& F, const Args& a, int layer) {
    const LocalId L_ = local_id(); (void)L_;
    const int lane = L_.lane, wave = L_.wave;
    constexpr int FPITCH = 4112;
    LAS unsigned char* Fs = F.lds + RING_OFF; LAS float* P = (LAS float*)(F.lds + RING_OFF + 16 * FPITCH + 256);
    const float* MOD = (const float*)(F.ws + WS_MOD); const bf16* H = (const bf16*)(F.ws + WS_H); bf16* A1 = (bf16*)(F.ws + WS_A1);
    const bf16* WR = (const bf16*)(F.ws + WS_WR) + (size_t)layer * 256 * 2048;
    int* ROUTE = (int*)(F.ws + WS_ROUTE); unsigned* cnt = (unsigned*)(F.ctl + CW_CNT + layer * 64); int* postok = (int*)(F.ws + WS_POS) + (size_t)layer * NE * POSCAP;
    const float* brg = a.in[I_BRG] + layer * 4; const float* bre = a.in[I_BRE] + layer * 32;
    bf16x8_t bfr[3][8];
#pragma unroll
    for (int nb = 0; nb < 3; ++nb)
#pragma unroll
        for (int ks = 0; ks < 8; ++ks) bfr[nb][ks] = *(const bf16x8_t*)(WR + (size_t)(nb * 16 + (lane & 15)) * 2048 + wave * 256 + ks * 32 + (lane >> 4) * 8);
    const int NG = layer == 1 ? NB * SEQ / 16 : T / 16;
    int it = 0;
    for (int g = F.vcu; g < NG; g += F.G, ++it) {
        int row0; if (layer == 1) { const int b = g >> 7; row0 = b * TPB + CTX + (g & 127) * 16; } else row0 = g * 16;
        const int j = mod_index(row0);
        const float* m = MOD + (size_t)(layer * 9 + j) * 12288;
        f32x4 v0[8], v1[8];
        const int r0 = 2 * wave, r1 = r0 + 1;
        hrow_load(H + (size_t)(row0 + r0) * DM, lane, v0);
        hrow_load(H + (size_t)(row0 + r1) * DM, lane, v1);
#define M2R_ROW(V, R) do { float ss = 0.f; \
        _Pragma("unroll") for (int q = 0; q < 8; ++q) ss += (V[q].x * V[q].x + V[q].y * V[q].y) + (V[q].z * V[q].z + V[q].w * V[q].w); \
        ss = wave_sum(ss); const float rn = 1.0f / sqrtf(ss * (1.0f / 2048.0f) + NORM_EPS); \
        _Pragma("unroll") for (int q = 0; q < 8; ++q) { const f32x4 sh = ((const f32x4*)(m + 3 * 2048))[lane + 64 * q], sc = ((const f32x4*)(m + 4 * 2048))[lane + 64 * q]; \
            const f32x4 y = V[q] * rn * (sc + 1.0f) + sh; v2u o; o.x = pk2(y.x, y.y); o.y = pk2(y.z, y.w); \
            ((v2u*)(A1 + (size_t)(row0 + (R)) * DM))[lane + 64 * q] = o; *(LAS v2u*)(Fs + (R) * FPITCH + (lane + 64 * q) * 8) = o; } } while (0)
        M2R_ROW(v0, r0); M2R_ROW(v1, r1);
#undef M2R_ROW
        __syncthreads();
        f32x4 acc[3];
#pragma unroll
        for (int nb = 0; nb < 3; ++nb) acc[nb] = (f32x4){0.f, 0.f, 0.f, 0.f};
#pragma unroll
        for (int ks = 0; ks < 8; ++ks) { const bf16x8_t af = *(const LAS bf16x8_t*)(Fs + (lane & 15) * FPITCH + (wave * 256 + ks * 32 + (lane >> 4) * 8) * 2);
#pragma unroll
            for (int nb = 0; nb < 3; ++nb) acc[nb] = __builtin_amdgcn_mfma_f32_16x16x32_bf16(af, bfr[nb][ks], acc[nb], 0, 0, 0); }
        LAS float* Pb = P + (it & 1) * (8 * 16 * 48);
#pragma unroll
        for (int nb = 0; nb < 3; ++nb)
#pragma unroll
            for (int rg = 0; rg < 4; ++rg) Pb[(wave * 16 + 4 * (lane >> 4) + rg) * 48 + nb * 16 + (lane & 15)] = acc[nb][rg];
        __syncthreads();
        if (wave == 0) {
            const bool valid = lane < 16; const int t = row0 + (lane & 15);
            int e0 = -1, e1 = -1; float w0 = 0.f, w1 = 0.f;
            if (valid) {
                const LAS float* pr = Pb + lane * 48;
                float gg[4];
#pragma unroll
                for (int i = 0; i < 4; ++i) { float sacc = brg[i];
#pragma unroll
                    for (int w = 0; w < 8; ++w) sacc += pr[w * 768 + i];
                    gg[i] = sacc; }
                int gi = 0; float gm = gg[0];
#pragma unroll
                for (int i = 1; i < 4; ++i) if (gg[i] > gm) { gm = gg[i]; gi = i; }
                float den = 0.f;
#pragma unroll
                for (int i = 0; i < 4; ++i) den += expf(gg[i] - gm);
                const float ptop = 1.0f / den;
                float el[8];
#pragma unroll
                for (int i = 0; i < 8; ++i) { float sacc = bre[gi * 8 + i];
#pragma unroll
                    for (int w = 0; w < 8; ++w) sacc += pr[w * 768 + 4 + gi * 8 + i];
                    el[i] = sacc; }
                int i1 = 0; float l1 = el[0];
#pragma unroll
                for (int i = 1; i < 8; ++i) if (el[i] > l1) { l1 = el[i]; i1 = i; }
                int i2 = -1; float l2 = -3.0e38f;
#pragma unroll
                for (int i = 0; i < 8; ++i) if (i != i1 && el[i] > l2) { l2 = el[i]; i2 = i; }
                const float ex = expf(l2 - l1), inv = 1.0f / (1.0f + ex);
                w0 = ptop * inv; w1 = ptop * ex * inv; e0 = gi * 8 + i1; e1 = gi * 8 + i2;
            }
            int rank0 = 0, rank1 = 0, mycnt = 0;
            const unsigned long long lt = (1ull << lane) - 1ull;
            for (int e = 0; e < NE; ++e) {
                const unsigned long long m0 = __ballot(e0 == e), m1 = __ballot(e1 == e);
                const int n0 = __popcll(m0), n1 = __popcll(m1);
                if (lane == e) mycnt = n0 + n1;
                if (e0 == e) rank0 = __popcll(m0 & lt);
                if (e1 == e) rank1 = n0 + __popcll(m1 & lt);
            }
            int basev = 0;
            if (lane < NE && mycnt > 0) basev = (int)__hip_atomic_fetch_add(cnt + lane, (unsigned)mycnt, RLX_AGENT);
            const int pos0 = __shfl(basev, e0 & 31) + rank0, pos1 = __shfl(basev, e1 & 31) + rank1;
            if (valid) { int* rec = ROUTE + (size_t)t * 8; rec[0] = e0; rec[1] = e1; rec[2] = pos0; rec[3] = pos1; rec[4] = __builtin_bit_cast(int, w0); rec[5] = __builtin_bit_cast(int, w1);
                         postok[(size_t)e0 * POSCAP + pos0] = t; postok[(size_t)e1 * POSCAP + pos1] = t; }
        }
    }
    __syncthreads();
}
__device__ __forceinline__ void p_gather(const Frame& F, int layer) {
    const LocalId L_ = local_id(); (void)L_;
    LAS int* offs = (LAS int*)(F.lds + RING_OFF);
    if (L_.tid == 0) { int o = 0; for (int e = 0; e < NE; ++e) { offs[e] = o; const unsigned c = __hip_atomic_load((unsigned*)(F.ctl + CW_CNT + layer * 64 + e), RLX_AGENT); o += (int)((c + 255u) & ~255u); } offs[NE] = o; }
    __syncthreads();
    if (blockIdx.x == 0 && L_.tid < NE) { const int e = L_.tid; int* texp = (int*)(F.ctl + CW_TEXP + layer * 256);
        for (int r = offs[e] >> 8; r < (offs[e + 1] >> 8); ++r) texp[r] = e;
        if (e == 0) *(int*)(F.ctl + CW_NRT + layer * 64) = offs[NE] >> 8; }
    int* ROUTE = (int*)(F.ws + WS_ROUTE); int* slot_tok = (int*)(F.ctl + CW_SLOT + layer * MAXSLOT);
    for (int t = F.vcu * 512 + L_.tid; t < T; t += F.G * 512) {
        if (layer == 1 && (t % TPB) < CTX) continue;
        int* rec = ROUTE + (size_t)t * 8;
        const int s0 = offs[rec[0]] + rec[2], s1 = offs[rec[1]] + rec[3];
        slot_tok[s0] = t; slot_tok[s1] = t; rec[6] = s0; rec[7] = s1;
    }
    __syncthreads();
}

constexpr int SLD = 2304;
template <int DQ, int QR>
__device__ __forceinline__ void naive_scores_softmax(LAS float* S, LAS float* qf, const bf16* Q, int ldq, const bf16* K, int ldk, int lo, int nk, float scale,
                                                     bool window, int qpos0, bool has_sink, float sink, int tid, int lane, int wave) {
    for (int i = tid; i < QR * DQ; i += 512) { const int r = i / DQ, d = i - r * DQ; qf[i] = bf2f(Q[(size_t)r * ldq + d]); }
    __syncthreads();
    for (int t = tid; t < nk; t += 512) {
        const int kr = t < CTX ? t : CTX + lo + (t - CTX);
        const bf16* kp = K + (size_t)kr * ldk;
        float acc[QR];
#pragma unroll
        for (int r = 0; r < QR; ++r) acc[r] = 0.f;
        for (int d = 0; d < DQ; d += 8) {
            const v4u kv = *(const v4u*)(kp + d);
            const float k0 = bflo(kv.x), k1 = bfhi(kv.x), k2 = bflo(kv.y), k3 = bfhi(kv.y), k4 = bflo(kv.z), k5 = bfhi(kv.z), k6 = bflo(kv.w), k7 = bfhi(kv.w);
#pragma unroll
            for (int r = 0; r < QR; ++r) { const LAS float* qp = qf + r * DQ + d;
                acc[r] += (k0 * qp[0] + k1 * qp[1]) + (k2 * qp[2] + k3 * qp[3]) + (k4 * qp[4] + k5 * qp[5]) + (k6 * qp[6] + k7 * qp[7]); }
        }
#pragma unroll
        for (int r = 0; r < QR; ++r) { float s = acc[r] * scale;
            if (window && t >= CTX) { const int dd = (qpos0 + r) - (lo + t - CTX); if (dd > 128 || dd < -128) s = -1e30f; }
            S[r * SLD + t] = s; }
    }
    __syncthreads();
    if (wave < QR) {
        LAS float* row = S + wave * SLD;
        float m = -1e30f; for (int t = lane; t < nk; t += 64) m = fmaxf(m, row[t]);
        m = wave_max(m); if (has_sink) m = fmaxf(m, sink);
        float sum = 0.f; for (int t = lane; t < nk; t += 64) { const float e = expf(row[t] - m); row[t] = e; sum += e; }
        sum = wave_sum(sum); if (has_sink) sum += expf(sink - m);
        const float inv = 1.0f / sum;
        for (int t = lane; t < nk; t += 64) row[t] *= inv;
    }
    __syncthreads();
}
template <int QR>
__device__ __forceinline__ void naive_pv(const LAS float* S, const bf16* V, int ldv, int lo, int nk, int tid, float (&o)[QR / 4]) {
    const int c = tid & 127, rg = tid >> 7; constexpr int RPT = QR / 4;
#pragma unroll
    for (int i = 0; i < RPT; ++i) o[i] = 0.f;
#pragma unroll 4
    for (int t = 0; t < nk; ++t) { const int kr = t < CTX ? t : CTX + lo + (t - CTX); const float v = bf2f(V[(size_t)kr * ldv + c]);
#pragma unroll
        for (int i = 0; i < RPT; ++i) o[i] += S[(rg * RPT + i) * SLD + t] * v; }
}
__device__ __forceinline__ void p_even_attn_naive(const Frame& F) {
    const LocalId L_ = local_id(); (void)L_;
    LAS float* S = (LAS float*)(F.lds + RING_OFF); LAS float* qf = (LAS float*)(F.lds + RING_OFF + 8 * SLD * 4);
    const bf16* Y1 = (const bf16*)(F.ws + WS_Y1); const bf16* QB = (const bf16*)(F.ws + WS_QB); const bf16* KV = (const bf16*)(F.ws + WS_KV); const bf16* KB = (const bf16*)(F.ws + WS_KB);
    bf16* MIX = (bf16*)(F.ws + WS_MIX);
    constexpr int UPV = NB * 8 * 288;
    for (int u = blockIdx.x; u < 2 * UPV; u += F.G) {
        const int var = u / UPV, rem = u - var * UPV, b = rem / 2304, rem2 = rem - b * 2304, h = rem2 / 288, ch = rem2 - h * 288;
        const int r0 = ch * 8, row0 = b * TPB + r0; const int nk = r0 < CTX ? CTX : TPB;
        float o[2];
        if (var == 0) {
            naive_scores_softmax<128, 8>(S, qf, Y1 + (size_t)row0 * EVEN_IN_P + h * 128, EVEN_IN_P, Y1 + (size_t)(b * TPB) * EVEN_IN_P + 1024 + (h >> 2) * 128, EVEN_IN_P, 0, nk,
                                         0.08838834764831845f, false, 0, false, 0.f, L_.tid, L_.lane, L_.wave);
            naive_pv<8>(S, Y1 + (size_t)(b * TPB) * EVEN_IN_P + 1280 + (h >> 2) * 128, EVEN_IN_P, 0, nk, L_.tid, o);
        } else {
            naive_scores_softmax<192, 8>(S, qf, QB + (size_t)row0 * 1536 + h * 192, 1536, KB + (size_t)(b * TPB) * 1536 + h * 192, 1536, 0, nk,
                                         0.07216878364870322f, false, 0, false, 0.f, L_.tid, L_.lane, L_.wave);
            naive_pv<8>(S, KV + (size_t)(b * TPB) * 2048 + h * 256 + 128, 2048, 0, nk, L_.tid, o);
        }
        const int c = L_.tid & 127, rg = L_.tid >> 7;
#pragma unroll
        for (int i = 0; i < 2; ++i) MIX[(size_t)(row0 + rg * 2 + i) * DM + var * 1024 + h * 128 + c] = (bf16)f2bf(o[i]);
        __syncthreads();
    }
}
__device__ __forceinline__ void p_odd_attn_naive(const Frame& F, const Args& a) {
    const LocalId L_ = local_id(); (void)L_;
    LAS float* S = (LAS float*)(F.lds + RING_OFF); LAS float* qf = (LAS float*)(F.lds + RING_OFF + 8 * SLD * 4); LAS float* ob = qf + 8 * 192;
    const bf16* Y1 = (const bf16*)(F.ws + WS_Y1); bf16* MIX = (bf16*)(F.ws + WS_MIX);
    float d1 = 0.f, d2 = 0.f;
    for (int i = 0; i < 64; ++i) { d1 += a.in[I_LQ1][i] * a.in[I_LK1][i]; d2 += a.in[I_LQ2][i] * a.in[I_LK2][i]; }
    const float lam = expf(d1) - expf(d2) + LAMBDA_INIT;
    constexpr int UC = NB * 8 * 512, UD = NB * 8 * 256;
    for (int u = blockIdx.x; u < UC + UD; u += F.G) {
        const int c = L_.tid & 127, rg = L_.tid >> 7;
        if (u < UC) {
            const int b = u / 4096, rem = u - b * 4096, h = rem / 512, ch = rem - h * 512;
            const int r0 = CTX + ch * 4, row0 = b * TPB + r0; const int nk = TPB;
            const bf16* kb = Y1 + (size_t)(b * TPB) * ODD_IN;
            naive_scores_softmax<64, 4>(S, qf, Y1 + (size_t)row0 * ODD_IN + (2 * h) * 64, ODD_IN, kb + 1024 + (2 * h) * 64, ODD_IN, 0, nk, 0.125f, false, 0, false, 0.f, L_.tid, L_.lane, L_.wave);
            naive_scores_softmax<64, 4>(S + 4 * SLD, qf, Y1 + (size_t)row0 * ODD_IN + (2 * h + 1) * 64, ODD_IN, kb + 1024 + (2 * h + 1) * 64, ODD_IN, 0, nk, 0.125f, false, 0, false, 0.f, L_.tid, L_.lane, L_.wave);
            for (int i = L_.tid; i < 4 * SLD; i += 512) S[i] = S[i] - lam * S[4 * SLD + i];
            __syncthreads();
            float o[1];
            naive_pv<4>(S, kb + 2048 + h * 128, ODD_IN, 0, nk, L_.tid, o);
            ob[rg * 128 + c] = o[0];
            __syncthreads();
            float ss = 0.f; for (int i = 0; i < 128; ++i) { const float v = ob[rg * 128 + i]; ss += v * v; }
            const float r = 1.0f / sqrtf(ss * (1.0f / 128.0f) + NORM_EPS);
            MIX[(size_t)(row0 + rg) * DM + h * 128 + c] = (bf16)f2bf(o[0] * r * a.in[I_SUBLN][c] * (1.0f - LAMBDA_INIT));
        } else {
            const int v = u - UC, b = v / 2048, rem = v - b * 2048, h = rem / 256, ch = rem - h * 256;
            const int s0 = ch * 8, row0 = b * TPB + CTX + s0;
            const int lo = s0 - 128 < 0 ? 0 : s0 - 128, hi = s0 + 7 + 128 > SEQ - 1 ? SEQ - 1 : s0 + 7 + 128; const int nk = CTX + (hi - lo + 1);
            const bf16* kb = Y1 + (size_t)(b * TPB) * ODD_IN;
            naive_scores_softmax<128, 8>(S, qf, Y1 + (size_t)row0 * ODD_IN + 3072 + h * 128, ODD_IN, kb + 4096 + (h >> 2) * 128, ODD_IN, lo, nk, 0.08838834764831845f, true, s0, true, a.in[I_SINK][h], L_.tid, L_.lane, L_.wave);
            float o[2];
            naive_pv<8>(S, kb + 4352 + (h >> 2) * 128, ODD_IN, lo, nk, L_.tid, o);
#pragma unroll
            for (int i = 0; i < 2; ++i) MIX[(size_t)(row0 + rg * 2 + i) * DM + 1024 + h * 128 + c] = (bf16)f2bf(o[i]);
        }
        __syncthreads();
    }
}

namespace att {
using bf16x8 = __attribute__((ext_vector_type(8))) short;
using s16x4  = __attribute__((ext_vector_type(4))) short;
using f32x16 = __attribute__((ext_vector_type(16))) float;
using u32x4  = __attribute__((ext_vector_type(4))) unsigned;
using f32x2  = __attribute__((ext_vector_type(2))) float;
#ifndef ATT_PK_SM
#define ATT_PK_SM 1
#endif
constexpr int KVBLK = 64, QBLK = 32;
constexpr int SHM_V = KVBLK * 128 * 2;
constexpr int K_OFF = 2 * SHM_V, K_MAX = KVBLK * 192 * 2, QL_OFF = K_OFF + 2 * K_MAX, WS_OFF = 131072 + 2048;
constexpr float THR = 8.f;
#define ATT_KSWZ(row, colB, RB) ((row) * (RB) + ((colB) ^ (((row) & 7) << 4)))
#define ATT_SBAR() __builtin_amdgcn_sched_barrier(0)
__device__ __forceinline__ int crow(int r, int hi) { return (r & 3) + 8 * (r >> 2) + 4 * hi; }
__device__ __forceinline__ unsigned cvtpk(float lo, float hi) { unsigned r; asm volatile("v_cvt_pk_bf16_f32 %0, %1, %2" : "=v"(r) : "v"(lo), "v"(hi)); return r; }

__device__ __forceinline__ void partialSM(f32x16& p0, f32x16& p1, float& m_reg, float& mn, float& alpha, float C, float thr_raw) {
  float pmax = p0[0];
#pragma unroll
  for (int r = 1; r < 16; ++r) pmax = fmaxf(pmax, p0[r]);
#pragma unroll
  for (int r = 0; r < 16; ++r) pmax = fmaxf(pmax, p1[r]);
  { auto rr = __builtin_amdgcn_permlane32_swap(__float_as_uint(pmax), __float_as_uint(pmax), false, false);
    pmax = fmaxf(__uint_as_float(rr[0]), __uint_as_float(rr[1])); }
  if (__builtin_expect(__all(pmax - m_reg <= thr_raw), 1)) { mn = m_reg; alpha = 1.f; }
  else { mn = fmaxf(m_reg, pmax); alpha = __builtin_amdgcn_exp2f((m_reg - mn) * C); m_reg = mn; }
  const float mnC = -mn * C;
#if ATT_PK_SM
  { const f32x2 C2 = {C, C}, M2 = {mnC, mnC};
#pragma unroll
    for (int r = 0; r < 16; r += 2) { f32x2 t = {p0[r], p0[r + 1]}; t = __builtin_elementwise_fma(t, C2, M2); p0[r] = t.x; p0[r + 1] = t.y; }
#pragma unroll
    for (int r = 0; r < 16; r += 2) { f32x2 t = {p1[r], p1[r + 1]}; t = __builtin_elementwise_fma(t, C2, M2); p1[r] = t.x; p1[r + 1] = t.y; } }
#else
#pragma unroll
  for (int r = 0; r < 16; ++r) p0[r] = fmaf(p0[r], C, mnC);
#pragma unroll
  for (int r = 0; r < 16; ++r) p1[r] = fmaf(p1[r], C, mnC);
#endif
#pragma unroll
  for (int r = 0; r < 16; ++r) p0[r] = __builtin_amdgcn_exp2f(p0[r]);
}
__device__ __forceinline__ void finishSM(f32x16& p0, f32x16& p1, float alpha, float& l_reg, bf16x8& pa0, bf16x8& pa1, bf16x8& pa2, bf16x8& pa3) {
#pragma unroll
  for (int r = 0; r < 16; ++r) p1[r] = __builtin_amdgcn_exp2f(p1[r]);
#if ATT_PK_SM
  f32x2 ps2 = {p0[0], p0[1]};
#pragma unroll
  for (int r = 2; r < 16; r += 2) ps2 += (f32x2){p0[r], p0[r + 1]};
#pragma unroll
  for (int r = 0; r < 16; r += 2) ps2 += (f32x2){p1[r], p1[r + 1]};
  float ps = ps2.x + ps2.y;
#else
  float ps = 0;
#pragma unroll
  for (int r = 0; r < 16; ++r) ps += p0[r];
#pragma unroll
  for (int r = 0; r < 16; ++r) ps += p1[r];
#endif
  { auto rr = __builtin_amdgcn_permlane32_swap(__float_as_uint(ps), __float_as_uint(ps), false, false);
    ps = __uint_as_float(rr[0]) + __uint_as_float(rr[1]); }
  l_reg = l_reg * alpha + ps;
#define ATT_PK4(P, BASE, OUT) do { unsigned a0 = cvtpk(P[BASE + 0], P[BASE + 1]), a1 = cvtpk(P[BASE + 2], P[BASE + 3]);   \
    unsigned b0 = cvtpk(P[BASE + 4], P[BASE + 5]), b1 = cvtpk(P[BASE + 6], P[BASE + 7]);                              \
    auto r0 = __builtin_amdgcn_permlane32_swap(a0, b0, false, false); auto r1 = __builtin_amdgcn_permlane32_swap(a1, b1, false, false); \
    u32x4 w = {r0[0], r1[0], r0[1], r1[1]}; OUT = *reinterpret_cast<bf16x8*>(&w); } while (0)
  ATT_PK4(p0, 0, pa0); ATT_PK4(p0, 8, pa1); ATT_PK4(p1, 0, pa2); ATT_PK4(p1, 8, pa3);
#undef ATT_PK4
}
template <int DQ, int NQT, int NQR, int QSB>
__device__ __forceinline__ void qkt(f32x16& p0, f32x16& p1, const char* Ks, const bf16x8 (&qr)[NQR], const char* qlds, const int (&kb)[4]) {
  p0 = f32x16{}; p1 = f32x16{};
#pragma unroll
  for (int d0 = 0; d0 < NQT; ++d0) {
    const bf16x8 b0 = *reinterpret_cast<const bf16x8*>(Ks + kb[d0 & 3] + (d0 >> 2) * 128);
    const bf16x8 b1 = *reinterpret_cast<const bf16x8*>(Ks + kb[d0 & 3] + (d0 >> 2) * 128 + 32 * DQ * 2);
    bf16x8 q; if (d0 < NQR) q = qr[d0 < NQR ? d0 : 0]; else q = *reinterpret_cast<const bf16x8*>(qlds + (d0 - NQR) * 1024);
    p0 = __builtin_amdgcn_mfma_f32_32x32x16_bf16(b0, q, p0, 0, 0, 0);
    p1 = __builtin_amdgcn_mfma_f32_32x32x16_bf16(b1, q, p1, 0, 0, 0);
    if (QSB > 0 && (d0 % (QSB > 0 ? QSB : 1)) == (QSB - 1) && d0 + 1 < NQT) ATT_SBAR(); }
}
__device__ __forceinline__ void mask_tile(f32x16& p0, f32x16& p1, int kp0, int qpos, int hi) {
#pragma unroll
  for (int r = 0; r < 16; ++r) { const int d = qpos - (kp0 + crow(r, hi));
    if (d > 128 || d < -128) p0[r] = -1e30f;
    if (d - 32 > 128 || d - 32 < -128) p1[r] = -1e30f; }
}
__device__ __forceinline__ int v_st(int k, int c) { const int kk = (k & ~0xC) | ((k & 4) << 1) | ((k & 8) >> 1); return ((kk >> 3) * 4 + (c >> 5)) * 512 + ((kk & 7) * 32 + (c & 31)) * 2; }
__device__ __forceinline__ int v_rd_base(int lane) { return ((lane & 3) << 3) | (((lane >> 2) & 3) << 6) | (((lane >> 4) & 1) << 5) | (((lane >> 5) & 1) << 8); }
constexpr int v_rd_off(int d0, int ks, int half) { return d0 * 512 + ks * 4096 + half * 2048; }
template <int OFF> __device__ __forceinline__ s16x4 tr_read(int vb) {
  s16x4 r; asm volatile("ds_read_b64_tr_b16 %0, %1 offset:%2" : "=&v"(r) : "v"(vb), "i"(OFF) : "memory"); return r;
}
template <int D0> __device__ __forceinline__ void pv_one(f32x16& od, int vb, bf16x8 pa0, bf16x8 pa1, bf16x8 pa2, bf16x8 pa3) {
  const s16x4 l0 = tr_read<v_rd_off(D0, 0, 0)>(vb), h0 = tr_read<v_rd_off(D0, 0, 1)>(vb), l1 = tr_read<v_rd_off(D0, 1, 0)>(vb), h1 = tr_read<v_rd_off(D0, 1, 1)>(vb);
  const s16x4 l2 = tr_read<v_rd_off(D0, 2, 0)>(vb), h2 = tr_read<v_rd_off(D0, 2, 1)>(vb), l3 = tr_read<v_rd_off(D0, 3, 0)>(vb), h3 = tr_read<v_rd_off(D0, 3, 1)>(vb);
  asm volatile("s_waitcnt lgkmcnt(0)" ::: "memory"); ATT_SBAR();
#define ATT_PK(L, H) (bf16x8){L[0], L[1], L[2], L[3], H[0], H[1], H[2], H[3]}
  od = __builtin_amdgcn_mfma_f32_32x32x16_bf16(pa0, ATT_PK(l0, h0), od, 0, 0, 0);
  od = __builtin_amdgcn_mfma_f32_32x32x16_bf16(pa1, ATT_PK(l1, h1), od, 0, 0, 0);
  od = __builtin_amdgcn_mfma_f32_32x32x16_bf16(pa2, ATT_PK(l2, h2), od, 0, 0, 0);
  od = __builtin_amdgcn_mfma_f32_32x32x16_bf16(pa3, ATT_PK(l3, h3), od, 0, 0, 0);
#undef ATT_PK
}
__device__ __forceinline__ void pv_d0(f32x16* o, int vb, bf16x8 pa0, bf16x8 pa1, bf16x8 pa2, bf16x8 pa3) {
  pv_one<0>(o[0], vb, pa0, pa1, pa2, pa3); pv_one<1>(o[1], vb, pa0, pa1, pa2, pa3); pv_one<2>(o[2], vb, pa0, pa1, pa2, pa3); pv_one<3>(o[3], vb, pa0, pa1, pa2, pa3);
}

template <int M> __device__ __forceinline__ float swz_xor(float v) { return __builtin_bit_cast(float, __builtin_amdgcn_ds_swizzle(__builtin_bit_cast(int, v), (M << 10) | 0x1F)); }
__device__ __forceinline__ float sum_xor32(float v) { auto rr = __builtin_amdgcn_permlane32_swap(__float_as_uint(v), __float_as_uint(v), false, false); return __uint_as_float(rr[0]) + __uint_as_float(rr[1]); }
__device__ __forceinline__ float bfx(short v) { return __builtin_bit_cast(float, ((unsigned)(unsigned short)v) << 16); }
template <int MODE, int NQ>
__device__ __forceinline__ void q_fix(bf16x8 (&q)[NQ], const float* gain, const float* tab  , int pos, int hi) {
  constexpr int DIM = NQ * 16;
  float x[NQ][8]; float ss = 0.f;
#pragma unroll
  for (int d0 = 0; d0 < NQ; ++d0)
#pragma unroll
    for (int j = 0; j < 8; ++j) { x[d0][j] = bfx(q[d0][j]); ss += x[d0][j] * x[d0][j]; }
  ss = sum_xor32(ss);
  const float r = 1.0f / sqrtf(ss * (1.0f / DIM) + 1e-6f);
#pragma unroll
  for (int d0 = 0; d0 < NQ; ++d0) { const float* g = gain + d0 * 16 + hi * 8;
#pragma unroll
    for (int j = 0; j < 8; ++j) x[d0][j] *= r * g[j]; }
  if (pos >= 0) {
    const int prow = pos >> 6, pcol = pos & 63;
    constexpr int RB0 = (MODE == 2) ? 8 : 0, NRB = (MODE == 1) ? 8 : 4, NF = (MODE == 1) ? 32 : 16, PX = (MODE == 1) ? 2 : 1;
    float y[NRB][8];
#pragma unroll
    for (int b = 0; b < NRB; ++b) { const int p = (b < NRB / 2) ? prow : pcol; const int f0 = (MODE == 1 ? (b & 1) * 16 : 0) + hi * 8; const float sg = (b & PX) ? 1.0f : -1.0f;
      const float* t = tab + (size_t)(p * NF + f0) * 2;
#pragma unroll
      for (int j = 0; j < 8; ++j) y[b][j] = x[RB0 + b][j] * t[2 * j] + sg * x[RB0 + (b ^ PX)][j] * t[2 * j + 1]; }
#pragma unroll
    for (int b = 0; b < NRB; ++b)
#pragma unroll
      for (int j = 0; j < 8; ++j) x[RB0 + b][j] = y[b][j];
  }
#pragma unroll
  for (int d0 = 0; d0 < NQ; ++d0) { u32x4 w; w.x = cvtpk(x[d0][0], x[d0][1]); w.y = cvtpk(x[d0][2], x[d0][3]); w.z = cvtpk(x[d0][4], x[d0][5]); w.w = cvtpk(x[d0][6], x[d0][7]); q[d0] = *reinterpret_cast<bf16x8*>(&w); }
}

template <int DQ, bool WINDOW, bool SINK, int LDQ, int LDK, int LDV, int SD, int QSB, int NQRMAX, bool DIFF = false, int QMODE = 0>
__device__ __forceinline__ void attn_unit(const bf16* __restrict__ Qb, const bf16* __restrict__ Kb, const bf16* __restrict__ Vb,
                                          bf16* __restrict__ Ob, int ntiles, int band_lo, int qpos0, float scale, float sink, char* lds, const float* gainp = nullptr,
                                          const float* qgain = nullptr, const float* qtab = nullptr, int qs0 = -1, int wv = 0) {
  constexpr int NQ = (DIFF ? DQ / 2 : DQ) / 16, NQR = NQ > NQRMAX ? NQRMAX : NQ, NCH = DQ / 64, RB = DQ * 2, SHM_K = KVBLK * DQ * 2, LDO = 2048;
  int tid = wv * 64 + lane_id_(); asm volatile("" : "+v"(tid));
  const int wid = tid >> 6, lane = tid & 63, r32 = lane & 31, hi = lane >> 5;
  const int comp = DIFF ? (wid >> 2) : 0, wrow = DIFF ? (wid & 3) : wid, kcomp = comp * 128;
  char* V_lds = lds; char* K_lds = lds + K_OFF;
  float* ws = (float*)(lds + WS_OFF) + wid * 64; float* li_l = ws; float* al_l = ws + 32;
  const float C = scale * 1.4426950408889634f, thr_raw = THR / scale;
  float m_reg = -1e30f, l_reg = 0; f32x16 o[4] = {}; bf16x8 qr[NQR];
  const unsigned qoff = (unsigned)((wrow * QBLK + r32) * LDQ + hi * 8 + comp * 64) * 2u;
  char* qlds = lds + QL_OFF + wid * ((NQ - NQR) * 1024) + lane * 16;
  if constexpr (QMODE == 0) {
#pragma unroll
    for (int d0 = 0; d0 < NQR; ++d0) qr[d0] = *reinterpret_cast<const bf16x8*>((const char*)Qb + qoff + d0 * 32);
    __syncthreads();
    if constexpr (NQ > NQR) {
#pragma unroll
      for (int d0 = NQR; d0 < NQ; ++d0) *reinterpret_cast<bf16x8*>(qlds + (d0 - NQR) * 1024) = *reinterpret_cast<const bf16x8*>((const char*)Qb + qoff + d0 * 32);
    }
  } else {
    bf16x8 qall[NQ];
#pragma unroll
    for (int d0 = 0; d0 < NQ; ++d0) qall[d0] = *reinterpret_cast<const bf16x8*>((const char*)Qb + qoff + d0 * 32);
    q_fix<QMODE, NQ>(qall, qgain, qtab, qs0 < 0 ? -1 : qs0 + wrow * QBLK + r32, hi);
#pragma unroll
    for (int d0 = 0; d0 < NQR; ++d0) qr[d0] = qall[d0];
    __syncthreads();
    if constexpr (NQ > NQR) {
#pragma unroll
      for (int d0 = NQR; d0 < NQ; ++d0) *reinterpret_cast<bf16x8*>(qlds + (d0 - NQR) * 1024) = qall[d0];
    }
  }
  const int sr = tid >> 4, sc = (tid & 15) * 8, vst0 = v_st(sr, sc);
  const unsigned voV = (unsigned)(sr * LDV + sc) * 2u;
  const int kr_ = tid >> 3, kc_ = (tid & 7) * 8;
  const unsigned voK = (unsigned)(kr_ * LDK + kc_) * 2u; const int kwr = ATT_KSWZ(kr_, kc_ * 2, RB);
  const int vb0 = (int)(uintptr_t)V_lds + v_rd_base(lane);
  int kb[4];
#pragma unroll
  for (int k = 0; k < 4; ++k) kb[k] = r32 * RB + ((k ^ ((r32 & 7) >> 1)) * 32) + ((hi ^ (r32 & 1)) * 16);
  const int qpos = qpos0 + wrow * QBLK + r32;
  struct { bf16x8 vs0, vs1, ks[NCH]; } sr_[SD];
#define ATT_KROW(j) (WINDOW ? ((j) < 4 ? (j) * KVBLK : 256 + band_lo + ((j) - 4) * KVBLK) : (j) * KVBLK)
#define ATT_SLOAD(i, j) do { const int k0_ = ATT_KROW(j); const char* vt_ = (const char*)Vb + (size_t)k0_ * (LDV * 2); const char* kt_ = (const char*)Kb + (size_t)k0_ * (LDK * 2); \
    sr_[i].vs0 = *reinterpret_cast<const bf16x8*>(vt_ + voV); sr_[i].vs1 = *reinterpret_cast<const bf16x8*>(vt_ + voV + 32 * LDV * 2); \
    _Pragma("unroll") for (int c_ = 0; c_ < NCH; ++c_) sr_[i].ks[c_] = *reinterpret_cast<const bf16x8*>(kt_ + voK + c_ * 128); } while (0)
#define ATT_SWRITE(b, i) do { *(bf16x8*)(V_lds + (b) * SHM_V + vst0) = sr_[i].vs0; *(bf16x8*)(V_lds + (b) * SHM_V + vst0 + 8192) = sr_[i].vs1; \
    _Pragma("unroll") for (int c_ = 0; c_ < NCH; ++c_) *(bf16x8*)(K_lds + (b) * SHM_K + kwr + c_ * 128) = sr_[i].ks[c_]; } while (0)
#define ATT_SWAIT() do { if constexpr (SD == 1) asm volatile("s_waitcnt vmcnt(0)" ::: "memory"); else if constexpr (NCH == 1) asm volatile("s_waitcnt vmcnt(3)" ::: "memory"); else if constexpr (NCH == 2) asm volatile("s_waitcnt vmcnt(4)" ::: "memory"); else asm volatile("s_waitcnt vmcnt(5)" ::: "memory"); } while (0)
#define ATT_RESC(a) do { if (__any((a) < 1.f)) { if (hi == 0) al_l[r32] = (a); asm volatile("s_waitcnt lgkmcnt(0)" ::: "memory"); \
    _Pragma("unroll") for (int d = 0; d < 4; ++d) _Pragma("unroll") for (int r = 0; r < 16; ++r) o[d][r] *= al_l[crow(r, hi)]; } } while (0)
#define ATT_MASK(P0, P1, j) do { if constexpr (WINDOW) { if ((j) >= 4) mask_tile(P0, P1, band_lo + ((j) - 4) * KVBLK, qpos, hi); } } while (0)
  f32x16 pA0, pA1, pB0, pB1; float mnA, mnB, alA, alB; bf16x8 pa0, pa1, pa2, pa3; const int NT = ntiles;
  constexpr int SE = 0, SO = SD - 1;
  ATT_SLOAD(SE, 0); asm volatile("s_waitcnt vmcnt(0)" ::: "memory"); ATT_SWRITE(0, SE); __syncthreads();
  qkt<DQ, NQ, NQR, QSB>(pA0, pA1, K_lds + kcomp, qr, qlds, kb); ATT_MASK(pA0, pA1, 0); partialSM(pA0, pA1, m_reg, mnA, alA, C, thr_raw);
  ATT_SLOAD(SO, 1); if constexpr (SD == 2) { if (2 < NT) ATT_SLOAD(SE, 2); }
  ATT_SWAIT(); ATT_SWRITE(1, SO); __syncthreads();
  for (int j = 1; j + 1 < NT; j += 2) {
    ATT_SBAR(); qkt<DQ, NQ, NQR, QSB>(pB0, pB1, K_lds + SHM_K + kcomp, qr, qlds, kb);
    finishSM(pA0, pA1, alA, l_reg, pa0, pa1, pa2, pa3); ATT_SBAR();
    ATT_SLOAD(SO, j + SD); ATT_SBAR();
    pv_d0(o, vb0, pa0, pa1, pa2, pa3); ATT_MASK(pB0, pB1, j); partialSM(pB0, pB1, m_reg, mnB, alB, C, thr_raw);
    __syncthreads(); ATT_SWAIT(); ATT_SWRITE(0, SE);
    ATT_RESC(alB); __syncthreads();
    ATT_SBAR(); qkt<DQ, NQ, NQR, QSB>(pA0, pA1, K_lds + kcomp, qr, qlds, kb);
    finishSM(pB0, pB1, alB, l_reg, pa0, pa1, pa2, pa3); ATT_SBAR();
    if (SD == 1 || j + 3 < NT) ATT_SLOAD(SE, j + 1 + SD); ATT_SBAR();
    pv_d0(o, vb0 + SHM_V, pa0, pa1, pa2, pa3); ATT_MASK(pA0, pA1, j + 1); partialSM(pA0, pA1, m_reg, mnA, alA, C, thr_raw);
    __syncthreads(); ATT_SWAIT(); ATT_SWRITE(1, SO);
    ATT_RESC(alA); __syncthreads();
  }
  ATT_SBAR(); qkt<DQ, NQ, NQR, QSB>(pB0, pB1, K_lds + SHM_K + kcomp, qr, qlds, kb);
  finishSM(pA0, pA1, alA, l_reg, pa0, pa1, pa2, pa3); ATT_SBAR();
  pv_d0(o, vb0, pa0, pa1, pa2, pa3); ATT_MASK(pB0, pB1, NT - 1); partialSM(pB0, pB1, m_reg, mnB, alB, C, thr_raw);
  __syncthreads(); ATT_RESC(alB);
  finishSM(pB0, pB1, alB, l_reg, pa0, pa1, pa2, pa3); ATT_SBAR();
  pv_d0(o, vb0 + SHM_V, pa0, pa1, pa2, pa3);
  if constexpr (SINK) l_reg += __builtin_amdgcn_exp2f(sink * 1.4426950408889634f - m_reg * C);
  if (hi == 0) li_l[r32] = l_reg; asm volatile("s_waitcnt lgkmcnt(0)" ::: "memory");
  float rli[16];
#pragma unroll
  for (int r = 0; r < 16; ++r) rli[r] = __builtin_amdgcn_rcpf(li_l[crow(r, hi)]);
  int tid2 = wv * 64 + lane_id_(); asm volatile("" : "+v"(tid2));
  if constexpr (!DIFF) {
    const bool odd = tid2 & 1;
    const unsigned ooff = (unsigned)(((tid2 >> 6) * QBLK + 4 * ((tid2 >> 5) & 1) + (tid2 & 1)) * LDO + (tid2 & 30)) * 2u;
#pragma unroll
    for (int rp = 0; rp < 8; ++rp) { const int orow = ((2 * rp) & 3) + 8 * ((2 * rp) >> 2);
#pragma unroll
      for (int d0 = 0; d0 < 4; ++d0) { const float a_ = o[d0][2 * rp] * rli[2 * rp], b_ = o[d0][2 * rp + 1] * rli[2 * rp + 1];
        const float rc = swz_xor<1>(odd ? a_ : b_);
        *reinterpret_cast<unsigned*>((char*)Ob + ooff + (orow * LDO + d0 * 32) * 2) = odd ? cvtpk(rc, b_) : cvtpk(a_, rc); } }
  } else {
    float* X = (float*)lds + ((tid2 >> 6) & 3) * 4096 + (tid2 & 63);
    __syncthreads();
    if (tid2 >= 256) {
#pragma unroll
      for (int d0 = 0; d0 < 4; ++d0)
#pragma unroll
        for (int r = 0; r < 16; ++r) X[(d0 * 16 + r) * 64] = sink * (o[d0][r] * rli[r]);
    }
    __syncthreads();
    if (tid2 < 256) {
      float g[4];
#pragma unroll
      for (int d0 = 0; d0 < 4; ++d0) g[d0] = gainp[d0 * 32 + (tid2 & 31)];
      const bool odd = tid2 & 1;
      const unsigned ooff = (unsigned)(((tid2 >> 6) * QBLK + 4 * ((tid2 >> 5) & 1) + (tid2 & 1)) * LDO + (tid2 & 30)) * 2u;
#pragma unroll
      for (int rp = 0; rp < 8; ++rp) { const int orow = ((2 * rp) & 3) + 8 * ((2 * rp) >> 2);
        float da[4], db[4], sa = 0.f, sb = 0.f;
#pragma unroll
        for (int d0 = 0; d0 < 4; ++d0) { da[d0] = o[d0][2 * rp] * rli[2 * rp] - X[(d0 * 16 + 2 * rp) * 64]; db[d0] = o[d0][2 * rp + 1] * rli[2 * rp + 1] - X[(d0 * 16 + 2 * rp + 1) * 64]; sa += da[d0] * da[d0]; sb += db[d0] * db[d0]; }
        sa += swz_xor<1>(sa); sa += swz_xor<2>(sa); sa += swz_xor<4>(sa); sa += swz_xor<8>(sa); sa += swz_xor<16>(sa);
        sb += swz_xor<1>(sb); sb += swz_xor<2>(sb); sb += swz_xor<4>(sb); sb += swz_xor<8>(sb); sb += swz_xor<16>(sb);
        const float ra = __builtin_amdgcn_rsqf(sa * (1.0f / 128.0f) + 1e-6f), rb = __builtin_amdgcn_rsqf(sb * (1.0f / 128.0f) + 1e-6f);
#pragma unroll
        for (int d0 = 0; d0 < 4; ++d0) { const float a_ = da[d0] * ra * g[d0], b_ = db[d0] * rb * g[d0];
          const float rc = swz_xor<1>(odd ? a_ : b_);
          *reinterpret_cast<unsigned*>((char*)Ob + ooff + (orow * LDO + d0 * 32) * 2) = odd ? cvtpk(rc, b_) : cvtpk(a_, rc); } }
    }
  }
#undef ATT_KROW
#undef ATT_SLOAD
#undef ATT_SWRITE
#undef ATT_SWAIT
#undef ATT_RESC
#undef ATT_MASK
}
}

__device__ __forceinline__ void p_even_attn(const Frame& F, const Args& a, char* lds) {
    const LocalId L_ = local_id(); (void)L_;
    const bf16* Y1 = (const bf16*)(F.ws + WS_Y1); const bf16* QB = (const bf16*)(F.ws + WS_QB); const bf16* KV = (const bf16*)(F.ws + WS_KV); const bf16* KB = (const bf16*)(F.ws + WS_KB);
    bf16* MIX = (bf16*)(F.ws + WS_MIX);
    const float* t128 = (const float*)(F.ws + WS_ROPE); const float* t64 = (const float*)(F.ws + WS_ROPE + 16384);
    for (int n = blockIdx.x; n < 512 + 64; n += F.G) {
        int b, h, row0, nt, qs0;
        if (n < 512) { const int i = n >> 8, c = n & 255, x = c & 7, lc = c >> 3, gi = i * 8 + x; b = gi >> 1; h = (gi & 1) * 4 + (lc >> 3); qs0 = (lc & 7) * 256; row0 = b * TPB + CTX + qs0; nt = 36; }
        else { const int m = n - 512; b = m >> 3; h = m & 7; row0 = b * TPB; nt = 4; qs0 = -1; }
        const size_t kb = (size_t)b * TPB;
        att::attn_unit<128, false, false, EVEN_IN_P, EVEN_IN_P, EVEN_IN_P, 2, 0, 8, false, 1>(Y1 + (size_t)row0 * EVEN_IN_P + h * 128, Y1 + kb * EVEN_IN_P + 1024 + (h >> 2) * 128, Y1 + kb * EVEN_IN_P + 1280 + (h >> 2) * 128,
                                                                                 MIX + (size_t)row0 * DM + h * 128, nt, 0, 0, 0.08838834764831845f, 0.f, lds, nullptr, a.in[I_AQN], t128, qs0, L_.wave);
    }
    for (int n = blockIdx.x; n < 512 + 64; n += F.G) {
        int b, h, row0, nt, qs0;
        if (n < 512) { const int i = n >> 8, c = n & 255, x = c & 7, lc = c >> 3, gi = i * 8 + x; b = gi >> 1; h = (gi & 1) * 4 + (lc >> 3); qs0 = (lc & 7) * 256; row0 = b * TPB + CTX + qs0; nt = 36; }
        else { const int m = n - 512; b = m >> 3; h = m & 7; row0 = b * TPB; nt = 4; qs0 = -1; }
        const size_t kb = (size_t)b * TPB;
        att::attn_unit<192, false, false, 1536, 1536, 2048, 1, 0, 8, false, 2>(QB + (size_t)row0 * 1536 + h * 192, KB + kb * 1536 + h * 192, KV + kb * 2048 + h * 256 + 128,
                                                                  MIX + (size_t)row0 * DM + 1024 + h * 128, nt, 0, 0, 0.07216878364870322f, 0.f, lds, nullptr, a.in[I_BQN], t64, qs0, L_.wave);
    }
    __syncthreads();
}
__device__ __forceinline__ void p_odd_attn(const Frame& F, const Args& a, char* lds) {
    const LocalId L_ = local_id(); (void)L_;
    const bf16* Y1 = (const bf16*)(F.ws + WS_Y1); bf16* O12 = (bf16*)(F.ws + WS_A1); bf16* MIX = (bf16*)(F.ws + WS_MIX);
#if ATT_DIFF_FUSED
    float d1 = 0.f, d2 = 0.f;
    for (int i = 0; i < 64; ++i) { d1 += a.in[I_LQ1][i] * a.in[I_LK1][i]; d2 += a.in[I_LQ2][i] * a.in[I_LK2][i]; }
    const float lam = expf(d1) - expf(d2) + LAMBDA_INIT;
    const float* gsub = (const float*)(F.ws + WS_ROPE + 32768);
    for (int n = blockIdx.x; n < 1024; n += F.G) {
        const int i = n >> 8, c = n & 255, x = c & 7, lc = c >> 3, gi = i * 8 + x, b = gi >> 2, h = (gi & 3) * 2 + (lc >> 4), row0 = b * TPB + CTX + (lc & 15) * 128;
        const size_t kb = (size_t)b * TPB * ODD_IN;
        att::attn_unit<128, false, false, ODD_IN, ODD_IN, ODD_IN, 2, 0, 8, true, 3>(Y1 + (size_t)row0 * ODD_IN + h * 128, Y1 + kb + 1024 + h * 128, Y1 + kb + 2048 + h * 128,
                                                                             MIX + (size_t)row0 * DM + h * 128, 36, 0, 0, 0.125f, lam, lds, gsub, a.in[I_CQN], (const float*)(F.ws + WS_ROPE + 16384), (lc & 15) * 128, L_.wave);
    }
#else
    for (int n = blockIdx.x; n < 1024; n += F.G) {
        const int i = n >> 8, c = n & 255, x = c & 7, lc = c >> 3, gi = i * 8 + x, b = gi >> 2, ch = (gi & 3) * 4 + (lc >> 3), row0 = b * TPB + CTX + (lc & 7) * 256;
        const size_t kb = (size_t)b * TPB * ODD_IN;
        att::attn_unit<64, false, false, ODD_IN, ODD_IN, ODD_IN, 2, 0, 8>(Y1 + (size_t)row0 * ODD_IN + ch * 64, Y1 + kb + 1024 + ch * 64, Y1 + kb + 2048 + (ch >> 1) * 128,
                                                                       O12 + (size_t)row0 * DM + ch * 128, 36, 0, 0, 0.125f, 0.f, lds, nullptr, nullptr, nullptr, -1, L_.wave);
    }
#endif
    for (int m = blockIdx.x; m < 512; m += F.G) {
        const int i = m >> 8, c = m & 255, x = c & 7, lc = c >> 3, gi = i * 8 + x, b = gi >> 1, kvh = gi & 1, h = kvh * 4 + (lc >> 3), s0 = (lc & 7) * 256, row0 = b * TPB + CTX + s0;
        const int lo = s0 - 128 < 0 ? 0 : s0 - 128, hie = s0 + 384 > SEQ ? SEQ : s0 + 384;
        const size_t kb = (size_t)b * TPB * ODD_IN;
        att::attn_unit<128, true, true, ODD_IN, ODD_IN, ODD_IN, 1, 0, 8, false, 1>(Y1 + (size_t)row0 * ODD_IN + 3072 + h * 128, Y1 + kb + 4096 + kvh * 128, Y1 + kb + 4352 + kvh * 128,
                                                                      MIX + (size_t)row0 * DM + 1024 + h * 128, 4 + (hie - lo) / 64, lo, s0, 0.08838834764831845f, a.in[I_SINK][h], lds, nullptr, a.in[I_DQN], (const float*)(F.ws + WS_ROPE), s0, L_.wave);
    }
    __syncthreads();
}
__device__ __forceinline__ void p_odd_combine(const Frame& F, const Args& a) {
    const LocalId L_ = local_id(); (void)L_;
    const int gw = F.vcu * NWAVES + L_.wave, NGW = F.G * NWAVES;
    const bf16* O12 = (const bf16*)(F.ws + WS_A1); bf16* MIX = (bf16*)(F.ws + WS_MIX);
    float d1 = 0.f, d2 = 0.f;
    for (int i = 0; i < 64; ++i) { d1 += a.in[I_LQ1][i] * a.in[I_LK1][i]; d2 += a.in[I_LQ2][i] * a.in[I_LK2][i]; }
    const float lam = expf(d1) - expf(d2) + LAMBDA_INIT;
    const float g0 = a.in[I_SUBLN][L_.lane] * (1.0f - LAMBDA_INIT), g1 = a.in[I_SUBLN][L_.lane + 64] * (1.0f - LAMBDA_INIT);
    for (int i = gw; i < NB * SEQ; i += NGW) {
        const int b = i / SEQ, row = b * TPB + CTX + (i - b * SEQ);
        const bf16* src = O12 + (size_t)row * DM; bf16* dst = MIX + (size_t)row * DM;
        for (int h = 0; h < 8; ++h) {
            const float x0 = bf2f(src[2 * h * 128 + L_.lane]) - lam * bf2f(src[(2 * h + 1) * 128 + L_.lane]);
            const float x1 = bf2f(src[2 * h * 128 + 64 + L_.lane]) - lam * bf2f(src[(2 * h + 1) * 128 + 64 + L_.lane]);
            const float ss = wave_sum(x0 * x0 + x1 * x1);
            const float r = 1.0f / sqrtf(ss * (1.0f / 128.0f) + NORM_EPS);
            dst[h * 128 + L_.lane] = (bf16)f2bf(x0 * r * g0); dst[h * 128 + 64 + L_.lane] = (bf16)f2bf(x1 * r * g1);
        }
    }
}

#ifndef FILL_S
#define FILL_S 2
#endif
#ifndef FILL_B
#define FILL_B 2
#endif
constexpr unsigned NCHUNK = 64u * 3072u / (8u * FILL_S), NCHUNK_L0 = NCHUNK / 2u, NCHUNK_L1GU = NCHUNK / 6u * 5u, FILL_NONE = 0xffffffffu;
template <bool BARRIER>
__device__ __forceinline__ void fill_loop(const Frame& F, const Args& a, unsigned* xgen, unsigned gen, unsigned lim) {
    const LocalId L_ = local_id();
    volatile LAS unsigned* st = F.MISC + 8;
    unsigned* ctr = (unsigned*)(F.ctl + CW_ITEM);
    unsigned cur = st[6] - 1u, nxt = st[7] - 1u; int s0 = (int)(st[16 + L_.wave] & 255u);
    __syncthreads();
    if (cur == FILL_NONE) { cur = nxt; nxt = FILL_NONE; s0 = 0; }
    if (cur == FILL_NONE) {
        if (L_.tid == 0) { const bool rel = BARRIER && xb_ld(xgen) != gen; st[5] = rel ? FILL_NONE : xb_add(ctr, 1u); }
        __syncthreads();
        cur = st[5];
        __syncthreads();
    }
    for (;;) {
        if (cur >= NCHUNK) { cur = FILL_NONE; nxt = FILL_NONE; s0 = 0; break; }
        if (!BARRIER && cur >= lim) break;
        unsigned nid = nxt;
        if (nxt == FILL_NONE && L_.tid == 0) nid = xb_add(ctr, 1u);
        int sN = s0; bool relw = false;
#pragma unroll 1
        for (; sN < FILL_S && !relw; sN += FILL_B) {
            const int r = (int)cur * (8 * FILL_S) + 8 * sN + L_.wave;
            TrAddr t[FILL_B]; f32x4 v[FILL_B][8];
#pragma unroll
            for (int j = 0; j < FILL_B; ++j) { t[j] = moe_item_addr(F, a, r + 8 * j); tr_load(v[j], t[j], L_.lane); }
            unsigned g = gen; if (BARRIER) g = (unsigned)__builtin_amdgcn_readfirstlane(xb_ld(xgen));
#pragma unroll
            for (int j = 0; j < FILL_B; ++j) tr_store(v[j], t[j], L_.lane);
            relw = (g != gen);
        }
        if (L_.lane == 0) st[16 + L_.wave] = (unsigned)sN | (relw ? 256u : 0u);
        if (L_.tid == 0) st[5] = nid;
        __syncthreads();
        nid = st[5]; bool partial = false, rel = false;
#pragma unroll
        for (int w = 0; w < NWAVES; ++w) { const unsigned x = st[16 + w]; partial = partial || ((x & 255u) < (unsigned)FILL_S); rel = rel || (x >= 256u); }
        __syncthreads();
        if (partial) { nxt = nid; s0 = sN; break; }
        cur = nid; nxt = FILL_NONE; s0 = 0;
        if (rel) break;
    }
    if (nxt != FILL_NONE && nxt >= NCHUNK) nxt = FILL_NONE;
    if (L_.lane == 0) st[16 + L_.wave] = (unsigned)s0;
    if (L_.tid == 0) { st[6] = cur + 1u; st[7] = nxt + 1u; }
    __syncthreads();
}
__device__ __forceinline__ void fill_until(const Frame& F, const Args& a, unsigned lim) { __syncthreads(); fill_loop<false>(F, a, nullptr, 0u, lim); }
__device__ __forceinline__ void xcd_barrier_fill(const XcdBarrier& b, const Frame& F, const Args& a) {
    asm volatile("s_waitcnt vmcnt(0)" ::: "memory");
    __syncthreads();
    volatile LAS unsigned* st = b.st;
    if (threadIdx.x == 0) {
        unsigned* bar = b.bar;
        __builtin_amdgcn_s_waitcnt(0);
        unsigned nloc = st[0], nx = st[1];
        if (nloc == 0u) { xcd_barrier_complete(bar, b.x, nloc, nx); st[0] = nloc; st[1] = nx; }
        const unsigned old = xb_add(&bar[XB_XSUB(b.x)], 1u);
        const unsigned gen = old / nloc;
        if (old + 1u == (gen + 1u) * nloc) {
            __builtin_amdgcn_fence(__ATOMIC_RELEASE, "agent");
            asm volatile("s_waitcnt vmcnt(0)" ::: "memory");
            const unsigned og = xb_add(&bar[XB_TOP], 1u);
            const unsigned tg = og / nx;
            if (og + 1u == (tg + 1u) * nx) xb_add(&bar[XB_TOPGEN], 1u);
            else XB_SPIN(xb_ld(&bar[XB_TOPGEN]) == tg, bar);
            __builtin_amdgcn_fence(__ATOMIC_ACQUIRE, "agent");
            xb_add(&bar[XB_XGEN(b.x)], 1u);
            asm volatile("s_waitcnt vmcnt(0)" ::: "memory");
            st[2] = 1u;
        } else { st[2] = 0u; st[3] = gen; }
    }
    __syncthreads();
    if (st[2] == 0u) {
        const unsigned gen = st[3];
        unsigned* xgen = &b.bar[XB_XGEN(b.x)];
        fill_loop<true>(F, a, xgen, gen, 0u);
        if (threadIdx.x == 0) {
            XB_SPIN(xb_ld(xgen) == gen, b.bar);
            __builtin_amdgcn_fence(__ATOMIC_ACQUIRE, "agent");
            asm volatile("s_waitcnt vmcnt(0)" ::: "memory");
        }
    }
    __syncthreads();
}

__device__ __forceinline__ int geff(int n, int G, int xr = 0) {
#if BG_CONVERT && !MK_PER_PHASE && BG_GEFF
    if (G % 8 != 0 || n <= 0) return G;
    const int rounds = (n + G - 1) / G + xr, g = ((n + rounds - 1) / rounds + 7) & ~7;
    return g < G ? g : G;
#else
    return G;
#endif
}
#ifndef XR_GEMM1E
#define XR_GEMM1E 0
#endif
#ifndef XR_GEMM3E
#define XR_GEMM3E 0
#endif
#ifndef XR_MOE_UP0
#define XR_MOE_UP0 0
#endif
#ifndef XR_MOE_DN0
#define XR_MOE_DN0 0
#endif
#ifndef XR_GEMM1O
#define XR_GEMM1O 0
#endif

__global__ void __launch_bounds__(NWAVES * 64, 2) trunk_fwd(Args args) {
    extern __shared__ __attribute__((aligned(16))) unsigned char lds[];
    Frame F;
    F.lds = (LAS unsigned char*)lds;
    F.MISC = (volatile LAS unsigned*)(F.lds + MISC_OFF);
    F.tid = threadIdx.x; F.lane = F.tid & 63; F.wave = __builtin_amdgcn_readfirstlane(F.tid >> 6);
    F.G = gridDim.x; { const int bx = blockIdx.x; F.vcu = (F.G % 8 == 0) ? (bx % 8) * (F.G / 8) + bx / 8 : bx; }
    F.ws = args.ws; F.ctl = (gu32*)(args.ws + WS_CTL);
    for (int u = F.tid; u < (LDS_BYTES - LDSCTL_OFF) / 4; u += NWAVES * 64) ((LAS unsigned*)(F.lds + LDSCTL_OFF))[u] = 0u;
    __syncthreads();
    XcdBarrier bar; bar.bar = (unsigned*)(F.ctl + CW_BAR); bar.x = 0; bar.st = nullptr;
#if !MK_PER_PHASE
    bar = xcd_barrier_post((unsigned*)(F.ctl + CW_BAR), F.MISC + 8);
#endif
    const int lo = args.ph_lo, hi = args.ph_hi;
#define IN(k) (lo <= (k) && (k) < hi)
#if MK_PER_PHASE
#define SEAM(k) do { } while (0)
#else
#define SEAM(k) do { if (IN(k) && IN((k) + 1)) xcd_barrier(bar); } while (0)
#endif
#if BG_CONVERT && !MK_PER_PHASE && BG_FILL
#define SEAMF(k) do { if (IN(k) && IN((k) + 1)) xcd_barrier_fill(bar, F, args); } while (0)
#else
#define SEAMF(k) SEAM(k)
#endif
    bf16* const A1 = (bf16*)(F.ws + WS_A1); bf16* const MIX = (bf16*)(F.ws + WS_MIX); bf16* const H = (bf16*)(F.ws + WS_H); const float* const MOD = (const float*)(F.ws + WS_MOD);
    PG8_LAS unsigned char* const ring = (PG8_LAS unsigned char*)(F.lds + RING_OFF);

#ifndef DUP_PHASE
#define DUP_PHASE (-1)
#endif
#ifndef PROBE_PHASE
#define PROBE_PHASE (-1)
#endif
constexpr size_t WS_DUMMY = 1600 * MiB;
#define PROBE(k, ...) do { if (PROBE_PHASE == (k) && IN(k)) { for (int r_ = 0; r_ < 3; ++r_) { __VA_ARGS__ xcd_barrier(bar); } } } while (0)
#define PH(k, ...) do { if (IN(k)) { __VA_ARGS__ if (DUP_PHASE == (k)) { for (int r_ = 0; r_ < 3; ++r_) { xcd_barrier(bar); __VA_ARGS__ } } } SEAM(k); } while (0)
#if BG_CONVERT
#define FILL_UNTIL(lim) fill_until(F, args, (lim))
#else
#define FILL_UNTIL(lim) do { } while (0)
#endif
#define PHF(k, ...) do { if (IN(k)) { __VA_ARGS__ if (DUP_PHASE == (k)) { for (int r_ = 0; r_ < 3; ++r_) { xcd_barrier(bar); __VA_ARGS__ } } } SEAMF(k); } while (0)
#define GEMM_STATIC(GE, EPI, Aptr, Bptr, N_, K_, ...) do { if ((int)blockIdx.x < (GE)) { pg8::Gemm g{(const bf16*)(Aptr), (const bf16*)(Bptr), (K_), (K_), (K_), nullptr}; pg8::StaticOrder S; S.init(T, (N_), (GE), (int)blockIdx.x); \
        pg8::EPI E{__VA_ARGS__}; pg8::gemm_phase<pg8::EPI, pg8::StaticOrder, false>(ring, g, S, E, F.wave); } } while (0)
#ifndef MOE_F32B
#define MOE_F32B 0
#endif
#define GEMM_MOE_F(EPI, GATH, Aptr, M0, M1, ESTR, LDN, COLMUL, HOFF, K_, layer, ...) do { const int nrt = __builtin_amdgcn_readfirstlane(*(const int*)(F.ctl + CW_NRT + (layer) * 64)); \
        pg8::Gemm g{(const bf16*)(Aptr), nullptr, (K_), 0, (K_), (const int*)(F.ctl + CW_SLOT + (layer) * MAXSLOT)}; pg8::BSrc bs{(M0), (M1), (size_t)(ESTR), (LDN), (COLMUL), (HOFF)}; \
        pg8::MoeOrder S; S.init((const int*)(F.ctl + CW_TEXP + (layer) * 256), nrt, F.G, (int)blockIdx.x); \
        pg8::EPI E{__VA_ARGS__}; pg8::gemm_phase_f32b<pg8::EPI, pg8::MoeOrder, GATH>(ring, g, bs, S, E, F.wave); } while (0)
#define GEMM_MOE_CHAIN(layer, Bgu, Bdn) do { const int nrt = __builtin_amdgcn_readfirstlane(moe_tables(F, (layer), F.wave * 64 + lane_id_())); \
        const PG8_LAS int* texp_ = (const PG8_LAS int*)(F.lds + LDS_TAB); unsigned* rdy_ = (unsigned*)(F.ctl + CW_RDY + (layer) * 16384); \
        { pg8::Gemm g{(const bf16*)A1, (const bf16*)(Bgu), DM, DM, DM, (const int*)(ws + WS_POS) + (size_t)(layer) * NE * POSCAP}; pg8::MoePublishOrder S; S.init(texp_, texp_ + 256, nrt, POSCAP, F.G, (int)blockIdx.x); S.ready = rdy_; \
          pg8::EpiSwiGLUwt E{(bf16*)(ws + WS_U), DE}; pg8::gemm_phase<pg8::EpiSwiGLUwt, pg8::MoePublishOrder, true>(ring, g, S, E, F.wave); } \
        { pg8::Gemm g{(const bf16*)(ws + WS_U), (const bf16*)(Bdn), DE, DE, DE, nullptr}; pg8::MoeCountedOrder S; S.init(texp_, texp_ + 256, nrt, POSCAP, F.G, (int)blockIdx.x); S.ready = rdy_; S.need = 64u; S.tmo = (unsigned*)F.ctl; S.wv = F.wave; \
          pg8::EpiStoreBf16 E{(bf16*)(ws + WS_YS), DM, 7}; pg8::gemm_phase<pg8::EpiStoreBf16, pg8::MoeCountedOrder, false>(ring, g, S, E, F.wave); } } while (0)
#define GEMM_ORDER(EPI, ORDER, INIT, Aptr, Bptr, K_, ...) do { pg8::Gemm g{(const bf16*)(Aptr), (const bf16*)(Bptr), (K_), (K_), (K_), nullptr}; pg8::ORDER S; S.init INIT; \
        pg8::EPI E{__VA_ARGS__}; pg8::gemm_phase<pg8::EPI, pg8::ORDER, false>(ring, g, S, E, F.wave); } while (0)
#define GEMM_ORDER_G(GE, EPI, ORDER, INIT, Aptr, Bptr, K_, ...) do { const int ge_ = (GE); if ((int)blockIdx.x < ge_) { pg8::Gemm g{(const bf16*)(Aptr), (const bf16*)(Bptr), (K_), (K_), (K_), nullptr}; pg8::ORDER S; S.init INIT; \
        pg8::EPI E{__VA_ARGS__}; pg8::gemm_phase<pg8::EPI, pg8::ORDER, false>(ring, g, S, E, F.wave); } } while (0)
#define GEMM_ROUTER_X(Bptr) do { pg8::Gemm g{(const bf16*)A1, (const bf16*)(Bptr), DM, DM, DM / RKS, nullptr}; pg8::SplitKXOrder S; S.init(RKS, DM / RKS, F.G, (int)blockIdx.x); \
        pg8::EpiLogits E{(float*)(ws + WS_LG), DM / RKS, (size_t)T * 64}; pg8::gemm_phase<pg8::EpiLogits, pg8::SplitKXOrder, false>(ring, g, S, E, F.wave); } while (0)
#define GEMM_ROUTER(Bptr) do { pg8::Gemm g{(const bf16*)A1, (const bf16*)(Bptr), DM, DM, DM / RKS, nullptr}; pg8::SplitKOrder S; S.init(T / 256, RKS, DM / RKS, F.G, (int)blockIdx.x); \
        pg8::EpiLogits E{(float*)(ws + WS_LG), DM / RKS, (size_t)T * 64}; pg8::gemm_phase<pg8::EpiLogits, pg8::SplitKOrder, false>(ring, g, S, E, F.wave); } while (0)
#define GEMM_MOE(XR, EPI, GATH, Aptr, Bptr, K_, layer, ...) do { const int nrt = __builtin_amdgcn_readfirstlane(moe_tables(F, (layer), F.wave * 64 + lane_id_())); \
        const int ge_ = geff(nrt * 8, F.G, (XR)); if ((int)blockIdx.x < ge_) { \
        pg8::Gemm g{(const bf16*)(Aptr), (const bf16*)(Bptr), (K_), (K_), (K_), (const int*)(ws + WS_POS) + (size_t)(layer) * NE * POSCAP}; pg8::MoeOrder S; \
        S.init((const PG8_LAS int*)(F.lds + LDS_TAB), (const PG8_LAS int*)(F.lds + LDS_TAB) + 256, nrt, POSCAP, ge_, (int)blockIdx.x); \
        pg8::EPI E{__VA_ARGS__}; pg8::gemm_phase<pg8::EPI, pg8::MoeOrder, GATH>(ring, g, S, E, F.wave); } } while (0)
    unsigned char* const ws = F.ws;
    PH(0, p0_prologue(F, args););
    PH(1, p_l0_mod1(F, args););
#ifdef NEXTRA_BAR
    for (int i_ = 0; i_ < NEXTRA_BAR; ++i_) xcd_barrier(bar);
#endif
    PHF(2, GEMM_STATIC(geff(72 * (KR_IN_POST1 ? 10 : 11), F.G, XR_GEMM1E), EpiStoreBf16, A1, ws + WS_WE_IN, (KR_IN_POST1 ? 2560 : EVEN_IN_P), DM, (bf16*)(ws + WS_Y1), EVEN_IN_P, 0x7fffffff););
    PROBE(3, p_even_post1(F, args, WS_DUMMY););
    PH(3, p_even_post1(F, args););
    PHF(4, GEMM_ORDER(EpiProj2, Proj2Order, (T, F.G, (int)blockIdx.x), ws + WS_CQN, ws + WS_WE_UQ, 512, (bf16*)(ws + WS_QB), (bf16*)(ws + WS_KV)););
    PH(5, p_even_post2(F, args););
#if USE_NAIVE_ATTN
    PH(6, p_even_attn_naive(F););
#else
    PHF(6, p_even_attn(F, args, (char*)lds););
#endif
    PHF(7, GEMM_STATIC(geff(72 * 8, F.G, XR_GEMM3E), EpiResidInit, MIX, ws + WS_WE_OUT, DM, DM, H, MOD + (size_t)0 * 9 * 12288 + 2 * 2048, args.in[I_X], args.in[I_CTX]););
#if FUSED_ROUTE
    PH(8, p_mod2_route(F, args, 0); FILL_UNTIL(NCHUNK_L0););
#else
    PH(8, p_mod2(F, 0););
    PH(9, GEMM_ROUTER(ws + WS_WR););
    PH(10, p_route(F, args, 0););
#endif
#if MOE_HANDOFF
    PH(12, GEMM_MOE_CHAIN(0, ws + WS_WGU, ws + WS_WDN););
#elif MOE_F32B
    PH(12, GEMM_MOE_F(EpiSwiGLU, true, A1, args.in[I_WG], args.in[I_WU], 2048 * 1024, 1024, 128, 0, DM, 0, (bf16*)(ws + WS_U), DE););
    PH(13, GEMM_MOE_F(EpiStoreBf16, false, ws + WS_U, args.in[I_WD], args.in[I_WD], 1024 * 2048, 2048, 256, 128, DE, 0, (bf16*)(ws + WS_YS), DM, 7););
#else
    PHF(12, GEMM_MOE(XR_MOE_UP0, EpiSwiGLU, true, A1, ws + WS_WGU, DM, 0, (bf16*)(ws + WS_U), DE););
    PHF(13, GEMM_MOE(XR_MOE_DN0, EpiStoreBf16, false, ws + WS_U, ws + WS_WDN, DE, 0, (bf16*)(ws + WS_YS), DM, 7););
#endif
    PROBE(14, p_l1_mod1(F, WS_DUMMY, WS_DUMMY + 160 * MiB););
    PH(14, p_l1_mod1(F););
    PHF(15, GEMM_ORDER_G(geff(64 * 18 + 80, F.G, XR_GEMM1O), EpiStoreBf16, OddInOrder, (ge_, (int)blockIdx.x), A1, ws + WS_WO_IN, DM, (bf16*)(ws + WS_Y1), ODD_IN, 0x7fffffff););
    PROBE(16, p_odd_post1(F, args, WS_DUMMY););
    PH(16, p_odd_post1(F, args););
#if USE_NAIVE_ATTN
    PH(17, p_odd_attn_naive(F, args););
    PH(18, ;);
#else
    PHF(17, p_odd_attn(F, args, (char*)lds););
#if !ATT_DIFF_FUSED
    PH(18, p_odd_combine(F, args););
#endif
#endif
    PHF(19, GEMM_ORDER(EpiResid, XOnlyOrder, (DM, F.G, (int)blockIdx.x), MIX, ws + WS_WO_OUT, DM, H, MOD + (size_t)1 * 9 * 12288 + 2 * 2048););
#if FUSED_ROUTE
    PH(20, p_mod2_route(F, args, 1); FILL_UNTIL(NCHUNK_L1GU););
#else
    PH(20, p_mod2(F, 1););
    PH(21, GEMM_ROUTER_X((const bf16*)(ws + WS_WR) + (size_t)256 * 2048););
    PH(22, p_route(F, args, 1););
#endif
#if MOE_HANDOFF
    PH(24, GEMM_MOE_CHAIN(1, (const bf16*)(ws + WS_WGU) + (size_t)32 * 2048 * 2048, (const bf16*)(ws + WS_WDN) + (size_t)32 * 2048 * 1024););
#elif MOE_F32B
    PH(24, GEMM_MOE_F(EpiSwiGLU, true, A1, args.in[I_WG] + (size_t)32 * 2048 * 1024, args.in[I_WU] + (size_t)32 * 2048 * 1024, 2048 * 1024, 1024, 128, 0, DM, 1, (bf16*)(ws + WS_U), DE););
    PH(25, GEMM_MOE_F(EpiStoreBf16, false, ws + WS_U, args.in[I_WD] + (size_t)32 * 1024 * 2048, args.in[I_WD] + (size_t)32 * 1024 * 2048, 1024 * 2048, 2048, 256, 128, DE, 1, (bf16*)(ws + WS_YS), DM, 7););
#else
    PHF(24, GEMM_MOE(0, EpiSwiGLU, true, A1, (const bf16*)(ws + WS_WGU) + (size_t)32 * 2048 * 2048, DM, 1, (bf16*)(ws + WS_U), DE); FILL_UNTIL(NCHUNK););
    PH(25, GEMM_MOE(0, EpiStoreBf16, false, ws + WS_U, (const bf16*)(ws + WS_WDN) + (size_t)32 * 2048 * 1024, DE, 1, (bf16*)(ws + WS_YS), DM, 7););
#endif
    PH(26, p_final(F, args.out););
#undef IN
#undef SEAM
}

extern "C" void kernel_launch(void* const* d_in, const int* in_sizes, int n_in, void* d_out, int out_size, void* d_ws, size_t ws_size, hipStream_t stream) {
    static int grid = 0;
    if (grid == 0) {
        if (n_in != 35 || out_size != NB * SEQ * DM || ws_size < WS_END) { fprintf(stderr, "kernel_launch: unexpected shapes: n_in %d out %d ws %zu (need %zu)\n", n_in, out_size, ws_size, (size_t)WS_END); grid = -1; return; }
        int dev = 0, cus = 0, per_cu = 0;
        if (hipGetDevice(&dev) != hipSuccess || hipDeviceGetAttribute(&cus, hipDeviceAttributeMultiprocessorCount, dev) != hipSuccess) { grid = -1; return; }
        if (hipFuncSetAttribute((const void*)trunk_fwd, hipFuncAttributeMaxDynamicSharedMemorySize, LDS_BYTES) != hipSuccess) { fprintf(stderr, "kernel_launch: hipFuncSetAttribute failed\n"); grid = -1; return; }
        if (hipOccupancyMaxActiveBlocksPerMultiprocessor(&per_cu, (const void*)trunk_fwd, NWAVES * 64, LDS_BYTES) != hipSuccess || per_cu < 1)
            fprintf(stderr, "kernel_launch: occupancy query reports %d workgroups per CU\n", per_cu);
        (void)hipGetLastError();
        grid = cus;
    }
    if (grid < 0) return;
    if (hipMemsetAsync((char*)d_ws + WS_CTL, 0, CTL_ZERO_BYTES, stream) != hipSuccess) { fprintf(stderr, "kernel_launch: memset failed\n"); return; }
    if (hipMemsetAsync((char*)d_ws + WS_POS, 0, (size_t)2 * NE * POSCAP * 4, stream) != hipSuccess) { fprintf(stderr, "kernel_launch: memset failed\n"); return; }
    Args a{};
    for (int i = 0; i < 35; ++i) a.in[i] = (const float*)d_in[i];
    a.out = (float*)d_out; a.ws = (unsigned char*)d_ws;
#if MK_PER_PHASE
    for (int p = 0; p < NPHASE; ++p) { a.ph_lo = p; a.ph_hi = p + 1; hipLaunchKernelGGL(trunk_fwd, dim3(grid), dim3(NWAVES * 64), LDS_BYTES, stream, a); }
#else
    a.ph_lo = 0; a.ph_hi = NPHASE; hipLaunchKernelGGL(trunk_fwd, dim3(grid), dim3(NWAVES * 64), LDS_BYTES, stream, a);
#endif
    const hipError_t le = hipPeekAtLastError();
    if (le != hipSuccess) fprintf(stderr, "kernel_launch: launch failed: %s\n", hipGetErrorName(le));
}
```

```cpp
#include <hip/hip_runtime.h>
#include <cstdio>
#include <cstdint>
__device__ __forceinline__ int lane_id_() { return (int)__builtin_amdgcn_mbcnt_hi(~0u, __builtin_amdgcn_mbcnt_lo(~0u, 0u)); }
#define MK_PER_PHASE 0
namespace pg8 {
#define PG8_LAS __attribute__((address_space(3)))
typedef unsigned short bf16_t;
typedef short bf16x8 __attribute__((ext_vector_type(8)));
typedef float f32x4 __attribute__((ext_vector_type(4)));
typedef unsigned u32x4 __attribute__((ext_vector_type(4)));
constexpr int BM = 256, BK = 64, HALF = 128, HTB = HALF * BK * 2  , STAGE_BYTES = 8 * HTB, NXCD = 8, WGM = 8;

__host__ __device__ __forceinline__ int lds_byte(int r, int c) { const int st = (r >> 4) * 2 + (c >> 5), rr = r & 15, cc = c & 31, ob = rr * 64 + cc * 2; return st * 1024 + (ob ^ (((ob >> 9) & 1) << 5)); }
__host__ __device__ __forceinline__ void stage_rc(int b, int& R, int& C) { const int st = b / 1024, sb = b % 1024, swz = sb ^ (((sb >> 9) & 1) << 5); R = (st >> 1) * 16 + swz / 64; C = (st & 1) * 32 + (swz % 64) / 2; }
__host__ __device__ __forceinline__ int perm32(int rho) { const int n = rho >> 4, i = rho & 15; return 8 * (i >> 2) + 4 * n + (i & 3); }

struct Unit { int pm, pn, ko, kt, gb; };
struct Gemm { const bf16_t* A; const bf16_t* Bt; int lda, ldb, K; const int* rowidx; };

#ifndef WGM_FIXED
#define WGM_FIXED 0
#endif
struct StaticOrder {
    int nM, nN, nwg, G, c, wgm;
    __host__ __device__ void init(int M, int N, int G_, int c_) { nM = M / BM; nN = N / BM; nwg = nM * nN; G = G_; c = c_;
        const int per = G_ / NXCD > 0 ? G_ / NXCD : 1; wgm = WGM_FIXED > 0 ? WGM_FIXED : (per + nN / 2) / nN; if (wgm < 1) wgm = 1; }
    __host__ __device__ bool next(int i, Unit& u) const {
        const long L = (long)i * G + c; if (L >= nwg) return false;
        int wgid = (int)L; { const int q = nwg / NXCD, r = nwg % NXCD, xcd = wgid % NXCD, off = wgid / NXCD; wgid = (xcd < r ? xcd * (q + 1) : r * (q + 1) + (xcd - r) * q) + off; }
        const int nig = wgm * nN, gid = wgid / nig, fm = gid * wgm, gsz = (nM - fm) < wgm ? (nM - fm) : wgm;
        u.pm = fm + ((wgid % nig) % gsz); u.pn = (wgid % nig) / gsz; u.ko = 0; u.kt = 0; u.gb = u.pm * BM; return true;
    }
    __device__ __forceinline__ void a_ready(const Unit&) const {}
    __device__ __forceinline__ void done(const Unit&) const {}
};


__device__ __forceinline__ unsigned cvt_pk_bf16(float lo, float hi) { unsigned r; asm volatile("v_cvt_pk_bf16_f32 %0, %1, %2" : "=v"(r) : "v"(lo), "v"(hi)); return r; }

#ifndef EPI_NT_STORE
#define EPI_NT_STORE 0
#endif
struct EpiStoreBf16 {
    static constexpr bool PERM = true, AFTER_DRAIN = false;
    bf16_t* O; int ldc; int pn_mask; bool nt = false;
    __device__ __forceinline__ void operator()(const f32x4 (&acc)[2][2][4][2], const Unit& u, int wr, int wc, int fr, int fq) const {
        const int row0 = u.pm * BM + wr * 64 + fr, col0 = (u.pn & pn_mask) * BM + wc * 32 + 8 * fq;
#pragma unroll
        for (int ai = 0; ai < 2; ++ai)
#pragma unroll
            for (int m = 0; m < 4; ++m) { bf16_t* rowp = O + (size_t)(row0 + ai * HALF + m * 16) * ldc + col0;
#pragma unroll
                for (int bj = 0; bj < 2; ++bj) { const f32x4 v0 = acc[ai][bj][m][0], v1 = acc[ai][bj][m][1];
                    u32x4 w; w.x = cvt_pk_bf16(v0[0], v0[1]); w.y = cvt_pk_bf16(v0[2], v0[3]); w.z = cvt_pk_bf16(v1[0], v1[1]); w.w = cvt_pk_bf16(v1[2], v1[3]);
                    if (EPI_NT_STORE || nt) __builtin_nontemporal_store(w, (u32x4*)(rowp + bj * HALF)); else *(u32x4*)(rowp + bj * HALF) = w; } }
    }
};
__device__ __forceinline__ float silu_f(float x) { return x * __builtin_amdgcn_rcpf(1.0f + __builtin_amdgcn_exp2f(-1.4426950408889634f * x)); }
struct EpiSwiGLU {
    static constexpr bool PERM = true, AFTER_DRAIN = false;
    bf16_t* O; int ldc;
    __device__ __forceinline__ void operator()(const f32x4 (&acc)[2][2][4][2], const Unit& u, int wr, int wc, int fr, int fq) const {
        const int row0 = u.pm * BM + wr * 64 + fr, col0 = (u.pn & 7) * HALF + wc * 32 + 8 * fq;
#pragma unroll
        for (int ai = 0; ai < 2; ++ai)
#pragma unroll
            for (int m = 0; m < 4; ++m) { bf16_t* rowp = O + (size_t)(row0 + ai * HALF + m * 16) * ldc + col0;
                const f32x4 g0 = acc[ai][0][m][0], g1 = acc[ai][0][m][1], u0 = acc[ai][1][m][0], u1 = acc[ai][1][m][1];
                u32x4 w; w.x = cvt_pk_bf16(silu_f(g0[0]) * u0[0], silu_f(g0[1]) * u0[1]); w.y = cvt_pk_bf16(silu_f(g0[2]) * u0[2], silu_f(g0[3]) * u0[3]);
                w.z = cvt_pk_bf16(silu_f(g1[0]) * u1[0], silu_f(g1[1]) * u1[1]); w.w = cvt_pk_bf16(silu_f(g1[2]) * u1[2], silu_f(g1[3]) * u1[3]);
                *(u32x4*)rowp = w; }
    }
};
__device__ __forceinline__ float bf_lo(unsigned w) { return __builtin_bit_cast(float, w << 16); }
__device__ __forceinline__ float bf_hi(unsigned w) { return __builtin_bit_cast(float, w & 0xffff0000u); }
struct EpiResid {
    static constexpr bool PERM = true, AFTER_DRAIN = false;
    bf16_t* H; const float* modg;
    __device__ __forceinline__ void operator()(const f32x4 (&acc)[2][2][4][2], const Unit& u, int wr, int wc, int fr, int fq) const {
        const int row0 = u.pm * BM + wr * 64 + fr, col0 = u.pn * BM + wc * 32 + 8 * fq;
        const int j = (u.pm % 9 == 0) ? 8 : (u.pm / 9);
        const float* g = modg + (size_t)j * 12288 + col0;
        f32x4 gv[2][2];
#pragma unroll
        for (int bj = 0; bj < 2; ++bj)
#pragma unroll
            for (int n = 0; n < 2; ++n) gv[bj][n] = *(const f32x4*)(g + bj * HALF + 4 * n);
#pragma unroll
        for (int ai = 0; ai < 2; ++ai)
#pragma unroll
            for (int m = 0; m < 4; ++m) { bf16_t* rowp = H + (size_t)(row0 + ai * HALF + m * 16) * 2048 + col0;
#pragma unroll
                for (int bj = 0; bj < 2; ++bj) { u32x4* p = (u32x4*)(rowp + bj * HALF); const u32x4 h = *p;
                    const f32x4 a0 = gv[bj][0] * acc[ai][bj][m][0], a1 = gv[bj][1] * acc[ai][bj][m][1];
                    u32x4 w; w.x = cvt_pk_bf16(bf_lo(h.x) + a0[0], bf_hi(h.x) + a0[1]); w.y = cvt_pk_bf16(bf_lo(h.y) + a0[2], bf_hi(h.y) + a0[3]);
                    w.z = cvt_pk_bf16(bf_lo(h.z) + a1[0], bf_hi(h.z) + a1[1]); w.w = cvt_pk_bf16(bf_lo(h.w) + a1[2], bf_hi(h.w) + a1[3]);
                    *p = w; } }
    }
};
#ifndef NT_RESX
#define NT_RESX 0
#endif
struct EpiResidInit {
    static constexpr bool PERM = true, AFTER_DRAIN = false;
    bf16_t* H; const float* modg; const float* xin; const float* ctxin;
    __device__ __forceinline__ void operator()(const f32x4 (&acc)[2][2][4][2], const Unit& u, int wr, int wc, int fr, int fq) const {
        const int rl0 = wr * 64 + fr, col0 = u.pn * BM + wc * 32 + 8 * fq;
        const int b = u.pm / 9, t = u.pm - 9 * b, j = (t == 0) ? 8 : b;
        const float* src = (t == 0) ? ctxin + (size_t)(b * 256) * 2048 : xin + (size_t)(b * 2048 + (t - 1) * 256) * 2048;
        const float* g = modg + (size_t)j * 12288 + col0;
        f32x4 gv[2][2];
#pragma unroll
        for (int bj = 0; bj < 2; ++bj)
#pragma unroll
            for (int n = 0; n < 2; ++n) gv[bj][n] = *(const f32x4*)(g + bj * HALF + 4 * n);
#pragma unroll
        for (int ai = 0; ai < 2; ++ai)
#pragma unroll
            for (int m = 0; m < 4; ++m) { const int rl = rl0 + ai * HALF + m * 16; bf16_t* rowp = H + (size_t)(u.pm * BM + rl) * 2048 + col0; const float* srow = src + (size_t)rl * 2048 + col0;
#pragma unroll
                for (int bj = 0; bj < 2; ++bj) {
#if NT_RESX
                    const f32x4 h0 = __builtin_nontemporal_load((const f32x4*)(srow + bj * HALF)), h1 = __builtin_nontemporal_load((const f32x4*)(srow + bj * HALF + 4));
#else
                    const f32x4 h0 = *(const f32x4*)(srow + bj * HALF), h1 = *(const f32x4*)(srow + bj * HALF + 4);
#endif
                    const f32x4 v0 = h0 + gv[bj][0] * acc[ai][bj][m][0], v1 = h1 + gv[bj][1] * acc[ai][bj][m][1];
                    u32x4 w; w.x = cvt_pk_bf16(v0[0], v0[1]); w.y = cvt_pk_bf16(v0[2], v0[3]); w.z = cvt_pk_bf16(v1[0], v1[1]); w.w = cvt_pk_bf16(v1[2], v1[3]);
                    *(u32x4*)(rowp + bj * HALF) = w; } }
    }
};
struct EpiLogits {
    static constexpr bool PERM = false, AFTER_DRAIN = false;
    float* LG; int kslice; size_t slice_stride;
    __device__ __forceinline__ void operator()(const f32x4 (&acc)[2][2][4][2], const Unit& u, int wr, int wc, int fr, int fq) const {
        if (wc >= 2) return;
        const int row0 = u.pm * BM + wr * 64 + fr, col0 = wc * 32 + 4 * fq;
        float* base = LG + (size_t)(u.ko / kslice) * slice_stride;
#pragma unroll
        for (int ai = 0; ai < 2; ++ai)
#pragma unroll
            for (int m = 0; m < 4; ++m) { float* rowp = base + (size_t)(row0 + ai * HALF + m * 16) * 64 + col0;
#pragma unroll
                for (int n = 0; n < 2; ++n) *(f32x4*)(rowp + n * 16) = acc[ai][0][m][n]; }
    }
};
struct SplitKOrder {
    int nM, KS, kslice, G, c;
    __device__ void init(int nM_, int KS_, int kslice_, int G_, int c_) { nM = nM_; KS = KS_; kslice = kslice_; G = G_; c = c_; }
    __device__ bool next(int i, Unit& u) const { const long L = (long)i * G + c; if (L >= (long)nM * KS) return false; const int ks = (int)L / nM; u.pm = (int)L - ks * nM; u.pn = 0; u.ko = ks * kslice; u.kt = 0; u.gb = 0; return true; }
    __device__ __forceinline__ void a_ready(const Unit&) const {}
    __device__ __forceinline__ void done(const Unit&) const {}
};
struct EvenInOrder {
    StaticOrder so; int G, c;
    __device__ void init(int M, int G_, int c_) { so.init(M, 2560, G_, c_); G = G_; c = c_; }
    __device__ bool next(int i, Unit& u) const {
        if (so.next(i, u)) return true;
        const long L = (long)i * G + c - so.nwg; if (L < 0 || L >= 72 * 4) return false;
        const int ks = (int)L / 72; u.pm = (int)L - ks * 72; u.pn = 10; u.ko = ks * 512; u.kt = 8; u.gb = 0; return true;
    }
    __device__ __forceinline__ void a_ready(const Unit&) const {}
    __device__ __forceinline__ void done(const Unit&) const {}
};
struct EpiEvenIn {
    static constexpr bool PERM = true, AFTER_DRAIN = false;
    bf16_t* Y; float* KRP;
    __device__ __forceinline__ void operator()(const f32x4 (&acc)[2][2][4][2], const Unit& u, int wr, int wc, int fr, int fq) const {
        if (u.pn < 10) { const EpiStoreBf16 e{Y, 2816, 0x7fffffff}; e(acc, u, wr, wc, fr, fq); return; }
        if (wc >= 2) return;
        const int row0 = u.pm * BM + wr * 64 + fr, col0 = wc * 32 + 8 * fq;
        float* base = KRP + (size_t)(u.ko >> 9) * ((size_t)18432 * 64);
#pragma unroll
        for (int ai = 0; ai < 2; ++ai)
#pragma unroll
            for (int m = 0; m < 4; ++m) { float* rowp = base + (size_t)(row0 + ai * HALF + m * 16) * 64 + col0;
#pragma unroll
                for (int n = 0; n < 2; ++n) *(f32x4*)(rowp + 4 * n) = acc[ai][0][m][n]; }
    }
};
struct Proj2Order {
    StaticOrder s1, s2; int G, c;
    __device__ void init(int M, int G_, int c_) { s1.init(M, 1536, G_, c_); s2.init(M, 2048, G_, c_); G = G_; c = c_; }
    __device__ bool next(int i, Unit& u) const {
        if (s1.next(i, u)) return true;
        StaticOrder t = s2; const long L = (long)i * G + c - s1.nwg; if (L < 0 || L >= s2.nwg) return false;
        t.G = 1; t.c = (int)L; if (!t.next(0, u)) return false;
        u.pm += 72; u.pn += 8; return true;
    }
    __device__ __forceinline__ void a_ready(const Unit&) const {}
    __device__ __forceinline__ void done(const Unit&) const {}
};
struct EpiProj2 {
    static constexpr bool PERM = true, AFTER_DRAIN = false;
    bf16_t* QB; bf16_t* KV;
    __device__ __forceinline__ void operator()(const f32x4 (&acc)[2][2][4][2], const Unit& u, int wr, int wc, int fr, int fq) const {
        if (u.pm < 72) { const EpiStoreBf16 e{QB, 1536, 0x7fffffff}; e(acc, u, wr, wc, fr, fq); }
        else { Unit v = u; v.pm -= 72; v.pn -= 8; const EpiStoreBf16 e{KV, 2048, 0x7fffffff}; e(acc, v, wr, wc, fr, fq); }
    }
};
struct XOnlyOrder {
    StaticOrder so;
    __device__ void init(int N, int G_, int c_) { so.init(64 * BM, N, G_, c_); }
    __device__ bool next(int i, Unit& u) const { if (!so.next(i, u)) return false; u.pm = 9 * (u.pm >> 3) + 1 + (u.pm & 7); return true; }
    __device__ __forceinline__ void a_ready(const Unit&) const {}
    __device__ __forceinline__ void done(const Unit&) const {}
};
struct OddInOrder {
    StaticOrder so; int G, c;
    __device__ void init(int G_, int c_) { so.init(64 * BM, 18 * BM, G_, c_); G = G_; c = c_; }
    __device__ bool next(int i, Unit& u) const {
        if (so.next(i, u)) { u.pm = 9 * (u.pm >> 3) + 1 + (u.pm & 7); return true; }
        const long L = (long)i * G + c - 64 * 18; if (L >= 80) return false;
        const int b = (int)L / 10, j = (int)L - b * 10; u.pm = 9 * b; u.pn = j < 8 ? 4 + j : 8 + j; u.ko = 0; u.kt = 0; u.gb = 0; return true;
    }
    __device__ __forceinline__ void a_ready(const Unit&) const {}
    __device__ __forceinline__ void done(const Unit&) const {}
};
struct SplitKXOrder {
    int KS, kslice, G, c;
    __device__ void init(int KS_, int kslice_, int G_, int c_) { KS = KS_; kslice = kslice_; G = G_; c = c_; }
    __device__ bool next(int i, Unit& u) const { const long L = (long)i * G + c; if (L >= 64L * KS) return false; const int ks = (int)L / 64, x = (int)L - ks * 64; u.pm = 9 * (x >> 3) + 1 + (x & 7); u.pn = 0; u.ko = ks * kslice; u.kt = 0; u.gb = 0; return true; }
    __device__ __forceinline__ void a_ready(const Unit&) const {}
    __device__ __forceinline__ void done(const Unit&) const {}
};
struct MoeOrder {
    const PG8_LAS int* texp; const PG8_LAS int* frt; int nunits, G, c, cap;
    __device__ void init(const PG8_LAS int* texp_, const PG8_LAS int* frt_, int n_row_tiles, int cap_, int G_, int c_) { texp = texp_; frt = frt_; nunits = n_row_tiles * 8; cap = cap_; G = G_; c = c_; }
    __device__ bool next(int i, Unit& u) const {
        const long L = (long)i * G + c; if (L >= nunits) return false;
        int wgid = (int)L; { const int q = nunits / NXCD, r = nunits % NXCD, xcd = wgid % NXCD, off = wgid / NXCD; wgid = (xcd < r ? xcd * (q + 1) : r * (q + 1) + (xcd - r) * q) + off; }
        const int rt = wgid >> 3, pn = wgid & 7, e = __builtin_amdgcn_readfirstlane(texp[rt]);
        u.pm = rt; u.pn = e * 8 + pn; u.ko = 0; u.kt = 0; u.gb = e * cap + (rt - __builtin_amdgcn_readfirstlane(frt[e])) * BM; return true;
    }
    __device__ __forceinline__ void a_ready(const Unit&) const {}
    __device__ __forceinline__ void done(const Unit&) const {}
};

struct MoePublishOrder : MoeOrder {
    unsigned* ready;
    __device__ __forceinline__ void done(const Unit& u) const {
        asm volatile("s_waitcnt vmcnt(0)" ::: "memory");
        if (lane_id_() == 0) __hip_atomic_fetch_add(ready + 64 * u.pm, 1u, __ATOMIC_RELAXED, __HIP_MEMORY_SCOPE_AGENT);
    }
};
struct MoeCountedOrder : MoeOrder {
    unsigned* ready; unsigned need; unsigned* tmo; int wv;
    __device__ bool next(int i, Unit& u) const {
        const int k0 = (nunits - c + G - 1) / G;
        const long l = (long)c + (long)(k0 + i) * G - nunits; if (l >= nunits) return false;
        int wgid = (int)l; { const int q = nunits / NXCD, r = nunits % NXCD, xcd = wgid % NXCD, off = wgid / NXCD; wgid = (xcd < r ? xcd * (q + 1) : r * (q + 1) + (xcd - r) * q) + off; }
        const int rt = wgid >> 3, pn = wgid & 7, e = __builtin_amdgcn_readfirstlane(texp[rt]);
        u.pm = rt; u.pn = e * 8 + pn; u.ko = 0; u.kt = 0; u.gb = 0; return true;
    }
    __device__ __forceinline__ void a_ready(const Unit& u) const {
        if (wv == 0) {
            const unsigned long long t0 = __builtin_amdgcn_s_memrealtime(); unsigned polls = 0;
            while ((unsigned)__builtin_amdgcn_readfirstlane(__hip_atomic_load(ready + 64 * u.pm, __ATOMIC_RELAXED, __HIP_MEMORY_SCOPE_AGENT)) < need) {
                if ((++polls & 255u) == 0u && __builtin_amdgcn_readfirstlane(__hip_atomic_load(tmo, __ATOMIC_RELAXED, __HIP_MEMORY_SCOPE_AGENT)) != 0u) break;
                if (__builtin_amdgcn_s_memrealtime() - t0 > 2000000ull) {
                    if (lane_id_() == 0) __hip_atomic_store(tmo, 1u, __ATOMIC_RELAXED, __HIP_MEMORY_SCOPE_AGENT);
                    break; }
                __builtin_amdgcn_s_sleep(2); }
            __builtin_amdgcn_fence(__ATOMIC_ACQUIRE, "agent");
            asm volatile("s_waitcnt vmcnt(0)" ::: "memory");
        }
        asm volatile("" ::: "memory"); __builtin_amdgcn_s_barrier(); asm volatile("" ::: "memory");
    }
};
struct EpiSwiGLUwt {
    static constexpr bool PERM = true, AFTER_DRAIN = false;
    bf16_t* O; int ldc;
    __device__ __forceinline__ void operator()(const f32x4 (&acc)[2][2][4][2], const Unit& u, int wr, int wc, int fr, int fq) const {
        const int row0 = u.pm * BM + wr * 64 + fr, col0 = (u.pn & 7) * HALF + wc * 32 + 8 * fq;
        const __amdgpu_buffer_rsrc_t rsrc = __builtin_amdgcn_make_buffer_rsrc((void*)O, 0, 0x7fffffff, 0x00020000);
#pragma unroll
        for (int ai = 0; ai < 2; ++ai)
#pragma unroll
            for (int m = 0; m < 4; ++m) { const unsigned off = (unsigned)(((size_t)(row0 + ai * HALF + m * 16) * ldc + col0) * 2);
                const f32x4 g0 = acc[ai][0][m][0], g1 = acc[ai][0][m][1], u0 = acc[ai][1][m][0], u1 = acc[ai][1][m][1];
                u32x4 w; w.x = cvt_pk_bf16(silu_f(g0[0]) * u0[0], silu_f(g0[1]) * u0[1]); w.y = cvt_pk_bf16(silu_f(g0[2]) * u0[2], silu_f(g0[3]) * u0[3]);
                w.z = cvt_pk_bf16(silu_f(g1[0]) * u1[0], silu_f(g1[1]) * u1[1]); w.w = cvt_pk_bf16(silu_f(g1[2]) * u1[2], silu_f(g1[3]) * u1[3]);
                __builtin_amdgcn_raw_buffer_store_b128(w, rsrc, (int)off, 0, 16  ); }
    }
};
}
namespace pg8 {
template <class Epi, class Sched, bool GATHER = false>
__device__ __forceinline__ void gemm_phase(PG8_LAS unsigned char* lds, const Gemm g, const Sched& S, const Epi& E, int wv) {
    int tid = wv * 64 + lane_id_(); asm volatile("" : "+v"(tid));
    const int wid = __builtin_amdgcn_readfirstlane(tid >> 6), lane = tid & 63, wr = wid >> 2, wc = wid & 3, fr = lane & 15, fq = lane >> 4;
    const int K = g.K, lda = g.lda, ldb = g.ldb;
    unsigned va[2][2], vn[2][2], voffB[2]; int sR[2], sC[2];
#pragma unroll
    for (int i = 0; i < 2; ++i) { int R, C; stage_rc(tid * 16 + i * 8192, R, C); const int Rb = Epi::PERM ? ((R & ~31) + perm32(R & 31)) : R; sR[i] = R; sC[i] = C;
        voffB[i] = (unsigned)(Rb * ldb + C) * 2u;
        va[0][i] = (unsigned)(R * lda + C) * 2u; va[1][i] = (unsigned)((R + HALF) * lda + C) * 2u; vn[0][i] = va[0][i]; vn[1][i] = va[1][i]; }
    const size_t kstep = (size_t)(BK * 2);
    const size_t hstepB = (size_t)HALF * ldb * 2;
    const size_t tstepA = (size_t)BM * lda * 2, tstepB = (size_t)BM * ldb * 2;
    const unsigned ldsw = (unsigned)wid * 1024u;
    const int aoff = lds_byte(wr * 64 + fr, fq * 8), boff = lds_byte(wc * 32 + fr, fq * 8);
#define PG8_SA(b, h) (((b) * 2 + (h)) * HTB)
#define PG8_SB(b, h) ((4 + (b) * 2 + (h)) * HTB)
#define PG8_STAGE(bufoff, gbase, voff) do { _Pragma("unroll") for (int _i = 0; _i < 2; ++_i) \
        __builtin_amdgcn_global_load_lds((const unsigned*)((const char*)(gbase) + (voff)[_i]), (PG8_LAS unsigned*)(lds + (bufoff) + ldsw + _i * 8192), 16, 0, 0); } while (0)
#define PG8_LDA(dst, b, h) do { _Pragma("unroll") for (int m = 0; m < 4; ++m) _Pragma("unroll") for (int k = 0; k < 2; ++k) dst[m][k] = *(const PG8_LAS bf16x8*)(lds + PG8_SA(b, h) + aoff + m * 2048 + k * 1024); } while (0)
#define PG8_LDB(dst, b, h) do { _Pragma("unroll") for (int n = 0; n < 2; ++n) _Pragma("unroll") for (int k = 0; k < 2; ++k) dst[n][k] = *(const PG8_LAS bf16x8*)(lds + PG8_SB(b, h) + boff + n * 2048 + k * 1024); } while (0)
#define PG8_MMA(ai, bj, At, Bt) do { __builtin_amdgcn_s_setprio(1); _Pragma("unroll") for (int m = 0; m < 4; ++m) _Pragma("unroll") for (int n = 0; n < 2; ++n) _Pragma("unroll") for (int k = 0; k < 2; ++k) \
        acc[ai][bj][m][n] = __builtin_amdgcn_mfma_f32_16x16x32_bf16(Bt[n][k], At[m][k], acc[ai][bj][m][n], 0, 0, 0); __builtin_amdgcn_s_setprio(0); } while (0)
#define PG8_WAIT_V(n) asm volatile("s_waitcnt vmcnt(" #n ")" ::: "memory")
#define PG8_WAIT_L(n) asm volatile("s_waitcnt lgkmcnt(" #n ")" ::: "memory")
#define PG8_BAR __builtin_amdgcn_s_barrier()
#define PG8_SCHED __builtin_amdgcn_sched_barrier(0)
#define PG8_GATHER_OFFS(dst, u) do { if constexpr (GATHER) { _Pragma("unroll") for (int _h = 0; _h < 2; ++_h) _Pragma("unroll") for (int _i = 0; _i < 2; ++_i) \
        dst[_h][_i] = (unsigned)(g.rowidx[(u).gb + _h * HALF + sR[_i]] * lda + sC[_i]) * 2u; } } while (0)
    Unit cur, nxt; int ui = 0;
    if (!S.next(0, cur)) return;
    f32x4 acc[2][2][4][2];
#pragma unroll
    for (int a = 0; a < 2; ++a)
#pragma unroll
        for (int b = 0; b < 2; ++b)
#pragma unroll
            for (int m = 0; m < 4; ++m)
#pragma unroll
                for (int n = 0; n < 2; ++n) acc[a][b][m][n] = (f32x4){0.f, 0.f, 0.f, 0.f};
    bf16x8 At[4][2], B0[2][2], B1[2][2];
    const char* cA = (const char*)g.A + (GATHER ? (size_t)0 : (size_t)cur.pm * tstepA) + (size_t)cur.ko * 2; const char* cB = (const char*)g.Bt + (size_t)cur.pn * tstepB + (size_t)cur.ko * 2;
    PG8_GATHER_OFFS(va, cur);
    S.a_ready(cur);
    PG8_STAGE(PG8_SB(0, 0), cB, voffB); PG8_STAGE(PG8_SB(0, 1), cB + hstepB, voffB); PG8_STAGE(PG8_SA(0, 0), cA, va[0]); PG8_STAGE(PG8_SA(0, 1), cA, va[1]);
    if (wr == 1) PG8_BAR;
    PG8_WAIT_V(2); PG8_BAR;
    PG8_STAGE(PG8_SB(1, 0), cB + kstep, voffB); PG8_STAGE(PG8_SA(1, 0), cA + kstep, va[0]); PG8_STAGE(PG8_SB(1, 1), cB + hstepB + kstep, voffB);
    PG8_WAIT_V(6); PG8_BAR;
    for (;;) {
        const bool has_next = S.next(ui + 1, nxt);
        const char* nA = has_next ? (const char*)g.A + (GATHER ? (size_t)0 : (size_t)nxt.pm * tstepA) + (size_t)nxt.ko * 2 : cA; const char* nB = has_next ? (const char*)g.Bt + (size_t)nxt.pn * tstepB + (size_t)nxt.ko * 2 : cB;
        if constexpr (GATHER) { if (has_next) PG8_GATHER_OFFS(vn, nxt); else { _Pragma("unroll") for (int _h = 0; _h < 2; ++_h) _Pragma("unroll") for (int _i = 0; _i < 2; ++_i) vn[_h][_i] = va[_h][_i]; } }
        const int nt = K / BK;
        for (int t = 0; t < nt; t += 2) {
            const bool last = (t == nt - 2);
            const char* a1 = cA + (size_t)(t + 1) * kstep;
            const char* a2 = last ? nA : cA + (size_t)(t + 2) * kstep; const char* b2 = last ? nB : cB + (size_t)(t + 2) * kstep;
            const char* a3 = a2 + kstep; const char* b3 = b2 + kstep;
            unsigned v2[2][2];
#pragma unroll
            for (int _h = 0; _h < 2; ++_h)
#pragma unroll
                for (int _i = 0; _i < 2; ++_i) v2[_h][_i] = (GATHER && last) ? vn[_h][_i] : va[_h][_i];
            if (last && has_next) S.a_ready(nxt);
            PG8_LDB(B0, 0, 0); PG8_LDB(B1, 0, 1); PG8_SCHED; PG8_LDA(At, 0, 0); PG8_STAGE(PG8_SA(1, 1), a1, va[1]);
            PG8_WAIT_V(8); PG8_WAIT_L(0); PG8_BAR; PG8_MMA(0, 0, At, B0); PG8_MMA(0, 1, At, B1); PG8_BAR; PG8_SCHED;
            PG8_LDA(At, 0, 1); PG8_STAGE(PG8_SB(0, 0), b2, voffB); PG8_STAGE(PG8_SB(0, 1), b2 + hstepB, voffB); PG8_STAGE(PG8_SA(0, 0), a2, v2[0]);
            PG8_WAIT_V(8); PG8_WAIT_L(0); PG8_BAR; PG8_MMA(1, 0, At, B0); PG8_MMA(1, 1, At, B1); PG8_BAR; PG8_SCHED;
            PG8_LDB(B0, 1, 0); PG8_LDB(B1, 1, 1); PG8_SCHED; PG8_LDA(At, 1, 0); PG8_STAGE(PG8_SA(0, 1), a2, v2[1]);
            PG8_WAIT_V(8); PG8_WAIT_L(0); PG8_BAR; PG8_MMA(0, 0, At, B0); PG8_MMA(0, 1, At, B1); PG8_BAR; PG8_SCHED;
            PG8_LDA(At, 1, 1); PG8_STAGE(PG8_SB(1, 0), b3, voffB); PG8_STAGE(PG8_SB(1, 1), b3 + hstepB, voffB); PG8_STAGE(PG8_SA(1, 0), a3, v2[0]);
            PG8_WAIT_V(8); PG8_WAIT_L(0); PG8_BAR; PG8_MMA(1, 0, At, B0); PG8_MMA(1, 1, At, B1); PG8_BAR; PG8_SCHED;
        }
        if (wr == 0) PG8_BAR;
        E(acc, cur, wr, wc, fr, fq); S.done(cur);
        if (!has_next) break;
#pragma unroll
        for (int a = 0; a < 2; ++a)
#pragma unroll
            for (int b = 0; b < 2; ++b)
#pragma unroll
                for (int m = 0; m < 4; ++m)
#pragma unroll
                    for (int n = 0; n < 2; ++n) acc[a][b][m][n] = (f32x4){0.f, 0.f, 0.f, 0.f};
        cur = nxt; cA = nA; cB = nB; ++ui;
        if constexpr (GATHER) { _Pragma("unroll") for (int _h = 0; _h < 2; ++_h) _Pragma("unroll") for (int _i = 0; _i < 2; ++_i) va[_h][_i] = vn[_h][_i]; }
        if (wr == 1) PG8_BAR;
    }
    PG8_WAIT_V(0);
    PG8_BAR;
#undef PG8_SA
#undef PG8_SB
#undef PG8_STAGE
#undef PG8_LDA
#undef PG8_LDB
#undef PG8_MMA
#undef PG8_WAIT_V
#undef PG8_WAIT_L
#undef PG8_BAR
#undef PG8_SCHED
#undef PG8_GATHER_OFFS
}
typedef unsigned u32x2 __attribute__((ext_vector_type(2)));
struct BSrc { const float* m0; const float* m1; size_t estride; int ldn, colmul, hoff; };
template <class Epi, class Sched, bool GATHER = false>
__device__ __forceinline__ void gemm_phase_f32b(PG8_LAS unsigned char* lds, const Gemm g, const BSrc bs, const Sched& S, const Epi& E, int wv) {
    int tid = wv * 64 + lane_id_(); asm volatile("" : "+v"(tid));
    const int wid = __builtin_amdgcn_readfirstlane(tid >> 6), lane = tid & 63, wr = wid >> 2, wc = wid & 3, fr = lane & 15, fq = lane >> 4;
    const int K = g.K, lda = g.lda;
    unsigned va00, va01, va10, va11, vn00, vn01, vn10, vn11;
#pragma unroll
    for (int i = 0; i < 2; ++i) { int R, C; stage_rc(tid * 16 + i * 8192, R, C);
        const unsigned o0_ = (unsigned)(R * lda + C) * 2u, o1_ = (unsigned)((R + HALF) * lda + C) * 2u; if (i == 0) { va00 = o0_; va10 = o1_; } else { va01 = o0_; va11 = o1_; } }
    vn00 = va00; vn01 = va01; vn10 = va10; vn11 = va11;
    const size_t kstep = (size_t)(BK * 2);
    const size_t tstepA = (size_t)BM * lda * 2;
    const int kq = lane & 15, nq = (lane >> 4) + 4 * wid;
    const int brow = (nq >> 3) * 32 + (Epi::PERM ? (16 * (nq & 1) + 4 * ((nq & 7) >> 1)) : (4 * (nq & 7)));
    const int bwr = lds_byte(brow, 4 * kq);
    const unsigned bvo = (unsigned)((4 * kq) * bs.ldn + 4 * nq) * 4u;
    const size_t bkstep = (size_t)BK * bs.ldn * 4, brstep = (size_t)bs.ldn * 4;
    f32x4 w0, w1, w2, w3;
    const unsigned ldsw = (unsigned)wid * 1024u;
    const int aoff = lds_byte(wr * 64 + fr, fq * 8), boff = lds_byte(wc * 32 + fr, fq * 8);
#define PG8_SA(b, h) (((b) * 2 + (h)) * HTB)
#define PG8_SB(b, h) ((4 + (b) * 2 + (h)) * HTB)
#define PG8_BLOAD(src) do { const char* p0_ = (const char*)(src); const char* p1_ = p0_ + brstep; const char* p2_ = p1_ + brstep; const char* p3_ = p2_ + brstep; \
        asm volatile("s_nop 4\n\tglobal_load_dwordx4 %0, %4, %5\n\tglobal_load_dwordx4 %1, %4, %6\n\tglobal_load_dwordx4 %2, %4, %7\n\tglobal_load_dwordx4 %3, %4, %8" \
                     : "=&v"(w0), "=&v"(w1), "=&v"(w2), "=&v"(w3) : "v"(bvo), "s"(p0_), "s"(p1_), "s"(p2_), "s"(p3_)); } while (0)
#define PG8_BWAIT(n) asm volatile("s_waitcnt vmcnt(" #n ")" : "+v"(w0), "+v"(w1), "+v"(w2), "+v"(w3))
#define PG8_BWRITE(bufoff) do { PG8_LAS unsigned char* d_ = lds + (bufoff) + bwr; \
        { u32x2 c_; c_.x = cvt_pk_bf16(w0[0], w1[0]); c_.y = cvt_pk_bf16(w2[0], w3[0]); *(PG8_LAS u32x2*)(d_) = c_; } \
        { u32x2 c_; c_.x = cvt_pk_bf16(w0[1], w1[1]); c_.y = cvt_pk_bf16(w2[1], w3[1]); *(PG8_LAS u32x2*)(d_ + 64) = c_; } \
        { u32x2 c_; c_.x = cvt_pk_bf16(w0[2], w1[2]); c_.y = cvt_pk_bf16(w2[2], w3[2]); *(PG8_LAS u32x2*)(d_ + 128) = c_; } \
        { u32x2 c_; c_.x = cvt_pk_bf16(w0[3], w1[3]); c_.y = cvt_pk_bf16(w2[3], w3[3]); *(PG8_LAS u32x2*)(d_ + 192) = c_; } } while (0)
#define PG8_BSRC(u, h) ((const char*)(((h) ? bs.m1 : bs.m0) + (size_t)((u).pn >> 3) * bs.estride + (size_t)((u).pn & 7) * bs.colmul + (h) * bs.hoff) + (size_t)(u).ko * brstep)
#define PG8_STAGE(bufoff, gbase, o0, o1) do { \
        __builtin_amdgcn_global_load_lds((const unsigned*)((const char*)(gbase) + (o0)), (PG8_LAS unsigned*)(lds + (bufoff) + ldsw), 16, 0, 0); \
        __builtin_amdgcn_global_load_lds((const unsigned*)((const char*)(gbase) + (o1)), (PG8_LAS unsigned*)(lds + (bufoff) + ldsw + 8192), 16, 0, 0); } while (0)
#define PG8_LDA(dst, b, h) do { _Pragma("unroll") for (int m = 0; m < 4; ++m) _Pragma("unroll") for (int k = 0; k < 2; ++k) dst[m][k] = *(const PG8_LAS bf16x8*)(lds + PG8_SA(b, h) + aoff + m * 2048 + k * 1024); } while (0)
#define PG8_LDB(dst, b, h) do { _Pragma("unroll") for (int n = 0; n < 2; ++n) _Pragma("unroll") for (int k = 0; k < 2; ++k) dst[n][k] = *(const PG8_LAS bf16x8*)(lds + PG8_SB(b, h) + boff + n * 2048 + k * 1024); } while (0)
#define PG8_MMA(ai, bj, At, Bt) do { __builtin_amdgcn_s_setprio(1); _Pragma("unroll") for (int m = 0; m < 4; ++m) _Pragma("unroll") for (int n = 0; n < 2; ++n) _Pragma("unroll") for (int k = 0; k < 2; ++k) \
        acc[ai][bj][m][n] = __builtin_amdgcn_mfma_f32_16x16x32_bf16(Bt[n][k], At[m][k], acc[ai][bj][m][n], 0, 0, 0); __builtin_amdgcn_s_setprio(0); } while (0)
#define PG8_WAIT_V(n) asm volatile("s_waitcnt vmcnt(" #n ")" ::: "memory")
#define PG8_WAIT_L(n) asm volatile("s_waitcnt lgkmcnt(" #n ")" ::: "memory")
#define PG8_BAR __builtin_amdgcn_s_barrier()
#define PG8_SCHED __builtin_amdgcn_sched_barrier(0)
#define PG8_GATHER_OFFS(d00, d01, d10, d11, u) do { if constexpr (GATHER) { const int* ri_ = g.rowidx + (u).gb; int t_ = wv * 64 + lane_id_(); asm volatile("" : "+v"(t_)); \
        int R0_, C0_, R1_, C1_; stage_rc(t_ * 16, R0_, C0_); stage_rc(t_ * 16 + 8192, R1_, C1_);     \
        d00 = (unsigned)(ri_[R0_] * lda + C0_) * 2u; d01 = (unsigned)(ri_[R1_] * lda + C1_) * 2u; \
        d10 = (unsigned)(ri_[HALF + R0_] * lda + C0_) * 2u; d11 = (unsigned)(ri_[HALF + R1_] * lda + C1_) * 2u; } } while (0)
    Unit cur, nxt; int ui = 0;
    if (!S.next(0, cur)) return;
    f32x4 acc[2][2][4][2];
#pragma unroll
    for (int a = 0; a < 2; ++a)
#pragma unroll
        for (int b = 0; b < 2; ++b)
#pragma unroll
            for (int m = 0; m < 4; ++m)
#pragma unroll
                for (int n = 0; n < 2; ++n) acc[a][b][m][n] = (f32x4){0.f, 0.f, 0.f, 0.f};
    bf16x8 At[4][2], B0[2][2], B1[2][2];
    const char* cA = (const char*)g.A + (GATHER ? (size_t)0 : (size_t)cur.pm * tstepA) + (size_t)cur.ko * 2; const char* cB0 = PG8_BSRC(cur, 0); const char* cB1 = PG8_BSRC(cur, 1);
    PG8_GATHER_OFFS(va00, va01, va10, va11, cur);
    S.a_ready(cur);
    PG8_STAGE(PG8_SA(0, 0), cA, va00, va01); PG8_STAGE(PG8_SA(0, 1), cA, va10, va11);
    PG8_BLOAD(cB0); PG8_BWAIT(0); PG8_BWRITE(PG8_SB(0, 0));
    PG8_BLOAD(cB1); PG8_BWAIT(0); PG8_BWRITE(PG8_SB(0, 1));
    PG8_BLOAD(cB0 + bkstep); PG8_BWAIT(0); PG8_BWRITE(PG8_SB(1, 0));
    PG8_BLOAD(cB1 + bkstep); PG8_STAGE(PG8_SA(1, 0), cA + kstep, va00, va01);
    PG8_WAIT_L(0);
    if (wr == 1) PG8_BAR;
    PG8_BAR;
    PG8_BAR;
    for (;;) {
        const bool has_next = S.next(ui + 1, nxt);
        const char* nA = has_next ? (const char*)g.A + (GATHER ? (size_t)0 : (size_t)nxt.pm * tstepA) + (size_t)nxt.ko * 2 : cA; const char* nB0 = has_next ? PG8_BSRC(nxt, 0) : cB0; const char* nB1 = has_next ? PG8_BSRC(nxt, 1) : cB1;
        const int nt = K / BK;
        for (int t = 0; t < nt; t += 2) {
            const bool last = (t == nt - 2);
            const char* a1 = cA + (size_t)(t + 1) * kstep;
            const char* a2 = last ? nA : cA + (size_t)(t + 2) * kstep;
            const char* b20 = last ? nB0 : cB0 + (size_t)(t + 2) * bkstep; const char* b21 = last ? nB1 : cB1 + (size_t)(t + 2) * bkstep;
            const char* a3 = a2 + kstep; const char* b30 = b20 + bkstep; const char* b31 = b21 + bkstep;
            if constexpr (GATHER) { if (last) { if (has_next) PG8_GATHER_OFFS(vn00, vn01, vn10, vn11, nxt); else { vn00 = va00; vn01 = va01; vn10 = va10; vn11 = va11; } } }
            const bool usen_ = GATHER && last;
            const unsigned v200 = usen_ ? vn00 : va00, v201 = usen_ ? vn01 : va01, v210 = usen_ ? vn10 : va10, v211 = usen_ ? vn11 : va11;
            if (last && has_next) S.a_ready(nxt);
            PG8_LDB(B0, 0, 0); PG8_LDB(B1, 0, 1); PG8_SCHED; PG8_LDA(At, 0, 0);
            PG8_BWAIT(2); PG8_BWRITE(PG8_SB(1, 1)); PG8_BLOAD(b20); PG8_STAGE(PG8_SA(1, 1), a1, va10, va11);
            PG8_WAIT_L(0); PG8_BAR; PG8_MMA(0, 0, At, B0); PG8_MMA(0, 1, At, B1); PG8_BAR; PG8_SCHED;
            PG8_LDA(At, 0, 1);
            PG8_BWAIT(2); PG8_BWRITE(PG8_SB(0, 0)); PG8_BLOAD(b21); PG8_STAGE(PG8_SA(0, 0), a2, v200, v201);
            PG8_WAIT_L(0); PG8_BAR; PG8_MMA(1, 0, At, B0); PG8_MMA(1, 1, At, B1); PG8_BAR; PG8_SCHED;
            PG8_LDB(B0, 1, 0); PG8_LDB(B1, 1, 1); PG8_SCHED; PG8_LDA(At, 1, 0);
            PG8_BWAIT(2); PG8_BWRITE(PG8_SB(0, 1)); PG8_BLOAD(b30); PG8_STAGE(PG8_SA(0, 1), a2, v210, v211);
            PG8_WAIT_L(0); PG8_BAR; PG8_MMA(0, 0, At, B0); PG8_MMA(0, 1, At, B1); PG8_BAR; PG8_SCHED;
            PG8_LDA(At, 1, 1);
            PG8_BWAIT(2); PG8_BWRITE(PG8_SB(1, 0)); PG8_BLOAD(b31); PG8_STAGE(PG8_SA(1, 0), a3, v200, v201);
            PG8_WAIT_L(0); PG8_BAR; PG8_MMA(1, 0, At, B0); PG8_MMA(1, 1, At, B1); PG8_BAR; PG8_SCHED;
        }
        if (wr == 0) PG8_BAR;
        E(acc, cur, wr, wc, fr, fq); S.done(cur);
        if (!has_next) break;
#pragma unroll
        for (int a = 0; a < 2; ++a)
#pragma unroll
            for (int b = 0; b < 2; ++b)
#pragma unroll
                for (int m = 0; m < 4; ++m)
#pragma unroll
                    for (int n = 0; n < 2; ++n) acc[a][b][m][n] = (f32x4){0.f, 0.f, 0.f, 0.f};
        cur = nxt; cA = nA; cB0 = nB0; cB1 = nB1; ++ui;
        if constexpr (GATHER) { va00 = vn00; va01 = vn01; va10 = vn10; va11 = vn11; }
        if (wr == 1) PG8_BAR;
    }
    PG8_WAIT_V(0);
    PG8_BAR;
#undef PG8_SA
#undef PG8_SB
#undef PG8_STAGE
#undef PG8_BLOAD
#undef PG8_BWAIT
#undef PG8_BWRITE
#undef PG8_BSRC
#undef PG8_LDA
#undef PG8_LDB
#undef PG8_MMA
#undef PG8_WAIT_V
#undef PG8_WAIT_L
#undef PG8_BAR
#undef PG8_SCHED
#undef PG8_GATHER_OFFS
}
}

#ifndef PG8_SP2
#define PG8_SP2 true
#endif
#ifndef PG8_ALIGN
#define PG8_ALIGN true
#endif
#ifndef MK_PER_PHASE
#define MK_PER_PHASE 0
#endif

constexpr int NWAVES = 8;
constexpr int DM = 2048, NB = 8, SEQ = 2048, CTX = 256, TPB = CTX + SEQ, T = NB * TPB;
constexpr int EVEN_IN_P = 2816, ODD_IN = 4608;
constexpr int NE = 32, DE = 1024, MAXSLOT = 45056;
constexpr float NORM_EPS = 1e-6f;
constexpr float LAMBDA_INIT = 0.35550906759f;
constexpr int NPHASE = 27;
#ifndef MOE_F32B
#define MOE_F32B 0
#endif
#ifndef KR_IN_POST1
#define KR_IN_POST1 1
#endif
#ifndef MOE_HANDOFF
#define MOE_HANDOFF 0
#endif
#ifndef FUSED_ROUTE
#define FUSED_ROUTE 1
#endif
#ifndef ATT_DIFF_FUSED
#define ATT_DIFF_FUSED 1
#endif
#ifndef BG_CONVERT
#define BG_CONVERT 1
#endif
#ifndef BG_FILL
#define BG_FILL 1
#endif
#ifndef BG_GEFF
#define BG_GEFF 1
#endif
#ifndef USE_NAIVE_ATTN
#define USE_NAIVE_ATTN 0
#endif

constexpr size_t MiB = 1u << 20;
constexpr size_t WS_CTL = 0, CTL_ZERO_BYTES = 1 * MiB;
constexpr size_t WS_MOD = 1 * MiB;
constexpr size_t WS_ROPE = 2 * MiB;
constexpr size_t WS_ROUTE = 3 * MiB;
constexpr size_t WS_WE_IN = 4 * MiB;
constexpr size_t WS_WE_UQ = 15 * MiB;
constexpr size_t WS_WE_UKV = 17 * MiB;
constexpr size_t WS_WE_OUT = 19 * MiB;
constexpr size_t WS_WO_IN = 27 * MiB;
constexpr size_t WS_WO_OUT = 45 * MiB;
constexpr size_t WS_WR = 53 * MiB;
constexpr size_t WS_WGU = 60 * MiB;
constexpr size_t WS_WDN = 572 * MiB;
constexpr size_t WS_H = 828 * MiB;
constexpr size_t WS_A1 = 972 * MiB;
constexpr size_t WS_MIX = 1044 * MiB;
constexpr size_t WS_R = 1116 * MiB;
constexpr size_t WS_Y1 = WS_R;
constexpr size_t WS_CQN = WS_R + 162 * MiB;
constexpr size_t WS_CKVN = WS_R + 180 * MiB;
constexpr size_t WS_QB = WS_R + 198 * MiB;
constexpr size_t WS_KV = WS_R + 252 * MiB;
constexpr size_t WS_KB = WS_R + 324 * MiB;
constexpr size_t WS_XS = WS_R;
constexpr size_t WS_U = WS_R + 176 * MiB;
constexpr size_t WS_YS = WS_R + 264 * MiB;
constexpr size_t WS_LG = WS_R + 440 * MiB;
constexpr size_t WS_POS = WS_R + 460 * MiB;
constexpr int POSCAP = 18432;
constexpr size_t WS_ZROW = WS_R + 466 * MiB;
constexpr int ZROW_IDX = (int)((WS_ZROW - WS_A1) / 4096);
constexpr size_t WS_END = WS_R + 467 * MiB;
constexpr int RKS = 4;
constexpr int CW_CNT = 64;
constexpr int CW_NRT = 256;
constexpr int CW_TEXP = 512;
constexpr int CW_BAR = 4096;
constexpr int CW_RDY = 32768;
constexpr int CW_ITEM = 8192;
constexpr int CW_SLOT = 16384;

constexpr int RING_OFF = 0, RING_BYTES = 131072;
constexpr int LDSCTL_OFF = RING_BYTES, MISC_OFF = LDSCTL_OFF + 320;
constexpr int LDS_BYTES = 147456;
constexpr int LDS_TAB = 135168;

#define GAS __attribute__((address_space(1)))
#define LAS __attribute__((address_space(3)))
typedef unsigned short bf16;
typedef unsigned v4u __attribute__((ext_vector_type(4)));
typedef unsigned v2u __attribute__((ext_vector_type(2)));
typedef float f32x4 __attribute__((ext_vector_type(4)));
typedef GAS unsigned gu32;
#define RLX_AGENT __ATOMIC_RELAXED, __HIP_MEMORY_SCOPE_AGENT
#define LDS_WAIT() asm volatile("s_waitcnt lgkmcnt(0)" ::: "memory")
#define VM_WAIT() asm volatile("s_waitcnt vmcnt(0)" ::: "memory")
__device__ __forceinline__ unsigned f2bf(float f) { unsigned u = __builtin_bit_cast(unsigned, f); return (u + 0x7fffu + ((u >> 16) & 1u)) >> 16; }
__device__ __forceinline__ unsigned pk2(float lo, float hi) { return f2bf(lo) | (f2bf(hi) << 16); }
__device__ __forceinline__ float bf2f(unsigned short h) { return __builtin_bit_cast(float, (unsigned)h << 16); }
__device__ __forceinline__ float bflo(unsigned w) { return __builtin_bit_cast(float, w << 16); }
__device__ __forceinline__ float bfhi(unsigned w) { return __builtin_bit_cast(float, w & 0xffff0000u); }
__device__ __forceinline__ float wave_sum(float v) {
#pragma unroll
    for (int o = 1; o < 64; o <<= 1) v += __shfl_xor(v, o);
    return v;
}
__device__ __forceinline__ float wave_max(float v) {
#pragma unroll
    for (int o = 1; o < 64; o <<= 1) v = fmaxf(v, __shfl_xor(v, o));
    return v;
}
#define XB_TMO      128
#define XB_XCNT(j)  (256  + 64 * (j))
#define XB_XSUB(j)  (1280 + 64 * (j))
#define XB_XGEN(j)  (2304 + 64 * (j))
#define XB_TOP      3328
#define XB_TOPGEN   3392
#define XCD_BAR_WORDS 3456
#define XB_SPIN_CAP (1u << 18)

__device__ __forceinline__ unsigned xb_ld(unsigned* p)              { return __hip_atomic_load(p, __ATOMIC_RELAXED, __HIP_MEMORY_SCOPE_AGENT); }
__device__ __forceinline__ unsigned xb_add(unsigned* p, unsigned v) { return __hip_atomic_fetch_add(p, v, __ATOMIC_RELAXED, __HIP_MEMORY_SCOPE_AGENT); }
__device__ __forceinline__ unsigned xb_xcc_id() { return (unsigned)__builtin_amdgcn_s_getreg((3 << 11) | 20) & 0xFu; }
#define XB_SPIN(cond, bar) do { unsigned _sp = 0; while (cond) { __builtin_amdgcn_s_sleep(1); \
    if ((++_sp & 255u) == 0u) { if (xb_ld(&(bar)[XB_TMO])) break; if (_sp > XB_SPIN_CAP) { atomicAdd(&(bar)[XB_TMO], 1u); break; } } } } while (0)

struct XcdBarrier {
    unsigned* bar; unsigned x;
    volatile LAS unsigned* st;
};

__device__ __forceinline__ XcdBarrier xcd_barrier_post(unsigned* bar, volatile LAS unsigned* st) {
    XcdBarrier b; b.bar = bar; b.x = xb_xcc_id(); b.st = st;
    if (threadIdx.x == 0) (void)xb_add(&bar[XB_XCNT(b.x)], 1u);
    return b;
}
__device__ __forceinline__ void xcd_barrier_complete(unsigned* bar, unsigned x, unsigned& nloc, unsigned& nx) {
    const unsigned G = gridDim.x * gridDim.y * gridDim.z;
    unsigned sum, cnt, mine, sp = 0u;
    for (;;) {
        sum = 0u; cnt = 0u; mine = 0u;
#pragma unroll
        for (unsigned j = 0; j < 16; ++j) { const unsigned c = xb_ld(&bar[XB_XCNT(j)]); sum += c; cnt += (c > 0u) ? 1u : 0u; mine = (j == x) ? c : mine; }
        if (sum == G) break;
        __builtin_amdgcn_s_sleep(1);
        if ((++sp & 255u) == 0u) { if (xb_ld(&bar[XB_TMO])) break; if (sp > XB_SPIN_CAP) { atomicAdd(&bar[XB_TMO], 1u); break; } }
    }
    nloc = mine > 0u ? mine : 1u; nx = cnt > 0u ? cnt : 1u;
}

__device__ __forceinline__ void xcd_barrier(const XcdBarrier& b) {
    asm volatile("s_waitcnt vmcnt(0)" ::: "memory");
    __syncthreads();
    if (threadIdx.x == 0) {
        unsigned* bar = b.bar;
        __builtin_amdgcn_s_waitcnt(0);
        unsigned nloc = b.st[0], nx = b.st[1];
        if (nloc == 0u) { xcd_barrier_complete(bar, b.x, nloc, nx); b.st[0] = nloc; b.st[1] = nx; }
        const unsigned old = xb_add(&bar[XB_XSUB(b.x)], 1u);
        const unsigned gen = old / nloc;
        if (old + 1u == (gen + 1u) * nloc) {
            __builtin_amdgcn_fence(__ATOMIC_RELEASE, "agent");
            asm volatile("s_waitcnt vmcnt(0)" ::: "memory");
            const unsigned og = xb_add(&bar[XB_TOP], 1u);
            const unsigned tg = og / nx;
            if (og + 1u == (tg + 1u) * nx) xb_add(&bar[XB_TOPGEN], 1u);
            else XB_SPIN(xb_ld(&bar[XB_TOPGEN]) == tg, bar);
            __builtin_amdgcn_fence(__ATOMIC_ACQUIRE, "agent");
            xb_add(&bar[XB_XGEN(b.x)], 1u);
            asm volatile("s_waitcnt vmcnt(0)" ::: "memory");
        } else {
            XB_SPIN(xb_ld(&bar[XB_XGEN(b.x)]) == gen, bar);
            __builtin_amdgcn_fence(__ATOMIC_ACQUIRE, "agent");
            asm volatile("s_waitcnt vmcnt(0)" ::: "memory");
        }
    }
    __syncthreads();
}

struct Frame {
    LAS unsigned char* lds;
    volatile LAS unsigned* MISC;
    gu32* ctl;
    unsigned char* ws;
    int tid, lane, wave, vcu, G;
};
typedef short bf16x8_t __attribute__((ext_vector_type(8)));
struct LocalId { int tid, lane, wave; };
__device__ __forceinline__ LocalId local_id_w(int wave) { int t = wave * 64 + lane_id_(); asm volatile("" : "+v"(t)); LocalId l; l.tid = t; l.lane = t & 63; l.wave = wave; return l; }
#define local_id() local_id_w(F.wave)
struct Args { const float* in[35]; float* out; unsigned char* ws; int ph_lo, ph_hi; };
enum { I_X = 0, I_C, I_CTX, I_CCTX, I_MODW, I_MODB, I_EWIN, I_EWOUT, I_AQN, I_AKN, I_BCQN, I_BWUQ, I_BCKVN, I_BWUKV, I_BQN, I_BKN, I_OWIN, I_OWOUT,
       I_CQN, I_CKN, I_LQ1, I_LK1, I_LQ2, I_LK2, I_SUBLN, I_DQN, I_DKN, I_SINK, I_WRG, I_BRG, I_WRE, I_BRE, I_WG, I_WU, I_WD };

__device__ __forceinline__ int mod_index(int row) { const int b = row / TPB; return (row - b * TPB) < CTX ? 8 : b; }

__device__ __forceinline__ unsigned cvt_pk_bf16(float lo, float hi) { unsigned r; asm volatile("v_cvt_pk_bf16_f32 %0, %1, %2" : "=v"(r) : "v"(lo), "v"(hi)); return r; }
#ifndef NT_THIN
#define NT_THIN 1
#endif
#if NT_THIN
#define NT_LD(p) __builtin_nontemporal_load(p)
#define NT_ST(v, p) __builtin_nontemporal_store((v), (p))
#else
#define NT_LD(p) (*(p))
#define NT_ST(v, p) (*(p) = (v))
#endif
#ifndef NT_X
#define NT_X 1
#endif
#ifndef NT_YS
#define NT_YS 1
#endif
#ifndef NT_OUT
#define NT_OUT 1
#endif
#define NT_LD_IF(c, p) ((c) ? NT_LD(p) : *(p))
#ifndef SMALL_W_CACHED
#define SMALL_W_CACHED 0
#endif
#ifndef TR_NT_LOAD
#define TR_NT_LOAD 1
#endif
#ifndef TR_NT_STORE
#define TR_NT_STORE 1
#endif
struct TrAddr { const float* src; bf16* dst; int N, Kd; };
__device__ __forceinline__ void tr_load(f32x4 (&v)[8], const TrAddr& t, int lane) {
    const int kr = lane >> 3, cq = lane & 7;
#pragma unroll
#if TR_NT_LOAD
    for (int i = 0; i < 8; ++i) v[i] = __builtin_nontemporal_load((const f32x4*)(t.src + (size_t)(8 * kr + i) * t.N + 4 * cq));
#else
    for (int i = 0; i < 8; ++i) v[i] = *(const f32x4*)(t.src + (size_t)(8 * kr + i) * t.N + 4 * cq);
#endif
}
template <bool NT = true>
__device__ __forceinline__ void tr_store(const f32x4 (&v)[8], const TrAddr& t, int lane) {
    const int kr = lane >> 3, cq = lane & 7;
#pragma unroll
    for (int e = 0; e < 4; ++e) { v4u o; o.x = cvt_pk_bf16(v[0][e], v[1][e]); o.y = cvt_pk_bf16(v[2][e], v[3][e]); o.z = cvt_pk_bf16(v[4][e], v[5][e]); o.w = cvt_pk_bf16(v[6][e], v[7][e]);
#if TR_NT_STORE
        if (NT) __builtin_nontemporal_store(o, (v4u*)(t.dst + (size_t)(4 * cq + e) * t.Kd + 8 * kr)); else *(GAS v4u*)(t.dst + (size_t)(4 * cq + e) * t.Kd + 8 * kr) = o; }
#else
        *(GAS v4u*)(t.dst + (size_t)(4 * cq + e) * t.Kd + 8 * kr) = o; }
#endif
}
__device__ __forceinline__ void transpose_item(const float* W, int N, int k0, int n0, bf16* dst, int Kd, LAS float* scr, int lane) {
    (void)scr; TrAddr t; t.src = W + (size_t)k0 * N + n0; t.dst = dst + k0; t.N = N; t.Kd = Kd;
    f32x4 v[8]; tr_load(v, t, lane); tr_store<!SMALL_W_CACHED>(v, t, lane);
}
__device__ __forceinline__ void small_transpose(const float* W, int K, int N, bf16* WT, int item, LAS float* scr, int lane) {
    const int nblk = N / 32, kb = item / nblk, nb = item - kb * nblk;
    transpose_item(W, N, kb * 64, nb * 32, WT + (size_t)(nb * 32) * K, K, scr, lane);
}
__device__ __forceinline__ TrAddr moe_item_addr(const Frame& F, const Args& a, int r) {
    int le, which, ri;
    if (r < 32 * 3072) { le = r / 3072; const int q = r - le * 3072; which = q >> 10; ri = q & 1023; }
    else if (r < 32 * 3072 + 32 * 2048) { const int r1 = r - 32 * 3072; le = 32 + (r1 >> 11); which = (r1 >> 10) & 1; ri = r1 & 1023; }
    else { const int r2 = r - (32 * 3072 + 32 * 2048); le = 32 + (r2 >> 10); which = 2; ri = r2 & 1023; }
    TrAddr t;
    if (which < 2) { const int kb = ri >> 5, n0 = (ri & 31) * 32;
        t.src = a.in[which == 0 ? I_WG : I_WU] + (size_t)le * 2048 * 1024 + (size_t)(kb * 64) * 1024 + n0; t.N = 1024;
        t.dst = (bf16*)(F.ws + WS_WGU) + (size_t)le * 2048 * 2048 + (size_t)((n0 >> 7) * 256 + which * 128 + (n0 & 127)) * 2048 + kb * 64; t.Kd = 2048;
    } else { const int kb = ri >> 6, n0 = (ri & 63) * 32;
        t.src = a.in[I_WD] + (size_t)le * 1024 * 2048 + (size_t)(kb * 64) * 2048 + n0; t.N = 2048;
        t.dst = (bf16*)(F.ws + WS_WDN) + (size_t)le * 2048 * 1024 + (size_t)n0 * 1024 + kb * 64; t.Kd = 1024; }
    return t;
}
__device__ __forceinline__ void moe_item(const Frame& F, const Args& a, int r, LAS float* scr, int lane) { (void)scr; const TrAddr t = moe_item_addr(F, a, r); f32x4 v[8]; tr_load(v, t, lane); tr_store(v, t, lane); }
__device__ __forceinline__ void p0_prologue(const Frame& F, const Args& a) {
    const LocalId L_ = local_id(); (void)L_;
    const int gt = F.vcu * 512 + L_.tid, NT = F.G * 512;
    {
        float2* t128 = (float2*)(F.ws + WS_ROPE); float2* t64 = (float2*)(F.ws + WS_ROPE + 16384);
        for (int i = gt; i < 3072; i += NT) {
            if (i < 2048) { const int pos = i >> 5, f = i & 31; const float inv = 1.0f / powf(10000.0f, (float)f / 32.0f); const float ang = (float)pos * inv; t128[i] = make_float2(cosf(ang), sinf(ang)); }
            else { const int k = i - 2048, pos = k >> 4, f = k & 15; const float inv = 1.0f / powf(10000.0f, (float)f / 16.0f); const float ang = (float)pos * inv; t64[k] = make_float2(cosf(ang), sinf(ang)); }
        }
    }
    { float* gsub = (float*)(F.ws + WS_ROPE + 32768); for (int i = gt; i < 128; i += NT) gsub[i] = a.in[I_SUBLN][i] * (1.0f - LAMBDA_INIT); }
    { v4u* pt = (v4u*)(F.ws + WS_POS); for (int i = gt; i < 2 * NE * POSCAP / 4; i += NT) pt[i] = (v4u){(unsigned)ZROW_IDX, (unsigned)ZROW_IDX, (unsigned)ZROW_IDX, (unsigned)ZROW_IDX};
      v4u* zr = (v4u*)(F.ws + WS_ZROW); for (int i = gt; i < 4096 / 16; i += NT) zr[i] = (v4u){0u, 0u, 0u, 0u}; }
    {
        bf16* WR = (bf16*)(F.ws + WS_WR);
        for (int i = gt; i < 2 * 256 * 2048; i += NT) { const int l = i >> 19, r = (i >> 11) & 255, k = i & 2047;
            float v = 0.f; if (r < 4) v = a.in[I_WRG][((size_t)l * 2048 + k) * 4 + r]; else if (r < 36) v = a.in[I_WRE][((size_t)l * 2048 + k) * 32 + (r - 4)];
            WR[i] = (bf16)f2bf(v); }
        v4u* z = (v4u*)((bf16*)(F.ws + WS_WE_IN) + (size_t)2624 * 2048);
        for (int i = gt; i < 192 * 2048 / 8; i += NT) z[i] = (v4u){0u, 0u, 0u, 0u};
    }
    {
        LAS float* sl = (LAS float*)(F.lds + RING_OFF);
        LAS float* red = (LAS float*)(F.lds + RING_OFF + 73728);
        for (int i = L_.tid; i < 9 * 2048; i += 512) { const int j = i >> 11, k = i & 2047; const float v = j < 8 ? a.in[I_C][j * 2048 + k] : a.in[I_CCTX][k]; sl[i] = v / (1.0f + expf(-v)); }
        __syncthreads();
        float* MOD = (float*)(F.ws + WS_MOD);
        const int cg = L_.lane & 31, ks = L_.lane >> 5;
        for (int item = blockIdx.x; item < 192; item += F.G) {
            const int layer = item / 96, chunk = item - layer * 96, col0 = chunk * 128;
            const float* W = a.in[I_MODW] + (size_t)layer * 2048 * 12288 + col0 + cg * 4;
            f32x4 acc[9];
#pragma unroll
            for (int j = 0; j < 9; ++j) acc[j] = (f32x4){0.f, 0.f, 0.f, 0.f};
#pragma unroll 8
            for (int it = 0; it < 128; ++it) { const int k = L_.wave * 256 + it * 2 + ks; const f32x4 w = *(const f32x4*)(W + (size_t)k * 12288);
#pragma unroll
                for (int j = 0; j < 9; ++j) { const float s = sl[j * 2048 + k]; acc[j] = acc[j] + w * s; } }
#pragma unroll
            for (int j = 0; j < 9; ++j)
#pragma unroll
                for (int e = 0; e < 4; ++e) { float v = acc[j][e]; v += __shfl_xor(v, 32); acc[j][e] = v; }
            if (L_.lane < 32) {
#pragma unroll
                for (int j = 0; j < 9; ++j)
#pragma unroll
                    for (int e = 0; e < 4; ++e) red[(L_.wave * 9 + j) * 128 + cg * 4 + e] = acc[j][e]; }
            __syncthreads();
            for (int t = L_.tid; t < 9 * 128; t += 512) { const int j = t >> 7, cc = t & 127; float s = a.in[I_MODB][layer * 12288 + col0 + cc];
#pragma unroll
                for (int w = 0; w < 8; ++w) s += red[(w * 9 + j) * 128 + cc];
                MOD[((size_t)layer * 9 + j) * 12288 + col0 + cc] = s; }
            __syncthreads();
        }
    }
    {
        LAS float* scr = (LAS float*)(F.lds + RING_OFF + L_.wave * 16384);
        const int gw = F.vcu * NWAVES + L_.wave, NGW = F.G * NWAVES;
        constexpr int I0 = 32 * 82, I1 = 8 * 48, I2 = 8 * 64, I3 = 32 * 64, I4 = 32 * 144, I5 = 32 * 64, NSMALL = I0 + I1 + I2 + I3 + I4 + I5;
#if MOE_F32B || BG_CONVERT
        constexpr int NMOE = 0;
#else
        constexpr int NMOE = 64 * 3072;
#endif
        for (int it = gw; it < NSMALL + NMOE; it += NGW) {
            int r = it;
            if (r < NSMALL) {
                if (r < I0) { small_transpose(a.in[I_EWIN], 2048, 2624, (bf16*)(F.ws + WS_WE_IN), r, scr, L_.lane); continue; } r -= I0;
                if (r < I1) { small_transpose(a.in[I_BWUQ], 512, 1536, (bf16*)(F.ws + WS_WE_UQ), r, scr, L_.lane); continue; } r -= I1;
                if (r < I2) { small_transpose(a.in[I_BWUKV], 512, 2048, (bf16*)(F.ws + WS_WE_UKV), r, scr, L_.lane); continue; } r -= I2;
                if (r < I3) { small_transpose(a.in[I_EWOUT], 2048, 2048, (bf16*)(F.ws + WS_WE_OUT), r, scr, L_.lane); continue; } r -= I3;
                if (r < I4) { small_transpose(a.in[I_OWIN], 2048, 4608, (bf16*)(F.ws + WS_WO_IN), r, scr, L_.lane); continue; } r -= I4;
                small_transpose(a.in[I_OWOUT], 2048, 2048, (bf16*)(F.ws + WS_WO_OUT), r, scr, L_.lane); continue;
            }
            moe_item(F, a, r - NSMALL, scr, L_.lane);
        }
    }
}

__device__ __forceinline__ void modulate_store(const f32x4 (&v)[8], const float* shift, const float* scale, bf16* orow, int lane) {
    float ss = 0.f;
#pragma unroll
    for (int j = 0; j < 8; ++j) ss += (v[j].x * v[j].x + v[j].y * v[j].y) + (v[j].z * v[j].z + v[j].w * v[j].w);
    ss = wave_sum(ss);
    const float r = 1.0f / sqrtf(ss * (1.0f / 2048.0f) + NORM_EPS);
#pragma unroll
    for (int j = 0; j < 8; ++j) { const f32x4 sh = ((const f32x4*)shift)[lane + 64 * j], sc = ((const f32x4*)scale)[lane + 64 * j];
        const f32x4 y = v[j] * r * (sc + 1.0f) + sh; v2u o; o.x = pk2(y.x, y.y); o.y = pk2(y.z, y.w); ((v2u*)orow)[lane + 64 * j] = o; }
}
__device__ __forceinline__ void moe_combine_load(const bf16* YS, const int* rec, const LAS int* offs, int lane, f32x4 (&y)[8]) {
    const int s0 = offs[rec[0]] + rec[2], s1 = offs[rec[1]] + rec[3]; const float w0 = __builtin_bit_cast(float, rec[4]), w1 = __builtin_bit_cast(float, rec[5]);
    const v2u* p0 = (const v2u*)(YS + (size_t)s0 * 2048); const v2u* p1 = (const v2u*)(YS + (size_t)s1 * 2048);
#pragma unroll
    for (int j = 0; j < 8; ++j) { const v2u a = NT_LD_IF(NT_YS, p0 + lane + 64 * j), b = NT_LD_IF(NT_YS, p1 + lane + 64 * j);
        y[j].x = w0 * bflo(a.x) + w1 * bflo(b.x); y[j].y = w0 * bfhi(a.x) + w1 * bfhi(b.x); y[j].z = w0 * bflo(a.y) + w1 * bflo(b.y); y[j].w = w0 * bfhi(a.y) + w1 * bfhi(b.y); }
}

__device__ __forceinline__ int moe_tables(const Frame& F, int layer, int tid) {
    LAS int* texp = (LAS int*)(F.lds + LDS_TAB); LAS int* frt = texp + 256; LAS int* offs = frt + 40;
    if (tid < 64) {
        const int e = tid & 31;
        const unsigned c = __hip_atomic_load((unsigned*)(F.ctl + CW_CNT + layer * 64 + e), RLX_AGENT);
        const int pad = (int)((c + 255u) & ~255u);
        int incl = pad;
#pragma unroll
        for (int d = 1; d < 32; d <<= 1) { const int v = __shfl_up(incl, d); if ((tid & 31) >= d) incl += v; }
        const int excl = incl - pad;
        if (tid < 32) { offs[e] = excl; frt[e] = excl >> 8; for (int r = excl >> 8; r < (incl >> 8); ++r) texp[r] = e; if (e == 31) { offs[NE] = incl; frt[NE] = incl >> 8; } }
    }
    __syncthreads();
    return frt[NE];
}
__device__ __forceinline__ void hrow_load(const bf16* hrow, int lane, f32x4 (&v)[8]) {
#pragma unroll
    for (int q = 0; q < 8; ++q) { const v2u w = ((const v2u*)hrow)[lane + 64 * q]; v[q].x = bflo(w.x); v[q].y = bfhi(w.x); v[q].z = bflo(w.y); v[q].w = bfhi(w.y); }
}
__device__ __forceinline__ void hrow_store(bf16* hrow, int lane, const f32x4 (&v)[8]) {
#pragma unroll
    for (int q = 0; q < 8; ++q) { v2u o; o.x = pk2(v[q].x, v[q].y); o.y = pk2(v[q].z, v[q].w); ((v2u*)hrow)[lane + 64 * q] = o; }
}
__device__ __forceinline__ void modulate_store_l(const f32x4 (&v)[8], const LAS float* shift, const LAS float* scale, bf16* orow, int lane) {
    float ss = 0.f;
#pragma unroll
    for (int j = 0; j < 8; ++j) ss += (v[j].x * v[j].x + v[j].y * v[j].y) + (v[j].z * v[j].z + v[j].w * v[j].w);
    ss = wave_sum(ss);
    const float r = 1.0f / sqrtf(ss * (1.0f / 2048.0f) + NORM_EPS);
#pragma unroll
    for (int j = 0; j < 8; ++j) { const f32x4 sh = ((const LAS f32x4*)shift)[lane + 64 * j], sc = ((const LAS f32x4*)scale)[lane + 64 * j];
        const f32x4 y = v[j] * r * (sc + 1.0f) + sh; v2u o; o.x = pk2(y.x, y.y); o.y = pk2(y.z, y.w); ((v2u*)orow)[lane + 64 * j] = o; }
}
__device__ __forceinline__ const float* l0_src_row(const Args& a, int row, int& j) {
    const int b = row / TPB, r = row - b * TPB; j = r < CTX ? 8 : b;
    return r < CTX ? a.in[I_CTX] + (size_t)(b * CTX + r) * DM : a.in[I_X] + (size_t)(b * SEQ + (r - CTX)) * DM;
}
__device__ __forceinline__ void p_l0_mod1(const Frame& F, const Args& a) {
    const LocalId L_ = local_id(); (void)L_;
    const int gw = F.vcu * NWAVES + L_.wave, NGW = F.G * NWAVES;
    const float* MOD = (const float*)(F.ws + WS_MOD); bf16* A1 = (bf16*)(F.ws + WS_A1);
    for (int r0 = gw; r0 < T; r0 += 2 * NGW) {
        const int r1 = r0 + NGW; const bool ok1 = r1 < T;
        int j0, j1 = 0; const float* s0 = l0_src_row(a, r0, j0); const float* s1 = ok1 ? l0_src_row(a, r1, j1) : s0;
        f32x4 v0[8], v1[8];
#pragma unroll
        for (int q = 0; q < 8; ++q) v0[q] = NT_LD_IF(NT_X, (const f32x4*)s0 + L_.lane + 64 * q);
#pragma unroll
        for (int q = 0; q < 8; ++q) v1[q] = NT_LD_IF(NT_X, (const f32x4*)s1 + L_.lane + 64 * q);
        const float* m0 = MOD + (size_t)(0 * 9 + j0) * 12288;
        modulate_store(v0, m0 + 0 * 2048, m0 + 1 * 2048, A1 + (size_t)r0 * DM, L_.lane);
        if (ok1) {
            const float* m1 = MOD + (size_t)(0 * 9 + j1) * 12288;
            modulate_store(v1, m1 + 0 * 2048, m1 + 1 * 2048, A1 + (size_t)r1 * DM, L_.lane);
        }
    }
}
__device__ __forceinline__ void p_mod2(const Frame& F, int layer) {
    const LocalId L_ = local_id(); (void)L_;
    const int gw = F.vcu * NWAVES + L_.wave, NGW = F.G * NWAVES;
    const float* MOD = (const float*)(F.ws + WS_MOD); const bf16* H = (const bf16*)(F.ws + WS_H); bf16* A1 = (bf16*)(F.ws + WS_A1);
    for (int r0 = gw; r0 < T; r0 += 2 * NGW) {
        const int r1 = r0 + NGW; const int j0 = mod_index(r0), j1 = r1 < T ? mod_index(r1) : 8;
        const bool ok0 = !(layer == 1 && j0 == 8), ok1 = r1 < T && !(layer == 1 && j1 == 8);
        f32x4 v0[8], v1[8];
        if (ok0) hrow_load(H + (size_t)r0 * DM, L_.lane, v0);
        if (ok1) hrow_load(H + (size_t)r1 * DM, L_.lane, v1);
        if (ok0) { const float* m = MOD + (size_t)(layer * 9 + j0) * 12288; modulate_store(v0, m + 3 * 2048, m + 4 * 2048, A1 + (size_t)r0 * DM, L_.lane); }
        if (ok1) { const float* m = MOD + (size_t)(layer * 9 + j1) * 12288; modulate_store(v1, m + 3 * 2048, m + 4 * 2048, A1 + (size_t)r1 * DM, L_.lane); }
    }
}
__device__ __forceinline__ void p_l1_mod1(const Frame& F, size_t hdst_off = WS_H, size_t adst_off = WS_A1) {
    const LocalId L_ = local_id(); (void)L_;
    const float* MOD = (const float*)(F.ws + WS_MOD); const bf16* H = (const bf16*)(F.ws + WS_H); bf16* Hd = (bf16*)(F.ws + hdst_off); bf16* A1 = (bf16*)(F.ws + adst_off);
    const bf16* YS = (const bf16*)(F.ws + WS_YS); const int* ROUTE = (const int*)(F.ws + WS_ROUTE);
    (void)moe_tables(F, 0, L_.tid); const LAS int* offs = (const LAS int*)(F.lds + LDS_TAB) + 296;
    const int RPB = (T + F.G - 1) / F.G, rb0 = F.vcu * RPB < T ? F.vcu * RPB : T, re0 = rb0 + RPB < T ? rb0 + RPB : T;
    LAS float* vec = (LAS float*)(F.lds + RING_OFF);
    for (int rb = rb0; rb < re0 || rb == rb0; rb += 256) {
      const int re = rb + 256 < re0 ? rb + 256 : re0;
      const int jlo = mod_index(rb < T ? rb : T - 1), jhi = mod_index(re > rb ? re - 1 : (rb < T ? rb : T - 1));
      for (int i = L_.tid; i < 2 * 3 * 512; i += 512) { const int st = i / 1536, rem = i - st * 1536, vv = rem >> 9, k = rem & 511; const int j = st ? jhi : jlo;
        const float* src = vv == 0 ? MOD + (size_t)(0 * 9 + j) * 12288 + 5 * 2048 : MOD + (size_t)(1 * 9 + j) * 12288 + (vv - 1) * 2048;
        ((LAS f32x4*)vec)[i] = ((const f32x4*)src)[k]; }
      __syncthreads();
      for (int r0 = rb + 2 * L_.wave; r0 < re; r0 += 16) {
        const int r1 = r0 + 1; const bool ok1 = r1 < re; const int rr1 = ok1 ? r1 : r0;
        const int j0 = mod_index(r0), j1 = mod_index(rr1);
        const LAS float* s0 = vec + (j0 == jlo ? 0 : 3 * 2048); const LAS float* s1 = vec + (j1 == jlo ? 0 : 3 * 2048);
        f32x4 v0[8], v1[8], y0[8], y1[8];
        moe_combine_load(YS, ROUTE + (size_t)r0 * 8, offs, L_.lane, y0);
        moe_combine_load(YS, ROUTE + (size_t)rr1 * 8, offs, L_.lane, y1);
        hrow_load(H + (size_t)r0 * DM, L_.lane, v0);
        hrow_load(H + (size_t)rr1 * DM, L_.lane, v1);
#pragma unroll
        for (int q = 0; q < 8; ++q) { v0[q] = v0[q] + ((const LAS f32x4*)s0)[L_.lane + 64 * q] * y0[q]; v1[q] = v1[q] + ((const LAS f32x4*)s1)[L_.lane + 64 * q] * y1[q]; }
        if (j0 != 8) hrow_store(Hd + (size_t)r0 * DM, L_.lane, v0);
        modulate_store_l(v0, s0 + 2048, s0 + 4096, A1 + (size_t)r0 * DM, L_.lane);
        if (ok1) {
            if (j1 != 8) hrow_store(Hd + (size_t)r1 * DM, L_.lane, v1);
            modulate_store_l(v1, s1 + 2048, s1 + 4096, A1 + (size_t)r1 * DM, L_.lane);
        }
      }
      __syncthreads();
    }
}
__device__ __forceinline__ void p_final(const Frame& F, float* out) {
    const LocalId L_ = local_id(); (void)L_;
    const float* MOD = (const float*)(F.ws + WS_MOD); const bf16* H = (const bf16*)(F.ws + WS_H);
    const bf16* YS = (const bf16*)(F.ws + WS_YS); const int* ROUTE = (const int*)(F.ws + WS_ROUTE);
    (void)moe_tables(F, 1, L_.tid); const LAS int* offs = (const LAS int*)(F.lds + LDS_TAB) + 296;
    constexpr int NX = NB * SEQ;
    const int RPB = (NX + F.G - 1) / F.G, ib0 = F.vcu * RPB < NX ? F.vcu * RPB : NX, ie0 = ib0 + RPB < NX ? ib0 + RPB : NX;
    LAS float* vec = (LAS float*)(F.lds + RING_OFF);
    for (int ib = ib0; ib < ie0 || ib == ib0; ib += 2048) {
      const int ie = ib + 2048 < ie0 ? ib + 2048 : ie0;
      const int blo = (ib < NX ? ib : NX - 1) / SEQ, bhi = (ie > ib ? ie - 1 : (ib < NX ? ib : NX - 1)) / SEQ;
      for (int i = L_.tid; i < 2 * 512; i += 512) { const int st = i >> 9, k = i & 511; const int b = st ? bhi : blo;
        ((LAS f32x4*)vec)[i] = ((const f32x4*)(MOD + (size_t)(1 * 9 + b) * 12288 + 5 * 2048))[k]; }
      __syncthreads();
      for (int i0 = ib + 2 * L_.wave; i0 < ie; i0 += 16) {
        const int i1 = i0 + 1; const bool ok1 = i1 < ie; const int ii1 = ok1 ? i1 : i0;
        const int b0 = i0 / SEQ, row0 = b0 * TPB + CTX + (i0 - b0 * SEQ), b1 = ii1 / SEQ, row1 = b1 * TPB + CTX + (ii1 - b1 * SEQ);
        const LAS float* g0 = vec + (b0 == blo ? 0 : 2048); const LAS float* g1 = vec + (b1 == blo ? 0 : 2048);
        f32x4 y0[8], y1[8], h0[8], h1[8];
        moe_combine_load(YS, ROUTE + (size_t)row0 * 8, offs, L_.lane, y0);
        moe_combine_load(YS, ROUTE + (size_t)row1 * 8, offs, L_.lane, y1);
        hrow_load(H + (size_t)row0 * DM, L_.lane, h0);
        hrow_load(H + (size_t)row1 * DM, L_.lane, h1);
#pragma unroll
        for (int q = 0; q < 8; ++q) { const f32x4 o_ = h0[q] + ((const LAS f32x4*)g0)[L_.lane + 64 * q] * y0[q]; if (NT_OUT) NT_ST(o_, (f32x4*)(out + (size_t)i0 * DM) + L_.lane + 64 * q); else ((f32x4*)(out + (size_t)i0 * DM))[L_.lane + 64 * q] = o_; }
        if (ok1) {
#pragma unroll
            for (int q = 0; q < 8; ++q) { const f32x4 o_ = h1[q] + ((const LAS f32x4*)g1)[L_.lane + 64 * q] * y1[q]; if (NT_OUT) NT_ST(o_, (f32x4*)(out + (size_t)i1 * DM) + L_.lane + 64 * q); else ((f32x4*)(out + (size_t)i1 * DM))[L_.lane + 64 * q] = o_; } }
      }
      __syncthreads();
    }
}

__device__ __forceinline__ void head128_norm_rope(const bf16* p, bf16* pd, const float* gain, bool rope, int prow, int pcol, const float2* t128, int lane) {
    const float x0 = bf2f(p[lane]), x1 = bf2f(p[lane + 64]);
    const float ss = wave_sum(x0 * x0 + x1 * x1);
    const float r = 1.0f / sqrtf(ss * (1.0f / 128.0f) + NORM_EPS);
    float y0 = x0 * r * gain[lane], y1 = x1 * r * gain[lane + 64];
    if (rope) {
        const int f = lane & 31; const float2 cr = t128[prow * 32 + f], cc = t128[pcol * 32 + f];
        const float p0 = __shfl_xor(y0, 32), p1 = __shfl_xor(y1, 32); const float sg = (lane & 32) ? 1.0f : -1.0f;
        y0 = y0 * cr.x + sg * p0 * cr.y; y1 = y1 * cc.x + sg * p1 * cc.y;
    }
    pd[lane] = (bf16)f2bf(y0); pd[lane + 64] = (bf16)f2bf(y1);
}
__device__ __forceinline__ float rope64_apply(float y, int prow, int pcol, const float2* t64, int lane) {
    const int f = lane & 15, pos = (lane & 32) ? pcol : prow; const float2 cs = t64[pos * 16 + f];
    const float pr = __shfl_xor(y, 16); const float sg = (lane & 16) ? 1.0f : -1.0f;
    return y * cs.x + sg * pr * cs.y;
}
__device__ __forceinline__ void head64_norm_rope(const bf16* p, bf16* pd, const float* gain, bool rope, int prow, int pcol, const float2* t64, int lane) {
    const float x = bf2f(p[lane]);
    const float ss = wave_sum(x * x);
    const float r = 1.0f / sqrtf(ss * (1.0f / 64.0f) + NORM_EPS);
    float y = x * r * gain[lane];
    if (rope) y = rope64_apply(y, prow, pcol, t64, lane);
    pd[lane] = (bf16)f2bf(y);
}
__device__ __forceinline__ void norm512(const bf16* src, const float* gain, bf16* dst, int lane) {
    const v4u w = ((const v4u*)src)[lane];
    float x[8] = {bflo(w.x), bfhi(w.x), bflo(w.y), bfhi(w.y), bflo(w.z), bfhi(w.z), bflo(w.w), bfhi(w.w)};
    float ss = 0.f;
#pragma unroll
    for (int i = 0; i < 8; ++i) ss += x[i] * x[i];
    ss = wave_sum(ss);
    const float r = 1.0f / sqrtf(ss * (1.0f / 512.0f) + NORM_EPS);
    const f32x4 g0 = ((const f32x4*)gain)[2 * lane], g1 = ((const f32x4*)gain)[2 * lane + 1];
    v4u o; o.x = pk2(x[0] * r * g0.x, x[1] * r * g0.y); o.y = pk2(x[2] * r * g0.z, x[3] * r * g0.w); o.z = pk2(x[4] * r * g1.x, x[5] * r * g1.y); o.w = pk2(x[6] * r * g1.z, x[7] * r * g1.w);
    ((v4u*)dst)[lane] = o;
}

__device__ __forceinline__ void unpack8(const v4u w, float (&x)[8]) { x[0] = bflo(w.x); x[1] = bfhi(w.x); x[2] = bflo(w.y); x[3] = bfhi(w.y); x[4] = bflo(w.z); x[5] = bfhi(w.z); x[6] = bflo(w.w); x[7] = bfhi(w.w); }
__device__ __forceinline__ v4u pack8(const float (&y)[8]) { v4u o; o.x = pk2(y[0], y[1]); o.y = pk2(y[2], y[3]); o.z = pk2(y[4], y[5]); o.w = pk2(y[6], y[7]); return o; }
__device__ __forceinline__ float sumsq8(const float (&x)[8]) { return ((x[0] * x[0] + x[1] * x[1]) + (x[2] * x[2] + x[3] * x[3])) + ((x[4] * x[4] + x[5] * x[5]) + (x[6] * x[6] + x[7] * x[7])); }
template <int GS> __device__ __forceinline__ float group_sum(float v) {
    v += __shfl_xor(v, 1); v += __shfl_xor(v, 2); v += __shfl_xor(v, 4); if (GS == 16) v += __shfl_xor(v, 8); return v;
}
template <int RD> __device__ __forceinline__ void rope8(float (&y)[8], int l, int prow, int pcol, const float2* tab) {
    constexpr int NF = RD / 4, LQ = NF / 8;
    const int quarter = l / LQ, f0 = (l % LQ) * 8, pos = (quarter >= 2) ? pcol : prow;
    const float sg = (quarter & 1) ? 1.0f : -1.0f;
    const f32x4* t = (const f32x4*)(tab + pos * NF + f0);
    const f32x4 c0 = t[0], c1 = t[1], c2 = t[2], c3 = t[3];
    float p[8];
#pragma unroll
    for (int j = 0; j < 8; ++j) p[j] = __shfl_xor(y[j], LQ);
    y[0] = y[0] * c0.x + sg * p[0] * c0.y; y[1] = y[1] * c0.z + sg * p[1] * c0.w; y[2] = y[2] * c1.x + sg * p[2] * c1.y; y[3] = y[3] * c1.z + sg * p[3] * c1.w;
    y[4] = y[4] * c2.x + sg * p[4] * c2.y; y[5] = y[5] * c2.z + sg * p[5] * c2.w; y[6] = y[6] * c3.x + sg * p[6] * c3.y; y[7] = y[7] * c3.z + sg * p[7] * c3.w;
}
template <int DIM> __device__ __forceinline__ v4u head_chunk(const v4u w, const float* gain, bool rope, int prow, int pcol, const float2* tab, int lane) {
    constexpr int GS = DIM / 8; const int l = lane & (GS - 1);
    float x[8]; unpack8(w, x);
    const float ss = group_sum<GS>(sumsq8(x));
    const float r = 1.0f / sqrtf(ss * (1.0f / DIM) + NORM_EPS);
    const f32x4 g0 = ((const f32x4*)gain)[2 * l], g1 = ((const f32x4*)gain)[2 * l + 1];
    x[0] *= r * g0.x; x[1] *= r * g0.y; x[2] *= r * g0.z; x[3] *= r * g0.w; x[4] *= r * g1.x; x[5] *= r * g1.y; x[6] *= r * g1.z; x[7] *= r * g1.w;
    if (rope) rope8<DIM>(x, l, prow, pcol, tab);
    return pack8(x);
}
__device__ __forceinline__ v4u norm512_chunk(const v4u w, const float* gain, int lane) {
    float x[8]; unpack8(w, x);
    const float ss = wave_sum(sumsq8(x));
    const float r = 1.0f / sqrtf(ss * (1.0f / 512.0f) + NORM_EPS);
    const f32x4 g0 = ((const f32x4*)gain)[2 * lane], g1 = ((const f32x4*)gain)[2 * lane + 1];
    x[0] *= r * g0.x; x[1] *= r * g0.y; x[2] *= r * g0.z; x[3] *= r * g0.w; x[4] *= r * g1.x; x[5] *= r * g1.y; x[6] *= r * g1.z; x[7] *= r * g1.w;
    return pack8(x);
}

__device__ __forceinline__ void p_even_post1(const Frame& F, const Args& a, size_t ydst_off = WS_Y1) {
    const LocalId L_ = local_id(); (void)L_;
    const int gw = F.vcu * NWAVES + L_.wave, NGW = F.G * NWAVES, lane = L_.lane;
    const bf16* Y1 = (const bf16*)(F.ws + WS_Y1); bf16* CQN = (bf16*)(F.ws + WS_CQN); bf16* CKVN = (bf16*)(F.ws + WS_CKVN);
    const float2* t128 = (const float2*)(F.ws + WS_ROPE);
    for (int row = gw; row < T; row += NGW) {
        const int b = row / TPB, r = row - b * TPB; const bool xr = r >= CTX; const int s = r - CTX, prow = xr ? (s >> 6) : 0, pcol = xr ? (s & 63) : 0;
        const v4u* y = (const v4u*)(Y1 + (size_t)row * EVEN_IN_P); v4u* yd = (v4u*)((bf16*)(F.ws + ydst_off) + (size_t)row * EVEN_IN_P);
        const v4u k0 = y[128 + (lane & 31)], cq = y[192 + lane], ckv = y[256 + lane];
        const v4u ok0 = head_chunk<128>(k0, a.in[I_AKN], xr, prow, pcol, t128, lane);
        const v4u ocq = norm512_chunk(cq, a.in[I_BCQN], lane), ockv = norm512_chunk(ckv, a.in[I_BCKVN], lane);
        if (lane < 32) yd[128 + lane] = ok0;
        ((v4u*)(CQN + (size_t)row * 512))[lane] = ocq; ((v4u*)(CKVN + (size_t)row * 512))[lane] = ockv;
    }
#if KR_IN_POST1
    {
        constexpr int FPITCH = 4112;
        LAS unsigned char* Fs = F.lds + RING_OFF; LAS float* P = (LAS float*)(F.lds + RING_OFF + 16 * FPITCH + 256);
        const bf16* A1 = (const bf16*)(F.ws + WS_A1); const bf16* WK = (const bf16*)(F.ws + WS_WE_IN) + (size_t)2560 * 2048; bf16* KR = (bf16*)(F.ws + WS_LG);
        const int wave = L_.wave;
        bf16x8_t bfr[4][8];
#pragma unroll
        for (int nb = 0; nb < 4; ++nb)
#pragma unroll
            for (int ks = 0; ks < 8; ++ks) bfr[nb][ks] = *(const bf16x8_t*)(WK + (size_t)(nb * 16 + (lane & 15)) * 2048 + wave * 256 + ks * 32 + (lane >> 4) * 8);
        __syncthreads();
        for (int g = F.vcu; g < T / 16; g += F.G) {
            const int row0 = g * 16;
#pragma unroll
            for (int rr = 0; rr < 2; ++rr) { const int r = 2 * wave + rr; const v4u* src = (const v4u*)(A1 + (size_t)(row0 + r) * DM);
#pragma unroll
                for (int q = 0; q < 4; ++q) *(LAS v4u*)(Fs + r * FPITCH + (lane + 64 * q) * 16) = src[lane + 64 * q]; }
            __syncthreads();
            f32x4 acc[4];
#pragma unroll
            for (int nb = 0; nb < 4; ++nb) acc[nb] = (f32x4){0.f, 0.f, 0.f, 0.f};
#pragma unroll
            for (int ks = 0; ks < 8; ++ks) { const bf16x8_t af = *(const LAS bf16x8_t*)(Fs + (lane & 15) * FPITCH + (wave * 256 + ks * 32 + (lane >> 4) * 8) * 2);
#pragma unroll
                for (int nb = 0; nb < 4; ++nb) acc[nb] = __builtin_amdgcn_mfma_f32_16x16x32_bf16(af, bfr[nb][ks], acc[nb], 0, 0, 0); }
#pragma unroll
            for (int nb = 0; nb < 4; ++nb)
#pragma unroll
                for (int rg = 0; rg < 4; ++rg) P[(wave * 16 + 4 * (lane >> 4) + rg) * 64 + nb * 16 + (lane & 15)] = acc[nb][rg];
            __syncthreads();
#pragma unroll
            for (int o = 0; o < 2; ++o) { const int idx = L_.tid + 512 * o, r = idx >> 6, c = idx & 63; float sacc = 0.f;
#pragma unroll
                for (int w = 0; w < 8; ++w) sacc += P[(w * 16 + r) * 64 + c];
                KR[(size_t)(row0 + r) * 64 + c] = (bf16)f2bf(sacc); }
            __syncthreads();
        }
    }
#endif
}
__device__ __forceinline__ void p_even_post2(const Frame& F, const Args& a, size_t qdst_off = WS_QB, size_t kdst_off = WS_KB) {
    const LocalId L_ = local_id(); (void)L_;
    const int gw = F.vcu * NWAVES + L_.wave, NGW = F.G * NWAVES, lane = L_.lane;
    const bf16* Y1 = (const bf16*)(F.ws + WS_Y1); const bf16* QB = (const bf16*)(F.ws + WS_QB); const bf16* KV = (const bf16*)(F.ws + WS_KV);
    bf16* KB = (bf16*)(F.ws + kdst_off); bf16* QBd = (bf16*)(F.ws + qdst_off);
    const float2* t64 = (const float2*)(F.ws + WS_ROPE + 16384);
    const float* gq = a.in[I_BQN]; const float* gk = a.in[I_BKN]; const float* KRP = (const float*)(F.ws + WS_LG);
    const int l16 = lane & 15, l8 = lane & 7, hn = lane >> 4, hr = lane >> 3;
    const f32x4 gqn0 = ((const f32x4*)gq)[2 * l16], gqn1 = ((const f32x4*)gq)[2 * l16 + 1], gqr0 = ((const f32x4*)(gq + 128))[2 * l8], gqr1 = ((const f32x4*)(gq + 128))[2 * l8 + 1];
    const f32x4 gkn0 = ((const f32x4*)gk)[2 * l16], gkn1 = ((const f32x4*)gk)[2 * l16 + 1], gkr0 = ((const f32x4*)(gk + 128))[2 * l8], gkr1 = ((const f32x4*)(gk + 128))[2 * l8 + 1];
    for (int row = gw; row < T; row += NGW) {
        const int b = row / TPB, r = row - b * TPB; const bool xr = r >= CTX; const int s = r - CTX, prow = xr ? (s >> 6) : 0, pcol = xr ? (s & 63) : 0;
        const bf16* q = QB + (size_t)row * 1536; const bf16* kv = KV + (size_t)row * 2048;
        const v4u wk0 = *(const v4u*)(kv + hn * 256 + l16 * 8), wk1 = *(const v4u*)(kv + (hn + 4) * 256 + l16 * 8);
#if KR_IN_POST1
        const v4u wkr = *(const v4u*)((const bf16*)(F.ws + WS_LG) + (size_t)row * 64 + l8 * 8);
#else
        const v4u wkr = *(const v4u*)(Y1 + (size_t)row * EVEN_IN_P + 2560 + l8 * 8);
#endif
#define POST2_ONE(W0, W1, WR, GN0, GN1, GR0, GR1, DST) do { \
        float x0[8], x1[8], xr_[8]; unpack8(W0, x0); unpack8(W1, x1); unpack8(WR, xr_); \
        const float n0 = group_sum<16>(sumsq8(x0)), n1 = group_sum<16>(sumsq8(x1)), rs = group_sum<8>(sumsq8(xr_));     \
        const float rs0 = __shfl(rs, 8 * hn), rs1 = __shfl(rs, 8 * (hn + 4));                                         \
        const float t0 = __shfl(n0, 16 * (hr & 3)), t1 = __shfl(n1, 16 * (hr & 3)); const float nr = (hr >> 2) ? t1 : t0;    \
        const float r0 = 1.0f / sqrtf((n0 + rs0) * (1.0f / 192.0f) + NORM_EPS), r1 = 1.0f / sqrtf((n1 + rs1) * (1.0f / 192.0f) + NORM_EPS), rr = 1.0f / sqrtf((nr + rs) * (1.0f / 192.0f) + NORM_EPS); \
        x0[0] *= r0 * GN0.x; x0[1] *= r0 * GN0.y; x0[2] *= r0 * GN0.z; x0[3] *= r0 * GN0.w; x0[4] *= r0 * GN1.x; x0[5] *= r0 * GN1.y; x0[6] *= r0 * GN1.z; x0[7] *= r0 * GN1.w; \
        x1[0] *= r1 * GN0.x; x1[1] *= r1 * GN0.y; x1[2] *= r1 * GN0.z; x1[3] *= r1 * GN0.w; x1[4] *= r1 * GN1.x; x1[5] *= r1 * GN1.y; x1[6] *= r1 * GN1.z; x1[7] *= r1 * GN1.w; \
        xr_[0] *= rr * GR0.x; xr_[1] *= rr * GR0.y; xr_[2] *= rr * GR0.z; xr_[3] *= rr * GR0.w; xr_[4] *= rr * GR1.x; xr_[5] *= rr * GR1.y; xr_[6] *= rr * GR1.z; xr_[7] *= rr * GR1.w; \
        if (xr) rope8<64>(xr_, l8, prow, pcol, t64); \
        *(v4u*)((DST) + hn * 192 + l16 * 8) = pack8(x0); *(v4u*)((DST) + (hn + 4) * 192 + l16 * 8) = pack8(x1); *(v4u*)((DST) + hr * 192 + 128 + l8 * 8) = pack8(xr_); } while (0)
        POST2_ONE(wk0, wk1, wkr, gkn0, gkn1, gkr0, gkr1, KB + (size_t)row * 1536);
#undef POST2_ONE
    }
}
__device__ __forceinline__ void p_odd_post1(const Frame& F, const Args& a, size_t ydst_off = WS_Y1) {
    const LocalId L_ = local_id(); (void)L_;
    const int gw = F.vcu * NWAVES + L_.wave, NGW = F.G * NWAVES, lane = L_.lane;
    const bf16* Y1 = (const bf16*)(F.ws + WS_Y1);
    const float2* t128 = (const float2*)(F.ws + WS_ROPE); const float2* t64 = (const float2*)(F.ws + WS_ROPE + 16384);
    for (int row = gw; row < T; row += NGW) {
        const int b = row / TPB, r = row - b * TPB; const bool xr = r >= CTX; const int s = r - CTX, prow = xr ? (s >> 6) : 0, pcol = xr ? (s & 63) : 0;
        const v4u* y = (const v4u*)(Y1 + (size_t)row * ODD_IN); v4u* yd = (v4u*)((bf16*)(F.ws + ydst_off) + (size_t)row * ODD_IN);
        const v4u kc0 = y[128 + lane], kc1 = y[192 + lane], kd0 = y[512 + (lane & 31)];
        const v4u p0 = head_chunk<64>(kc0, a.in[I_CKN], xr, prow, pcol, t64, lane), p1 = head_chunk<64>(kc1, a.in[I_CKN], xr, prow, pcol, t64, lane);
        const v4u p2 = head_chunk<128>(kd0, a.in[I_DKN], xr, prow, pcol, t128, lane);
        yd[128 + lane] = p0; yd[192 + lane] = p1; if (lane < 32) yd[512 + lane] = p2;
    }
}

__device__ __forceinline__ void p_route(const Frame& F, const Args& a, int layer) {
    const LocalId L_ = local_id(); (void)L_;
    const float* LG = (const float*)(F.ws + WS_LG); int* ROUTE = (int*)(F.ws + WS_ROUTE);
    unsigned* cnt = (unsigned*)(F.ctl + CW_CNT + layer * 64);
    const float* brg = a.in[I_BRG] + layer * 4; const float* bre = a.in[I_BRE] + layer * 32;
    const int NT = F.G * 512;
    for (int base = F.vcu * 512 + L_.wave * 64; base < T; base += NT) {
        const int t = base + L_.lane;
        bool valid = t < T; if (valid && layer == 1) valid = (t % TPB) >= CTX;
        int e0 = -1, e1 = -1; float w0 = 0.f, w1 = 0.f;
        if (valid) {
            const float* lg = LG + (size_t)t * 64;
            float g[4]; for (int i = 0; i < 4; ++i) { float v = brg[i]; for (int ks = 0; ks < RKS; ++ks) v += lg[(size_t)ks * T * 64 + i]; g[i] = v; }
            int gi = 0; float gm = g[0]; for (int i = 1; i < 4; ++i) if (g[i] > gm) { gm = g[i]; gi = i; }
            float den = 0.f; for (int i = 0; i < 4; ++i) den += expf(g[i] - gm);
            const float ptop = 1.0f / den;
            float el[8]; for (int i = 0; i < 8; ++i) { float v = bre[gi * 8 + i]; for (int ks = 0; ks < RKS; ++ks) v += lg[(size_t)ks * T * 64 + 4 + gi * 8 + i]; el[i] = v; }
            int i1 = 0; float l1 = el[0]; for (int i = 1; i < 8; ++i) if (el[i] > l1) { l1 = el[i]; i1 = i; }
            int i2 = -1; float l2 = -3.0e38f; for (int i = 0; i < 8; ++i) if (i != i1 && el[i] > l2) { l2 = el[i]; i2 = i; }
            const float ex = expf(l2 - l1), inv = 1.0f / (1.0f + ex);
            w0 = ptop * inv; w1 = ptop * ex * inv; e0 = gi * 8 + i1; e1 = gi * 8 + i2;
        }
        int pos0 = 0, pos1 = 0;
        const unsigned long long lt = (1ull << L_.lane) - 1ull;
        for (int e = 0; e < NE; ++e) {
            const unsigned long long m0 = __ballot(e0 == e), m1 = __ballot(e1 == e);
            const int n0 = __popcll(m0), n1 = __popcll(m1);
            if (n0 + n1 == 0) continue;
            unsigned basev = 0;
            if (L_.lane == 0) basev = __hip_atomic_fetch_add(cnt + e, (unsigned)(n0 + n1), RLX_AGENT);
            basev = (unsigned)__builtin_amdgcn_readfirstlane((int)basev);
            if (e0 == e) pos0 = (int)basev + __popcll(m0 & lt);
            if (e1 == e) pos1 = (int)basev + n0 + __popcll(m1 & lt);
        }
        if (valid) { int* rec = ROUTE + (size_t)t * 8; rec[0] = e0; rec[1] = e1; rec[2] = pos0; rec[3] = pos1; rec[4] = __builtin_bit_cast(int, w0); rec[5] = __builtin_bit_cast(int, w1); }
    }
}
__device__ __forceinline__ void p_mod2_route(const Frame& F, const Args& a, int layer) {
    const LocalId L_ = local_id(); (void)L_;
    const int lane = L_.lane, wave = L_.wave;
    constexpr int FPITCH = 4112;
    LAS unsigned char* Fs = F.lds + RING_OFF; LAS float* P = (LAS float*)(F.lds + RING_OFF + 16 * FPITCH + 256);
    const float* MOD = (const float*)(F.ws + WS_MOD); const bf16* H = (const bf16*)(F.ws + WS_H); bf16* A1 = (bf16*)(F.ws + WS_A1);
    const bf16* WR = (const bf16*)(F.ws + WS_WR) + (size_t)layer * 256 * 2048;
    int* ROUTE = (int*)(F.ws + WS_ROUTE); unsigned* cnt = (unsigned*)(F.ctl + CW_CNT + layer * 64); int* postok = (int*)(F.ws + WS_POS) + (size_t)layer * NE * POSCAP;
    const float* brg = a.in[I_BRG] + layer * 4; const float* bre = a.in[I_BRE] + layer * 32;
    bf16x8_t bfr[3][8];
#pragma unroll
    for (int nb = 0; nb < 3; ++nb)
#pragma unroll
        for (int ks = 0; ks < 8; ++ks) bfr[nb][ks] = *(const bf16x8_t*)(WR + (size_t)(nb * 16 + (lane & 15)) * 2048 + wave * 256 + ks * 32 + (lane >> 4) * 8);
    const int NG = layer == 1 ? NB * SEQ / 16 : T / 16;
    int it = 0;
    for (int g = F.vcu; g < NG; g += F.G, ++it) {
        int row0; if (layer == 1) { const int b = g >> 7; row0 = b * TPB + CTX + (g & 127) * 16; } else row0 = g * 16;
        const int j = mod_index(row0);
        const float* m = MOD + (size_t)(layer * 9 + j) * 12288;
        f32x4 v0[8], v1[8];
        const int r0 = 2 * wave, r1 = r0 + 1;
        hrow_load(H + (size_t)(row0 + r0) * DM, lane, v0);
        hrow_load(H + (size_t)(row0 + r1) * DM, lane, v1);
#define M2R_ROW(V, R) do { float ss = 0.f; \
        _Pragma("unroll") for (int q = 0; q < 8; ++q) ss += (V[q].x * V[q].x + V[q].y * V[q].y) + (V[q].z * V[q].z + V[q].w * V[q].w); \
        ss = wave_sum(ss); const float rn = 1.0f / sqrtf(ss * (1.0f / 2048.0f) + NORM_EPS); \
        _Pragma("unroll") for (int q = 0; q < 8; ++q) { const f32x4 sh = ((const f32x4*)(m + 3 * 2048))[lane + 64 * q], sc = ((const f32x4*)(m + 4 * 2048))[lane + 64 * q]; \
            const f32x4 y = V[q] * rn * (sc + 1.0f) + sh; v2u o; o.x = pk2(y.x, y.y); o.y = pk2(y.z, y.w); \
            ((v2u*)(A1 + (size_t)(row0 + (R)) * DM))[lane + 64 * q] = o; *(LAS v2u*)(Fs + (R) * FPITCH + (lane + 64 * q) * 8) = o; } } while (0)
        M2R_ROW(v0, r0); M2R_ROW(v1, r1);
#undef M2R_ROW
        __syncthreads();
        f32x4 acc[3];
#pragma unroll
        for (int nb = 0; nb < 3; ++nb) acc[nb] = (f32x4){0.f, 0.f, 0.f, 0.f};
#pragma unroll
        for (int ks = 0; ks < 8; ++ks) { const bf16x8_t af = *(const LAS bf16x8_t*)(Fs + (lane & 15) * FPITCH + (wave * 256 + ks * 32 + (lane >> 4) * 8) * 2);
#pragma unroll
            for (int nb = 0; nb < 3; ++nb) acc[nb] = __builtin_amdgcn_mfma_f32_16x16x32_bf16(af, bfr[nb][ks], acc[nb], 0, 0, 0); }
        LAS float* Pb = P + (it & 1) * (8 * 16 * 48);
#pragma unroll
        for (int nb = 0; nb < 3; ++nb)
#pragma unroll
            for (int rg = 0; rg < 4; ++rg) Pb[(wave * 16 + 4 * (lane >> 4) + rg) * 48 + nb * 16 + (lane & 15)] = acc[nb][rg];
        __syncthreads();
        if (wave == 0) {
            const bool valid = lane < 16; const int t = row0 + (lane & 15);
            int e0 = -1, e1 = -1; float w0 = 0.f, w1 = 0.f;
            if (valid) {
                const LAS float* pr = Pb + lane * 48;
                float gg[4];
#pragma unroll
                for (int i = 0; i < 4; ++i) { float sacc = brg[i];
#pragma unroll
                    for (int w = 0; w < 8; ++w) sacc += pr[w * 768 + i];
                    gg[i] = sacc; }
                int gi = 0; float gm = gg[0];
#pragma unroll
                for (int i = 1; i < 4; ++i) if (gg[i] > gm) { gm = gg[i]; gi = i; }
                float den = 0.f;
#pragma unroll
                for (int i = 0; i < 4; ++i) den += expf(gg[i] - gm);
                const float ptop = 1.0f / den;
                float el[8];
#pragma unroll
                for (int i = 0; i < 8; ++i) { float sacc = bre[gi * 8 + i];
#pragma unroll
                    for (int w = 0; w < 8; ++w) sacc += pr[w * 768 + 4 + gi * 8 + i];
                    el[i] = sacc; }
                int i1 = 0; float l1 = el[0];
#pragma unroll
                for (int i = 1; i < 8; ++i) if (el[i] > l1) { l1 = el[i]; i1 = i; }
                int i2 = -1; float l2 = -3.0e38f;
#pragma unroll
                for (int i = 0; i < 8; ++i) if (i != i1 && el[i] > l2) { l2 = el[i]; i2 = i; }
                const float ex = expf(l2 - l1), inv = 1.0f / (1.0f + ex);
                w0 = ptop * inv; w1 = ptop * ex * inv; e0 = gi * 8 + i1; e1 = gi * 8 + i2;
            }
            int rank0 = 0, rank1 = 0, mycnt = 0;
            const unsigned long long lt = (1ull << lane) - 1ull;
            for (int e = 0; e < NE; ++e) {
                const unsigned long long m0 = __ballot(e0 == e), m1 = __ballot(e1 == e);
                const int n0 = __popcll(m0), n1 = __popcll(m1);
                if (lane == e) mycnt = n0 + n1;
                if (e0 == e) rank0 = __popcll(m0 & lt);
                if (e1 == e) rank1 = n0 + __popcll(m1 & lt);
            }
            int basev = 0;
            if (lane < NE && mycnt > 0) basev = (int)__hip_atomic_fetch_add(cnt + lane, (unsigned)mycnt, RLX_AGENT);
            const int pos0 = __shfl(basev, e0 & 31) + rank0, pos1 = __shfl(basev, e1 & 31) + rank1;
            if (valid) { int* rec = ROUTE + (size_t)t * 8; rec[0] = e0; rec[1] = e1; rec[2] = pos0; rec[3] = pos1; rec[4] = __builtin_bit_cast(int, w0); rec[5] = __builtin_bit_cast(int, w1);
                         postok[(size_t)e0 * POSCAP + pos0] = t; postok[(size_t)e1 * POSCAP + pos1] = t; }
        }
    }
    __syncthreads();
}
__device__ __forceinline__ void p_gather(const Frame& F, int layer) {
    const LocalId L_ = local_id(); (void)L_;
    LAS int* offs = (LAS int*)(F.lds + RING_OFF);
    if (L_.tid == 0) { int o = 0; for (int e = 0; e < NE; ++e) { offs[e] = o; const unsigned c = __hip_atomic_load((unsigned*)(F.ctl + CW_CNT + layer * 64 + e), RLX_AGENT); o += (int)((c + 255u) & ~255u); } offs[NE] = o; }
    __syncthreads();
    if (blockIdx.x == 0 && L_.tid < NE) { const int e = L_.tid; int* texp = (int*)(F.ctl + CW_TEXP + layer * 256);
        for (int r = offs[e] >> 8; r < (offs[e + 1] >> 8); ++r) texp[r] = e;
        if (e == 0) *(int*)(F.ctl + CW_NRT + layer * 64) = offs[NE] >> 8; }
    int* ROUTE = (int*)(F.ws + WS_ROUTE); int* slot_tok = (int*)(F.ctl + CW_SLOT + layer * MAXSLOT);
    for (int t = F.vcu * 512 + L_.tid; t < T; t += F.G * 512) {
        if (layer == 1 && (t % TPB) < CTX) continue;
        int* rec = ROUTE + (size_t)t * 8;
        const int s0 = offs[rec[0]] + rec[2], s1 = offs[rec[1]] + rec[3];
        slot_tok[s0] = t; slot_tok[s1] = t; rec[6] = s0; rec[7] = s1;
    }
    __syncthreads();
}

constexpr int SLD = 2304;
template <int DQ, int QR>
__device__ __forceinline__ void naive_scores_softmax(LAS float* S, LAS float* qf, const bf16* Q, int ldq, const bf16* K, int ldk, int lo, int nk, float scale,
                                                     bool window, int qpos0, bool has_sink, float sink, int tid, int lane, int wave) {
    for (int i = tid; i < QR * DQ; i += 512) { const int r = i / DQ, d = i - r * DQ; qf[i] = bf2f(Q[(size_t)r * ldq + d]); }
    __syncthreads();
    for (int t = tid; t < nk; t += 512) {
        const int kr = t < CTX ? t : CTX + lo + (t - CTX);
        const bf16* kp = K + (size_t)kr * ldk;
        float acc[QR];
#pragma unroll
        for (int r = 0; r < QR; ++r) acc[r] = 0.f;
        for (int d = 0; d < DQ; d += 8) {
            const v4u kv = *(const v4u*)(kp + d);
            const float k0 = bflo(kv.x), k1 = bfhi(kv.x), k2 = bflo(kv.y), k3 = bfhi(kv.y), k4 = bflo(kv.z), k5 = bfhi(kv.z), k6 = bflo(kv.w), k7 = bfhi(kv.w);
#pragma unroll
            for (int r = 0; r < QR; ++r) { const LAS float* qp = qf + r * DQ + d;
                acc[r] += (k0 * qp[0] + k1 * qp[1]) + (k2 * qp[2] + k3 * qp[3]) + (k4 * qp[4] + k5 * qp[5]) + (k6 * qp[6] + k7 * qp[7]); }
        }
#pragma unroll
        for (int r = 0; r < QR; ++r) { float s = acc[r] * scale;
            if (window && t >= CTX) { const int dd = (qpos0 + r) - (lo + t - CTX); if (dd > 128 || dd < -128) s = -1e30f; }
            S[r * SLD + t] = s; }
    }
    __syncthreads();
    if (wave < QR) {
        LAS float* row = S + wave * SLD;
        float m = -1e30f; for (int t = lane; t < nk; t += 64) m = fmaxf(m, row[t]);
        m = wave_max(m); if (has_sink) m = fmaxf(m, sink);
        float sum = 0.f; for (int t = lane; t < nk; t += 64) { const float e = expf(row[t] - m); row[t] = e; sum += e; }
        sum = wave_sum(sum); if (has_sink) sum += expf(sink - m);
        const float inv = 1.0f / sum;
        for (int t = lane; t < nk; t += 64) row[t] *= inv;
    }
    __syncthreads();
}
template <int QR>
__device__ __forceinline__ void naive_pv(const LAS float* S, const bf16* V, int ldv, int lo, int nk, int tid, float (&o)[QR / 4]) {
    const int c = tid & 127, rg = tid >> 7; constexpr int RPT = QR / 4;
#pragma unroll
    for (int i = 0; i < RPT; ++i) o[i] = 0.f;
#pragma unroll 4
    for (int t = 0; t < nk; ++t) { const int kr = t < CTX ? t : CTX + lo + (t - CTX); const float v = bf2f(V[(size_t)kr * ldv + c]);
#pragma unroll
        for (int i = 0; i < RPT; ++i) o[i] += S[(rg * RPT + i) * SLD + t] * v; }
}
__device__ __forceinline__ void p_even_attn_naive(const Frame& F) {
    const LocalId L_ = local_id(); (void)L_;
    LAS float* S = (LAS float*)(F.lds + RING_OFF); LAS float* qf = (LAS float*)(F.lds + RING_OFF + 8 * SLD * 4);
    const bf16* Y1 = (const bf16*)(F.ws + WS_Y1); const bf16* QB = (const bf16*)(F.ws + WS_QB); const bf16* KV = (const bf16*)(F.ws + WS_KV); const bf16* KB = (const bf16*)(F.ws + WS_KB);
    bf16* MIX = (bf16*)(F.ws + WS_MIX);
    constexpr int UPV = NB * 8 * 288;
    for (int u = blockIdx.x; u < 2 * UPV; u += F.G) {
        const int var = u / UPV, rem = u - var * UPV, b = rem / 2304, rem2 = rem - b * 2304, h = rem2 / 288, ch = rem2 - h * 288;
        const int r0 = ch * 8, row0 = b * TPB + r0; const int nk = r0 < CTX ? CTX : TPB;
        float o[2];
        if (var == 0) {
            naive_scores_softmax<128, 8>(S, qf, Y1 + (size_t)row0 * EVEN_IN_P + h * 128, EVEN_IN_P, Y1 + (size_t)(b * TPB) * EVEN_IN_P + 1024 + (h >> 2) * 128, EVEN_IN_P, 0, nk,
                                         0.08838834764831845f, false, 0, false, 0.f, L_.tid, L_.lane, L_.wave);
            naive_pv<8>(S, Y1 + (size_t)(b * TPB) * EVEN_IN_P + 1280 + (h >> 2) * 128, EVEN_IN_P, 0, nk, L_.tid, o);
        } else {
            naive_scores_softmax<192, 8>(S, qf, QB + (size_t)row0 * 1536 + h * 192, 1536, KB + (size_t)(b * TPB) * 1536 + h * 192, 1536, 0, nk,
                                         0.07216878364870322f, false, 0, false, 0.f, L_.tid, L_.lane, L_.wave);
            naive_pv<8>(S, KV + (size_t)(b * TPB) * 2048 + h * 256 + 128, 2048, 0, nk, L_.tid, o);
        }
        const int c = L_.tid & 127, rg = L_.tid >> 7;
#pragma unroll
        for (int i = 0; i < 2; ++i) MIX[(size_t)(row0 + rg * 2 + i) * DM + var * 1024 + h * 128 + c] = (bf16)f2bf(o[i]);
        __syncthreads();
    }
}
__device__ __forceinline__ void p_odd_attn_naive(const Frame& F, const Args& a) {
    const LocalId L_ = local_id(); (void)L_;
    LAS float* S = (LAS float*)(F.lds + RING_OFF); LAS float* qf = (LAS float*)(F.lds + RING_OFF + 8 * SLD * 4); LAS float* ob = qf + 8 * 192;
    const bf16* Y1 = (const bf16*)(F.ws + WS_Y1); bf16* MIX = (bf16*)(F.ws + WS_MIX);
    float d1 = 0.f, d2 = 0.f;
    for (int i = 0; i < 64; ++i) { d1 += a.in[I_LQ1][i] * a.in[I_LK1][i]; d2 += a.in[I_LQ2][i] * a.in[I_LK2][i]; }
    const float lam = expf(d1) - expf(d2) + LAMBDA_INIT;
    constexpr int UC = NB * 8 * 512, UD = NB * 8 * 256;
    for (int u = blockIdx.x; u < UC + UD; u += F.G) {
        const int c = L_.tid & 127, rg = L_.tid >> 7;
        if (u < UC) {
            const int b = u / 4096, rem = u - b * 4096, h = rem / 512, ch = rem - h * 512;
            const int r0 = CTX + ch * 4, row0 = b * TPB + r0; const int nk = TPB;
            const bf16* kb = Y1 + (size_t)(b * TPB) * ODD_IN;
            naive_scores_softmax<64, 4>(S, qf, Y1 + (size_t)row0 * ODD_IN + (2 * h) * 64, ODD_IN, kb + 1024 + (2 * h) * 64, ODD_IN, 0, nk, 0.125f, false, 0, false, 0.f, L_.tid, L_.lane, L_.wave);
            naive_scores_softmax<64, 4>(S + 4 * SLD, qf, Y1 + (size_t)row0 * ODD_IN + (2 * h + 1) * 64, ODD_IN, kb + 1024 + (2 * h + 1) * 64, ODD_IN, 0, nk, 0.125f, false, 0, false, 0.f, L_.tid, L_.lane, L_.wave);
            for (int i = L_.tid; i < 4 * SLD; i += 512) S[i] = S[i] - lam * S[4 * SLD + i];
            __syncthreads();
            float o[1];
            naive_pv<4>(S, kb + 2048 + h * 128, ODD_IN, 0, nk, L_.tid, o);
            ob[rg * 128 + c] = o[0];
            __syncthreads();
            float ss = 0.f; for (int i = 0; i < 128; ++i) { const float v = ob[rg * 128 + i]; ss += v * v; }
            const float r = 1.0f / sqrtf(ss * (1.0f / 128.0f) + NORM_EPS);
            MIX[(size_t)(row0 + rg) * DM + h * 128 + c] = (bf16)f2bf(o[0] * r * a.in[I_SUBLN][c] * (1.0f - LAMBDA_INIT));
        } else {
            const int v = u - UC, b = v / 2048, rem = v - b * 2048, h = rem / 256, ch = rem - h * 256;
            const int s0 = ch * 8, row0 = b * TPB + CTX + s0;
            const int lo = s0 - 128 < 0 ? 0 : s0 - 128, hi = s0 + 7 + 128 > SEQ - 1 ? SEQ - 1 : s0 + 7 + 128; const int nk = CTX + (hi - lo + 1);
            const bf16* kb = Y1 + (size_t)(b * TPB) * ODD_IN;
            naive_scores_softmax<128, 8>(S, qf, Y1 + (size_t)row0 * ODD_IN + 3072 + h * 128, ODD_IN, kb + 4096 + (h >> 2) * 128, ODD_IN, lo, nk, 0.08838834764831845f, true, s0, true, a.in[I_SINK][h], L_.tid, L_.lane, L_.wave);
            float o[2];
            naive_pv<8>(S, kb + 4352 + (h >> 2) * 128, ODD_IN, lo, nk, L_.tid, o);
#pragma unroll
            for (int i = 0; i < 2; ++i) MIX[(size_t)(row0 + rg * 2 + i) * DM + 1024 + h * 128 + c] = (bf16)f2bf(o[i]);
        }
        __syncthreads();
    }
}

namespace att {
using bf16x8 = __attribute__((ext_vector_type(8))) short;
using s16x4  = __attribute__((ext_vector_type(4))) short;
using f32x16 = __attribute__((ext_vector_type(16))) float;
using u32x4  = __attribute__((ext_vector_type(4))) unsigned;
using f32x2  = __attribute__((ext_vector_type(2))) float;
#ifndef ATT_EARLY_KV
#define ATT_EARLY_KV 1
#endif
#ifndef ATT_EARLY_OK
#define ATT_EARLY_OK(DQ, QMODE, DIFF, WINDOW) ((DQ) <= 128)
#endif
#ifndef ATT_PK_SM
#define ATT_PK_SM 1
#endif
constexpr int KVBLK = 64, QBLK = 32;
constexpr int SHM_V = KVBLK * 128 * 2;
constexpr int K_OFF = 2 * SHM_V, K_MAX = KVBLK * 192 * 2, QL_OFF = K_OFF + 2 * K_MAX, WS_OFF = 131072 + 2048;
constexpr float THR = 8.f;
#define ATT_KSWZ(row, colB, RB) ((row) * (RB) + ((colB) ^ (((row) & 7) << 4)))
#define ATT_SBAR() __builtin_amdgcn_sched_barrier(0)
__device__ __forceinline__ int crow(int r, int hi) { return (r & 3) + 8 * (r >> 2) + 4 * hi; }
__device__ __forceinline__ unsigned cvtpk(float lo, float hi) { unsigned r; asm volatile("v_cvt_pk_bf16_f32 %0, %1, %2" : "=v"(r) : "v"(lo), "v"(hi)); return r; }

__device__ __forceinline__ void partialSM(f32x16& p0, f32x16& p1, float& m_reg, float& mn, float& alpha, float C, float thr_raw) {
  float pmax = p0[0];
#pragma unroll
  for (int r = 1; r < 16; ++r) pmax = fmaxf(pmax, p0[r]);
#pragma unroll
  for (int r = 0; r < 16; ++r) pmax = fmaxf(pmax, p1[r]);
  { auto rr = __builtin_amdgcn_permlane32_swap(__float_as_uint(pmax), __float_as_uint(pmax), false, false);
    pmax = fmaxf(__uint_as_float(rr[0]), __uint_as_float(rr[1])); }
  if (__builtin_expect(__all(pmax - m_reg <= thr_raw), 1)) { mn = m_reg; alpha = 1.f; }
  else { mn = fmaxf(m_reg, pmax); alpha = __builtin_amdgcn_exp2f((m_reg - mn) * C); m_reg = mn; }
  const float mnC = -mn * C;
#if ATT_PK_SM
  { const f32x2 C2 = {C, C}, M2 = {mnC, mnC};
#pragma unroll
    for (int r = 0; r < 16; r += 2) { f32x2 t = {p0[r], p0[r + 1]}; t = __builtin_elementwise_fma(t, C2, M2); p0[r] = t.x; p0[r + 1] = t.y; }
#pragma unroll
    for (int r = 0; r < 16; r += 2) { f32x2 t = {p1[r], p1[r + 1]}; t = __builtin_elementwise_fma(t, C2, M2); p1[r] = t.x; p1[r + 1] = t.y; } }
#else
#pragma unroll
  for (int r = 0; r < 16; ++r) p0[r] = fmaf(p0[r], C, mnC);
#pragma unroll
  for (int r = 0; r < 16; ++r) p1[r] = fmaf(p1[r], C, mnC);
#endif
#pragma unroll
  for (int r = 0; r < 16; ++r) p0[r] = __builtin_amdgcn_exp2f(p0[r]);
}
__device__ __forceinline__ void finishSM(f32x16& p0, f32x16& p1, float alpha, float& l_reg, bf16x8& pa0, bf16x8& pa1, bf16x8& pa2, bf16x8& pa3) {
#pragma unroll
  for (int r = 0; r < 16; ++r) p1[r] = __builtin_amdgcn_exp2f(p1[r]);
#if ATT_PK_SM
  f32x2 ps2 = {p0[0], p0[1]};
#pragma unroll
  for (int r = 2; r < 16; r += 2) ps2 += (f32x2){p0[r], p0[r + 1]};
#pragma unroll
  for (int r = 0; r < 16; r += 2) ps2 += (f32x2){p1[r], p1[r + 1]};
  float ps = ps2.x + ps2.y;
#else
  float ps = 0;
#pragma unroll
  for (int r = 0; r < 16; ++r) ps += p0[r];
#pragma unroll
  for (int r = 0; r < 16; ++r) ps += p1[r];
#endif
  { auto rr = __builtin_amdgcn_permlane32_swap(__float_as_uint(ps), __float_as_uint(ps), false, false);
    ps = __uint_as_float(rr[0]) + __uint_as_float(rr[1]); }
  l_reg = l_reg * alpha + ps;
#define ATT_PK4(P, BASE, OUT) do { unsigned a0 = cvtpk(P[BASE + 0], P[BASE + 1]), a1 = cvtpk(P[BASE + 2], P[BASE + 3]);   \
    unsigned b0 = cvtpk(P[BASE + 4], P[BASE + 5]), b1 = cvtpk(P[BASE + 6], P[BASE + 7]);                              \
    auto r0 = __builtin_amdgcn_permlane32_swap(a0, b0, false, false); auto r1 = __builtin_amdgcn_permlane32_swap(a1, b1, false, false); \
    u32x4 w = {r0[0], r1[0], r0[1], r1[1]}; OUT = *reinterpret_cast<bf16x8*>(&w); } while (0)
  ATT_PK4(p0, 0, pa0); ATT_PK4(p0, 8, pa1); ATT_PK4(p1, 0, pa2); ATT_PK4(p1, 8, pa3);
#undef ATT_PK4
}
template <int DQ, int NQT, int NQR, int QSB>
__device__ __forceinline__ void qkt(f32x16& p0, f32x16& p1, const char* Ks, const bf16x8 (&qr)[NQR], const char* qlds, const int (&kb)[4]) {
  p0 = f32x16{}; p1 = f32x16{};
#pragma unroll
  for (int d0 = 0; d0 < NQT; ++d0) {
    const bf16x8 b0 = *reinterpret_cast<const bf16x8*>(Ks + kb[d0 & 3] + (d0 >> 2) * 128);
    const bf16x8 b1 = *reinterpret_cast<const bf16x8*>(Ks + kb[d0 & 3] + (d0 >> 2) * 128 + 32 * DQ * 2);
    bf16x8 q; if (d0 < NQR) q = qr[d0 < NQR ? d0 : 0]; else q = *reinterpret_cast<const bf16x8*>(qlds + (d0 - NQR) * 1024);
    p0 = __builtin_amdgcn_mfma_f32_32x32x16_bf16(b0, q, p0, 0, 0, 0);
    p1 = __builtin_amdgcn_mfma_f32_32x32x16_bf16(b1, q, p1, 0, 0, 0);
    if (QSB > 0 && (d0 % (QSB > 0 ? QSB : 1)) == (QSB - 1) && d0 + 1 < NQT) ATT_SBAR(); }
}
__device__ __forceinline__ void mask_tile(f32x16& p0, f32x16& p1, int kp0, int qpos, int hi) {
#pragma unroll
  for (int r = 0; r < 16; ++r) { const int d = qpos - (kp0 + crow(r, hi));
    if (d > 128 || d < -128) p0[r] = -1e30f;
    if (d - 32 > 128 || d - 32 < -128) p1[r] = -1e30f; }
}
__device__ __forceinline__ int v_st(int k, int c) { const int kk = (k & ~0xC) | ((k & 4) << 1) | ((k & 8) >> 1); return ((kk >> 3) * 4 + (c >> 5)) * 512 + ((kk & 7) * 32 + (c & 31)) * 2; }
__device__ __forceinline__ int v_rd_base(int lane) { return ((lane & 3) << 3) | (((lane >> 2) & 3) << 6) | (((lane >> 4) & 1) << 5) | (((lane >> 5) & 1) << 8); }
constexpr int v_rd_off(int d0, int ks, int half) { return d0 * 512 + ks * 4096 + half * 2048; }
template <int OFF> __device__ __forceinline__ s16x4 tr_read(int vb) {
  s16x4 r; asm volatile("ds_read_b64_tr_b16 %0, %1 offset:%2" : "=&v"(r) : "v"(vb), "i"(OFF) : "memory"); return r;
}
template <int D0> __device__ __forceinline__ void pv_one(f32x16& od, int vb, bf16x8 pa0, bf16x8 pa1, bf16x8 pa2, bf16x8 pa3) {
  const s16x4 l0 = tr_read<v_rd_off(D0, 0, 0)>(vb), h0 = tr_read<v_rd_off(D0, 0, 1)>(vb), l1 = tr_read<v_rd_off(D0, 1, 0)>(vb), h1 = tr_read<v_rd_off(D0, 1, 1)>(vb);
  const s16x4 l2 = tr_read<v_rd_off(D0, 2, 0)>(vb), h2 = tr_read<v_rd_off(D0, 2, 1)>(vb), l3 = tr_read<v_rd_off(D0, 3, 0)>(vb), h3 = tr_read<v_rd_off(D0, 3, 1)>(vb);
  asm volatile("s_waitcnt lgkmcnt(0)" ::: "memory"); ATT_SBAR();
#define ATT_PK(L, H) (bf16x8){L[0], L[1], L[2], L[3], H[0], H[1], H[2], H[3]}
  od = __builtin_amdgcn_mfma_f32_32x32x16_bf16(pa0, ATT_PK(l0, h0), od, 0, 0, 0);
  od = __builtin_amdgcn_mfma_f32_32x32x16_bf16(pa1, ATT_PK(l1, h1), od, 0, 0, 0);
  od = __builtin_amdgcn_mfma_f32_32x32x16_bf16(pa2, ATT_PK(l2, h2), od, 0, 0, 0);
  od = __builtin_amdgcn_mfma_f32_32x32x16_bf16(pa3, ATT_PK(l3, h3), od, 0, 0, 0);
#undef ATT_PK
}
__device__ __forceinline__ void pv_d0(f32x16* o, int vb, bf16x8 pa0, bf16x8 pa1, bf16x8 pa2, bf16x8 pa3) {
  pv_one<0>(o[0], vb, pa0, pa1, pa2, pa3); pv_one<1>(o[1], vb, pa0, pa1, pa2, pa3); pv_one<2>(o[2], vb, pa0, pa1, pa2, pa3); pv_one<3>(o[3], vb, pa0, pa1, pa2, pa3);
}

template <int M> __device__ __forceinline__ float swz_xor(float v) { return __builtin_bit_cast(float, __builtin_amdgcn_ds_swizzle(__builtin_bit_cast(int, v), (M << 10) | 0x1F)); }
__device__ __forceinline__ float sum_xor32(float v) { auto rr = __builtin_amdgcn_permlane32_swap(__float_as_uint(v), __float_as_uint(v), false, false); return __uint_as_float(rr[0]) + __uint_as_float(rr[1]); }
__device__ __forceinline__ float bfx(short v) { return __builtin_bit_cast(float, ((unsigned)(unsigned short)v) << 16); }
template <int MODE, int NQ>
__device__ __forceinline__ void q_fix(bf16x8 (&q)[NQ], const float* gain, const float* tab  , int pos, int hi) {
  constexpr int DIM = NQ * 16;
  float x[NQ][8]; float ss = 0.f;
#pragma unroll
  for (int d0 = 0; d0 < NQ; ++d0)
#pragma unroll
    for (int j = 0; j < 8; ++j) { x[d0][j] = bfx(q[d0][j]); ss += x[d0][j] * x[d0][j]; }
  ss = sum_xor32(ss);
  const float r = 1.0f / sqrtf(ss * (1.0f / DIM) + 1e-6f);
#pragma unroll
  for (int d0 = 0; d0 < NQ; ++d0) { const float* g = gain + d0 * 16 + hi * 8;
#pragma unroll
    for (int j = 0; j < 8; ++j) x[d0][j] *= r * g[j]; }
  if (pos >= 0) {
    const int prow = pos >> 6, pcol = pos & 63;
    constexpr int RB0 = (MODE == 2) ? 8 : 0, NRB = (MODE == 1) ? 8 : 4, NF = (MODE == 1) ? 32 : 16, PX = (MODE == 1) ? 2 : 1;
    float y[NRB][8];
#pragma unroll
    for (int b = 0; b < NRB; ++b) { const int p = (b < NRB / 2) ? prow : pcol; const int f0 = (MODE == 1 ? (b & 1) * 16 : 0) + hi * 8; const float sg = (b & PX) ? 1.0f : -1.0f;
      const float* t = tab + (size_t)(p * NF + f0) * 2;
#pragma unroll
      for (int j = 0; j < 8; ++j) y[b][j] = x[RB0 + b][j] * t[2 * j] + sg * x[RB0 + (b ^ PX)][j] * t[2 * j + 1]; }
#pragma unroll
    for (int b = 0; b < NRB; ++b)
#pragma unroll
      for (int j = 0; j < 8; ++j) x[RB0 + b][j] = y[b][j];
  }
#pragma unroll
  for (int d0 = 0; d0 < NQ; ++d0) { u32x4 w; w.x = cvtpk(x[d0][0], x[d0][1]); w.y = cvtpk(x[d0][2], x[d0][3]); w.z = cvtpk(x[d0][4], x[d0][5]); w.w = cvtpk(x[d0][6], x[d0][7]); q[d0] = *reinterpret_cast<bf16x8*>(&w); }
}

template <int DQ, bool WINDOW, bool SINK, int LDQ, int LDK, int LDV, int SD, int QSB, int NQRMAX, bool DIFF = false, int QMODE = 0>
__device__ __forceinline__ void attn_unit(const bf16* __restrict__ Qb, const bf16* __restrict__ Kb, const bf16* __restrict__ Vb,
                                          bf16* __restrict__ Ob, int ntiles, int band_lo, int qpos0, float scale, float sink, char* lds, const float* gainp = nullptr,
                                          const float* qgain = nullptr, const float* qtab = nullptr, int qs0 = -1, int wv = 0) {
  constexpr int NQ = (DIFF ? DQ / 2 : DQ) / 16, NQR = NQ > NQRMAX ? NQRMAX : NQ, NCH = DQ / 64, RB = DQ * 2, SHM_K = KVBLK * DQ * 2, LDO = 2048;
  int tid = wv * 64 + lane_id_(); asm volatile("" : "+v"(tid));
  const int wid = tid >> 6, lane = tid & 63, r32 = lane & 31, hi = lane >> 5;
  const int comp = DIFF ? (wid >> 2) : 0, wrow = DIFF ? (wid & 3) : wid, kcomp = comp * 128;
  char* V_lds = lds; char* K_lds = lds + K_OFF;
  float* ws = (float*)(lds + WS_OFF) + wid * 64; float* li_l = ws; float* al_l = ws + 32;
  const float C = scale * 1.4426950408889634f, thr_raw = THR / scale;
  float m_reg = -1e30f, l_reg = 0; f32x16 o[4] = {}; bf16x8 qr[NQR];
  const unsigned qoff = (unsigned)((wrow * QBLK + r32) * LDQ + hi * 8 + comp * 64) * 2u;
  char* qlds = lds + QL_OFF + wid * ((NQ - NQR) * 1024) + lane * 16;
  const int sr = tid >> 4, sc = (tid & 15) * 8, vst0 = v_st(sr, sc);
  const unsigned voV = (unsigned)(sr * LDV + sc) * 2u;
  const int kr_ = tid >> 3, kc_ = (tid & 7) * 8;
  const unsigned voK = (unsigned)(kr_ * LDK + kc_) * 2u; const int kwr = ATT_KSWZ(kr_, kc_ * 2, RB);
  const int vb0 = (int)(uintptr_t)V_lds + v_rd_base(lane);
  int kb[4];
#pragma unroll
  for (int k = 0; k < 4; ++k) kb[k] = r32 * RB + ((k ^ ((r32 & 7) >> 1)) * 32) + ((hi ^ (r32 & 1)) * 16);
  const int qpos = qpos0 + wrow * QBLK + r32;
  struct { bf16x8 vs0, vs1, ks[NCH]; } sr_[SD];
#define ATT_KROW(j) (WINDOW ? ((j) < 4 ? (j) * KVBLK : 256 + band_lo + ((j) - 4) * KVBLK) : (j) * KVBLK)
#define ATT_SLOAD(i, j) do { const int k0_ = ATT_KROW(j); const char* vt_ = (const char*)Vb + (size_t)k0_ * (LDV * 2); const char* kt_ = (const char*)Kb + (size_t)k0_ * (LDK * 2); \
    sr_[i].vs0 = *reinterpret_cast<const bf16x8*>(vt_ + voV); sr_[i].vs1 = *reinterpret_cast<const bf16x8*>(vt_ + voV + 32 * LDV * 2); \
    _Pragma("unroll") for (int c_ = 0; c_ < NCH; ++c_) sr_[i].ks[c_] = *reinterpret_cast<const bf16x8*>(kt_ + voK + c_ * 128); } while (0)
#define ATT_SWRITE(b, i) do { *(bf16x8*)(V_lds + (b) * SHM_V + vst0) = sr_[i].vs0; *(bf16x8*)(V_lds + (b) * SHM_V + vst0 + 8192) = sr_[i].vs1; \
    _Pragma("unroll") for (int c_ = 0; c_ < NCH; ++c_) *(bf16x8*)(K_lds + (b) * SHM_K + kwr + c_ * 128) = sr_[i].ks[c_]; } while (0)
  constexpr int SE = 0, SO = SD - 1;
  constexpr bool EARLY_KV = ATT_EARLY_KV && ATT_EARLY_OK(DQ, QMODE, DIFF, WINDOW);
  if constexpr (EARLY_KV) ATT_SLOAD(SE, 0);
  if constexpr (QMODE == 0) {
#pragma unroll
    for (int d0 = 0; d0 < NQR; ++d0) qr[d0] = *reinterpret_cast<const bf16x8*>((const char*)Qb + qoff + d0 * 32);
    __syncthreads();
    if constexpr (NQ > NQR) {
#pragma unroll
      for (int d0 = NQR; d0 < NQ; ++d0) *reinterpret_cast<bf16x8*>(qlds + (d0 - NQR) * 1024) = *reinterpret_cast<const bf16x8*>((const char*)Qb + qoff + d0 * 32);
    }
  } else {
    bf16x8 qall[NQ];
#pragma unroll
    for (int d0 = 0; d0 < NQ; ++d0) qall[d0] = *reinterpret_cast<const bf16x8*>((const char*)Qb + qoff + d0 * 32);
    q_fix<QMODE, NQ>(qall, qgain, qtab, qs0 < 0 ? -1 : qs0 + wrow * QBLK + r32, hi);
#pragma unroll
    for (int d0 = 0; d0 < NQR; ++d0) qr[d0] = qall[d0];
    __syncthreads();
    if constexpr (NQ > NQR) {
#pragma unroll
      for (int d0 = NQR; d0 < NQ; ++d0) *reinterpret_cast<bf16x8*>(qlds + (d0 - NQR) * 1024) = qall[d0];
    }
  }
#define ATT_SWAIT() do { if constexpr (SD == 1) asm volatile("s_waitcnt vmcnt(0)" ::: "memory"); else if constexpr (NCH == 1) asm volatile("s_waitcnt vmcnt(3)" ::: "memory"); else if constexpr (NCH == 2) asm volatile("s_waitcnt vmcnt(4)" ::: "memory"); else asm volatile("s_waitcnt vmcnt(5)" ::: "memory"); } while (0)
#define ATT_RESC(a) do { if (__any((a) < 1.f)) { if (hi == 0) al_l[r32] = (a); asm volatile("s_waitcnt lgkmcnt(0)" ::: "memory"); \
    _Pragma("unroll") for (int d = 0; d < 4; ++d) _Pragma("unroll") for (int r = 0; r < 16; ++r) o[d][r] *= al_l[crow(r, hi)]; } } while (0)
#define ATT_MASK(P0, P1, j) do { if constexpr (WINDOW) { if ((j) >= 4) mask_tile(P0, P1, band_lo + ((j) - 4) * KVBLK, qpos, hi); } } while (0)
  f32x16 pA0, pA1, pB0, pB1; float mnA, mnB, alA, alB; bf16x8 pa0, pa1, pa2, pa3; const int NT = ntiles;
  if constexpr (!EARLY_KV) ATT_SLOAD(SE, 0);
  asm volatile("s_waitcnt vmcnt(0)" ::: "memory"); ATT_SWRITE(0, SE); __syncthreads();
  qkt<DQ, NQ, NQR, QSB>(pA0, pA1, K_lds + kcomp, qr, qlds, kb); ATT_MASK(pA0, pA1, 0); partialSM(pA0, pA1, m_reg, mnA, alA, C, thr_raw);
  ATT_SLOAD(SO, 1); if constexpr (SD == 2) { if (2 < NT) ATT_SLOAD(SE, 2); }
  ATT_SWAIT(); ATT_SWRITE(1, SO); __syncthreads();
  for (int j = 1; j + 1 < NT; j += 2) {
    ATT_SBAR(); qkt<DQ, NQ, NQR, QSB>(pB0, pB1, K_lds + SHM_K + kcomp, qr, qlds, kb);
    finishSM(pA0, pA1, alA, l_reg, pa0, pa1, pa2, pa3); ATT_SBAR();
    ATT_SLOAD(SO, j + SD); ATT_SBAR();
    pv_d0(o, vb0, pa0, pa1, pa2, pa3); ATT_MASK(pB0, pB1, j); partialSM(pB0, pB1, m_reg, mnB, alB, C, thr_raw);
    __syncthreads(); ATT_SWAIT(); ATT_SWRITE(0, SE);
    ATT_RESC(alB); __syncthreads();
    ATT_SBAR(); qkt<DQ, NQ, NQR, QSB>(pA0, pA1, K_lds + kcomp, qr, qlds, kb);
    finishSM(pB0, pB1, alB, l_reg, pa0, pa1, pa2, pa3); ATT_SBAR();
    if (SD == 1 || j + 3 < NT) ATT_SLOAD(SE, j + 1 + SD); ATT_SBAR();
    pv_d0(o, vb0 + SHM_V, pa0, pa1, pa2, pa3); ATT_MASK(pA0, pA1, j + 1); partialSM(pA0, pA1, m_reg, mnA, alA, C, thr_raw);
    __syncthreads(); ATT_SWAIT(); ATT_SWRITE(1, SO);
    ATT_RESC(alA); __syncthreads();
  }
  ATT_SBAR(); qkt<DQ, NQ, NQR, QSB>(pB0, pB1, K_lds + SHM_K + kcomp, qr, qlds, kb);
  finishSM(pA0, pA1, alA, l_reg, pa0, pa1, pa2, pa3); ATT_SBAR();
  pv_d0(o, vb0, pa0, pa1, pa2, pa3); ATT_MASK(pB0, pB1, NT - 1); partialSM(pB0, pB1, m_reg, mnB, alB, C, thr_raw);
  __syncthreads(); ATT_RESC(alB);
  finishSM(pB0, pB1, alB, l_reg, pa0, pa1, pa2, pa3); ATT_SBAR();
  pv_d0(o, vb0 + SHM_V, pa0, pa1, pa2, pa3);
  if constexpr (SINK) l_reg += __builtin_amdgcn_exp2f(sink * 1.4426950408889634f - m_reg * C);
  if (hi == 0) li_l[r32] = l_reg; asm volatile("s_waitcnt lgkmcnt(0)" ::: "memory");
  float rli[16];
#pragma unroll
  for (int r = 0; r < 16; ++r) rli[r] = __builtin_amdgcn_rcpf(li_l[crow(r, hi)]);
  int tid2 = wv * 64 + lane_id_(); asm volatile("" : "+v"(tid2));
  if constexpr (!DIFF) {
    const bool odd = tid2 & 1;
    const unsigned ooff = (unsigned)(((tid2 >> 6) * QBLK + 4 * ((tid2 >> 5) & 1) + (tid2 & 1)) * LDO + (tid2 & 30)) * 2u;
#pragma unroll
    for (int rp = 0; rp < 8; ++rp) { const int orow = ((2 * rp) & 3) + 8 * ((2 * rp) >> 2);
#pragma unroll
      for (int d0 = 0; d0 < 4; ++d0) { const float a_ = o[d0][2 * rp] * rli[2 * rp], b_ = o[d0][2 * rp + 1] * rli[2 * rp + 1];
        const float rc = swz_xor<1>(odd ? a_ : b_);
        *reinterpret_cast<unsigned*>((char*)Ob + ooff + (orow * LDO + d0 * 32) * 2) = odd ? cvtpk(rc, b_) : cvtpk(a_, rc); } }
  } else {
    float* X = (float*)lds + ((tid2 >> 6) & 3) * 4096 + (tid2 & 63);
    __syncthreads();
    if (tid2 >= 256) {
#pragma unroll
      for (int d0 = 0; d0 < 4; ++d0)
#pragma unroll
        for (int r = 0; r < 16; ++r) X[(d0 * 16 + r) * 64] = sink * (o[d0][r] * rli[r]);
    }
    __syncthreads();
    if (tid2 < 256) {
      float g[4];
#pragma unroll
      for (int d0 = 0; d0 < 4; ++d0) g[d0] = gainp[d0 * 32 + (tid2 & 31)];
      const bool odd = tid2 & 1;
      const unsigned ooff = (unsigned)(((tid2 >> 6) * QBLK + 4 * ((tid2 >> 5) & 1) + (tid2 & 1)) * LDO + (tid2 & 30)) * 2u;
#pragma unroll
      for (int rp = 0; rp < 8; ++rp) { const int orow = ((2 * rp) & 3) + 8 * ((2 * rp) >> 2);
        float da[4], db[4], sa = 0.f, sb = 0.f;
#pragma unroll
        for (int d0 = 0; d0 < 4; ++d0) { da[d0] = o[d0][2 * rp] * rli[2 * rp] - X[(d0 * 16 + 2 * rp) * 64]; db[d0] = o[d0][2 * rp + 1] * rli[2 * rp + 1] - X[(d0 * 16 + 2 * rp + 1) * 64]; sa += da[d0] * da[d0]; sb += db[d0] * db[d0]; }
        sa += swz_xor<1>(sa); sa += swz_xor<2>(sa); sa += swz_xor<4>(sa); sa += swz_xor<8>(sa); sa += swz_xor<16>(sa);
        sb += swz_xor<1>(sb); sb += swz_xor<2>(sb); sb += swz_xor<4>(sb); sb += swz_xor<8>(sb); sb += swz_xor<16>(sb);
        const float ra = __builtin_amdgcn_rsqf(sa * (1.0f / 128.0f) + 1e-6f), rb = __builtin_amdgcn_rsqf(sb * (1.0f / 128.0f) + 1e-6f);
#pragma unroll
        for (int d0 = 0; d0 < 4; ++d0) { const float a_ = da[d0] * ra * g[d0], b_ = db[d0] * rb * g[d0];
          const float rc = swz_xor<1>(odd ? a_ : b_);
          *reinterpret_cast<unsigned*>((char*)Ob + ooff + (orow * LDO + d0 * 32) * 2) = odd ? cvtpk(rc, b_) : cvtpk(a_, rc); } }
    }
  }
#undef ATT_KROW
#undef ATT_SLOAD
#undef ATT_SWRITE
#undef ATT_SWAIT
#undef ATT_RESC
#undef ATT_MASK
}
}

__device__ __forceinline__ void p_even_attn(const Frame& F, const Args& a, char* lds) {
    const LocalId L_ = local_id(); (void)L_;
    const bf16* Y1 = (const bf16*)(F.ws + WS_Y1); const bf16* QB = (const bf16*)(F.ws + WS_QB); const bf16* KV = (const bf16*)(F.ws + WS_KV); const bf16* KB = (const bf16*)(F.ws + WS_KB);
    bf16* MIX = (bf16*)(F.ws + WS_MIX);
    const float* t128 = (const float*)(F.ws + WS_ROPE); const float* t64 = (const float*)(F.ws + WS_ROPE + 16384);
    for (int n = blockIdx.x; n < 512 + 64; n += F.G) {
        int b, h, row0, nt, qs0;
        if (n < 512) { const int i = n >> 8, c = n & 255, x = c & 7, lc = c >> 3, gi = i * 8 + x; b = gi >> 1; h = (gi & 1) * 4 + (lc >> 3); qs0 = (lc & 7) * 256; row0 = b * TPB + CTX + qs0; nt = 36; }
        else { const int m = n - 512; b = m >> 3; h = m & 7; row0 = b * TPB; nt = 4; qs0 = -1; }
        const size_t kb = (size_t)b * TPB;
        att::attn_unit<128, false, false, EVEN_IN_P, EVEN_IN_P, EVEN_IN_P, 2, 0, 8, false, 1>(Y1 + (size_t)row0 * EVEN_IN_P + h * 128, Y1 + kb * EVEN_IN_P + 1024 + (h >> 2) * 128, Y1 + kb * EVEN_IN_P + 1280 + (h >> 2) * 128,
                                                                                 MIX + (size_t)row0 * DM + h * 128, nt, 0, 0, 0.08838834764831845f, 0.f, lds, nullptr, a.in[I_AQN], t128, qs0, L_.wave);
    }
    for (int n = blockIdx.x; n < 512 + 64; n += F.G) {
        int b, h, row0, nt, qs0;
        if (n < 512) { const int i = n >> 8, c = n & 255, x = c & 7, lc = c >> 3, gi = i * 8 + x; b = gi >> 1; h = (gi & 1) * 4 + (lc >> 3); qs0 = (lc & 7) * 256; row0 = b * TPB + CTX + qs0; nt = 36; }
        else { const int m = n - 512; b = m >> 3; h = m & 7; row0 = b * TPB; nt = 4; qs0 = -1; }
        const size_t kb = (size_t)b * TPB;
        att::attn_unit<192, false, false, 1536, 1536, 2048, 1, 0, 8, false, 2>(QB + (size_t)row0 * 1536 + h * 192, KB + kb * 1536 + h * 192, KV + kb * 2048 + h * 256 + 128,
                                                                  MIX + (size_t)row0 * DM + 1024 + h * 128, nt, 0, 0, 0.07216878364870322f, 0.f, lds, nullptr, a.in[I_BQN], t64, qs0, L_.wave);
    }
    __syncthreads();
}
__device__ __forceinline__ void p_odd_attn(const Frame& F, const Args& a, char* lds) {
    const LocalId L_ = local_id(); (void)L_;
    const bf16* Y1 = (const bf16*)(F.ws + WS_Y1); bf16* O12 = (bf16*)(F.ws + WS_A1); bf16* MIX = (bf16*)(F.ws + WS_MIX);
#if ATT_DIFF_FUSED
    float d1 = 0.f, d2 = 0.f;
    for (int i = 0; i < 64; ++i) { d1 += a.in[I_LQ1][i] * a.in[I_LK1][i]; d2 += a.in[I_LQ2][i] * a.in[I_LK2][i]; }
    const float lam = expf(d1) - expf(d2) + LAMBDA_INIT;
    const float* gsub = (const float*)(F.ws + WS_ROPE + 32768);
    for (int n = blockIdx.x; n < 1024; n += F.G) {
        const int i = n >> 8, c = n & 255, x = c & 7, lc = c >> 3, gi = i * 8 + x, b = gi >> 2, h = (gi & 3) * 2 + (lc >> 4), row0 = b * TPB + CTX + (lc & 15) * 128;
        const size_t kb = (size_t)b * TPB * ODD_IN;
        att::attn_unit<128, false, false, ODD_IN, ODD_IN, ODD_IN, 2, 0, 8, true, 3>(Y1 + (size_t)row0 * ODD_IN + h * 128, Y1 + kb + 1024 + h * 128, Y1 + kb + 2048 + h * 128,
                                                                             MIX + (size_t)row0 * DM + h * 128, 36, 0, 0, 0.125f, lam, lds, gsub, a.in[I_CQN], (const float*)(F.ws + WS_ROPE + 16384), (lc & 15) * 128, L_.wave);
    }
#else
    for (int n = blockIdx.x; n < 1024; n += F.G) {
        const int i = n >> 8, c = n & 255, x = c & 7, lc = c >> 3, gi = i * 8 + x, b = gi >> 2, ch = (gi & 3) * 4 + (lc >> 3), row0 = b * TPB + CTX + (lc & 7) * 256;
        const size_t kb = (size_t)b * TPB * ODD_IN;
        att::attn_unit<64, false, false, ODD_IN, ODD_IN, ODD_IN, 2, 0, 8>(Y1 + (size_t)row0 * ODD_IN + ch * 64, Y1 + kb + 1024 + ch * 64, Y1 + kb + 2048 + (ch >> 1) * 128,
                                                                       O12 + (size_t)row0 * DM + ch * 128, 36, 0, 0, 0.125f, 0.f, lds, nullptr, nullptr, nullptr, -1, L_.wave);
    }
#endif
    for (int m = blockIdx.x; m < 512; m += F.G) {
        const int i = m >> 8, c = m & 255, x = c & 7, lc = c >> 3, gi = i * 8 + x, b = gi >> 1, kvh = gi & 1, h = kvh * 4 + (lc >> 3), s0 = (lc & 7) * 256, row0 = b * TPB + CTX + s0;
        const int lo = s0 - 128 < 0 ? 0 : s0 - 128, hie = s0 + 384 > SEQ ? SEQ : s0 + 384;
        const size_t kb = (size_t)b * TPB * ODD_IN;
        att::attn_unit<128, true, true, ODD_IN, ODD_IN, ODD_IN, 1, 0, 8, false, 1>(Y1 + (size_t)row0 * ODD_IN + 3072 + h * 128, Y1 + kb + 4096 + kvh * 128, Y1 + kb + 4352 + kvh * 128,
                                                                      MIX + (size_t)row0 * DM + 1024 + h * 128, 4 + (hie - lo) / 64, lo, s0, 0.08838834764831845f, a.in[I_SINK][h], lds, nullptr, a.in[I_DQN], (const float*)(F.ws + WS_ROPE), s0, L_.wave);
    }
    __syncthreads();
}
__device__ __forceinline__ void p_odd_combine(const Frame& F, const Args& a) {
    const LocalId L_ = local_id(); (void)L_;
    const int gw = F.vcu * NWAVES + L_.wave, NGW = F.G * NWAVES;
    const bf16* O12 = (const bf16*)(F.ws + WS_A1); bf16* MIX = (bf16*)(F.ws + WS_MIX);
    float d1 = 0.f, d2 = 0.f;
    for (int i = 0; i < 64; ++i) { d1 += a.in[I_LQ1][i] * a.in[I_LK1][i]; d2 += a.in[I_LQ2][i] * a.in[I_LK2][i]; }
    const float lam = expf(d1) - expf(d2) + LAMBDA_INIT;
    const float g0 = a.in[I_SUBLN][L_.lane] * (1.0f - LAMBDA_INIT), g1 = a.in[I_SUBLN][L_.lane + 64] * (1.0f - LAMBDA_INIT);
    for (int i = gw; i < NB * SEQ; i += NGW) {
        const int b = i / SEQ, row = b * TPB + CTX + (i - b * SEQ);
        const bf16* src = O12 + (size_t)row * DM; bf16* dst = MIX + (size_t)row * DM;
        for (int h = 0; h < 8; ++h) {
            const float x0 = bf2f(src[2 * h * 128 + L_.lane]) - lam * bf2f(src[(2 * h + 1) * 128 + L_.lane]);
            const float x1 = bf2f(src[2 * h * 128 + 64 + L_.lane]) - lam * bf2f(src[(2 * h + 1) * 128 + 64 + L_.lane]);
            const float ss = wave_sum(x0 * x0 + x1 * x1);
            const float r = 1.0f / sqrtf(ss * (1.0f / 128.0f) + NORM_EPS);
            dst[h * 128 + L_.lane] = (bf16)f2bf(x0 * r * g0); dst[h * 128 + 64 + L_.lane] = (bf16)f2bf(x1 * r * g1);
        }
    }
}

#ifndef FILL_S
#define FILL_S 2
#endif
#ifndef FILL_B
#define FILL_B 2
#endif
constexpr unsigned NCHUNK = 64u * 3072u / (8u * FILL_S), NCHUNK_L0 = NCHUNK / 2u, NCHUNK_L1GU = NCHUNK / 6u * 5u, FILL_NONE = 0xffffffffu;
template <bool BARRIER>
__device__ __forceinline__ void fill_loop(const Frame& F, const Args& a, unsigned* xgen, unsigned gen, unsigned lim) {
    const LocalId L_ = local_id();
    volatile LAS unsigned* st = F.MISC + 8;
    unsigned* ctr = (unsigned*)(F.ctl + CW_ITEM);
    unsigned cur = st[6] - 1u, nxt = st[7] - 1u; int s0 = (int)(st[16 + L_.wave] & 255u);
    __syncthreads();
    if (cur == FILL_NONE) { cur = nxt; nxt = FILL_NONE; s0 = 0; }
    if (cur == FILL_NONE) {
        if (L_.tid == 0) { const bool rel = BARRIER && xb_ld(xgen) != gen; st[5] = rel ? FILL_NONE : xb_add(ctr, 1u); }
        __syncthreads();
        cur = st[5];
        __syncthreads();
    }
    for (;;) {
        if (cur >= NCHUNK) { cur = FILL_NONE; nxt = FILL_NONE; s0 = 0; break; }
        if (!BARRIER && cur >= lim) break;
        unsigned nid = nxt;
        if (nxt == FILL_NONE && L_.tid == 0) nid = xb_add(ctr, 1u);
        int sN = s0; bool relw = false;
#pragma unroll 1
        for (; sN < FILL_S && !relw; sN += FILL_B) {
            const int r = (int)cur * (8 * FILL_S) + 8 * sN + L_.wave;
            TrAddr t[FILL_B]; f32x4 v[FILL_B][8];
#pragma unroll
            for (int j = 0; j < FILL_B; ++j) { t[j] = moe_item_addr(F, a, r + 8 * j); tr_load(v[j], t[j], L_.lane); }
            unsigned g = gen; if (BARRIER) g = (unsigned)__builtin_amdgcn_readfirstlane(xb_ld(xgen));
#pragma unroll
            for (int j = 0; j < FILL_B; ++j) tr_store(v[j], t[j], L_.lane);
            relw = (g != gen);
        }
        if (L_.lane == 0) st[16 + L_.wave] = (unsigned)sN | (relw ? 256u : 0u);
        if (L_.tid == 0) st[5] = nid;
        __syncthreads();
        nid = st[5]; bool partial = false, rel = false;
#pragma unroll
        for (int w = 0; w < NWAVES; ++w) { const unsigned x = st[16 + w]; partial = partial || ((x & 255u) < (unsigned)FILL_S); rel = rel || (x >= 256u); }
        __syncthreads();
        if (partial) { nxt = nid; s0 = sN; break; }
        cur = nid; nxt = FILL_NONE; s0 = 0;
        if (rel) break;
    }
    if (nxt != FILL_NONE && nxt >= NCHUNK) nxt = FILL_NONE;
    if (L_.lane == 0) st[16 + L_.wave] = (unsigned)s0;
    if (L_.tid == 0) { st[6] = cur + 1u; st[7] = nxt + 1u; }
    __syncthreads();
}
__device__ __forceinline__ void fill_until(const Frame& F, const Args& a, unsigned lim) { __syncthreads(); fill_loop<false>(F, a, nullptr, 0u, lim); }
__device__ __forceinline__ void xcd_barrier_fill(const XcdBarrier& b, const Frame& F, const Args& a) {
    asm volatile("s_waitcnt vmcnt(0)" ::: "memory");
    __syncthreads();
    volatile LAS unsigned* st = b.st;
    if (threadIdx.x == 0) {
        unsigned* bar = b.bar;
        __builtin_amdgcn_s_waitcnt(0);
        unsigned nloc = st[0], nx = st[1];
        if (nloc == 0u) { xcd_barrier_complete(bar, b.x, nloc, nx); st[0] = nloc; st[1] = nx; }
        const unsigned old = xb_add(&bar[XB_XSUB(b.x)], 1u);
        const unsigned gen = old / nloc;
        if (old + 1u == (gen + 1u) * nloc) {
            __builtin_amdgcn_fence(__ATOMIC_RELEASE, "agent");
            asm volatile("s_waitcnt vmcnt(0)" ::: "memory");
            const unsigned og = xb_add(&bar[XB_TOP], 1u);
            const unsigned tg = og / nx;
            if (og + 1u == (tg + 1u) * nx) xb_add(&bar[XB_TOPGEN], 1u);
            else XB_SPIN(xb_ld(&bar[XB_TOPGEN]) == tg, bar);
            __builtin_amdgcn_fence(__ATOMIC_ACQUIRE, "agent");
            xb_add(&bar[XB_XGEN(b.x)], 1u);
            asm volatile("s_waitcnt vmcnt(0)" ::: "memory");
            st[2] = 1u;
        } else { st[2] = 0u; st[3] = gen; }
    }
    __syncthreads();
    if (st[2] == 0u) {
        const unsigned gen = st[3];
        unsigned* xgen = &b.bar[XB_XGEN(b.x)];
        fill_loop<true>(F, a, xgen, gen, 0u);
        if (threadIdx.x == 0) {
            XB_SPIN(xb_ld(xgen) == gen, b.bar);
            __builtin_amdgcn_fence(__ATOMIC_ACQUIRE, "agent");
            asm volatile("s_waitcnt vmcnt(0)" ::: "memory");
        }
    }
    __syncthreads();
}

__device__ __forceinline__ int geff(int n, int G, int xr = 0) {
#if BG_CONVERT && !MK_PER_PHASE && BG_GEFF
    if (G % 8 != 0 || n <= 0) return G;
    const int rounds = (n + G - 1) / G + xr, g = ((n + rounds - 1) / rounds + 7) & ~7;
    return g < G ? g : G;
#else
    return G;
#endif
}
#ifndef Y1O_NT
#define Y1O_NT 0
#endif
#ifndef YS_NT
#define YS_NT 0
#endif
#ifndef XR_GEMM1E
#define XR_GEMM1E 0
#endif
#ifndef XR_GEMM3E
#define XR_GEMM3E 0
#endif
#ifndef XR_MOE_UP0
#define XR_MOE_UP0 0
#endif
#ifndef XR_MOE_DN0
#define XR_MOE_DN0 0
#endif
#ifndef XR_GEMM1O
#define XR_GEMM1O 0
#endif

__global__ void __launch_bounds__(NWAVES * 64, 2) trunk_fwd(Args args) {
    extern __shared__ __attribute__((aligned(16))) unsigned char lds[];
    Frame F;
    F.lds = (LAS unsigned char*)lds;
    F.MISC = (volatile LAS unsigned*)(F.lds + MISC_OFF);
    F.tid = threadIdx.x; F.lane = F.tid & 63; F.wave = __builtin_amdgcn_readfirstlane(F.tid >> 6);
    F.G = gridDim.x; { const int bx = blockIdx.x; F.vcu = (F.G % 8 == 0) ? (bx % 8) * (F.G / 8) + bx / 8 : bx; }
    F.ws = args.ws; F.ctl = (gu32*)(args.ws + WS_CTL);
    for (int u = F.tid; u < (LDS_BYTES - LDSCTL_OFF) / 4; u += NWAVES * 64) ((LAS unsigned*)(F.lds + LDSCTL_OFF))[u] = 0u;
    __syncthreads();
    XcdBarrier bar; bar.bar = (unsigned*)(F.ctl + CW_BAR); bar.x = 0; bar.st = nullptr;
#if !MK_PER_PHASE
    bar = xcd_barrier_post((unsigned*)(F.ctl + CW_BAR), F.MISC + 8);
#endif
    const int lo = args.ph_lo, hi = args.ph_hi;
#define IN(k) (lo <= (k) && (k) < hi)
#if MK_PER_PHASE
#define SEAM(k) do { } while (0)
#else
#define SEAM(k) do { if (IN(k) && IN((k) + 1)) xcd_barrier(bar); } while (0)
#endif
#if BG_CONVERT && !MK_PER_PHASE && BG_FILL
#define SEAMF(k) do { if (IN(k) && IN((k) + 1)) xcd_barrier_fill(bar, F, args); } while (0)
#else
#define SEAMF(k) SEAM(k)
#endif
    bf16* const A1 = (bf16*)(F.ws + WS_A1); bf16* const MIX = (bf16*)(F.ws + WS_MIX); bf16* const H = (bf16*)(F.ws + WS_H); const float* const MOD = (const float*)(F.ws + WS_MOD);
    PG8_LAS unsigned char* const ring = (PG8_LAS unsigned char*)(F.lds + RING_OFF);

#ifndef DUP_PHASE
#define DUP_PHASE (-1)
#endif
#ifndef PROBE_PHASE
#define PROBE_PHASE (-1)
#endif
constexpr size_t WS_DUMMY = 1600 * MiB;
#define PROBE(k, ...) do { if (PROBE_PHASE == (k) && IN(k)) { for (int r_ = 0; r_ < 3; ++r_) { __VA_ARGS__ xcd_barrier(bar); } } } while (0)
#define PH(k, ...) do { if (IN(k)) { __VA_ARGS__ if (DUP_PHASE == (k)) { for (int r_ = 0; r_ < 3; ++r_) { xcd_barrier(bar); __VA_ARGS__ } } } SEAM(k); } while (0)
#if BG_CONVERT
#define FILL_UNTIL(lim) fill_until(F, args, (lim))
#else
#define FILL_UNTIL(lim) do { } while (0)
#endif
#define PHF(k, ...) do { if (IN(k)) { __VA_ARGS__ if (DUP_PHASE == (k)) { for (int r_ = 0; r_ < 3; ++r_) { xcd_barrier(bar); __VA_ARGS__ } } } SEAMF(k); } while (0)
#define GEMM_STATIC(GE, EPI, Aptr, Bptr, N_, K_, ...) do { if ((int)blockIdx.x < (GE)) { pg8::Gemm g{(const bf16*)(Aptr), (const bf16*)(Bptr), (K_), (K_), (K_), nullptr}; pg8::StaticOrder S; S.init(T, (N_), (GE), (int)blockIdx.x); \
        pg8::EPI E{__VA_ARGS__}; pg8::gemm_phase<pg8::EPI, pg8::StaticOrder, false>(ring, g, S, E, F.wave); } } while (0)
#ifndef MOE_F32B
#define MOE_F32B 0
#endif
#define GEMM_MOE_F(EPI, GATH, Aptr, M0, M1, ESTR, LDN, COLMUL, HOFF, K_, layer, ...) do { const int nrt = __builtin_amdgcn_readfirstlane(*(const int*)(F.ctl + CW_NRT + (layer) * 64)); \
        pg8::Gemm g{(const bf16*)(Aptr), nullptr, (K_), 0, (K_), (const int*)(F.ctl + CW_SLOT + (layer) * MAXSLOT)}; pg8::BSrc bs{(M0), (M1), (size_t)(ESTR), (LDN), (COLMUL), (HOFF)}; \
        pg8::MoeOrder S; S.init((const int*)(F.ctl + CW_TEXP + (layer) * 256), nrt, F.G, (int)blockIdx.x); \
        pg8::EPI E{__VA_ARGS__}; pg8::gemm_phase_f32b<pg8::EPI, pg8::MoeOrder, GATH>(ring, g, bs, S, E, F.wave); } while (0)
#define GEMM_MOE_CHAIN(layer, Bgu, Bdn) do { const int nrt = __builtin_amdgcn_readfirstlane(moe_tables(F, (layer), F.wave * 64 + lane_id_())); \
        const PG8_LAS int* texp_ = (const PG8_LAS int*)(F.lds + LDS_TAB); unsigned* rdy_ = (unsigned*)(F.ctl + CW_RDY + (layer) * 16384); \
        { pg8::Gemm g{(const bf16*)A1, (const bf16*)(Bgu), DM, DM, DM, (const int*)(ws + WS_POS) + (size_t)(layer) * NE * POSCAP}; pg8::MoePublishOrder S; S.init(texp_, texp_ + 256, nrt, POSCAP, F.G, (int)blockIdx.x); S.ready = rdy_; \
          pg8::EpiSwiGLUwt E{(bf16*)(ws + WS_U), DE}; pg8::gemm_phase<pg8::EpiSwiGLUwt, pg8::MoePublishOrder, true>(ring, g, S, E, F.wave); } \
        { pg8::Gemm g{(const bf16*)(ws + WS_U), (const bf16*)(Bdn), DE, DE, DE, nullptr}; pg8::MoeCountedOrder S; S.init(texp_, texp_ + 256, nrt, POSCAP, F.G, (int)blockIdx.x); S.ready = rdy_; S.need = 64u; S.tmo = (unsigned*)F.ctl; S.wv = F.wave; \
          pg8::EpiStoreBf16 E{(bf16*)(ws + WS_YS), DM, 7}; pg8::gemm_phase<pg8::EpiStoreBf16, pg8::MoeCountedOrder, false>(ring, g, S, E, F.wave); } } while (0)
#define GEMM_ORDER(EPI, ORDER, INIT, Aptr, Bptr, K_, ...) do { pg8::Gemm g{(const bf16*)(Aptr), (const bf16*)(Bptr), (K_), (K_), (K_), nullptr}; pg8::ORDER S; S.init INIT; \
        pg8::EPI E{__VA_ARGS__}; pg8::gemm_phase<pg8::EPI, pg8::ORDER, false>(ring, g, S, E, F.wave); } while (0)
#define GEMM_ORDER_G(GE, EPI, ORDER, INIT, Aptr, Bptr, K_, ...) do { const int ge_ = (GE); if ((int)blockIdx.x < ge_) { pg8::Gemm g{(const bf16*)(Aptr), (const bf16*)(Bptr), (K_), (K_), (K_), nullptr}; pg8::ORDER S; S.init INIT; \
        pg8::EPI E{__VA_ARGS__}; pg8::gemm_phase<pg8::EPI, pg8::ORDER, false>(ring, g, S, E, F.wave); } } while (0)
#define GEMM_ROUTER_X(Bptr) do { pg8::Gemm g{(const bf16*)A1, (const bf16*)(Bptr), DM, DM, DM / RKS, nullptr}; pg8::SplitKXOrder S; S.init(RKS, DM / RKS, F.G, (int)blockIdx.x); \
        pg8::EpiLogits E{(float*)(ws + WS_LG), DM / RKS, (size_t)T * 64}; pg8::gemm_phase<pg8::EpiLogits, pg8::SplitKXOrder, false>(ring, g, S, E, F.wave); } while (0)
#define GEMM_ROUTER(Bptr) do { pg8::Gemm g{(const bf16*)A1, (const bf16*)(Bptr), DM, DM, DM / RKS, nullptr}; pg8::SplitKOrder S; S.init(T / 256, RKS, DM / RKS, F.G, (int)blockIdx.x); \
        pg8::EpiLogits E{(float*)(ws + WS_LG), DM / RKS, (size_t)T * 64}; pg8::gemm_phase<pg8::EpiLogits, pg8::SplitKOrder, false>(ring, g, S, E, F.wave); } while (0)
#define GEMM_MOE(XR, EPI, GATH, Aptr, Bptr, K_, layer, ...) do { const int nrt = __builtin_amdgcn_readfirstlane(moe_tables(F, (layer), F.wave * 64 + lane_id_())); \
        const int ge_ = geff(nrt * 8, F.G, (XR)); if ((int)blockIdx.x < ge_) { \
        pg8::Gemm g{(const bf16*)(Aptr), (const bf16*)(Bptr), (K_), (K_), (K_), (const int*)(ws + WS_POS) + (size_t)(layer) * NE * POSCAP}; pg8::MoeOrder S; \
        S.init((const PG8_LAS int*)(F.lds + LDS_TAB), (const PG8_LAS int*)(F.lds + LDS_TAB) + 256, nrt, POSCAP, ge_, (int)blockIdx.x); \
        pg8::EPI E{__VA_ARGS__}; pg8::gemm_phase<pg8::EPI, pg8::MoeOrder, GATH>(ring, g, S, E, F.wave); } } while (0)
    unsigned char* const ws = F.ws;
    PH(0, p0_prologue(F, args););
    PH(1, p_l0_mod1(F, args););
#ifdef NEXTRA_BAR
    for (int i_ = 0; i_ < NEXTRA_BAR; ++i_) xcd_barrier(bar);
#endif
    PHF(2, GEMM_STATIC(geff(72 * (KR_IN_POST1 ? 10 : 11), F.G, XR_GEMM1E), EpiStoreBf16, A1, ws + WS_WE_IN, (KR_IN_POST1 ? 2560 : EVEN_IN_P), DM, (bf16*)(ws + WS_Y1), EVEN_IN_P, 0x7fffffff););
    PROBE(3, p_even_post1(F, args, WS_DUMMY););
    PH(3, p_even_post1(F, args););
    PHF(4, GEMM_ORDER(EpiProj2, Proj2Order, (T, F.G, (int)blockIdx.x), ws + WS_CQN, ws + WS_WE_UQ, 512, (bf16*)(ws + WS_QB), (bf16*)(ws + WS_KV)););
    PH(5, p_even_post2(F, args););
#if USE_NAIVE_ATTN
    PH(6, p_even_attn_naive(F););
#else
    PHF(6, p_even_attn(F, args, (char*)lds););
#endif
    PHF(7, GEMM_STATIC(geff(72 * 8, F.G, XR_GEMM3E), EpiResidInit, MIX, ws + WS_WE_OUT, DM, DM, H, MOD + (size_t)0 * 9 * 12288 + 2 * 2048, args.in[I_X], args.in[I_CTX]););
#if FUSED_ROUTE
    PH(8, p_mod2_route(F, args, 0); FILL_UNTIL(NCHUNK_L0););
#else
    PH(8, p_mod2(F, 0););
    PH(9, GEMM_ROUTER(ws + WS_WR););
    PH(10, p_route(F, args, 0););
#endif
#if MOE_HANDOFF
    PH(12, GEMM_MOE_CHAIN(0, ws + WS_WGU, ws + WS_WDN););
#elif MOE_F32B
    PH(12, GEMM_MOE_F(EpiSwiGLU, true, A1, args.in[I_WG], args.in[I_WU], 2048 * 1024, 1024, 128, 0, DM, 0, (bf16*)(ws + WS_U), DE););
    PH(13, GEMM_MOE_F(EpiStoreBf16, false, ws + WS_U, args.in[I_WD], args.in[I_WD], 1024 * 2048, 2048, 256, 128, DE, 0, (bf16*)(ws + WS_YS), DM, 7););
#else
    PHF(12, GEMM_MOE(XR_MOE_UP0, EpiSwiGLU, true, A1, ws + WS_WGU, DM, 0, (bf16*)(ws + WS_U), DE););
    PHF(13, GEMM_MOE(XR_MOE_DN0, EpiStoreBf16, false, ws + WS_U, ws + WS_WDN, DE, 0, (bf16*)(ws + WS_YS), DM, 7, (bool)YS_NT););
#endif
    PROBE(14, p_l1_mod1(F, WS_DUMMY, WS_DUMMY + 160 * MiB););
    PH(14, p_l1_mod1(F););
    PHF(15, GEMM_ORDER_G(geff(64 * 18 + 80, F.G, XR_GEMM1O), EpiStoreBf16, OddInOrder, (ge_, (int)blockIdx.x), A1, ws + WS_WO_IN, DM, (bf16*)(ws + WS_Y1), ODD_IN, 0x7fffffff, (bool)Y1O_NT););
    PROBE(16, p_odd_post1(F, args, WS_DUMMY););
    PH(16, p_odd_post1(F, args););
#if USE_NAIVE_ATTN
    PH(17, p_odd_attn_naive(F, args););
    PH(18, ;);
#else
    PHF(17, p_odd_attn(F, args, (char*)lds););
#if !ATT_DIFF_FUSED
    PH(18, p_odd_combine(F, args););
#endif
#endif
    PHF(19, GEMM_ORDER(EpiResid, XOnlyOrder, (DM, F.G, (int)blockIdx.x), MIX, ws + WS_WO_OUT, DM, H, MOD + (size_t)1 * 9 * 12288 + 2 * 2048););
#if FUSED_ROUTE
    PH(20, p_mod2_route(F, args, 1); FILL_UNTIL(NCHUNK_L1GU););
#else
    PH(20, p_mod2(F, 1););
    PH(21, GEMM_ROUTER_X((const bf16*)(ws + WS_WR) + (size_t)256 * 2048););
    PH(22, p_route(F, args, 1););
#endif
#if MOE_HANDOFF
    PH(24, GEMM_MOE_CHAIN(1, (const bf16*)(ws + WS_WGU) + (size_t)32 * 2048 * 2048, (const bf16*)(ws + WS_WDN) + (size_t)32 * 2048 * 1024););
#elif MOE_F32B
    PH(24, GEMM_MOE_F(EpiSwiGLU, true, A1, args.in[I_WG] + (size_t)32 * 2048 * 1024, args.in[I_WU] + (size_t)32 * 2048 * 1024, 2048 * 1024, 1024, 128, 0, DM, 1, (bf16*)(ws + WS_U), DE););
    PH(25, GEMM_MOE_F(EpiStoreBf16, false, ws + WS_U, args.in[I_WD] + (size_t)32 * 1024 * 2048, args.in[I_WD] + (size_t)32 * 1024 * 2048, 1024 * 2048, 2048, 256, 128, DE, 1, (bf16*)(ws + WS_YS), DM, 7););
#else
    PHF(24, GEMM_MOE(0, EpiSwiGLU, true, A1, (const bf16*)(ws + WS_WGU) + (size_t)32 * 2048 * 2048, DM, 1, (bf16*)(ws + WS_U), DE); FILL_UNTIL(NCHUNK););
    PH(25, GEMM_MOE(0, EpiStoreBf16, false, ws + WS_U, (const bf16*)(ws + WS_WDN) + (size_t)32 * 2048 * 1024, DE, 1, (bf16*)(ws + WS_YS), DM, 7, (bool)YS_NT););
#endif
    PH(26, p_final(F, args.out););
#undef IN
#undef SEAM
}

extern "C" void kernel_launch(void* const* d_in, const int* in_sizes, int n_in, void* d_out, int out_size, void* d_ws, size_t ws_size, hipStream_t stream) {
    static int grid = 0;
    if (grid == 0) {
        if (n_in != 35 || out_size != NB * SEQ * DM || ws_size < WS_END) { fprintf(stderr, "kernel_launch: unexpected shapes: n_in %d out %d ws %zu (need %zu)\n", n_in, out_size, ws_size, (size_t)WS_END); grid = -1; return; }
        int dev = 0, cus = 0, per_cu = 0;
        if (hipGetDevice(&dev) != hipSuccess || hipDeviceGetAttribute(&cus, hipDeviceAttributeMultiprocessorCount, dev) != hipSuccess) { grid = -1; return; }
        if (hipFuncSetAttribute((const void*)trunk_fwd, hipFuncAttributeMaxDynamicSharedMemorySize, LDS_BYTES) != hipSuccess) { fprintf(stderr, "kernel_launch: hipFuncSetAttribute failed\n"); grid = -1; return; }
        if (hipOccupancyMaxActiveBlocksPerMultiprocessor(&per_cu, (const void*)trunk_fwd, NWAVES * 64, LDS_BYTES) != hipSuccess || per_cu < 1)
            fprintf(stderr, "kernel_launch: occupancy query reports %d workgroups per CU\n", per_cu);
        (void)hipGetLastError();
        grid = cus;
    }
    if (grid < 0) return;
    if (hipMemsetAsync((char*)d_ws + WS_CTL, 0, CTL_ZERO_BYTES, stream) != hipSuccess) { fprintf(stderr, "kernel_launch: memset failed\n"); return; }
    Args a{};
    for (int i = 0; i < 35; ++i) a.in[i] = (const float*)d_in[i];
    a.out = (float*)d_out; a.ws = (unsigned char*)d_ws;
#if MK_PER_PHASE
    for (int p = 0; p < NPHASE; ++p) { a.ph_lo = p; a.ph_hi = p + 1; hipLaunchKernelGGL(trunk_fwd, dim3(grid), dim3(NWAVES * 64), LDS_BYTES, stream, a); }
#else
    a.ph_lo = 0; a.ph_hi = NPHASE; hipLaunchKernelGGL(trunk_fwd, dim3(grid), dim3(NWAVES * 64), LDS_BYTES, stream, a);
#endif
    const hipError_t le = hipPeekAtLastError();
    if (le != hipSuccess) fprintf(stderr, "kernel_launch: launch failed: %s\n", hipGetErrorName(le));
}
```
